# Optimizing an MI355X kernel written in HIP

```python
import math
import jax, jax.numpy as jnp
from jax import lax
import numpy as np

D_MODEL = 1024
BATCH = 8
SEQ = 4096
DEPTH = 2

N_BRANCH = 4
BRANCH_W = D_MODEL // 4
HEAD_DIM = 64
POOL_WINDOWS = (2, 4, 8, 16)
POOL_GROUP = BRANCH_W // len(POOL_WINDOWS)
FOX_HEADS = BRANCH_W // HEAD_DIM
DSA_HEADS = BRANCH_W // HEAD_DIM
IDX_HEADS = 4
IDX_DIM = 64
DSA_TOPK = 256
CONV_W = 31
CONV_CH = BRANCH_W
N_GROUPS = 4
EXPERTS_PER_GROUP = 4
N_EXPERTS = N_GROUPS * EXPERTS_PER_GROUP
TOP_K_INNER = 2
D_FF_EXPERT = D_MODEL // 2

Q_BLOCK = 128
LN_EPS = 1e-5
NEG_INF = -1e30
DEEPNORM_ALPHA = (2.0 * DEPTH) ** 0.25
DEEPNORM_BETA = (8.0 * DEPTH) ** -0.25

SPLIT_SIZES = (
    BRANCH_W,
    FOX_HEADS * HEAD_DIM,
    FOX_HEADS * HEAD_DIM,
    FOX_HEADS * HEAD_DIM,
    FOX_HEADS,
    DSA_HEADS * HEAD_DIM,
    HEAD_DIM,
    HEAD_DIM,
    IDX_HEADS * IDX_DIM,
    IDX_DIM,
    IDX_HEADS,
    2 * CONV_CH,
    N_BRANCH * D_MODEL,
)
P_TOTAL = sum(SPLIT_SIZES)

kernel_name = "hybrid_pool_fox_dsa_conv_hmoe_deepnorm"


def layer_norm(x, g, b):
    xf = x.astype(jnp.float32)
    mu = jnp.mean(xf, axis=-1, keepdims=True)
    var = jnp.mean(jnp.square(xf - mu), axis=-1, keepdims=True)
    return ((xf - mu) * lax.rsqrt(var + LN_EPS) * g + b).astype(x.dtype)


def split_columns(p):
    outs, off = [], 0
    for n in SPLIT_SIZES:
        outs.append(p[..., off:off + n])
        off += n
    return outs


def pool_mixer(v, pool_w, pool_scale):
    B, S, C = v.shape
    vf = v.astype(jnp.float32)
    cs = jnp.cumsum(vf, axis=1)
    pos = jnp.arange(1, S + 1, dtype=jnp.float32)
    outs = []
    for g, w in enumerate(POOL_WINDOWS):
        sl = slice(g * POOL_GROUP, (g + 1) * POOL_GROUP)
        csg = cs[..., sl]
        lag = jnp.pad(csg, ((0, 0), (w, 0), (0, 0)))[:, :S]
        cnt = jnp.minimum(pos, float(w))[None, :, None]
        outs.append((csg - lag) / cnt - vf[..., sl])
    pooled = jnp.stack(outs, axis=2).astype(v.dtype)
    mixed = jnp.einsum('bsgc,gcd->bsgd', pooled, pool_w).reshape(B, S, C)
    return mixed * pool_scale


def fox_attention(q, k, v, f_logit):
    B, S, H, Dh = q.shape
    nb = S // Q_BLOCK
    scale = HEAD_DIM ** -0.5
    c = jnp.cumsum(jax.nn.log_sigmoid(f_logit.astype(jnp.float32)), axis=1)
    c_k = c.transpose(0, 2, 1)
    qb = q.reshape(B, nb, Q_BLOCK, H, Dh).swapaxes(0, 1)
    cb = c.reshape(B, nb, Q_BLOCK, H).swapaxes(0, 1)
    kpos = jnp.arange(S)

    def block(args):
        qi, ci, start = args
        qpos = start + jnp.arange(Q_BLOCK)
        s = jnp.einsum('bqhd,bkhd->bhqk', qi, k).astype(jnp.float32) * scale
        s = s + ci.transpose(0, 2, 1)[..., None] - c_k[:, :, None, :]
        s = jnp.where(kpos[None, :] <= qpos[:, None], s, NEG_INF)
        p = jax.nn.softmax(s, axis=-1).astype(v.dtype)
        return jnp.einsum('bhqk,bkhd->bqhd', p, v)

    out = lax.map(block, (qb, cb, jnp.arange(nb) * Q_BLOCK))
    return out.swapaxes(0, 1).reshape(B, S, H * Dh)


def dsa_attention(q, k, v, q_idx, k_idx, w_idx):
    B, S, H, Dh = q.shape
    nb = S // Q_BLOCK
    topk = min(DSA_TOPK, S // 4)
    scale = HEAD_DIM ** -0.5
    slopes = jnp.asarray([2.0 ** (-8.0 * (h + 1) / DSA_HEADS) for h in range(DSA_HEADS)],
                         dtype=jnp.float32)
    qb = q.reshape(B, nb, Q_BLOCK, H, Dh).swapaxes(0, 1)
    qib = q_idx.reshape(B, nb, Q_BLOCK, IDX_HEADS, IDX_DIM).swapaxes(0, 1)
    wib = w_idx.reshape(B, nb, Q_BLOCK, IDX_HEADS).swapaxes(0, 1)
    kpos = jnp.arange(S)
    gather = jax.vmap(lambda a, i: a[i])

    def block(args):
        qi, qii, wi, start = args
        qpos = start + jnp.arange(Q_BLOCK)
        rel = jax.nn.relu(jnp.einsum('bqhd,bkd->bqhk', qii, k_idx).astype(jnp.float32))
        score = jnp.einsum('bqhk,bqh->bqk', rel, wi.astype(jnp.float32))
        score = jnp.where(kpos[None, None, :] <= qpos[None, :, None], score, NEG_INF)
        _, idx = lax.top_k(score, topk)
        k_sel = gather(k, idx)
        v_sel = gather(v, idx)
        logits = jnp.einsum('bqhd,bqkd->bhqk', qi, k_sel).astype(jnp.float32) * scale
        dist = (qpos[None, :, None] - idx).astype(jnp.float32)
        logits = logits - slopes[None, :, None, None] * dist[:, None]
        valid = (idx <= qpos[None, :, None])[:, None]
        logits = jnp.where(valid, logits, NEG_INF)
        p = jax.nn.softmax(logits, axis=-1).astype(v.dtype)
        return jnp.einsum('bhqk,bqkd->bqhd', p, v_sel)

    out = lax.map(block, (qb, qib, wib, jnp.arange(nb) * Q_BLOCK))
    return out.swapaxes(0, 1).reshape(B, S, H * Dh)


def conv_module(a, conv_dw, conv_b, ln_g, ln_b):
    C = CONV_CH
    h = a[..., :C] * jax.nn.sigmoid(a[..., C:])
    y = lax.conv_general_dilated(h, conv_dw[:, None, :].astype(h.dtype), window_strides=(1,),
                                 padding=((CONV_W - 1, 0),),
                                 dimension_numbers=('NWC', 'WIO', 'NWC'),
                                 feature_group_count=C) + conv_b
    return jax.nn.silu(layer_norm(y, ln_g, ln_b))


def hier_moe(x, rg, rg_b, re, re_b, wg, wu, wd):
    B, S, D = x.shape
    t = x.reshape(-1, D)
    pg = jax.nn.softmax((t @ rg).astype(jnp.float32) + rg_b, axis=-1)
    pg_top, g_idx = lax.top_k(pg, 1)
    le = ((t @ re).astype(jnp.float32) + re_b).reshape(-1, N_GROUPS, EXPERTS_PER_GROUP)
    le = jnp.take_along_axis(le, g_idx[:, :, None], axis=1)[:, 0]
    pe_top, e_idx = lax.top_k(jax.nn.softmax(le, axis=-1), TOP_K_INNER)
    pe_top = pe_top / jnp.sum(pe_top, axis=-1, keepdims=True)
    gate = pg_top * pe_top
    expert_id = g_idx * EXPERTS_PER_GROUP + e_idx
    combine = jnp.sum(jax.nn.one_hot(expert_id, N_EXPERTS, dtype=jnp.float32) * gate[..., None],
                      axis=1)
    out = jnp.zeros(t.shape, jnp.float32)
    for e in range(N_EXPERTS):
        h = jax.nn.silu(t @ wg[e]) * (t @ wu[e])
        out = out + combine[:, e:e + 1] * (h @ wd[e]).astype(jnp.float32)
    return out.astype(x.dtype).reshape(B, S, D)


def setup_inputs(seed: int = 0) -> dict:
    key = jax.random.key(seed)
    ks = jax.random.split(key, 32)
    L, D = DEPTH, D_MODEL
    f32 = jnp.float32
    nrm = lambda k, shape, s: (jax.random.normal(k, shape, f32) * s)
    return {
        "x": nrm(ks[0], (BATCH, SEQ, D), 1.0),
        "ln_in_g": 1.0 + nrm(ks[1], (D,), 0.05),
        "ln_in_b": nrm(ks[2], (D,), 0.05),
        "w_in": nrm(ks[3], (L, D, P_TOTAL), D ** -0.5),
        "b_forget": 3.0 + nrm(ks[4], (L, FOX_HEADS), 0.5),
        "b_gate": nrm(ks[5], (L, N_BRANCH * D), 0.1),
        "pool_w": nrm(ks[6], (L, len(POOL_WINDOWS), POOL_GROUP, POOL_GROUP), POOL_GROUP ** -0.5),
        "pool_scale": 1.0 + nrm(ks[7], (L, BRANCH_W), 0.1),
        "conv_dw": nrm(ks[8], (L, CONV_W, CONV_CH), CONV_W ** -0.5),
        "conv_b": nrm(ks[9], (L, CONV_CH), 0.02),
        "conv_ln_g": 1.0 + nrm(ks[10], (L, CONV_CH), 0.05),
        "conv_ln_b": nrm(ks[11], (L, CONV_CH), 0.05),
        "w_branch": nrm(ks[12], (L, N_BRANCH, BRANCH_W, D), BRANCH_W ** -0.5),
        "w_out": nrm(ks[13], (L, D, D), D ** -0.5 * DEEPNORM_BETA),
        "ln1_g": 1.0 + nrm(ks[14], (L, D), 0.05),
        "ln1_b": nrm(ks[15], (L, D), 0.05),
        "router_g": nrm(ks[16], (L, D, N_GROUPS), D ** -0.5),
        "router_g_b": nrm(ks[17], (L, N_GROUPS), 0.01),
        "router_e": nrm(ks[18], (L, D, N_EXPERTS), D ** -0.5),
        "router_e_b": nrm(ks[19], (L, N_EXPERTS), 0.01),
        "expert_w_gate": nrm(ks[20], (L, N_EXPERTS, D, D_FF_EXPERT), D ** -0.5),
        "expert_w_up": nrm(ks[21], (L, N_EXPERTS, D, D_FF_EXPERT), D ** -0.5),
        "expert_w_down": nrm(ks[22], (L, N_EXPERTS, D_FF_EXPERT, D), D_FF_EXPERT ** -0.5 * DEEPNORM_BETA),
        "ln2_g": 1.0 + nrm(ks[23], (L, D), 0.05),
        "ln2_b": nrm(ks[24], (L, D), 0.05),
    }


def reference(x, ln_in_g, ln_in_b, w_in, b_forget, b_gate, pool_w, pool_scale, conv_dw, conv_b,
              conv_ln_g, conv_ln_b, w_branch, w_out, ln1_g, ln1_b, router_g, router_g_b,
              router_e, router_e_b, expert_w_gate, expert_w_up, expert_w_down, ln2_g, ln2_b):
    B, S, D = x.shape
    h = layer_norm(x, ln_in_g, ln_in_b)
    for l in range(DEPTH):
        (pool_v, fq, fk, fv, ff, dq, dk, dv, iq, ik, iw, conv_in, gate) = split_columns(h @ w_in[l])
        br_a = pool_mixer(pool_v, pool_w[l], pool_scale[l])
        br_b = fox_attention(fq.reshape(B, S, FOX_HEADS, HEAD_DIM),
                             fk.reshape(B, S, FOX_HEADS, HEAD_DIM),
                             fv.reshape(B, S, FOX_HEADS, HEAD_DIM),
                             ff + b_forget[l])
        br_c = dsa_attention(dq.reshape(B, S, DSA_HEADS, HEAD_DIM), dk, dv,
                             iq.reshape(B, S, IDX_HEADS, IDX_DIM), ik, iw)
        br_d = conv_module(conv_in, conv_dw[l], conv_b[l], conv_ln_g[l], conv_ln_b[l])
        branches = jnp.stack([br_a, br_b.astype(br_a.dtype), br_c.astype(br_a.dtype),
                              br_d.astype(br_a.dtype)], axis=2)
        up = jnp.einsum('bsnc,ncd->bsnd', branches, w_branch[l])
        g = jax.nn.sigmoid(gate.reshape(B, S, N_BRANCH, D) + b_gate[l].reshape(N_BRANCH, D))
        mixed = jnp.sum(g * up, axis=2) @ w_out[l]
        h = layer_norm(DEEPNORM_ALPHA * h + mixed, ln1_g[l], ln1_b[l])
        moe = hier_moe(h, router_g[l], router_g_b[l], router_e[l], router_e_b[l],
                       expert_w_gate[l], expert_w_up[l], expert_w_down[l])
        h = layer_norm(DEEPNORM_ALPHA * h + moe, ln2_g[l], ln2_b[l])
    return h
```

```cpp
#include <hip/hip_runtime.h>
#include <hip/hip_bf16.h>
#include <cstdio>
#include <cstdint>
#include <cmath>

constexpr int BATCH = 8, SEQ = 4096, DM = 1024, NTOK = BATCH * SEQ, DEPTH = 2;
constexpr int P_TOTAL = 6344, PS = 2304;
constexpr int C_POOL = 0, C_FQ = 256, C_FK = 512, C_FV = 768, C_DQ = 1024, C_IQ = 1280, C_CONV = 1536, C_DK = 2048, C_DV = 2112, C_IK = 2176, C_FF = 2240, C_IW = 2244;
constexpr float LN_EPS = 1e-5f;
constexpr float ALPHA = 1.4142135623730951f;
constexpr float LOG2E = 1.4426950408889634f;
constexpr int NWAVES = 8;
constexpr int NCLS = 24;
constexpr int MAXTILES = NTOK / 256 + NCLS;

constexpr size_t MiB = 1u << 20;
constexpr size_t WS_CTL = 0, CTL_ZERO_BYTES = 1 * MiB;
constexpr size_t WS_FW = 1 * MiB;
constexpr size_t WS_BIAS2 = 2 * MiB;
constexpr size_t WS_LIST = 3 * MiB;
constexpr size_t WS_GWL = 6 * MiB;
constexpr size_t WS_SELW = 12 * MiB;
constexpr size_t WS_STASH = 28 * MiB;
constexpr size_t WS_W = 60 * MiB;
constexpr size_t W_SM = 0, W_GT = 4718592, W_BR = W_GT + 8 * MiB, W_OUT = W_BR + 2 * MiB, W_GU = W_OUT + 2 * MiB, W_D = W_GU + 32 * MiB, W_LAYER = W_D + 16 * MiB;
constexpr size_t WS_HB = 190 * MiB;
constexpr size_t WS_R1 = 254 * MiB;
constexpr size_t WS_R2 = 398 * MiB;
constexpr size_t WS_END = 474 * MiB;
static_assert(WS_W + 2 * W_LAYER <= WS_HB && WS_R1 + (size_t)NTOK * PS * 2 <= WS_R2 && WS_R2 + (size_t)MAXTILES * 256 * DM * 2 <= WS_END, "d_ws map");
constexpr int CW_BAR = 4096;
constexpr int CW_CNT = 16384;

constexpr int RING_OFF = 0, RING_BYTES = 131072;
constexpr int LDSCTL_OFF = RING_BYTES, MISC_OFF = LDSCTL_OFF + 320;
constexpr int LDS_BYTES = 147456;

#define GAS __attribute__((address_space(1)))
#define LAS __attribute__((address_space(3)))
typedef unsigned short bf16;
typedef unsigned v4u __attribute__((ext_vector_type(4)));
typedef unsigned v2u __attribute__((ext_vector_type(2)));
typedef float f32x4 __attribute__((ext_vector_type(4)));
typedef float f32x16 __attribute__((ext_vector_type(16)));
typedef short bf16x8 __attribute__((ext_vector_type(8)));
typedef GAS unsigned gu32;
#define RLX_AGENT __ATOMIC_RELAXED, __HIP_MEMORY_SCOPE_AGENT
#define LDS_WAIT() asm volatile("s_waitcnt lgkmcnt(0)" ::: "memory")
#define VM_WAIT() asm volatile("s_waitcnt vmcnt(0)" ::: "memory")
__device__ __forceinline__ int opaque_i(int x) { asm volatile("" : "+v"(x)); return x; }
__device__ __forceinline__ int opaque_s(int x) { asm volatile("" : "+s"(x)); return x; }
__device__ __forceinline__ unsigned f2bf(float f) { unsigned u = __builtin_bit_cast(unsigned, f); return (u + 0x7fffu + ((u >> 16) & 1u)) >> 16; }
__device__ __forceinline__ unsigned pk2(float lo, float hi) { return f2bf(lo) | (f2bf(hi) << 16); }
__device__ __forceinline__ float bfl(unsigned w) { return __uint_as_float(w << 16); }
__device__ __forceinline__ float bfh(unsigned w) { return __uint_as_float(w & 0xffff0000u); }
__device__ __forceinline__ float bf1(bf16 h) { return __uint_as_float((unsigned)h << 16); }
__device__ __forceinline__ float sigmoidf_(float x) { return __builtin_amdgcn_rcpf(1.f + __builtin_amdgcn_exp2f(-x * LOG2E)); }

#define XB_TMO      128
#define XB_XCNT(j)  (256  + 64 * (j))
#define XB_XSUB(j)  (1280 + 64 * (j))
#define XB_XGEN(j)  (2304 + 64 * (j))
#define XB_TOP      3328
#define XB_TOPGEN   3392
#define XCD_BAR_WORDS 3456
#define XB_SPIN_CAP (1u << 18)
__device__ __forceinline__ unsigned xb_ld(unsigned* p)              { return __hip_atomic_load(p, __ATOMIC_RELAXED, __HIP_MEMORY_SCOPE_AGENT); }
__device__ __forceinline__ unsigned xb_add(unsigned* p, unsigned v) { return __hip_atomic_fetch_add(p, v, __ATOMIC_RELAXED, __HIP_MEMORY_SCOPE_AGENT); }
__device__ __forceinline__ unsigned xb_xcc_id() { return (unsigned)__builtin_amdgcn_s_getreg((3 << 11) | 20) & 0xFu; }
#define XB_SPIN(cond, bar) do { unsigned _sp = 0; while (cond) { __builtin_amdgcn_s_sleep(1); \
    if ((++_sp & 255u) == 0u) { if (xb_ld(&(bar)[XB_TMO])) break; if (_sp > XB_SPIN_CAP) { atomicAdd(&(bar)[XB_TMO], 1u); break; } } } } while (0)
struct XcdBarrier { unsigned* bar; unsigned x; volatile LAS unsigned* st; };
__device__ __forceinline__ XcdBarrier xcd_barrier_post(unsigned* bar, volatile LAS unsigned* st) {
    XcdBarrier b; b.bar = bar; b.x = xb_xcc_id(); b.st = st;
    if (threadIdx.x == 0) (void)xb_add(&bar[XB_XCNT(b.x)], 1u);
    return b;
}
__device__ __forceinline__ void xcd_barrier_complete(unsigned* bar, unsigned x, unsigned& nloc, unsigned& nx) {
    const unsigned G = gridDim.x * gridDim.y * gridDim.z;
    unsigned sum, cnt, mine, sp = 0u;
    for (;;) {
        sum = 0u; cnt = 0u; mine = 0u;
#pragma unroll
        for (unsigned j = 0; j < 16; ++j) { const unsigned c = xb_ld(&bar[XB_XCNT(j)]); sum += c; cnt += (c > 0u) ? 1u : 0u; mine = (j == x) ? c : mine; }
        if (sum == G) break;
        __builtin_amdgcn_s_sleep(1);
        if ((++sp & 255u) == 0u) { if (xb_ld(&bar[XB_TMO])) break; if (sp > XB_SPIN_CAP) { atomicAdd(&bar[XB_TMO], 1u); break; } }
    }
    nloc = mine > 0u ? mine : 1u; nx = cnt > 0u ? cnt : 1u;
}
__device__ __forceinline__ void xcd_barrier(const XcdBarrier& b) {
    asm volatile("s_waitcnt vmcnt(0)" ::: "memory");
    __syncthreads();
    if (opaque_i((int)threadIdx.x) == 0) {
        unsigned* bar = b.bar; const unsigned bx = (unsigned)opaque_s((int)xb_xcc_id());
        __builtin_amdgcn_s_waitcnt(0);
        unsigned nloc = b.st[0], nx = b.st[1];
        if (nloc == 0u) { xcd_barrier_complete(bar, bx, nloc, nx); b.st[0] = nloc; b.st[1] = nx; }
        const unsigned old = xb_add(&bar[XB_XSUB(bx)], 1u);
        const unsigned gen = old / nloc;
        if (old + 1u == (gen + 1u) * nloc) {
            __builtin_amdgcn_fence(__ATOMIC_RELEASE, "agent");
            asm volatile("s_waitcnt vmcnt(0)" ::: "memory");
            const unsigned og = xb_add(&bar[XB_TOP], 1u);
            const unsigned tg = og / nx;
            if (og + 1u == (tg + 1u) * nx) xb_add(&bar[XB_TOPGEN], 1u);
            else XB_SPIN(xb_ld(&bar[XB_TOPGEN]) == tg, bar);
            __builtin_amdgcn_fence(__ATOMIC_ACQUIRE, "agent");
            xb_add(&bar[XB_XGEN(bx)], 1u);
            asm volatile("s_waitcnt vmcnt(0)" ::: "memory");
        } else {
            XB_SPIN(xb_ld(&bar[XB_XGEN(bx)]) == gen, bar);
            __builtin_amdgcn_fence(__ATOMIC_ACQUIRE, "agent");
            asm volatile("s_waitcnt vmcnt(0)" ::: "memory");
        }
    }
    __syncthreads();
}
namespace pg8 {
#define PG8_LAS __attribute__((address_space(3)))
typedef unsigned short bf16_t;
typedef short bf16x8 __attribute__((ext_vector_type(8)));
typedef float f32x4 __attribute__((ext_vector_type(4)));
typedef float f32x2 __attribute__((ext_vector_type(2)));
typedef unsigned u32x4 __attribute__((ext_vector_type(4)));
typedef unsigned u32x2 __attribute__((ext_vector_type(2)));
constexpr int BM = 256, BK = 64, HALF = 128, HTB = HALF * BK * 2  , STAGE_BYTES = 8 * HTB, NXCD = 8, WGM = 8;
constexpr int LD = 1024;
constexpr size_t ROWB = 2048;
constexpr size_t HSTEP = (size_t)HALF * ROWB;
constexpr size_t TSTEP = 2 * HSTEP;

__host__ __device__ __forceinline__ int lds_byte(int r, int c) { const int st = (r >> 4) * 2 + (c >> 5), rr = r & 15, cc = c & 31, ob = rr * 64 + cc * 2; return st * 1024 + (ob ^ (((ob >> 9) & 1) << 5)); }
__host__ __device__ __forceinline__ void stage_rc(int b, int& R, int& C) { const int st = b / 1024, sb = b % 1024, swz = sb ^ (((sb >> 9) & 1) << 5); R = (st >> 1) * 16 + swz / 64; C = (st & 1) * 32 + (swz % 64) / 2; }
__host__ __device__ __forceinline__ int perm32(int rho) { const int n = rho >> 4, i = rho & 15; return 8 * (i >> 2) + 4 * n + (i & 3); }

struct GU {
    const char* A;
    const char* B0;
    const char* B1;
    int nt, ks;
    const int* rows;
    int rbase, rcnt;
    int pm, pn, a0, a1;
};

__device__ __forceinline__ unsigned cvt_pk_bf16(float lo, float hi) { unsigned r; asm volatile("v_cvt_pk_bf16_f32 %0, %1, %2" : "=v"(r) : "v"(lo), "v"(hi)); return r; }
__device__ __forceinline__ float bf_lo(unsigned w) { return __uint_as_float(w << 16); }
__device__ __forceinline__ float bf_hi(unsigned w) { return __uint_as_float(w & 0xffff0000u); }

template <class Epi, class Sched, bool GATHER>
__device__ __forceinline__ void gemm_phase(PG8_LAS unsigned char* lds, PG8_LAS unsigned* xlds  , const Sched& S, Epi& E) {
    const int tid = opaque_i((int)threadIdx.x), wid = __builtin_amdgcn_readfirstlane(tid >> 6), lane = tid & 63, wr = wid >> 2, wc = wid & 3, fr = lane & 15, fq = lane >> 4;
    unsigned voffB[2], vA[2][2];
#pragma unroll
    for (int i = 0; i < 2; ++i) { int R, C; stage_rc(tid * 16 + i * 8192, R, C); const int Rb = Epi::PERM ? ((R & ~31) + perm32(R & 31)) : R;
        voffB[i] = (unsigned)(Rb * LD + C) * 2u;
        vA[0][i] = (unsigned)(R * LD + C) * 2u; vA[1][i] = vA[0][i]; }
    const size_t kstep = (size_t)(BK * 2);
    const unsigned ldsw = (unsigned)wid * 1024u;
    const int aoff = lds_byte(wr * 64 + fr, fq * 8), boff = lds_byte(wc * 32 + fr, fq * 8);
#define PG8_SA(b, h) (((b) * 2 + (h)) * HTB)
#define PG8_SB(b, h) ((4 + (b) * 2 + (h)) * HTB)
#define PG8_STAGE(bufoff, gbase, voff) do { _Pragma("unroll") for (int _i = 0; _i < 2; ++_i) \
        __builtin_amdgcn_global_load_lds((const unsigned*)((const char*)(gbase) + (voff)[_i]), (PG8_LAS unsigned*)(lds + (bufoff) + ldsw + _i * 8192), 16, 0, 0); } while (0)
#define PG8_STAGEA(bufoff, gbase, h) do { if constexpr (GATHER) { PG8_STAGE(bufoff, gbase, vA[h]); } else { PG8_STAGE(bufoff, (gbase) + (h) * HSTEP, vA[0]); } } while (0)
#define PG8_LDA(dst, b, h) do { _Pragma("unroll") for (int m = 0; m < 4; ++m) _Pragma("unroll") for (int k = 0; k < 2; ++k) dst[m][k] = *(const PG8_LAS bf16x8*)(lds + PG8_SA(b, h) + aoff + m * 2048 + k * 1024); } while (0)
#define PG8_LDB(dst, b, h) do { _Pragma("unroll") for (int n = 0; n < 2; ++n) _Pragma("unroll") for (int k = 0; k < 2; ++k) dst[n][k] = *(const PG8_LAS bf16x8*)(lds + PG8_SB(b, h) + boff + n * 2048 + k * 1024); } while (0)
#define PG8_MMA(ai, bj, At, Bt) do { __builtin_amdgcn_s_setprio(1); _Pragma("unroll") for (int m = 0; m < 4; ++m) _Pragma("unroll") for (int n = 0; n < 2; ++n) _Pragma("unroll") for (int k = 0; k < 2; ++k) \
        acc[ai][bj][m][n] = __builtin_amdgcn_mfma_f32_16x16x32_bf16(Bt[n][k], At[m][k], acc[ai][bj][m][n], 0, 0, 0); __builtin_amdgcn_s_setprio(0); } while (0)
#define PG8_WAIT_V(n) asm volatile("s_waitcnt vmcnt(" #n ")" ::: "memory")
#define PG8_WAIT_L(n) asm volatile("s_waitcnt lgkmcnt(" #n ")" ::: "memory")
#define PG8_BAR __builtin_amdgcn_s_barrier()
#define PG8_SCHED __builtin_amdgcn_sched_barrier(0)
#define PG8_BP(u, tau) ((tau) < (u).ks ? (u).B0 + (size_t)(tau) * kstep : (u).B1 + (size_t)((tau) - (u).ks) * kstep)
#define PG8_GATHER_OFFS(dst, u) do { if constexpr (GATHER) { _Pragma("unroll") for (int _h = 0; _h < 2; ++_h) _Pragma("unroll") for (int _i = 0; _i < 2; ++_i) { \
        int _R, _C; stage_rc(opaque_i(tid) * 16 + _i * 8192, _R, _C); int _p = (u).rbase + _h * HALF + _R; _p = _p < (u).rcnt ? _p : (u).rcnt - 1; dst[_h][_i] = (unsigned)(u).rows[_p] * (unsigned)ROWB + (unsigned)_C * 2u; } } } while (0)
    GU cur, nxt; int ui = 0;
    if (!S.next(0, cur)) return;
    f32x4 acc[2][2][4][2];
#pragma unroll
    for (int a = 0; a < 2; ++a)
#pragma unroll
        for (int b = 0; b < 2; ++b)
#pragma unroll
            for (int m = 0; m < 4; ++m)
#pragma unroll
                for (int n = 0; n < 2; ++n) acc[a][b][m][n] = (f32x4){0.f, 0.f, 0.f, 0.f};
    bf16x8 At[4][2], B0[2][2], B1[2][2];
    PG8_GATHER_OFFS(vA, cur);
    const char* cA = cur.A;
    { const char* b0 = PG8_BP(cur, 0); const char* b1 = PG8_BP(cur, 1);
      PG8_STAGE(PG8_SB(0, 0), b0, voffB); PG8_STAGE(PG8_SB(0, 1), b0 + HSTEP, voffB); PG8_STAGEA(PG8_SA(0, 0), cA, 0); PG8_STAGEA(PG8_SA(0, 1), cA, 1);
      if (wr == 1) PG8_BAR;
      PG8_WAIT_V(2); PG8_BAR;
      PG8_STAGE(PG8_SB(1, 0), b1, voffB); PG8_STAGEA(PG8_SA(1, 0), cA + kstep, 0); PG8_STAGE(PG8_SB(1, 1), b1 + HSTEP, voffB);
      PG8_WAIT_V(6); PG8_BAR; }
    for (;;) {
        const bool has_next = S.next(ui + 1, nxt);
        if (!has_next) nxt = cur;
        if constexpr (GATHER) { unsigned vn[2][2];
#pragma unroll
            for (int h = 0; h < 2; ++h)
#pragma unroll
                for (int i = 0; i < 2; ++i) vn[h][i] = vA[h][i];
            if (has_next) { PG8_GATHER_OFFS(vn, nxt); }
#pragma unroll
            for (int h = 0; h < 2; ++h)
#pragma unroll
                for (int i = 0; i < 2; ++i) xlds[(h * 2 + i) * 512 + tid] = vn[h][i]; }
        const char* nA = nxt.A;
        const int nt = cur.nt;
        for (int t = 0; t < nt; t += 2) {
            const bool last = (t == nt - 2);
            const char* a1 = cA + (size_t)(t + 1) * kstep;
            const char* a2 = last ? nA : cA + (size_t)(t + 2) * kstep;
            const char* b2 = last ? PG8_BP(nxt, 0) : PG8_BP(cur, t + 2);
            const char* a3 = a2 + kstep; const char* b3 = b2 + kstep;
            PG8_LDB(B0, 0, 0); PG8_LDB(B1, 0, 1); PG8_SCHED; PG8_LDA(At, 0, 0); PG8_STAGEA(PG8_SA(1, 1), a1, 1);
            if constexpr (GATHER) { if (last) {
#pragma unroll
                for (int h = 0; h < 2; ++h)
#pragma unroll
                    for (int i = 0; i < 2; ++i) vA[h][i] = xlds[(h * 2 + i) * 512 + tid]; } }
            PG8_WAIT_V(8); PG8_WAIT_L(0); PG8_BAR; PG8_MMA(0, 0, At, B0); PG8_MMA(0, 1, At, B1); PG8_BAR; PG8_SCHED;
            PG8_LDA(At, 0, 1); PG8_STAGE(PG8_SB(0, 0), b2, voffB); PG8_STAGE(PG8_SB(0, 1), b2 + HSTEP, voffB); PG8_STAGEA(PG8_SA(0, 0), a2, 0);
            PG8_WAIT_V(8); PG8_WAIT_L(0); PG8_BAR; PG8_MMA(1, 0, At, B0); PG8_MMA(1, 1, At, B1); PG8_BAR; PG8_SCHED;
            PG8_LDB(B0, 1, 0); PG8_LDB(B1, 1, 1); PG8_SCHED; PG8_LDA(At, 1, 0); PG8_STAGEA(PG8_SA(0, 1), a2, 1);
            PG8_WAIT_V(8); PG8_WAIT_L(0); PG8_BAR; PG8_MMA(0, 0, At, B0); PG8_MMA(0, 1, At, B1); PG8_BAR; PG8_SCHED;
            PG8_LDA(At, 1, 1); PG8_STAGE(PG8_SB(1, 0), b3, voffB); PG8_STAGE(PG8_SB(1, 1), b3 + HSTEP, voffB); PG8_STAGEA(PG8_SA(1, 0), a3, 0);
            PG8_WAIT_V(8); PG8_WAIT_L(0); PG8_BAR; PG8_MMA(1, 0, At, B0); PG8_MMA(1, 1, At, B1); PG8_BAR; PG8_SCHED;
        }
        if (wr == 0) PG8_BAR;
        E(acc, cur, wr, wc, fr, fq);
        if (!has_next) break;
#pragma unroll
        for (int a = 0; a < 2; ++a)
#pragma unroll
            for (int b = 0; b < 2; ++b)
#pragma unroll
                for (int m = 0; m < 4; ++m)
#pragma unroll
                    for (int n = 0; n < 2; ++n) acc[a][b][m][n] = (f32x4){0.f, 0.f, 0.f, 0.f};
        cur = nxt; cA = nA; ++ui;
        if (wr == 1) PG8_BAR;
    }
    PG8_WAIT_V(0);
    PG8_BAR;
#undef PG8_SA
#undef PG8_SB
#undef PG8_STAGE
#undef PG8_STAGEA
#undef PG8_LDA
#undef PG8_LDB
#undef PG8_MMA
#undef PG8_WAIT_V
#undef PG8_WAIT_L
#undef PG8_BAR
#undef PG8_SCHED
#undef PG8_BP
#undef PG8_GATHER_OFFS
}
}
namespace attn_body {
using bf16=__hip_bfloat16;
using bf16x8=__attribute__((ext_vector_type(8)))short;
using s16x4=__attribute__((ext_vector_type(4)))short;
using f32x16=__attribute__((ext_vector_type(16)))float;
using f32x4=__attribute__((ext_vector_type(4)))float;
using u32x4=__attribute__((ext_vector_type(4)))unsigned;
constexpr int SEQ=4096,D=64;
constexpr int KVP=2304;
constexpr int OP=1024;
constexpr int NW=8,QBLK=32,QB=QBLK*NW,KVBLK=64,NQB=SEQ/QB;
__device__ __forceinline__ int crow(int r,int hi){return (r&3)+8*(r>>2)+4*hi;}
#define SBAR() __builtin_amdgcn_sched_barrier(0)
__device__ __forceinline__ void cmask(f32x16&p0,f32x16&p1,int jb,int qrel,int hi){
  const float NEG=-INFINITY; int kb=64*jb+4*hi;
  #pragma unroll
  for(int r=0;r<16;++r){int kv=kb+(r&3)+8*(r>>2); if(kv>qrel)p0[r]=NEG; if(kv+32>qrel)p1[r]=NEG;}
}
__device__ __forceinline__ void bmask(f32x16&p0,f32x16&p1,unsigned long long w,int hi){
  const float NEG=-INFINITY; const unsigned lo=((unsigned)w)>>(4*hi), up=((unsigned)(w>>32))>>(4*hi);
  #pragma unroll
  for(int r=0;r<16;++r){const int bit=(r&3)+8*(r>>2); if(!((lo>>bit)&1u))p0[r]=NEG; if(!((up>>bit)&1u))p1[r]=NEG;}
}
constexpr int NSLOT=3, SLOTB=8192;
constexpr int LDS_K=0, LDS_V=NSLOT*SLOTB, LDS_WS=2*NSLOT*SLOTB, LDS_OST=LDS_WS+NW*64*4, LDS_BIAS=LDS_OST+NW*4096, LDS_BYTES=LDS_BIAS+SEQ*4;
constexpr float C2=0.125f*1.4426950408889634f;
__device__ __forceinline__ void glds16(const void*gsrc,unsigned lds_dst){unsigned keep;
  asm volatile("s_mov_b32 %0, m0\n\ts_mov_b32 m0, %2\n\ts_nop 0\n\tglobal_load_lds_dwordx4 %1, off\n\ts_mov_b32 m0, %0":"=&s"(keep):"v"(gsrc),"s"(lds_dst):"memory");}
__device__ __forceinline__ float max3f(float a,float b,float c){float r;asm("v_max3_f32 %0, %1, %2, %3":"=v"(r):"v"(a),"v"(b),"v"(c));return r;}
__device__ __forceinline__ float max2f(float a,float b){float r;asm("v_max_f32_e32 %0, %1, %2":"=v"(r):"v"(a),"v"(b));return r;}
__device__ __forceinline__ float fadd_s(float a,float b){float r;asm("v_add_f32_e32 %0, %1, %2":"=v"(r):"v"(a),"v"(b));return r;}
__device__ __forceinline__ float fsub_s(float a,float b){float r;asm("v_sub_f32_e32 %0, %1, %2":"=v"(r):"v"(a),"v"(b));return r;}
typedef float f32x2_t __attribute__((ext_vector_type(2))); typedef __bf16 bf16x2_t __attribute__((ext_vector_type(2)));
__device__ __forceinline__ unsigned cvtpk_s(float lo,float hi){f32x2_t v={lo,hi};bf16x2_t b=__builtin_convertvector(v,bf16x2_t);return __builtin_bit_cast(unsigned,b);}
#define WAIT_BAR(N) asm volatile("s_waitcnt vmcnt(" #N ") lgkmcnt(0)\n\ts_barrier":::"memory")

typedef __attribute__((address_space(3))) const char* lds_cptr;
typedef short v4i16_t __attribute__((ext_vector_type(4)));
__device__ __forceinline__ void binit(f32x16&p0,f32x16&p1,lds_cptr bp,float mhat){
  #pragma unroll
  for(int g=0;g<4;++g){ const f32x4 a=*(const __attribute__((address_space(3))) f32x4*)(bp+g*32); const f32x4 b=*(const __attribute__((address_space(3))) f32x4*)(bp+128+g*32);
    #pragma unroll
    for(int i=0;i<4;++i){p0[4*g+i]=a[i]-mhat;p1[4*g+i]=b[i]-mhat;} }
}
__device__ __forceinline__ void qkt(f32x16&p0,f32x16&p1,const char*Kslot,const bf16x8*qr,int r32,int hi){
  const char*kb=Kslot+hi*1024+r32*16;
  #pragma unroll
  for(int d0=0;d0<4;++d0){
    const bf16x8 b0=*reinterpret_cast<const bf16x8*>(kb+d0*2048);
    const bf16x8 b1=*reinterpret_cast<const bf16x8*>(kb+d0*2048+512);
    p0=__builtin_amdgcn_mfma_f32_32x32x16_bf16(b0,qr[d0],p0,0,0,0);p1=__builtin_amdgcn_mfma_f32_32x32x16_bf16(b1,qr[d0],p1,0,0,0);}
}
__device__ __forceinline__ void kload8(bf16x8*kf,lds_cptr kp){
  kf[0]=*(const __attribute__((address_space(3))) bf16x8*)(kp);      kf[1]=*(const __attribute__((address_space(3))) bf16x8*)(kp+512);
  kf[2]=*(const __attribute__((address_space(3))) bf16x8*)(kp+2048); kf[3]=*(const __attribute__((address_space(3))) bf16x8*)(kp+2560);
  kf[4]=*(const __attribute__((address_space(3))) bf16x8*)(kp+4096); kf[5]=*(const __attribute__((address_space(3))) bf16x8*)(kp+4608);
  kf[6]=*(const __attribute__((address_space(3))) bf16x8*)(kp+6144); kf[7]=*(const __attribute__((address_space(3))) bf16x8*)(kp+6656);
}
__device__ __forceinline__ void kload2(bf16x8*kf,lds_cptr kp,int j){ kf[2*j]=*(const __attribute__((address_space(3))) bf16x8*)(kp+j*2048); kf[2*j+1]=*(const __attribute__((address_space(3))) bf16x8*)(kp+j*2048+512); }
__device__ __forceinline__ s16x4 vtr(lds_cptr p){ return __builtin_bit_cast(s16x4,__builtin_amdgcn_ds_read_tr16_b64_v4i16((__attribute__((address_space(3))) v4i16_t*)p)); }
__device__ __forceinline__ float rowmax(const f32x16&p0,const f32x16&p1){
  float a=max3f(p0[0],p0[1],p1[0]),b=max3f(p0[2],p0[3],p1[1]);a=max3f(a,p1[2],p1[3]);
  #pragma unroll
  for(int r=4;r<16;r+=4){a=max3f(a,p0[r],p0[r+1]);b=max3f(b,p0[r+2],p0[r+3]);a=max3f(a,p1[r],p1[r+1]);b=max3f(b,p1[r+2],p1[r+3]);}
  const float m=max2f(a,b);
  auto rr=__builtin_amdgcn_permlane32_swap(__float_as_uint(m),__float_as_uint(m),false,false);
  return max2f(__uint_as_float(rr[0]),__uint_as_float(rr[1]));
}
__device__ __forceinline__ void pv(f32x16*o,int vb,bf16x8 pa0,bf16x8 pa1,bf16x8 pa2,bf16x8 pa3){
  #pragma unroll
  for(int d0=0;d0<2;++d0){s16x4 lo[4],hi[4];
    #pragma unroll
    for(int ks=0;ks<4;++ks){
      asm volatile("ds_read_b64_tr_b16 %0,%1 offset:%c2":"=&v"(lo[ks]):"v"(vb),"i"(d0*4096+ks*1024):"memory");
      asm volatile("ds_read_b64_tr_b16 %0,%1 offset:%c2":"=&v"(hi[ks]):"v"(vb),"i"(d0*4096+ks*1024+512):"memory");}
    asm volatile("s_waitcnt lgkmcnt(0)":::"memory");SBAR();
    #define PK(k) (bf16x8){lo[k][0],lo[k][1],lo[k][2],lo[k][3],hi[k][0],hi[k][1],hi[k][2],hi[k][3]}
    o[d0]=__builtin_amdgcn_mfma_f32_32x32x16_bf16(pa0,PK(0),o[d0],0,0,0);
    o[d0]=__builtin_amdgcn_mfma_f32_32x32x16_bf16(pa1,PK(1),o[d0],0,0,0);
    o[d0]=__builtin_amdgcn_mfma_f32_32x32x16_bf16(pa2,PK(2),o[d0],0,0,0);
    o[d0]=__builtin_amdgcn_mfma_f32_32x32x16_bf16(pa3,PK(3),o[d0],0,0,0);
    #undef PK
  }
}

template<int THRL,bool MASK> __device__ __forceinline__ void attn_unit(int q0,const bf16*Qs,const bf16*__restrict__ Ks,const bf16*__restrict__ Vs,bf16*Os,
                                                                       const float*biasg,float slope2,const unsigned long long*maskw,char*shm){
  const int tid=opaque_i((int)threadIdx.x),lane=tid&63,r32=lane&31,hi=lane>>5; const int wid=__builtin_amdgcn_readfirstlane(tid>>6);
  const bf16*Qw=Qs+(long)(q0+wid*QBLK)*KVP;
  const unsigned lds0=(unsigned)(uintptr_t)shm;
  float*wsf=(float*)(shm+LDS_WS)+wid*64;
  { float*bl=(float*)(shm+LDS_BIAS); const int nk=q0+QB;
    if(biasg){ for(int s=tid;s<nk;s+=NW*64)bl[s]=biasg[s]; } else { for(int s=tid;s<nk;s+=NW*64)bl[s]=slope2*(float)s; }
    asm volatile("s_waitcnt vmcnt(0) lgkmcnt(0)":::"memory"); }
  const bf16*ksrc=Ks+(long)lane*KVP+wid*8;
  const bf16*vsrc=Vs+(long)(16*(wid&3)+(lane>>2))*KVP+(wid>>2)*32+(lane&3)*8;
  const unsigned kdst=lds0+LDS_K+wid*1024, vdst=lds0+LDS_V+wid*1024;
  #define DMA_K(t,slot) glds16(ksrc+(long)(t)*KVBLK*KVP,(unsigned)__builtin_amdgcn_readfirstlane(kdst+(slot)))
  #define DMA_V(t,slot) glds16(vsrc+(long)(t)*KVBLK*KVP,(unsigned)__builtin_amdgcn_readfirstlane(vdst+(slot)))
  const int vb0=(int)(lds0+LDS_V)+((lane>>4)&1)*32+(lane&3)*8+(4*hi+((lane&15)>>2))*64;
  const char*Kbase=shm+LDS_K; bf16x8 kf[8];
  const lds_cptr shm3=(lds_cptr)shm; const lds_cptr kp0=shm3+LDS_K+hi*1024+r32*16; const lds_cptr vp0=shm3+LDS_V+((lane>>4)&1)*32+(lane&3)*8+(4*hi+((lane&15)>>2))*64;
  const lds_cptr bp0=shm3+LDS_BIAS+hi*16;
  const int NT=(q0+QB)/KVBLK;
  DMA_K(0,0);DMA_V(0,0);DMA_K(1,SLOTB);
  bf16x8 qr[4];
  #pragma unroll
  for(int d0=0;d0<4;++d0)qr[d0]=*reinterpret_cast<const bf16x8*>(&Qw[(long)r32*KVP+d0*16+hi*8]);
  const unsigned long long*mwp=MASK?maskw+(q0+wid*QBLK+r32):nullptr;
  unsigned long long mw_cur=0ull,mw_nxt=0ull;
  if(MASK){mw_cur=mwp[0];mw_nxt=mwp[SEQ];}
  float mhat=0.f,l_reg=0.f;f32x16 o[2];o[0]=f32x16{};o[1]=f32x16{};
  const int qrel=wid*QBLK+r32;
  #define CMASK(P0,P1,t) do{ if(MASK){ bmask(P0,P1,mw_cur,hi); } else { int jb_=(t)-(NT-4); if(jb_>=0)cmask(P0,P1,jb_,qrel,hi); } }while(0)
  bool resc=false;
  #define START(P0,P1) do{ const float rm=rowmax(P0,P1); resc=false; \
    { const float dl=__builtin_fmaxf(rm,-60000.f); mhat=fadd_s(mhat,dl); \
      _Pragma("unroll") for(int r=0;r<16;++r){P0[r]=fsub_s(P0[r],dl);P1[r]=fsub_s(P1[r],dl);} } \
    _Pragma("unroll") for(int r=0;r<16;++r)P0[r]=__builtin_amdgcn_exp2f(P0[r]); }while(0)
  #define RESC() do{ if(resc){ asm volatile("s_waitcnt lgkmcnt(0)":::"memory"); \
      _Pragma("unroll") for(int d_=0;d_<2;++d_) _Pragma("unroll") for(int r=0;r<16;++r)o[d_][r]*=wsf[crow(r,hi)]; } }while(0)
  f32x16 pA0,pA1,pB0,pB1;
  int sl_prev=0,sl_cur=0,sl_next=SLOTB;
  #define ROT() do{sl_prev=sl_cur;sl_cur=sl_next;sl_next=(sl_next==(NSLOT-1)*SLOTB)?0:sl_next+SLOTB;}while(0)
  DMA_K(2,2*SLOTB);
  WAIT_BAR(3);
  binit(pA0,pA1,bp0,0.f);
  qkt(pA0,pA1,Kbase,qr,r32,hi);asm volatile("s_nop 15\n\ts_nop 7":"+v"(pA0),"+v"(pA1));CMASK(pA0,pA1,0);
  START(pA0,pA1);
  _Pragma("unroll") for(int r=0;r<16;++r)pA1[r]=__builtin_amdgcn_exp2f(pA1[r]);
  WAIT_BAR(0);
  DMA_K(3,0);DMA_V(1,SLOTB);
  ROT();
  kload8(kf,kp0+sl_cur);
  if(MASK){mw_cur=mw_nxt; mw_nxt=mwp[2*SEQ];}
  WAIT_BAR(2);
  s16x4 vlo[8],vhi[8]; u32x4 pw0,pw1,pw2,pw3;
  #define PKW(P,B) cvtpk_s(P[B],P[B+1])
  #define PAF(k) __builtin_bit_cast(bf16x8,pw##k)
  #define VFR(i) (bf16x8){vlo[i][0],vlo[i][1],vlo[i][2],vlo[i][3],vhi[i][0],vhi[i][1],vhi[i][2],vhi[i][3]}
  #define PIN(x) asm volatile("":"+v"(x))
  #define MX3(a,b,c) __builtin_fmaxf(__builtin_fmaxf((a),(b)),(c))
  #define GAPA(MF,A0,A1,A2,A3,W0,W1,PW) do{ MF; sacc+=A0; sacc+=A1; sacc+=A2; sacc+=A3; PIN(sacc); W0; W1; PIN(PW); SBAR(); }while(0)
  #define EX(v) __builtin_amdgcn_exp2f(v)
  #define GAPB(MF,X,B) do{ MF; X[B]=EX(X[B]); X[B+1]=EX(X[B+1]); X[B+2]=EX(X[B+2]); X[B+3]=EX(X[B+3]); PIN(X); SBAR(); }while(0)
  #define VRD(i) do{ vlo[i]=vtr(vp_+(((i)>>2)*4096+((i)&3)*1024)); vhi[i]=vtr(vp_+(((i)>>2)*4096+((i)&3)*1024+512)); }while(0)
  #define KRD(G,j) do{ if(G){ kload2(kf,kp0+sl_next,j); SBAR(); } }while(0)
  #define STEP(C0,C1,P0,P1,t,GK,GV,GL) do{ SBAR(); \
    const lds_cptr vp_=vp0+sl_prev; \
    binit(C0,C1,bp0+(t)*256,mhat); SBAR(); \
    VRD(0); SBAR(); float sacc=(P0[0]+P0[1]); \
    GAPA(C0=__builtin_amdgcn_mfma_f32_32x32x16_bf16(kf[0],qr[0],C0,0,0,0), P0[2],P0[3],P0[4],P0[5],     pw0[0]=PKW(P0,0), pw0[1]=PKW(P0,2), pw0); \
    VRD(4); SBAR(); GAPA(C1=__builtin_amdgcn_mfma_f32_32x32x16_bf16(kf[1],qr[0],C1,0,0,0), P0[6],P0[7],P0[8],P0[9],     pw0[2]=PKW(P0,4), pw0[3]=PKW(P0,6), pw0); \
    VRD(1); SBAR(); GAPA(C0=__builtin_amdgcn_mfma_f32_32x32x16_bf16(kf[2],qr[1],C0,0,0,0),   P0[10],P0[11],P0[12],P0[13], pw1[0]=PKW(P0,8), pw1[1]=PKW(P0,10), pw1); \
    VRD(5); SBAR(); GAPA(C1=__builtin_amdgcn_mfma_f32_32x32x16_bf16(kf[3],qr[1],C1,0,0,0),   P0[14],P0[15],P1[0],P1[1],   pw1[2]=PKW(P0,12),pw1[3]=PKW(P0,14), pw1); \
    VRD(2); SBAR(); GAPA(C0=__builtin_amdgcn_mfma_f32_32x32x16_bf16(kf[4],qr[2],C0,0,0,0),   P1[2],P1[3],P1[4],P1[5],     pw2[0]=PKW(P1,0), pw2[1]=PKW(P1,2), pw2); \
    VRD(6); SBAR(); GAPA(C1=__builtin_amdgcn_mfma_f32_32x32x16_bf16(kf[5],qr[2],C1,0,0,0),   P1[6],P1[7],P1[8],P1[9],     pw2[2]=PKW(P1,4), pw2[3]=PKW(P1,6), pw2); \
    VRD(3); SBAR(); GAPA(C0=__builtin_amdgcn_mfma_f32_32x32x16_bf16(kf[6],qr[3],C0,0,0,0),   P1[10],P1[11],P1[12],P1[13], pw3[0]=PKW(P1,8), pw3[1]=PKW(P1,10), pw3); \
    VRD(7); SBAR(); GAPA(C1=__builtin_amdgcn_mfma_f32_32x32x16_bf16(kf[7],qr[3],C1,0,0,0),   P1[14],P1[15],0.f,0.f,       pw3[2]=PKW(P1,12),pw3[3]=PKW(P1,14), pw3); \
    l_reg+=sacc; \
    if(GK){DMA_K((t)+3,sl_cur);} if(GV){DMA_V((t)+1,sl_next);} \
    CMASK(C0,C1,t); \
    if(MASK){ mw_cur=mw_nxt; if((t)+2<NT) mw_nxt=mwp[(long)((t)+2)*SEQ]; } \
    { float a=MX3(C0[0],C0[1],C1[0]),b=MX3(C0[2],C0[3],C1[1]); a=MX3(a,C1[2],C1[3]); \
      _Pragma("unroll") for(int r=4;r<16;r+=4){a=MX3(a,C0[r],C0[r+1]);b=MX3(b,C0[r+2],C0[r+3]);a=MX3(a,C1[r],C1[r+1]);b=MX3(b,C1[r+2],C1[r+3]);} \
      float rm=__builtin_fmaxf(a,b); { auto rr=__builtin_amdgcn_permlane32_swap(__float_as_uint(rm),__float_as_uint(rm),false,false); rm=__builtin_fmaxf(__uint_as_float(rr[0]),__uint_as_float(rr[1])); } \
      resc=false; \
      if(__builtin_expect(__any(rm>(float)THRL),0)){ const float dl=__builtin_fmaxf(rm,0.f); mhat+=dl; \
        _Pragma("unroll") for(int r=0;r<16;++r){C0[r]-=dl;C1[r]-=dl;} \
        const float f=__builtin_amdgcn_exp2f(-dl); l_reg*=f; if(hi==0)wsf[r32]=f; resc=true; } } \
    SBAR(); \
    GAPB(o[0]=__builtin_amdgcn_mfma_f32_32x32x16_bf16(PAF(0),VFR(0),o[0],0,0,0), C0,0); \
    GAPB(o[1]=__builtin_amdgcn_mfma_f32_32x32x16_bf16(PAF(0),VFR(4),o[1],0,0,0), C0,4); \
    KRD(GL,0); GAPB(o[0]=__builtin_amdgcn_mfma_f32_32x32x16_bf16(PAF(1),VFR(1),o[0],0,0,0), C0,8); \
    KRD(GL,1); GAPB(o[1]=__builtin_amdgcn_mfma_f32_32x32x16_bf16(PAF(1),VFR(5),o[1],0,0,0), C0,12); \
    KRD(GL,2); GAPB(o[0]=__builtin_amdgcn_mfma_f32_32x32x16_bf16(PAF(2),VFR(2),o[0],0,0,0), C1,0); \
    KRD(GL,3); GAPB(o[1]=__builtin_amdgcn_mfma_f32_32x32x16_bf16(PAF(2),VFR(6),o[1],0,0,0), C1,4); \
    GAPB(o[0]=__builtin_amdgcn_mfma_f32_32x32x16_bf16(PAF(3),VFR(3),o[0],0,0,0), C1,8); \
    GAPB(o[1]=__builtin_amdgcn_mfma_f32_32x32x16_bf16(PAF(3),VFR(7),o[1],0,0,0), C1,12); \
    }while(0)
  int t=1;
  #define ENDW(tt) do{ if((tt)+3<NT){WAIT_BAR(2);} else if((tt)+2<NT){WAIT_BAR(1);} else {WAIT_BAR(0);} }while(0)
  for(;t+1<NT;t+=2){
    STEP(pB0,pB1,pA0,pA1,t,(t+3<NT),(t+1<NT),(t+1<NT));       ENDW(t);   RESC(); ROT();
    STEP(pA0,pA1,pB0,pB1,t+1,(t+4<NT),(t+2<NT),(t+2<NT));     ENDW(t+1); RESC(); ROT();
  }
  STEP(pB0,pB1,pA0,pA1,NT-1,false,false,false); RESC();
  { float sacc=pB0[0]+pB0[1]; _Pragma("unroll") for(int r=2;r<16;++r)sacc+=pB0[r]; _Pragma("unroll") for(int r=0;r<16;++r)sacc+=pB1[r]; l_reg+=sacc;
    pw0=(u32x4){PKW(pB0,0),PKW(pB0,2),PKW(pB0,4),PKW(pB0,6)};pw1=(u32x4){PKW(pB0,8),PKW(pB0,10),PKW(pB0,12),PKW(pB0,14)};pw2=(u32x4){PKW(pB1,0),PKW(pB1,2),PKW(pB1,4),PKW(pB1,6)};pw3=(u32x4){PKW(pB1,8),PKW(pB1,10),PKW(pB1,12),PKW(pB1,14)};
    SBAR(); pv(o,vb0+sl_cur,PAF(0),PAF(1),PAF(2),PAF(3)); }
  #undef PKW
  #undef PAF
  #undef VFR
  #undef PIN
  #undef MX3
  #undef GAPA
  #undef GAPB
  #undef EX
  #undef VRD
  #undef KRD
  #undef STEP
  #undef ENDW
  {auto rr=__builtin_amdgcn_permlane32_swap(__float_as_uint(l_reg),__float_as_uint(l_reg),false,false);l_reg=__uint_as_float(rr[0])+__uint_as_float(rr[1]);}
  if(hi==0)wsf[32+r32]=l_reg;asm volatile("s_waitcnt lgkmcnt(0)":::"memory");
  float rli[16];
  #pragma unroll
  for(int r=0;r<16;++r)rli[r]=__builtin_amdgcn_rcpf(wsf[32+crow(r,hi)]);
  bf16*Ow=Os+(long)(q0+wid*QBLK)*OP;
  { bf16*stg=(bf16*)(shm+LDS_OST)+wid*2048;
    #pragma unroll
    for(int r=0;r<16;++r){const int orow=crow(r,hi);
      #pragma unroll
      for(int d0=0;d0<2;++d0)stg[orow*64+d0*32+r32]=__float2bfloat16(o[d0][r]*rli[r]);}
    asm volatile("s_waitcnt lgkmcnt(0)":::"memory");
    #pragma unroll
    for(int i=0;i<4;++i){const int row=i*8+(lane>>3),ch=lane&7; const u32x4 v=*(const u32x4*)(stg+row*64+ch*8); *(u32x4*)(Ow+(long)row*OP+ch*8)=v;} }
  asm volatile("s_waitcnt lgkmcnt(0)\n\ts_barrier":::"memory");
  #undef DMA_K
  #undef DMA_V
  #undef CMASK
  #undef START
  #undef RESC
  #undef ROT
}
#undef SBAR
#undef WAIT_BAR
}
struct Args { const float* in[25]; float* out; unsigned char* ws; int ph_lo, ph_hi; };
struct Frame {
    LAS unsigned char* lds; unsigned char* ldsg;
    volatile LAS unsigned* MISC;
    gu32* ctl;
    int tid, lane, wave, vcu, G;
    unsigned char* ws; float* out;
};
__device__ __forceinline__ float wave_sum(float v) {
#pragma unroll
    for (int o = 1; o < 64; o <<= 1) v += __shfl_xor(v, o);
    return v;
}
__device__ __forceinline__ bf16* wsb(const Frame& F, size_t off) { return (bf16*)(F.ws + off); }

__device__ __forceinline__ int map_small(int r) {
    if (r < 1024) return r;
    if (r < 1280) return 1028 + (r - 1024);
    if (r < 1536) return 1412 + (r - 1280);
    if (r < 2048) return 1736 + (r - 1536);
    if (r < 2112) return 1284 + (r - 2048);
    if (r < 2176) return 1348 + (r - 2112);
    if (r < 2240) return 1668 + (r - 2176);
    if (r < 2244) return 1024 + (r - 2240);
    if (r < 2248) return 1732 + (r - 2244);
    return -1;
}
__device__ __forceinline__ void tr_item(const float* src, int ld_src, int k0, int srccol, bf16* dst, int ld_dst, LAS float* scr, int lane) {
#pragma unroll 8
    for (int i = 0; i < 32; ++i) { const int kk = 2 * i + (lane >> 5); scr[kk * 33 + (lane & 31)] = srccol >= 0 ? src[(size_t)(k0 + kk) * ld_src + srccol] : 0.f; }
    LDS_WAIT(); asm volatile("" ::: "memory");
    const int c = lane & 7;
#pragma unroll
    for (int j = 0; j < 4; ++j) { const int n = (lane >> 3) + 8 * j; const LAS float* s = scr + (8 * c) * 33 + n;
        v4u o; o.x = pk2(s[0 * 33], s[1 * 33]); o.y = pk2(s[2 * 33], s[3 * 33]); o.z = pk2(s[4 * 33], s[5 * 33]); o.w = pk2(s[6 * 33], s[7 * 33]);
        *(GAS v4u*)(dst + (size_t)n * ld_dst + 8 * c) = o; }
    LDS_WAIT(); asm volatile("" ::: "memory");
}
constexpr int IT_SM = 72 * 16, IT_GT = 128 * 16, IT_BR = 512, IT_OUT = 512, IT_GU = 16 * 512, IT_D = 16 * 256, IT_LAYER = IT_SM + IT_GT + IT_BR + IT_OUT + IT_GU + IT_D;
__device__ __forceinline__ void p0_item(const Frame& F, const Args& a, int it, LAS float* scr) {
    const int l = it / IT_LAYER; int j = it % IT_LAYER; const int n = F.lane & 31;
    bf16* W = wsb(F, WS_W + (size_t)l * W_LAYER);
    if (j < IT_SM) { const int g = j / 16, kb = j % 16; tr_item(a.in[3] + (size_t)l * DM * P_TOTAL, P_TOTAL, kb * 64, map_small(g * 32 + n), W + W_SM / 2 + (size_t)(g * 32) * DM + kb * 64, DM, scr, F.lane); return; } j -= IT_SM;
    if (j < IT_GT) { const int g = j / 16, kb = j % 16; tr_item(a.in[3] + (size_t)l * DM * P_TOTAL, P_TOTAL, kb * 64, 2248 + g * 32 + n, W + W_GT / 2 + (size_t)(g * 32) * DM + kb * 64, DM, scr, F.lane); return; } j -= IT_GT;
    if (j < IT_BR) { const int nb = j / 128, jj = j % 128, g = jj / 4, kb = jj % 4;
        tr_item(a.in[12] + ((size_t)l * 4 + nb) * 256 * DM, DM, kb * 64, g * 32 + n, W + W_BR / 2 + (size_t)(g * 32) * DM + nb * 256 + kb * 64, DM, scr, F.lane); return; } j -= IT_BR;
    if (j < IT_OUT) { const int g = j / 16, kb = j % 16; tr_item(a.in[13] + (size_t)l * DM * DM, DM, kb * 64, g * 32 + n, W + W_OUT / 2 + (size_t)(g * 32) * DM + kb * 64, DM, scr, F.lane); return; } j -= IT_OUT;
    if (j < IT_GU) { const int e = j / 512, jj = j % 512, g = jj / 16, kb = jj % 16; const int r0 = g * 32, q = r0 >> 8, within = r0 & 255; const bool isup = within >= 128;
        const float* src = (isup ? a.in[21] : a.in[20]) + ((size_t)l * 16 + e) * DM * 512;
        tr_item(src, 512, kb * 64, 128 * q + (within & 127) + n, W + W_GU / 2 + (size_t)e * DM * DM + (size_t)r0 * DM + kb * 64, DM, scr, F.lane); return; } j -= IT_GU;
    { const int e = j / 256, jj = j % 256, g = jj / 8, kb = jj % 8;
        tr_item(a.in[22] + ((size_t)l * 16 + e) * 512 * DM, DM, kb * 64, g * 32 + n, W + W_D / 2 + (size_t)(e >> 1) * DM * DM + (size_t)(g * 32) * DM + (e & 1) * 512 + kb * 64, DM, scr, F.lane); }
}
__device__ __forceinline__ void ln_row(const Frame& F, const float* xrow, const float* g, const float* b, float* orow, bf16* brow, f32x4 (&v)[4]) {
    const GAS f32x4* xr = (const GAS f32x4*)xrow + F.lane; float s = 0.f;
#pragma unroll
    for (int j = 0; j < 4; ++j) { v[j] = xr[64 * j]; s += (v[j].x + v[j].y) + (v[j].z + v[j].w); }
    const float mean = wave_sum(s) * (1.f / DM); float s2 = 0.f;
#pragma unroll
    for (int j = 0; j < 4; ++j) { v[j] = v[j] - mean; s2 += (v[j].x * v[j].x + v[j].y * v[j].y) + (v[j].z * v[j].z + v[j].w * v[j].w); }
    const float rstd = 1.f / sqrtf(wave_sum(s2) * (1.f / DM) + LN_EPS);
    GAS f32x4* o4 = (GAS f32x4*)orow + F.lane; GAS v2u* o8 = (GAS v2u*)brow + F.lane;
#pragma unroll
    for (int j = 0; j < 4; ++j) { const f32x4 gg = ((const GAS f32x4*)g)[F.lane + 64 * j], bb = ((const GAS f32x4*)b)[F.lane + 64 * j];
        v[j] = v[j] * rstd * gg + bb; o4[64 * j] = v[j]; v2u w; w.x = pk2(v[j].x, v[j].y); w.y = pk2(v[j].z, v[j].w); o8[64 * j] = w; }
}
__device__ __forceinline__ void p0_prologue(const Frame& F, const Args& a) {
    LAS float* scr = (LAS float*)(F.lds + RING_OFF + F.wave * 16384);
    const int gw = F.vcu * NWAVES + F.wave, NGW = F.G * NWAVES;
    for (int it = gw; it < DEPTH * IT_LAYER; it += NGW) p0_item(F, a, it, scr);
    for (int m = gw; m < NTOK; m += NGW) { f32x4 v[4]; ln_row(F, a.in[0] + (size_t)m * DM, a.in[1], a.in[2], F.out + (size_t)m * DM, wsb(F, WS_HB) + (size_t)m * DM, v); }
}

struct TileOrder {
    int nM, nN, nwg, G, c;
    __device__ void init(int nM_, int nN_, int G_, int c_) { nM = nM_; nN = nN_; nwg = nM * nN; G = G_; c = c_; }
    __device__ bool tile(int i, int& pm, int& pn) const {
        const long L = (long)i * G + c; if (L >= nwg) return false;
        int wgid = (int)L; { const int q = nwg / 8, r = nwg % 8, xcd = wgid % 8, off = wgid / 8; wgid = (xcd < r ? xcd * (q + 1) : r * (q + 1) + (xcd - r) * q) + off; }
        const int nig = 8 * nN, gid = wgid / nig, fm = gid * 8, gsz = (nM - fm) < 8 ? (nM - fm) : 8;
        pm = fm + ((wgid % nig) % gsz); pn = (wgid % nig) / gsz; return true;
    }
};
struct SchedA { TileOrder T; const char* A; const char* B;
    __device__ bool next(int i, pg8::GU& u) const { int pm, pn; if (!T.tile(i, pm, pn)) return false; u.A = A + (size_t)pm * pg8::TSTEP; u.B0 = B + (size_t)pn * pg8::TSTEP; u.B1 = u.B0; u.nt = 16; u.ks = 16; u.pm = pm; u.pn = pn; u.rows = nullptr; u.rbase = 0; u.rcnt = 0; u.a0 = 0; u.a1 = 0; return true; } };
struct EpiA { static constexpr bool PERM = true; bf16* P; float* FW;
    __device__ __forceinline__ void operator()(const pg8::f32x4 (&acc)[2][2][4][2], const pg8::GU& u, int wr, int wc, int fr, int fq) {
        const float sc = (u.pn == 1 || u.pn == 4) ? 0.125f * LOG2E : 1.f;
        const int row0 = u.pm * 256 + wr * 64 + fr, col0 = u.pn * 256 + wc * 32 + 8 * fq;
#pragma unroll
        for (int ai = 0; ai < 2; ++ai)
#pragma unroll
            for (int m = 0; m < 4; ++m) { const int row = row0 + ai * 128 + m * 16; bf16* rowp = P + (size_t)row * PS + col0;
#pragma unroll
                for (int bj = 0; bj < 2; ++bj) { const pg8::f32x4 v0 = acc[ai][bj][m][0] * sc, v1 = acc[ai][bj][m][1] * sc; v4u w;
                    w.x = pg8::cvt_pk_bf16(v0[0], v0[1]); w.y = pg8::cvt_pk_bf16(v0[2], v0[3]); w.z = pg8::cvt_pk_bf16(v1[0], v1[1]); w.w = pg8::cvt_pk_bf16(v1[2], v1[3]);
                    *(v4u*)(rowp + bj * 128) = w;
                    if (bj == 1 && u.pn == 8 && wc == 2 && fq == 0) { *(f32x4*)(FW + (size_t)row * 8) = v0; *(f32x4*)(FW + (size_t)row * 8 + 4) = v1; } } }
    } };
struct SchedC { TileOrder T; const char* HBp; const char* BRp; const char* WGp; const char* WBp;
    __device__ bool next(int i, pg8::GU& u) const { int pm, pd; if (!T.tile(i >> 3, pm, pd)) return false; const int sub = i & 7, n = sub >> 1, isg = sub & 1;
        u.pm = pm; u.pn = pd; u.a0 = n; u.a1 = isg; u.rows = nullptr; u.rbase = 0; u.rcnt = 0;
        if (isg) { u.A = HBp + (size_t)pm * pg8::TSTEP; u.B0 = WGp + (size_t)(n * 4 + pd) * pg8::TSTEP; u.nt = 16; }
        else     { u.A = BRp + (size_t)pm * pg8::TSTEP + n * 512; u.B0 = WBp + (size_t)pd * pg8::TSTEP + n * 512; u.nt = 4; }
        u.B1 = u.B0; u.ks = u.nt; return true; } };
struct EpiC { static constexpr bool PERM = true; v4u* stash; bf16* MIX; const float* bgate;
    __device__ __forceinline__ void operator()(const pg8::f32x4 (&acc)[2][2][4][2], const pg8::GU& u, int wr, int wc, int fr, int fq) {
        const int n = u.a0; const int tid = opaque_i((int)threadIdx.x);
        if (!u.a1) {
#pragma unroll
            for (int ai = 0; ai < 2; ++ai)
#pragma unroll
                for (int m = 0; m < 4; ++m)
#pragma unroll
                    for (int bj = 0; bj < 2; ++bj) { const pg8::f32x4 v0 = acc[ai][bj][m][0], v1 = acc[ai][bj][m][1]; v4u w;
                        w.x = pg8::cvt_pk_bf16(v0[0], v0[1]); w.y = pg8::cvt_pk_bf16(v0[2], v0[3]); w.z = pg8::cvt_pk_bf16(v1[0], v1[1]); w.w = pg8::cvt_pk_bf16(v1[2], v1[3]);
                        stash[((ai * 4 + m) * 2 + bj) * 512 + tid] = w; }
        } else {
            const int row0 = u.pm * 256 + wr * 64 + fr, colt = wc * 32 + 8 * fq;
#pragma unroll
            for (int bj = 0; bj < 2; ++bj) { const float* bp = bgate + n * DM + u.pn * 256 + colt + bj * 128; const f32x4 b0 = *(const f32x4*)bp, b1 = *(const f32x4*)(bp + 4);
#pragma unroll
                for (int ai = 0; ai < 2; ++ai)
#pragma unroll
                    for (int m = 0; m < 4; ++m) { const v4u uw = stash[((ai * 4 + m) * 2 + bj) * 512 + tid];
                        bf16* mp = MIX + (size_t)(row0 + ai * 128 + m * 16) * DM + u.pn * 256 + colt + bj * 128;
                        const pg8::f32x4 g0 = acc[ai][bj][m][0] + b0, g1 = acc[ai][bj][m][1] + b1;
                        float r[8]; r[0] = sigmoidf_(g0[0]) * bfl(uw.x); r[1] = sigmoidf_(g0[1]) * bfh(uw.x); r[2] = sigmoidf_(g0[2]) * bfl(uw.y); r[3] = sigmoidf_(g0[3]) * bfh(uw.y);
                        r[4] = sigmoidf_(g1[0]) * bfl(uw.z); r[5] = sigmoidf_(g1[1]) * bfh(uw.z); r[6] = sigmoidf_(g1[2]) * bfl(uw.w); r[7] = sigmoidf_(g1[3]) * bfh(uw.w);
                        if (n > 0) { const v4u pw = *(const v4u*)mp; r[0] += bfl(pw.x); r[1] += bfh(pw.x); r[2] += bfl(pw.y); r[3] += bfh(pw.y); r[4] += bfl(pw.z); r[5] += bfh(pw.z); r[6] += bfl(pw.w); r[7] += bfh(pw.w); }
                        v4u o; o.x = pg8::cvt_pk_bf16(r[0], r[1]); o.y = pg8::cvt_pk_bf16(r[2], r[3]); o.z = pg8::cvt_pk_bf16(r[4], r[5]); o.w = pg8::cvt_pk_bf16(r[6], r[7]);
                        *(v4u*)mp = o; asm volatile("" ::: "memory"); } }
        }
    } };
struct SchedC2 { TileOrder T; const char* A; const char* B;
    __device__ bool next(int i, pg8::GU& u) const { int pm, pn; if (!T.tile(i, pm, pn)) return false; u.A = A + (size_t)pm * pg8::TSTEP; u.B0 = B + (size_t)pn * pg8::TSTEP; u.B1 = u.B0; u.nt = 16; u.ks = 16; u.pm = pm; u.pn = pn; u.rows = nullptr; u.rbase = 0; u.rcnt = 0; u.a0 = 0; u.a1 = 0; return true; } };
struct EpiRes { static constexpr bool PERM = false; float* out;
    __device__ __forceinline__ void operator()(const pg8::f32x4 (&acc)[2][2][4][2], const pg8::GU& u, int wr, int wc, int fr, int fq) {
        const int row0 = u.pm * 256 + wr * 64 + fr, col0 = u.pn * 256 + wc * 32 + 4 * fq;
#pragma unroll
        for (int ai = 0; ai < 2; ++ai)
#pragma unroll
            for (int m = 0; m < 4; ++m) { float* rowp = out + (size_t)(row0 + ai * 128 + m * 16) * DM + col0;
#pragma unroll
                for (int bj = 0; bj < 2; ++bj)
#pragma unroll
                    for (int n = 0; n < 2; ++n) { f32x4* p = (f32x4*)(rowp + bj * 128 + n * 16); *p = *p * ALPHA + acc[ai][bj][m][n]; } }
    } };
__device__ __forceinline__ void cls_lookup(const LAS int* tab, int tau, int& c, int& j) {
    int cc = 0;
#pragma unroll 1
    for (int k = 1; k < NCLS; ++k) if (tab[32 + k] <= tau) cc = k;
    c = cc; j = tau - tab[32 + cc];
}
__device__ __forceinline__ void cls_experts(int c, int& ea, int& eb) { const int g = c / 6, p = c % 6; const int i = p < 3 ? 0 : (p < 5 ? 1 : 2); const int jj = p < 3 ? p + 1 : (p < 5 ? p - 1 : 3); ea = g * 4 + i; eb = g * 4 + jj; }
struct SchedD1 { const LAS int* tab; int G, c0; const char* HBp; const char* WGU; const int* list;
    __device__ bool next(int i, pg8::GU& u) const { const int L = i * G + c0; if (L >= tab[57] * 8) return false; const int tau = L >> 3, pn = L & 7; int c, j; cls_lookup(tab, tau, c, j); int ea, eb; cls_experts(c, ea, eb);
        const int e = (pn >> 2) ? eb : ea;
        u.A = HBp; u.B0 = WGU + (size_t)e * DM * DM * 2 + (size_t)(pn & 3) * pg8::TSTEP; u.B1 = u.B0; u.nt = 16; u.ks = 16; u.rows = list + (size_t)c * NTOK; u.rbase = j * 256; u.rcnt = tab[c];
        u.pm = tau; u.pn = pn; u.a0 = c; u.a1 = j; return true; } };
struct EpiD1 { static constexpr bool PERM = true; bf16* ACT; const float* gwl;
    __device__ __forceinline__ void operator()(const pg8::f32x4 (&acc)[2][2][4][2], const pg8::GU& u, int wr, int wc, int fr, int fq) {
        const int half = u.pn >> 2, col = half * 512 + (u.pn & 3) * 128 + wc * 32 + 8 * fq;
#pragma unroll
        for (int ai = 0; ai < 2; ++ai)
#pragma unroll
            for (int m = 0; m < 4; ++m) { const int r = ai * 128 + wr * 64 + m * 16 + opaque_i(fr), pos = u.rbase + r;
                const float gw = pos < u.rcnt ? gwl[((size_t)u.a0 * NTOK + pos) * 2 + half] : 0.f;
                const pg8::f32x4 g0 = acc[ai][0][m][0], g1 = acc[ai][0][m][1], u0 = acc[ai][1][m][0], u1 = acc[ai][1][m][1]; float r8[8];
#pragma unroll
                for (int k = 0; k < 4; ++k) { r8[k] = g0[k] * sigmoidf_(g0[k]) * u0[k] * gw; r8[4 + k] = g1[k] * sigmoidf_(g1[k]) * u1[k] * gw; }
                v4u o; o.x = pg8::cvt_pk_bf16(r8[0], r8[1]); o.y = pg8::cvt_pk_bf16(r8[2], r8[3]); o.z = pg8::cvt_pk_bf16(r8[4], r8[5]); o.w = pg8::cvt_pk_bf16(r8[6], r8[7]);
                *(v4u*)(ACT + ((size_t)u.pm * 256 + r) * DM + col) = o; asm volatile("" ::: "memory"); }
    } };
struct SchedD2 { const LAS int* tab; int G, c0; const char* ACTp; const char* WD; const int* list;
    __device__ bool next(int i, pg8::GU& u) const { const int L = i * G + c0; if (L >= tab[57] * 4) return false; const int tau = L >> 2, pn = L & 3; int c, j; cls_lookup(tab, tau, c, j); int ea, eb; cls_experts(c, ea, eb);
        u.A = ACTp + (size_t)tau * pg8::TSTEP; u.B0 = WD + (size_t)(ea >> 1) * DM * DM * 2 + (ea & 1) * 1024 + (size_t)pn * pg8::TSTEP; u.B1 = WD + (size_t)(eb >> 1) * DM * DM * 2 + (eb & 1) * 1024 + (size_t)pn * pg8::TSTEP;
        u.nt = 16; u.ks = 8; u.rows = list + (size_t)c * NTOK; u.rbase = j * 256; u.rcnt = tab[c]; u.pm = tau; u.pn = pn; u.a0 = c; u.a1 = j; return true; } };
struct EpiD2 { static constexpr bool PERM = false; float* out;
    __device__ __forceinline__ void operator()(const pg8::f32x4 (&acc)[2][2][4][2], const pg8::GU& u, int wr, int wc, int fr, int fq) {
        const int col0 = u.pn * 256 + wc * 32 + 4 * fq;
#pragma unroll
        for (int ai = 0; ai < 2; ++ai)
#pragma unroll
            for (int m = 0; m < 4; ++m) { const int pos = u.rbase + ai * 128 + wr * 64 + m * 16 + opaque_i(fr);
                if (pos < u.rcnt) { float* rowp = out + (size_t)u.rows[pos] * DM + col0;
#pragma unroll
                    for (int bj = 0; bj < 2; ++bj)
#pragma unroll
                        for (int n = 0; n < 2; ++n) { f32x4* p = (f32x4*)(rowp + bj * 128 + n * 16); *p = *p * ALPHA + acc[ai][bj][m][n]; } } }
    } };
typedef float f32x2v __attribute__((ext_vector_type(2)));
__device__ __forceinline__ float log_sigmoid_(float x) { return fminf(x, 0.f) - log1pf(expf(-fabsf(x))); }
__device__ __forceinline__ void fox_cumsum(const Frame& F, int bh, const float* FW, const float* bfor, float* bias2) {
    const int b = bh >> 2, h = bh & 3; const float bf = bfor[h]; const float* src = FW + ((size_t)b * SEQ + F.lane * 64) * 8 + h; float tot = 0.f;
    for (int i = 0; i < 64; ++i) tot += log_sigmoid_(src[(size_t)i * 8] + bf);
    float inc = tot;
#pragma unroll
    for (int o = 1; o < 64; o <<= 1) { const float t = __shfl_up(inc, o); if (F.lane >= o) inc += t; }
    float run = inc - tot; float* dst = bias2 + (size_t)bh * SEQ + F.lane * 64;
    for (int i = 0; i < 64; ++i) { run += log_sigmoid_(src[(size_t)i * 8] + bf); dst[i] = -run * LOG2E; }
}
__device__ __forceinline__ void pool_unit(const Frame& F, int tile, const bf16* P, const float* pw, const float* pscale, bf16* BR) {
    const int g = F.wave & 3, th = F.wave >> 2, r32 = F.lane & 31, hi = F.lane >> 5, win = 2 << g;
    const int tok = tile * 64 + th * 32 + r32, tb = tok & (SEQ - 1); const int nrow = tb + 1 < win ? tb + 1 : win; const float inv = 1.f / (float)nrow;
    bf16x8 af[4];
#pragma unroll
    for (int ks = 0; ks < 4; ++ks) { const bf16* src = P + (size_t)tok * PS + C_POOL + g * 64 + ks * 16 + hi * 8; float s[8];
#pragma unroll
        for (int k = 0; k < 8; ++k) s[k] = 0.f;
        v4u cur = *(const v4u*)src;
        for (int j = 0; j < nrow; ++j) { const v4u w = *(const v4u*)(src - (size_t)j * PS);
            s[0] += bfl(w.x); s[1] += bfh(w.x); s[2] += bfl(w.y); s[3] += bfh(w.y); s[4] += bfl(w.z); s[5] += bfh(w.z); s[6] += bfl(w.w); s[7] += bfh(w.w); }
        float c[8] = {bfl(cur.x), bfh(cur.x), bfl(cur.y), bfh(cur.y), bfl(cur.z), bfh(cur.z), bfl(cur.w), bfh(cur.w)};
        v4u o; o.x = pk2(s[0] * inv - c[0], s[1] * inv - c[1]); o.y = pk2(s[2] * inv - c[2], s[3] * inv - c[3]); o.z = pk2(s[4] * inv - c[4], s[5] * inv - c[5]); o.w = pk2(s[6] * inv - c[6], s[7] * inv - c[7]);
        af[ks] = __builtin_bit_cast(bf16x8, o); }
#pragma unroll
    for (int db = 0; db < 2; ++db) { f32x16 acc = {};
#pragma unroll
        for (int ks = 0; ks < 4; ++ks) { const float* wp = pw + ((size_t)g * 64 + ks * 16 + hi * 8) * 64 + db * 32 + r32;
            v4u o; o.x = pk2(wp[0], wp[64]); o.y = pk2(wp[128], wp[192]); o.z = pk2(wp[256], wp[320]); o.w = pk2(wp[384], wp[448]);
            acc = __builtin_amdgcn_mfma_f32_32x32x16_bf16(af[ks], __builtin_bit_cast(bf16x8, o), acc, 0, 0, 0); }
        const int col = g * 64 + db * 32 + r32; const float sc = pscale[col];
#pragma unroll
        for (int r = 0; r < 16; ++r) { const int row = tile * 64 + th * 32 + (r & 3) + 8 * (r >> 2) + 4 * hi; BR[(size_t)row * DM + col] = (bf16)f2bf(acc[r] * sc); } }
}
__device__ __forceinline__ void conv_unit(const Frame& F, int tile, const bf16* P, const float* dw, const float* cb, const float* lg, const float* lb, bf16* BR) {
    LAS float* hb = (LAS float*)(F.lds + RING_OFF);
    LAS float* yb = hb + 62 * 256;
    const int t0 = tile * 32, tb0 = t0 & (SEQ - 1);
#pragma unroll 1
    for (int e = F.tid; e < 62 * 32; e += NWAVES * 64) { const int rr = e >> 5, c8 = (e & 31) * 8; const int trel = rr - 30; float h[8];
        if (tb0 + trel >= 0) { const bf16* src = P + (size_t)(t0 + trel) * PS + C_CONV + c8; const v4u a = *(const v4u*)src, gt = *(const v4u*)(src + 256);
            h[0] = bfl(a.x) * sigmoidf_(bfl(gt.x)); h[1] = bfh(a.x) * sigmoidf_(bfh(gt.x)); h[2] = bfl(a.y) * sigmoidf_(bfl(gt.y)); h[3] = bfh(a.y) * sigmoidf_(bfh(gt.y));
            h[4] = bfl(a.z) * sigmoidf_(bfl(gt.z)); h[5] = bfh(a.z) * sigmoidf_(bfh(gt.z)); h[6] = bfl(a.w) * sigmoidf_(bfl(gt.w)); h[7] = bfh(a.w) * sigmoidf_(bfh(gt.w)); }
        else {
#pragma unroll
            for (int k = 0; k < 8; ++k) h[k] = 0.f; }
        *(LAS f32x4*)(hb + rr * 256 + c8) = (f32x4){h[0], h[1], h[2], h[3]}; *(LAS f32x4*)(hb + rr * 256 + c8 + 4) = (f32x4){h[4], h[5], h[6], h[7]}; }
    __syncthreads();
    { const int c = F.tid & 255, hf = F.tid >> 8; float w[31];
#pragma unroll
      for (int j = 0; j < 31; ++j) w[j] = dw[j * 256 + c];
      const float bias = cb[c];
#pragma unroll 1
      for (int q4 = 0; q4 < 4; ++q4) { const int tt = hf * 16 + q4 * 4; float x[34];
#pragma unroll
          for (int j = 0; j < 34; ++j) x[j] = hb[(tt + j) * 256 + c];
#pragma unroll
          for (int o = 0; o < 4; ++o) { float a = bias;
#pragma unroll
              for (int j = 0; j < 31; ++j) a += x[o + j] * w[j];
              yb[(tt + o) * 256 + c] = a; } } }
    __syncthreads();
#pragma unroll 1
    for (int q = 0; q < 4; ++q) { const int tt = F.wave * 4 + q; const f32x4 v = *(const LAS f32x4*)(yb + tt * 256 + F.lane * 4);
        const float mean = wave_sum((v.x + v.y) + (v.z + v.w)) * (1.f / 256.f); const f32x4 d = v - mean;
        const float var = wave_sum((d.x * d.x + d.y * d.y) + (d.z * d.z + d.w * d.w)) * (1.f / 256.f); const float rstd = 1.f / sqrtf(var + LN_EPS);
        const f32x4 gg = *(const f32x4*)(lg + F.lane * 4), bb = *(const f32x4*)(lb + F.lane * 4); const f32x4 y = d * rstd * gg + bb;
        v2u o; o.x = pk2(y.x * sigmoidf_(y.x), y.y * sigmoidf_(y.y)); o.y = pk2(y.z * sigmoidf_(y.z), y.w * sigmoidf_(y.w));
        *(v2u*)(BR + (size_t)(t0 + tt) * DM + 768 + F.lane * 4) = o; }
    __syncthreads();
}
__device__ __forceinline__ int key16_(float s) {
    const unsigned u = __float_as_uint(s); int m = (int)(u & 0x7fffffffu) - 0x3B000000; m = m < 0 ? 0 : m; m = m > 0x07FFFFFF ? 0x07FFFFFF : m; m >>= 12;
    return (u >> 31) ? 32767 - m : 32768 + m;
}
constexpr int DS_HIST = 0, DS_GT = 32768, DS_EQ = 49152, DS_SM = 65536;
__device__ __forceinline__ void dsa_scores(const bf16x8 (&qf)[4][4], const bf16* kp, const float (&w)[4], int (&key)[16]) {
    bf16x8 kf[4];
#pragma unroll
    for (int ks = 0; ks < 4; ++ks) kf[ks] = *(const bf16x8*)(kp + ks * 16);
    float sc[16];
#pragma unroll
    for (int hh = 0; hh < 4; ++hh) { f32x16 a = {};
#pragma unroll
        for (int ks = 0; ks < 4; ++ks) a = __builtin_amdgcn_mfma_f32_32x32x16_bf16(kf[ks], qf[hh][ks], a, 0, 0, 0);
#pragma unroll
        for (int r = 0; r < 16; ++r) sc[r] = hh == 0 ? w[0] * fmaxf(a[r], 0.f) : fmaf(w[hh], fmaxf(a[r], 0.f), sc[r]);
        __builtin_amdgcn_sched_barrier(0); }
#pragma unroll
    for (int r = 0; r < 16; ++r) key[r] = key16_(sc[r] + 0.f);
}
__device__ __forceinline__ void hist_scan(const LAS unsigned* h, int K, int lane, int& bin, int& above, int& inbin) {
    const v4u hv = *(const LAS v4u*)(h + 4 * lane); const int s = (int)(hv.x + hv.y + hv.z + hv.w); int suf = s;
#pragma unroll
    for (int o = 1; o < 64; o <<= 1) { const int t = __shfl_down(suf, o); if (lane + o < 64) suf += t; }
    const int excl = suf - s; const bool hit = (excl < K) && (K <= suf);
    int b = 0, c = excl, nb = 0;
    if (c + (int)hv.w >= K) { b = 3; nb = (int)hv.w; } else { c += (int)hv.w; if (c + (int)hv.z >= K) { b = 2; nb = (int)hv.z; } else { c += (int)hv.z; if (c + (int)hv.y >= K) { b = 1; nb = (int)hv.y; } else { c += (int)hv.y; b = 0; nb = (int)hv.x; } } }
    const unsigned long long m = __ballot(hit); const int src = m ? (int)__builtin_ctzll(m) : 0;
    bin = __shfl(4 * lane + b, src); above = __shfl(c, src); inbin = __shfl(nb, src);
    if (!m) { bin = 0; above = 0; inbin = 0; }
}
__device__ __forceinline__ void dsa_mask_unit(const Frame& F, int b, int j, const bf16* P, const float* FW, unsigned long long* selw) {
    LAS unsigned* HIST = (LAS unsigned*)(F.lds + RING_OFF + DS_HIST);
    LAS unsigned* GT = (LAS unsigned*)(F.lds + RING_OFF + DS_GT);
    LAS unsigned* EQ = (LAS unsigned*)(F.lds + RING_OFF + DS_EQ);
    LAS int* SM = (LAS int*)(F.lds + RING_OFF + DS_SM);
    const int r32 = F.lane & 31, hi = F.lane >> 5, t0 = j * 32; const size_t brow = (size_t)b * SEQ;
    bf16x8 qf[4][4];
#pragma unroll
    for (int hh = 0; hh < 4; ++hh)
#pragma unroll
        for (int ks = 0; ks < 4; ++ks) qf[hh][ks] = *(const bf16x8*)(P + (brow + t0 + r32) * PS + C_IQ + hh * 64 + ks * 16 + hi * 8);
    float w[4]; { const f32x4 wv = *(const f32x4*)(FW + (brow + t0 + r32) * 8 + 4); w[0] = wv.x; w[1] = wv.y; w[2] = wv.z; w[3] = wv.w; }
    const bf16* kbase = P + (brow + r32) * PS + C_IK + hi * 8;
    const int tq = t0 + r32;
    for (int e = F.tid; e < 8192; e += NWAVES * 64) HIST[e] = 0u;
    if (F.tid == 0) SM[160] = 0;
    __syncthreads();
#pragma unroll 1
    for (int i = F.wave; i <= j; i += NWAVES) { int key[16]; dsa_scores(qf, kbase + (size_t)i * 32 * PS, w, key);
#pragma unroll
        for (int r = 0; r < 16; ++r) { const int kv = i * 32 + (r & 3) + 8 * (r >> 2) + 4 * hi; if (kv <= tq) __hip_atomic_fetch_add(&HIST[r32 * 256 + (key[r] >> 8)], 1u, __ATOMIC_RELAXED, __HIP_MEMORY_SCOPE_WORKGROUP); } }
    __syncthreads();
#pragma unroll 1
    for (int q = F.wave * 4; q < F.wave * 4 + 4; ++q) { int bin, above, inbin; hist_scan(HIST + q * 256, 256, F.lane, bin, above, inbin); if (F.lane == 0) { SM[q] = bin; SM[32 + q] = above; } }
    __syncthreads();
    for (int e = F.tid; e < 8192; e += NWAVES * 64) HIST[e] = 0u;
    __syncthreads();
    const int myb1 = SM[r32];
#pragma unroll 1
    for (int i = F.wave; i <= j; i += NWAVES) { int key[16]; dsa_scores(qf, kbase + (size_t)i * 32 * PS, w, key);
#pragma unroll
        for (int r = 0; r < 16; ++r) { const int kv = i * 32 + (r & 3) + 8 * (r >> 2) + 4 * hi; if (kv <= tq && (key[r] >> 8) == myb1) __hip_atomic_fetch_add(&HIST[r32 * 256 + (key[r] & 255)], 1u, __ATOMIC_RELAXED, __HIP_MEMORY_SCOPE_WORKGROUP); } }
    __syncthreads();
#pragma unroll 1
    for (int q = F.wave * 4; q < F.wave * 4 + 4; ++q) { int bin, above, inbin; const int ab1 = SM[32 + q]; hist_scan(HIST + q * 256, 256 - ab1, F.lane, bin, above, inbin);
        if (F.lane == 0) { const int total = t0 + q + 1;
            if (total <= 256) { SM[64 + q] = -1; SM[96 + q] = 0; SM[128 + q] = 0; }
            else { const int quota = 256 - (ab1 + above); SM[64 + q] = (SM[q] << 8) | bin; SM[96 + q] = quota; SM[128 + q] = inbin; if (quota < inbin) SM[160] = 1; } } }
    __syncthreads();
    const int thr = SM[64 + r32]; const bool allacc = SM[96 + r32] >= SM[128 + r32];
#pragma unroll 1
    for (int i = F.wave; i <= j; i += NWAVES) { int key[16]; dsa_scores(qf, kbase + (size_t)i * 32 * PS, w, key); unsigned gtw = 0u, eqw = 0u;
#pragma unroll
        for (int r = 0; r < 16; ++r) { const int bit = (r & 3) + 8 * (r >> 2) + 4 * hi, kv = i * 32 + bit; const bool valid = kv <= tq;
            if (valid && key[r] > thr) gtw |= 1u << bit; if (valid && key[r] == thr) eqw |= 1u << bit; }
        gtw |= (unsigned)__shfl_xor((int)gtw, 32); eqw |= (unsigned)__shfl_xor((int)eqw, 32);
        if (allacc) { gtw |= eqw; eqw = 0u; }
        if (hi == 0) GT[i * 32 + r32] = gtw; else EQ[i * 32 + r32] = eqw; }
    __syncthreads();
    if (SM[160] != 0 && F.tid < 32) { const int q = F.tid; const int quota = SM[96 + q]; if (quota < SM[128 + q]) { int run = 0;
            for (int i = 0; i <= j; ++i) { unsigned e = EQ[i * 32 + q]; if (e) { const int allowed = quota - run; if (allowed <= 0) e = 0u; else { int pc = __popc(e); while (pc > allowed) { e &= ~(0x80000000u >> __clz(e)); --pc; } }
                    run += __popc(e); GT[i * 32 + q] |= e; } } } }
    __syncthreads();
    { const int ntile64 = 4 * (j / 8 + 1); unsigned long long* dst = selw + (size_t)b * 64 * SEQ + t0;
      for (int e = F.tid; e < ntile64 * 32; e += NWAVES * 64) { const int T = e >> 5, q = e & 31; const unsigned lo = (2 * T <= j) ? GT[(2 * T) * 32 + q] : 0u, up = (2 * T + 1 <= j) ? GT[(2 * T + 1) * 32 + q] : 0u;
          dst[(size_t)T * SEQ + q] = ((unsigned long long)up << 32) | lo; } }
    __syncthreads();
}
__device__ __forceinline__ void ln1_router_phase(const Frame& F, const Args& a, int l) {
    LAS float* RW = (LAS float*)(F.lds + RING_OFF);
    LAS int* LC = (LAS int*)(F.lds + RING_OFF + 81920);
    LAS int* LTOK = LC + 64;
    LAS int* LCLS = LTOK + 128; LAS int* LPOS = LCLS + 128; LAS float* LGA = (LAS float*)(LPOS + 128); LAS float* LGB = LGA + 128;
    const float* rg = a.in[16] + (size_t)l * DM * 4; const float* re = a.in[18] + (size_t)l * DM * 16;
    for (int e = F.tid; e < DM * 4; e += NWAVES * 64) RW[(e >> 2) * 20 + (e & 3)] = rg[e];
    for (int e = F.tid; e < DM * 16; e += NWAVES * 64) RW[(e >> 4) * 20 + 4 + (e & 15)] = re[e];
    if (F.tid < 64) LC[F.tid] = 0;
    __syncthreads();
    const float* rgb = a.in[17] + l * 4; const float* reb = a.in[19] + l * 16;
    const float* g1 = a.in[14] + (size_t)l * DM; const float* b1 = a.in[15] + (size_t)l * DM;
    int* list = (int*)(F.ws + WS_LIST); float* gwl = (float*)(F.ws + WS_GWL);
    const int rows_per_blk = NTOK / F.G;
    for (int rr = F.wave; rr < rows_per_blk; rr += NWAVES) { const int m = F.vcu * rows_per_blk + rr; f32x4 v[4];
        ln_row(F, F.out + (size_t)m * DM, g1, b1, F.out + (size_t)m * DM, wsb(F, WS_HB) + (size_t)m * DM, v);
        float lg[20];
#pragma unroll
        for (int c = 0; c < 20; ++c) lg[c] = 0.f;
#pragma unroll
        for (int jj = 0; jj < 4; ++jj)
#pragma unroll
            for (int k = 0; k < 4; ++k) { const LAS float* wr = RW + (256 * jj + 4 * F.lane + k) * 20; const float xv = v[jj][k];
#pragma unroll
                for (int c4 = 0; c4 < 5; ++c4) { const f32x4 wv = *(const LAS f32x4*)(wr + 4 * c4); lg[4 * c4] += xv * wv.x; lg[4 * c4 + 1] += xv * wv.y; lg[4 * c4 + 2] += xv * wv.z; lg[4 * c4 + 3] += xv * wv.w; } }
#pragma unroll
        for (int c = 0; c < 20; ++c) lg[c] = wave_sum(lg[c]);
        float gl[4]; int gi = 0; float gm;
#pragma unroll
        for (int c = 0; c < 4; ++c) gl[c] = lg[c] + rgb[c];
        gm = gl[0];
#pragma unroll
        for (int c = 1; c < 4; ++c) if (gl[c] > gm) { gm = gl[c]; gi = c; }
        float gs = 0.f;
#pragma unroll
        for (int c = 0; c < 4; ++c) gs += expf(gl[c] - gm);
        const float pg = 1.f / gs;
        float el[4];
#pragma unroll
        for (int c = 0; c < 4; ++c) { float x = 0.f;
#pragma unroll
            for (int g = 0; g < 4; ++g) if (gi == g) x = lg[4 + 4 * g + c] + reb[4 * g + c];
            el[c] = x; }
        int i1 = 0; float m1 = el[0];
#pragma unroll
        for (int c = 1; c < 4; ++c) if (el[c] > m1) { m1 = el[c]; i1 = c; }
        int i2 = -1; float m2 = -INFINITY;
#pragma unroll
        for (int c = 0; c < 4; ++c) if (c != i1 && el[c] > m2) { m2 = el[c]; i2 = c; }
        const float e2 = expf(m2 - m1); const float p1 = 1.f / (1.f + e2), p2 = e2 / (1.f + e2);
        const int ia = i1 < i2 ? i1 : i2, ib = i1 < i2 ? i2 : i1; const float ga = pg * (i1 < i2 ? p1 : p2), gb = pg * (i1 < i2 ? p2 : p1);
        const int pidx = ia == 0 ? ib - 1 : (ia == 1 ? ib + 1 : 5); const int cls = gi * 6 + pidx;
        if (F.lane == 0) { const int pos = __hip_atomic_fetch_add(&LC[cls], 1, __ATOMIC_RELAXED, __HIP_MEMORY_SCOPE_WORKGROUP); LTOK[rr] = m; LCLS[rr] = cls; LPOS[rr] = pos; LGA[rr] = ga; LGB[rr] = gb; }
    }
    __syncthreads();
    if (F.tid < NCLS) { const int n = LC[F.tid]; LC[32 + F.tid] = n ? (int)atomicAdd((unsigned*)(F.ctl + CW_CNT + (l * NCLS + F.tid) * 64), (unsigned)n) : 0; }
    __syncthreads();
    for (int rr = F.tid; rr < rows_per_blk; rr += NWAVES * 64) { const int cls = LCLS[rr], pos = LC[32 + cls] + LPOS[rr];
        list[(size_t)cls * NTOK + pos] = LTOK[rr]; gwl[((size_t)cls * NTOK + pos) * 2] = LGA[rr]; gwl[((size_t)cls * NTOK + pos) * 2 + 1] = LGB[rr]; }
    __syncthreads();
}
__device__ __forceinline__ void ln2_phase(const Frame& F, const Args& a, int l) {
    const float* g2 = a.in[23] + (size_t)l * DM; const float* b2 = a.in[24] + (size_t)l * DM;
    const int gw = F.vcu * NWAVES + F.wave, NGW = F.G * NWAVES;
    for (int m = gw; m < NTOK; m += NGW) { f32x4 v[4]; ln_row(F, F.out + (size_t)m * DM, g2, b2, F.out + (size_t)m * DM, wsb(F, WS_HB) + (size_t)m * DM, v); }
}
__device__ __forceinline__ void moe_table(const Frame& F, int l, LAS int* tab) {
    const int tid = opaque_i(F.tid);
    if (tid < NCLS) tab[tid] = (int)__hip_atomic_load(F.ctl + CW_CNT + (l * NCLS + tid) * 64, RLX_AGENT);
    __syncthreads();
    if (tid == 0) { int s = 0; for (int c = 0; c < NCLS; ++c) { tab[32 + c] = s; s += (tab[c] + 255) >> 8; } tab[32 + NCLS] = s; tab[57] = s; }
    __syncthreads();
}
#ifndef MK_PER_PHASE
#define MK_PER_PHASE 0
#endif
constexpr int PH_PER_LAYER = 9, N_PHASES = 1 + DEPTH * PH_PER_LAYER;
__global__ void __launch_bounds__(NWAVES * 64, 2) fwd_kernel(Args args) {
    extern __shared__ __attribute__((aligned(16))) unsigned char lds[];
    Frame F0; Frame& F = F0;
    F.lds = (LAS unsigned char*)lds; F.ldsg = lds;
    F.MISC = (volatile LAS unsigned*)(F.lds + MISC_OFF);
    F.tid = threadIdx.x; F.lane = F.tid & 63; F.wave = __builtin_amdgcn_readfirstlane(F.tid >> 6);
    F.G = gridDim.x; { const int bx = blockIdx.x; F.vcu = (F.G % 8 == 0) ? (bx % 8) * (F.G / 8) + bx / 8 : bx; }
    F.ws = args.ws; F.out = args.out; F.ctl = (gu32*)(args.ws + WS_CTL);
    for (int u = F.tid; u < (LDS_BYTES - LDSCTL_OFF) / 4; u += NWAVES * 64) ((LAS unsigned*)(F.lds + LDSCTL_OFF))[u] = 0u;
    __syncthreads();
    XcdBarrier bar; bar.bar = (unsigned*)(F.ctl + CW_BAR); bar.x = 0; bar.st = nullptr;
    if (!MK_PER_PHASE) bar = xcd_barrier_post((unsigned*)(F.ctl + CW_BAR), F.MISC + 8);
    const int lo = MK_PER_PHASE ? args.ph_lo : 0, hi = MK_PER_PHASE ? args.ph_hi : N_PHASES;
#define IN(k) (lo <= (k) && (k) < hi)
#ifndef PH_ONLY
#define PH_ONLY -1
#endif
#define EN(k) (PH_ONLY < 0 || PH_ONLY == (k))
#define SEAM(k) do { if (IN(k) && IN((k) + 1)) xcd_barrier(bar); } while (0)
    LAS int* TAB = (LAS int*)(F.lds + LDSCTL_OFF + 64);
    bf16* const HB = wsb(F, WS_HB); bf16* const P = wsb(F, WS_R1); bf16* const MIX = wsb(F, WS_R1); bf16* const BR = wsb(F, WS_R2); bf16* const ACT = wsb(F, WS_R2);
    float* const FW = (float*)(F.ws + WS_FW); float* const BIAS2 = (float*)(F.ws + WS_BIAS2); unsigned long long* const SELW = (unsigned long long*)(F.ws + WS_SELW);

#define FRESH(Fn) Frame Fn = F0; Fn.tid = opaque_i(F0.tid); Fn.lane = Fn.tid & 63; Fn.wave = __builtin_amdgcn_readfirstlane(Fn.tid >> 6)
    if (EN(0) && IN(0)) { FRESH(Fp); p0_prologue(Fp, args); }
    SEAM(0);
#pragma unroll 1
    for (int l0 = 0; l0 < DEPTH; ++l0) {
        const int pb = 1 + PH_PER_LAYER * l0;
#define l opaque_s(l0)
#define W (wsb(F, WS_W + (size_t)l * W_LAYER))
        if (EN(1) && IN(pb)) { SchedA S; S.T.init(NTOK / 256, PS / 256, F.G, (int)blockIdx.x); S.A = (const char*)HB; S.B = (const char*)(W + W_SM / 2);
            EpiA E{P, FW}; pg8::gemm_phase<EpiA, SchedA, false>(F.lds + RING_OFF, (LAS unsigned*)(F.lds + LDSCTL_OFF + 1024), S, E); }
        SEAM(pb);
        if (EN(2) && IN(pb + 1)) { FRESH(Fp);
#ifndef NO_CUMSUM
            if (F.vcu < 32 && Fp.wave == 0) fox_cumsum(Fp, F.vcu, FW, args.in[4] + l * 4, BIAS2);
#endif
#ifndef NO_POOL
            for (int k = 0; k < 2; ++k) pool_unit(Fp, F.vcu * 2 + k, P, args.in[6] + (size_t)l * 4 * 64 * 64, args.in[7] + (size_t)l * 256, BR);
#endif
#ifndef NO_CONV
            for (int k = 0; k < 4; ++k) conv_unit(Fp, F.vcu * 4 + k, P, args.in[8] + (size_t)l * 31 * 256, args.in[9] + (size_t)l * 256, args.in[10] + (size_t)l * 256, args.in[11] + (size_t)l * 256, BR);
#endif
#ifndef NO_DSA
            { const int b = F.vcu >> 5, s = F.vcu & 31;
#pragma unroll 1
              for (int k = 0; k < 4; ++k) { const int j = k == 0 ? 127 - s : (k == 1 ? 64 + s : (k == 2 ? 63 - s : s)); dsa_mask_unit(Fp, b, j, P, FW, SELW); } }
#endif
        }
        SEAM(pb + 1);
        if (EN(3) && IN(pb + 2)) { const int sg = F.vcu >> 3, s = F.vcu & 7, b = sg >> 2, h = sg & 3; const size_t rb = (size_t)b * SEQ;
            const attn_body::bf16* Pb = (const attn_body::bf16*)P + rb * PS; attn_body::bf16* Ob = (attn_body::bf16*)BR + rb * DM;
#pragma unroll 1
            for (int k = 0; k < 2; ++k) { const int qb = k == 0 ? 15 - s : s;
                attn_body::attn_unit<8, false>(qb * 256, Pb + C_FQ + h * 64, Pb + C_FK + h * 64, Pb + C_FV + h * 64, Ob + 256 + h * 64, BIAS2 + (size_t)(b * 4 + h) * SEQ, 0.f, nullptr, (char*)lds + RING_OFF); }
            const float slope2 = exp2f(-2.f * (float)(h + 1)) * LOG2E;
#pragma unroll 1
            for (int k = 0; k < 2; ++k) { const int qb = k == 0 ? 15 - s : s;
                attn_body::attn_unit<8, true>(qb * 256, Pb + C_DQ + h * 64, Pb + C_DK, Pb + C_DV, Ob + 512 + h * 64, nullptr, slope2, SELW + (size_t)b * 64 * SEQ, (char*)lds + RING_OFF); }
        }
        SEAM(pb + 2);
        if (EN(4) && IN(pb + 3)) { SchedC S; S.T.init(NTOK / 256, DM / 256, F.G, (int)blockIdx.x); S.HBp = (const char*)HB; S.BRp = (const char*)BR; S.WGp = (const char*)(W + W_GT / 2); S.WBp = (const char*)(W + W_BR / 2);
            EpiC E{(v4u*)(F.ws + WS_STASH + (size_t)blockIdx.x * 131072), MIX, args.in[5] + (size_t)l * 4 * DM}; pg8::gemm_phase<EpiC, SchedC, false>(F.lds + RING_OFF, (LAS unsigned*)(F.lds + LDSCTL_OFF + 1024), S, E); }
        SEAM(pb + 3);
        if (EN(5) && IN(pb + 4)) { SchedC2 S; S.T.init(NTOK / 256, DM / 256, F.G, (int)blockIdx.x); S.A = (const char*)MIX; S.B = (const char*)(W + W_OUT / 2);
            EpiRes E{F.out}; pg8::gemm_phase<EpiRes, SchedC2, false>(F.lds + RING_OFF, (LAS unsigned*)(F.lds + LDSCTL_OFF + 1024), S, E); }
        SEAM(pb + 4);
        if (EN(6) && IN(pb + 5)) { FRESH(Fp); ln1_router_phase(Fp, args, l); }
        SEAM(pb + 5);
        if (EN(7) && IN(pb + 6)) { moe_table(F, l, TAB);
            SchedD1 S{TAB, F.G, (int)blockIdx.x, (const char*)HB, (const char*)(W + W_GU / 2), (const int*)(F.ws + WS_LIST)};
            EpiD1 E{ACT, (const float*)(F.ws + WS_GWL)}; pg8::gemm_phase<EpiD1, SchedD1, true>(F.lds + RING_OFF, (LAS unsigned*)(F.lds + LDSCTL_OFF + 1024), S, E); }
        SEAM(pb + 6);
        if (EN(8) && IN(pb + 7)) { moe_table(F, l, TAB);
            SchedD2 S{TAB, F.G, (int)blockIdx.x, (const char*)ACT, (const char*)(W + W_D / 2), (const int*)(F.ws + WS_LIST)};
            EpiD2 E{F.out}; pg8::gemm_phase<EpiD2, SchedD2, false>(F.lds + RING_OFF, (LAS unsigned*)(F.lds + LDSCTL_OFF + 1024), S, E); }
        SEAM(pb + 7);
        if (EN(9) && IN(pb + 8)) { FRESH(Fp); ln2_phase(Fp, args, l); }
        SEAM(pb + 8);
#undef l
#undef W
    }
#undef IN
#undef SEAM
}

extern "C" void kernel_launch(void* const* d_in, const int* in_sizes, int n_in, void* d_out, int out_size, void* d_ws, size_t ws_size, hipStream_t stream) {
    static int grid = 0;
    if (grid == 0) {
        if (n_in != 25 || in_sizes[0] != NTOK * DM || out_size != NTOK * DM || ws_size < WS_END) { fprintf(stderr, "kernel_launch: unexpected shapes (n_in %d, in0 %d, out %d, ws %zu); nothing launched\n", n_in, n_in > 0 ? in_sizes[0] : -1, out_size, ws_size); grid = -1; return; }
        int dev = 0, cus = 0, per_cu = 0;
        if (hipGetDevice(&dev) != hipSuccess || hipDeviceGetAttribute(&cus, hipDeviceAttributeMultiprocessorCount, dev) != hipSuccess) { grid = -1; return; }
        if (hipFuncSetAttribute((const void*)fwd_kernel, hipFuncAttributeMaxDynamicSharedMemorySize, LDS_BYTES) != hipSuccess) { fprintf(stderr, "kernel_launch: hipFuncSetAttribute failed\n"); grid = -1; return; }
        if (hipOccupancyMaxActiveBlocksPerMultiprocessor(&per_cu, (const void*)fwd_kernel, NWAVES * 64, LDS_BYTES) != hipSuccess || per_cu < 1) fprintf(stderr, "kernel_launch: occupancy query reports %d\n", per_cu);
        (void)hipGetLastError();
        grid = cus;
        if (grid != 256) { fprintf(stderr, "kernel_launch: built for 256 CUs, device has %d; nothing launched\n", cus); grid = -1; return; }
    }
    if (grid < 0) return;
    if (hipMemsetAsync((char*)d_ws + WS_CTL, 0, CTL_ZERO_BYTES, stream) != hipSuccess) return;
    Args a{};
    for (int i = 0; i < 25; ++i) a.in[i] = (const float*)d_in[i];
    a.out = (float*)d_out; a.ws = (unsigned char*)d_ws;
#if MK_PER_PHASE
    for (int p = 0; p < N_PHASES; ++p) { a.ph_lo = p; a.ph_hi = p + 1; hipLaunchKernelGGL(fwd_kernel, dim3(grid), dim3(NWAVES * 64), LDS_BYTES, stream, a); }
#else
    a.ph_lo = 0; a.ph_hi = N_PHASES;
    hipLaunchKernelGGL(fwd_kernel, dim3(grid), dim3(NWAVES * 64), LDS_BYTES, stream, a);
#endif
}
```

```cpp
#include <hip/hip_runtime.h>
#include <hip/hip_bf16.h>
#include <cstdio>
#include <cstdint>
#include <cmath>

constexpr int BATCH = 8, SEQ = 4096, DM = 1024, NTOK = BATCH * SEQ, DEPTH = 2;
constexpr int P_TOTAL = 6344, PS = 2304;
constexpr int C_POOL = 0, C_FQ = 256, C_FK = 512, C_FV = 768, C_DQ = 1024, C_IQ = 1280, C_CONV = 1536, C_DK = 2048, C_DV = 2112, C_IK = 2176, C_FF = 2240, C_IW = 2244;
constexpr float LN_EPS = 1e-5f;
constexpr float ALPHA = 1.4142135623730951f;
constexpr float LOG2E = 1.4426950408889634f;
constexpr int NWAVES = 8;
constexpr int NCLS = 24;
constexpr int MAXTILES = NTOK / 256 + NCLS;

constexpr size_t MiB = 1u << 20;
constexpr size_t WS_CTL = 0, CTL_ZERO_BYTES = 1 * MiB;
constexpr size_t WS_FW = 1 * MiB;
constexpr size_t WS_BIAS2 = 2 * MiB;
constexpr size_t WS_LIST = 3 * MiB;
constexpr size_t WS_GWL = 6 * MiB;
constexpr size_t WS_SELW = 12 * MiB;
constexpr size_t WS_STASH = 28 * MiB;
constexpr size_t WS_W = 60 * MiB;
constexpr size_t W_SM = 0, W_GT = 4718592, W_BR = W_GT + 8 * MiB, W_OUT = W_BR + 2 * MiB, W_GU = W_OUT + 2 * MiB, W_D = W_GU + 32 * MiB, W_LAYER = W_D + 16 * MiB;
constexpr size_t WS_HB = 190 * MiB;
constexpr size_t WS_R1 = 254 * MiB;
constexpr size_t WS_R2 = 398 * MiB;
constexpr size_t WS_END = 474 * MiB;
static_assert(WS_W + 2 * W_LAYER <= WS_HB && WS_R1 + (size_t)NTOK * PS * 2 <= WS_R2 && WS_R2 + (size_t)MAXTILES * 256 * DM * 2 <= WS_END, "d_ws map");
constexpr int CW_BAR = 4096;
constexpr int CW_CNT = 16384;

constexpr int RING_OFF = 0, RING_BYTES = 131072;
constexpr int LDSCTL_OFF = RING_BYTES, MISC_OFF = LDSCTL_OFF + 320;
constexpr int LDS_BYTES = 147456;

#define GAS __attribute__((address_space(1)))
#define LAS __attribute__((address_space(3)))
typedef unsigned short bf16;
typedef unsigned v4u __attribute__((ext_vector_type(4)));
typedef unsigned v2u __attribute__((ext_vector_type(2)));
typedef float f32x4 __attribute__((ext_vector_type(4)));
typedef float f32x16 __attribute__((ext_vector_type(16)));
typedef short bf16x8 __attribute__((ext_vector_type(8)));
typedef GAS unsigned gu32;
#define RLX_AGENT __ATOMIC_RELAXED, __HIP_MEMORY_SCOPE_AGENT
#define LDS_WAIT() asm volatile("s_waitcnt lgkmcnt(0)" ::: "memory")
#define VM_WAIT() asm volatile("s_waitcnt vmcnt(0)" ::: "memory")
__device__ __forceinline__ int opaque_i(int x) { asm volatile("" : "+v"(x)); return x; }
__device__ __forceinline__ int opaque_s(int x) { asm volatile("" : "+s"(x)); return x; }
__device__ __forceinline__ unsigned f2bf(float f) { unsigned u = __builtin_bit_cast(unsigned, f); return (u + 0x7fffu + ((u >> 16) & 1u)) >> 16; }
__device__ __forceinline__ unsigned pk2(float lo, float hi) { return f2bf(lo) | (f2bf(hi) << 16); }
__device__ __forceinline__ float bfl(unsigned w) { return __uint_as_float(w << 16); }
__device__ __forceinline__ float bfh(unsigned w) { return __uint_as_float(w & 0xffff0000u); }
__device__ __forceinline__ float bf1(bf16 h) { return __uint_as_float((unsigned)h << 16); }
__device__ __forceinline__ float sigmoidf_(float x) { return __builtin_amdgcn_rcpf(1.f + __builtin_amdgcn_exp2f(-x * LOG2E)); }

#define XB_TMO      128
#define XB_XCNT(j)  (256  + 64 * (j))
#define XB_XSUB(j)  (1280 + 64 * (j))
#define XB_XGEN(j)  (2304 + 64 * (j))
#define XB_TOP      3328
#define XB_TOPGEN   3392
#define XCD_BAR_WORDS 3456
#define XB_SPIN_CAP (1u << 18)
__device__ __forceinline__ unsigned xb_ld(unsigned* p)              { return __hip_atomic_load(p, __ATOMIC_RELAXED, __HIP_MEMORY_SCOPE_AGENT); }
__device__ __forceinline__ unsigned xb_add(unsigned* p, unsigned v) { return __hip_atomic_fetch_add(p, v, __ATOMIC_RELAXED, __HIP_MEMORY_SCOPE_AGENT); }
__device__ __forceinline__ unsigned xb_xcc_id() { return (unsigned)__builtin_amdgcn_s_getreg((3 << 11) | 20) & 0xFu; }
#define XB_SPIN(cond, bar) do { unsigned _sp = 0; while (cond) { __builtin_amdgcn_s_sleep(1); \
    if ((++_sp & 255u) == 0u) { if (xb_ld(&(bar)[XB_TMO])) break; if (_sp > XB_SPIN_CAP) { atomicAdd(&(bar)[XB_TMO], 1u); break; } } } } while (0)
struct XcdBarrier { unsigned* bar; unsigned x; volatile LAS unsigned* st; };
__device__ __forceinline__ XcdBarrier xcd_barrier_post(unsigned* bar, volatile LAS unsigned* st) {
    XcdBarrier b; b.bar = bar; b.x = xb_xcc_id(); b.st = st;
    if (threadIdx.x == 0) (void)xb_add(&bar[XB_XCNT(b.x)], 1u);
    return b;
}
__device__ __forceinline__ void xcd_barrier_complete(unsigned* bar, unsigned x, unsigned& nloc, unsigned& nx) {
    const unsigned G = gridDim.x * gridDim.y * gridDim.z;
    unsigned sum, cnt, mine, sp = 0u;
    for (;;) {
        sum = 0u; cnt = 0u; mine = 0u;
#pragma unroll
        for (unsigned j = 0; j < 16; ++j) { const unsigned c = xb_ld(&bar[XB_XCNT(j)]); sum += c; cnt += (c > 0u) ? 1u : 0u; mine = (j == x) ? c : mine; }
        if (sum == G) break;
        __builtin_amdgcn_s_sleep(1);
        if ((++sp & 255u) == 0u) { if (xb_ld(&bar[XB_TMO])) break; if (sp > XB_SPIN_CAP) { atomicAdd(&bar[XB_TMO], 1u); break; } }
    }
    nloc = mine > 0u ? mine : 1u; nx = cnt > 0u ? cnt : 1u;
}
__device__ __forceinline__ void xcd_barrier(const XcdBarrier& b) {
    asm volatile("s_waitcnt vmcnt(0)" ::: "memory");
    __syncthreads();
    if (opaque_i((int)threadIdx.x) == 0) {
        unsigned* bar = b.bar; const unsigned bx = (unsigned)opaque_s((int)xb_xcc_id());
        __builtin_amdgcn_s_waitcnt(0);
        unsigned nloc = b.st[0], nx = b.st[1];
        if (nloc == 0u) { xcd_barrier_complete(bar, bx, nloc, nx); b.st[0] = nloc; b.st[1] = nx; }
        const unsigned old = xb_add(&bar[XB_XSUB(bx)], 1u);
        const unsigned gen = old / nloc;
        if (old + 1u == (gen + 1u) * nloc) {
            __builtin_amdgcn_fence(__ATOMIC_RELEASE, "agent");
            asm volatile("s_waitcnt vmcnt(0)" ::: "memory");
            const unsigned og = xb_add(&bar[XB_TOP], 1u);
            const unsigned tg = og / nx;
            if (og + 1u == (tg + 1u) * nx) xb_add(&bar[XB_TOPGEN], 1u);
            else XB_SPIN(xb_ld(&bar[XB_TOPGEN]) == tg, bar);
            __builtin_amdgcn_fence(__ATOMIC_ACQUIRE, "agent");
            xb_add(&bar[XB_XGEN(bx)], 1u);
            asm volatile("s_waitcnt vmcnt(0)" ::: "memory");
        } else {
            XB_SPIN(xb_ld(&bar[XB_XGEN(bx)]) == gen, bar);
            __builtin_amdgcn_fence(__ATOMIC_ACQUIRE, "agent");
            asm volatile("s_waitcnt vmcnt(0)" ::: "memory");
        }
    }
    __syncthreads();
}
namespace pg8 {
#define PG8_LAS __attribute__((address_space(3)))
typedef unsigned short bf16_t;
typedef short bf16x8 __attribute__((ext_vector_type(8)));
typedef float f32x4 __attribute__((ext_vector_type(4)));
typedef float f32x2 __attribute__((ext_vector_type(2)));
typedef unsigned u32x4 __attribute__((ext_vector_type(4)));
typedef unsigned u32x2 __attribute__((ext_vector_type(2)));
constexpr int BM = 256, BK = 64, HALF = 128, HTB = HALF * BK * 2  , STAGE_BYTES = 8 * HTB, NXCD = 8, WGM = 8;
constexpr int LD = 1024;
constexpr size_t ROWB = 2048;
constexpr size_t HSTEP = (size_t)HALF * ROWB;
constexpr size_t TSTEP = 2 * HSTEP;

__host__ __device__ __forceinline__ int lds_byte(int r, int c) { const int st = (r >> 4) * 2 + (c >> 5), rr = r & 15, cc = c & 31, ob = rr * 64 + cc * 2; return st * 1024 + (ob ^ (((ob >> 9) & 1) << 5)); }
__host__ __device__ __forceinline__ void stage_rc(int b, int& R, int& C) { const int st = b / 1024, sb = b % 1024, swz = sb ^ (((sb >> 9) & 1) << 5); R = (st >> 1) * 16 + swz / 64; C = (st & 1) * 32 + (swz % 64) / 2; }
__host__ __device__ __forceinline__ int perm32(int rho) { const int n = rho >> 4, i = rho & 15; return 8 * (i >> 2) + 4 * n + (i & 3); }

struct GU {
    const char* A;
    const char* B0;
    const char* B1;
    int nt, ks;
    const int* rows;
    int rbase, rcnt;
    int pm, pn, a0, a1;
};

__device__ __forceinline__ unsigned cvt_pk_bf16(float lo, float hi) { unsigned r; asm volatile("v_cvt_pk_bf16_f32 %0, %1, %2" : "=v"(r) : "v"(lo), "v"(hi)); return r; }
__device__ __forceinline__ float bf_lo(unsigned w) { return __uint_as_float(w << 16); }
__device__ __forceinline__ float bf_hi(unsigned w) { return __uint_as_float(w & 0xffff0000u); }

template <class Epi, class Sched, bool GATHER>
__device__ __forceinline__ void gemm_phase(PG8_LAS unsigned char* lds, PG8_LAS unsigned* xlds  , const Sched& S, Epi& E) {
    const int tid = opaque_i((int)threadIdx.x), wid = __builtin_amdgcn_readfirstlane(tid >> 6), lane = tid & 63, wr = wid >> 2, wc = wid & 3, fr = lane & 15, fq = lane >> 4;
    unsigned voffB[2], vA[2][2];
#pragma unroll
    for (int i = 0; i < 2; ++i) { int R, C; stage_rc(tid * 16 + i * 8192, R, C); const int Rb = Epi::PERM ? ((R & ~31) + perm32(R & 31)) : R;
        voffB[i] = (unsigned)(Rb * LD + C) * 2u;
        vA[0][i] = (unsigned)(R * LD + C) * 2u; vA[1][i] = vA[0][i]; }
    const size_t kstep = (size_t)(BK * 2);
    const unsigned ldsw = (unsigned)wid * 1024u;
    const int aoff = lds_byte(wr * 64 + fr, fq * 8), boff = lds_byte(wc * 32 + fr, fq * 8);
#define PG8_SA(b, h) (((b) * 2 + (h)) * HTB)
#define PG8_SB(b, h) ((4 + (b) * 2 + (h)) * HTB)
#define PG8_STAGE(bufoff, gbase, voff) do { _Pragma("unroll") for (int _i = 0; _i < 2; ++_i) \
        __builtin_amdgcn_global_load_lds((const unsigned*)((const char*)(gbase) + (voff)[_i]), (PG8_LAS unsigned*)(lds + (bufoff) + ldsw + _i * 8192), 16, 0, 0); } while (0)
#define PG8_STAGEA(bufoff, gbase, h) do { if constexpr (GATHER) { PG8_STAGE(bufoff, gbase, vA[h]); } else { PG8_STAGE(bufoff, (gbase) + (h) * HSTEP, vA[0]); } } while (0)
#define PG8_LDA(dst, b, h) do { _Pragma("unroll") for (int m = 0; m < 4; ++m) _Pragma("unroll") for (int k = 0; k < 2; ++k) dst[m][k] = *(const PG8_LAS bf16x8*)(lds + PG8_SA(b, h) + aoff + m * 2048 + k * 1024); } while (0)
#define PG8_LDB(dst, b, h) do { _Pragma("unroll") for (int n = 0; n < 2; ++n) _Pragma("unroll") for (int k = 0; k < 2; ++k) dst[n][k] = *(const PG8_LAS bf16x8*)(lds + PG8_SB(b, h) + boff + n * 2048 + k * 1024); } while (0)
#define PG8_MMA(ai, bj, At, Bt) do { __builtin_amdgcn_s_setprio(1); _Pragma("unroll") for (int m = 0; m < 4; ++m) _Pragma("unroll") for (int n = 0; n < 2; ++n) _Pragma("unroll") for (int k = 0; k < 2; ++k) \
        acc[ai][bj][m][n] = __builtin_amdgcn_mfma_f32_16x16x32_bf16(Bt[n][k], At[m][k], acc[ai][bj][m][n], 0, 0, 0); __builtin_amdgcn_s_setprio(0); } while (0)
#define PG8_WAIT_V(n) asm volatile("s_waitcnt vmcnt(" #n ")" ::: "memory")
#define PG8_WAIT_L(n) asm volatile("s_waitcnt lgkmcnt(" #n ")" ::: "memory")
#define PG8_BAR __builtin_amdgcn_s_barrier()
#define PG8_SCHED __builtin_amdgcn_sched_barrier(0)
#define PG8_BP(u, tau) ((tau) < (u).ks ? (u).B0 + (size_t)(tau) * kstep : (u).B1 + (size_t)((tau) - (u).ks) * kstep)
#define PG8_GATHER_OFFS(dst, u) do { if constexpr (GATHER) { _Pragma("unroll") for (int _h = 0; _h < 2; ++_h) _Pragma("unroll") for (int _i = 0; _i < 2; ++_i) { \
        int _R, _C; stage_rc(opaque_i(tid) * 16 + _i * 8192, _R, _C); int _p = (u).rbase + _h * HALF + _R; _p = _p < (u).rcnt ? _p : (u).rcnt - 1; dst[_h][_i] = (unsigned)(u).rows[_p] * (unsigned)ROWB + (unsigned)_C * 2u; } } } while (0)
    GU cur, nxt; int ui = 0;
    if (!S.next(0, cur)) return;
    f32x4 acc[2][2][4][2];
#pragma unroll
    for (int a = 0; a < 2; ++a)
#pragma unroll
        for (int b = 0; b < 2; ++b)
#pragma unroll
            for (int m = 0; m < 4; ++m)
#pragma unroll
                for (int n = 0; n < 2; ++n) acc[a][b][m][n] = (f32x4){0.f, 0.f, 0.f, 0.f};
    bf16x8 At[4][2], B0[2][2], B1[2][2];
    PG8_GATHER_OFFS(vA, cur);
    const char* cA = cur.A;
    { const char* b0 = PG8_BP(cur, 0); const char* b1 = PG8_BP(cur, 1);
      PG8_STAGE(PG8_SB(0, 0), b0, voffB); PG8_STAGE(PG8_SB(0, 1), b0 + HSTEP, voffB); PG8_STAGEA(PG8_SA(0, 0), cA, 0); PG8_STAGEA(PG8_SA(0, 1), cA, 1);
      if (wr == 1) PG8_BAR;
      PG8_WAIT_V(2); PG8_BAR;
      PG8_STAGE(PG8_SB(1, 0), b1, voffB); PG8_STAGEA(PG8_SA(1, 0), cA + kstep, 0); PG8_STAGE(PG8_SB(1, 1), b1 + HSTEP, voffB);
      PG8_WAIT_V(6); PG8_BAR; }
    for (;;) {
        const bool has_next = S.next(ui + 1, nxt);
        if (!has_next) nxt = cur;
        if constexpr (GATHER) { unsigned vn[2][2];
#pragma unroll
            for (int h = 0; h < 2; ++h)
#pragma unroll
                for (int i = 0; i < 2; ++i) vn[h][i] = vA[h][i];
            if (has_next) { PG8_GATHER_OFFS(vn, nxt); }
#pragma unroll
            for (int h = 0; h < 2; ++h)
#pragma unroll
                for (int i = 0; i < 2; ++i) xlds[(h * 2 + i) * 512 + tid] = vn[h][i]; }
        const char* nA = nxt.A;
        const int nt = cur.nt;
        for (int t = 0; t < nt; t += 2) {
            const bool last = (t == nt - 2);
            const char* a1 = cA + (size_t)(t + 1) * kstep;
            const char* a2 = last ? nA : cA + (size_t)(t + 2) * kstep;
            const char* b2 = last ? PG8_BP(nxt, 0) : PG8_BP(cur, t + 2);
            const char* a3 = a2 + kstep; const char* b3 = b2 + kstep;
            PG8_LDB(B0, 0, 0); PG8_LDB(B1, 0, 1); PG8_SCHED; PG8_LDA(At, 0, 0); PG8_STAGEA(PG8_SA(1, 1), a1, 1);
            if constexpr (GATHER) { if (last) {
#pragma unroll
                for (int h = 0; h < 2; ++h)
#pragma unroll
                    for (int i = 0; i < 2; ++i) vA[h][i] = xlds[(h * 2 + i) * 512 + tid]; } }
            PG8_WAIT_V(8); PG8_WAIT_L(0); PG8_BAR; PG8_MMA(0, 0, At, B0); PG8_MMA(0, 1, At, B1); PG8_BAR; PG8_SCHED;
            PG8_LDA(At, 0, 1); PG8_STAGE(PG8_SB(0, 0), b2, voffB); PG8_STAGE(PG8_SB(0, 1), b2 + HSTEP, voffB); PG8_STAGEA(PG8_SA(0, 0), a2, 0);
            PG8_WAIT_V(8); PG8_WAIT_L(0); PG8_BAR; PG8_MMA(1, 0, At, B0); PG8_MMA(1, 1, At, B1); PG8_BAR; PG8_SCHED;
            PG8_LDB(B0, 1, 0); PG8_LDB(B1, 1, 1); PG8_SCHED; PG8_LDA(At, 1, 0); PG8_STAGEA(PG8_SA(0, 1), a2, 1);
            PG8_WAIT_V(8); PG8_WAIT_L(0); PG8_BAR; PG8_MMA(0, 0, At, B0); PG8_MMA(0, 1, At, B1); PG8_BAR; PG8_SCHED;
            PG8_LDA(At, 1, 1); PG8_STAGE(PG8_SB(1, 0), b3, voffB); PG8_STAGE(PG8_SB(1, 1), b3 + HSTEP, voffB); PG8_STAGEA(PG8_SA(1, 0), a3, 0);
            PG8_WAIT_V(8); PG8_WAIT_L(0); PG8_BAR; PG8_MMA(1, 0, At, B0); PG8_MMA(1, 1, At, B1); PG8_BAR; PG8_SCHED;
        }
        if (wr == 0) PG8_BAR;
        E(acc, cur, wr, wc, fr, fq);
        if (!has_next) break;
#pragma unroll
        for (int a = 0; a < 2; ++a)
#pragma unroll
            for (int b = 0; b < 2; ++b)
#pragma unroll
                for (int m = 0; m < 4; ++m)
#pragma unroll
                    for (int n = 0; n < 2; ++n) acc[a][b][m][n] = (f32x4){0.f, 0.f, 0.f, 0.f};
        cur = nxt; cA = nA; ++ui;
        if (wr == 1) PG8_BAR;
    }
    PG8_WAIT_V(0);
    PG8_BAR;
#undef PG8_SA
#undef PG8_SB
#undef PG8_STAGE
#undef PG8_STAGEA
#undef PG8_LDA
#undef PG8_LDB
#undef PG8_MMA
#undef PG8_WAIT_V
#undef PG8_WAIT_L
#undef PG8_BAR
#undef PG8_SCHED
#undef PG8_BP
#undef PG8_GATHER_OFFS
}
}
namespace attn_body {
using bf16=__hip_bfloat16;
using bf16x8=__attribute__((ext_vector_type(8)))short;
using s16x4=__attribute__((ext_vector_type(4)))short;
using f32x16=__attribute__((ext_vector_type(16)))float;
using f32x4=__attribute__((ext_vector_type(4)))float;
using u32x4=__attribute__((ext_vector_type(4)))unsigned;
constexpr int SEQ=4096,D=64;
constexpr int KVP=2304;
constexpr int OP=1024;
constexpr int NW=8,QBLK=32,QB=QBLK*NW,KVBLK=64,NQB=SEQ/QB;
__device__ __forceinline__ int crow(int r,int hi){return (r&3)+8*(r>>2)+4*hi;}
#define SBAR() __builtin_amdgcn_sched_barrier(0)
__device__ __forceinline__ void cmask(f32x16&p0,f32x16&p1,int jb,int qrel,int hi){
  const float NEG=-INFINITY; int kb=64*jb+4*hi;
  #pragma unroll
  for(int r=0;r<16;++r){int kv=kb+(r&3)+8*(r>>2); if(kv>qrel)p0[r]=NEG; if(kv+32>qrel)p1[r]=NEG;}
}
__device__ __forceinline__ void bmask(f32x16&p0,f32x16&p1,unsigned long long w,int hi){
  const float NEG=-INFINITY; const unsigned lo=((unsigned)w)>>(4*hi), up=((unsigned)(w>>32))>>(4*hi);
  #pragma unroll
  for(int r=0;r<16;++r){const int bit=(r&3)+8*(r>>2); if(!((lo>>bit)&1u))p0[r]=NEG; if(!((up>>bit)&1u))p1[r]=NEG;}
}
constexpr int NSLOT=3, SLOTB=8192;
constexpr int LDS_K=0, LDS_V=NSLOT*SLOTB, LDS_WS=2*NSLOT*SLOTB, LDS_OST=LDS_WS+NW*64*4, LDS_BIAS=LDS_OST+NW*4096, LDS_BYTES=LDS_BIAS+SEQ*4;
constexpr float C2=0.125f*1.4426950408889634f;
__device__ __forceinline__ void glds16(const void*gsrc,unsigned lds_dst){unsigned keep;
  asm volatile("s_mov_b32 %0, m0\n\ts_mov_b32 m0, %2\n\ts_nop 0\n\tglobal_load_lds_dwordx4 %1, off\n\ts_mov_b32 m0, %0":"=&s"(keep):"v"(gsrc),"s"(lds_dst):"memory");}
__device__ __forceinline__ float max3f(float a,float b,float c){float r;asm("v_max3_f32 %0, %1, %2, %3":"=v"(r):"v"(a),"v"(b),"v"(c));return r;}
__device__ __forceinline__ float max2f(float a,float b){float r;asm("v_max_f32_e32 %0, %1, %2":"=v"(r):"v"(a),"v"(b));return r;}
__device__ __forceinline__ float fadd_s(float a,float b){float r;asm("v_add_f32_e32 %0, %1, %2":"=v"(r):"v"(a),"v"(b));return r;}
__device__ __forceinline__ float fsub_s(float a,float b){float r;asm("v_sub_f32_e32 %0, %1, %2":"=v"(r):"v"(a),"v"(b));return r;}
typedef float f32x2_t __attribute__((ext_vector_type(2))); typedef __bf16 bf16x2_t __attribute__((ext_vector_type(2)));
__device__ __forceinline__ unsigned cvtpk_s(float lo,float hi){f32x2_t v={lo,hi};bf16x2_t b=__builtin_convertvector(v,bf16x2_t);return __builtin_bit_cast(unsigned,b);}
#define WAIT_BAR(N) asm volatile("s_waitcnt vmcnt(" #N ") lgkmcnt(0)\n\ts_barrier":::"memory")

typedef __attribute__((address_space(3))) const char* lds_cptr;
typedef short v4i16_t __attribute__((ext_vector_type(4)));
__device__ __forceinline__ void binit(f32x16&p0,f32x16&p1,lds_cptr bp,float mhat){
  #pragma unroll
  for(int g=0;g<4;++g){ const f32x4 a=*(const __attribute__((address_space(3))) f32x4*)(bp+g*32); const f32x4 b=*(const __attribute__((address_space(3))) f32x4*)(bp+128+g*32);
    #pragma unroll
    for(int i=0;i<4;++i){p0[4*g+i]=a[i]-mhat;p1[4*g+i]=b[i]-mhat;} }
}
__device__ __forceinline__ void qkt(f32x16&p0,f32x16&p1,const char*Kslot,const bf16x8*qr,int r32,int hi){
  const char*kb=Kslot+hi*1024+r32*16;
  #pragma unroll
  for(int d0=0;d0<4;++d0){
    const bf16x8 b0=*reinterpret_cast<const bf16x8*>(kb+d0*2048);
    const bf16x8 b1=*reinterpret_cast<const bf16x8*>(kb+d0*2048+512);
    p0=__builtin_amdgcn_mfma_f32_32x32x16_bf16(b0,qr[d0],p0,0,0,0);p1=__builtin_amdgcn_mfma_f32_32x32x16_bf16(b1,qr[d0],p1,0,0,0);}
}
__device__ __forceinline__ void kload8(bf16x8*kf,lds_cptr kp){
  kf[0]=*(const __attribute__((address_space(3))) bf16x8*)(kp);      kf[1]=*(const __attribute__((address_space(3))) bf16x8*)(kp+512);
  kf[2]=*(const __attribute__((address_space(3))) bf16x8*)(kp+2048); kf[3]=*(const __attribute__((address_space(3))) bf16x8*)(kp+2560);
  kf[4]=*(const __attribute__((address_space(3))) bf16x8*)(kp+4096); kf[5]=*(const __attribute__((address_space(3))) bf16x8*)(kp+4608);
  kf[6]=*(const __attribute__((address_space(3))) bf16x8*)(kp+6144); kf[7]=*(const __attribute__((address_space(3))) bf16x8*)(kp+6656);
}
__device__ __forceinline__ void kload2(bf16x8*kf,lds_cptr kp,int j){ kf[2*j]=*(const __attribute__((address_space(3))) bf16x8*)(kp+j*2048); kf[2*j+1]=*(const __attribute__((address_space(3))) bf16x8*)(kp+j*2048+512); }
__device__ __forceinline__ s16x4 vtr(lds_cptr p){ return __builtin_bit_cast(s16x4,__builtin_amdgcn_ds_read_tr16_b64_v4i16((__attribute__((address_space(3))) v4i16_t*)p)); }
__device__ __forceinline__ float rowmax(const f32x16&p0,const f32x16&p1){
  float a=max3f(p0[0],p0[1],p1[0]),b=max3f(p0[2],p0[3],p1[1]);a=max3f(a,p1[2],p1[3]);
  #pragma unroll
  for(int r=4;r<16;r+=4){a=max3f(a,p0[r],p0[r+1]);b=max3f(b,p0[r+2],p0[r+3]);a=max3f(a,p1[r],p1[r+1]);b=max3f(b,p1[r+2],p1[r+3]);}
  const float m=max2f(a,b);
  auto rr=__builtin_amdgcn_permlane32_swap(__float_as_uint(m),__float_as_uint(m),false,false);
  return max2f(__uint_as_float(rr[0]),__uint_as_float(rr[1]));
}
__device__ __forceinline__ void pv(f32x16*o,int vb,bf16x8 pa0,bf16x8 pa1,bf16x8 pa2,bf16x8 pa3){
  #pragma unroll
  for(int d0=0;d0<2;++d0){s16x4 lo[4],hi[4];
    #pragma unroll
    for(int ks=0;ks<4;++ks){
      asm volatile("ds_read_b64_tr_b16 %0,%1 offset:%c2":"=&v"(lo[ks]):"v"(vb),"i"(d0*4096+ks*1024):"memory");
      asm volatile("ds_read_b64_tr_b16 %0,%1 offset:%c2":"=&v"(hi[ks]):"v"(vb),"i"(d0*4096+ks*1024+512):"memory");}
    asm volatile("s_waitcnt lgkmcnt(0)":::"memory");SBAR();
    #define PK(k) (bf16x8){lo[k][0],lo[k][1],lo[k][2],lo[k][3],hi[k][0],hi[k][1],hi[k][2],hi[k][3]}
    o[d0]=__builtin_amdgcn_mfma_f32_32x32x16_bf16(pa0,PK(0),o[d0],0,0,0);
    o[d0]=__builtin_amdgcn_mfma_f32_32x32x16_bf16(pa1,PK(1),o[d0],0,0,0);
    o[d0]=__builtin_amdgcn_mfma_f32_32x32x16_bf16(pa2,PK(2),o[d0],0,0,0);
    o[d0]=__builtin_amdgcn_mfma_f32_32x32x16_bf16(pa3,PK(3),o[d0],0,0,0);
    #undef PK
  }
}

template<int THRL,bool MASK> __device__ __forceinline__ void attn_unit(int q0,const bf16*Qs,const bf16*__restrict__ Ks,const bf16*__restrict__ Vs,bf16*Os,
                                                                       const float*biasg,float slope2,const unsigned long long*maskw,char*shm){
  const int tid=opaque_i((int)threadIdx.x),lane=tid&63,r32=lane&31,hi=lane>>5; const int wid=__builtin_amdgcn_readfirstlane(tid>>6);
  const bf16*Qw=Qs+(long)(q0+wid*QBLK)*KVP;
  const unsigned lds0=(unsigned)(uintptr_t)shm;
  float*wsf=(float*)(shm+LDS_WS)+wid*64;
  unsigned long long mwA=0ull,mwB=0ull;
  { float*bl=(float*)(shm+LDS_BIAS); const int nk=q0+QB;
    if(biasg){ for(int s=tid;s<nk;s+=NW*64)bl[s]=biasg[s]; } else { for(int s=tid;s<nk;s+=NW*64)bl[s]=slope2*(float)s; }
    if(MASK){ const unsigned long long*mp0=maskw+(q0+wid*QBLK+(lane&31)); mwA=mp0[0]; mwB=mp0[SEQ]; asm volatile("":"+v"(mwA),"+v"(mwB)); }
    asm volatile("s_waitcnt vmcnt(0) lgkmcnt(0)":::"memory"); }
  const bf16*ksrc=Ks+(long)lane*KVP+wid*8;
  const bf16*vsrc=Vs+(long)(16*(wid&3)+(lane>>2))*KVP+(wid>>2)*32+(lane&3)*8;
  const unsigned kdst=lds0+LDS_K+wid*1024, vdst=lds0+LDS_V+wid*1024;
  #define DMA_K(t,slot) glds16(ksrc+(long)(t)*KVBLK*KVP,(unsigned)__builtin_amdgcn_readfirstlane(kdst+(slot)))
  #define DMA_V(t,slot) glds16(vsrc+(long)(t)*KVBLK*KVP,(unsigned)__builtin_amdgcn_readfirstlane(vdst+(slot)))
  const int vb0=(int)(lds0+LDS_V)+((lane>>4)&1)*32+(lane&3)*8+(4*hi+((lane&15)>>2))*64;
  const char*Kbase=shm+LDS_K; bf16x8 kf[8];
  const lds_cptr shm3=(lds_cptr)shm; const lds_cptr kp0=shm3+LDS_K+hi*1024+r32*16; const lds_cptr vp0=shm3+LDS_V+((lane>>4)&1)*32+(lane&3)*8+(4*hi+((lane&15)>>2))*64;
  const lds_cptr bp0=shm3+LDS_BIAS+hi*16;
  const int NT=(q0+QB)/KVBLK;
  DMA_K(0,0);DMA_V(0,0);DMA_K(1,SLOTB);
  bf16x8 qr[4];
  #pragma unroll
  for(int d0=0;d0<4;++d0)qr[d0]=*reinterpret_cast<const bf16x8*>(&Qw[(long)r32*KVP+d0*16+hi*8]);
  const unsigned long long*mwp=MASK?maskw+(q0+wid*QBLK+r32):nullptr;
  #define MLOAD(MW,t) do{ if(MASK){ MW=mwp[(long)(t)*SEQ]; } }while(0)
  #define MPIN(MW) do{}while(0)
  float mhat=0.f,l_reg=0.f;f32x16 o[2];o[0]=f32x16{};o[1]=f32x16{};
  const int qrel=wid*QBLK+r32;
  #define CMASK(P0,P1,t,MW) do{ if(MASK){ bmask(P0,P1,MW,hi); } else { int jb_=(t)-(NT-4); if(jb_>=0)cmask(P0,P1,jb_,qrel,hi); } }while(0)
  bool resc=false;
  #define START(P0,P1) do{ const float rm=rowmax(P0,P1); resc=false; \
    { const float dl=__builtin_fmaxf(rm,-60000.f); mhat=fadd_s(mhat,dl); \
      _Pragma("unroll") for(int r=0;r<16;++r){P0[r]=fsub_s(P0[r],dl);P1[r]=fsub_s(P1[r],dl);} } \
    _Pragma("unroll") for(int r=0;r<16;++r)P0[r]=__builtin_amdgcn_exp2f(P0[r]); }while(0)
  #define RESC() do{ if(resc){ asm volatile("s_waitcnt lgkmcnt(0)":::"memory"); \
      _Pragma("unroll") for(int d_=0;d_<2;++d_) _Pragma("unroll") for(int r=0;r<16;++r)o[d_][r]*=wsf[crow(r,hi)]; } }while(0)
  f32x16 pA0,pA1,pB0,pB1;
  int sl_prev=0,sl_cur=0,sl_next=SLOTB;
  #define ROT() do{sl_prev=sl_cur;sl_cur=sl_next;sl_next=(sl_next==(NSLOT-1)*SLOTB)?0:sl_next+SLOTB;}while(0)
  DMA_K(2,2*SLOTB);
  WAIT_BAR(3);
  binit(pA0,pA1,bp0,0.f);
  qkt(pA0,pA1,Kbase,qr,r32,hi);asm volatile("s_nop 15\n\ts_nop 7":"+v"(pA0),"+v"(pA1));CMASK(pA0,pA1,0,mwA);
  START(pA0,pA1);
  _Pragma("unroll") for(int r=0;r<16;++r)pA1[r]=__builtin_amdgcn_exp2f(pA1[r]);
  WAIT_BAR(0);
  DMA_K(3,0);DMA_V(1,SLOTB);MLOAD(mwA,2);
  ROT();
  kload8(kf,kp0+sl_cur);
  if(MASK){WAIT_BAR(3);}else{WAIT_BAR(2);}
  s16x4 vlo[8],vhi[8]; u32x4 pw0,pw1,pw2,pw3;
  #define PKW(P,B) cvtpk_s(P[B],P[B+1])
  #define PAF(k) __builtin_bit_cast(bf16x8,pw##k)
  #define VFR(i) (bf16x8){vlo[i][0],vlo[i][1],vlo[i][2],vlo[i][3],vhi[i][0],vhi[i][1],vhi[i][2],vhi[i][3]}
  #define PIN(x) asm volatile("":"+v"(x))
  #define MX3(a,b,c) __builtin_fmaxf(__builtin_fmaxf((a),(b)),(c))
  #define GAPA(MF,A0,A1,A2,A3,W0,W1,PW) do{ MF; sacc+=A0; sacc+=A1; sacc+=A2; sacc+=A3; PIN(sacc); W0; W1; PIN(PW); SBAR(); }while(0)
  #define EX(v) __builtin_amdgcn_exp2f(v)
  #define GAPB(MF,X,B) do{ MF; X[B]=EX(X[B]); X[B+1]=EX(X[B+1]); X[B+2]=EX(X[B+2]); X[B+3]=EX(X[B+3]); PIN(X); SBAR(); }while(0)
  #define VRD(i) do{ vlo[i]=vtr(vp_+(((i)>>2)*4096+((i)&3)*1024)); vhi[i]=vtr(vp_+(((i)>>2)*4096+((i)&3)*1024+512)); }while(0)
  #define KRD(G,j) do{ if(G){ kload2(kf,kp0+sl_next,j); SBAR(); } }while(0)
  #define STEP(C0,C1,P0,P1,t,GK,GV,GL,MW,GM,DOCM) do{ SBAR(); \
    const lds_cptr vp_=vp0+sl_prev; \
    binit(C0,C1,bp0+(t)*256,mhat); SBAR(); \
    VRD(0); SBAR(); float sacc=(P0[0]+P0[1]); \
    GAPA(C0=__builtin_amdgcn_mfma_f32_32x32x16_bf16(kf[0],qr[0],C0,0,0,0), P0[2],P0[3],P0[4],P0[5],     pw0[0]=PKW(P0,0), pw0[1]=PKW(P0,2), pw0); \
    VRD(4); SBAR(); GAPA(C1=__builtin_amdgcn_mfma_f32_32x32x16_bf16(kf[1],qr[0],C1,0,0,0), P0[6],P0[7],P0[8],P0[9],     pw0[2]=PKW(P0,4), pw0[3]=PKW(P0,6), pw0); \
    VRD(1); SBAR(); GAPA(C0=__builtin_amdgcn_mfma_f32_32x32x16_bf16(kf[2],qr[1],C0,0,0,0),   P0[10],P0[11],P0[12],P0[13], pw1[0]=PKW(P0,8), pw1[1]=PKW(P0,10), pw1); \
    VRD(5); SBAR(); GAPA(C1=__builtin_amdgcn_mfma_f32_32x32x16_bf16(kf[3],qr[1],C1,0,0,0),   P0[14],P0[15],P1[0],P1[1],   pw1[2]=PKW(P0,12),pw1[3]=PKW(P0,14), pw1); \
    VRD(2); SBAR(); GAPA(C0=__builtin_amdgcn_mfma_f32_32x32x16_bf16(kf[4],qr[2],C0,0,0,0),   P1[2],P1[3],P1[4],P1[5],     pw2[0]=PKW(P1,0), pw2[1]=PKW(P1,2), pw2); \
    VRD(6); SBAR(); GAPA(C1=__builtin_amdgcn_mfma_f32_32x32x16_bf16(kf[5],qr[2],C1,0,0,0),   P1[6],P1[7],P1[8],P1[9],     pw2[2]=PKW(P1,4), pw2[3]=PKW(P1,6), pw2); \
    VRD(3); SBAR(); GAPA(C0=__builtin_amdgcn_mfma_f32_32x32x16_bf16(kf[6],qr[3],C0,0,0,0),   P1[10],P1[11],P1[12],P1[13], pw3[0]=PKW(P1,8), pw3[1]=PKW(P1,10), pw3); \
    VRD(7); SBAR(); GAPA(C1=__builtin_amdgcn_mfma_f32_32x32x16_bf16(kf[7],qr[3],C1,0,0,0),   P1[14],P1[15],0.f,0.f,       pw3[2]=PKW(P1,12),pw3[3]=PKW(P1,14), pw3); \
    l_reg+=sacc; \
    if(MASK&&(DOCM)){ CMASK(C0,C1,t,MW); } \
    if(GK){DMA_K((t)+3,sl_cur);} if(GV){DMA_V((t)+1,sl_next);} \
    if(!MASK&&(DOCM)){ CMASK(C0,C1,t,MW); } \
    if(GM){ MLOAD(MW,(t)+2); } \
    { float a=MX3(C0[0],C0[1],C1[0]),b=MX3(C0[2],C0[3],C1[1]); a=MX3(a,C1[2],C1[3]); \
      _Pragma("unroll") for(int r=4;r<16;r+=4){a=MX3(a,C0[r],C0[r+1]);b=MX3(b,C0[r+2],C0[r+3]);a=MX3(a,C1[r],C1[r+1]);b=MX3(b,C1[r+2],C1[r+3]);} \
      float rm=__builtin_fmaxf(a,b); { auto rr=__builtin_amdgcn_permlane32_swap(__float_as_uint(rm),__float_as_uint(rm),false,false); rm=__builtin_fmaxf(__uint_as_float(rr[0]),__uint_as_float(rr[1])); } \
      resc=false; \
      if(__builtin_expect(__any(rm>(float)THRL),0)){ const float dl=__builtin_fmaxf(rm,0.f); mhat+=dl; \
        _Pragma("unroll") for(int r=0;r<16;++r){C0[r]-=dl;C1[r]-=dl;} \
        const float f=__builtin_amdgcn_exp2f(-dl); l_reg*=f; if(hi==0)wsf[r32]=f; resc=true; } } \
    SBAR(); \
    GAPB(o[0]=__builtin_amdgcn_mfma_f32_32x32x16_bf16(PAF(0),VFR(0),o[0],0,0,0), C0,0); \
    GAPB(o[1]=__builtin_amdgcn_mfma_f32_32x32x16_bf16(PAF(0),VFR(4),o[1],0,0,0), C0,4); \
    KRD(GL,0); GAPB(o[0]=__builtin_amdgcn_mfma_f32_32x32x16_bf16(PAF(1),VFR(1),o[0],0,0,0), C0,8); \
    KRD(GL,1); GAPB(o[1]=__builtin_amdgcn_mfma_f32_32x32x16_bf16(PAF(1),VFR(5),o[1],0,0,0), C0,12); \
    KRD(GL,2); GAPB(o[0]=__builtin_amdgcn_mfma_f32_32x32x16_bf16(PAF(2),VFR(2),o[0],0,0,0), C1,0); \
    KRD(GL,3); GAPB(o[1]=__builtin_amdgcn_mfma_f32_32x32x16_bf16(PAF(2),VFR(6),o[1],0,0,0), C1,4); \
    GAPB(o[0]=__builtin_amdgcn_mfma_f32_32x32x16_bf16(PAF(3),VFR(3),o[0],0,0,0), C1,8); \
    GAPB(o[1]=__builtin_amdgcn_mfma_f32_32x32x16_bf16(PAF(3),VFR(7),o[1],0,0,0), C1,12); \
    }while(0)
  int t=1;
  #define ENDW(tt) do{ if((tt)+3<NT){ if(MASK){WAIT_BAR(3);}else{WAIT_BAR(2);} } else if((tt)+2<NT){ if(MASK){WAIT_BAR(2);}else{WAIT_BAR(1);} } else {WAIT_BAR(0);} }while(0)
  for(;t+5<NT;t+=2){
    STEP(pB0,pB1,pA0,pA1,t,true,true,true,mwB,MASK,MASK);     if(MASK){WAIT_BAR(3);}else{WAIT_BAR(2);} MPIN(mwA); RESC(); ROT();
    STEP(pA0,pA1,pB0,pB1,t+1,true,true,true,mwA,MASK,MASK);   if(MASK){WAIT_BAR(3);}else{WAIT_BAR(2);} MPIN(mwB); RESC(); ROT();
  }
  for(;t+1<NT;t+=2){
    STEP(pB0,pB1,pA0,pA1,t,(t+3<NT),(t+1<NT),(t+1<NT),mwB,(MASK&&(t+2<NT)),true);       ENDW(t);   MPIN(mwA); RESC(); ROT();
    STEP(pA0,pA1,pB0,pB1,t+1,(t+4<NT),(t+2<NT),(t+2<NT),mwA,(MASK&&(t+3<NT)),true);     ENDW(t+1); MPIN(mwB); RESC(); ROT();
  }
  STEP(pB0,pB1,pA0,pA1,NT-1,false,false,false,mwB,false,true); RESC();
  { float sacc=pB0[0]+pB0[1]; _Pragma("unroll") for(int r=2;r<16;++r)sacc+=pB0[r]; _Pragma("unroll") for(int r=0;r<16;++r)sacc+=pB1[r]; l_reg+=sacc;
    pw0=(u32x4){PKW(pB0,0),PKW(pB0,2),PKW(pB0,4),PKW(pB0,6)};pw1=(u32x4){PKW(pB0,8),PKW(pB0,10),PKW(pB0,12),PKW(pB0,14)};pw2=(u32x4){PKW(pB1,0),PKW(pB1,2),PKW(pB1,4),PKW(pB1,6)};pw3=(u32x4){PKW(pB1,8),PKW(pB1,10),PKW(pB1,12),PKW(pB1,14)};
    SBAR(); pv(o,vb0+sl_cur,PAF(0),PAF(1),PAF(2),PAF(3)); }
  #undef PKW
  #undef PAF
  #undef VFR
  #undef PIN
  #undef MX3
  #undef GAPA
  #undef GAPB
  #undef EX
  #undef VRD
  #undef KRD
  #undef STEP
  #undef ENDW
  {auto rr=__builtin_amdgcn_permlane32_swap(__float_as_uint(l_reg),__float_as_uint(l_reg),false,false);l_reg=__uint_as_float(rr[0])+__uint_as_float(rr[1]);}
  if(hi==0)wsf[32+r32]=l_reg;asm volatile("s_waitcnt lgkmcnt(0)":::"memory");
  float rli[16];
  #pragma unroll
  for(int r=0;r<16;++r)rli[r]=__builtin_amdgcn_rcpf(wsf[32+crow(r,hi)]);
  bf16*Ow=Os+(long)(q0+wid*QBLK)*OP;
  { bf16*stg=(bf16*)(shm+LDS_OST)+wid*2048;
    #pragma unroll
    for(int r=0;r<16;++r){const int orow=crow(r,hi);
      #pragma unroll
      for(int d0=0;d0<2;++d0)stg[orow*64+d0*32+r32]=__float2bfloat16(o[d0][r]*rli[r]);}
    asm volatile("s_waitcnt lgkmcnt(0)":::"memory");
    #pragma unroll
    for(int i=0;i<4;++i){const int row=i*8+(lane>>3),ch=lane&7; const u32x4 v=*(const u32x4*)(stg+row*64+ch*8); *(u32x4*)(Ow+(long)row*OP+ch*8)=v;} }
  asm volatile("s_waitcnt lgkmcnt(0)\n\ts_barrier":::"memory");
  #undef DMA_K
  #undef MLOAD
  #undef MPIN
  #undef DMA_V
  #undef CMASK
  #undef START
  #undef RESC
  #undef ROT
}
#undef SBAR
#undef WAIT_BAR
}
struct Args { const float* in[25]; float* out; unsigned char* ws; int ph_lo, ph_hi; };
struct Frame {
    LAS unsigned char* lds; unsigned char* ldsg;
    volatile LAS unsigned* MISC;
    gu32* ctl;
    int tid, lane, wave, vcu, G;
    unsigned char* ws; float* out;
};
__device__ __forceinline__ float dpp_add_(float v, float acc_src, int) { return v; }
#define DPP_F(v, ctrl, rmask) __builtin_bit_cast(float, __builtin_amdgcn_update_dpp(0, __builtin_bit_cast(int, (v)), (ctrl), (rmask), 0xF, false))
__device__ __forceinline__ float wave_sum(float v) {
    v += DPP_F(v, 0xB1, 0xF);
    v += DPP_F(v, 0x4E, 0xF);
    v += DPP_F(v, 0x141, 0xF);
    v += DPP_F(v, 0x140, 0xF);
    v += DPP_F(v, 0x142, 0xA);
    v += DPP_F(v, 0x143, 0xC);
    return __builtin_bit_cast(float, __builtin_amdgcn_readlane(__builtin_bit_cast(int, v), 63));
}
__device__ __forceinline__ bf16* wsb(const Frame& F, size_t off) { return (bf16*)(F.ws + off); }

__device__ __forceinline__ int map_small(int r) {
    if (r < 1024) return r;
    if (r < 1280) return 1028 + (r - 1024);
    if (r < 1536) return 1412 + (r - 1280);
    if (r < 2048) return 1736 + (r - 1536);
    if (r < 2112) return 1284 + (r - 2048);
    if (r < 2176) return 1348 + (r - 2112);
    if (r < 2240) return 1668 + (r - 2176);
    if (r < 2244) return 1024 + (r - 2240);
    if (r < 2248) return 1732 + (r - 2244);
    return -1;
}
__device__ __forceinline__ void tr_item(const float* src, int ld_src, int k0, int srccol, bf16* dst, int ld_dst, LAS float* scr, int lane) {
#pragma unroll 8
    for (int i = 0; i < 32; ++i) { const int kk = 2 * i + (lane >> 5); scr[kk * 33 + (lane & 31)] = srccol >= 0 ? src[(size_t)(k0 + kk) * ld_src + srccol] : 0.f; }
    LDS_WAIT(); asm volatile("" ::: "memory");
    const int c = lane & 7;
#pragma unroll
    for (int j = 0; j < 4; ++j) { const int n = (lane >> 3) + 8 * j; const LAS float* s = scr + (8 * c) * 33 + n;
        v4u o; o.x = pk2(s[0 * 33], s[1 * 33]); o.y = pk2(s[2 * 33], s[3 * 33]); o.z = pk2(s[4 * 33], s[5 * 33]); o.w = pk2(s[6 * 33], s[7 * 33]);
        *(GAS v4u*)(dst + (size_t)n * ld_dst + 8 * c) = o; }
    LDS_WAIT(); asm volatile("" ::: "memory");
}
constexpr int IT_SM = 72 * 16, IT_GT = 128 * 16, IT_BR = 512, IT_OUT = 512, IT_GU = 16 * 512, IT_D = 16 * 256, IT_LAYER = IT_SM + IT_GT + IT_BR + IT_OUT + IT_GU + IT_D;
__device__ __forceinline__ void p0_item(const Frame& F, const Args& a, int it, LAS float* scr) {
    const int l = it / IT_LAYER; int j = it % IT_LAYER; const int n = F.lane & 31;
    bf16* W = wsb(F, WS_W + (size_t)l * W_LAYER);
    if (j < IT_SM) { const int g = j / 16, kb = j % 16; tr_item(a.in[3] + (size_t)l * DM * P_TOTAL, P_TOTAL, kb * 64, map_small(g * 32 + n), W + W_SM / 2 + (size_t)(g * 32) * DM + kb * 64, DM, scr, F.lane); return; } j -= IT_SM;
    if (j < IT_GT) { const int g = j / 16, kb = j % 16; tr_item(a.in[3] + (size_t)l * DM * P_TOTAL, P_TOTAL, kb * 64, 2248 + g * 32 + n, W + W_GT / 2 + (size_t)(g * 32) * DM + kb * 64, DM, scr, F.lane); return; } j -= IT_GT;
    if (j < IT_BR) { const int nb = j / 128, jj = j % 128, g = jj / 4, kb = jj % 4;
        tr_item(a.in[12] + ((size_t)l * 4 + nb) * 256 * DM, DM, kb * 64, g * 32 + n, W + W_BR / 2 + (size_t)(g * 32) * DM + nb * 256 + kb * 64, DM, scr, F.lane); return; } j -= IT_BR;
    if (j < IT_OUT) { const int g = j / 16, kb = j % 16; tr_item(a.in[13] + (size_t)l * DM * DM, DM, kb * 64, g * 32 + n, W + W_OUT / 2 + (size_t)(g * 32) * DM + kb * 64, DM, scr, F.lane); return; } j -= IT_OUT;
    if (j < IT_GU) { const int e = j / 512, jj = j % 512, g = jj / 16, kb = jj % 16; const int r0 = g * 32, q = r0 >> 8, within = r0 & 255; const bool isup = within >= 128;
        const float* src = (isup ? a.in[21] : a.in[20]) + ((size_t)l * 16 + e) * DM * 512;
        tr_item(src, 512, kb * 64, 128 * q + (within & 127) + n, W + W_GU / 2 + (size_t)e * DM * DM + (size_t)r0 * DM + kb * 64, DM, scr, F.lane); return; } j -= IT_GU;
    { const int e = j / 256, jj = j % 256, g = jj / 8, kb = jj % 8;
        tr_item(a.in[22] + ((size_t)l * 16 + e) * 512 * DM, DM, kb * 64, g * 32 + n, W + W_D / 2 + (size_t)(e >> 1) * DM * DM + (size_t)(g * 32) * DM + (e & 1) * 512 + kb * 64, DM, scr, F.lane); }
}
__device__ __forceinline__ void ln_load(const Frame& F, const float* xrow, f32x4 (&v)[4]) {
    const GAS f32x4* xr = (const GAS f32x4*)xrow + F.lane;
#pragma unroll
    for (int j = 0; j < 4; ++j) v[j] = xr[64 * j];
}
__device__ __forceinline__ void ln_row(const Frame& F, const float* g, const float* b, float* orow, bf16* brow, f32x4 (&v)[4], bool dry = false) {
    float s = 0.f;
#pragma unroll
    for (int j = 0; j < 4; ++j) s += (v[j].x + v[j].y) + (v[j].z + v[j].w);
    const float mean = wave_sum(s) * (1.f / DM); float s2 = 0.f;
#pragma unroll
    for (int j = 0; j < 4; ++j) { v[j] = v[j] - mean; s2 += (v[j].x * v[j].x + v[j].y * v[j].y) + (v[j].z * v[j].z + v[j].w * v[j].w); }
    const float rstd = 1.f / sqrtf(wave_sum(s2) * (1.f / DM) + LN_EPS);
    GAS f32x4* o4 = (GAS f32x4*)orow + F.lane; GAS v2u* o8 = (GAS v2u*)brow + F.lane;
#pragma unroll
    for (int j = 0; j < 4; ++j) { const f32x4 gg = ((const GAS f32x4*)g)[F.lane + 64 * j], bb = ((const GAS f32x4*)b)[F.lane + 64 * j];
        v[j] = v[j] * rstd * gg + bb; v2u w; w.x = pk2(v[j].x, v[j].y); w.y = pk2(v[j].z, v[j].w); if (!dry) { o4[64 * j] = v[j]; o8[64 * j] = w; } }
}
__device__ __forceinline__ void p0_prologue(const Frame& F, const Args& a) {
    LAS float* scr = (LAS float*)(F.lds + RING_OFF + F.wave * 16384);
    const int gw = F.vcu * NWAVES + F.wave, NGW = F.G * NWAVES;
    for (int it = gw; it < DEPTH * IT_LAYER; it += NGW) p0_item(F, a, it, scr);
    { f32x4 nx[4]; ln_load(F, a.in[0] + (size_t)gw * DM, nx);
      for (int m = gw; m < NTOK; m += NGW) { f32x4 v[4];
#pragma unroll
          for (int j = 0; j < 4; ++j) v[j] = nx[j];
          if (m + NGW < NTOK) ln_load(F, a.in[0] + (size_t)(m + NGW) * DM, nx);
          ln_row(F, a.in[1], a.in[2], F.out + (size_t)m * DM, wsb(F, WS_HB) + (size_t)m * DM, v); } }
}

struct TileOrder {
    int nM, nN, nwg, G, c;
    __device__ void init(int nM_, int nN_, int G_, int c_) { nM = nM_; nN = nN_; nwg = nM * nN; G = G_; c = c_; }
    __device__ bool tile(int i, int& pm, int& pn) const {
        const long L = (long)i * G + c; if (L >= nwg) return false;
        int wgid = (int)L; { const int q = nwg / 8, r = nwg % 8, xcd = wgid % 8, off = wgid / 8; wgid = (xcd < r ? xcd * (q + 1) : r * (q + 1) + (xcd - r) * q) + off; }
        const int nig = 8 * nN, gid = wgid / nig, fm = gid * 8, gsz = (nM - fm) < 8 ? (nM - fm) : 8;
        pm = fm + ((wgid % nig) % gsz); pn = (wgid % nig) / gsz; return true;
    }
};
struct SchedA { TileOrder T; const char* A; const char* B;
    __device__ bool next(int i, pg8::GU& u) const { int pm, pn; if (!T.tile(i, pm, pn)) return false; u.A = A + (size_t)pm * pg8::TSTEP; u.B0 = B + (size_t)pn * pg8::TSTEP; u.B1 = u.B0; u.nt = 16; u.ks = 16; u.pm = pm; u.pn = pn; u.rows = nullptr; u.rbase = 0; u.rcnt = 0; u.a0 = 0; u.a1 = 0; return true; } };
struct EpiA { static constexpr bool PERM = true; bf16* P; float* FW;
    __device__ __forceinline__ void operator()(const pg8::f32x4 (&acc)[2][2][4][2], const pg8::GU& u, int wr, int wc, int fr, int fq) {
        const float sc = (u.pn == 1 || u.pn == 4) ? 0.125f * LOG2E : 1.f;
        const int row0 = u.pm * 256 + wr * 64 + fr, col0 = u.pn * 256 + wc * 32 + 8 * fq;
#pragma unroll
        for (int ai = 0; ai < 2; ++ai)
#pragma unroll
            for (int m = 0; m < 4; ++m) { const int row = row0 + ai * 128 + m * 16; bf16* rowp = P + (size_t)row * PS + col0;
#pragma unroll
                for (int bj = 0; bj < 2; ++bj) { const pg8::f32x4 v0 = acc[ai][bj][m][0] * sc, v1 = acc[ai][bj][m][1] * sc; v4u w;
                    w.x = pg8::cvt_pk_bf16(v0[0], v0[1]); w.y = pg8::cvt_pk_bf16(v0[2], v0[3]); w.z = pg8::cvt_pk_bf16(v1[0], v1[1]); w.w = pg8::cvt_pk_bf16(v1[2], v1[3]);
                    *(v4u*)(rowp + bj * 128) = w;
                    if (bj == 1 && u.pn == 8 && wc == 2 && fq == 0) { *(f32x4*)(FW + (size_t)row * 8) = v0; *(f32x4*)(FW + (size_t)row * 8 + 4) = v1; } } }
    } };
struct SchedC { TileOrder T; const char* HBp; const char* BRp; const char* WGp; const char* WBp;
    __device__ bool next(int i, pg8::GU& u) const { int pm, pd; if (!T.tile(i >> 3, pm, pd)) return false; const int sub = i & 7, n = sub >> 1, isg = sub & 1;
        u.pm = pm; u.pn = pd; u.a0 = n; u.a1 = isg; u.rows = nullptr; u.rbase = 0; u.rcnt = 0;
        if (isg) { u.A = HBp + (size_t)pm * pg8::TSTEP; u.B0 = WGp + (size_t)(n * 4 + pd) * pg8::TSTEP; u.nt = 16; }
        else     { u.A = BRp + (size_t)pm * pg8::TSTEP + n * 512; u.B0 = WBp + (size_t)pd * pg8::TSTEP + n * 512; u.nt = 4; }
        u.B1 = u.B0; u.ks = u.nt; return true; } };
struct EpiC { static constexpr bool PERM = true; v4u* stash; bf16* MIX; const float* bgate;
    __device__ __forceinline__ void operator()(const pg8::f32x4 (&acc)[2][2][4][2], const pg8::GU& u, int wr, int wc, int fr, int fq) {
        const int n = u.a0; const int tid = opaque_i((int)threadIdx.x);
        if (!u.a1) {
#pragma unroll
            for (int ai = 0; ai < 2; ++ai)
#pragma unroll
                for (int m = 0; m < 4; ++m)
#pragma unroll
                    for (int bj = 0; bj < 2; ++bj) { const pg8::f32x4 v0 = acc[ai][bj][m][0], v1 = acc[ai][bj][m][1]; v4u w;
                        w.x = pg8::cvt_pk_bf16(v0[0], v0[1]); w.y = pg8::cvt_pk_bf16(v0[2], v0[3]); w.z = pg8::cvt_pk_bf16(v1[0], v1[1]); w.w = pg8::cvt_pk_bf16(v1[2], v1[3]);
                        stash[((ai * 4 + m) * 2 + bj) * 512 + tid] = w; }
        } else {
            const int row0 = u.pm * 256 + wr * 64 + fr, colt = wc * 32 + 8 * fq;
#pragma unroll
            for (int bj = 0; bj < 2; ++bj) { const float* bp = bgate + n * DM + u.pn * 256 + colt + bj * 128; const f32x4 b0 = *(const f32x4*)bp, b1 = *(const f32x4*)(bp + 4);
#pragma unroll
                for (int ai = 0; ai < 2; ++ai)
#pragma unroll
                    for (int m = 0; m < 4; ++m) { const v4u uw = stash[((ai * 4 + m) * 2 + bj) * 512 + tid];
                        bf16* mp = MIX + (size_t)(row0 + ai * 128 + m * 16) * DM + u.pn * 256 + colt + bj * 128;
                        const pg8::f32x4 g0 = acc[ai][bj][m][0] + b0, g1 = acc[ai][bj][m][1] + b1;
                        float r[8]; r[0] = sigmoidf_(g0[0]) * bfl(uw.x); r[1] = sigmoidf_(g0[1]) * bfh(uw.x); r[2] = sigmoidf_(g0[2]) * bfl(uw.y); r[3] = sigmoidf_(g0[3]) * bfh(uw.y);
                        r[4] = sigmoidf_(g1[0]) * bfl(uw.z); r[5] = sigmoidf_(g1[1]) * bfh(uw.z); r[6] = sigmoidf_(g1[2]) * bfl(uw.w); r[7] = sigmoidf_(g1[3]) * bfh(uw.w);
                        if (n > 0) { const v4u pw = *(const v4u*)mp; r[0] += bfl(pw.x); r[1] += bfh(pw.x); r[2] += bfl(pw.y); r[3] += bfh(pw.y); r[4] += bfl(pw.z); r[5] += bfh(pw.z); r[6] += bfl(pw.w); r[7] += bfh(pw.w); }
                        v4u o; o.x = pg8::cvt_pk_bf16(r[0], r[1]); o.y = pg8::cvt_pk_bf16(r[2], r[3]); o.z = pg8::cvt_pk_bf16(r[4], r[5]); o.w = pg8::cvt_pk_bf16(r[6], r[7]);
                        *(v4u*)mp = o; asm volatile("" ::: "memory"); } }
        }
    } };
struct SchedC2 { TileOrder T; const char* A; const char* B;
    __device__ bool next(int i, pg8::GU& u) const { int pm, pn; if (!T.tile(i, pm, pn)) return false; u.A = A + (size_t)pm * pg8::TSTEP; u.B0 = B + (size_t)pn * pg8::TSTEP; u.B1 = u.B0; u.nt = 16; u.ks = 16; u.pm = pm; u.pn = pn; u.rows = nullptr; u.rbase = 0; u.rcnt = 0; u.a0 = 0; u.a1 = 0; return true; } };
struct EpiRes { static constexpr bool PERM = false; float* out; bool dry;
    __device__ __forceinline__ void operator()(const pg8::f32x4 (&acc)[2][2][4][2], const pg8::GU& u, int wr, int wc, int fr, int fq) {
        const int row0 = u.pm * 256 + wr * 64 + fr, col0 = u.pn * 256 + wc * 32 + 4 * fq;
#pragma unroll
        for (int ai = 0; ai < 2; ++ai)
#pragma unroll
            for (int m = 0; m < 4; ++m) { float* rowp = out + (size_t)(row0 + ai * 128 + m * 16) * DM + col0;
#pragma unroll
                for (int bj = 0; bj < 2; ++bj)
#pragma unroll
                    for (int n = 0; n < 2; ++n) { f32x4* p = (f32x4*)(rowp + bj * 128 + n * 16); const f32x4 r_ = *p * ALPHA + acc[ai][bj][m][n]; if (!dry) *p = r_; } }
    } };
__device__ __forceinline__ void cls_lookup(const LAS int* tab, int tau, int& c, int& j) {
    int cc = 0;
#pragma unroll 1
    for (int k = 1; k < NCLS; ++k) if (tab[32 + k] <= tau) cc = k;
    c = cc; j = tau - tab[32 + cc];
}
__device__ __forceinline__ void cls_experts(int c, int& ea, int& eb) { const int g = c / 6, p = c % 6; const int i = p < 3 ? 0 : (p < 5 ? 1 : 2); const int jj = p < 3 ? p + 1 : (p < 5 ? p - 1 : 3); ea = g * 4 + i; eb = g * 4 + jj; }
struct SchedD1 { const LAS int* tab; int G, c0; const char* HBp; const char* WGU; const int* list;
    __device__ bool next(int i, pg8::GU& u) const { const int L = i * G + c0; if (L >= tab[57] * 8) return false; const int tau = L >> 3, pn = L & 7; int c, j; cls_lookup(tab, tau, c, j); int ea, eb; cls_experts(c, ea, eb);
        const int e = (pn >> 2) ? eb : ea;
        u.A = HBp; u.B0 = WGU + (size_t)e * DM * DM * 2 + (size_t)(pn & 3) * pg8::TSTEP; u.B1 = u.B0; u.nt = 16; u.ks = 16; u.rows = list + (size_t)c * NTOK; u.rbase = j * 256; u.rcnt = tab[c];
        u.pm = tau; u.pn = pn; u.a0 = c; u.a1 = j; return true; } };
struct EpiD1 { static constexpr bool PERM = true; bf16* ACT; const float* gwl;
    __device__ __forceinline__ void operator()(const pg8::f32x4 (&acc)[2][2][4][2], const pg8::GU& u, int wr, int wc, int fr, int fq) {
        const int half = u.pn >> 2, col = half * 512 + (u.pn & 3) * 128 + wc * 32 + 8 * fq;
#pragma unroll
        for (int ai = 0; ai < 2; ++ai)
#pragma unroll
            for (int m = 0; m < 4; ++m) { const int r = ai * 128 + wr * 64 + m * 16 + opaque_i(fr), pos = u.rbase + r;
                const float gw = pos < u.rcnt ? gwl[((size_t)u.a0 * NTOK + pos) * 2 + half] : 0.f;
                const pg8::f32x4 g0 = acc[ai][0][m][0], g1 = acc[ai][0][m][1], u0 = acc[ai][1][m][0], u1 = acc[ai][1][m][1]; float r8[8];
#pragma unroll
                for (int k = 0; k < 4; ++k) { r8[k] = g0[k] * sigmoidf_(g0[k]) * u0[k] * gw; r8[4 + k] = g1[k] * sigmoidf_(g1[k]) * u1[k] * gw; }
                v4u o; o.x = pg8::cvt_pk_bf16(r8[0], r8[1]); o.y = pg8::cvt_pk_bf16(r8[2], r8[3]); o.z = pg8::cvt_pk_bf16(r8[4], r8[5]); o.w = pg8::cvt_pk_bf16(r8[6], r8[7]);
                *(v4u*)(ACT + ((size_t)u.pm * 256 + r) * DM + col) = o; asm volatile("" ::: "memory"); }
    } };
struct SchedD2 { const LAS int* tab; int G, c0; const char* ACTp; const char* WD; const int* list;
    __device__ bool next(int i, pg8::GU& u) const { const int L = i * G + c0; if (L >= tab[57] * 4) return false; const int tau = L >> 2, pn = L & 3; int c, j; cls_lookup(tab, tau, c, j); int ea, eb; cls_experts(c, ea, eb);
        u.A = ACTp + (size_t)tau * pg8::TSTEP; u.B0 = WD + (size_t)(ea >> 1) * DM * DM * 2 + (ea & 1) * 1024 + (size_t)pn * pg8::TSTEP; u.B1 = WD + (size_t)(eb >> 1) * DM * DM * 2 + (eb & 1) * 1024 + (size_t)pn * pg8::TSTEP;
        u.nt = 16; u.ks = 8; u.rows = list + (size_t)c * NTOK; u.rbase = j * 256; u.rcnt = tab[c]; u.pm = tau; u.pn = pn; u.a0 = c; u.a1 = j; return true; } };
struct EpiD2 { static constexpr bool PERM = false; float* out; bool dry;
    __device__ __forceinline__ void operator()(const pg8::f32x4 (&acc)[2][2][4][2], const pg8::GU& u, int wr, int wc, int fr, int fq) {
        const int col0 = u.pn * 256 + wc * 32 + 4 * fq;
#pragma unroll
        for (int ai = 0; ai < 2; ++ai)
#pragma unroll
            for (int m = 0; m < 4; ++m) { const int pos = u.rbase + ai * 128 + wr * 64 + m * 16 + opaque_i(fr);
                if (pos < u.rcnt) { float* rowp = out + (size_t)u.rows[pos] * DM + col0;
#pragma unroll
                    for (int bj = 0; bj < 2; ++bj)
#pragma unroll
                        for (int n = 0; n < 2; ++n) { f32x4* p = (f32x4*)(rowp + bj * 128 + n * 16); const f32x4 r_ = *p * ALPHA + acc[ai][bj][m][n]; if (!dry) *p = r_; } } }
    } };
typedef float f32x2v __attribute__((ext_vector_type(2)));
__device__ __forceinline__ float log_sigmoid_(float x) { return fminf(x, 0.f) - __builtin_amdgcn_logf(1.f + __builtin_amdgcn_exp2f(-fabsf(x) * LOG2E)) * 0.6931471805599453f; }
__device__ __forceinline__ void fox_cumsum(const Frame& F, int bh, const float* FW, const float* bfor, float* bias2) {
    const int b = bh >> 2, h = bh & 3; const float bf = bfor[h]; const float* src = FW + ((size_t)b * SEQ + F.lane * 64) * 8 + h; float tot = 0.f;
    for (int i = 0; i < 64; ++i) tot += log_sigmoid_(src[(size_t)i * 8] + bf);
    float inc = tot;
#pragma unroll
    for (int o = 1; o < 64; o <<= 1) { const float t = __shfl_up(inc, o); if (F.lane >= o) inc += t; }
    float run = inc - tot; float* dst = bias2 + (size_t)bh * SEQ + F.lane * 64;
    for (int i = 0; i < 64; ++i) { run += log_sigmoid_(src[(size_t)i * 8] + bf); dst[i] = -run * LOG2E; }
}
__device__ __forceinline__ void pool_unit(const Frame& F, int tile, const bf16* P, const float* pw, const float* pscale, bf16* BR) {
    const int g = F.wave & 3, th = F.wave >> 2, r32 = F.lane & 31, hi = F.lane >> 5, win = 2 << g;
    const int tok = tile * 64 + th * 32 + r32, tb = tok & (SEQ - 1); const int nrow = tb + 1 < win ? tb + 1 : win; const float inv = 1.f / (float)nrow;
    bf16x8 af[4];
#pragma unroll
    for (int ks = 0; ks < 4; ++ks) { const bf16* src = P + (size_t)tok * PS + C_POOL + g * 64 + ks * 16 + hi * 8; float s[8];
#pragma unroll
        for (int k = 0; k < 8; ++k) s[k] = 0.f;
        v4u cur = *(const v4u*)src;
        for (int j = 0; j < nrow; ++j) { const v4u w = *(const v4u*)(src - (size_t)j * PS);
            s[0] += bfl(w.x); s[1] += bfh(w.x); s[2] += bfl(w.y); s[3] += bfh(w.y); s[4] += bfl(w.z); s[5] += bfh(w.z); s[6] += bfl(w.w); s[7] += bfh(w.w); }
        float c[8] = {bfl(cur.x), bfh(cur.x), bfl(cur.y), bfh(cur.y), bfl(cur.z), bfh(cur.z), bfl(cur.w), bfh(cur.w)};
        v4u o; o.x = pk2(s[0] * inv - c[0], s[1] * inv - c[1]); o.y = pk2(s[2] * inv - c[2], s[3] * inv - c[3]); o.z = pk2(s[4] * inv - c[4], s[5] * inv - c[5]); o.w = pk2(s[6] * inv - c[6], s[7] * inv - c[7]);
        af[ks] = __builtin_bit_cast(bf16x8, o); }
#pragma unroll
    for (int db = 0; db < 2; ++db) { f32x16 acc = {};
#pragma unroll
        for (int ks = 0; ks < 4; ++ks) { const float* wp = pw + ((size_t)g * 64 + ks * 16 + hi * 8) * 64 + db * 32 + r32;
            v4u o; o.x = pk2(wp[0], wp[64]); o.y = pk2(wp[128], wp[192]); o.z = pk2(wp[256], wp[320]); o.w = pk2(wp[384], wp[448]);
            acc = __builtin_amdgcn_mfma_f32_32x32x16_bf16(af[ks], __builtin_bit_cast(bf16x8, o), acc, 0, 0, 0); }
        const int col = g * 64 + db * 32 + r32; const float sc = pscale[col];
#pragma unroll
        for (int r = 0; r < 16; ++r) { const int row = tile * 64 + th * 32 + (r & 3) + 8 * (r >> 2) + 4 * hi; BR[(size_t)row * DM + col] = (bf16)f2bf(acc[r] * sc); } }
}
__device__ __forceinline__ void conv_unit(const Frame& F, int tile, const bf16* P, const float* dw, const float* cb, const float* lg, const float* lb, bf16* BR) {
    LAS float* hb = (LAS float*)(F.lds + RING_OFF);
    LAS float* yb = hb + 62 * 256;
    const int t0 = tile * 32, tb0 = t0 & (SEQ - 1);
#pragma unroll 1
    for (int e = F.tid; e < 62 * 32; e += NWAVES * 64) { const int rr = e >> 5, c8 = (e & 31) * 8; const int trel = rr - 30; float h[8];
        if (tb0 + trel >= 0) { const bf16* src = P + (size_t)(t0 + trel) * PS + C_CONV + c8; const v4u a = *(const v4u*)src, gt = *(const v4u*)(src + 256);
            h[0] = bfl(a.x) * sigmoidf_(bfl(gt.x)); h[1] = bfh(a.x) * sigmoidf_(bfh(gt.x)); h[2] = bfl(a.y) * sigmoidf_(bfl(gt.y)); h[3] = bfh(a.y) * sigmoidf_(bfh(gt.y));
            h[4] = bfl(a.z) * sigmoidf_(bfl(gt.z)); h[5] = bfh(a.z) * sigmoidf_(bfh(gt.z)); h[6] = bfl(a.w) * sigmoidf_(bfl(gt.w)); h[7] = bfh(a.w) * sigmoidf_(bfh(gt.w)); }
        else {
#pragma unroll
            for (int k = 0; k < 8; ++k) h[k] = 0.f; }
        *(LAS f32x4*)(hb + rr * 256 + c8) = (f32x4){h[0], h[1], h[2], h[3]}; *(LAS f32x4*)(hb + rr * 256 + c8 + 4) = (f32x4){h[4], h[5], h[6], h[7]}; }
    __syncthreads();
    { const int c = F.tid & 255, hf = F.tid >> 8; float w[31];
#pragma unroll
      for (int j = 0; j < 31; ++j) w[j] = dw[j * 256 + c];
      const float bias = cb[c];
#pragma unroll 1
      for (int q4 = 0; q4 < 4; ++q4) { const int tt = hf * 16 + q4 * 4; float x[34];
#pragma unroll
          for (int j = 0; j < 34; ++j) x[j] = hb[(tt + j) * 256 + c];
#pragma unroll
          for (int o = 0; o < 4; ++o) { float a = bias;
#pragma unroll
              for (int j = 0; j < 31; ++j) a += x[o + j] * w[j];
              yb[(tt + o) * 256 + c] = a; } } }
    __syncthreads();
#pragma unroll 1
    for (int q = 0; q < 4; ++q) { const int tt = F.wave * 4 + q; const f32x4 v = *(const LAS f32x4*)(yb + tt * 256 + F.lane * 4);
        const float mean = wave_sum((v.x + v.y) + (v.z + v.w)) * (1.f / 256.f); const f32x4 d = v - mean;
        const float var = wave_sum((d.x * d.x + d.y * d.y) + (d.z * d.z + d.w * d.w)) * (1.f / 256.f); const float rstd = 1.f / sqrtf(var + LN_EPS);
        const f32x4 gg = *(const f32x4*)(lg + F.lane * 4), bb = *(const f32x4*)(lb + F.lane * 4); const f32x4 y = d * rstd * gg + bb;
        v2u o; o.x = pk2(y.x * sigmoidf_(y.x), y.y * sigmoidf_(y.y)); o.y = pk2(y.z * sigmoidf_(y.z), y.w * sigmoidf_(y.w));
        *(v2u*)(BR + (size_t)(t0 + tt) * DM + 768 + F.lane * 4) = o; }
    __syncthreads();
}
__device__ __forceinline__ int key16_(float s) { const int u = (int)__float_as_uint(s); int m = (u & 0x7fffffff) - 0x3B000000; m = (m < 0 ? 0 : (m > 0x07FFFFFF ? 0x07FFFFFF : m)) >> 12; return 32768 + (m ^ (u >> 31)); }
__device__ __forceinline__ float key_lbound(int k) {
    if (k <= 0) return -INFINITY; if (k >= 65536) return INFINITY;
    if (k >= 32769) return __uint_as_float((unsigned)(((k - 32768) << 12) + 0x3B000000));
    if (k == 32768) return 0.f;
    return -__uint_as_float((unsigned)(((32768 - k) << 12) + 0x3B000000 - 1));
}
constexpr int DS_HIST = 0, DS_GT = 32768, DS_EQ = 49152, DS_SM = 65536;
typedef float f32x2p __attribute__((ext_vector_type(2)));
__device__ __forceinline__ void dsa_ldk(bf16x8 (&kf)[4], const bf16* kp) {
#pragma unroll
    for (int ks = 0; ks < 4; ++ks) kf[ks] = *(const bf16x8*)(kp + ks * 16);
}
__device__ __forceinline__ void dsa_scores(const bf16x8 (&qf)[4][4], const bf16x8 (&kf)[4], const float (&w)[4], float (&sc)[16]) {
    f32x16 a[4];
#pragma unroll
    for (int hh = 0; hh < 4; ++hh) { a[hh] = (f32x16){};
#pragma unroll
        for (int ks = 0; ks < 4; ++ks) a[hh] = __builtin_amdgcn_mfma_f32_32x32x16_bf16(kf[ks], qf[hh][ks], a[hh], 0, 0, 0); }
#pragma unroll
    for (int r = 0; r < 16; r += 2) { f32x2p s2 = (f32x2p){fmaxf(a[0][r], 0.f), fmaxf(a[0][r + 1], 0.f)} * w[0];
#pragma unroll
        for (int hh = 1; hh < 4; ++hh) s2 = (f32x2p){fmaxf(a[hh][r], 0.f), fmaxf(a[hh][r + 1], 0.f)} * w[hh] + s2;
        sc[r] = s2.x + 0.f; sc[r + 1] = s2.y + 0.f; }
}
__device__ __forceinline__ void hist_scan(const LAS unsigned* h, int K, int lane, int& bin, int& above, int& inbin) {
    const v4u hv = *(const LAS v4u*)(h + 4 * lane); const int s = (int)(hv.x + hv.y + hv.z + hv.w); int suf = s;
#pragma unroll
    for (int o = 1; o < 64; o <<= 1) { const int t = __shfl_down(suf, o); if (lane + o < 64) suf += t; }
    const int excl = suf - s; const bool hit = (excl < K) && (K <= suf);
    int b = 0, c = excl, nb = 0;
    if (c + (int)hv.w >= K) { b = 3; nb = (int)hv.w; } else { c += (int)hv.w; if (c + (int)hv.z >= K) { b = 2; nb = (int)hv.z; } else { c += (int)hv.z; if (c + (int)hv.y >= K) { b = 1; nb = (int)hv.y; } else { c += (int)hv.y; b = 0; nb = (int)hv.x; } } }
    const unsigned long long m = __ballot(hit); const int src = m ? (int)__builtin_ctzll(m) : 0;
    bin = __shfl(4 * lane + b, src); above = __shfl(c, src); inbin = __shfl(nb, src);
    if (!m) { bin = 0; above = 0; inbin = 0; }
}
#define DSA_TILE_LOOP(...) do { bf16x8 kf[4]; int i = F.wave; if (i <= j) dsa_ldk(kf, kbase + (size_t)i * 32 * PS); \
    _Pragma("unroll 1") for (; i <= j; i += NWAVES) { bf16x8 kn[4]; const int inx = i + NWAVES <= j ? i + NWAVES : i; dsa_ldk(kn, kbase + (size_t)inx * 32 * PS); \
        float sc[16]; dsa_scores(qf, kf, w, sc); const bool diag = (i == j); __VA_ARGS__ \
        _Pragma("unroll") for (int ks = 0; ks < 4; ++ks) kf[ks] = kn[ks]; } } while (0)
__device__ __forceinline__ void dsa_mask_unit(const Frame& F, int b, int j, const bf16* P, const float* FW, unsigned long long* selw) {
    LAS unsigned* HIST = (LAS unsigned*)(F.lds + RING_OFF + DS_HIST);
    LAS unsigned* GT = (LAS unsigned*)(F.lds + RING_OFF + DS_GT);
    LAS unsigned* EQ = (LAS unsigned*)(F.lds + RING_OFF + DS_EQ);
    LAS int* SM = (LAS int*)(F.lds + RING_OFF + DS_SM);
    const int r32 = F.lane & 31, hi = F.lane >> 5, t0 = j * 32; const size_t brow = (size_t)b * SEQ;
    bf16x8 qf[4][4];
#pragma unroll
    for (int hh = 0; hh < 4; ++hh)
#pragma unroll
        for (int ks = 0; ks < 4; ++ks) qf[hh][ks] = *(const bf16x8*)(P + (brow + t0 + r32) * PS + C_IQ + hh * 64 + ks * 16 + hi * 8);
    float w[4]; { const f32x4 wv = *(const f32x4*)(FW + (brow + t0 + r32) * 8 + 4); w[0] = wv.x; w[1] = wv.y; w[2] = wv.z; w[3] = wv.w; }
    const bf16* kbase = P + (brow + r32) * PS + C_IK + hi * 8;
    const int qlim = r32 - 4 * hi;
    LAS unsigned* hrow = HIST + r32 * 256;
    for (int e = F.tid; e < 8192; e += NWAVES * 64) HIST[e] = 0u;
    if (F.tid == 0) SM[160] = 0;
    __syncthreads();
    DSA_TILE_LOOP({ _Pragma("unroll")
        for (int r = 0; r < 16; ++r) { const int kh = key16_(sc[r]) >> 8; if (!diag || (r & 3) + 8 * (r >> 2) <= qlim) __hip_atomic_fetch_add(hrow + kh, 1u, __ATOMIC_RELAXED, __HIP_MEMORY_SCOPE_WORKGROUP); } });
    __syncthreads();
#pragma unroll 1
    for (int q = F.wave * 4; q < F.wave * 4 + 4; ++q) { int bin, above, inbin; hist_scan(HIST + q * 256, 256, F.lane, bin, above, inbin); if (F.lane == 0) { SM[q] = bin; SM[32 + q] = above; } }
    __syncthreads();
    for (int e = F.tid; e < 8192; e += NWAVES * 64) HIST[e] = 0u;
    __syncthreads();
    const int myb1 = SM[r32];
    DSA_TILE_LOOP({ _Pragma("unroll")
        for (int r = 0; r < 16; ++r) { const int k = key16_(sc[r]); if ((k >> 8) == myb1 && (!diag || (r & 3) + 8 * (r >> 2) <= qlim)) __hip_atomic_fetch_add(hrow + (k & 255), 1u, __ATOMIC_RELAXED, __HIP_MEMORY_SCOPE_WORKGROUP); } });
    __syncthreads();
#pragma unroll 1
    for (int q = F.wave * 4; q < F.wave * 4 + 4; ++q) { int bin, above, inbin; const int ab1 = SM[32 + q]; hist_scan(HIST + q * 256, 256 - ab1, F.lane, bin, above, inbin);
        if (F.lane == 0) { const int total = t0 + q + 1;
            if (total <= 256) { SM[64 + q] = -1; SM[96 + q] = 0; SM[128 + q] = 0; }
            else { const int quota = 256 - (ab1 + above); SM[64 + q] = (SM[q] << 8) | bin; SM[96 + q] = quota; SM[128 + q] = inbin; if (quota < inbin) SM[160] = 1; } } }
    __syncthreads();
    const int thr = SM[64 + r32]; const bool allacc = SM[96 + r32] >= SM[128 + r32];
    const float lge = key_lbound(thr), lgt = key_lbound(thr + 1);
    DSA_TILE_LOOP({ unsigned gtw = 0u, gew = 0u; _Pragma("unroll")
        for (int r = 0; r < 16; ++r) { const int bit = (r & 3) + 8 * (r >> 2); const bool valid = !diag || bit <= qlim;
            if (valid && sc[r] >= lgt) gtw |= 1u << bit; if (valid && sc[r] >= lge) gew |= 1u << bit; }
        gtw <<= 4 * hi; gew <<= 4 * hi;
        gtw |= (unsigned)__shfl_xor((int)gtw, 32); gew |= (unsigned)__shfl_xor((int)gew, 32);
        unsigned eqw = gew & ~gtw;
        if (allacc) { gtw = gew; eqw = 0u; }
        if (hi == 0) GT[i * 32 + r32] = gtw; else EQ[i * 32 + r32] = eqw; });
    __syncthreads();
    if (SM[160] != 0 && F.tid < 32) { const int q = F.tid; const int quota = SM[96 + q]; if (quota < SM[128 + q]) { int run = 0;
            for (int i = 0; i <= j; ++i) { unsigned e = EQ[i * 32 + q]; if (e) { const int allowed = quota - run; if (allowed <= 0) e = 0u; else { int pc = __popc(e); while (pc > allowed) { e &= ~(0x80000000u >> __clz(e)); --pc; } }
                    run += __popc(e); GT[i * 32 + q] |= e; } } } }
    __syncthreads();
    { const int ntile64 = 4 * (j / 8 + 1); unsigned long long* dst = selw + (size_t)b * 64 * SEQ + t0;
      for (int e = F.tid; e < ntile64 * 32; e += NWAVES * 64) { const int T = e >> 5, q = e & 31; const unsigned lo = (2 * T <= j) ? GT[(2 * T) * 32 + q] : 0u, up = (2 * T + 1 <= j) ? GT[(2 * T + 1) * 32 + q] : 0u;
          dst[(size_t)T * SEQ + q] = ((unsigned long long)up << 32) | lo; } }
    __syncthreads();
}
#undef DSA_TILE_LOOP
__device__ __forceinline__ void ln1_router_phase(const Frame& F, const Args& a, int l, bool dry = false) {
    LAS float* RW = (LAS float*)(F.lds + RING_OFF);
    LAS int* LC = (LAS int*)(F.lds + RING_OFF + 81920);
    LAS int* LTOK = LC + 64;
    LAS int* LCLS = LTOK + 128; LAS int* LPOS = LCLS + 128; LAS float* LGA = (LAS float*)(LPOS + 128); LAS float* LGB = LGA + 128;
    const float* rg = a.in[16] + (size_t)l * DM * 4; const float* re = a.in[18] + (size_t)l * DM * 16;
    for (int e = F.tid; e < DM * 4; e += NWAVES * 64) { const int k = e >> 2, c = e & 3, ln = (k & 255) >> 2, kidx = (k >> 8) * 4 + (k & 3); RW[((kidx * 5 + 0) * 64 + ln) * 4 + c] = rg[e]; }
    for (int e = F.tid; e < DM * 16; e += NWAVES * 64) { const int k = e >> 4, c = 4 + (e & 15), ln = (k & 255) >> 2, kidx = (k >> 8) * 4 + (k & 3); RW[((kidx * 5 + (c >> 2)) * 64 + ln) * 4 + (c & 3)] = re[e]; }
    if (F.tid < 64) LC[F.tid] = 0;
    __syncthreads();
    const float* rgb = a.in[17] + l * 4; const float* reb = a.in[19] + l * 16;
    const float* g1 = a.in[14] + (size_t)l * DM; const float* b1 = a.in[15] + (size_t)l * DM;
    int* list = (int*)(F.ws + WS_LIST); float* gwl = (float*)(F.ws + WS_GWL);
    const int rows_per_blk = NTOK / F.G;
    f32x4 nx[4]; ln_load(F, F.out + (size_t)(F.vcu * rows_per_blk + F.wave) * DM, nx);
    for (int rr = F.wave; rr < rows_per_blk; rr += NWAVES) { const int m = F.vcu * rows_per_blk + rr; f32x4 v[4];
#pragma unroll
        for (int j = 0; j < 4; ++j) v[j] = nx[j];
        if (rr + NWAVES < rows_per_blk) ln_load(F, F.out + (size_t)(m + NWAVES) * DM, nx);
        ln_row(F, g1, b1, F.out + (size_t)m * DM, wsb(F, WS_HB) + (size_t)m * DM, v, dry);
        float lg[20];
#pragma unroll
        for (int c = 0; c < 20; ++c) lg[c] = 0.f;
#pragma unroll
        for (int jj = 0; jj < 4; ++jj)
#pragma unroll
            for (int k = 0; k < 4; ++k) { const LAS float* wr = RW + (((jj * 4 + k) * 5) * 64 + F.lane) * 4; const float xv = v[jj][k];
#pragma unroll
                for (int c4 = 0; c4 < 5; ++c4) { const f32x4 wv = *(const LAS f32x4*)(wr + c4 * 256); lg[4 * c4] += xv * wv.x; lg[4 * c4 + 1] += xv * wv.y; lg[4 * c4 + 2] += xv * wv.z; lg[4 * c4 + 3] += xv * wv.w; } }
#pragma unroll
        for (int c = 0; c < 20; ++c) lg[c] = wave_sum(lg[c]);
        float gl[4]; int gi = 0; float gm;
#pragma unroll
        for (int c = 0; c < 4; ++c) gl[c] = lg[c] + rgb[c];
        gm = gl[0];
#pragma unroll
        for (int c = 1; c < 4; ++c) if (gl[c] > gm) { gm = gl[c]; gi = c; }
        float gs = 0.f;
#pragma unroll
        for (int c = 0; c < 4; ++c) gs += expf(gl[c] - gm);
        const float pg = 1.f / gs;
        float el[4];
#pragma unroll
        for (int c = 0; c < 4; ++c) { float x = 0.f;
#pragma unroll
            for (int g = 0; g < 4; ++g) if (gi == g) x = lg[4 + 4 * g + c] + reb[4 * g + c];
            el[c] = x; }
        int i1 = 0; float m1 = el[0];
#pragma unroll
        for (int c = 1; c < 4; ++c) if (el[c] > m1) { m1 = el[c]; i1 = c; }
        int i2 = -1; float m2 = -INFINITY;
#pragma unroll
        for (int c = 0; c < 4; ++c) if (c != i1 && el[c] > m2) { m2 = el[c]; i2 = c; }
        const float e2 = expf(m2 - m1); const float p1 = 1.f / (1.f + e2), p2 = e2 / (1.f + e2);
        const int ia = i1 < i2 ? i1 : i2, ib = i1 < i2 ? i2 : i1; const float ga = pg * (i1 < i2 ? p1 : p2), gb = pg * (i1 < i2 ? p2 : p1);
        const int pidx = ia == 0 ? ib - 1 : (ia == 1 ? ib + 1 : 5); const int cls = gi * 6 + pidx;
        if (F.lane == 0) { const int pos = __hip_atomic_fetch_add(&LC[cls], 1, __ATOMIC_RELAXED, __HIP_MEMORY_SCOPE_WORKGROUP); LTOK[rr] = m; LCLS[rr] = cls; LPOS[rr] = pos; LGA[rr] = ga; LGB[rr] = gb; }
    }
    __syncthreads();
    if (dry) return;
    if (F.tid < NCLS) { const int n = LC[F.tid]; LC[32 + F.tid] = n ? (int)atomicAdd((unsigned*)(F.ctl + CW_CNT + (l * NCLS + F.tid) * 64), (unsigned)n) : 0; }
    __syncthreads();
    for (int rr = F.tid; rr < rows_per_blk; rr += NWAVES * 64) { const int cls = LCLS[rr], pos = LC[32 + cls] + LPOS[rr];
        list[(size_t)cls * NTOK + pos] = LTOK[rr]; gwl[((size_t)cls * NTOK + pos) * 2] = LGA[rr]; gwl[((size_t)cls * NTOK + pos) * 2 + 1] = LGB[rr]; }
    __syncthreads();
}
__device__ __forceinline__ void ln2_phase(const Frame& F, const Args& a, int l, bool dry = false) {
    const float* g2 = a.in[23] + (size_t)l * DM; const float* b2 = a.in[24] + (size_t)l * DM;
    const int gw = F.vcu * NWAVES + F.wave, NGW = F.G * NWAVES;
    f32x4 nx[4]; ln_load(F, F.out + (size_t)gw * DM, nx);
    for (int m = gw; m < NTOK; m += NGW) { f32x4 v[4];
#pragma unroll
        for (int j = 0; j < 4; ++j) v[j] = nx[j];
        if (m + NGW < NTOK) ln_load(F, F.out + (size_t)(m + NGW) * DM, nx);
        ln_row(F, g2, b2, F.out + (size_t)m * DM, wsb(F, WS_HB) + (size_t)m * DM, v, dry); }
}
__device__ __forceinline__ void moe_table(const Frame& F, int l, LAS int* tab) {
    const int tid = opaque_i(F.tid);
    if (tid < NCLS) tab[tid] = (int)__hip_atomic_load(F.ctl + CW_CNT + (l * NCLS + tid) * 64, RLX_AGENT);
    __syncthreads();
    if (tid == 0) { int s = 0; for (int c = 0; c < NCLS; ++c) { tab[32 + c] = s; s += (tab[c] + 255) >> 8; } tab[32 + NCLS] = s; tab[57] = s; }
    __syncthreads();
}
#ifndef REP_PHASE
#define REP_PHASE 0
#endif
#define NREP(k) ((REP_PHASE) == (k) ? 2 : 1)
#define DRY(k) ((REP_PHASE) == (k) && rep_ == 0 && args.ph_hi != 7777)
#ifndef MK_PER_PHASE
#define MK_PER_PHASE 0
#endif
constexpr int PH_PER_LAYER = 9, N_PHASES = 1 + DEPTH * PH_PER_LAYER;
__global__ void __launch_bounds__(NWAVES * 64, 2) fwd_kernel(Args args) {
    extern __shared__ __attribute__((aligned(16))) unsigned char lds[];
    Frame F0; Frame& F = F0;
    F.lds = (LAS unsigned char*)lds; F.ldsg = lds;
    F.MISC = (volatile LAS unsigned*)(F.lds + MISC_OFF);
    F.tid = threadIdx.x; F.lane = F.tid & 63; F.wave = __builtin_amdgcn_readfirstlane(F.tid >> 6);
    F.G = gridDim.x; { const int bx = blockIdx.x; F.vcu = (F.G % 8 == 0) ? (bx % 8) * (F.G / 8) + bx / 8 : bx; }
    F.ws = args.ws; F.out = args.out; F.ctl = (gu32*)(args.ws + WS_CTL);
    for (int u = F.tid; u < (LDS_BYTES - LDSCTL_OFF) / 4; u += NWAVES * 64) ((LAS unsigned*)(F.lds + LDSCTL_OFF))[u] = 0u;
    __syncthreads();
    XcdBarrier bar; bar.bar = (unsigned*)(F.ctl + CW_BAR); bar.x = 0; bar.st = nullptr;
    if (!MK_PER_PHASE) bar = xcd_barrier_post((unsigned*)(F.ctl + CW_BAR), F.MISC + 8);
    const int lo = MK_PER_PHASE ? args.ph_lo : 0, hi = MK_PER_PHASE ? args.ph_hi : N_PHASES;
#define IN(k) (lo <= (k) && (k) < hi)
#ifndef PH_ONLY
#define PH_ONLY -1
#endif
#define EN(k) (PH_ONLY < 0 || PH_ONLY == (k))
#define SEAM(k) do { if (IN(k) && IN((k) + 1)) xcd_barrier(bar); } while (0)
    LAS int* TAB = (LAS int*)(F.lds + LDSCTL_OFF + 64);
    bf16* const HB = wsb(F, WS_HB); bf16* const P = wsb(F, WS_R1); bf16* const MIX = wsb(F, WS_R1); bf16* const BR = wsb(F, WS_R2); bf16* const ACT = wsb(F, WS_R2);
    float* const FW = (float*)(F.ws + WS_FW); float* const BIAS2 = (float*)(F.ws + WS_BIAS2); unsigned long long* const SELW = (unsigned long long*)(F.ws + WS_SELW);

#define FRESH(Fn) Frame Fn = F0; Fn.tid = opaque_i(F0.tid); Fn.lane = Fn.tid & 63; Fn.wave = __builtin_amdgcn_readfirstlane(Fn.tid >> 6)
    for (int rep_ = 0; rep_ < ((REP_PHASE) == 10 ? 2 : 1); ++rep_) if (EN(0) && IN(0)) { FRESH(Fp); p0_prologue(Fp, args); }
    SEAM(0);
#pragma unroll 1
    for (int l0 = 0; l0 < DEPTH; ++l0) {
        const int pb = 1 + PH_PER_LAYER * l0;
#define l opaque_s(l0)
#define W (wsb(F, WS_W + (size_t)l * W_LAYER))
        for (int rep_ = 0; rep_ < NREP(1); ++rep_) if (EN(1) && IN(pb)) { SchedA S; S.T.init(NTOK / 256, PS / 256, F.G, (int)blockIdx.x); S.A = (const char*)HB; S.B = (const char*)(W + W_SM / 2);
            EpiA E{P, FW}; pg8::gemm_phase<EpiA, SchedA, false>(F.lds + RING_OFF, (LAS unsigned*)(F.lds + LDSCTL_OFF + 1024), S, E); }
        SEAM(pb);
        for (int rep_ = 0; rep_ < NREP(2); ++rep_) if (EN(2) && IN(pb + 1)) { FRESH(Fp);
#ifndef NO_CUMSUM
            if (F.vcu < 32 && Fp.wave == 0) fox_cumsum(Fp, F.vcu, FW, args.in[4] + l * 4, BIAS2);
#endif
#ifndef NO_POOL
            for (int rp_ = 0; rp_ < ((REP_PHASE) == 21 ? 2 : 1); ++rp_) for (int k = 0; k < 2; ++k) pool_unit(Fp, F.vcu * 2 + k, P, args.in[6] + (size_t)l * 4 * 64 * 64, args.in[7] + (size_t)l * 256, BR);
#endif
#ifndef NO_CONV
            for (int rp_ = 0; rp_ < ((REP_PHASE) == 22 ? 2 : 1); ++rp_) for (int k = 0; k < 4; ++k) conv_unit(Fp, F.vcu * 4 + k, P, args.in[8] + (size_t)l * 31 * 256, args.in[9] + (size_t)l * 256, args.in[10] + (size_t)l * 256, args.in[11] + (size_t)l * 256, BR);
#endif
#ifndef NO_DSA
            { const int b = F.vcu >> 5, s = F.vcu & 31;
#pragma unroll 1
              for (int k = 0; k < ((REP_PHASE) == 23 ? 8 : 4); ++k) { const int j = (k & 3) == 0 ? 127 - s : ((k & 3) == 1 ? 64 + s : ((k & 3) == 2 ? 63 - s : s)); dsa_mask_unit(Fp, b, j, P, FW, SELW); } }
#endif
        }
        SEAM(pb + 1);
        for (int rep_ = 0; rep_ < NREP(3); ++rep_) if (EN(3) && IN(pb + 2)) { const int sg = F.vcu >> 3, s = F.vcu & 7, b = sg >> 2, h = sg & 3; const size_t rb = (size_t)b * SEQ;
            const attn_body::bf16* Pb = (const attn_body::bf16*)P + rb * PS; attn_body::bf16* Ob = (attn_body::bf16*)BR + rb * DM;
#pragma unroll 1
            for (int k = 0; k < ((REP_PHASE) == 31 ? 4 : 2); ++k) { const int qb = (k & 1) == 0 ? 15 - s : s;
                attn_body::attn_unit<8, false>(qb * 256, Pb + C_FQ + h * 64, Pb + C_FK + h * 64, Pb + C_FV + h * 64, Ob + 256 + h * 64, BIAS2 + (size_t)(b * 4 + h) * SEQ, 0.f, nullptr, (char*)lds + RING_OFF); }
            const float slope2 = exp2f(-2.f * (float)(h + 1)) * LOG2E;
#pragma unroll 1
            for (int k = 0; k < ((REP_PHASE) == 32 ? 4 : 2); ++k) { const int qb = (k & 1) == 0 ? 15 - s : s;
                attn_body::attn_unit<8, true>(qb * 256, Pb + C_DQ + h * 64, Pb + C_DK, Pb + C_DV, Ob + 512 + h * 64, nullptr, slope2, SELW + (size_t)b * 64 * SEQ, (char*)lds + RING_OFF); }
        }
        SEAM(pb + 2);
        for (int rep_ = 0; rep_ < NREP(4); ++rep_) if (EN(4) && IN(pb + 3)) { SchedC S; S.T.init(NTOK / 256, DM / 256, F.G, (int)blockIdx.x); S.HBp = (const char*)HB; S.BRp = (const char*)BR; S.WGp = (const char*)(W + W_GT / 2); S.WBp = (const char*)(W + W_BR / 2);
            EpiC E{(v4u*)(F.ws + WS_STASH + (size_t)blockIdx.x * 131072), MIX, args.in[5] + (size_t)l * 4 * DM}; pg8::gemm_phase<EpiC, SchedC, false>(F.lds + RING_OFF, (LAS unsigned*)(F.lds + LDSCTL_OFF + 1024), S, E); }
        SEAM(pb + 3);
        for (int rep_ = 0; rep_ < NREP(5); ++rep_) if (EN(5) && IN(pb + 4)) { SchedC2 S; S.T.init(NTOK / 256, DM / 256, F.G, (int)blockIdx.x); S.A = (const char*)MIX; S.B = (const char*)(W + W_OUT / 2);
            EpiRes E{F.out, DRY(5)}; pg8::gemm_phase<EpiRes, SchedC2, false>(F.lds + RING_OFF, (LAS unsigned*)(F.lds + LDSCTL_OFF + 1024), S, E); }
        SEAM(pb + 4);
        for (int rep_ = 0; rep_ < NREP(6); ++rep_) if (EN(6) && IN(pb + 5)) { FRESH(Fp); ln1_router_phase(Fp, args, l, DRY(6)); }
        SEAM(pb + 5);
        for (int rep_ = 0; rep_ < NREP(7); ++rep_) if (EN(7) && IN(pb + 6)) { moe_table(F, l, TAB);
            SchedD1 S{TAB, F.G, (int)blockIdx.x, (const char*)HB, (const char*)(W + W_GU / 2), (const int*)(F.ws + WS_LIST)};
            EpiD1 E{ACT, (const float*)(F.ws + WS_GWL)}; pg8::gemm_phase<EpiD1, SchedD1, true>(F.lds + RING_OFF, (LAS unsigned*)(F.lds + LDSCTL_OFF + 1024), S, E); }
        SEAM(pb + 6);
        for (int rep_ = 0; rep_ < NREP(8); ++rep_) if (EN(8) && IN(pb + 7)) { moe_table(F, l, TAB);
            SchedD2 S{TAB, F.G, (int)blockIdx.x, (const char*)ACT, (const char*)(W + W_D / 2), (const int*)(F.ws + WS_LIST)};
            EpiD2 E{F.out, DRY(8)}; pg8::gemm_phase<EpiD2, SchedD2, false>(F.lds + RING_OFF, (LAS unsigned*)(F.lds + LDSCTL_OFF + 1024), S, E); }
        SEAM(pb + 7);
        for (int rep_ = 0; rep_ < NREP(9); ++rep_) if (EN(9) && IN(pb + 8)) { FRESH(Fp); ln2_phase(Fp, args, l, DRY(9)); }
        SEAM(pb + 8);
#undef l
#undef W
    }
#undef IN
#undef SEAM
}

extern "C" void kernel_launch(void* const* d_in, const int* in_sizes, int n_in, void* d_out, int out_size, void* d_ws, size_t ws_size, hipStream_t stream) {
    static int grid = 0;
    if (grid == 0) {
        if (n_in != 25 || in_sizes[0] != NTOK * DM || out_size != NTOK * DM || ws_size < WS_END) { fprintf(stderr, "kernel_launch: unexpected shapes (n_in %d, in0 %d, out %d, ws %zu); nothing launched\n", n_in, n_in > 0 ? in_sizes[0] : -1, out_size, ws_size); grid = -1; return; }
        int dev = 0, cus = 0, per_cu = 0;
        if (hipGetDevice(&dev) != hipSuccess || hipDeviceGetAttribute(&cus, hipDeviceAttributeMultiprocessorCount, dev) != hipSuccess) { grid = -1; return; }
        if (hipFuncSetAttribute((const void*)fwd_kernel, hipFuncAttributeMaxDynamicSharedMemorySize, LDS_BYTES) != hipSuccess) { fprintf(stderr, "kernel_launch: hipFuncSetAttribute failed\n"); grid = -1; return; }
        if (hipOccupancyMaxActiveBlocksPerMultiprocessor(&per_cu, (const void*)fwd_kernel, NWAVES * 64, LDS_BYTES) != hipSuccess || per_cu < 1) fprintf(stderr, "kernel_launch: occupancy query reports %d\n", per_cu);
        (void)hipGetLastError();
        grid = cus;
        if (grid != 256) { fprintf(stderr, "kernel_launch: built for 256 CUs, device has %d; nothing launched\n", cus); grid = -1; return; }
    }
    if (grid < 0) return;
    if (hipMemsetAsync((char*)d_ws + WS_CTL, 0, CTL_ZERO_BYTES, stream) != hipSuccess) return;
    Args a{};
    for (int i = 0; i < 25; ++i) a.in[i] = (const float*)d_in[i];
    a.out = (float*)d_out; a.ws = (unsigned char*)d_ws;
#if MK_PER_PHASE
    for (int p = 0; p < N_PHASES; ++p) { a.ph_lo = p; a.ph_hi = p + 1; hipLaunchKernelGGL(fwd_kernel, dim3(grid), dim3(NWAVES * 64), LDS_BYTES, stream, a); }
#else
    a.ph_lo = 0; a.ph_hi = N_PHASES;
    hipLaunchKernelGGL(fwd_kernel, dim3(grid), dim3(NWAVES * 64), LDS_BYTES, stream, a);
#endif
}
```

```cpp
#include <hip/hip_runtime.h>
#include <hip/hip_bf16.h>
#include <cstdio>
#include <cstdint>
#include <cmath>

#ifndef REP_PHASE
#define REP_PHASE 0
#endif
#define PROBE_BEGIN(id) do { if ((REP_PHASE) == 100 + (id) && blockIdx.x == 0) { __syncthreads(); if (F.wave == 0 && lane_id_() == 0) { const unsigned long long t_ = __builtin_amdgcn_s_memrealtime(); PRB[2] = (unsigned)t_; PRB[3] = (unsigned)(t_ >> 32); } } } while (0)
#define PROBE_END(id) do { if ((REP_PHASE) == 100 + (id) && blockIdx.x == 0) { __syncthreads(); if (F.wave == 0 && lane_id_() == 0) { const unsigned long long t_ = __builtin_amdgcn_s_memrealtime() - (((unsigned long long)PRB[3] << 32) | PRB[2]); const unsigned long long a_ = ((((unsigned long long)PRB[1]) << 32) | PRB[0]) + t_; PRB[0] = (unsigned)a_; PRB[1] = (unsigned)(a_ >> 32); } } } while (0)
constexpr int BATCH = 8, SEQ = 4096, DM = 1024, NTOK = BATCH * SEQ, DEPTH = 2;
constexpr int P_TOTAL = 6344, PS = 2304;
constexpr int C_POOL = 0, C_FQ = 256, C_FK = 512, C_FV = 768, C_DQ = 1024, C_IQ = 1280, C_CONV = 1536, C_DK = 2048, C_DV = 2112, C_IK = 2176, C_FF = 2240, C_IW = 2244;
constexpr float LN_EPS = 1e-5f;
constexpr float ALPHA = 1.4142135623730951f;
constexpr float LOG2E = 1.4426950408889634f;
constexpr int NWAVES = 8;
constexpr int NCLS = 24;
constexpr int MAXTILES = NTOK / 256 + NCLS;

constexpr size_t MiB = 1u << 20;
constexpr size_t WS_CTL = 0, CTL_ZERO_BYTES = 1 * MiB;
constexpr size_t WS_FW = 1 * MiB;
constexpr size_t WS_BIAS2 = 2 * MiB;
constexpr size_t WS_LIST = 3 * MiB;
constexpr size_t WS_GWL = 6 * MiB;
constexpr size_t WS_SELW = 12 * MiB;
constexpr size_t WS_STASH = 28 * MiB;
constexpr size_t WS_W = 60 * MiB;
constexpr size_t W_SM = 0, W_GT = 4718592, W_BR = W_GT + 8 * MiB, W_OUT = W_BR + 2 * MiB, W_GU = W_OUT + 2 * MiB, W_D = W_GU + 32 * MiB, W_LAYER = W_D + 16 * MiB;
constexpr size_t WS_HB = 190 * MiB;
constexpr size_t WS_R1 = 254 * MiB;
constexpr size_t WS_R2 = 398 * MiB;
constexpr size_t WS_KIDX = 474 * MiB;
constexpr size_t WS_END = 478 * MiB;
static_assert(WS_W + 2 * W_LAYER <= WS_HB && WS_R1 + (size_t)NTOK * PS * 2 <= WS_R2 && WS_R2 + (size_t)MAXTILES * 256 * DM * 2 <= WS_END, "d_ws map");
constexpr int CW_BAR = 4096;
constexpr int CW_SEAMC = 8192;
constexpr int CW_CNT = 16384;

constexpr int RING_OFF = 0, RING_BYTES = 131072;
constexpr int LDSCTL_OFF = RING_BYTES, MISC_OFF = LDSCTL_OFF + 320;
constexpr int LDS_BYTES = 147456;

#define GAS __attribute__((address_space(1)))
#define LAS __attribute__((address_space(3)))
typedef unsigned short bf16;
typedef unsigned v4u __attribute__((ext_vector_type(4)));
typedef unsigned v2u __attribute__((ext_vector_type(2)));
typedef float f32x4 __attribute__((ext_vector_type(4)));
typedef float f32x16 __attribute__((ext_vector_type(16)));
typedef short bf16x8 __attribute__((ext_vector_type(8)));
typedef GAS unsigned gu32;
#define RLX_AGENT __ATOMIC_RELAXED, __HIP_MEMORY_SCOPE_AGENT
#define LDS_WAIT() asm volatile("s_waitcnt lgkmcnt(0)" ::: "memory")
#define VM_WAIT() asm volatile("s_waitcnt vmcnt(0)" ::: "memory")
__device__ __forceinline__ int opaque_i(int x) { asm volatile("" : "+v"(x)); return x; }
__device__ __forceinline__ int lane_id_() { int x; asm volatile("v_mbcnt_lo_u32_b32 %0, -1, 0\n\tv_mbcnt_hi_u32_b32 %0, -1, %0" : "=v"(x)); return x; }
__device__ __forceinline__ int opaque_s(int x) { asm volatile("" : "+s"(x)); return x; }
__device__ __forceinline__ unsigned f2bf(float f) { unsigned u = __builtin_bit_cast(unsigned, f); return (u + 0x7fffu + ((u >> 16) & 1u)) >> 16; }
__device__ __forceinline__ unsigned pk2(float lo, float hi) { return f2bf(lo) | (f2bf(hi) << 16); }
__device__ __forceinline__ float bfl(unsigned w) { return __uint_as_float(w << 16); }
__device__ __forceinline__ float bfh(unsigned w) { return __uint_as_float(w & 0xffff0000u); }
__device__ __forceinline__ float bf1(bf16 h) { return __uint_as_float((unsigned)h << 16); }
__device__ __forceinline__ float sigmoidf_(float x) { return __builtin_amdgcn_rcpf(1.f + __builtin_amdgcn_exp2f(-x * LOG2E)); }

#define XB_TMO      128
#define XB_XCNT(j)  (256  + 64 * (j))
#define XB_XSUB(j)  (1280 + 64 * (j))
#define XB_XGEN(j)  (2304 + 64 * (j))
#define XB_TOP      3328
#define XB_TOPGEN   3392
#define XCD_BAR_WORDS 3456
#define XB_SPIN_CAP (1u << 18)
__device__ __forceinline__ unsigned xb_ld(unsigned* p)              { return __hip_atomic_load(p, __ATOMIC_RELAXED, __HIP_MEMORY_SCOPE_AGENT); }
__device__ __forceinline__ unsigned xb_add(unsigned* p, unsigned v) { return __hip_atomic_fetch_add(p, v, __ATOMIC_RELAXED, __HIP_MEMORY_SCOPE_AGENT); }
__device__ __forceinline__ unsigned xb_xcc_id() { return (unsigned)__builtin_amdgcn_s_getreg((3 << 11) | 20) & 0xFu; }
#define XB_SPIN(cond, bar) do { unsigned _sp = 0; while (cond) { __builtin_amdgcn_s_sleep(1); \
    if ((++_sp & 255u) == 0u) { if (xb_ld(&(bar)[XB_TMO])) break; if (_sp > XB_SPIN_CAP) { atomicAdd(&(bar)[XB_TMO], 1u); break; } } } } while (0)
struct XcdBarrier { unsigned* bar; unsigned x; volatile LAS unsigned* st; };
__device__ __forceinline__ XcdBarrier xcd_barrier_post(unsigned* bar, volatile LAS unsigned* st) {
    XcdBarrier b; b.bar = bar; b.x = xb_xcc_id(); b.st = st;
    if (threadIdx.x == 0) (void)xb_add(&bar[XB_XCNT(b.x)], 1u);
    return b;
}
__device__ __forceinline__ void xcd_barrier_complete(unsigned* bar, unsigned x, unsigned& nloc, unsigned& nx) {
    const unsigned G = gridDim.x * gridDim.y * gridDim.z;
    unsigned sum, cnt, mine, sp = 0u;
    for (;;) {
        sum = 0u; cnt = 0u; mine = 0u;
#pragma unroll
        for (unsigned j = 0; j < 16; ++j) { const unsigned c = xb_ld(&bar[XB_XCNT(j)]); sum += c; cnt += (c > 0u) ? 1u : 0u; mine = (j == x) ? c : mine; }
        if (sum == G) break;
        __builtin_amdgcn_s_sleep(1);
        if ((++sp & 255u) == 0u) { if (xb_ld(&bar[XB_TMO])) break; if (sp > XB_SPIN_CAP) { atomicAdd(&bar[XB_TMO], 1u); break; } }
    }
    nloc = mine > 0u ? mine : 1u; nx = cnt > 0u ? cnt : 1u;
}
__device__ __forceinline__ void xcd_barrier(const XcdBarrier& b, int wave) {
    asm volatile("s_waitcnt vmcnt(0)" ::: "memory");
    __syncthreads();
    if (wave == 0 && lane_id_() == 0) {
        unsigned* bar = b.bar; const unsigned bx = (unsigned)opaque_s((int)xb_xcc_id());
        __builtin_amdgcn_s_waitcnt(0);
        unsigned nloc = b.st[0], nx = b.st[1];
        if (nloc == 0u) { xcd_barrier_complete(bar, bx, nloc, nx); b.st[0] = nloc; b.st[1] = nx; }
        const unsigned old = xb_add(&bar[XB_XSUB(bx)], 1u);
        const unsigned gen = old / nloc;
        if (old + 1u == (gen + 1u) * nloc) {
            __builtin_amdgcn_fence(__ATOMIC_RELEASE, "agent");
            asm volatile("s_waitcnt vmcnt(0)" ::: "memory");
            const unsigned og = xb_add(&bar[XB_TOP], 1u);
            const unsigned tg = og / nx;
            if (og + 1u == (tg + 1u) * nx) xb_add(&bar[XB_TOPGEN], 1u);
            else XB_SPIN(xb_ld(&bar[XB_TOPGEN]) == tg, bar);
            __builtin_amdgcn_fence(__ATOMIC_ACQUIRE, "agent");
            xb_add(&bar[XB_XGEN(bx)], 1u);
            asm volatile("s_waitcnt vmcnt(0)" ::: "memory");
        } else {
            XB_SPIN(xb_ld(&bar[XB_XGEN(bx)]) == gen, bar);
            __builtin_amdgcn_fence(__ATOMIC_ACQUIRE, "agent");
            asm volatile("s_waitcnt vmcnt(0)" ::: "memory");
        }
    }
    __syncthreads();
}
namespace pg8 {
#define PG8_LAS __attribute__((address_space(3)))
typedef unsigned short bf16_t;
typedef short bf16x8 __attribute__((ext_vector_type(8)));
typedef float f32x4 __attribute__((ext_vector_type(4)));
typedef float f32x2 __attribute__((ext_vector_type(2)));
typedef unsigned u32x4 __attribute__((ext_vector_type(4)));
typedef unsigned u32x2 __attribute__((ext_vector_type(2)));
constexpr int BM = 256, BK = 64, HALF = 128, HTB = HALF * BK * 2  , STAGE_BYTES = 8 * HTB, NXCD = 8, WGM = 8;
constexpr int LD = 1024;
constexpr size_t ROWB = 2048;
constexpr size_t HSTEP = (size_t)HALF * ROWB;
constexpr size_t TSTEP = 2 * HSTEP;

__host__ __device__ __forceinline__ int lds_byte(int r, int c) { const int st = (r >> 4) * 2 + (c >> 5), rr = r & 15, cc = c & 31, ob = rr * 64 + cc * 2; return st * 1024 + (ob ^ (((ob >> 9) & 1) << 5)); }
__host__ __device__ __forceinline__ void stage_rc(int b, int& R, int& C) { const int st = b / 1024, sb = b % 1024, swz = sb ^ (((sb >> 9) & 1) << 5); R = (st >> 1) * 16 + swz / 64; C = (st & 1) * 32 + (swz % 64) / 2; }
__host__ __device__ __forceinline__ int perm32(int rho) { const int n = rho >> 4, i = rho & 15; return 8 * (i >> 2) + 4 * n + (i & 3); }

struct GU {
    const char* A;
    const char* B0;
    const char* B1;
    int nt, ks;
    const int* rows;
    int rbase, rcnt;
    int pm, pn, a0, a1;
};

__device__ __forceinline__ unsigned cvt_pk_bf16(float lo, float hi) { unsigned r; asm volatile("v_cvt_pk_bf16_f32 %0, %1, %2" : "=v"(r) : "v"(lo), "v"(hi)); return r; }
__device__ __forceinline__ float bf_lo(unsigned w) { return __uint_as_float(w << 16); }
__device__ __forceinline__ float bf_hi(unsigned w) { return __uint_as_float(w & 0xffff0000u); }

template <class Epi, class Sched, bool GATHER>
__device__ __forceinline__ void gemm_phase(PG8_LAS unsigned char* lds, PG8_LAS unsigned* xlds  , const int wid_in  , const Sched& S, Epi& E) {
    const int wid = opaque_s(wid_in), lane = lane_id_(), tid = wid * 64 + lane, wr = wid >> 2, wc = wid & 3, fr = lane & 15, fq = lane >> 4;
    unsigned voffB[2], vA[2][2];
#pragma unroll
    for (int i = 0; i < 2; ++i) { int R, C; stage_rc(tid * 16 + i * 8192, R, C); const int Rb = Epi::PERM ? ((R & ~31) + perm32(R & 31)) : R;
        voffB[i] = (unsigned)(Rb * LD + C) * 2u;
        vA[0][i] = (unsigned)(R * LD + C) * 2u; vA[1][i] = vA[0][i]; }
    const size_t kstep = (size_t)(BK * 2);
    const unsigned ldsw = (unsigned)wid * 1024u;
    const int aoff = lds_byte(wr * 64 + fr, fq * 8), boff = lds_byte(wc * 32 + fr, fq * 8);
#define PG8_SA(b, h) (((b) * 2 + (h)) * HTB)
#define PG8_SB(b, h) ((4 + (b) * 2 + (h)) * HTB)
#define PG8_STAGE(bufoff, gbase, voff) do { _Pragma("unroll") for (int _i = 0; _i < 2; ++_i) \
        __builtin_amdgcn_global_load_lds((const unsigned*)((const char*)(gbase) + (voff)[_i]), (PG8_LAS unsigned*)(lds + (bufoff) + ldsw + _i * 8192), 16, 0, 0); } while (0)
#define PG8_STAGEA(bufoff, gbase, h) do { if constexpr (GATHER) { PG8_STAGE(bufoff, gbase, vA[h]); } else { PG8_STAGE(bufoff, (gbase) + (h) * HSTEP, vA[0]); } } while (0)
#define PG8_LDA(dst, b, h) do { _Pragma("unroll") for (int m = 0; m < 4; ++m) _Pragma("unroll") for (int k = 0; k < 2; ++k) dst[m][k] = *(const PG8_LAS bf16x8*)(lds + PG8_SA(b, h) + aoff + m * 2048 + k * 1024); } while (0)
#define PG8_LDB(dst, b, h) do { _Pragma("unroll") for (int n = 0; n < 2; ++n) _Pragma("unroll") for (int k = 0; k < 2; ++k) dst[n][k] = *(const PG8_LAS bf16x8*)(lds + PG8_SB(b, h) + boff + n * 2048 + k * 1024); } while (0)
#define PG8_MMA(ai, bj, At, Bt) do { __builtin_amdgcn_s_setprio(1); _Pragma("unroll") for (int m = 0; m < 4; ++m) _Pragma("unroll") for (int n = 0; n < 2; ++n) _Pragma("unroll") for (int k = 0; k < 2; ++k) \
        acc[ai][bj][m][n] = __builtin_amdgcn_mfma_f32_16x16x32_bf16(Bt[n][k], At[m][k], acc[ai][bj][m][n], 0, 0, 0); __builtin_amdgcn_s_setprio(0); } while (0)
#define PG8_WAIT_V(n) asm volatile("s_waitcnt vmcnt(" #n ")" ::: "memory")
#define PG8_WAIT_L(n) asm volatile("s_waitcnt lgkmcnt(" #n ")" ::: "memory")
#define PG8_BAR __builtin_amdgcn_s_barrier()
#define PG8_SCHED __builtin_amdgcn_sched_barrier(0)
#define PG8_BP(u, tau) ((tau) < (u).ks ? (u).B0 + (size_t)(tau) * kstep : (u).B1 + (size_t)((tau) - (u).ks) * kstep)
#define PG8_GATHER_OFFS(dst, u) do { if constexpr (GATHER) { _Pragma("unroll") for (int _h = 0; _h < 2; ++_h) _Pragma("unroll") for (int _i = 0; _i < 2; ++_i) { \
        int _R, _C; stage_rc((wid * 64 + lane_id_()) * 16 + _i * 8192, _R, _C); int _p = (u).rbase + _h * HALF + _R; _p = _p < (u).rcnt ? _p : (u).rcnt - 1; dst[_h][_i] = (unsigned)(u).rows[_p] * (unsigned)ROWB + (unsigned)_C * 2u; } } } while (0)
    GU cur, nxt; int ui = 0;
    if (!S.next(0, cur)) return;
    f32x4 acc[2][2][4][2];
#pragma unroll
    for (int a = 0; a < 2; ++a)
#pragma unroll
        for (int b = 0; b < 2; ++b)
#pragma unroll
            for (int m = 0; m < 4; ++m)
#pragma unroll
                for (int n = 0; n < 2; ++n) acc[a][b][m][n] = (f32x4){0.f, 0.f, 0.f, 0.f};
    bf16x8 At[4][2], B0[2][2], B1[2][2];
    PG8_GATHER_OFFS(vA, cur);
    const char* cA = cur.A;
    { const char* b0 = PG8_BP(cur, 0); const char* b1 = PG8_BP(cur, 1);
      PG8_STAGE(PG8_SB(0, 0), b0, voffB); PG8_STAGE(PG8_SB(0, 1), b0 + HSTEP, voffB); PG8_STAGEA(PG8_SA(0, 0), cA, 0); PG8_STAGEA(PG8_SA(0, 1), cA, 1);
      if (wr == 1) PG8_BAR;
      PG8_WAIT_V(2); PG8_BAR;
      PG8_STAGE(PG8_SB(1, 0), b1, voffB); PG8_STAGEA(PG8_SA(1, 0), cA + kstep, 0); PG8_STAGE(PG8_SB(1, 1), b1 + HSTEP, voffB);
      PG8_WAIT_V(6); PG8_BAR; }
    for (;;) {
        const bool has_next = S.next(ui + 1, nxt);
        if (!has_next) nxt = cur;
        if constexpr (GATHER) { unsigned vn[2][2];
#pragma unroll
            for (int h = 0; h < 2; ++h)
#pragma unroll
                for (int i = 0; i < 2; ++i) vn[h][i] = vA[h][i];
            if (has_next) { PG8_GATHER_OFFS(vn, nxt); }
#pragma unroll
            for (int h = 0; h < 2; ++h)
#pragma unroll
                for (int i = 0; i < 2; ++i) xlds[(h * 2 + i) * 512 + tid] = vn[h][i]; }
        const char* nA = nxt.A;
        const int nt = cur.nt;
        for (int t = 0; t < nt; t += 2) {
            const bool last = (t == nt - 2);
            const char* a1 = cA + (size_t)(t + 1) * kstep;
            const char* a2 = last ? nA : cA + (size_t)(t + 2) * kstep;
            const char* b2 = last ? PG8_BP(nxt, 0) : PG8_BP(cur, t + 2);
            const char* a3 = a2 + kstep; const char* b3 = b2 + kstep;
            PG8_LDB(B0, 0, 0); PG8_LDB(B1, 0, 1); PG8_SCHED; PG8_LDA(At, 0, 0); PG8_STAGEA(PG8_SA(1, 1), a1, 1);
            if constexpr (GATHER) { if (last) {
#pragma unroll
                for (int h = 0; h < 2; ++h)
#pragma unroll
                    for (int i = 0; i < 2; ++i) vA[h][i] = xlds[(h * 2 + i) * 512 + tid]; } }
            PG8_WAIT_V(8); PG8_WAIT_L(0); PG8_BAR; PG8_MMA(0, 0, At, B0); PG8_MMA(0, 1, At, B1); PG8_BAR; PG8_SCHED;
            PG8_LDA(At, 0, 1); PG8_STAGE(PG8_SB(0, 0), b2, voffB); PG8_STAGE(PG8_SB(0, 1), b2 + HSTEP, voffB); PG8_STAGEA(PG8_SA(0, 0), a2, 0);
            PG8_WAIT_V(8); PG8_WAIT_L(0); PG8_BAR; PG8_MMA(1, 0, At, B0); PG8_MMA(1, 1, At, B1); PG8_BAR; PG8_SCHED;
            PG8_LDB(B0, 1, 0); PG8_LDB(B1, 1, 1); PG8_SCHED; PG8_LDA(At, 1, 0); PG8_STAGEA(PG8_SA(0, 1), a2, 1);
            PG8_WAIT_V(8); PG8_WAIT_L(0); PG8_BAR; PG8_MMA(0, 0, At, B0); PG8_MMA(0, 1, At, B1); PG8_BAR; PG8_SCHED;
            PG8_LDA(At, 1, 1); PG8_STAGE(PG8_SB(1, 0), b3, voffB); PG8_STAGE(PG8_SB(1, 1), b3 + HSTEP, voffB); PG8_STAGEA(PG8_SA(1, 0), a3, 0);
            PG8_WAIT_V(8); PG8_WAIT_L(0); PG8_BAR; PG8_MMA(1, 0, At, B0); PG8_MMA(1, 1, At, B1); PG8_BAR; PG8_SCHED;
        }
        if (wr == 0) PG8_BAR;
        E(acc, cur, wr, wc, fr, fq);
        if (!has_next) break;
#pragma unroll
        for (int a = 0; a < 2; ++a)
#pragma unroll
            for (int b = 0; b < 2; ++b)
#pragma unroll
                for (int m = 0; m < 4; ++m)
#pragma unroll
                    for (int n = 0; n < 2; ++n) acc[a][b][m][n] = (f32x4){0.f, 0.f, 0.f, 0.f};
        cur = nxt; cA = nA; ++ui;
        if (wr == 1) PG8_BAR;
    }
    PG8_WAIT_V(0);
    PG8_BAR;
#undef PG8_SA
#undef PG8_SB
#undef PG8_STAGE
#undef PG8_STAGEA
#undef PG8_LDA
#undef PG8_LDB
#undef PG8_MMA
#undef PG8_WAIT_V
#undef PG8_WAIT_L
#undef PG8_BAR
#undef PG8_SCHED
#undef PG8_BP
#undef PG8_GATHER_OFFS
}

template <class Epi, class Sched>
__device__ __forceinline__ void gemm_phase_n128(PG8_LAS unsigned char* lds, const int wid_in, const Sched& S, Epi& E) {
    const int wid = opaque_s(wid_in), lane = lane_id_(), tid = wid * 64 + lane, wr = wid >> 2, wc = wid & 3, fr = lane & 15, fq = lane >> 4;
    unsigned voffB[2], voffA[2];
#pragma unroll
    for (int i = 0; i < 2; ++i) { int R, C; stage_rc(tid * 16 + i * 8192, R, C); const int Rb = (R & ~31) + perm32(R & 31);
        voffB[i] = (unsigned)(Rb * LD + C) * 2u; voffA[i] = (unsigned)(R * LD + C) * 2u; }
    const size_t kstep = (size_t)(BK * 2);
    const unsigned ldsw = (unsigned)wid * 1024u;
    const int aoff = lds_byte(wr * 64 + fr, fq * 8), boff = lds_byte(wc * 32 + fr, fq * 8);
#define PG8_SA(b, h) (((b) * 2 + (h)) * HTB)
#define PG8_SB(b, h) ((4 + (b) * 2 + (h)) * HTB)
#define PG8_STAGE(bufoff, gbase, voff) do { _Pragma("unroll") for (int _i = 0; _i < 2; ++_i) \
        __builtin_amdgcn_global_load_lds((const unsigned*)((const char*)(gbase) + (voff)[_i]), (PG8_LAS unsigned*)(lds + (bufoff) + ldsw + _i * 8192), 16, 0, 0); } while (0)
#define PG8_LDA(dst, b, h) do { _Pragma("unroll") for (int m = 0; m < 4; ++m) _Pragma("unroll") for (int k = 0; k < 2; ++k) dst[m][k] = *(const PG8_LAS bf16x8*)(lds + PG8_SA(b, h) + aoff + m * 2048 + k * 1024); } while (0)
#define PG8_LDB(dst, b, h) do { _Pragma("unroll") for (int n = 0; n < 2; ++n) _Pragma("unroll") for (int k = 0; k < 2; ++k) dst[n][k] = *(const PG8_LAS bf16x8*)(lds + PG8_SB(b, h) + boff + n * 2048 + k * 1024); } while (0)
#define PG8_MMA(ai, At, Bt) do { __builtin_amdgcn_s_setprio(1); _Pragma("unroll") for (int m = 0; m < 4; ++m) _Pragma("unroll") for (int n = 0; n < 2; ++n) _Pragma("unroll") for (int k = 0; k < 2; ++k) \
        acc[ai][m][n] = __builtin_amdgcn_mfma_f32_16x16x32_bf16(Bt[n][k], At[m][k], acc[ai][m][n], 0, 0, 0); __builtin_amdgcn_s_setprio(0); } while (0)
#define PG8_WAIT_V(n) asm volatile("s_waitcnt vmcnt(" #n ")" ::: "memory")
#define PG8_WAIT_L(n) asm volatile("s_waitcnt lgkmcnt(" #n ")" ::: "memory")
#define PG8_BAR __builtin_amdgcn_s_barrier()
#define PG8_SCHED __builtin_amdgcn_sched_barrier(0)
    GU cur, nxt; int ui = 0;
    if (!S.next(0, cur)) return;
    f32x4 acc[2][4][2];
#pragma unroll
    for (int a = 0; a < 2; ++a)
#pragma unroll
        for (int m = 0; m < 4; ++m)
#pragma unroll
            for (int n = 0; n < 2; ++n) acc[a][m][n] = (f32x4){0.f, 0.f, 0.f, 0.f};
    bf16x8 At[4][2], B0[2][2];
    u32x4 st_u[2][4], st_s[2][4];
    const char* cA = cur.A; const char* cB = cur.B0;
    PG8_STAGE(PG8_SB(0, 0), cB, voffB); PG8_STAGE(PG8_SA(0, 0), cA, voffA); PG8_STAGE(PG8_SA(0, 1), cA + HSTEP, voffA);
    if (wr == 1) PG8_BAR;
    PG8_WAIT_V(2); PG8_BAR;
    PG8_STAGE(PG8_SB(1, 0), cB + kstep, voffB); PG8_STAGE(PG8_SA(1, 0), cA + kstep, voffA);
    PG8_WAIT_V(4); PG8_BAR;
    for (;;) {
        const bool has_next = S.next(ui + 1, nxt);
        if (!has_next) nxt = cur;
        const char* nA = nxt.A; const char* nB = nxt.B0;
        const int nt = cur.nt;
        for (int t = 0; t < nt; t += 2) {
            const bool last = (t == nt - 2);
            const char* a1 = cA + (size_t)(t + 1) * kstep;
            const char* a2 = last ? nA : cA + (size_t)(t + 2) * kstep;
            const char* b2 = last ? nB : cB + (size_t)(t + 2) * kstep;
            const char* a3 = a2 + kstep; const char* b3 = b2 + kstep;
            PG8_LDB(B0, 0, 0); PG8_SCHED; PG8_LDA(At, 0, 0); PG8_STAGE(PG8_SA(1, 1), a1 + HSTEP, voffA);
            PG8_WAIT_V(6); PG8_WAIT_L(0); PG8_BAR; PG8_MMA(0, At, B0); PG8_BAR; PG8_SCHED;
            PG8_LDA(At, 0, 1); PG8_STAGE(PG8_SB(0, 0), b2, voffB); PG8_STAGE(PG8_SA(0, 0), a2, voffA);
            PG8_WAIT_V(6); PG8_WAIT_L(0); PG8_BAR; PG8_MMA(1, At, B0); PG8_BAR; PG8_SCHED;
            PG8_LDB(B0, 1, 0); PG8_SCHED; PG8_LDA(At, 1, 0); PG8_STAGE(PG8_SA(0, 1), a2 + HSTEP, voffA);
            PG8_WAIT_V(6); PG8_WAIT_L(0); PG8_BAR; PG8_MMA(0, At, B0); PG8_BAR; PG8_SCHED;
            PG8_LDA(At, 1, 1); PG8_STAGE(PG8_SB(1, 0), b3, voffB); PG8_STAGE(PG8_SA(1, 0), a3, voffA);
            PG8_WAIT_V(6); PG8_WAIT_L(0); PG8_BAR; PG8_MMA(1, At, B0); PG8_BAR; PG8_SCHED;
        }
        if (wr == 0) PG8_BAR;
        E(acc, st_u, st_s, cur, wr, wc, fr, fq);
        if (!has_next) break;
#pragma unroll
        for (int a = 0; a < 2; ++a)
#pragma unroll
            for (int m = 0; m < 4; ++m)
#pragma unroll
                for (int n = 0; n < 2; ++n) acc[a][m][n] = (f32x4){0.f, 0.f, 0.f, 0.f};
        cur = nxt; cA = nA; cB = nB; ++ui;
        if (wr == 1) PG8_BAR;
    }
    PG8_WAIT_V(0);
    PG8_BAR;
#undef PG8_SA
#undef PG8_SB
#undef PG8_STAGE
#undef PG8_LDA
#undef PG8_LDB
#undef PG8_MMA
#undef PG8_WAIT_V
#undef PG8_WAIT_L
#undef PG8_BAR
#undef PG8_SCHED
}
}
namespace attn_body {
using bf16=__hip_bfloat16;
using bf16x8=__attribute__((ext_vector_type(8)))short;
using s16x4=__attribute__((ext_vector_type(4)))short;
using f32x16=__attribute__((ext_vector_type(16)))float;
using f32x4=__attribute__((ext_vector_type(4)))float;
using u32x4=__attribute__((ext_vector_type(4)))unsigned;
constexpr int SEQ=4096,D=64;
constexpr int KVP=2304;
constexpr int OP=1024;
constexpr int NW=8,QBLK=32,QB=QBLK*NW,KVBLK=64,NQB=SEQ/QB;
__device__ __forceinline__ int crow(int r,int hi){return (r&3)+8*(r>>2)+4*hi;}
#define SBAR() __builtin_amdgcn_sched_barrier(0)
__device__ __forceinline__ void cmask(f32x16&p0,f32x16&p1,int jb,int qrel,int hi){
  const float NEG=-INFINITY; int kb=64*jb+4*hi;
  #pragma unroll
  for(int r=0;r<16;++r){int kv=kb+(r&3)+8*(r>>2); if(kv>qrel)p0[r]=NEG; if(kv+32>qrel)p1[r]=NEG;}
}
__device__ __forceinline__ void bmask(f32x16&p0,f32x16&p1,unsigned long long w,int hi){
  const float NEG=-INFINITY; const unsigned lo=((unsigned)w)>>(4*hi), up=((unsigned)(w>>32))>>(4*hi);
  #pragma unroll
  for(int r=0;r<16;++r){const int bit=(r&3)+8*(r>>2); if(!((lo>>bit)&1u))p0[r]=NEG; if(!((up>>bit)&1u))p1[r]=NEG;}
}
constexpr int NSLOT=3, SLOTB=8192;
constexpr int LDS_K=0, LDS_V=NSLOT*SLOTB, LDS_WS=2*NSLOT*SLOTB, LDS_OST=LDS_WS+NW*64*4, LDS_BIAS=LDS_OST+NW*4096, LDS_BYTES=LDS_BIAS+SEQ*4;
constexpr float C2=0.125f*1.4426950408889634f;
__device__ __forceinline__ void glds16(const void*gsrc,unsigned lds_dst){unsigned keep;
  asm volatile("s_mov_b32 %0, m0\n\ts_mov_b32 m0, %2\n\ts_nop 0\n\tglobal_load_lds_dwordx4 %1, off\n\ts_mov_b32 m0, %0":"=&s"(keep):"v"(gsrc),"s"(lds_dst):"memory");}
__device__ __forceinline__ float max3f(float a,float b,float c){float r;asm("v_max3_f32 %0, %1, %2, %3":"=v"(r):"v"(a),"v"(b),"v"(c));return r;}
__device__ __forceinline__ float max2f(float a,float b){float r;asm("v_max_f32_e32 %0, %1, %2":"=v"(r):"v"(a),"v"(b));return r;}
__device__ __forceinline__ float fadd_s(float a,float b){float r;asm("v_add_f32_e32 %0, %1, %2":"=v"(r):"v"(a),"v"(b));return r;}
__device__ __forceinline__ float fsub_s(float a,float b){float r;asm("v_sub_f32_e32 %0, %1, %2":"=v"(r):"v"(a),"v"(b));return r;}
typedef float f32x2_t __attribute__((ext_vector_type(2))); typedef __bf16 bf16x2_t __attribute__((ext_vector_type(2)));
__device__ __forceinline__ unsigned cvtpk_s(float lo,float hi){f32x2_t v={lo,hi};bf16x2_t b=__builtin_convertvector(v,bf16x2_t);return __builtin_bit_cast(unsigned,b);}
#define WAIT_BAR(N) asm volatile("s_waitcnt vmcnt(" #N ") lgkmcnt(0)\n\ts_barrier":::"memory")

typedef __attribute__((address_space(3))) const char* lds_cptr;
typedef short v4i16_t __attribute__((ext_vector_type(4)));
__device__ __forceinline__ void binit(f32x16&p0,f32x16&p1,lds_cptr bp,float mhat){
  typedef float f2_ __attribute__((ext_vector_type(2))); const f2_ m2={mhat,mhat};
  #pragma unroll
  for(int g=0;g<4;++g){ const f32x4 a=*(const __attribute__((address_space(3))) f32x4*)(bp+g*32); const f32x4 b=*(const __attribute__((address_space(3))) f32x4*)(bp+128+g*32);
    const f2_ a0=(f2_){a[0],a[1]}-m2,a1=(f2_){a[2],a[3]}-m2,b0=(f2_){b[0],b[1]}-m2,b1=(f2_){b[2],b[3]}-m2;
    p0[4*g]=a0.x;p0[4*g+1]=a0.y;p0[4*g+2]=a1.x;p0[4*g+3]=a1.y; p1[4*g]=b0.x;p1[4*g+1]=b0.y;p1[4*g+2]=b1.x;p1[4*g+3]=b1.y; }
}
__device__ __forceinline__ void qkt(f32x16&p0,f32x16&p1,const char*Kslot,const bf16x8*qr,int r32,int hi){
  const char*kb=Kslot+hi*1024+r32*16;
  #pragma unroll
  for(int d0=0;d0<4;++d0){
    const bf16x8 b0=*reinterpret_cast<const bf16x8*>(kb+d0*2048);
    const bf16x8 b1=*reinterpret_cast<const bf16x8*>(kb+d0*2048+512);
    p0=__builtin_amdgcn_mfma_f32_32x32x16_bf16(b0,qr[d0],p0,0,0,0);p1=__builtin_amdgcn_mfma_f32_32x32x16_bf16(b1,qr[d0],p1,0,0,0);}
}
__device__ __forceinline__ void kload8(bf16x8*kf,lds_cptr kp){
  kf[0]=*(const __attribute__((address_space(3))) bf16x8*)(kp);      kf[1]=*(const __attribute__((address_space(3))) bf16x8*)(kp+512);
  kf[2]=*(const __attribute__((address_space(3))) bf16x8*)(kp+2048); kf[3]=*(const __attribute__((address_space(3))) bf16x8*)(kp+2560);
  kf[4]=*(const __attribute__((address_space(3))) bf16x8*)(kp+4096); kf[5]=*(const __attribute__((address_space(3))) bf16x8*)(kp+4608);
  kf[6]=*(const __attribute__((address_space(3))) bf16x8*)(kp+6144); kf[7]=*(const __attribute__((address_space(3))) bf16x8*)(kp+6656);
}
__device__ __forceinline__ void kload2(bf16x8*kf,lds_cptr kp,int j){ kf[2*j]=*(const __attribute__((address_space(3))) bf16x8*)(kp+j*2048); kf[2*j+1]=*(const __attribute__((address_space(3))) bf16x8*)(kp+j*2048+512); }
__device__ __forceinline__ s16x4 vtr(lds_cptr p){ return __builtin_bit_cast(s16x4,__builtin_amdgcn_ds_read_tr16_b64_v4i16((__attribute__((address_space(3))) v4i16_t*)p)); }
__device__ __forceinline__ float rowmax(const f32x16&p0,const f32x16&p1){
  float a=max3f(p0[0],p0[1],p1[0]),b=max3f(p0[2],p0[3],p1[1]);a=max3f(a,p1[2],p1[3]);
  #pragma unroll
  for(int r=4;r<16;r+=4){a=max3f(a,p0[r],p0[r+1]);b=max3f(b,p0[r+2],p0[r+3]);a=max3f(a,p1[r],p1[r+1]);b=max3f(b,p1[r+2],p1[r+3]);}
  const float m=max2f(a,b);
  auto rr=__builtin_amdgcn_permlane32_swap(__float_as_uint(m),__float_as_uint(m),false,false);
  return max2f(__uint_as_float(rr[0]),__uint_as_float(rr[1]));
}
__device__ __forceinline__ void pv(f32x16*o,int vb,bf16x8 pa0,bf16x8 pa1,bf16x8 pa2,bf16x8 pa3){
  #pragma unroll
  for(int d0=0;d0<2;++d0){s16x4 lo[4],hi[4];
    #pragma unroll
    for(int ks=0;ks<4;++ks){
      asm volatile("ds_read_b64_tr_b16 %0,%1 offset:%c2":"=&v"(lo[ks]):"v"(vb),"i"(d0*4096+ks*1024):"memory");
      asm volatile("ds_read_b64_tr_b16 %0,%1 offset:%c2":"=&v"(hi[ks]):"v"(vb),"i"(d0*4096+ks*1024+512):"memory");}
    asm volatile("s_waitcnt lgkmcnt(0)":::"memory");SBAR();
    #define PK(k) (bf16x8){lo[k][0],lo[k][1],lo[k][2],lo[k][3],hi[k][0],hi[k][1],hi[k][2],hi[k][3]}
    o[d0]=__builtin_amdgcn_mfma_f32_32x32x16_bf16(pa0,PK(0),o[d0],0,0,0);
    o[d0]=__builtin_amdgcn_mfma_f32_32x32x16_bf16(pa1,PK(1),o[d0],0,0,0);
    o[d0]=__builtin_amdgcn_mfma_f32_32x32x16_bf16(pa2,PK(2),o[d0],0,0,0);
    o[d0]=__builtin_amdgcn_mfma_f32_32x32x16_bf16(pa3,PK(3),o[d0],0,0,0);
    #undef PK
  }
}

template<int THRL,bool MASK> __device__ __forceinline__ void attn_unit(int q0,const bf16*Qs,const bf16*__restrict__ Ks,const bf16*__restrict__ Vs,bf16*Os,
                                                                       const float*biasg,float slope2,const unsigned long long*maskw,char*shm,const int wid_in){
  const int wid=opaque_s(wid_in),lane=lane_id_(),tid=wid*64+lane,r32=lane&31,hi=lane>>5;
  const bf16*Qw=Qs+(long)(q0+wid*QBLK)*KVP;
  const unsigned lds0=(unsigned)(uintptr_t)shm;
  float*wsf=(float*)(shm+LDS_WS)+wid*64;
  unsigned long long mwA=0ull,mwB=0ull;
  { float*bl=(float*)(shm+LDS_BIAS); const int nk=q0+QB;
    if(biasg){ for(int s=tid;s<nk;s+=NW*64)bl[s]=biasg[s]; } else { for(int s=tid;s<nk;s+=NW*64)bl[s]=slope2*(float)s; }
    if(MASK){ const unsigned long long*mp0=maskw+(q0+wid*QBLK+(lane&31)); mwA=mp0[0]; mwB=mp0[SEQ]; asm volatile("":"+v"(mwA),"+v"(mwB)); }
    asm volatile("s_waitcnt vmcnt(0) lgkmcnt(0)":::"memory"); }
  const bf16*ksrc=Ks+(long)lane*KVP+wid*8;
  const bf16*vsrc=Vs+(long)(16*(wid&3)+(lane>>2))*KVP+(wid>>2)*32+(lane&3)*8;
  const unsigned kdst=lds0+LDS_K+wid*1024, vdst=lds0+LDS_V+wid*1024;
  #define DMA_K(t,slot) glds16(ksrc+(long)(t)*KVBLK*KVP,(unsigned)__builtin_amdgcn_readfirstlane(kdst+(slot)))
  #define DMA_V(t,slot) glds16(vsrc+(long)(t)*KVBLK*KVP,(unsigned)__builtin_amdgcn_readfirstlane(vdst+(slot)))
  const int vb0=(int)(lds0+LDS_V)+((lane>>4)&1)*32+(lane&3)*8+(4*hi+((lane&15)>>2))*64;
  const char*Kbase=shm+LDS_K; bf16x8 kf[8];
  const lds_cptr shm3=(lds_cptr)shm; const lds_cptr kp0=shm3+LDS_K+hi*1024+r32*16; const lds_cptr vp0=shm3+LDS_V+((lane>>4)&1)*32+(lane&3)*8+(4*hi+((lane&15)>>2))*64;
  const lds_cptr bp0=shm3+LDS_BIAS+hi*16;
  const int NT=(q0+QB)/KVBLK;
  DMA_K(0,0);DMA_V(0,0);DMA_K(1,SLOTB);
  bf16x8 qr[4];
  #pragma unroll
  for(int d0=0;d0<4;++d0)qr[d0]=*reinterpret_cast<const bf16x8*>(&Qw[(long)r32*KVP+d0*16+hi*8]);
  const unsigned long long*mwp=MASK?maskw+(q0+wid*QBLK+r32):nullptr;
  #define MLOAD(MW,t) do{ if(MASK){ MW=mwp[(long)(t)*SEQ]; } }while(0)
  #define MPIN(MW) do{}while(0)
  float mhat=0.f,l_reg=0.f;f32x16 o[2];o[0]=f32x16{};o[1]=f32x16{};
  const int qrel=wid*QBLK+r32;
  #define CMASK(P0,P1,t,MW) do{ if(MASK){ bmask(P0,P1,MW,hi); } else { int jb_=(t)-(NT-4); if(jb_>=0)cmask(P0,P1,jb_,qrel,hi); } }while(0)
  bool resc=false;
  #define START(P0,P1) do{ const float rm=rowmax(P0,P1); resc=false; \
    { const float dl=__builtin_fmaxf(rm,-60000.f); mhat=fadd_s(mhat,dl); \
      _Pragma("unroll") for(int r=0;r<16;++r){P0[r]=fsub_s(P0[r],dl);P1[r]=fsub_s(P1[r],dl);} } \
    _Pragma("unroll") for(int r=0;r<16;++r)P0[r]=__builtin_amdgcn_exp2f(P0[r]); }while(0)
  #define RESC() do{ if(resc){ asm volatile("s_waitcnt lgkmcnt(0)":::"memory"); \
      _Pragma("unroll") for(int d_=0;d_<2;++d_) _Pragma("unroll") for(int r=0;r<16;++r)o[d_][r]*=wsf[crow(r,hi)]; } }while(0)
  f32x16 pA0,pA1,pB0,pB1;
  int sl_prev=0,sl_cur=0,sl_next=SLOTB;
  #define ROT() do{sl_prev=sl_cur;sl_cur=sl_next;sl_next=(sl_next==(NSLOT-1)*SLOTB)?0:sl_next+SLOTB;}while(0)
  DMA_K(2,2*SLOTB);
  WAIT_BAR(3);
  binit(pA0,pA1,bp0,0.f);
  qkt(pA0,pA1,Kbase,qr,r32,hi);asm volatile("s_nop 15\n\ts_nop 7":"+v"(pA0),"+v"(pA1));CMASK(pA0,pA1,0,mwA);
  START(pA0,pA1);
  _Pragma("unroll") for(int r=0;r<16;++r)pA1[r]=__builtin_amdgcn_exp2f(pA1[r]);
  WAIT_BAR(0);
  DMA_K(3,0);DMA_V(1,SLOTB);MLOAD(mwA,2);
  ROT();
  kload8(kf,kp0+sl_cur);
  if(MASK){WAIT_BAR(3);}else{WAIT_BAR(2);}
  s16x4 vlo[8],vhi[8]; u32x4 pw0,pw1,pw2,pw3;
  #define PKW(P,B) cvtpk_s(P[B],P[B+1])
  #define PAF(k) __builtin_bit_cast(bf16x8,pw##k)
  #define VFR(i) (bf16x8){vlo[i][0],vlo[i][1],vlo[i][2],vlo[i][3],vhi[i][0],vhi[i][1],vhi[i][2],vhi[i][3]}
  #define PIN(x) asm volatile("":"+v"(x))
  #define MX3(a,b,c) __builtin_fmaxf(__builtin_fmaxf((a),(b)),(c))
  #define GAPA(MF,A0,A1,A2,A3,W0,W1,PW) do{ MF; sacc+=A0; sacc+=A1; sacc+=A2; sacc+=A3; PIN(sacc); W0; W1; PIN(PW); SBAR(); }while(0)
  #define EX(v) __builtin_amdgcn_exp2f(v)
  #define GAPB(MF,X,B) do{ MF; X[B]=EX(X[B]); X[B+1]=EX(X[B+1]); X[B+2]=EX(X[B+2]); X[B+3]=EX(X[B+3]); PIN(X); SBAR(); }while(0)
  #define VRD(i) do{ vlo[i]=vtr(vp_+(((i)>>2)*4096+((i)&3)*1024)); vhi[i]=vtr(vp_+(((i)>>2)*4096+((i)&3)*1024+512)); }while(0)
  #define KRD(G,j) do{ if(G){ kload2(kf,kp0+sl_next,j); SBAR(); } }while(0)
  #define STEP(C0,C1,P0,P1,t,GK,GV,GL,MW,GM,DOCM) do{ SBAR(); \
    const lds_cptr vp_=vp0+sl_prev; \
    binit(C0,C1,bp0+(t)*256,mhat); SBAR(); \
    VRD(0); SBAR(); float sacc=(P0[0]+P0[1]); \
    GAPA(C0=__builtin_amdgcn_mfma_f32_32x32x16_bf16(kf[0],qr[0],C0,0,0,0), P0[2],P0[3],P0[4],P0[5],     pw0[0]=PKW(P0,0), pw0[1]=PKW(P0,2), pw0); \
    VRD(4); SBAR(); GAPA(C1=__builtin_amdgcn_mfma_f32_32x32x16_bf16(kf[1],qr[0],C1,0,0,0), P0[6],P0[7],P0[8],P0[9],     pw0[2]=PKW(P0,4), pw0[3]=PKW(P0,6), pw0); \
    VRD(1); SBAR(); GAPA(C0=__builtin_amdgcn_mfma_f32_32x32x16_bf16(kf[2],qr[1],C0,0,0,0),   P0[10],P0[11],P0[12],P0[13], pw1[0]=PKW(P0,8), pw1[1]=PKW(P0,10), pw1); \
    VRD(5); SBAR(); GAPA(C1=__builtin_amdgcn_mfma_f32_32x32x16_bf16(kf[3],qr[1],C1,0,0,0),   P0[14],P0[15],P1[0],P1[1],   pw1[2]=PKW(P0,12),pw1[3]=PKW(P0,14), pw1); \
    VRD(2); SBAR(); GAPA(C0=__builtin_amdgcn_mfma_f32_32x32x16_bf16(kf[4],qr[2],C0,0,0,0),   P1[2],P1[3],P1[4],P1[5],     pw2[0]=PKW(P1,0), pw2[1]=PKW(P1,2), pw2); \
    VRD(6); SBAR(); GAPA(C1=__builtin_amdgcn_mfma_f32_32x32x16_bf16(kf[5],qr[2],C1,0,0,0),   P1[6],P1[7],P1[8],P1[9],     pw2[2]=PKW(P1,4), pw2[3]=PKW(P1,6), pw2); \
    VRD(3); SBAR(); GAPA(C0=__builtin_amdgcn_mfma_f32_32x32x16_bf16(kf[6],qr[3],C0,0,0,0),   P1[10],P1[11],P1[12],P1[13], pw3[0]=PKW(P1,8), pw3[1]=PKW(P1,10), pw3); \
    VRD(7); SBAR(); GAPA(C1=__builtin_amdgcn_mfma_f32_32x32x16_bf16(kf[7],qr[3],C1,0,0,0),   P1[14],P1[15],0.f,0.f,       pw3[2]=PKW(P1,12),pw3[3]=PKW(P1,14), pw3); \
    l_reg+=sacc; \
    if(MASK&&(DOCM)){ CMASK(C0,C1,t,MW); } \
    if(GK){DMA_K((t)+3,sl_cur);} if(GV){DMA_V((t)+1,sl_next);} \
    if(!MASK&&(DOCM)){ CMASK(C0,C1,t,MW); } \
    if(GM){ MLOAD(MW,(t)+2); } \
    { float a=MX3(C0[0],C0[1],C1[0]),b=MX3(C0[2],C0[3],C1[1]); a=MX3(a,C1[2],C1[3]); \
      _Pragma("unroll") for(int r=4;r<16;r+=4){a=MX3(a,C0[r],C0[r+1]);b=MX3(b,C0[r+2],C0[r+3]);a=MX3(a,C1[r],C1[r+1]);b=MX3(b,C1[r+2],C1[r+3]);} \
      float rm=__builtin_fmaxf(a,b); { auto rr=__builtin_amdgcn_permlane32_swap(__float_as_uint(rm),__float_as_uint(rm),false,false); rm=__builtin_fmaxf(__uint_as_float(rr[0]),__uint_as_float(rr[1])); } \
      resc=false; \
      if(__builtin_expect(__any(rm>(float)THRL),0)){ const float dl=__builtin_fmaxf(rm,0.f); mhat+=dl; \
        _Pragma("unroll") for(int r=0;r<16;++r){C0[r]-=dl;C1[r]-=dl;} \
        const float f=__builtin_amdgcn_exp2f(-dl); l_reg*=f; if(hi==0)wsf[r32]=f; resc=true; } } \
    SBAR(); \
    GAPB(o[0]=__builtin_amdgcn_mfma_f32_32x32x16_bf16(PAF(0),VFR(0),o[0],0,0,0), C0,0); \
    GAPB(o[1]=__builtin_amdgcn_mfma_f32_32x32x16_bf16(PAF(0),VFR(4),o[1],0,0,0), C0,4); \
    KRD(GL,0); GAPB(o[0]=__builtin_amdgcn_mfma_f32_32x32x16_bf16(PAF(1),VFR(1),o[0],0,0,0), C0,8); \
    KRD(GL,1); GAPB(o[1]=__builtin_amdgcn_mfma_f32_32x32x16_bf16(PAF(1),VFR(5),o[1],0,0,0), C0,12); \
    KRD(GL,2); GAPB(o[0]=__builtin_amdgcn_mfma_f32_32x32x16_bf16(PAF(2),VFR(2),o[0],0,0,0), C1,0); \
    KRD(GL,3); GAPB(o[1]=__builtin_amdgcn_mfma_f32_32x32x16_bf16(PAF(2),VFR(6),o[1],0,0,0), C1,4); \
    GAPB(o[0]=__builtin_amdgcn_mfma_f32_32x32x16_bf16(PAF(3),VFR(3),o[0],0,0,0), C1,8); \
    GAPB(o[1]=__builtin_amdgcn_mfma_f32_32x32x16_bf16(PAF(3),VFR(7),o[1],0,0,0), C1,12); \
    }while(0)
  int t=1;
  #define ENDW(tt) do{ if((tt)+3<NT){ if(MASK){WAIT_BAR(3);}else{WAIT_BAR(2);} } else if((tt)+2<NT){ if(MASK){WAIT_BAR(2);}else{WAIT_BAR(1);} } else {WAIT_BAR(0);} }while(0)
  for(;t+5<NT;t+=2){
    STEP(pB0,pB1,pA0,pA1,t,true,true,true,mwB,MASK,MASK);     if(MASK){WAIT_BAR(3);}else{WAIT_BAR(2);} MPIN(mwA); RESC(); ROT();
    STEP(pA0,pA1,pB0,pB1,t+1,true,true,true,mwA,MASK,MASK);   if(MASK){WAIT_BAR(3);}else{WAIT_BAR(2);} MPIN(mwB); RESC(); ROT();
  }
  for(;t+1<NT;t+=2){
    STEP(pB0,pB1,pA0,pA1,t,(t+3<NT),(t+1<NT),(t+1<NT),mwB,(MASK&&(t+2<NT)),true);       ENDW(t);   MPIN(mwA); RESC(); ROT();
    STEP(pA0,pA1,pB0,pB1,t+1,(t+4<NT),(t+2<NT),(t+2<NT),mwA,(MASK&&(t+3<NT)),true);     ENDW(t+1); MPIN(mwB); RESC(); ROT();
  }
  STEP(pB0,pB1,pA0,pA1,NT-1,false,false,false,mwB,false,true); RESC();
  { float sacc=pB0[0]+pB0[1]; _Pragma("unroll") for(int r=2;r<16;++r)sacc+=pB0[r]; _Pragma("unroll") for(int r=0;r<16;++r)sacc+=pB1[r]; l_reg+=sacc;
    pw0=(u32x4){PKW(pB0,0),PKW(pB0,2),PKW(pB0,4),PKW(pB0,6)};pw1=(u32x4){PKW(pB0,8),PKW(pB0,10),PKW(pB0,12),PKW(pB0,14)};pw2=(u32x4){PKW(pB1,0),PKW(pB1,2),PKW(pB1,4),PKW(pB1,6)};pw3=(u32x4){PKW(pB1,8),PKW(pB1,10),PKW(pB1,12),PKW(pB1,14)};
    SBAR(); pv(o,vb0+sl_cur,PAF(0),PAF(1),PAF(2),PAF(3)); }
  #undef PKW
  #undef PAF
  #undef VFR
  #undef PIN
  #undef MX3
  #undef GAPA
  #undef GAPB
  #undef EX
  #undef VRD
  #undef KRD
  #undef STEP
  #undef ENDW
  {auto rr=__builtin_amdgcn_permlane32_swap(__float_as_uint(l_reg),__float_as_uint(l_reg),false,false);l_reg=__uint_as_float(rr[0])+__uint_as_float(rr[1]);}
  if(hi==0)wsf[32+r32]=l_reg;asm volatile("s_waitcnt lgkmcnt(0)":::"memory");
  float rli[16];
  #pragma unroll
  for(int r=0;r<16;++r)rli[r]=__builtin_amdgcn_rcpf(wsf[32+crow(r,hi)]);
  bf16*Ow=Os+(long)(q0+wid*QBLK)*OP;
  { bf16*stg=(bf16*)(shm+LDS_OST)+wid*2048;
    #pragma unroll
    for(int r=0;r<16;++r){const int orow=crow(r,hi);
      #pragma unroll
      for(int d0=0;d0<2;++d0)stg[orow*64+d0*32+r32]=__float2bfloat16(o[d0][r]*rli[r]);}
    asm volatile("s_waitcnt lgkmcnt(0)":::"memory");
    #pragma unroll
    for(int i=0;i<4;++i){const int row=i*8+(lane>>3),ch=lane&7; const u32x4 v=*(const u32x4*)(stg+row*64+ch*8); *(u32x4*)(Ow+(long)row*OP+ch*8)=v;} }
  asm volatile("s_waitcnt lgkmcnt(0)\n\ts_barrier":::"memory");
  #undef DMA_K
  #undef MLOAD
  #undef MPIN
  #undef DMA_V
  #undef CMASK
  #undef START
  #undef RESC
  #undef ROT
}
#undef SBAR
#undef WAIT_BAR
}
struct Args { const float* in[25]; float* out; unsigned char* ws; int ph_lo, ph_hi; };
struct Frame {
    LAS unsigned char* lds; unsigned char* ldsg;
    volatile LAS unsigned* MISC;
    gu32* ctl;
    int tid, lane, wave, vcu, G;
    unsigned char* ws; float* out;
};
__device__ __forceinline__ float dpp_add_(float v, float acc_src, int) { return v; }
#define DPP_F(v, ctrl, rmask) __builtin_bit_cast(float, __builtin_amdgcn_update_dpp(0, __builtin_bit_cast(int, (v)), (ctrl), (rmask), 0xF, false))
__device__ __forceinline__ float wave_sum(float v) {
    v += DPP_F(v, 0xB1, 0xF);
    v += DPP_F(v, 0x4E, 0xF);
    v += DPP_F(v, 0x141, 0xF);
    v += DPP_F(v, 0x140, 0xF);
    v += DPP_F(v, 0x142, 0xA);
    v += DPP_F(v, 0x143, 0xC);
    return __builtin_bit_cast(float, __builtin_amdgcn_readlane(__builtin_bit_cast(int, v), 63));
}
__device__ __forceinline__ bf16* wsb(const Frame& F, size_t off) { return (bf16*)(F.ws + off); }

__device__ __forceinline__ int map_small(int r) {
    if (r < 1024) return r;
    if (r < 1280) return 1028 + (r - 1024);
    if (r < 1536) return 1412 + (r - 1280);
    if (r < 2048) return 1736 + (r - 1536);
    if (r < 2112) return 1284 + (r - 2048);
    if (r < 2176) return 1348 + (r - 2112);
    if (r < 2240) return 1668 + (r - 2176);
    if (r < 2244) return 1024 + (r - 2240);
    if (r < 2248) return 1732 + (r - 2244);
    return -1;
}
__device__ __forceinline__ void tr_item(const float* src, int ld_src, int k0, int srccol, bf16* dst, int ld_dst, LAS float* scr, int lane) {
    float tv[32];
#pragma unroll
    for (int i = 0; i < 32; ++i) { const int kk = 2 * i + (lane >> 5); tv[i] = src[(size_t)(k0 + kk) * ld_src + (srccol >= 0 ? srccol : 0)]; }
#pragma unroll
    for (int i = 0; i < 32; ++i) { const int kk = 2 * i + (lane >> 5); scr[kk * 33 + (lane & 31)] = srccol >= 0 ? tv[i] : 0.f; }
    LDS_WAIT(); asm volatile("" ::: "memory");
    const int c = lane & 7;
#pragma unroll
    for (int j = 0; j < 4; ++j) { const int n = (lane >> 3) + 8 * j; const LAS float* s = scr + (8 * c) * 33 + n;
        v4u o; o.x = pk2(s[0 * 33], s[1 * 33]); o.y = pk2(s[2 * 33], s[3 * 33]); o.z = pk2(s[4 * 33], s[5 * 33]); o.w = pk2(s[6 * 33], s[7 * 33]);
        *(GAS v4u*)(dst + (size_t)n * ld_dst + 8 * c) = o; }
    LDS_WAIT(); asm volatile("" ::: "memory");
}
constexpr int IT_SM = 72 * 16, IT_GT = 128 * 16, IT_BR = 512, IT_OUT = 512, IT_GU = 16 * 512, IT_D = 16 * 256, IT_LAYER = IT_SM + IT_GT + IT_BR + IT_OUT + IT_GU + IT_D;
__device__ __forceinline__ void p0_item(const Frame& F, const Args& a, int it, LAS float* scr) {
    const int l = it / IT_LAYER; int j = it % IT_LAYER; const int n = F.lane & 31;
    bf16* W = wsb(F, WS_W + (size_t)l * W_LAYER);
    if (j < IT_SM) { const int g = j / 16, kb = j % 16; tr_item(a.in[3] + (size_t)l * DM * P_TOTAL, P_TOTAL, kb * 64, map_small(g * 32 + n), W + W_SM / 2 + (size_t)(g * 32) * DM + kb * 64, DM, scr, F.lane); return; } j -= IT_SM;
    if (j < IT_GT) { const int g = j / 16, kb = j % 16; tr_item(a.in[3] + (size_t)l * DM * P_TOTAL, P_TOTAL, kb * 64, 2248 + g * 32 + n, W + W_GT / 2 + (size_t)(g * 32) * DM + kb * 64, DM, scr, F.lane); return; } j -= IT_GT;
    if (j < IT_BR) { const int nb = j / 128, jj = j % 128, g = jj / 4, kb = jj % 4;
        tr_item(a.in[12] + ((size_t)l * 4 + nb) * 256 * DM, DM, kb * 64, g * 32 + n, W + W_BR / 2 + (size_t)(g * 32) * DM + nb * 256 + kb * 64, DM, scr, F.lane); return; } j -= IT_BR;
    if (j < IT_OUT) { const int g = j / 16, kb = j % 16; tr_item(a.in[13] + (size_t)l * DM * DM, DM, kb * 64, g * 32 + n, W + W_OUT / 2 + (size_t)(g * 32) * DM + kb * 64, DM, scr, F.lane); return; } j -= IT_OUT;
    if (j < IT_GU) { const int e = j / 512, jj = j % 512, g = jj / 16, kb = jj % 16; const int r0 = g * 32, q = r0 >> 8, within = r0 & 255; const bool isup = within >= 128;
        const float* src = (isup ? a.in[21] : a.in[20]) + ((size_t)l * 16 + e) * DM * 512;
        tr_item(src, 512, kb * 64, 128 * q + (within & 127) + n, W + W_GU / 2 + (size_t)e * DM * DM + (size_t)r0 * DM + kb * 64, DM, scr, F.lane); return; } j -= IT_GU;
    { const int e = j / 256, jj = j % 256, g = jj / 8, kb = jj % 8;
        tr_item(a.in[22] + ((size_t)l * 16 + e) * 512 * DM, DM, kb * 64, g * 32 + n, W + W_D / 2 + (size_t)(e >> 1) * DM * DM + (size_t)(g * 32) * DM + (e & 1) * 512 + kb * 64, DM, scr, F.lane); }
}
__device__ __forceinline__ void ln_load(const Frame& F, const float* xrow, f32x4 (&v)[4]) {
    const GAS f32x4* xr = (const GAS f32x4*)xrow + F.lane;
#pragma unroll
    for (int j = 0; j < 4; ++j) v[j] = xr[64 * j];
}
struct LnGB { f32x4 g[4], b[4]; };
__device__ __forceinline__ void ln_gb_load(const Frame& F, const float* g, const float* b, LnGB& gb) {
#pragma unroll
    for (int j = 0; j < 4; ++j) { gb.g[j] = ((const GAS f32x4*)g)[F.lane + 64 * j]; gb.b[j] = ((const GAS f32x4*)b)[F.lane + 64 * j]; }
}
__device__ __forceinline__ void ln_load_bf(const Frame& F, const bf16* xrow, f32x4 (&v)[4]) {
    const GAS v2u* xr = (const GAS v2u*)xrow + F.lane;
#pragma unroll
    for (int j = 0; j < 4; ++j) { const v2u w = xr[64 * j]; v[j] = (f32x4){bfl(w.x), bfh(w.x), bfl(w.y), bfh(w.y)}; }
}
__device__ __forceinline__ void ln_row(const Frame& F, const LnGB& gb, float* orow  , bf16* brow  , f32x4 (&v)[4], bool dry = false) {
    float s = 0.f;
#pragma unroll
    for (int j = 0; j < 4; ++j) s += (v[j].x + v[j].y) + (v[j].z + v[j].w);
    const float mean = wave_sum(s) * (1.f / DM); float s2 = 0.f;
#pragma unroll
    for (int j = 0; j < 4; ++j) { v[j] = v[j] - mean; s2 += (v[j].x * v[j].x + v[j].y * v[j].y) + (v[j].z * v[j].z + v[j].w * v[j].w); }
    const float rstd = 1.f / sqrtf(wave_sum(s2) * (1.f / DM) + LN_EPS);
    GAS f32x4* o4 = (GAS f32x4*)orow + F.lane; GAS v2u* o8 = (GAS v2u*)brow + F.lane;
#pragma unroll
    for (int j = 0; j < 4; ++j) { v[j] = v[j] * rstd * gb.g[j] + gb.b[j]; v2u w; w.x = pk2(v[j].x, v[j].y); w.y = pk2(v[j].z, v[j].w); if (!dry) { if (orow) o4[64 * j] = v[j]; if (brow) o8[64 * j] = w; } }
}
__device__ __forceinline__ void p0_prologue(const Frame& F_, const Args& a) { Frame F = F_; F.lane = lane_id_(); F.tid = F.wave * 64 + F.lane;
    LAS float* scr = (LAS float*)(F.lds + RING_OFF + F.wave * 16384);
    const int gw = F.vcu * NWAVES + F.wave, NGW = F.G * NWAVES;
    for (int it = gw; it < DEPTH * IT_LAYER; it += NGW) p0_item(F, a, it, scr);
    { LnGB gb; ln_gb_load(F, a.in[1], a.in[2], gb); f32x4 nx[4]; ln_load(F, a.in[0] + (size_t)gw * DM, nx);
      for (int m = gw; m < NTOK; m += NGW) { f32x4 v[4];
#pragma unroll
          for (int j = 0; j < 4; ++j) v[j] = nx[j];
          if (m + NGW < NTOK) ln_load(F, a.in[0] + (size_t)(m + NGW) * DM, nx);
          ln_row(F, gb, nullptr, wsb(F, WS_HB) + (size_t)m * DM, v); } }
}

#ifndef TO_WGM
#define TO_WGM 8
#endif
struct TileOrder {
    int nM, nN, nwg, G, c;
    __device__ void init(int nM_, int nN_, int G_, int c_) { nM = nM_; nN = nN_; nwg = nM * nN; G = G_; c = c_; }
    __device__ bool tile(int i, int& pm, int& pn) const {
        const long L = (long)i * G + c; if (L >= nwg) return false;
        int wgid = (int)L; { const int q = nwg / 8, r = nwg % 8, xcd = wgid % 8, off = wgid / 8; wgid = (xcd < r ? xcd * (q + 1) : r * (q + 1) + (xcd - r) * q) + off; }
        const int nig = TO_WGM * nN, gid = wgid / nig, fm = gid * TO_WGM, gsz = (nM - fm) < TO_WGM ? (nM - fm) : TO_WGM;
        pm = fm + ((wgid % nig) % gsz); pn = (wgid % nig) / gsz; return true;
    }
};
struct SchedA { TileOrder T; const char* A; const char* B;
    __device__ bool next(int i, pg8::GU& u) const { int pm, pn; if (!T.tile(i, pm, pn)) return false; u.A = A + (size_t)pm * pg8::TSTEP; u.B0 = B + (size_t)pn * pg8::TSTEP; u.B1 = u.B0; u.nt = 16; u.ks = 16; u.pm = pm; u.pn = pn; u.rows = nullptr; u.rbase = 0; u.rcnt = 0; u.a0 = 0; u.a1 = 0; return true; } };
struct EpiA { static constexpr bool PERM = true; bf16* P; float* FW; bf16* KIDX;
    __device__ __forceinline__ void operator()(const pg8::f32x4 (&acc)[2][2][4][2], const pg8::GU& u, int wr, int wc, int fr, int fq) {
        const float sc = (u.pn == 1 || u.pn == 4) ? 0.125f * LOG2E : 1.f;
        const int row0 = u.pm * 256 + wr * 64 + fr, col0 = u.pn * 256 + wc * 32 + 8 * fq;
#pragma unroll
        for (int ai = 0; ai < 2; ++ai)
#pragma unroll
            for (int m = 0; m < 4; ++m) { const int row = row0 + ai * 128 + m * 16; bf16* rowp = P + (size_t)row * PS + col0;
#pragma unroll
                for (int bj = 0; bj < 2; ++bj) { const pg8::f32x4 v0 = acc[ai][bj][m][0] * sc, v1 = acc[ai][bj][m][1] * sc; v4u w;
                    w.x = pg8::cvt_pk_bf16(v0[0], v0[1]); w.y = pg8::cvt_pk_bf16(v0[2], v0[3]); w.z = pg8::cvt_pk_bf16(v1[0], v1[1]); w.w = pg8::cvt_pk_bf16(v1[2], v1[3]);
                    *(v4u*)(rowp + bj * 128) = w;
                    if (bj == 1 && u.pn == 8 && wc < 2) *(v4u*)(KIDX + (size_t)row * 64 + wc * 32 + 8 * fq) = w;
                    if (bj == 1 && u.pn == 8 && wc == 2 && fq == 0) { *(f32x4*)(FW + (size_t)row * 8) = v0; *(f32x4*)(FW + (size_t)row * 8 + 4) = v1; } } }
    } };
struct SchedC { TileOrder T; const char* HBp; const char* BRp; const char* WGp; const char* WBp; bool collapse;
    __device__ bool next(int i, pg8::GU& u) const { int pm, pd; if (!T.tile(i >> 3, pm, pd)) return false; const int sub = i & 7, n = sub >> 1, isg = sub & 1; const int pm_o = pm, pd_o = pd; if (collapse) { pm &= 7; pd = 0; }
        u.pm = pm; u.pn = pd; u.a0 = n; u.a1 = isg; u.rows = nullptr; u.rbase = 0; u.rcnt = 0;
        if (isg) { u.A = HBp + (size_t)pm * pg8::TSTEP; u.B0 = WGp + (size_t)(n * 8 + pd) * pg8::HSTEP; u.nt = 16; }
        else     { u.A = BRp + (size_t)pm * pg8::TSTEP + n * 512; u.B0 = WBp + (size_t)pd * pg8::HSTEP + n * 512; u.nt = 4; }
        u.B1 = u.B0; u.ks = u.nt; u.pm = pm_o; u.pn = pd_o; return true; } };
struct EpiC { static constexpr bool PERM = true; bf16* MIX; const float* bgate; bool dry;
    __device__ __forceinline__ void operator()(const pg8::f32x4 (&acc)[2][4][2], pg8::u32x4 (&upk)[2][4], pg8::u32x4 (&sum)[2][4]  , const pg8::GU& u, int wr, int wc, int fr, int fq) {
        const int n = u.a0;
        if (!u.a1) {
#pragma unroll
            for (int ai = 0; ai < 2; ++ai)
#pragma unroll
                for (int m = 0; m < 4; ++m) { const pg8::f32x4 v0 = acc[ai][m][0], v1 = acc[ai][m][1]; v4u w;
                    w.x = pg8::cvt_pk_bf16(v0[0], v0[1]); w.y = pg8::cvt_pk_bf16(v0[2], v0[3]); w.z = pg8::cvt_pk_bf16(v1[0], v1[1]); w.w = pg8::cvt_pk_bf16(v1[2], v1[3]); upk[ai][m] = w; }
        } else {
            const int colt = u.pn * 128 + wc * 32 + 8 * fq; const float* bp = bgate + n * DM + colt; const f32x4 b0 = *(const f32x4*)bp, b1 = *(const f32x4*)(bp + 4);
#pragma unroll
            for (int ai = 0; ai < 2; ++ai)
#pragma unroll
                for (int m = 0; m < 4; ++m) { const v4u uw = upk[ai][m]; const pg8::f32x4 g0 = acc[ai][m][0] + b0, g1 = acc[ai][m][1] + b1;
                    pg8::f32x4 r0, r1; r0[0] = sigmoidf_(g0[0]) * bfl(uw.x); r0[1] = sigmoidf_(g0[1]) * bfh(uw.x); r0[2] = sigmoidf_(g0[2]) * bfl(uw.y); r0[3] = sigmoidf_(g0[3]) * bfh(uw.y);
                    r1[0] = sigmoidf_(g1[0]) * bfl(uw.z); r1[1] = sigmoidf_(g1[1]) * bfh(uw.z); r1[2] = sigmoidf_(g1[2]) * bfl(uw.w); r1[3] = sigmoidf_(g1[3]) * bfh(uw.w);
                    if (n > 0) { const v4u pw = sum[ai][m]; r0[0] += bfl(pw.x); r0[1] += bfh(pw.x); r0[2] += bfl(pw.y); r0[3] += bfh(pw.y); r1[0] += bfl(pw.z); r1[1] += bfh(pw.z); r1[2] += bfl(pw.w); r1[3] += bfh(pw.w); }
                    v4u o; o.x = pg8::cvt_pk_bf16(r0[0], r0[1]); o.y = pg8::cvt_pk_bf16(r0[2], r0[3]); o.z = pg8::cvt_pk_bf16(r1[0], r1[1]); o.w = pg8::cvt_pk_bf16(r1[2], r1[3]); sum[ai][m] = o; }
            if (n == 3) { const int row0 = u.pm * 256 + wr * 64 + fr;
#pragma unroll
                for (int ai = 0; ai < 2; ++ai)
#pragma unroll
                    for (int m = 0; m < 4; ++m) *(v4u*)(MIX + (size_t)(row0 + ai * 128 + m * 16) * DM + colt) = sum[ai][m]; }
        }
    } };
struct SchedC2 { TileOrder T; const char* A; const char* B;
    __device__ bool next(int i, pg8::GU& u) const { int pm, pn; if (!T.tile(i, pm, pn)) return false; u.A = A + (size_t)pm * pg8::TSTEP; u.B0 = B + (size_t)pn * pg8::TSTEP; u.B1 = u.B0; u.nt = 16; u.ks = 16; u.pm = pm; u.pn = pn; u.rows = nullptr; u.rbase = 0; u.rcnt = 0; u.a0 = 0; u.a1 = 0; return true; } };
struct EpiRes { static constexpr bool PERM = false; bf16* V1; const bf16* HB; bool dry;
    __device__ __forceinline__ void operator()(const pg8::f32x4 (&acc)[2][2][4][2], const pg8::GU& u, int wr, int wc, int fr, int fq) {
        const int row0 = u.pm * 256 + wr * 64 + fr, col0 = u.pn * 256 + wc * 32 + 4 * fq;
#pragma unroll
        for (int ai = 0; ai < 2; ++ai)
#pragma unroll
            for (int m = 0; m < 4; ++m) { const size_t ro = (size_t)(row0 + ai * 128 + m * 16) * DM + col0;
#pragma unroll
                for (int bj = 0; bj < 2; ++bj)
#pragma unroll
                    for (int n = 0; n < 2; ++n) { const v2u hw = *(const v2u*)(HB + ro + bj * 128 + n * 16); const f32x4 hv = (f32x4){bfl(hw.x), bfh(hw.x), bfl(hw.y), bfh(hw.y)};
                        const f32x4 r_ = hv * ALPHA + acc[ai][bj][m][n]; v2u o; o.x = pk2(r_.x, r_.y); o.y = pk2(r_.z, r_.w); if (!dry) *(v2u*)(V1 + ro + bj * 128 + n * 16) = o; } }
    } };
__device__ __forceinline__ void cls_lookup(const LAS int* tab, int tau, int& c, int& j) {
    int cc = 0;
#pragma unroll 1
    for (int k = 1; k < NCLS; ++k) if (tab[32 + k] <= tau) cc = k;
    c = cc; j = tau - tab[32 + cc];
}
__device__ __forceinline__ void cls_experts(int c, int& ea, int& eb) { const int g = c / 6, p = c % 6; const int i = p < 3 ? 0 : (p < 5 ? 1 : 2); const int jj = p < 3 ? p + 1 : (p < 5 ? p - 1 : 3); ea = g * 4 + i; eb = g * 4 + jj; }
struct SchedD1 { const LAS int* tab; int G, c0; const char* HBp; const char* WGU; const int* list;
    __device__ bool next(int i, pg8::GU& u) const { const int L = i * G + c0; if (L >= tab[57] * 8) return false; const int tau = L >> 3, pn = L & 7; int c, j; cls_lookup(tab, tau, c, j); int ea, eb; cls_experts(c, ea, eb);
        const int e = (pn >> 2) ? eb : ea;
        u.A = HBp; u.B0 = WGU + (size_t)e * DM * DM * 2 + (size_t)(pn & 3) * pg8::TSTEP; u.B1 = u.B0; u.nt = 16; u.ks = 16; u.rows = list + (size_t)c * NTOK; u.rbase = j * 256; u.rcnt = tab[c];
        u.pm = tau; u.pn = pn; u.a0 = c; u.a1 = j; return true; } };
struct EpiD1 { static constexpr bool PERM = true; bf16* ACT; const float* gwl;
    __device__ __forceinline__ void operator()(const pg8::f32x4 (&acc)[2][2][4][2], const pg8::GU& u, int wr, int wc, int fr, int fq) {
        const int half = u.pn >> 2, col = half * 512 + (u.pn & 3) * 128 + wc * 32 + 8 * fq;
#pragma unroll
        for (int ai = 0; ai < 2; ++ai)
#pragma unroll
            for (int m = 0; m < 4; ++m) { const int r = ai * 128 + wr * 64 + m * 16 + opaque_i(fr), pos = u.rbase + r;
                const float gw = pos < u.rcnt ? gwl[((size_t)u.a0 * NTOK + pos) * 2 + half] : 0.f;
                const pg8::f32x4 g0 = acc[ai][0][m][0], g1 = acc[ai][0][m][1], u0 = acc[ai][1][m][0], u1 = acc[ai][1][m][1]; float r8[8];
#pragma unroll
                for (int k = 0; k < 4; ++k) { r8[k] = g0[k] * sigmoidf_(g0[k]) * u0[k] * gw; r8[4 + k] = g1[k] * sigmoidf_(g1[k]) * u1[k] * gw; }
                v4u o; o.x = pg8::cvt_pk_bf16(r8[0], r8[1]); o.y = pg8::cvt_pk_bf16(r8[2], r8[3]); o.z = pg8::cvt_pk_bf16(r8[4], r8[5]); o.w = pg8::cvt_pk_bf16(r8[6], r8[7]);
                *(v4u*)(ACT + ((size_t)u.pm * 256 + r) * DM + col) = o; asm volatile("" ::: "memory"); }
    } };
struct SchedD2 { const LAS int* tab; int G, c0; const char* ACTp; const char* WD; const int* list;
    __device__ bool next(int i, pg8::GU& u) const { const int L = i * G + c0; if (L >= tab[57] * 4) return false; const int tau = L >> 2, pn = L & 3; int c, j; cls_lookup(tab, tau, c, j); int ea, eb; cls_experts(c, ea, eb);
        u.A = ACTp + (size_t)tau * pg8::TSTEP; u.B0 = WD + (size_t)(ea >> 1) * DM * DM * 2 + (ea & 1) * 1024 + (size_t)pn * pg8::TSTEP; u.B1 = WD + (size_t)(eb >> 1) * DM * DM * 2 + (eb & 1) * 1024 + (size_t)pn * pg8::TSTEP;
        u.nt = 16; u.ks = 8; u.rows = list + (size_t)c * NTOK; u.rbase = j * 256; u.rcnt = tab[c]; u.pm = tau; u.pn = pn; u.a0 = c; u.a1 = j; return true; } };
struct EpiD2 { static constexpr bool PERM = false; bf16* V2; const bf16* HB; bool dry;
    __device__ __forceinline__ void operator()(const pg8::f32x4 (&acc)[2][2][4][2], const pg8::GU& u, int wr, int wc, int fr, int fq) {
        const int col0 = u.pn * 256 + wc * 32 + 4 * fq;
#pragma unroll
        for (int ai = 0; ai < 2; ++ai)
#pragma unroll
            for (int m = 0; m < 4; ++m) { const int pos = u.rbase + ai * 128 + wr * 64 + m * 16 + opaque_i(fr);
                if (pos < u.rcnt) { const size_t ro = (size_t)u.rows[pos] * DM + col0;
#pragma unroll
                    for (int bj = 0; bj < 2; ++bj)
#pragma unroll
                        for (int n = 0; n < 2; ++n) { const v2u hw = *(const v2u*)(HB + ro + bj * 128 + n * 16); const f32x4 hv = (f32x4){bfl(hw.x), bfh(hw.x), bfl(hw.y), bfh(hw.y)};
                            const f32x4 r_ = hv * ALPHA + acc[ai][bj][m][n]; v2u o; o.x = pk2(r_.x, r_.y); o.y = pk2(r_.z, r_.w); if (!dry) *(v2u*)(V2 + ro + bj * 128 + n * 16) = o; } } }
    } };
typedef float f32x2v __attribute__((ext_vector_type(2)));
__device__ __forceinline__ float log_sigmoid_(float x) { return fminf(x, 0.f) - __builtin_amdgcn_logf(1.f + __builtin_amdgcn_exp2f(-fabsf(x) * LOG2E)) * 0.6931471805599453f; }
__device__ __forceinline__ void fox_cumsum(const Frame& F_, int bh, const float* FW, const float* bfor, float* bias2) { Frame F = F_; F.lane = lane_id_(); F.tid = F.wave * 64 + F.lane;
    const int b = bh >> 2, h = bh & 3; const float bf = bfor[h]; const float* src = FW + ((size_t)b * SEQ + F.lane * 64) * 8 + h; float tot = 0.f;
    for (int i = 0; i < 64; ++i) tot += log_sigmoid_(src[(size_t)i * 8] + bf);
    float inc = tot;
#pragma unroll
    for (int o = 1; o < 64; o <<= 1) { const float t = __shfl_up(inc, o); if (F.lane >= o) inc += t; }
    float run = inc - tot; float* dst = bias2 + (size_t)bh * SEQ + F.lane * 64;
    for (int i = 0; i < 64; ++i) { run += log_sigmoid_(src[(size_t)i * 8] + bf); dst[i] = -run * LOG2E; }
}
template <int WIN> __device__ __forceinline__ void pool_frags(bf16x8 (&af)[4], const bf16* src0, int tb) {
    const int nrow = tb + 1 < WIN ? tb + 1 : WIN; const float inv = 1.f / (float)nrow;
#pragma unroll
    for (int ks = 0; ks < 4; ++ks) { const bf16* src = src0 + ks * 16; v4u wv[WIN];
#pragma unroll
        for (int j = 0; j < WIN; ++j) wv[j] = *(const v4u*)(src - (size_t)(j <= tb ? j : 0) * PS);
        float s[8];
#pragma unroll
        for (int k = 0; k < 8; ++k) s[k] = 0.f;
#pragma unroll
        for (int j = 0; j < WIN; ++j) { if (j <= tb) { const v4u w = wv[j];
            s[0] += bfl(w.x); s[1] += bfh(w.x); s[2] += bfl(w.y); s[3] += bfh(w.y); s[4] += bfl(w.z); s[5] += bfh(w.z); s[6] += bfl(w.w); s[7] += bfh(w.w); } }
        const v4u cur = wv[0];
        const float c[8] = {bfl(cur.x), bfh(cur.x), bfl(cur.y), bfh(cur.y), bfl(cur.z), bfh(cur.z), bfl(cur.w), bfh(cur.w)};
        v4u o; o.x = pk2(s[0] * inv - c[0], s[1] * inv - c[1]); o.y = pk2(s[2] * inv - c[2], s[3] * inv - c[3]); o.z = pk2(s[4] * inv - c[4], s[5] * inv - c[5]); o.w = pk2(s[6] * inv - c[6], s[7] * inv - c[7]);
        af[ks] = __builtin_bit_cast(bf16x8, o); }
}
__device__ __forceinline__ void pool_unit(const Frame& F_, int tile, const bf16* P, const float* pw, const float* pscale, bf16* BR) { Frame F = F_; F.lane = lane_id_(); F.tid = F.wave * 64 + F.lane;
    const int g = F.wave & 3, th = F.wave >> 2, r32 = F.lane & 31, hi = F.lane >> 5;
    const int tok = tile * 64 + th * 32 + r32, tb = tok & (SEQ - 1);
    const bf16* src0 = P + (size_t)tok * PS + C_POOL + g * 64 + hi * 8;
    bf16x8 af[4];
    if (g == 0) pool_frags<2>(af, src0, tb); else if (g == 1) pool_frags<4>(af, src0, tb); else if (g == 2) pool_frags<8>(af, src0, tb); else pool_frags<16>(af, src0, tb);
#pragma unroll
    for (int db = 0; db < 2; ++db) { f32x16 acc = {};
#pragma unroll
        for (int ks = 0; ks < 4; ++ks) { const float* wp = pw + ((size_t)g * 64 + ks * 16 + hi * 8) * 64 + db * 32 + r32;
            v4u o; o.x = pk2(wp[0], wp[64]); o.y = pk2(wp[128], wp[192]); o.z = pk2(wp[256], wp[320]); o.w = pk2(wp[384], wp[448]);
            acc = __builtin_amdgcn_mfma_f32_32x32x16_bf16(af[ks], __builtin_bit_cast(bf16x8, o), acc, 0, 0, 0); }
        const int col = g * 64 + db * 32 + r32; const float sc = pscale[col];
#pragma unroll
        for (int r = 0; r < 16; ++r) { const int row = tile * 64 + th * 32 + (r & 3) + 8 * (r >> 2) + 4 * hi; BR[(size_t)row * DM + col] = (bf16)f2bf(acc[r] * sc); } }
}
__device__ __forceinline__ void conv_unit(const Frame& F_, int tile, const bf16* P, const float* dw, const float* cb, const float* lg, const float* lb, bf16* BR) { Frame F = F_; F.lane = lane_id_(); F.tid = F.wave * 64 + F.lane;
    LAS float* hb = (LAS float*)(F.lds + RING_OFF);
    LAS float* yb = hb + 62 * 256;
    const int t0 = tile * 32, tb0 = t0 & (SEQ - 1);
    { v4u av[4], gv[4];
#pragma unroll
      for (int k = 0; k < 4; ++k) { const int e = F.tid + k * NWAVES * 64, rr = e >> 5, c8 = (e & 31) * 8, trel = rr - 30; const bool ok = e < 62 * 32 && tb0 + trel >= 0;
          const bf16* src = P + (size_t)(t0 + (ok ? trel : 0)) * PS + C_CONV + c8; av[k] = *(const v4u*)src; gv[k] = *(const v4u*)(src + 256); }
#pragma unroll
      for (int k = 0; k < 4; ++k) { const int e = F.tid + k * NWAVES * 64, rr = e >> 5, c8 = (e & 31) * 8, trel = rr - 30; const bool ok = tb0 + trel >= 0; const v4u a = av[k], gt = gv[k]; float h[8];
          h[0] = bfl(a.x) * sigmoidf_(bfl(gt.x)); h[1] = bfh(a.x) * sigmoidf_(bfh(gt.x)); h[2] = bfl(a.y) * sigmoidf_(bfl(gt.y)); h[3] = bfh(a.y) * sigmoidf_(bfh(gt.y));
          h[4] = bfl(a.z) * sigmoidf_(bfl(gt.z)); h[5] = bfh(a.z) * sigmoidf_(bfh(gt.z)); h[6] = bfl(a.w) * sigmoidf_(bfl(gt.w)); h[7] = bfh(a.w) * sigmoidf_(bfh(gt.w));
          if (!ok) {
#pragma unroll
              for (int q = 0; q < 8; ++q) h[q] = 0.f; }
          if (e < 62 * 32) { *(LAS f32x4*)(hb + rr * 256 + c8) = (f32x4){h[0], h[1], h[2], h[3]}; *(LAS f32x4*)(hb + rr * 256 + c8 + 4) = (f32x4){h[4], h[5], h[6], h[7]}; } } }
    __syncthreads();
    { const int c = F.tid & 255, hf = F.tid >> 8; float w[31];
#pragma unroll
      for (int j = 0; j < 31; ++j) w[j] = dw[j * 256 + c];
      const float bias = cb[c];
#pragma unroll 1
      for (int q4 = 0; q4 < 4; ++q4) { const int tt = hf * 16 + q4 * 4; float x[34];
#pragma unroll
          for (int j = 0; j < 34; ++j) x[j] = hb[(tt + j) * 256 + c];
#pragma unroll
          for (int o = 0; o < 4; ++o) { float a = bias;
#pragma unroll
              for (int j = 0; j < 31; ++j) a += x[o + j] * w[j];
              yb[(tt + o) * 256 + c] = a; } } }
    __syncthreads();
#pragma unroll 1
    for (int q = 0; q < 4; ++q) { const int tt = F.wave * 4 + q; const f32x4 v = *(const LAS f32x4*)(yb + tt * 256 + F.lane * 4);
        const float mean = wave_sum((v.x + v.y) + (v.z + v.w)) * (1.f / 256.f); const f32x4 d = v - mean;
        const float var = wave_sum((d.x * d.x + d.y * d.y) + (d.z * d.z + d.w * d.w)) * (1.f / 256.f); const float rstd = 1.f / sqrtf(var + LN_EPS);
        const f32x4 gg = *(const f32x4*)(lg + F.lane * 4), bb = *(const f32x4*)(lb + F.lane * 4); const f32x4 y = d * rstd * gg + bb;
        v2u o; o.x = pk2(y.x * sigmoidf_(y.x), y.y * sigmoidf_(y.y)); o.y = pk2(y.z * sigmoidf_(y.z), y.w * sigmoidf_(y.w));
        *(v2u*)(BR + (size_t)(t0 + tt) * DM + 768 + F.lane * 4) = o; }
    __syncthreads();
}
__device__ __forceinline__ int key28_(float s) { const int u = (int)__float_as_uint(s); int m = (u & 0x7fffffff) - 0x3B000000; m = m < 0 ? 0 : (m > 0x07FFFFFF ? 0x07FFFFFF : m); return 0x08000000 + (m ^ (u >> 31)); }
__device__ __forceinline__ int key9_(float s) { const int u = (int)__float_as_uint(s); int m = ((u >> 19) & 0xfff) - 0x760; m = m < 0 ? 0 : (m > 255 ? 255 : m); return 256 + (m ^ (u >> 31)); }
__device__ __forceinline__ float key28_lbound(long long kv) {
    if (kv <= 0) return -INFINITY; if (kv > 0x0FFFFFFFll) return INFINITY;
    if (kv > 0x08000000ll) return __uint_as_float((unsigned)(0x3B000000ll + (kv - 0x08000000ll)));
    if (kv == 0x08000000ll) return 0.f;
    return -__uint_as_float((unsigned)(0x3B000000ll + (0x07FFFFFFll - kv)));
}
constexpr int DS_HIST = 0, DS_GT = 65536, DS_EQ = 81920, DS_KT = 98304, DS_SM = LDSCTL_OFF + 1024 - RING_OFF, DS_CAP = 512;
typedef float f32x2p __attribute__((ext_vector_type(2)));
__device__ __forceinline__ float relu_(float x) { const int b = (int)__float_as_uint(x); return __uint_as_float((unsigned)(b > 0 ? b : 0)); }
__device__ __forceinline__ void dsa_ldk(bf16x8 (&kf)[4], const bf16* kp) {
#pragma unroll
    for (int m = 0; m < 4; ++m) kf[m] = *(const bf16x8*)(kp + m * 512);
}
__device__ __forceinline__ void dsa_kfrag(bf16x8 (&kf)[4], const bf16x8 (&raw)[4], LAS unsigned char* kt, int lane) {
    const int rw = lane >> 3, cw = lane & 7, r32 = lane & 31, hi = lane >> 5;
#pragma unroll
    for (int m = 0; m < 4; ++m) *(LAS bf16x8*)(kt + (8 * m + rw) * 128 + ((cw ^ rw) << 4)) = raw[m];
#pragma unroll
    for (int ks = 0; ks < 4; ++ks) kf[ks] = *(const LAS bf16x8*)(kt + r32 * 128 + (((2 * ks + hi) ^ (r32 & 7)) << 4));
}
__device__ __forceinline__ void dsa_scores(const bf16x8 (&qf)[4][4], const bf16x8 (&kf)[4], const float (&w)[4], float (&sc)[16]) {
    f32x16 a[4];
#pragma unroll
    for (int hh = 0; hh < 4; ++hh) { a[hh] = (f32x16){};
#pragma unroll
        for (int ks = 0; ks < 4; ++ks) a[hh] = __builtin_amdgcn_mfma_f32_32x32x16_bf16(kf[ks], qf[hh][ks], a[hh], 0, 0, 0); }
#pragma unroll
    for (int r = 0; r < 16; r += 2) { f32x2p s2 = (f32x2p){relu_(a[0][r]), relu_(a[0][r + 1])} * w[0];
#pragma unroll
        for (int hh = 1; hh < 4; ++hh) s2 = (f32x2p){relu_(a[hh][r]), relu_(a[hh][r + 1])} * w[hh] + s2;
        sc[r] = s2.x + 0.f; sc[r + 1] = s2.y + 0.f; }
}
template <int NB4> __device__ __forceinline__ void hist_scan(const LAS unsigned* h, int K, int lane, int& bin, int& above, int& inbin, int* total = nullptr) {
    unsigned hv[NB4 * 4]; int s = 0;
#pragma unroll
    for (int g = 0; g < NB4; ++g) { const v4u t = *(const LAS v4u*)(h + NB4 * 4 * lane + 4 * g); hv[4 * g] = t.x; hv[4 * g + 1] = t.y; hv[4 * g + 2] = t.z; hv[4 * g + 3] = t.w; s += (int)(t.x + t.y + t.z + t.w); }
    int suf = s;
#pragma unroll
    for (int o = 1; o < 64; o <<= 1) { const int t = __shfl_down(suf, o); if (lane + o < 64) suf += t; }
    if (total) *total = __shfl(suf, 0);
    const int excl = suf - s; const bool hit = (excl < K) && (K <= suf);
    int b = 0, c = excl, nb = 0; bool done = false;
#pragma unroll
    for (int k = NB4 * 4 - 1; k >= 0; --k) { if (!done) { if (c + (int)hv[k] >= K) { b = k; nb = (int)hv[k]; done = true; } else c += (int)hv[k]; } }
    const unsigned long long m = __ballot(hit); const int src = m ? (int)__builtin_ctzll(m) : 0;
    bin = __shfl(NB4 * 4 * lane + b, src); above = __shfl(c, src); inbin = __shfl(nb, src);
    if (!m) { bin = 0; above = 0; inbin = 0; }
}
#define DSA_ONE_TILE(KF, I, ...) do { const int i = (I); float sc[16]; { bf16x8 kfr[4]; dsa_kfrag(kfr, KF, ktile, F.lane); dsa_scores(qf, kfr, w, sc); } \
        if (i == j) { constexpr bool DIAG = true; __VA_ARGS__ } else { constexpr bool DIAG = false; __VA_ARGS__ } } while (0)
#define DSA_TILE_LOOP_S(STRIDE, ...) do { bf16x8 ka[4], kb[4]; int i0 = F.wave; \
    { const int ia = i0 <= j ? i0 : 0, ib = i0 + (STRIDE) <= j ? i0 + (STRIDE) : ia; dsa_ldk(ka, kbase + (size_t)ia * 32 * 64); dsa_ldk(kb, kbase + (size_t)ib * 32 * 64); } \
    _Pragma("unroll 1") for (; i0 <= j; i0 += 2 * (STRIDE)) { bf16x8 na[4], nb[4]; \
        { const int ia = i0 + 2 * (STRIDE) <= j ? i0 + 2 * (STRIDE) : i0, ib = i0 + 3 * (STRIDE) <= j ? i0 + 3 * (STRIDE) : i0; dsa_ldk(na, kbase + (size_t)ia * 32 * 64); dsa_ldk(nb, kbase + (size_t)ib * 32 * 64); } \
        __builtin_amdgcn_sched_barrier(0); \
        DSA_ONE_TILE(ka, i0, __VA_ARGS__); \
        if (i0 + (STRIDE) <= j) DSA_ONE_TILE(kb, i0 + (STRIDE), __VA_ARGS__); \
        _Pragma("unroll") for (int ks = 0; ks < 4; ++ks) { ka[ks] = na[ks]; kb[ks] = nb[ks]; } } } while (0)
#define DSA_TILE_LOOP(...) DSA_TILE_LOOP_S(NWAVES, __VA_ARGS__)
#define DSA_VALID(r) (!DIAG || ((r) & 3) + 8 * ((r) >> 2) <= qlim)
__device__ __forceinline__ void dsa_mask_unit(const Frame& F_, int b, int j, const bf16* P, const bf16* KIDX, const float* FW, unsigned long long* selw) { Frame F = F_; F.lane = lane_id_(); F.tid = F.wave * 64 + F.lane;
    LAS unsigned* HIST = (LAS unsigned*)(F.lds + RING_OFF + DS_HIST);
    LAS unsigned* GT = (LAS unsigned*)(F.lds + RING_OFF + DS_GT);
    LAS unsigned* EQ = (LAS unsigned*)(F.lds + RING_OFF + DS_EQ);
    LAS int* SM = (LAS int*)(F.lds + RING_OFF + DS_SM); volatile LAS unsigned* PRB = (volatile LAS unsigned*)(F.lds + LDSCTL_OFF + 512);
    PROBE_BEGIN(1);
    const int r32 = F.lane & 31, hi = F.lane >> 5, t0 = j * 32; const size_t brow = (size_t)b * SEQ;
    bf16x8 qf[4][4];
#pragma unroll
    for (int hh = 0; hh < 4; ++hh)
#pragma unroll
        for (int ks = 0; ks < 4; ++ks) qf[hh][ks] = *(const bf16x8*)(P + (brow + t0 + r32) * PS + C_IQ + hh * 64 + ks * 16 + hi * 8);
    float w[4]; { const f32x4 wv = *(const f32x4*)(FW + (brow + t0 + r32) * 8 + 4); w[0] = wv.x; w[1] = wv.y; w[2] = wv.z; w[3] = wv.w; }
    const bf16* kbase = KIDX + brow * 64 + F.lane * 8;
    LAS unsigned char* ktile = F.lds + RING_OFF + DS_KT + F.wave * 4096;
    const int qlim = r32 - 4 * hi;
    LAS unsigned* hrow = HIST + r32 * 512;
#define DSA_ZERO_HIST() do { for (int e = F.tid; e < 4096; e += NWAVES * 64) ((LAS v4u*)HIST)[e] = (v4u){0u, 0u, 0u, 0u}; } while (0)
    DSA_ZERO_HIST();
    if (F.tid < 64) SM[128 + F.tid] = 0;
    __syncthreads();
    PROBE_END(1); PROBE_BEGIN(2);
#if REP_PHASE == 41
    { float dummy = 0.f; DSA_TILE_LOOP({ _Pragma("unroll") for (int r = 0; r < 16; ++r) dummy += sc[r]; }); if (dummy == 12345.678f) SM[170] = 1; }
#endif
#if REP_PHASE == 42
    { LAS unsigned* drow = EQ + (r32 & 7) * 512; DSA_TILE_LOOP({ _Pragma("unroll") for (int r = 0; r < 16; ++r) { const int kh = key28_(sc[r]) >> 19; if (DSA_VALID(r)) __hip_atomic_fetch_add(drow + kh, 1u, __ATOMIC_RELAXED, __HIP_MEMORY_SCOPE_WORKGROUP); } }); }
#endif
#if REP_PHASE == 43
    { DSA_ZERO_HIST(); __syncthreads(); for (int q = F.wave * 4; q < F.wave * 4 + 4; ++q) { int bin, above, inbin; hist_scan<2>(HIST + q * 512, 256, F.lane, bin, above, inbin); if (F.lane == 0) SM[171] = bin; } __syncthreads(); __syncthreads(); __syncthreads(); }
#endif
    DSA_TILE_LOOP({ _Pragma("unroll")
        for (int r = 0; r < 16; ++r) { const int kh = key9_(sc[r]); if (DSA_VALID(r)) __hip_atomic_fetch_add(hrow + kh, 1u, __ATOMIC_RELAXED, __HIP_MEMORY_SCOPE_WORKGROUP); } });
    __syncthreads();
    PROBE_END(2); PROBE_BEGIN(3);
#pragma unroll 1
    for (int q = F.wave * 4; q < F.wave * 4 + 4; ++q) { int bin, above, inbin; hist_scan<2>(HIST + q * 512, 256, F.lane, bin, above, inbin);
        if (F.lane == 0) { const int total = t0 + q + 1;
            if (total <= 256) { SM[q] = -1; SM[32 + q] = 0; SM[64 + q] = 0; SM[96 + q] = 0; }
            else { SM[q] = bin; SM[32 + q] = above; SM[64 + q] = inbin; SM[96 + q] = 256 - above; if (inbin > DS_CAP) SM[160] = 1; } } }
    __syncthreads();
    PROBE_END(3); PROBE_BEGIN(4);
    const int myb1 = SM[r32];
    if (SM[160] == 0) {
        const float lge = key28_lbound((long long)myb1 << 19), lgt = key28_lbound(((long long)myb1 + 1) << 19);
        LAS unsigned* lrow = HIST + r32 * DS_CAP;
        DSA_TILE_LOOP({ unsigned gtw = 0u; unsigned cw = 0u; _Pragma("unroll")
            for (int r = 0; r < 16; ++r) { const int bit = (r & 3) + 8 * (r >> 2); const bool valid = DSA_VALID(r);
                if (valid && sc[r] >= lgt) gtw |= 1u << bit; else if (valid && sc[r] >= lge) cw |= 1u << r; }
            if (cw) {
                LAS float* sl = (LAS float*)ktile + F.lane; _Pragma("unroll")
                for (int r = 0; r < 16; ++r) sl[r * 64] = sc[r];
                int slot = (int)__hip_atomic_fetch_add((LAS unsigned*)SM + 128 + r32, (unsigned)__popc(cw), __ATOMIC_RELAXED, __HIP_MEMORY_SCOPE_WORKGROUP);
                while (cw) { const int r = __builtin_ctz(cw); cw &= cw - 1u; const float sv = sl[r * 64]; const int bit = (r & 3) + 8 * (r >> 2);
                    if (slot < DS_CAP) lrow[slot] = ((unsigned)(key28_(sv) & 0x7FFFF) << 12) | (unsigned)(4095 - (i * 32 + bit + 4 * hi)); ++slot; } }
            gtw <<= 4 * hi; gtw |= (unsigned)__shfl_xor((int)gtw, 32);
            if (hi == 0) GT[i * 32 + r32] = gtw; });
        __syncthreads();
        PROBE_END(4); PROBE_BEGIN(5);
#pragma unroll 1
        for (int q = F.wave * 4; q < F.wave * 4 + 4; ++q) { const int n = SM[128 + q] < DS_CAP ? SM[128 + q] : DS_CAP, quota = SM[96 + q]; const LAS unsigned* lq = HIST + q * DS_CAP;
            for (int c0 = 0; c0 < n; c0 += 64) { const int ci = c0 + F.lane; const unsigned e = ci < n ? lq[ci] : 0xffffffffu; int rank = 0;
                int k = 0;
                for (; k + 16 <= n; k += 16) { const v4u c0 = *(const LAS v4u*)(lq + k), c1 = *(const LAS v4u*)(lq + k + 4), c2 = *(const LAS v4u*)(lq + k + 8), c3 = *(const LAS v4u*)(lq + k + 12);
                    rank += (c0.x > e ? 1 : 0) + (c0.y > e ? 1 : 0) + (c0.z > e ? 1 : 0) + (c0.w > e ? 1 : 0) + (c1.x > e ? 1 : 0) + (c1.y > e ? 1 : 0) + (c1.z > e ? 1 : 0) + (c1.w > e ? 1 : 0)
                          + (c2.x > e ? 1 : 0) + (c2.y > e ? 1 : 0) + (c2.z > e ? 1 : 0) + (c2.w > e ? 1 : 0) + (c3.x > e ? 1 : 0) + (c3.y > e ? 1 : 0) + (c3.z > e ? 1 : 0) + (c3.w > e ? 1 : 0); }
                for (; k < n; ++k) rank += (lq[k] > e) ? 1 : 0;
                if (ci < n && rank < quota) { const int idx = 4095 - (int)(e & 4095u); __hip_atomic_fetch_or(GT + (idx >> 5) * 32 + q, 1u << (idx & 31), __ATOMIC_RELAXED, __HIP_MEMORY_SCOPE_WORKGROUP); } } }
        __syncthreads();
    } else {
        DSA_ZERO_HIST();
        __syncthreads();
        DSA_TILE_LOOP({ _Pragma("unroll")
            for (int r = 0; r < 16; ++r) { const int k = key28_(sc[r]); if ((k >> 19) == myb1 && DSA_VALID(r)) __hip_atomic_fetch_add(hrow + ((k >> 11) & 255), 1u, __ATOMIC_RELAXED, __HIP_MEMORY_SCOPE_WORKGROUP); } });
        __syncthreads();
#pragma unroll 1
        for (int q = F.wave * 4; q < F.wave * 4 + 4; ++q) { int bin, above, inbin; const int b1 = SM[q], ab1 = SM[32 + q]; hist_scan<1>(HIST + q * 512, 256 - ab1, F.lane, bin, above, inbin);
            if (F.lane == 0) { if (b1 < 0) { SM[192 + q] = -1; SM[96 + q] = 0; SM[224 + q] = 0; }
                else { const int quota = 256 - (ab1 + above); SM[192 + q] = (b1 << 8) | bin; SM[96 + q] = quota; SM[224 + q] = inbin; if (quota < inbin) SM[161] = 1; } } }
        __syncthreads();
        const int thr = SM[192 + r32]; const bool allacc = SM[96 + r32] >= SM[224 + r32];
        const float lge = key28_lbound((long long)thr << 11), lgt = key28_lbound(((long long)thr + 1) << 11);
        DSA_TILE_LOOP({ unsigned gtw = 0u; unsigned gew = 0u; _Pragma("unroll")
            for (int r = 0; r < 16; ++r) { const int bit = (r & 3) + 8 * (r >> 2); const bool valid = DSA_VALID(r);
                if (valid && sc[r] >= lgt) gtw |= 1u << bit; if (valid && sc[r] >= lge) gew |= 1u << bit; }
            gtw <<= 4 * hi; gew <<= 4 * hi;
            gtw |= (unsigned)__shfl_xor((int)gtw, 32); gew |= (unsigned)__shfl_xor((int)gew, 32);
            unsigned eqw = gew & ~gtw;
            if (allacc) { gtw = gew; eqw = 0u; }
            if (hi == 0) GT[i * 32 + r32] = gtw; else EQ[i * 32 + r32] = eqw; });
        __syncthreads();
        if (SM[161] != 0 && F.tid < 32) { const int q = F.tid; const int quota = SM[96 + q]; if (quota < SM[224 + q]) { int run = 0;
                for (int i = 0; i <= j; ++i) { unsigned e = EQ[i * 32 + q]; if (e) { const int allowed = quota - run; if (allowed <= 0) e = 0u; else { int pc = __popc(e); while (pc > allowed) { e &= ~(0x80000000u >> __clz(e)); --pc; } }
                        run += __popc(e); GT[i * 32 + q] |= e; } } } }
        __syncthreads();
    }
    PROBE_END(5); PROBE_BEGIN(6);
    { const int ntile64 = 4 * (j / 8 + 1); unsigned long long* dst = selw + (size_t)b * 64 * SEQ + t0;
      for (int e = F.tid; e < ntile64 * 32; e += NWAVES * 64) { const int T = e >> 5, q = e & 31; const unsigned lo = (2 * T <= j) ? GT[(2 * T) * 32 + q] : 0u, up = (2 * T + 1 <= j) ? GT[(2 * T + 1) * 32 + q] : 0u;
          dst[(size_t)T * SEQ + q] = ((unsigned long long)up << 32) | lo; } }
    __syncthreads();
    PROBE_END(6);
}
#undef DSA_TILE_LOOP
#undef DSA_ZERO_HIST
#undef DSA_TILE_LOOP_S
#undef DSA_ONE_TILE
#undef DSA_VALID
__device__ __forceinline__ void ln1_router_phase(const Frame& F_, const Args& a, int l, bool dry = false) { Frame F = F_; F.lane = lane_id_(); F.tid = F.wave * 64 + F.lane;
    LAS float* RW = (LAS float*)(F.lds + RING_OFF);
    LAS int* LC = (LAS int*)(F.lds + RING_OFF + 81920);
    LAS int* LTOK = LC + 64;
    LAS int* LCLS = LTOK + 128; LAS int* LPOS = LCLS + 128; LAS float* LGA = (LAS float*)(LPOS + 128); LAS float* LGB = LGA + 128;
    volatile LAS unsigned* PRB = (volatile LAS unsigned*)(F.lds + LDSCTL_OFF + 512);
    PROBE_BEGIN(31);
    const float* rg = a.in[16] + (size_t)l * DM * 4; const float* re = a.in[18] + (size_t)l * DM * 16;
    for (int e = F.tid; e < DM * 4; e += NWAVES * 64) { const int k = e >> 2, c = e & 3, ln = (k & 255) >> 2, kidx = (k >> 8) * 4 + (k & 3); RW[((kidx * 5 + 0) * 64 + ln) * 4 + c] = rg[e]; }
    for (int e = F.tid; e < DM * 16; e += NWAVES * 64) { const int k = e >> 4, c = 4 + (e & 15), ln = (k & 255) >> 2, kidx = (k >> 8) * 4 + (k & 3); RW[((kidx * 5 + (c >> 2)) * 64 + ln) * 4 + (c & 3)] = re[e]; }
    if (F.tid < 64) LC[F.tid] = 0;
    __syncthreads();
    PROBE_END(31); PROBE_BEGIN(32);
    const float* rgb = a.in[17] + l * 4; const float* reb = a.in[19] + l * 16;
    const float* g1 = a.in[14] + (size_t)l * DM; const float* b1 = a.in[15] + (size_t)l * DM;
    int* list = (int*)(F.ws + WS_LIST); float* gwl = (float*)(F.ws + WS_GWL);
    const int rows_per_blk = NTOK / F.G;
    LnGB gb; ln_gb_load(F, g1, b1, gb);
    float rb[20];
#pragma unroll
    for (int c = 0; c < 4; ++c) rb[c] = rgb[c];
#pragma unroll
    for (int c = 0; c < 16; ++c) rb[4 + c] = reb[c];
    const bf16* V1 = wsb(F, WS_R2);
    f32x4 nx[4]; ln_load_bf(F, V1 + (size_t)(F.vcu * rows_per_blk + F.wave) * DM, nx);
    for (int rr = F.wave; rr < rows_per_blk; rr += NWAVES) { const int m = F.vcu * rows_per_blk + rr; f32x4 v[4];
#pragma unroll
        for (int j = 0; j < 4; ++j) v[j] = nx[j];
        if (rr + NWAVES < rows_per_blk) ln_load_bf(F, V1 + (size_t)(m + NWAVES) * DM, nx);
        ln_row(F, gb, nullptr, wsb(F, WS_HB) + (size_t)m * DM, v, dry);
        float gl[4] = {0.f, 0.f, 0.f, 0.f};
#pragma unroll
        for (int jj = 0; jj < 4; ++jj)
#pragma unroll
            for (int k = 0; k < 4; ++k) { const f32x4 wv = *(const LAS f32x4*)(RW + (((jj * 4 + k) * 5) * 64 + F.lane) * 4); const float xv = v[jj][k];
                gl[0] += xv * wv.x; gl[1] += xv * wv.y; gl[2] += xv * wv.z; gl[3] += xv * wv.w; }
        int gi = 0; float gm;
#pragma unroll
        for (int c = 0; c < 4; ++c) gl[c] = wave_sum(gl[c]) + rb[c];
        gm = gl[0];
#pragma unroll
        for (int c = 1; c < 4; ++c) if (gl[c] > gm) { gm = gl[c]; gi = c; }
        float gs = 0.f;
#pragma unroll
        for (int c = 0; c < 4; ++c) gs += expf(gl[c] - gm);
        const float pg = 1.f / gs;
        float el[4] = {0.f, 0.f, 0.f, 0.f};
        { const LAS float* wg = RW + ((1 + gi) * 64 + F.lane) * 4;
#pragma unroll
          for (int jj = 0; jj < 4; ++jj)
#pragma unroll
            for (int k = 0; k < 4; ++k) { const f32x4 wv = *(const LAS f32x4*)(wg + ((jj * 4 + k) * 5) * 256); const float xv = v[jj][k];
                el[0] += xv * wv.x; el[1] += xv * wv.y; el[2] += xv * wv.z; el[3] += xv * wv.w; } }
#pragma unroll
        for (int c = 0; c < 4; ++c) { float bsel = rb[4 + c];
#pragma unroll
            for (int g = 1; g < 4; ++g) if (gi == g) bsel = rb[4 + 4 * g + c];
            el[c] = wave_sum(el[c]) + bsel; }
        int i1 = 0; float m1 = el[0];
#pragma unroll
        for (int c = 1; c < 4; ++c) if (el[c] > m1) { m1 = el[c]; i1 = c; }
        int i2 = -1; float m2 = -INFINITY;
#pragma unroll
        for (int c = 0; c < 4; ++c) if (c != i1 && el[c] > m2) { m2 = el[c]; i2 = c; }
        const float e2 = expf(m2 - m1); const float p1 = 1.f / (1.f + e2), p2 = e2 / (1.f + e2);
        const int ia = i1 < i2 ? i1 : i2, ib = i1 < i2 ? i2 : i1; const float ga = pg * (i1 < i2 ? p1 : p2), gb = pg * (i1 < i2 ? p2 : p1);
        const int pidx = ia == 0 ? ib - 1 : (ia == 1 ? ib + 1 : 5); const int cls = gi * 6 + pidx;
        if (F.lane == 0) { const int pos = __hip_atomic_fetch_add(&LC[cls], 1, __ATOMIC_RELAXED, __HIP_MEMORY_SCOPE_WORKGROUP); LTOK[rr] = m; LCLS[rr] = cls; LPOS[rr] = pos; LGA[rr] = ga; LGB[rr] = gb; }
    }
    __syncthreads();
    PROBE_END(32);
    if (dry) return;
    PROBE_BEGIN(33);
    if (F.tid < NCLS) { const int n = LC[F.tid]; LC[32 + F.tid] = n ? (int)atomicAdd((unsigned*)(F.ctl + CW_CNT + (l * NCLS + F.tid) * 64), (unsigned)n) : 0; }
    __syncthreads();
    for (int rr = F.tid; rr < rows_per_blk; rr += NWAVES * 64) { const int cls = LCLS[rr], pos = LC[32 + cls] + LPOS[rr];
        list[(size_t)cls * NTOK + pos] = LTOK[rr]; gwl[((size_t)cls * NTOK + pos) * 2] = LGA[rr]; gwl[((size_t)cls * NTOK + pos) * 2 + 1] = LGB[rr]; }
    __syncthreads();
    PROBE_END(33);
}
__device__ __forceinline__ void ln2_phase(const Frame& F_, const Args& a, int l, bool dry = false) { Frame F = F_; F.lane = lane_id_(); F.tid = F.wave * 64 + F.lane;
    const float* g2 = a.in[23] + (size_t)l * DM; const float* b2 = a.in[24] + (size_t)l * DM; const bf16* V2 = wsb(F, WS_R1); const bool last = (l == DEPTH - 1);
    const int gw = F.vcu * NWAVES + F.wave, NGW = F.G * NWAVES;
    LnGB gb; ln_gb_load(F, g2, b2, gb);
    f32x4 nx[4]; ln_load_bf(F, V2 + (size_t)gw * DM, nx);
    for (int m = gw; m < NTOK; m += NGW) { f32x4 v[4];
#pragma unroll
        for (int j = 0; j < 4; ++j) v[j] = nx[j];
        if (m + NGW < NTOK) ln_load_bf(F, V2 + (size_t)(m + NGW) * DM, nx);
        ln_row(F, gb, last ? F.out + (size_t)m * DM : nullptr, wsb(F, WS_HB) + (size_t)m * DM, v, dry); }
}
__device__ __forceinline__ void moe_table(const Frame& F, int l, LAS int* tab) {
    const int tid = F.wave * 64 + lane_id_();
    if (tid < NCLS) tab[tid] = (int)__hip_atomic_load(F.ctl + CW_CNT + (l * NCLS + tid) * 64, RLX_AGENT);
    __syncthreads();
    if (tid == 0) { int s = 0; for (int c = 0; c < NCLS; ++c) { tab[32 + c] = s; s += (tab[c] + 255) >> 8; } tab[32 + NCLS] = s; tab[57] = s; }
    __syncthreads();
}
#define NREP(k) (((REP_PHASE) == (k) || ((k) == 4 && ((REP_PHASE) == 60 || (REP_PHASE) == 61))) ? 2 : 1)
#define DRY(k) ((REP_PHASE) == (k) && rep_ == 0 && args.ph_hi != 7777)
#ifndef MK_PER_PHASE
#define MK_PER_PHASE 0
#endif
constexpr int PH_PER_LAYER = 9, N_PHASES = 1 + DEPTH * PH_PER_LAYER;
__global__ void __launch_bounds__(NWAVES * 64, 2) fwd_kernel(Args args) {
    extern __shared__ __attribute__((aligned(16))) unsigned char lds[];
    Frame F0; Frame& F = F0;
    F.lds = (LAS unsigned char*)lds; F.ldsg = lds;
    F.MISC = (volatile LAS unsigned*)(F.lds + MISC_OFF);
    F.wave = __builtin_amdgcn_readfirstlane((int)threadIdx.x >> 6); F.lane = lane_id_(); F.tid = F.wave * 64 + F.lane;
    F.G = gridDim.x; { const int bx = blockIdx.x; F.vcu = (F.G % 8 == 0) ? (bx % 8) * (F.G / 8) + bx / 8 : bx; }
    F.ws = args.ws; F.out = args.out; F.ctl = (gu32*)(args.ws + WS_CTL);
    for (int u = F0.tid; u < (LDS_BYTES - LDSCTL_OFF) / 4; u += NWAVES * 64) ((LAS unsigned*)(F.lds + LDSCTL_OFF))[u] = 0u;
    __syncthreads();
    XcdBarrier bar; bar.bar = (unsigned*)(F.ctl + CW_BAR); bar.x = 0; bar.st = nullptr;
    if (!MK_PER_PHASE) bar = xcd_barrier_post((unsigned*)(F.ctl + CW_BAR), F.MISC + 8);
    const int lo = MK_PER_PHASE ? args.ph_lo : 0, hi = MK_PER_PHASE ? args.ph_hi : N_PHASES;
#define IN(k) (lo <= (k) && (k) < hi)
#ifndef PH_ONLY
#define PH_ONLY -1
#endif
#define EN(k) (PH_ONLY < 0 || PH_ONLY == (k))
#define SEAM(k) do { if (IN(k) && IN((k) + 1)) { PROBE_BEGIN(20); xcd_barrier(bar, F0.wave); PROBE_END(20); } } while (0)
    volatile LAS unsigned* PRB = (volatile LAS unsigned*)(F0.lds + LDSCTL_OFF + 512);
    LAS int* TAB = (LAS int*)(F.lds + LDSCTL_OFF + 64);
    bf16* const HB = wsb(F, WS_HB); bf16* const P = wsb(F, WS_R1); bf16* const MIX = wsb(F, WS_R1); bf16* const BR = wsb(F, WS_R2); bf16* const ACT = wsb(F, WS_R2);
    float* const FW = (float*)(F.ws + WS_FW); float* const BIAS2 = (float*)(F.ws + WS_BIAS2); unsigned long long* const SELW = (unsigned long long*)(F.ws + WS_SELW);

#define FRESH(Fn) Frame Fn = F0; Fn.vcu = opaque_s(F0.vcu); Fn.wave = opaque_s(F0.wave); Fn.lane = lane_id_(); Fn.tid = Fn.wave * 64 + Fn.lane
    for (int rep_ = 0; rep_ < ((REP_PHASE) == 10 ? 2 : 1); ++rep_) if (EN(0) && IN(0)) { FRESH(Fp); p0_prologue(Fp, args); }
    SEAM(0);
#pragma unroll 1
    for (int l0 = 0; l0 < DEPTH; ++l0) {
        const int pb = 1 + PH_PER_LAYER * l0;
#define l opaque_s(l0)
#define W (wsb(F, WS_W + (size_t)l * W_LAYER))
        for (int rep_ = 0; rep_ < NREP(1); ++rep_) if (EN(1) && IN(pb)) { SchedA S; S.T.init(NTOK / 256, PS / 256, F.G, opaque_s((int)blockIdx.x)); S.A = (const char*)HB; S.B = (const char*)(W + W_SM / 2);
            EpiA E{P, FW, wsb(F, WS_KIDX)}; pg8::gemm_phase<EpiA, SchedA, false>(F.lds + RING_OFF, (LAS unsigned*)(F.lds + LDSCTL_OFF + 1024), F0.wave, S, E); }
        SEAM(pb);
        for (int rep_ = 0; rep_ < NREP(2); ++rep_) if (EN(2) && IN(pb + 1)) { FRESH(Fp);
#ifndef NO_CUMSUM
            if (Fp.vcu < 32 && Fp.wave == 0) fox_cumsum(Fp, Fp.vcu, FW, args.in[4] + l * 4, BIAS2);
#endif
#ifndef NO_POOL
            for (int rp_ = 0; rp_ < ((REP_PHASE) == 21 ? 2 : 1); ++rp_) for (int k = 0; k < 2; ++k) pool_unit(Fp, Fp.vcu * 2 + k, P, args.in[6] + (size_t)l * 4 * 64 * 64, args.in[7] + (size_t)l * 256, BR);
#endif
#ifndef NO_CONV
            for (int rp_ = 0; rp_ < ((REP_PHASE) == 22 ? 2 : 1); ++rp_) for (int k = 0; k < 4; ++k) conv_unit(Fp, Fp.vcu * 4 + k, P, args.in[8] + (size_t)l * 31 * 256, args.in[9] + (size_t)l * 256, args.in[10] + (size_t)l * 256, args.in[11] + (size_t)l * 256, BR);
#endif
#ifndef NO_DSA
            { const int b = Fp.vcu >> 5, s = Fp.vcu & 31;
#pragma unroll 1
              for (int k = 0; k < ((REP_PHASE) == 23 ? 8 : 4); ++k) { const int j = (k & 3) == 0 ? 127 - s : ((k & 3) == 1 ? 64 + s : ((k & 3) == 2 ? 63 - s : s)); dsa_mask_unit(Fp, b, j, P, wsb(F, WS_KIDX), FW, SELW); } }
#endif
        }
        SEAM(pb + 1);
        for (int rep_ = 0; rep_ < NREP(3); ++rep_) if (EN(3) && IN(pb + 2)) { const int vc_ = opaque_s(F0.vcu); const int sg = vc_ >> 3, s = vc_ & 7, b = sg >> 2, h = sg & 3; const size_t rb = (size_t)b * SEQ;
            const attn_body::bf16* Pb = (const attn_body::bf16*)P + rb * PS; attn_body::bf16* Ob = (attn_body::bf16*)BR + rb * DM;
#pragma unroll 1
            for (int k = 0; k < ((REP_PHASE) == 31 ? 4 : 2); ++k) { const int qb = (k & 1) == 0 ? 15 - s : s;
                attn_body::attn_unit<24, false>(qb * 256, Pb + C_FQ + h * 64, Pb + C_FK + h * 64, Pb + C_FV + h * 64, Ob + 256 + h * 64, BIAS2 + (size_t)(b * 4 + h) * SEQ, 0.f, nullptr, (char*)lds + RING_OFF, F0.wave); }
            const float slope2 = exp2f(-2.f * (float)(h + 1)) * LOG2E;
#pragma unroll 1
            for (int k = 0; k < ((REP_PHASE) == 32 ? 4 : 2); ++k) { const int qb = (k & 1) == 0 ? 15 - s : s;
                attn_body::attn_unit<24, true>(qb * 256, Pb + C_DQ + h * 64, Pb + C_DK, Pb + C_DV, Ob + 512 + h * 64, nullptr, slope2, SELW + (size_t)b * 64 * SEQ, (char*)lds + RING_OFF, F0.wave); }
        }
        SEAM(pb + 2);
        for (int rep_ = 0; rep_ < NREP(4); ++rep_) if (EN(4) && IN(pb + 3)) { SchedC S; S.T.init(NTOK / 256, DM / 128, F.G, opaque_s((int)blockIdx.x)); S.HBp = (const char*)HB; S.BRp = (const char*)BR; S.WGp = (const char*)(W + W_GT / 2); S.WBp = (const char*)(W + W_BR / 2); S.collapse = ((REP_PHASE) == 61 && rep_ == 0 && args.ph_hi != 7777);
            EpiC E; E.dry = (((REP_PHASE) == 60 || (REP_PHASE) == 61) && rep_ == 0 && args.ph_hi != 7777); E.MIX = MIX; E.bgate = args.in[5] + (size_t)l * 4 * DM; pg8::gemm_phase_n128<EpiC, SchedC>(F.lds + RING_OFF, F0.wave, S, E); }
        SEAM(pb + 3);
        for (int rep_ = 0; rep_ < NREP(5); ++rep_) if (EN(5) && IN(pb + 4)) { SchedC2 S; S.T.init(NTOK / 256, DM / 256, F.G, opaque_s((int)blockIdx.x)); S.A = (const char*)MIX; S.B = (const char*)(W + W_OUT / 2);
            EpiRes E{BR  , HB, DRY(5)}; pg8::gemm_phase<EpiRes, SchedC2, false>(F.lds + RING_OFF, (LAS unsigned*)(F.lds + LDSCTL_OFF + 1024), F0.wave, S, E); }
        SEAM(pb + 4);
        for (int rep_ = 0; rep_ < NREP(6); ++rep_) if (EN(6) && IN(pb + 5)) { FRESH(Fp); PROBE_BEGIN(21); ln1_router_phase(Fp, args, l, DRY(6)); PROBE_END(21); }
        SEAM(pb + 5);
        for (int rep_ = 0; rep_ < NREP(7); ++rep_) if (EN(7) && IN(pb + 6)) { moe_table(F, l, TAB);
            SchedD1 S{TAB, F.G, opaque_s((int)blockIdx.x), (const char*)HB, (const char*)(W + W_GU / 2), (const int*)(F.ws + WS_LIST)};
            EpiD1 E{ACT, (const float*)(F.ws + WS_GWL)}; pg8::gemm_phase<EpiD1, SchedD1, true>(F.lds + RING_OFF, (LAS unsigned*)(F.lds + LDSCTL_OFF + 1024), F0.wave, S, E); }
        SEAM(pb + 6);
        for (int rep_ = 0; rep_ < NREP(8); ++rep_) if (EN(8) && IN(pb + 7)) { moe_table(F, l, TAB);
            SchedD2 S{TAB, F.G, opaque_s((int)blockIdx.x), (const char*)ACT, (const char*)(W + W_D / 2), (const int*)(F.ws + WS_LIST)};
            EpiD2 E{wsb(F, WS_R1), HB, DRY(8)}; pg8::gemm_phase<EpiD2, SchedD2, false>(F.lds + RING_OFF, (LAS unsigned*)(F.lds + LDSCTL_OFF + 1024), F0.wave, S, E); }
        SEAM(pb + 7);
        for (int rep_ = 0; rep_ < NREP(9); ++rep_) if (EN(9) && IN(pb + 8)) { FRESH(Fp); PROBE_BEGIN(22); ln2_phase(Fp, args, l, DRY(9)); PROBE_END(22); }
        SEAM(pb + 8);
#undef l
#undef W
    }
#undef IN
#undef SEAM
    if ((REP_PHASE) >= 100 && blockIdx.x == 0 && F0.wave == 0 && lane_id_() == 0) { volatile LAS unsigned* PRB = (volatile LAS unsigned*)(F0.lds + LDSCTL_OFF + 512); const unsigned long long a_ = (((unsigned long long)PRB[1]) << 32) | PRB[0];
        const unsigned long long t0_ = __builtin_amdgcn_s_memrealtime(); while (__builtin_amdgcn_s_memrealtime() - t0_ < a_) __builtin_amdgcn_s_sleep(8); }
}

extern "C" void kernel_launch(void* const* d_in, const int* in_sizes, int n_in, void* d_out, int out_size, void* d_ws, size_t ws_size, hipStream_t stream) {
    static int grid = 0;
    if (grid == 0) {
        if (n_in != 25 || in_sizes[0] != NTOK * DM || out_size != NTOK * DM || ws_size < WS_END) { fprintf(stderr, "kernel_launch: unexpected shapes (n_in %d, in0 %d, out %d, ws %zu); nothing launched\n", n_in, n_in > 0 ? in_sizes[0] : -1, out_size, ws_size); grid = -1; return; }
        int dev = 0, cus = 0, per_cu = 0;
        if (hipGetDevice(&dev) != hipSuccess || hipDeviceGetAttribute(&cus, hipDeviceAttributeMultiprocessorCount, dev) != hipSuccess) { grid = -1; return; }
        if (hipFuncSetAttribute((const void*)fwd_kernel, hipFuncAttributeMaxDynamicSharedMemorySize, LDS_BYTES) != hipSuccess) { fprintf(stderr, "kernel_launch: hipFuncSetAttribute failed\n"); grid = -1; return; }
        if (hipOccupancyMaxActiveBlocksPerMultiprocessor(&per_cu, (const void*)fwd_kernel, NWAVES * 64, LDS_BYTES) != hipSuccess || per_cu < 1) fprintf(stderr, "kernel_launch: occupancy query reports %d\n", per_cu);
        (void)hipGetLastError();
        grid = cus;
        if (grid != 256) { fprintf(stderr, "kernel_launch: built for 256 CUs, device has %d; nothing launched\n", cus); grid = -1; return; }
    }
    if (grid < 0) return;
    if (hipMemsetAsync((char*)d_ws + WS_CTL, 0, CTL_ZERO_BYTES, stream) != hipSuccess) return;
    Args a{};
    for (int i = 0; i < 25; ++i) a.in[i] = (const float*)d_in[i];
    a.out = (float*)d_out; a.ws = (unsigned char*)d_ws;
#if MK_PER_PHASE
    for (int p = 0; p < N_PHASES; ++p) { a.ph_lo = p; a.ph_hi = p + 1; hipLaunchKernelGGL(fwd_kernel, dim3(grid), dim3(NWAVES * 64), LDS_BYTES, stream, a); }
#else
    a.ph_lo = 0; a.ph_hi = N_PHASES;
    hipLaunchKernelGGL(fwd_kernel, dim3(grid), dim3(NWAVES * 64), LDS_BYTES, stream, a);
#endif
}
```

```cpp
#include <hip/hip_runtime.h>
#include <hip/hip_bf16.h>
#include <cstdio>
#include <cstdint>
#include <cmath>

#ifndef REP_PHASE
#define REP_PHASE 0
#endif
#define PROBE_BEGIN(id) do { if ((REP_PHASE) == 100 + (id) && blockIdx.x == 0) { __syncthreads(); if (F.wave == 0 && lane_id_() == 0) { const unsigned long long t_ = __builtin_amdgcn_s_memrealtime(); PRB[2] = (unsigned)t_; PRB[3] = (unsigned)(t_ >> 32); } } } while (0)
#define PROBE_END(id) do { if ((REP_PHASE) == 100 + (id) && blockIdx.x == 0) { __syncthreads(); if (F.wave == 0 && lane_id_() == 0) { const unsigned long long t_ = __builtin_amdgcn_s_memrealtime() - (((unsigned long long)PRB[3] << 32) | PRB[2]); const unsigned long long a_ = ((((unsigned long long)PRB[1]) << 32) | PRB[0]) + t_; PRB[0] = (unsigned)a_; PRB[1] = (unsigned)(a_ >> 32); } } } while (0)
constexpr int BATCH = 8, SEQ = 4096, DM = 1024, NTOK = BATCH * SEQ, DEPTH = 2;
constexpr int P_TOTAL = 6344, PS = 2304;
constexpr int C_POOL = 0, C_FQ = 256, C_FK = 512, C_FV = 768, C_DQ = 1024, C_IQ = 1280, C_CONV = 1536, C_DK = 2048, C_DV = 2112, C_IK = 2176, C_FF = 2240, C_IW = 2244;
constexpr float LN_EPS = 1e-5f;
constexpr float ALPHA = 1.4142135623730951f;
constexpr float LOG2E = 1.4426950408889634f;
constexpr int NWAVES = 8;
constexpr int NCLS = 24;
constexpr int MAXTILES = NTOK / 256 + NCLS;

constexpr size_t MiB = 1u << 20;
constexpr size_t WS_CTL = 0, CTL_ZERO_BYTES = 1 * MiB;
constexpr size_t WS_FW = 1 * MiB;
constexpr size_t WS_BIAS2 = 2 * MiB;
constexpr size_t WS_LIST = 3 * MiB;
constexpr size_t WS_GWL = 6 * MiB;
constexpr size_t WS_SELW = 12 * MiB;
constexpr size_t WS_HB8 = 28 * MiB;
constexpr size_t WS_W = 60 * MiB;
constexpr size_t W_SM = 0, W_GT = 4718592, W_BR = W_GT + 8 * MiB, W_OUT = W_BR + 2 * MiB, W_GU = W_OUT + 2 * MiB, W_D = W_GU + 32 * MiB, W_LAYER = W_D + 16 * MiB;
constexpr size_t WS_HB = 190 * MiB;
constexpr size_t WS_R1 = 254 * MiB;
constexpr size_t WS_R2 = 398 * MiB;
constexpr size_t WS_KIDX = 474 * MiB;
constexpr size_t WS_END = 478 * MiB;
static_assert(WS_W + 2 * W_LAYER <= WS_HB && WS_R1 + (size_t)NTOK * PS * 2 <= WS_R2 && WS_R2 + (size_t)MAXTILES * 256 * DM * 2 <= WS_END, "d_ws map");
constexpr int CW_BAR = 4096;
constexpr int CW_SEAMC = 8192;
constexpr int CW_CNT = 16384;

constexpr int RING_OFF = 0, RING_BYTES = 131072;
constexpr int LDSCTL_OFF = RING_BYTES, MISC_OFF = LDSCTL_OFF + 320;
constexpr int LDS_BYTES = 147456;

#define GAS __attribute__((address_space(1)))
#define LAS __attribute__((address_space(3)))
typedef unsigned short bf16;
typedef unsigned v4u __attribute__((ext_vector_type(4)));
typedef unsigned v2u __attribute__((ext_vector_type(2)));
typedef float f32x4 __attribute__((ext_vector_type(4)));
typedef float f32x16 __attribute__((ext_vector_type(16)));
typedef short bf16x8 __attribute__((ext_vector_type(8)));
typedef GAS unsigned gu32;
#define RLX_AGENT __ATOMIC_RELAXED, __HIP_MEMORY_SCOPE_AGENT
#define LDS_WAIT() asm volatile("s_waitcnt lgkmcnt(0)" ::: "memory")
#define VM_WAIT() asm volatile("s_waitcnt vmcnt(0)" ::: "memory")
__device__ __forceinline__ int opaque_i(int x) { asm volatile("" : "+v"(x)); return x; }
__device__ __forceinline__ int lane_id_() { int x; asm volatile("v_mbcnt_lo_u32_b32 %0, -1, 0\n\tv_mbcnt_hi_u32_b32 %0, -1, %0" : "=v"(x)); return x; }
__device__ __forceinline__ float zero_() { int z = 0; asm volatile("" : "+v"(z)); return __builtin_bit_cast(float, z); }
__device__ __forceinline__ int opaque_s(int x) { asm volatile("" : "+s"(x)); return x; }
__device__ __forceinline__ unsigned f2bf(float f) { unsigned u = __builtin_bit_cast(unsigned, f); return (u + 0x7fffu + ((u >> 16) & 1u)) >> 16; }
__device__ __forceinline__ unsigned pk2(float lo, float hi) { return f2bf(lo) | (f2bf(hi) << 16); }
__device__ __forceinline__ unsigned pk4_fp8(float a, float b, float c, float d) { int r = __builtin_amdgcn_cvt_pk_fp8_f32(a, b, 0, false); r = __builtin_amdgcn_cvt_pk_fp8_f32(c, d, r, true); return (unsigned)r; }
__device__ __forceinline__ float bfl(unsigned w) { return __uint_as_float(w << 16); }
__device__ __forceinline__ float bfh(unsigned w) { return __uint_as_float(w & 0xffff0000u); }
__device__ __forceinline__ float bf1(bf16 h) { return __uint_as_float((unsigned)h << 16); }
__device__ __forceinline__ float sigmoidf_(float x) { return __builtin_amdgcn_rcpf(1.f + __builtin_amdgcn_exp2f(-x * LOG2E)); }

#define XB_TMO      128
#define XB_XCNT(j)  (256  + 64 * (j))
#define XB_XSUB(j)  (1280 + 64 * (j))
#define XB_XGEN(j)  (2304 + 64 * (j))
#define XB_TOP      3328
#define XB_TOPGEN   3392
#define XCD_BAR_WORDS 3456
#define XB_SPIN_CAP (1u << 18)
__device__ __forceinline__ unsigned xb_ld(unsigned* p)              { return __hip_atomic_load(p, __ATOMIC_RELAXED, __HIP_MEMORY_SCOPE_AGENT); }
__device__ __forceinline__ unsigned xb_add(unsigned* p, unsigned v) { return __hip_atomic_fetch_add(p, v, __ATOMIC_RELAXED, __HIP_MEMORY_SCOPE_AGENT); }
__device__ __forceinline__ unsigned xb_xcc_id() { return (unsigned)__builtin_amdgcn_s_getreg((3 << 11) | 20) & 0xFu; }
#define XB_SPIN(cond, bar) do { unsigned _sp = 0; while (cond) { __builtin_amdgcn_s_sleep(1); \
    if ((++_sp & 255u) == 0u) { if (xb_ld(&(bar)[XB_TMO])) break; if (_sp > XB_SPIN_CAP) { atomicAdd(&(bar)[XB_TMO], 1u); break; } } } } while (0)
struct XcdBarrier { unsigned* bar; unsigned x; volatile LAS unsigned* st; };
__device__ __forceinline__ XcdBarrier xcd_barrier_post(unsigned* bar, volatile LAS unsigned* st) {
    XcdBarrier b; b.bar = bar; b.x = xb_xcc_id(); b.st = st;
    if (threadIdx.x == 0) (void)xb_add(&bar[XB_XCNT(b.x)], 1u);
    return b;
}
__device__ __forceinline__ void xcd_barrier_complete(unsigned* bar, unsigned x, unsigned& nloc, unsigned& nx) {
    const unsigned G = gridDim.x * gridDim.y * gridDim.z;
    unsigned sum, cnt, mine, sp = 0u;
    for (;;) {
        sum = 0u; cnt = 0u; mine = 0u;
#pragma unroll
        for (unsigned j = 0; j < 16; ++j) { const unsigned c = xb_ld(&bar[XB_XCNT(j)]); sum += c; cnt += (c > 0u) ? 1u : 0u; mine = (j == x) ? c : mine; }
        if (sum == G) break;
        __builtin_amdgcn_s_sleep(1);
        if ((++sp & 255u) == 0u) { if (xb_ld(&bar[XB_TMO])) break; if (sp > XB_SPIN_CAP) { atomicAdd(&bar[XB_TMO], 1u); break; } }
    }
    nloc = mine > 0u ? mine : 1u; nx = cnt > 0u ? cnt : 1u;
}
__device__ __forceinline__ void xcd_barrier(const XcdBarrier& b, int wave) {
    asm volatile("s_waitcnt vmcnt(0)" ::: "memory");
    __syncthreads();
    if (wave == 0 && lane_id_() == 0) {
        unsigned* bar = b.bar; const unsigned bx = (unsigned)opaque_s((int)xb_xcc_id());
        __builtin_amdgcn_s_waitcnt(0);
        unsigned nloc = b.st[0], nx = b.st[1];
        if (nloc == 0u) { xcd_barrier_complete(bar, bx, nloc, nx); b.st[0] = nloc; b.st[1] = nx; }
        const unsigned old = xb_add(&bar[XB_XSUB(bx)], 1u);
        const unsigned gen = old / nloc;
        if (old + 1u == (gen + 1u) * nloc) {
            __builtin_amdgcn_fence(__ATOMIC_RELEASE, "agent");
            asm volatile("s_waitcnt vmcnt(0)" ::: "memory");
            const unsigned og = xb_add(&bar[XB_TOP], 1u);
            const unsigned tg = og / nx;
            if (og + 1u == (tg + 1u) * nx) xb_add(&bar[XB_TOPGEN], 1u);
            else XB_SPIN(xb_ld(&bar[XB_TOPGEN]) == tg, bar);
            __builtin_amdgcn_fence(__ATOMIC_ACQUIRE, "agent");
            xb_add(&bar[XB_XGEN(bx)], 1u);
            asm volatile("s_waitcnt vmcnt(0)" ::: "memory");
        } else {
            XB_SPIN(xb_ld(&bar[XB_XGEN(bx)]) == gen, bar);
            __builtin_amdgcn_fence(__ATOMIC_ACQUIRE, "agent");
            asm volatile("s_waitcnt vmcnt(0)" ::: "memory");
        }
    }
    __syncthreads();
}
namespace pg8 {
#define PG8_LAS __attribute__((address_space(3)))
typedef unsigned short bf16_t;
typedef short bf16x8 __attribute__((ext_vector_type(8)));
typedef float f32x4 __attribute__((ext_vector_type(4)));
typedef float f32x2 __attribute__((ext_vector_type(2)));
typedef unsigned u32x4 __attribute__((ext_vector_type(4)));
typedef unsigned u32x2 __attribute__((ext_vector_type(2)));
constexpr int BM = 256, BK = 64, HALF = 128, HTB = HALF * BK * 2  , STAGE_BYTES = 8 * HTB, NXCD = 8, WGM = 8;
constexpr int LD = 1024;
constexpr size_t ROWB = 2048;
constexpr size_t HSTEP = (size_t)HALF * ROWB;
constexpr size_t TSTEP = 2 * HSTEP;

__host__ __device__ __forceinline__ int lds_byte(int r, int c) { const int st = (r >> 4) * 2 + (c >> 5), rr = r & 15, cc = c & 31, ob = rr * 64 + cc * 2; return st * 1024 + (ob ^ (((ob >> 9) & 1) << 5)); }
__host__ __device__ __forceinline__ void stage_rc(int b, int& R, int& C) { const int st = b / 1024, sb = b % 1024, swz = sb ^ (((sb >> 9) & 1) << 5); R = (st >> 1) * 16 + swz / 64; C = (st & 1) * 32 + (swz % 64) / 2; }
__host__ __device__ __forceinline__ int perm32(int rho) { const int n = rho >> 4, i = rho & 15; return 8 * (i >> 2) + 4 * n + (i & 3); }

struct GU {
    const char* A;
    const char* B0;
    const char* B1;
    int nt, ks;
    const int* rows;
    int rbase, rcnt;
    int pm, pn, a0, a1;
};

__device__ __forceinline__ unsigned cvt_pk_bf16(float lo, float hi) { unsigned r; asm volatile("v_cvt_pk_bf16_f32 %0, %1, %2" : "=v"(r) : "v"(lo), "v"(hi)); return r; }
__device__ __forceinline__ float bf_lo(unsigned w) { return __uint_as_float(w << 16); }
__device__ __forceinline__ float bf_hi(unsigned w) { return __uint_as_float(w & 0xffff0000u); }

template <class Epi, class Sched, bool GATHER>
__device__ __forceinline__ void gemm_phase(PG8_LAS unsigned char* lds, PG8_LAS unsigned* xlds  , const int wid_in  , const Sched& S, Epi& E) {
    const int wid = opaque_s(wid_in), lane = lane_id_(), tid = wid * 64 + lane, wr = wid >> 2, wc = wid & 3, fr = lane & 15, fq = lane >> 4;
    unsigned voffB[2], vA[2][2];
#pragma unroll
    for (int i = 0; i < 2; ++i) { int R, C; stage_rc(tid * 16 + i * 8192, R, C); const int Rb = Epi::PERM ? ((R & ~31) + perm32(R & 31)) : R;
        voffB[i] = (unsigned)(Rb * LD + C) * 2u;
        vA[0][i] = (unsigned)(R * LD + C) * 2u; vA[1][i] = vA[0][i]; }
    const size_t kstep = (size_t)(BK * 2);
    const unsigned ldsw = (unsigned)wid * 1024u;
    const int aoff = lds_byte(wr * 64 + fr, fq * 8), boff = lds_byte(wc * 32 + fr, fq * 8);
#define PG8_SA(b, h) (((b) * 2 + (h)) * HTB)
#define PG8_SB(b, h) ((4 + (b) * 2 + (h)) * HTB)
#define PG8_STAGE(bufoff, gbase, voff) do { _Pragma("unroll") for (int _i = 0; _i < 2; ++_i) \
        __builtin_amdgcn_global_load_lds((const unsigned*)((const char*)(gbase) + (voff)[_i]), (PG8_LAS unsigned*)(lds + (bufoff) + ldsw + _i * 8192), 16, 0, 0); } while (0)
#define PG8_STAGEA(bufoff, gbase, h) do { if constexpr (GATHER) { PG8_STAGE(bufoff, gbase, vA[h]); } else { PG8_STAGE(bufoff, (gbase) + (h) * HSTEP, vA[0]); } } while (0)
#define PG8_LDA(dst, b, h) do { _Pragma("unroll") for (int m = 0; m < 4; ++m) _Pragma("unroll") for (int k = 0; k < 2; ++k) dst[m][k] = *(const PG8_LAS bf16x8*)(lds + PG8_SA(b, h) + aoff + m * 2048 + k * 1024); } while (0)
#define PG8_LDB(dst, b, h) do { _Pragma("unroll") for (int n = 0; n < 2; ++n) _Pragma("unroll") for (int k = 0; k < 2; ++k) dst[n][k] = *(const PG8_LAS bf16x8*)(lds + PG8_SB(b, h) + boff + n * 2048 + k * 1024); } while (0)
#define PG8_MMA(ai, bj, At, Bt) do { __builtin_amdgcn_s_setprio(1); _Pragma("unroll") for (int m = 0; m < 4; ++m) _Pragma("unroll") for (int n = 0; n < 2; ++n) _Pragma("unroll") for (int k = 0; k < 2; ++k) \
        acc[ai][bj][m][n] = __builtin_amdgcn_mfma_f32_16x16x32_bf16(Bt[n][k], At[m][k], acc[ai][bj][m][n], 0, 0, 0); __builtin_amdgcn_s_setprio(0); } while (0)
#define PG8_WAIT_V(n) asm volatile("s_waitcnt vmcnt(" #n ")" ::: "memory")
#define PG8_WAIT_L(n) asm volatile("s_waitcnt lgkmcnt(" #n ")" ::: "memory")
#define PG8_BAR __builtin_amdgcn_s_barrier()
#define PG8_SCHED __builtin_amdgcn_sched_barrier(0)
#define PG8_BP(u, tau) ((tau) < (u).ks ? (u).B0 + (size_t)(tau) * kstep : (u).B1 + (size_t)((tau) - (u).ks) * kstep)
#define PG8_GATHER_OFFS(dst, u) do { if constexpr (GATHER) { _Pragma("unroll") for (int _h = 0; _h < 2; ++_h) _Pragma("unroll") for (int _i = 0; _i < 2; ++_i) { \
        int _R, _C; stage_rc((wid * 64 + lane_id_()) * 16 + _i * 8192, _R, _C); int _p = (u).rbase + _h * HALF + _R; _p = _p < (u).rcnt ? _p : (u).rcnt - 1; dst[_h][_i] = (unsigned)(u).rows[_p] * (unsigned)ROWB + (unsigned)_C * 2u; } } } while (0)
    GU cur, nxt; int ui = 0;
    if (!S.next(0, cur)) return;
    f32x4 acc[2][2][4][2];
#pragma unroll
    for (int a = 0; a < 2; ++a)
#pragma unroll
        for (int b = 0; b < 2; ++b)
#pragma unroll
            for (int m = 0; m < 4; ++m)
#pragma unroll
                for (int n = 0; n < 2; ++n) { const float z_ = zero_(); acc[a][b][m][n] = (f32x4){z_, z_, z_, z_}; }
    bf16x8 At[4][2], B0[2][2], B1[2][2];
    PG8_GATHER_OFFS(vA, cur);
    const char* cA = cur.A;
    { const char* b0 = PG8_BP(cur, 0); const char* b1 = PG8_BP(cur, 1);
      PG8_STAGE(PG8_SB(0, 0), b0, voffB); PG8_STAGE(PG8_SB(0, 1), b0 + HSTEP, voffB); PG8_STAGEA(PG8_SA(0, 0), cA, 0); PG8_STAGEA(PG8_SA(0, 1), cA, 1);
      if (wr == 1) PG8_BAR;
      PG8_WAIT_V(2); PG8_BAR;
      PG8_STAGE(PG8_SB(1, 0), b1, voffB); PG8_STAGEA(PG8_SA(1, 0), cA + kstep, 0); PG8_STAGE(PG8_SB(1, 1), b1 + HSTEP, voffB);
      PG8_WAIT_V(6); PG8_BAR; }
    for (;;) {
        const bool has_next = S.next(ui + 1, nxt);
        if (!has_next) nxt = cur;
        if constexpr (GATHER) { unsigned vn[2][2];
#pragma unroll
            for (int h = 0; h < 2; ++h)
#pragma unroll
                for (int i = 0; i < 2; ++i) vn[h][i] = vA[h][i];
            if (has_next) { PG8_GATHER_OFFS(vn, nxt); }
#pragma unroll
            for (int h = 0; h < 2; ++h)
#pragma unroll
                for (int i = 0; i < 2; ++i) xlds[(h * 2 + i) * 512 + tid] = vn[h][i]; }
        const char* nA = nxt.A;
        const int nt = cur.nt;
        for (int t = 0; t < nt; t += 2) {
            const bool last = (t == nt - 2);
            const char* a1 = cA + (size_t)(t + 1) * kstep;
            const char* a2 = last ? nA : cA + (size_t)(t + 2) * kstep;
            const char* b2 = last ? PG8_BP(nxt, 0) : PG8_BP(cur, t + 2);
            const char* a3 = a2 + kstep; const char* b3 = b2 + kstep;
            PG8_LDB(B0, 0, 0); PG8_LDB(B1, 0, 1); PG8_SCHED; PG8_LDA(At, 0, 0); PG8_STAGEA(PG8_SA(1, 1), a1, 1);
            if constexpr (GATHER) { if (last) {
#pragma unroll
                for (int h = 0; h < 2; ++h)
#pragma unroll
                    for (int i = 0; i < 2; ++i) vA[h][i] = xlds[(h * 2 + i) * 512 + tid]; } }
            PG8_WAIT_V(8); PG8_WAIT_L(0); PG8_BAR; PG8_MMA(0, 0, At, B0); PG8_MMA(0, 1, At, B1); PG8_BAR; PG8_SCHED;
            PG8_LDA(At, 0, 1); PG8_STAGE(PG8_SB(0, 0), b2, voffB); PG8_STAGE(PG8_SB(0, 1), b2 + HSTEP, voffB); PG8_STAGEA(PG8_SA(0, 0), a2, 0);
            PG8_WAIT_V(8); PG8_WAIT_L(0); PG8_BAR; PG8_MMA(1, 0, At, B0); PG8_MMA(1, 1, At, B1); PG8_BAR; PG8_SCHED;
            PG8_LDB(B0, 1, 0); PG8_LDB(B1, 1, 1); PG8_SCHED; PG8_LDA(At, 1, 0); PG8_STAGEA(PG8_SA(0, 1), a2, 1);
            PG8_WAIT_V(8); PG8_WAIT_L(0); PG8_BAR; PG8_MMA(0, 0, At, B0); PG8_MMA(0, 1, At, B1); PG8_BAR; PG8_SCHED;
            PG8_LDA(At, 1, 1); PG8_STAGE(PG8_SB(1, 0), b3, voffB); PG8_STAGE(PG8_SB(1, 1), b3 + HSTEP, voffB); PG8_STAGEA(PG8_SA(1, 0), a3, 0);
            PG8_WAIT_V(8); PG8_WAIT_L(0); PG8_BAR; PG8_MMA(1, 0, At, B0); PG8_MMA(1, 1, At, B1); PG8_BAR; PG8_SCHED;
        }
        if (wr == 0) PG8_BAR;
        E(acc, cur, wr, wc, fr, fq);
        if (!has_next) break;
#pragma unroll
        for (int a = 0; a < 2; ++a)
#pragma unroll
            for (int b = 0; b < 2; ++b)
#pragma unroll
                for (int m = 0; m < 4; ++m)
#pragma unroll
                    for (int n = 0; n < 2; ++n) { const float z_ = zero_(); acc[a][b][m][n] = (f32x4){z_, z_, z_, z_}; }
        cur = nxt; cA = nA; ++ui;
        if (wr == 1) PG8_BAR;
    }
    PG8_WAIT_V(0);
    PG8_BAR;
#undef PG8_SA
#undef PG8_SB
#undef PG8_STAGE
#undef PG8_STAGEA
#undef PG8_LDA
#undef PG8_LDB
#undef PG8_MMA
#undef PG8_WAIT_V
#undef PG8_WAIT_L
#undef PG8_BAR
#undef PG8_SCHED
#undef PG8_BP
#undef PG8_GATHER_OFFS
}

template <class Epi, class Sched>
__device__ __forceinline__ void gemm_phase_n128(PG8_LAS unsigned char* lds, const int wid_in, const Sched& S, Epi& E) {
    const int wid = opaque_s(wid_in), lane = lane_id_(), tid = wid * 64 + lane, wr = wid >> 2, wc = wid & 3, fr = lane & 15, fq = lane >> 4;
    unsigned voffB[2], voffA[2];
#pragma unroll
    for (int i = 0; i < 2; ++i) { int R, C; stage_rc(tid * 16 + i * 8192, R, C); const int Rb = (R & ~31) + perm32(R & 31);
        voffB[i] = (unsigned)(Rb * LD + C) * 2u; voffA[i] = (unsigned)(R * LD + C) * 2u; }
    const size_t kstep = (size_t)(BK * 2);
    const unsigned ldsw = (unsigned)wid * 1024u;
    const int aoff = lds_byte(wr * 64 + fr, fq * 8), boff = lds_byte(wc * 32 + fr, fq * 8);
#define PG8_SA(b, h) (((b) * 2 + (h)) * HTB)
#define PG8_SB(b, h) ((4 + (b) * 2 + (h)) * HTB)
#define PG8_STAGE(bufoff, gbase, voff) do { _Pragma("unroll") for (int _i = 0; _i < 2; ++_i) \
        __builtin_amdgcn_global_load_lds((const unsigned*)((const char*)(gbase) + (voff)[_i]), (PG8_LAS unsigned*)(lds + (bufoff) + ldsw + _i * 8192), 16, 0, 0); } while (0)
#define PG8_LDA(dst, b, h) do { _Pragma("unroll") for (int m = 0; m < 4; ++m) _Pragma("unroll") for (int k = 0; k < 2; ++k) dst[m][k] = *(const PG8_LAS bf16x8*)(lds + PG8_SA(b, h) + aoff + m * 2048 + k * 1024); } while (0)
#define PG8_LDB(dst, b, h) do { _Pragma("unroll") for (int n = 0; n < 2; ++n) _Pragma("unroll") for (int k = 0; k < 2; ++k) dst[n][k] = *(const PG8_LAS bf16x8*)(lds + PG8_SB(b, h) + boff + n * 2048 + k * 1024); } while (0)
#define PG8_MMA(ai, At, Bt) do { __builtin_amdgcn_s_setprio(1); _Pragma("unroll") for (int m = 0; m < 4; ++m) _Pragma("unroll") for (int n = 0; n < 2; ++n) _Pragma("unroll") for (int k = 0; k < 2; ++k) \
        acc[ai][m][n] = __builtin_amdgcn_mfma_f32_16x16x32_bf16(Bt[n][k], At[m][k], acc[ai][m][n], 0, 0, 0); __builtin_amdgcn_s_setprio(0); } while (0)
#define PG8_WAIT_V(n) asm volatile("s_waitcnt vmcnt(" #n ")" ::: "memory")
#define PG8_WAIT_L(n) asm volatile("s_waitcnt lgkmcnt(" #n ")" ::: "memory")
#define PG8_BAR __builtin_amdgcn_s_barrier()
#define PG8_SCHED __builtin_amdgcn_sched_barrier(0)
    GU cur, nxt; int ui = 0;
    if (!S.next(0, cur)) return;
    f32x4 acc[2][4][2];
#pragma unroll
    for (int a = 0; a < 2; ++a)
#pragma unroll
        for (int m = 0; m < 4; ++m)
#pragma unroll
            for (int n = 0; n < 2; ++n) { const float z_ = zero_(); acc[a][m][n] = (f32x4){z_, z_, z_, z_}; }
    bf16x8 At[4][2], B0[2][2];
    u32x4 st_u[2][4], st_s[2][4];
    const char* cA = cur.A; const char* cB = cur.B0;
    PG8_STAGE(PG8_SB(0, 0), cB, voffB); PG8_STAGE(PG8_SA(0, 0), cA, voffA); PG8_STAGE(PG8_SA(0, 1), cA + HSTEP, voffA);
    if (wr == 1) PG8_BAR;
    PG8_WAIT_V(2); PG8_BAR;
    PG8_STAGE(PG8_SB(1, 0), cB + kstep, voffB); PG8_STAGE(PG8_SA(1, 0), cA + kstep, voffA);
    PG8_WAIT_V(4); PG8_BAR;
    for (;;) {
        const bool has_next = S.next(ui + 1, nxt);
        if (!has_next) nxt = cur;
        const char* nA = nxt.A; const char* nB = nxt.B0;
        const int nt = cur.nt;
        for (int t = 0; t < nt; t += 2) {
            const bool last = (t == nt - 2);
            const char* a1 = cA + (size_t)(t + 1) * kstep;
            const char* a2 = last ? nA : cA + (size_t)(t + 2) * kstep;
            const char* b2 = last ? nB : cB + (size_t)(t + 2) * kstep;
            const char* a3 = a2 + kstep; const char* b3 = b2 + kstep;
            PG8_LDB(B0, 0, 0); PG8_SCHED; PG8_LDA(At, 0, 0); PG8_STAGE(PG8_SA(1, 1), a1 + HSTEP, voffA);
            PG8_WAIT_V(6); PG8_WAIT_L(0); PG8_BAR; PG8_MMA(0, At, B0); PG8_BAR; PG8_SCHED;
            PG8_LDA(At, 0, 1); PG8_STAGE(PG8_SB(0, 0), b2, voffB); PG8_STAGE(PG8_SA(0, 0), a2, voffA);
            PG8_WAIT_V(6); PG8_WAIT_L(0); PG8_BAR; PG8_MMA(1, At, B0); PG8_BAR; PG8_SCHED;
            PG8_LDB(B0, 1, 0); PG8_SCHED; PG8_LDA(At, 1, 0); PG8_STAGE(PG8_SA(0, 1), a2 + HSTEP, voffA);
            PG8_WAIT_V(6); PG8_WAIT_L(0); PG8_BAR; PG8_MMA(0, At, B0); PG8_BAR; PG8_SCHED;
            PG8_LDA(At, 1, 1); PG8_STAGE(PG8_SB(1, 0), b3, voffB); PG8_STAGE(PG8_SA(1, 0), a3, voffA);
            PG8_WAIT_V(6); PG8_WAIT_L(0); PG8_BAR; PG8_MMA(1, At, B0); PG8_BAR; PG8_SCHED;
        }
        if (wr == 0) PG8_BAR;
        E(acc, st_u, st_s, cur, wr, wc, fr, fq);
        if (!has_next) break;
#pragma unroll
        for (int a = 0; a < 2; ++a)
#pragma unroll
            for (int m = 0; m < 4; ++m)
#pragma unroll
                for (int n = 0; n < 2; ++n) { const float z_ = zero_(); acc[a][m][n] = (f32x4){z_, z_, z_, z_}; }
        cur = nxt; cA = nA; cB = nB; ++ui;
        if (wr == 1) PG8_BAR;
    }
    PG8_WAIT_V(0);
    PG8_BAR;
#undef PG8_SA
#undef PG8_SB
#undef PG8_STAGE
#undef PG8_LDA
#undef PG8_LDB
#undef PG8_MMA
#undef PG8_WAIT_V
#undef PG8_WAIT_L
#undef PG8_BAR
#undef PG8_SCHED
}
__device__ __forceinline__ void glds16_s(const char* sbase, unsigned voff, unsigned lds_dst) { unsigned keep;
    asm volatile("s_mov_b32 %0, m0\n\ts_mov_b32 m0, %3\n\ts_nop 0\n\tglobal_load_lds_dwordx4 %1, %2\n\ts_mov_b32 m0, %0" : "=&s"(keep) : "v"(voff), "s"(sbase), "s"(lds_dst) : "memory"); }
typedef int v8i_t __attribute__((ext_vector_type(8)));
typedef int v4i_t __attribute__((ext_vector_type(4)));
__device__ __forceinline__ v8i_t cat8(bf16x8 lo, bf16x8 hi) { const v4i_t a = __builtin_bit_cast(v4i_t, lo), b = __builtin_bit_cast(v4i_t, hi); return __builtin_shufflevector(a, b, 0, 1, 2, 3, 4, 5, 6, 7); }
template <class Epi, class Sched>
__device__ __forceinline__ void gemm_phase_c8(PG8_LAS unsigned char* lds, const int wid_in, const Sched& S, Epi& E) {
    const int wid = opaque_s(wid_in), lane = lane_id_(), tid = wid * 64 + lane, wr = wid >> 2, wc = wid & 3, fr = lane & 15, fq = lane >> 4;
    unsigned voffB[2], voffA[2];
#pragma unroll
    for (int i = 0; i < 2; ++i) { int R, C; stage_rc(tid * 16 + i * 8192, R, C); const int Rb = (R & ~31) + perm32(R & 31);
        voffB[i] = (unsigned)(Rb * LD + C) * 2u; voffA[i] = (unsigned)(R * LD + C) * 2u; }
    const size_t kstep = (size_t)(BK * 2);
    const unsigned ldsb = (unsigned)__builtin_amdgcn_readfirstlane((int)((unsigned)(size_t)lds + (unsigned)wid * 1024u));
    const int aoff = lds_byte(wr * 64 + fr, fq * 8), boff = lds_byte(wc * 32 + fr, fq * 8);
    const int aoff8 = lds_byte(wr * 64 + fr, 16 * fq), boff8 = lds_byte(wc * 32 + fr, 16 * fq);
#define PG8_SA(b, h) (((b) * 2 + (h)) * HTB)
#define PG8_SB(b, h) ((4 + (b) * 2 + (h)) * HTB)
#define PG8_STAGE(bufoff, gbase, voff) do { _Pragma("unroll") for (int _i = 0; _i < 2; ++_i) glds16_s((const char*)(gbase), (voff)[_i], ldsb + (unsigned)((bufoff) + _i * 8192)); } while (0)
#define PG8_STAGE8(bufoff, gbase, voff) do { _Pragma("unroll") for (int _i = 0; _i < 2; ++_i) { const unsigned _v = ((voff)[_i] + ((voff)[_i] & 2047u)) >> 1; glds16_s((const char*)(gbase), _v, ldsb + (unsigned)((bufoff) + _i * 8192)); } } while (0)
#define PG8_STB(bufoff, gbase, f8) do { if (f8) { PG8_STAGE8(bufoff, gbase, voffB); } else { PG8_STAGE(bufoff, gbase, voffB); } } while (0)
#define PG8_STA(bufoff, gbase, h, f8) do { if (f8) { PG8_STAGE8(bufoff, (gbase) + (h) * (HSTEP / 2), voffA); } else { PG8_STAGE(bufoff, (gbase) + (h) * HSTEP, voffA); } } while (0)
#define PG8_LDA(dst, b, h) do { _Pragma("unroll") for (int m = 0; m < 4; ++m) _Pragma("unroll") for (int k = 0; k < 2; ++k) dst[m][k] = *(const PG8_LAS bf16x8*)(lds + PG8_SA(b, h) + aoff + m * 2048 + k * 1024); } while (0)
#define PG8_LDB(dst, b, h) do { _Pragma("unroll") for (int n = 0; n < 2; ++n) _Pragma("unroll") for (int k = 0; k < 2; ++k) dst[n][k] = *(const PG8_LAS bf16x8*)(lds + PG8_SB(b, h) + boff + n * 2048 + k * 1024); } while (0)
#define PG8_LDA8(dst, b, h) do { _Pragma("unroll") for (int m = 0; m < 4; ++m) _Pragma("unroll") for (int k = 0; k < 2; ++k) dst[m][k] = *(const PG8_LAS bf16x8*)(lds + PG8_SA(b, h) + aoff8 + m * 2048 + k * 16); } while (0)
#define PG8_LDB8(dst, b, h) do { _Pragma("unroll") for (int n = 0; n < 2; ++n) _Pragma("unroll") for (int k = 0; k < 2; ++k) dst[n][k] = *(const PG8_LAS bf16x8*)(lds + PG8_SB(b, h) + boff8 + n * 2048 + k * 16); } while (0)
#define PG8_MMA(ai, At, Bt) do { __builtin_amdgcn_s_setprio(1); _Pragma("unroll") for (int m = 0; m < 4; ++m) _Pragma("unroll") for (int n = 0; n < 2; ++n) _Pragma("unroll") for (int k = 0; k < 2; ++k) \
        acc[ai][m][n] = __builtin_amdgcn_mfma_f32_16x16x32_bf16(Bt[n][k], At[m][k], acc[ai][m][n], 0, 0, 0); __builtin_amdgcn_s_setprio(0); } while (0)
#define PG8_MMA8(ai, At, Bt) do { __builtin_amdgcn_s_setprio(1); _Pragma("unroll") for (int m = 0; m < 4; ++m) _Pragma("unroll") for (int n = 0; n < 2; ++n) \
        acc[ai][m][n] = __builtin_amdgcn_mfma_scale_f32_16x16x128_f8f6f4(cat8(Bt[n][0], Bt[n][1]), cat8(At[m][0], At[m][1]), acc[ai][m][n], 0, 0, 0, 0, 0, 0); __builtin_amdgcn_s_setprio(0); } while (0)
#define PG8_WAIT_V(n) asm volatile("s_waitcnt vmcnt(" #n ")" ::: "memory")
#define PG8_WAIT_L(n) asm volatile("s_waitcnt lgkmcnt(" #n ")" ::: "memory")
#define PG8_BAR __builtin_amdgcn_s_barrier()
#define PG8_SCHED __builtin_amdgcn_sched_barrier(0)
    GU cu, cg, nxt; int ui = 0;
    if (!S.next(0, cu)) return;
    f32x4 acc[2][4][2];
#define PG8_ZACC() do { _Pragma("unroll") for (int a = 0; a < 2; ++a) _Pragma("unroll") for (int m = 0; m < 4; ++m) _Pragma("unroll") for (int n = 0; n < 2; ++n) { const float z_ = zero_(); acc[a][m][n] = (f32x4){z_, z_, z_, z_}; } } while (0)
    PG8_ZACC();
    bf16x8 At[4][2], B0[2][2];
    u32x4 st_u[2][4], st_s[2][4];
    PG8_STB(PG8_SB(0, 0), cu.B0, false); PG8_STA(PG8_SA(0, 0), cu.A, 0, false); PG8_STA(PG8_SA(0, 1), cu.A, 1, false);
    if (wr == 1) PG8_BAR;
    PG8_WAIT_V(2); PG8_BAR;
    PG8_STB(PG8_SB(1, 0), cu.B0 + kstep, false); PG8_STA(PG8_SA(1, 0), cu.A + kstep, 0, false);
    PG8_WAIT_V(4); PG8_BAR;
#define PG8_KLOOP(LDA_, LDB_, MMA_, C8, N8, cA, cB, nA, nB, nt) \
        for (int t = 0; t < (nt); t += 2) { \
            const bool last = (t == (nt) - 2); \
            const char* a1 = (cA) + (size_t)(t + 1) * kstep; \
            const char* a2 = last ? (nA) : (cA) + (size_t)(t + 2) * kstep; \
            const char* b2 = last ? (nB) : (cB) + (size_t)(t + 2) * kstep; \
            const char* a3 = a2 + kstep; const char* b3 = b2 + kstep; \
            LDB_(B0, 0, 0); PG8_SCHED; LDA_(At, 0, 0); PG8_STA(PG8_SA(1, 1), a1, 1, C8); \
            PG8_WAIT_V(6); PG8_WAIT_L(0); PG8_BAR; MMA_(0, At, B0); PG8_BAR; PG8_SCHED; \
            if (last) { LDA_(At, 0, 1); PG8_STB(PG8_SB(0, 0), b2, N8); PG8_STA(PG8_SA(0, 0), a2, 0, N8); } else { LDA_(At, 0, 1); PG8_STB(PG8_SB(0, 0), b2, C8); PG8_STA(PG8_SA(0, 0), a2, 0, C8); } \
            PG8_WAIT_V(6); PG8_WAIT_L(0); PG8_BAR; MMA_(1, At, B0); PG8_BAR; PG8_SCHED; \
            if (last) { LDB_(B0, 1, 0); PG8_SCHED; LDA_(At, 1, 0); PG8_STA(PG8_SA(0, 1), a2, 1, N8); } else { LDB_(B0, 1, 0); PG8_SCHED; LDA_(At, 1, 0); PG8_STA(PG8_SA(0, 1), a2, 1, C8); } \
            PG8_WAIT_V(6); PG8_WAIT_L(0); PG8_BAR; MMA_(0, At, B0); PG8_BAR; PG8_SCHED; \
            if (last) { LDA_(At, 1, 1); PG8_STB(PG8_SB(1, 0), b3, N8); PG8_STA(PG8_SA(1, 0), a3, 0, N8); } else { LDA_(At, 1, 1); PG8_STB(PG8_SB(1, 0), b3, C8); PG8_STA(PG8_SA(1, 0), a3, 0, C8); } \
            PG8_WAIT_V(6); PG8_WAIT_L(0); PG8_BAR; MMA_(1, At, B0); PG8_BAR; PG8_SCHED; \
        }
    for (;;) {
        S.next(ui + 1, cg);
        PG8_KLOOP(PG8_LDA, PG8_LDB, PG8_MMA, false, true, cu.A, cu.B0, cg.A, cg.B0, cu.nt)
        if (wr == 0) PG8_BAR;
        { const int l2_ = lane_id_(); E(acc, st_u, st_s, cu, wr, wc, l2_ & 15, l2_ >> 4); }
        PG8_ZACC();
        if (wr == 1) PG8_BAR;
        const bool has_next = S.next(ui + 2, nxt);
        if (!has_next) { nxt.A = S.BRp; nxt.B0 = S.WBp; }
        PG8_KLOOP(PG8_LDA8, PG8_LDB8, PG8_MMA8, true, false, cg.A, cg.B0, nxt.A, nxt.B0, cg.nt)
        if (wr == 0) PG8_BAR;
        { const int l2_ = lane_id_(); E(acc, st_u, st_s, cg, wr, wc, l2_ & 15, l2_ >> 4); }
        if (!has_next) break;
        PG8_ZACC();
        cu = nxt; ui += 2;
        if (wr == 1) PG8_BAR;
    }
#undef PG8_KLOOP
#undef PG8_ZACC
    PG8_WAIT_V(0);
    PG8_BAR;
#undef PG8_SA
#undef PG8_SB
#undef PG8_STAGE
#undef PG8_STAGE8
#undef PG8_STB
#undef PG8_STA
#undef PG8_LDA
#undef PG8_LDB
#undef PG8_LDA8
#undef PG8_LDB8
#undef PG8_MMA
#undef PG8_MMA8
#undef PG8_WAIT_V
#undef PG8_WAIT_L
#undef PG8_BAR
#undef PG8_SCHED
}
}
namespace attn_body {
using bf16=__hip_bfloat16;
using bf16x8=__attribute__((ext_vector_type(8)))short;
using s16x4=__attribute__((ext_vector_type(4)))short;
using f32x16=__attribute__((ext_vector_type(16)))float;
using f32x4=__attribute__((ext_vector_type(4)))float;
using u32x4=__attribute__((ext_vector_type(4)))unsigned;
constexpr int SEQ=4096,D=64;
constexpr int KVP=2304;
constexpr int OP=1024;
constexpr int NW=8,QBLK=32,QB=QBLK*NW,KVBLK=64,NQB=SEQ/QB;
__device__ __forceinline__ int crow(int r,int hi){return (r&3)+8*(r>>2)+4*hi;}
#define SBAR() __builtin_amdgcn_sched_barrier(0)
__device__ __forceinline__ void cmask(f32x16&p0,f32x16&p1,int jb,int qrel,int hi){
  const float NEG=-INFINITY; int kb=64*jb+4*hi;
  #pragma unroll
  for(int r=0;r<16;++r){int kv=kb+(r&3)+8*(r>>2); if(kv>qrel)p0[r]=NEG; if(kv+32>qrel)p1[r]=NEG;}
}
__device__ __forceinline__ void bmask(f32x16&p0,f32x16&p1,unsigned long long w,int hi){
  const float NEG=-INFINITY; const unsigned lo=((unsigned)w)>>(4*hi), up=((unsigned)(w>>32))>>(4*hi);
  #pragma unroll
  for(int r=0;r<16;++r){const int bit=(r&3)+8*(r>>2); if(!((lo>>bit)&1u))p0[r]=NEG; if(!((up>>bit)&1u))p1[r]=NEG;}
}
constexpr int NSLOT=3, SLOTB=8192;
constexpr int LDS_K=0, LDS_V=NSLOT*SLOTB, LDS_WS=2*NSLOT*SLOTB, LDS_OST=LDS_WS+NW*64*4, LDS_BIAS=LDS_OST+NW*4096, LDS_BYTES=LDS_BIAS+SEQ*4;
constexpr float C2=0.125f*1.4426950408889634f;
__device__ __forceinline__ void glds16(const void*gsrc,unsigned lds_dst){unsigned keep;
  asm volatile("s_mov_b32 %0, m0\n\ts_mov_b32 m0, %2\n\ts_nop 0\n\tglobal_load_lds_dwordx4 %1, off\n\ts_mov_b32 m0, %0":"=&s"(keep):"v"(gsrc),"s"(lds_dst):"memory");}
__device__ __forceinline__ float max3f(float a,float b,float c){float r;asm("v_max3_f32 %0, %1, %2, %3":"=v"(r):"v"(a),"v"(b),"v"(c));return r;}
__device__ __forceinline__ float max2f(float a,float b){float r;asm("v_max_f32_e32 %0, %1, %2":"=v"(r):"v"(a),"v"(b));return r;}
__device__ __forceinline__ float fadd_s(float a,float b){float r;asm("v_add_f32_e32 %0, %1, %2":"=v"(r):"v"(a),"v"(b));return r;}
__device__ __forceinline__ float fsub_s(float a,float b){float r;asm("v_sub_f32_e32 %0, %1, %2":"=v"(r):"v"(a),"v"(b));return r;}
typedef float f32x2_t __attribute__((ext_vector_type(2))); typedef __bf16 bf16x2_t __attribute__((ext_vector_type(2)));
__device__ __forceinline__ unsigned cvtpk_s(float lo,float hi){f32x2_t v={lo,hi};bf16x2_t b=__builtin_convertvector(v,bf16x2_t);return __builtin_bit_cast(unsigned,b);}
#define WAIT_BAR(N) asm volatile("s_waitcnt vmcnt(" #N ") lgkmcnt(0)\n\ts_barrier":::"memory")

typedef __attribute__((address_space(3))) const char* lds_cptr;
typedef short v4i16_t __attribute__((ext_vector_type(4)));
__device__ __forceinline__ void binit(f32x16&p0,f32x16&p1,lds_cptr bp,float mhat){
  typedef float f2_ __attribute__((ext_vector_type(2))); const f2_ m2={mhat,mhat};
  #pragma unroll
  for(int g=0;g<4;++g){ const f32x4 a=*(const __attribute__((address_space(3))) f32x4*)(bp+g*32); const f32x4 b=*(const __attribute__((address_space(3))) f32x4*)(bp+128+g*32);
    const f2_ a0=(f2_){a[0],a[1]}-m2,a1=(f2_){a[2],a[3]}-m2,b0=(f2_){b[0],b[1]}-m2,b1=(f2_){b[2],b[3]}-m2;
    p0[4*g]=a0.x;p0[4*g+1]=a0.y;p0[4*g+2]=a1.x;p0[4*g+3]=a1.y; p1[4*g]=b0.x;p1[4*g+1]=b0.y;p1[4*g+2]=b1.x;p1[4*g+3]=b1.y; }
}
__device__ __forceinline__ void qkt(f32x16&p0,f32x16&p1,const char*Kslot,const bf16x8*qr,int r32,int hi){
  const char*kb=Kslot+hi*1024+r32*16;
  #pragma unroll
  for(int d0=0;d0<4;++d0){
    const bf16x8 b0=*reinterpret_cast<const bf16x8*>(kb+d0*2048);
    const bf16x8 b1=*reinterpret_cast<const bf16x8*>(kb+d0*2048+512);
    p0=__builtin_amdgcn_mfma_f32_32x32x16_bf16(b0,qr[d0],p0,0,0,0);p1=__builtin_amdgcn_mfma_f32_32x32x16_bf16(b1,qr[d0],p1,0,0,0);}
}
__device__ __forceinline__ void kload8(bf16x8*kf,lds_cptr kp){
  kf[0]=*(const __attribute__((address_space(3))) bf16x8*)(kp);      kf[1]=*(const __attribute__((address_space(3))) bf16x8*)(kp+512);
  kf[2]=*(const __attribute__((address_space(3))) bf16x8*)(kp+2048); kf[3]=*(const __attribute__((address_space(3))) bf16x8*)(kp+2560);
  kf[4]=*(const __attribute__((address_space(3))) bf16x8*)(kp+4096); kf[5]=*(const __attribute__((address_space(3))) bf16x8*)(kp+4608);
  kf[6]=*(const __attribute__((address_space(3))) bf16x8*)(kp+6144); kf[7]=*(const __attribute__((address_space(3))) bf16x8*)(kp+6656);
}
__device__ __forceinline__ void kload2(bf16x8*kf,lds_cptr kp,int j){ kf[2*j]=*(const __attribute__((address_space(3))) bf16x8*)(kp+j*2048); kf[2*j+1]=*(const __attribute__((address_space(3))) bf16x8*)(kp+j*2048+512); }
__device__ __forceinline__ s16x4 vtr(lds_cptr p){ return __builtin_bit_cast(s16x4,__builtin_amdgcn_ds_read_tr16_b64_v4i16((__attribute__((address_space(3))) v4i16_t*)p)); }
__device__ __forceinline__ float rowmax(const f32x16&p0,const f32x16&p1){
  float a=max3f(p0[0],p0[1],p1[0]),b=max3f(p0[2],p0[3],p1[1]);a=max3f(a,p1[2],p1[3]);
  #pragma unroll
  for(int r=4;r<16;r+=4){a=max3f(a,p0[r],p0[r+1]);b=max3f(b,p0[r+2],p0[r+3]);a=max3f(a,p1[r],p1[r+1]);b=max3f(b,p1[r+2],p1[r+3]);}
  const float m=max2f(a,b);
  auto rr=__builtin_amdgcn_permlane32_swap(__float_as_uint(m),__float_as_uint(m),false,false);
  return max2f(__uint_as_float(rr[0]),__uint_as_float(rr[1]));
}
__device__ __forceinline__ void pv(f32x16*o,int vb,bf16x8 pa0,bf16x8 pa1,bf16x8 pa2,bf16x8 pa3){
  #pragma unroll
  for(int d0=0;d0<2;++d0){s16x4 lo[4],hi[4];
    #pragma unroll
    for(int ks=0;ks<4;++ks){
      asm volatile("ds_read_b64_tr_b16 %0,%1 offset:%c2":"=&v"(lo[ks]):"v"(vb),"i"(d0*4096+ks*1024):"memory");
      asm volatile("ds_read_b64_tr_b16 %0,%1 offset:%c2":"=&v"(hi[ks]):"v"(vb),"i"(d0*4096+ks*1024+512):"memory");}
    asm volatile("s_waitcnt lgkmcnt(0)":::"memory");SBAR();
    #define PK(k) (bf16x8){lo[k][0],lo[k][1],lo[k][2],lo[k][3],hi[k][0],hi[k][1],hi[k][2],hi[k][3]}
    o[d0]=__builtin_amdgcn_mfma_f32_32x32x16_bf16(pa0,PK(0),o[d0],0,0,0);
    o[d0]=__builtin_amdgcn_mfma_f32_32x32x16_bf16(pa1,PK(1),o[d0],0,0,0);
    o[d0]=__builtin_amdgcn_mfma_f32_32x32x16_bf16(pa2,PK(2),o[d0],0,0,0);
    o[d0]=__builtin_amdgcn_mfma_f32_32x32x16_bf16(pa3,PK(3),o[d0],0,0,0);
    #undef PK
  }
}

template<int THRL,bool MASK> __device__ __forceinline__ void attn_unit(int q0,const bf16*Qs,const bf16*__restrict__ Ks,const bf16*__restrict__ Vs,bf16*Os,
                                                                       const float*biasg,float slope2,const unsigned long long*maskw,char*shm,const int wid_in){
  const int wid=opaque_s(wid_in),lane=lane_id_(),tid=wid*64+lane,r32=lane&31,hi=lane>>5;
  const bf16*Qw=Qs+(long)(q0+wid*QBLK)*KVP;
  const unsigned lds0=(unsigned)(uintptr_t)shm;
  float*wsf=(float*)(shm+LDS_WS)+wid*64;
  unsigned long long mwA=0ull,mwB=0ull;
  { float*bl=(float*)(shm+LDS_BIAS); const int nk=q0+QB;
    if(biasg){ for(int s=tid;s<nk;s+=NW*64)bl[s]=biasg[s]; } else { for(int s=tid;s<nk;s+=NW*64)bl[s]=slope2*(float)s; }
    if(MASK){ const unsigned long long*mp0=maskw+(q0+wid*QBLK+(lane&31)); mwA=mp0[0]; mwB=mp0[SEQ]; asm volatile("":"+v"(mwA),"+v"(mwB)); }
    asm volatile("s_waitcnt vmcnt(0) lgkmcnt(0)":::"memory"); }
  const bf16*ksrc=Ks+(long)lane*KVP+wid*8;
  const bf16*vsrc=Vs+(long)(16*(wid&3)+(lane>>2))*KVP+(wid>>2)*32+(lane&3)*8;
  const unsigned kdst=lds0+LDS_K+wid*1024, vdst=lds0+LDS_V+wid*1024;
  #define DMA_K(t,slot) glds16(ksrc+(long)(t)*KVBLK*KVP,(unsigned)__builtin_amdgcn_readfirstlane(kdst+(slot)))
  #define DMA_V(t,slot) glds16(vsrc+(long)(t)*KVBLK*KVP,(unsigned)__builtin_amdgcn_readfirstlane(vdst+(slot)))
  const int vb0=(int)(lds0+LDS_V)+((lane>>4)&1)*32+(lane&3)*8+(4*hi+((lane&15)>>2))*64;
  const char*Kbase=shm+LDS_K; bf16x8 kf[8];
  const lds_cptr shm3=(lds_cptr)shm; const lds_cptr kp0=shm3+LDS_K+hi*1024+r32*16; const lds_cptr vp0=shm3+LDS_V+((lane>>4)&1)*32+(lane&3)*8+(4*hi+((lane&15)>>2))*64;
  const lds_cptr bp0=shm3+LDS_BIAS+hi*16;
  const int NT=(q0+QB)/KVBLK;
  DMA_K(0,0);DMA_V(0,0);DMA_K(1,SLOTB);
  bf16x8 qr[4];
  #pragma unroll
  for(int d0=0;d0<4;++d0)qr[d0]=*reinterpret_cast<const bf16x8*>(&Qw[(long)r32*KVP+d0*16+hi*8]);
  const unsigned long long*mwp=MASK?maskw+(q0+wid*QBLK+r32):nullptr;
  #define MLOAD(MW,t) do{ if(MASK){ MW=mwp[(long)(t)*SEQ]; } }while(0)
  #define MPIN(MW) do{}while(0)
  float mhat=0.f,l_reg=0.f;f32x16 o[2];o[0]=f32x16{};o[1]=f32x16{};
  const int qrel=wid*QBLK+r32;
  #define CMASK(P0,P1,t,MW) do{ if(MASK){ bmask(P0,P1,MW,hi); } else { int jb_=(t)-(NT-4); if(jb_>=0)cmask(P0,P1,jb_,qrel,hi); } }while(0)
  bool resc=false;
  #define START(P0,P1) do{ const float rm=rowmax(P0,P1); resc=false; \
    { const float dl=__builtin_fmaxf(rm,-60000.f); mhat=fadd_s(mhat,dl); \
      _Pragma("unroll") for(int r=0;r<16;++r){P0[r]=fsub_s(P0[r],dl);P1[r]=fsub_s(P1[r],dl);} } \
    _Pragma("unroll") for(int r=0;r<16;++r)P0[r]=__builtin_amdgcn_exp2f(P0[r]); }while(0)
  #define RESC() do{ if(resc){ asm volatile("s_waitcnt lgkmcnt(0)":::"memory"); \
      _Pragma("unroll") for(int d_=0;d_<2;++d_) _Pragma("unroll") for(int r=0;r<16;++r)o[d_][r]*=wsf[crow(r,hi)]; } }while(0)
  f32x16 pA0,pA1,pB0,pB1;
  int sl_prev=0,sl_cur=0,sl_next=SLOTB;
  #define ROT() do{sl_prev=sl_cur;sl_cur=sl_next;sl_next=(sl_next==(NSLOT-1)*SLOTB)?0:sl_next+SLOTB;}while(0)
  DMA_K(2,2*SLOTB);
  WAIT_BAR(3);
  binit(pA0,pA1,bp0,0.f);
  qkt(pA0,pA1,Kbase,qr,r32,hi);asm volatile("s_nop 15\n\ts_nop 7":"+v"(pA0),"+v"(pA1));CMASK(pA0,pA1,0,mwA);
  START(pA0,pA1);
  _Pragma("unroll") for(int r=0;r<16;++r)pA1[r]=__builtin_amdgcn_exp2f(pA1[r]);
  WAIT_BAR(0);
  DMA_K(3,0);DMA_V(1,SLOTB);MLOAD(mwA,2);
  ROT();
  kload8(kf,kp0+sl_cur);
  if(MASK){WAIT_BAR(3);}else{WAIT_BAR(2);}
  s16x4 vlo[8],vhi[8]; u32x4 pw0,pw1,pw2,pw3;
  #define PKW(P,B) cvtpk_s(P[B],P[B+1])
  #define PAF(k) __builtin_bit_cast(bf16x8,pw##k)
  #define VFR(i) (bf16x8){vlo[i][0],vlo[i][1],vlo[i][2],vlo[i][3],vhi[i][0],vhi[i][1],vhi[i][2],vhi[i][3]}
  #define PIN(x) asm volatile("":"+v"(x))
  #define MX3(a,b,c) __builtin_fmaxf(__builtin_fmaxf((a),(b)),(c))
  #define GAPA(MF,A0,A1,A2,A3,W0,W1,PW) do{ MF; sacc+=A0; sacc+=A1; sacc+=A2; sacc+=A3; PIN(sacc); W0; W1; PIN(PW); SBAR(); }while(0)
  #define EX(v) __builtin_amdgcn_exp2f(v)
  #define GAPB(MF,X,B) do{ MF; X[B]=EX(X[B]); X[B+1]=EX(X[B+1]); X[B+2]=EX(X[B+2]); X[B+3]=EX(X[B+3]); PIN(X); SBAR(); }while(0)
  #define VRD(i) do{ vlo[i]=vtr(vp_+(((i)>>2)*4096+((i)&3)*1024)); vhi[i]=vtr(vp_+(((i)>>2)*4096+((i)&3)*1024+512)); }while(0)
  #define KRD(G,j) do{ if(G){ kload2(kf,kp0+sl_next,j); SBAR(); } }while(0)
  #define STEP(C0,C1,P0,P1,t,GK,GV,GL,MW,GM,DOCM) do{ SBAR(); \
    const lds_cptr vp_=vp0+sl_prev; \
    binit(C0,C1,bp0+(t)*256,mhat); SBAR(); \
    VRD(0); SBAR(); float sacc=(P0[0]+P0[1]); \
    GAPA(C0=__builtin_amdgcn_mfma_f32_32x32x16_bf16(kf[0],qr[0],C0,0,0,0), P0[2],P0[3],P0[4],P0[5],     pw0[0]=PKW(P0,0), pw0[1]=PKW(P0,2), pw0); \
    VRD(4); SBAR(); GAPA(C1=__builtin_amdgcn_mfma_f32_32x32x16_bf16(kf[1],qr[0],C1,0,0,0), P0[6],P0[7],P0[8],P0[9],     pw0[2]=PKW(P0,4), pw0[3]=PKW(P0,6), pw0); \
    VRD(1); SBAR(); GAPA(C0=__builtin_amdgcn_mfma_f32_32x32x16_bf16(kf[2],qr[1],C0,0,0,0),   P0[10],P0[11],P0[12],P0[13], pw1[0]=PKW(P0,8), pw1[1]=PKW(P0,10), pw1); \
    VRD(5); SBAR(); GAPA(C1=__builtin_amdgcn_mfma_f32_32x32x16_bf16(kf[3],qr[1],C1,0,0,0),   P0[14],P0[15],P1[0],P1[1],   pw1[2]=PKW(P0,12),pw1[3]=PKW(P0,14), pw1); \
    VRD(2); SBAR(); GAPA(C0=__builtin_amdgcn_mfma_f32_32x32x16_bf16(kf[4],qr[2],C0,0,0,0),   P1[2],P1[3],P1[4],P1[5],     pw2[0]=PKW(P1,0), pw2[1]=PKW(P1,2), pw2); \
    VRD(6); SBAR(); GAPA(C1=__builtin_amdgcn_mfma_f32_32x32x16_bf16(kf[5],qr[2],C1,0,0,0),   P1[6],P1[7],P1[8],P1[9],     pw2[2]=PKW(P1,4), pw2[3]=PKW(P1,6), pw2); \
    VRD(3); SBAR(); GAPA(C0=__builtin_amdgcn_mfma_f32_32x32x16_bf16(kf[6],qr[3],C0,0,0,0),   P1[10],P1[11],P1[12],P1[13], pw3[0]=PKW(P1,8), pw3[1]=PKW(P1,10), pw3); \
    VRD(7); SBAR(); GAPA(C1=__builtin_amdgcn_mfma_f32_32x32x16_bf16(kf[7],qr[3],C1,0,0,0),   P1[14],P1[15],0.f,0.f,       pw3[2]=PKW(P1,12),pw3[3]=PKW(P1,14), pw3); \
    l_reg+=sacc; \
    if(MASK&&(DOCM)){ CMASK(C0,C1,t,MW); } \
    if(GK){DMA_K((t)+3,sl_cur);} if(GV){DMA_V((t)+1,sl_next);} \
    if(!MASK&&(DOCM)){ CMASK(C0,C1,t,MW); } \
    if(GM){ MLOAD(MW,(t)+2); } \
    { float a=MX3(C0[0],C0[1],C1[0]),b=MX3(C0[2],C0[3],C1[1]); a=MX3(a,C1[2],C1[3]); \
      _Pragma("unroll") for(int r=4;r<16;r+=4){a=MX3(a,C0[r],C0[r+1]);b=MX3(b,C0[r+2],C0[r+3]);a=MX3(a,C1[r],C1[r+1]);b=MX3(b,C1[r+2],C1[r+3]);} \
      float rm=__builtin_fmaxf(a,b); { auto rr=__builtin_amdgcn_permlane32_swap(__float_as_uint(rm),__float_as_uint(rm),false,false); rm=__builtin_fmaxf(__uint_as_float(rr[0]),__uint_as_float(rr[1])); } \
      resc=false; \
      if(__builtin_expect(__any(rm>(float)THRL),0)){ const float dl=__builtin_fmaxf(rm,0.f); mhat+=dl; \
        _Pragma("unroll") for(int r=0;r<16;++r){C0[r]-=dl;C1[r]-=dl;} \
        const float f=__builtin_amdgcn_exp2f(-dl); l_reg*=f; if(hi==0)wsf[r32]=f; resc=true; } } \
    SBAR(); \
    GAPB(o[0]=__builtin_amdgcn_mfma_f32_32x32x16_bf16(PAF(0),VFR(0),o[0],0,0,0), C0,0); \
    GAPB(o[1]=__builtin_amdgcn_mfma_f32_32x32x16_bf16(PAF(0),VFR(4),o[1],0,0,0), C0,4); \
    KRD(GL,0); GAPB(o[0]=__builtin_amdgcn_mfma_f32_32x32x16_bf16(PAF(1),VFR(1),o[0],0,0,0), C0,8); \
    KRD(GL,1); GAPB(o[1]=__builtin_amdgcn_mfma_f32_32x32x16_bf16(PAF(1),VFR(5),o[1],0,0,0), C0,12); \
    KRD(GL,2); GAPB(o[0]=__builtin_amdgcn_mfma_f32_32x32x16_bf16(PAF(2),VFR(2),o[0],0,0,0), C1,0); \
    KRD(GL,3); GAPB(o[1]=__builtin_amdgcn_mfma_f32_32x32x16_bf16(PAF(2),VFR(6),o[1],0,0,0), C1,4); \
    GAPB(o[0]=__builtin_amdgcn_mfma_f32_32x32x16_bf16(PAF(3),VFR(3),o[0],0,0,0), C1,8); \
    GAPB(o[1]=__builtin_amdgcn_mfma_f32_32x32x16_bf16(PAF(3),VFR(7),o[1],0,0,0), C1,12); \
    }while(0)
  int t=1;
  #define ENDW(tt) do{ if((tt)+3<NT){ if(MASK){WAIT_BAR(3);}else{WAIT_BAR(2);} } else if((tt)+2<NT){ if(MASK){WAIT_BAR(2);}else{WAIT_BAR(1);} } else {WAIT_BAR(0);} }while(0)
  for(;t+5<NT;t+=2){
    STEP(pB0,pB1,pA0,pA1,t,true,true,true,mwB,MASK,MASK);     if(MASK){WAIT_BAR(3);}else{WAIT_BAR(2);} MPIN(mwA); RESC(); ROT();
    STEP(pA0,pA1,pB0,pB1,t+1,true,true,true,mwA,MASK,MASK);   if(MASK){WAIT_BAR(3);}else{WAIT_BAR(2);} MPIN(mwB); RESC(); ROT();
  }
  for(;t+1<NT;t+=2){
    STEP(pB0,pB1,pA0,pA1,t,(t+3<NT),(t+1<NT),(t+1<NT),mwB,(MASK&&(t+2<NT)),true);       ENDW(t);   MPIN(mwA); RESC(); ROT();
    STEP(pA0,pA1,pB0,pB1,t+1,(t+4<NT),(t+2<NT),(t+2<NT),mwA,(MASK&&(t+3<NT)),true);     ENDW(t+1); MPIN(mwB); RESC(); ROT();
  }
  STEP(pB0,pB1,pA0,pA1,NT-1,false,false,false,mwB,false,true); RESC();
  { float sacc=pB0[0]+pB0[1]; _Pragma("unroll") for(int r=2;r<16;++r)sacc+=pB0[r]; _Pragma("unroll") for(int r=0;r<16;++r)sacc+=pB1[r]; l_reg+=sacc;
    pw0=(u32x4){PKW(pB0,0),PKW(pB0,2),PKW(pB0,4),PKW(pB0,6)};pw1=(u32x4){PKW(pB0,8),PKW(pB0,10),PKW(pB0,12),PKW(pB0,14)};pw2=(u32x4){PKW(pB1,0),PKW(pB1,2),PKW(pB1,4),PKW(pB1,6)};pw3=(u32x4){PKW(pB1,8),PKW(pB1,10),PKW(pB1,12),PKW(pB1,14)};
    SBAR(); pv(o,vb0+sl_cur,PAF(0),PAF(1),PAF(2),PAF(3)); }
  #undef PKW
  #undef PAF
  #undef VFR
  #undef PIN
  #undef MX3
  #undef GAPA
  #undef GAPB
  #undef EX
  #undef VRD
  #undef KRD
  #undef STEP
  #undef ENDW
  {auto rr=__builtin_amdgcn_permlane32_swap(__float_as_uint(l_reg),__float_as_uint(l_reg),false,false);l_reg=__uint_as_float(rr[0])+__uint_as_float(rr[1]);}
  if(hi==0)wsf[32+r32]=l_reg;asm volatile("s_waitcnt lgkmcnt(0)":::"memory");
  float rli[16];
  #pragma unroll
  for(int r=0;r<16;++r)rli[r]=__builtin_amdgcn_rcpf(wsf[32+crow(r,hi)]);
  bf16*Ow=Os+(long)(q0+wid*QBLK)*OP;
  { bf16*stg=(bf16*)(shm+LDS_OST)+wid*2048;
    #pragma unroll
    for(int r=0;r<16;++r){const int orow=crow(r,hi);
      #pragma unroll
      for(int d0=0;d0<2;++d0)stg[orow*64+d0*32+r32]=__float2bfloat16(o[d0][r]*rli[r]);}
    asm volatile("s_waitcnt lgkmcnt(0)":::"memory");
    #pragma unroll
    for(int i=0;i<4;++i){const int row=i*8+(lane>>3),ch=lane&7; const u32x4 v=*(const u32x4*)(stg+row*64+ch*8); *(u32x4*)(Ow+(long)row*OP+ch*8)=v;} }
  asm volatile("s_waitcnt lgkmcnt(0)\n\ts_barrier":::"memory");
  #undef DMA_K
  #undef MLOAD
  #undef MPIN
  #undef DMA_V
  #undef CMASK
  #undef START
  #undef RESC
  #undef ROT
}
#undef SBAR
#undef WAIT_BAR
}
struct Args { const float* in[25]; float* out; unsigned char* ws; int ph_lo, ph_hi; };
struct Frame {
    LAS unsigned char* lds; unsigned char* ldsg;
    volatile LAS unsigned* MISC;
    gu32* ctl;
    int tid, lane, wave, vcu, G;
    unsigned char* ws; float* out;
};
__device__ __forceinline__ float dpp_add_(float v, float acc_src, int) { return v; }
#define DPP_F(v, ctrl, rmask) __builtin_bit_cast(float, __builtin_amdgcn_update_dpp(0, __builtin_bit_cast(int, (v)), (ctrl), (rmask), 0xF, false))
__device__ __forceinline__ float wave_sum(float v) {
    v += DPP_F(v, 0xB1, 0xF);
    v += DPP_F(v, 0x4E, 0xF);
    v += DPP_F(v, 0x141, 0xF);
    v += DPP_F(v, 0x140, 0xF);
    v += DPP_F(v, 0x142, 0xA);
    v += DPP_F(v, 0x143, 0xC);
    return __builtin_bit_cast(float, __builtin_amdgcn_readlane(__builtin_bit_cast(int, v), 63));
}
__device__ __forceinline__ bf16* wsb(const Frame& F, size_t off) { return (bf16*)(F.ws + off); }

__device__ __forceinline__ int map_small(int r) {
    if (r < 1024) return r;
    if (r < 1280) return 1028 + (r - 1024);
    if (r < 1536) return 1412 + (r - 1280);
    if (r < 2048) return 1736 + (r - 1536);
    if (r < 2112) return 1284 + (r - 2048);
    if (r < 2176) return 1348 + (r - 2112);
    if (r < 2240) return 1668 + (r - 2176);
    if (r < 2244) return 1024 + (r - 2240);
    if (r < 2248) return 1732 + (r - 2244);
    return -1;
}
__device__ __forceinline__ void tr_item(const float* src, int ld_src, int k0, int srccol, bf16* dst, int ld_dst, LAS float* scr, int lane) {
    float tv[32];
#pragma unroll
    for (int i = 0; i < 32; ++i) { const int kk = 2 * i + (lane >> 5); tv[i] = src[(size_t)(k0 + kk) * ld_src + (srccol >= 0 ? srccol : 0)]; }
#pragma unroll
    for (int i = 0; i < 32; ++i) { const int kk = 2 * i + (lane >> 5); scr[kk * 33 + (lane & 31)] = srccol >= 0 ? tv[i] : 0.f; }
    LDS_WAIT(); asm volatile("" ::: "memory");
    const int c = lane & 7;
#pragma unroll
    for (int j = 0; j < 4; ++j) { const int n = (lane >> 3) + 8 * j; const LAS float* s = scr + (8 * c) * 33 + n;
        v4u o; o.x = pk2(s[0 * 33], s[1 * 33]); o.y = pk2(s[2 * 33], s[3 * 33]); o.z = pk2(s[4 * 33], s[5 * 33]); o.w = pk2(s[6 * 33], s[7 * 33]);
        *(GAS v4u*)(dst + (size_t)n * ld_dst + 8 * c) = o; }
    LDS_WAIT(); asm volatile("" ::: "memory");
}
constexpr float GATE_WSCALE = 32.f;
__device__ __forceinline__ void tr_item8(const float* src, int ld_src, int k0, int srccol, unsigned char* dst, int ld_dst, LAS float* scr, int lane) {
    float tv[32];
#pragma unroll
    for (int i = 0; i < 32; ++i) { const int kk = 2 * i + (lane >> 5); tv[i] = src[(size_t)(k0 + kk) * ld_src + srccol]; }
#pragma unroll
    for (int i = 0; i < 32; ++i) { const int kk = 2 * i + (lane >> 5); scr[kk * 33 + (lane & 31)] = tv[i] * GATE_WSCALE; }
    LDS_WAIT(); asm volatile("" ::: "memory");
    const int c = lane & 7;
#pragma unroll
    for (int j = 0; j < 4; ++j) { const int n = (lane >> 3) + 8 * j; const LAS float* s = scr + (8 * c) * 33 + n;
        v2u o; o.x = pk4_fp8(s[0 * 33], s[1 * 33], s[2 * 33], s[3 * 33]); o.y = pk4_fp8(s[4 * 33], s[5 * 33], s[6 * 33], s[7 * 33]);
        *(GAS v2u*)(dst + (size_t)n * ld_dst + 8 * c) = o; }
    LDS_WAIT(); asm volatile("" ::: "memory");
}
constexpr int IT_SM = 72 * 16, IT_GT = 128 * 16, IT_BR = 512, IT_OUT = 512, IT_GU = 16 * 512, IT_D = 16 * 256, IT_LAYER = IT_SM + IT_GT + IT_BR + IT_OUT + IT_GU + IT_D;
__device__ __forceinline__ void p0_item(const Frame& F, const Args& a, int it, LAS float* scr) {
    const int l = it / IT_LAYER; int j = it % IT_LAYER; const int n = F.lane & 31;
    bf16* W = wsb(F, WS_W + (size_t)l * W_LAYER);
    if (j < IT_SM) { const int g = j / 16, kb = j % 16; tr_item(a.in[3] + (size_t)l * DM * P_TOTAL, P_TOTAL, kb * 64, map_small(g * 32 + n), W + W_SM / 2 + (size_t)(g * 32) * DM + kb * 64, DM, scr, F.lane); return; } j -= IT_SM;
    if (j < IT_GT) { const int g = j / 16, kb = j % 16; tr_item8(a.in[3] + (size_t)l * DM * P_TOTAL, P_TOTAL, kb * 64, 2248 + g * 32 + n, (unsigned char*)W + W_GT + (size_t)(g * 32) * DM + kb * 64, DM, scr, F.lane); return; } j -= IT_GT;
    if (j < IT_BR) { const int nb = j / 128, jj = j % 128, g = jj / 4, kb = jj % 4;
        tr_item(a.in[12] + ((size_t)l * 4 + nb) * 256 * DM, DM, kb * 64, g * 32 + n, W + W_BR / 2 + (size_t)(g * 32) * DM + nb * 256 + kb * 64, DM, scr, F.lane); return; } j -= IT_BR;
    if (j < IT_OUT) { const int g = j / 16, kb = j % 16; tr_item(a.in[13] + (size_t)l * DM * DM, DM, kb * 64, g * 32 + n, W + W_OUT / 2 + (size_t)(g * 32) * DM + kb * 64, DM, scr, F.lane); return; } j -= IT_OUT;
    if (j < IT_GU) { const int e = j / 512, jj = j % 512, g = jj / 16, kb = jj % 16; const int r0 = g * 32, q = r0 >> 8, within = r0 & 255; const bool isup = within >= 128;
        const float* src = (isup ? a.in[21] : a.in[20]) + ((size_t)l * 16 + e) * DM * 512;
        tr_item(src, 512, kb * 64, 128 * q + (within & 127) + n, W + W_GU / 2 + (size_t)e * DM * DM + (size_t)r0 * DM + kb * 64, DM, scr, F.lane); return; } j -= IT_GU;
    { const int e = j / 256, jj = j % 256, g = jj / 8, kb = jj % 8;
        tr_item(a.in[22] + ((size_t)l * 16 + e) * 512 * DM, DM, kb * 64, g * 32 + n, W + W_D / 2 + (size_t)(e >> 1) * DM * DM + (size_t)(g * 32) * DM + (e & 1) * 512 + kb * 64, DM, scr, F.lane); }
}
__device__ __forceinline__ void ln_load(const Frame& F, const float* xrow, f32x4 (&v)[4]) {
    const GAS f32x4* xr = (const GAS f32x4*)xrow + F.lane;
#pragma unroll
    for (int j = 0; j < 4; ++j) v[j] = xr[64 * j];
}
struct LnGB { f32x4 g[4], b[4]; };
__device__ __forceinline__ void ln_gb_load(const Frame& F, const float* g, const float* b, LnGB& gb) {
#pragma unroll
    for (int j = 0; j < 4; ++j) { gb.g[j] = ((const GAS f32x4*)g)[F.lane + 64 * j]; gb.b[j] = ((const GAS f32x4*)b)[F.lane + 64 * j]; }
}
__device__ __forceinline__ void ln_load_bf(const Frame& F, const bf16* xrow, f32x4 (&v)[4]) {
    const GAS v2u* xr = (const GAS v2u*)xrow + F.lane;
#pragma unroll
    for (int j = 0; j < 4; ++j) { const v2u w = xr[64 * j]; v[j] = (f32x4){bfl(w.x), bfh(w.x), bfl(w.y), bfh(w.y)}; }
}
__device__ __forceinline__ void ln_row(const Frame& F, const LnGB& gb, float* orow  , bf16* brow  , f32x4 (&v)[4], bool dry = false, unsigned char* frow = nullptr  ) {
    float s = 0.f;
#pragma unroll
    for (int j = 0; j < 4; ++j) s += (v[j].x + v[j].y) + (v[j].z + v[j].w);
    const float mean = wave_sum(s) * (1.f / DM); float s2 = 0.f;
#pragma unroll
    for (int j = 0; j < 4; ++j) { v[j] = v[j] - mean; s2 += (v[j].x * v[j].x + v[j].y * v[j].y) + (v[j].z * v[j].z + v[j].w * v[j].w); }
    const float rstd = 1.f / sqrtf(wave_sum(s2) * (1.f / DM) + LN_EPS);
    GAS f32x4* o4 = (GAS f32x4*)orow + F.lane; GAS v2u* o8 = (GAS v2u*)brow + F.lane; GAS unsigned* o1 = (GAS unsigned*)frow + F.lane;
#pragma unroll
    for (int j = 0; j < 4; ++j) { v[j] = v[j] * rstd * gb.g[j] + gb.b[j]; v2u w; w.x = pk2(v[j].x, v[j].y); w.y = pk2(v[j].z, v[j].w); if (!dry) { if (orow) o4[64 * j] = v[j]; if (brow) o8[64 * j] = w; if (frow) o1[64 * j] = pk4_fp8(v[j].x, v[j].y, v[j].z, v[j].w); } }
}
__device__ __forceinline__ void p0_prologue(const Frame& F_, const Args& a) { Frame F = F_; F.lane = lane_id_(); F.tid = F.wave * 64 + F.lane;
    LAS float* scr = (LAS float*)(F.lds + RING_OFF + F.wave * 16384);
    const int gw = F.vcu * NWAVES + F.wave, NGW = F.G * NWAVES;
    for (int it = gw; it < DEPTH * IT_LAYER; it += NGW) p0_item(F, a, it, scr);
    { LnGB gb; ln_gb_load(F, a.in[1], a.in[2], gb); f32x4 nx[4]; ln_load(F, a.in[0] + (size_t)gw * DM, nx);
      for (int m = gw; m < NTOK; m += NGW) { f32x4 v[4];
#pragma unroll
          for (int j = 0; j < 4; ++j) v[j] = nx[j];
          if (m + NGW < NTOK) ln_load(F, a.in[0] + (size_t)(m + NGW) * DM, nx);
          ln_row(F, gb, nullptr, wsb(F, WS_HB) + (size_t)m * DM, v, false, F.ws + WS_HB8 + (size_t)m * DM); } }
}

#ifndef TO_WGM
#define TO_WGM 8
#endif
struct TileOrder {
    int nM, nN, nwg, G, c;
    __device__ void init(int nM_, int nN_, int G_, int c_) { nM = nM_; nN = nN_; nwg = nM * nN; G = G_; c = c_; }
    __device__ bool tile(int i, int& pm, int& pn) const {
        const long L = (long)i * G + c; if (L >= nwg) return false;
        int wgid = (int)L; { const int q = nwg / 8, r = nwg % 8, xcd = wgid % 8, off = wgid / 8; wgid = (xcd < r ? xcd * (q + 1) : r * (q + 1) + (xcd - r) * q) + off; }
        const int nig = TO_WGM * nN, gid = wgid / nig, fm = gid * TO_WGM, gsz = (nM - fm) < TO_WGM ? (nM - fm) : TO_WGM;
        pm = fm + ((wgid % nig) % gsz); pn = (wgid % nig) / gsz; return true;
    }
};
struct SchedA { TileOrder T; const char* A; const char* B;
    __device__ bool next(int i, pg8::GU& u) const { int pm, pn; if (!T.tile(i, pm, pn)) return false; u.A = A + (size_t)pm * pg8::TSTEP; u.B0 = B + (size_t)pn * pg8::TSTEP; u.B1 = u.B0; u.nt = 16; u.ks = 16; u.pm = pm; u.pn = pn; u.rows = nullptr; u.rbase = 0; u.rcnt = 0; u.a0 = 0; u.a1 = 0; return true; } };
struct EpiA { static constexpr bool PERM = true; bf16* P; float* FW; bf16* KIDX;
    __device__ __forceinline__ void operator()(const pg8::f32x4 (&acc)[2][2][4][2], const pg8::GU& u, int wr, int wc, int fr, int fq) {
        const float sc = (u.pn == 1 || u.pn == 4) ? 0.125f * LOG2E : 1.f;
        const int row0 = u.pm * 256 + wr * 64 + fr, col0 = u.pn * 256 + wc * 32 + 8 * fq;
#pragma unroll
        for (int ai = 0; ai < 2; ++ai)
#pragma unroll
            for (int m = 0; m < 4; ++m) { const int row = row0 + ai * 128 + m * 16; bf16* rowp = P + (size_t)row * PS + col0;
#pragma unroll
                for (int bj = 0; bj < 2; ++bj) { const pg8::f32x4 v0 = acc[ai][bj][m][0] * sc, v1 = acc[ai][bj][m][1] * sc; v4u w;
                    w.x = pg8::cvt_pk_bf16(v0[0], v0[1]); w.y = pg8::cvt_pk_bf16(v0[2], v0[3]); w.z = pg8::cvt_pk_bf16(v1[0], v1[1]); w.w = pg8::cvt_pk_bf16(v1[2], v1[3]);
                    *(v4u*)(rowp + bj * 128) = w;
                    if (bj == 1 && u.pn == 8 && wc < 2) *(v4u*)(KIDX + (size_t)row * 64 + wc * 32 + 8 * fq) = w;
                    if (bj == 1 && u.pn == 8 && wc == 2 && fq == 0) { *(f32x4*)(FW + (size_t)row * 8) = v0; *(f32x4*)(FW + (size_t)row * 8 + 4) = v1; } } }
    } };
struct SchedC { TileOrder T; const char* HBp; const char* BRp; const char* WGp; const char* WBp; bool collapse;
    __device__ bool next(int i, pg8::GU& u) const { int pm, pd; if (!T.tile(i >> 3, pm, pd)) return false; const int sub = i & 7, n = sub >> 1, isg = sub & 1; const int pm_o = pm, pd_o = pd; if (collapse) { pm &= 7; pd = 0; }
        u.pm = pm; u.pn = pd; u.a0 = n; u.a1 = isg; u.rows = nullptr; u.rbase = 0; u.rcnt = 0;
        if (isg) { u.A = HBp + (size_t)pm * (pg8::TSTEP / 2); u.B0 = WGp + (size_t)(n * 8 + pd) * (pg8::HSTEP / 2); u.nt = 8; }
        else     { u.A = BRp + (size_t)pm * pg8::TSTEP + n * 512; u.B0 = WBp + (size_t)pd * pg8::HSTEP + n * 512; u.nt = 4; }
        u.B1 = u.B0; u.ks = u.nt; u.pm = pm_o; u.pn = pd_o; return true; } };
struct EpiC { static constexpr bool PERM = true; bf16* MIX; const float* bgate; bool dry;
    __device__ __forceinline__ void operator()(const pg8::f32x4 (&acc)[2][4][2], pg8::u32x4 (&upk)[2][4], pg8::u32x4 (&sum)[2][4]  , const pg8::GU& u, int wr, int wc, int fr, int fq) {
        const int n = u.a0;
        if (!u.a1) {
#pragma unroll
            for (int ai = 0; ai < 2; ++ai)
#pragma unroll
                for (int m = 0; m < 4; ++m) { const pg8::f32x4 v0 = acc[ai][m][0], v1 = acc[ai][m][1]; v4u w;
                    w.x = pg8::cvt_pk_bf16(v0[0], v0[1]); w.y = pg8::cvt_pk_bf16(v0[2], v0[3]); w.z = pg8::cvt_pk_bf16(v1[0], v1[1]); w.w = pg8::cvt_pk_bf16(v1[2], v1[3]); upk[ai][m] = w; }
        } else {
            const int colt = u.pn * 128 + wc * 32 + 8 * fq; const float* bp = bgate + n * DM + colt; const f32x4 b0 = *(const f32x4*)bp, b1 = *(const f32x4*)(bp + 4);
#pragma unroll
            for (int ai = 0; ai < 2; ++ai)
#pragma unroll
                for (int m = 0; m < 4; ++m) { const v4u uw = upk[ai][m]; const pg8::f32x4 g0 = acc[ai][m][0] * (1.f / GATE_WSCALE) + b0, g1 = acc[ai][m][1] * (1.f / GATE_WSCALE) + b1;
                    pg8::f32x4 r0, r1; r0[0] = sigmoidf_(g0[0]) * bfl(uw.x); r0[1] = sigmoidf_(g0[1]) * bfh(uw.x); r0[2] = sigmoidf_(g0[2]) * bfl(uw.y); r0[3] = sigmoidf_(g0[3]) * bfh(uw.y);
                    r1[0] = sigmoidf_(g1[0]) * bfl(uw.z); r1[1] = sigmoidf_(g1[1]) * bfh(uw.z); r1[2] = sigmoidf_(g1[2]) * bfl(uw.w); r1[3] = sigmoidf_(g1[3]) * bfh(uw.w);
                    if (n > 0) { const v4u pw = sum[ai][m]; r0[0] += bfl(pw.x); r0[1] += bfh(pw.x); r0[2] += bfl(pw.y); r0[3] += bfh(pw.y); r1[0] += bfl(pw.z); r1[1] += bfh(pw.z); r1[2] += bfl(pw.w); r1[3] += bfh(pw.w); }
                    v4u o; o.x = pg8::cvt_pk_bf16(r0[0], r0[1]); o.y = pg8::cvt_pk_bf16(r0[2], r0[3]); o.z = pg8::cvt_pk_bf16(r1[0], r1[1]); o.w = pg8::cvt_pk_bf16(r1[2], r1[3]); sum[ai][m] = o; }
            if (n == 3) { const int row0 = u.pm * 256 + wr * 64 + fr;
#pragma unroll
                for (int ai = 0; ai < 2; ++ai)
#pragma unroll
                    for (int m = 0; m < 4; ++m) *(v4u*)(MIX + (size_t)(row0 + ai * 128 + m * 16) * DM + colt) = sum[ai][m]; }
        }
    } };
struct SchedC2 { TileOrder T; const char* A; const char* B;
    __device__ bool next(int i, pg8::GU& u) const { int pm, pn; if (!T.tile(i, pm, pn)) return false; u.A = A + (size_t)pm * pg8::TSTEP; u.B0 = B + (size_t)pn * pg8::TSTEP; u.B1 = u.B0; u.nt = 16; u.ks = 16; u.pm = pm; u.pn = pn; u.rows = nullptr; u.rbase = 0; u.rcnt = 0; u.a0 = 0; u.a1 = 0; return true; } };
struct EpiRes { static constexpr bool PERM = false; bf16* V1; const bf16* HB; bool dry;
    __device__ __forceinline__ void operator()(const pg8::f32x4 (&acc)[2][2][4][2], const pg8::GU& u, int wr, int wc, int fr, int fq) {
        const int row0 = u.pm * 256 + wr * 64 + fr, col0 = u.pn * 256 + wc * 32 + 4 * fq;
#pragma unroll
        for (int ai = 0; ai < 2; ++ai)
#pragma unroll
            for (int m = 0; m < 4; ++m) { const size_t ro = (size_t)(row0 + ai * 128 + m * 16) * DM + col0;
#pragma unroll
                for (int bj = 0; bj < 2; ++bj)
#pragma unroll
                    for (int n = 0; n < 2; ++n) { const v2u hw = *(const v2u*)(HB + ro + bj * 128 + n * 16); const f32x4 hv = (f32x4){bfl(hw.x), bfh(hw.x), bfl(hw.y), bfh(hw.y)};
                        const f32x4 r_ = hv * ALPHA + acc[ai][bj][m][n]; v2u o; o.x = pk2(r_.x, r_.y); o.y = pk2(r_.z, r_.w); if (!dry) *(v2u*)(V1 + ro + bj * 128 + n * 16) = o; } }
    } };
__device__ __forceinline__ void cls_lookup(const LAS int* tab, int tau, int& c, int& j) {
    int cc = 0;
#pragma unroll 1
    for (int k = 1; k < NCLS; ++k) if (tab[32 + k] <= tau) cc = k;
    c = cc; j = tau - tab[32 + cc];
}
__device__ __forceinline__ void cls_experts(int c, int& ea, int& eb) { const int g = c / 6, p = c % 6; const int i = p < 3 ? 0 : (p < 5 ? 1 : 2); const int jj = p < 3 ? p + 1 : (p < 5 ? p - 1 : 3); ea = g * 4 + i; eb = g * 4 + jj; }
struct SchedD1 { const LAS int* tab; int G, c0; const char* HBp; const char* WGU; const int* list;
    __device__ bool next(int i, pg8::GU& u) const { const int L = i * G + c0; if (L >= tab[57] * 8) return false; const int tau = L >> 3, pn = L & 7; int c, j; cls_lookup(tab, tau, c, j); int ea, eb; cls_experts(c, ea, eb);
        const int e = (pn >> 2) ? eb : ea;
        u.A = HBp; u.B0 = WGU + (size_t)e * DM * DM * 2 + (size_t)(pn & 3) * pg8::TSTEP; u.B1 = u.B0; u.nt = 16; u.ks = 16; u.rows = list + (size_t)c * NTOK; u.rbase = j * 256; u.rcnt = tab[c];
        u.pm = tau; u.pn = pn; u.a0 = c; u.a1 = j; return true; } };
struct EpiD1 { static constexpr bool PERM = true; bf16* ACT; const float* gwl;
    __device__ __forceinline__ void operator()(const pg8::f32x4 (&acc)[2][2][4][2], const pg8::GU& u, int wr, int wc, int fr, int fq) {
        const int half = u.pn >> 2, col = half * 512 + (u.pn & 3) * 128 + wc * 32 + 8 * fq;
#pragma unroll
        for (int ai = 0; ai < 2; ++ai)
#pragma unroll
            for (int m = 0; m < 4; ++m) { const int r = ai * 128 + wr * 64 + m * 16 + opaque_i(fr), pos = u.rbase + r;
                const float gw = pos < u.rcnt ? gwl[((size_t)u.a0 * NTOK + pos) * 2 + half] : 0.f;
                const pg8::f32x4 g0 = acc[ai][0][m][0], g1 = acc[ai][0][m][1], u0 = acc[ai][1][m][0], u1 = acc[ai][1][m][1]; float r8[8];
#pragma unroll
                for (int k = 0; k < 4; ++k) { r8[k] = g0[k] * sigmoidf_(g0[k]) * u0[k] * gw; r8[4 + k] = g1[k] * sigmoidf_(g1[k]) * u1[k] * gw; }
                v4u o; o.x = pg8::cvt_pk_bf16(r8[0], r8[1]); o.y = pg8::cvt_pk_bf16(r8[2], r8[3]); o.z = pg8::cvt_pk_bf16(r8[4], r8[5]); o.w = pg8::cvt_pk_bf16(r8[6], r8[7]);
                *(v4u*)(ACT + ((size_t)u.pm * 256 + r) * DM + col) = o; asm volatile("" ::: "memory"); }
    } };
struct SchedD2 { const LAS int* tab; int G, c0; const char* ACTp; const char* WD; const int* list;
    __device__ bool next(int i, pg8::GU& u) const { const int L = i * G + c0; if (L >= tab[57] * 4) return false; const int tau = L >> 2, pn = L & 3; int c, j; cls_lookup(tab, tau, c, j); int ea, eb; cls_experts(c, ea, eb);
        u.A = ACTp + (size_t)tau * pg8::TSTEP; u.B0 = WD + (size_t)(ea >> 1) * DM * DM * 2 + (ea & 1) * 1024 + (size_t)pn * pg8::TSTEP; u.B1 = WD + (size_t)(eb >> 1) * DM * DM * 2 + (eb & 1) * 1024 + (size_t)pn * pg8::TSTEP;
        u.nt = 16; u.ks = 8; u.rows = list + (size_t)c * NTOK; u.rbase = j * 256; u.rcnt = tab[c]; u.pm = tau; u.pn = pn; u.a0 = c; u.a1 = j; return true; } };
struct EpiD2 { static constexpr bool PERM = false; bf16* V2; const bf16* HB; bool dry;
    __device__ __forceinline__ void operator()(const pg8::f32x4 (&acc)[2][2][4][2], const pg8::GU& u, int wr, int wc, int fr, int fq) {
        const int col0 = u.pn * 256 + wc * 32 + 4 * fq;
#pragma unroll
        for (int ai = 0; ai < 2; ++ai)
#pragma unroll
            for (int m = 0; m < 4; ++m) { const int pos = u.rbase + ai * 128 + wr * 64 + m * 16 + opaque_i(fr);
                if (pos < u.rcnt) { const size_t ro = (size_t)u.rows[pos] * DM + col0;
#pragma unroll
                    for (int bj = 0; bj < 2; ++bj)
#pragma unroll
                        for (int n = 0; n < 2; ++n) { const v2u hw = *(const v2u*)(HB + ro + bj * 128 + n * 16); const f32x4 hv = (f32x4){bfl(hw.x), bfh(hw.x), bfl(hw.y), bfh(hw.y)};
                            const f32x4 r_ = hv * ALPHA + acc[ai][bj][m][n]; v2u o; o.x = pk2(r_.x, r_.y); o.y = pk2(r_.z, r_.w); if (!dry) *(v2u*)(V2 + ro + bj * 128 + n * 16) = o; } } }
    } };
typedef float f32x2v __attribute__((ext_vector_type(2)));
__device__ __forceinline__ float log_sigmoid_(float x) { return fminf(x, 0.f) - __builtin_amdgcn_logf(1.f + __builtin_amdgcn_exp2f(-fabsf(x) * LOG2E)) * 0.6931471805599453f; }
__device__ __forceinline__ void fox_cumsum(const Frame& F_, int bh, const float* FW, const float* bfor, float* bias2) { Frame F = F_; F.lane = lane_id_(); F.tid = F.wave * 64 + F.lane;
    const int b = bh >> 2, h = bh & 3; const float bf = bfor[h]; const float* src = FW + ((size_t)b * SEQ + F.lane * 64) * 8 + h; float tot = 0.f;
    for (int i = 0; i < 64; ++i) tot += log_sigmoid_(src[(size_t)i * 8] + bf);
    float inc = tot;
#pragma unroll
    for (int o = 1; o < 64; o <<= 1) { const float t = __shfl_up(inc, o); if (F.lane >= o) inc += t; }
    float run = inc - tot; float* dst = bias2 + (size_t)bh * SEQ + F.lane * 64;
    for (int i = 0; i < 64; ++i) { run += log_sigmoid_(src[(size_t)i * 8] + bf); dst[i] = -run * LOG2E; }
}
template <int WIN> __device__ __forceinline__ void pool_frags(bf16x8 (&af)[4], const bf16* src0, int tb) {
    const int nrow = tb + 1 < WIN ? tb + 1 : WIN; const float inv = 1.f / (float)nrow;
#pragma unroll
    for (int ks = 0; ks < 4; ++ks) { const bf16* src = src0 + ks * 16; v4u wv[WIN];
#pragma unroll
        for (int j = 0; j < WIN; ++j) wv[j] = *(const v4u*)(src - (size_t)(j <= tb ? j : 0) * PS);
        float s[8];
#pragma unroll
        for (int k = 0; k < 8; ++k) s[k] = 0.f;
#pragma unroll
        for (int j = 0; j < WIN; ++j) { if (j <= tb) { const v4u w = wv[j];
            s[0] += bfl(w.x); s[1] += bfh(w.x); s[2] += bfl(w.y); s[3] += bfh(w.y); s[4] += bfl(w.z); s[5] += bfh(w.z); s[6] += bfl(w.w); s[7] += bfh(w.w); } }
        const v4u cur = wv[0];
        const float c[8] = {bfl(cur.x), bfh(cur.x), bfl(cur.y), bfh(cur.y), bfl(cur.z), bfh(cur.z), bfl(cur.w), bfh(cur.w)};
        v4u o; o.x = pk2(s[0] * inv - c[0], s[1] * inv - c[1]); o.y = pk2(s[2] * inv - c[2], s[3] * inv - c[3]); o.z = pk2(s[4] * inv - c[4], s[5] * inv - c[5]); o.w = pk2(s[6] * inv - c[6], s[7] * inv - c[7]);
        af[ks] = __builtin_bit_cast(bf16x8, o); }
}
__device__ __forceinline__ void pool_unit(const Frame& F_, int tile, const bf16* P, const float* pw, const float* pscale, bf16* BR) { Frame F = F_; F.lane = lane_id_(); F.tid = F.wave * 64 + F.lane;
    const int g = F.wave & 3, th = F.wave >> 2, r32 = F.lane & 31, hi = F.lane >> 5;
    const int tok = tile * 64 + th * 32 + r32, tb = tok & (SEQ - 1);
    const bf16* src0 = P + (size_t)tok * PS + C_POOL + g * 64 + hi * 8;
    bf16x8 af[4];
    if (g == 0) pool_frags<2>(af, src0, tb); else if (g == 1) pool_frags<4>(af, src0, tb); else if (g == 2) pool_frags<8>(af, src0, tb); else pool_frags<16>(af, src0, tb);
#pragma unroll
    for (int db = 0; db < 2; ++db) { f32x16 acc = {};
#pragma unroll
        for (int ks = 0; ks < 4; ++ks) { const float* wp = pw + ((size_t)g * 64 + ks * 16 + hi * 8) * 64 + db * 32 + r32;
            v4u o; o.x = pk2(wp[0], wp[64]); o.y = pk2(wp[128], wp[192]); o.z = pk2(wp[256], wp[320]); o.w = pk2(wp[384], wp[448]);
            acc = __builtin_amdgcn_mfma_f32_32x32x16_bf16(af[ks], __builtin_bit_cast(bf16x8, o), acc, 0, 0, 0); }
        const int col = g * 64 + db * 32 + r32; const float sc = pscale[col];
#pragma unroll
        for (int r = 0; r < 16; ++r) { const int row = tile * 64 + th * 32 + (r & 3) + 8 * (r >> 2) + 4 * hi; BR[(size_t)row * DM + col] = (bf16)f2bf(acc[r] * sc); } }
}
__device__ __forceinline__ void conv_unit(const Frame& F_, int tile, const bf16* P, const float* dw, const float* cb, const float* lg, const float* lb, bf16* BR) { Frame F = F_; F.lane = lane_id_(); F.tid = F.wave * 64 + F.lane;
    LAS float* hb = (LAS float*)(F.lds + RING_OFF);
    LAS float* yb = hb + 62 * 256;
    const int t0 = tile * 32, tb0 = t0 & (SEQ - 1);
    { v4u av[4], gv[4];
#pragma unroll
      for (int k = 0; k < 4; ++k) { const int e = F.tid + k * NWAVES * 64, rr = e >> 5, c8 = (e & 31) * 8, trel = rr - 30; const bool ok = e < 62 * 32 && tb0 + trel >= 0;
          const bf16* src = P + (size_t)(t0 + (ok ? trel : 0)) * PS + C_CONV + c8; av[k] = *(const v4u*)src; gv[k] = *(const v4u*)(src + 256); }
#pragma unroll
      for (int k = 0; k < 4; ++k) { const int e = F.tid + k * NWAVES * 64, rr = e >> 5, c8 = (e & 31) * 8, trel = rr - 30; const bool ok = tb0 + trel >= 0; const v4u a = av[k], gt = gv[k]; float h[8];
          h[0] = bfl(a.x) * sigmoidf_(bfl(gt.x)); h[1] = bfh(a.x) * sigmoidf_(bfh(gt.x)); h[2] = bfl(a.y) * sigmoidf_(bfl(gt.y)); h[3] = bfh(a.y) * sigmoidf_(bfh(gt.y));
          h[4] = bfl(a.z) * sigmoidf_(bfl(gt.z)); h[5] = bfh(a.z) * sigmoidf_(bfh(gt.z)); h[6] = bfl(a.w) * sigmoidf_(bfl(gt.w)); h[7] = bfh(a.w) * sigmoidf_(bfh(gt.w));
          if (!ok) {
#pragma unroll
              for (int q = 0; q < 8; ++q) h[q] = 0.f; }
          if (e < 62 * 32) { *(LAS f32x4*)(hb + rr * 256 + c8) = (f32x4){h[0], h[1], h[2], h[3]}; *(LAS f32x4*)(hb + rr * 256 + c8 + 4) = (f32x4){h[4], h[5], h[6], h[7]}; } } }
    __syncthreads();
    { const int c = F.tid & 255, hf = F.tid >> 8; float w[31];
#pragma unroll
      for (int j = 0; j < 31; ++j) w[j] = dw[j * 256 + c];
      const float bias = cb[c];
#pragma unroll 1
      for (int q4 = 0; q4 < 4; ++q4) { const int tt = hf * 16 + q4 * 4; float x[34];
#pragma unroll
          for (int j = 0; j < 34; ++j) x[j] = hb[(tt + j) * 256 + c];
#pragma unroll
          for (int o = 0; o < 4; ++o) { float a = bias;
#pragma unroll
              for (int j = 0; j < 31; ++j) a += x[o + j] * w[j];
              yb[(tt + o) * 256 + c] = a; } } }
    __syncthreads();
#pragma unroll 1
    for (int q = 0; q < 4; ++q) { const int tt = F.wave * 4 + q; const f32x4 v = *(const LAS f32x4*)(yb + tt * 256 + F.lane * 4);
        const float mean = wave_sum((v.x + v.y) + (v.z + v.w)) * (1.f / 256.f); const f32x4 d = v - mean;
        const float var = wave_sum((d.x * d.x + d.y * d.y) + (d.z * d.z + d.w * d.w)) * (1.f / 256.f); const float rstd = 1.f / sqrtf(var + LN_EPS);
        const f32x4 gg = *(const f32x4*)(lg + F.lane * 4), bb = *(const f32x4*)(lb + F.lane * 4); const f32x4 y = d * rstd * gg + bb;
        v2u o; o.x = pk2(y.x * sigmoidf_(y.x), y.y * sigmoidf_(y.y)); o.y = pk2(y.z * sigmoidf_(y.z), y.w * sigmoidf_(y.w));
        *(v2u*)(BR + (size_t)(t0 + tt) * DM + 768 + F.lane * 4) = o; }
    __syncthreads();
}
__device__ __forceinline__ int key28_(float s) { const int u = (int)__float_as_uint(s); int m = (u & 0x7fffffff) - 0x3B000000; m = m < 0 ? 0 : (m > 0x07FFFFFF ? 0x07FFFFFF : m); return 0x08000000 + (m ^ (u >> 31)); }
__device__ __forceinline__ int key9_(float s) { const int u = (int)__float_as_uint(s); int m = ((u >> 19) & 0xfff) - 0x760; m = m < 0 ? 0 : (m > 255 ? 255 : m); return 256 + (m ^ (u >> 31)); }
__device__ __forceinline__ float key28_lbound(long long kv) {
    if (kv <= 0) return -INFINITY; if (kv > 0x0FFFFFFFll) return INFINITY;
    if (kv > 0x08000000ll) return __uint_as_float((unsigned)(0x3B000000ll + (kv - 0x08000000ll)));
    if (kv == 0x08000000ll) return 0.f;
    return -__uint_as_float((unsigned)(0x3B000000ll + (0x07FFFFFFll - kv)));
}
constexpr int DS_HIST = 0, DS_GT = 65536, DS_EQ = 81920, DS_KT = 98304, DS_SM = LDSCTL_OFF + 1024 - RING_OFF, DS_CAP = 512;
typedef float f32x2p __attribute__((ext_vector_type(2)));
__device__ __forceinline__ float relu_(float x) { const int b = (int)__float_as_uint(x); return __uint_as_float((unsigned)(b > 0 ? b : 0)); }
__device__ __forceinline__ void dsa_ldk(bf16x8 (&kf)[4], const bf16* kp) {
#pragma unroll
    for (int m = 0; m < 4; ++m) kf[m] = *(const bf16x8*)(kp + m * 512);
}
__device__ __forceinline__ void dsa_kfrag(bf16x8 (&kf)[4], const bf16x8 (&raw)[4], LAS unsigned char* kt, int lane) {
    const int rw = lane >> 3, cw = lane & 7, r32 = lane & 31, hi = lane >> 5;
#pragma unroll
    for (int m = 0; m < 4; ++m) *(LAS bf16x8*)(kt + (8 * m + rw) * 128 + ((cw ^ rw) << 4)) = raw[m];
#pragma unroll
    for (int ks = 0; ks < 4; ++ks) kf[ks] = *(const LAS bf16x8*)(kt + r32 * 128 + (((2 * ks + hi) ^ (r32 & 7)) << 4));
}
__device__ __forceinline__ void dsa_scores(const bf16x8 (&qf)[4][4], const bf16x8 (&kf)[4], const float (&w)[4], float (&sc)[16]) {
    f32x16 a[4];
#pragma unroll
    for (int hh = 0; hh < 4; ++hh) { a[hh] = (f32x16){};
#pragma unroll
        for (int ks = 0; ks < 4; ++ks) a[hh] = __builtin_amdgcn_mfma_f32_32x32x16_bf16(kf[ks], qf[hh][ks], a[hh], 0, 0, 0); }
#pragma unroll
    for (int r = 0; r < 16; r += 2) { f32x2p s2 = (f32x2p){relu_(a[0][r]), relu_(a[0][r + 1])} * w[0];
#pragma unroll
        for (int hh = 1; hh < 4; ++hh) s2 = (f32x2p){relu_(a[hh][r]), relu_(a[hh][r + 1])} * w[hh] + s2;
        sc[r] = s2.x + 0.f; sc[r + 1] = s2.y + 0.f; }
}
template <int NB4> __device__ __forceinline__ void hist_scan(const LAS unsigned* h, int K, int lane, int& bin, int& above, int& inbin, int* total = nullptr) {
    unsigned hv[NB4 * 4]; int s = 0;
#pragma unroll
    for (int g = 0; g < NB4; ++g) { const v4u t = *(const LAS v4u*)(h + NB4 * 4 * lane + 4 * g); hv[4 * g] = t.x; hv[4 * g + 1] = t.y; hv[4 * g + 2] = t.z; hv[4 * g + 3] = t.w; s += (int)(t.x + t.y + t.z + t.w); }
    int suf = s;
#pragma unroll
    for (int o = 1; o < 64; o <<= 1) { const int t = __shfl_down(suf, o); if (lane + o < 64) suf += t; }
    if (total) *total = __shfl(suf, 0);
    const int excl = suf - s; const bool hit = (excl < K) && (K <= suf);
    int b = 0, c = excl, nb = 0; bool done = false;
#pragma unroll
    for (int k = NB4 * 4 - 1; k >= 0; --k) { if (!done) { if (c + (int)hv[k] >= K) { b = k; nb = (int)hv[k]; done = true; } else c += (int)hv[k]; } }
    const unsigned long long m = __ballot(hit); const int src = m ? (int)__builtin_ctzll(m) : 0;
    bin = __shfl(NB4 * 4 * lane + b, src); above = __shfl(c, src); inbin = __shfl(nb, src);
    if (!m) { bin = 0; above = 0; inbin = 0; }
}
#define DSA_ONE_TILE(KF, I, ...) do { const int i = (I); float sc[16]; { bf16x8 kfr[4]; dsa_kfrag(kfr, KF, ktile, F.lane); dsa_scores(qf, kfr, w, sc); } \
        if (i == j) { constexpr bool DIAG = true; __VA_ARGS__ } else { constexpr bool DIAG = false; __VA_ARGS__ } } while (0)
#define DSA_TILE_LOOP_S(STRIDE, ...) do { bf16x8 ka[4], kb[4]; int i0 = F.wave; \
    { const int ia = i0 <= j ? i0 : 0, ib = i0 + (STRIDE) <= j ? i0 + (STRIDE) : ia; dsa_ldk(ka, kbase + (size_t)ia * 32 * 64); dsa_ldk(kb, kbase + (size_t)ib * 32 * 64); } \
    _Pragma("unroll 1") for (; i0 <= j; i0 += 2 * (STRIDE)) { bf16x8 na[4], nb[4]; \
        { const int ia = i0 + 2 * (STRIDE) <= j ? i0 + 2 * (STRIDE) : i0, ib = i0 + 3 * (STRIDE) <= j ? i0 + 3 * (STRIDE) : i0; dsa_ldk(na, kbase + (size_t)ia * 32 * 64); dsa_ldk(nb, kbase + (size_t)ib * 32 * 64); } \
        __builtin_amdgcn_sched_barrier(0); \
        DSA_ONE_TILE(ka, i0, __VA_ARGS__); \
        if (i0 + (STRIDE) <= j) DSA_ONE_TILE(kb, i0 + (STRIDE), __VA_ARGS__); \
        _Pragma("unroll") for (int ks = 0; ks < 4; ++ks) { ka[ks] = na[ks]; kb[ks] = nb[ks]; } } } while (0)
#define DSA_TILE_LOOP(...) DSA_TILE_LOOP_S(NWAVES, __VA_ARGS__)
#define DSA_VALID(r) (!DIAG || ((r) & 3) + 8 * ((r) >> 2) <= qlim)
__device__ __forceinline__ void dsa_mask_unit(const Frame& F_, int b, int j, const bf16* P, const bf16* KIDX, const float* FW, unsigned long long* selw) { Frame F = F_; F.lane = lane_id_(); F.tid = F.wave * 64 + F.lane;
    LAS unsigned* HIST = (LAS unsigned*)(F.lds + RING_OFF + DS_HIST);
    LAS unsigned* GT = (LAS unsigned*)(F.lds + RING_OFF + DS_GT);
    LAS unsigned* EQ = (LAS unsigned*)(F.lds + RING_OFF + DS_EQ);
    LAS int* SM = (LAS int*)(F.lds + RING_OFF + DS_SM); volatile LAS unsigned* PRB = (volatile LAS unsigned*)(F.lds + LDSCTL_OFF + 512);
    PROBE_BEGIN(1);
    const int r32 = F.lane & 31, hi = F.lane >> 5, t0 = j * 32; const size_t brow = (size_t)b * SEQ;
    bf16x8 qf[4][4];
#pragma unroll
    for (int hh = 0; hh < 4; ++hh)
#pragma unroll
        for (int ks = 0; ks < 4; ++ks) qf[hh][ks] = *(const bf16x8*)(P + (brow + t0 + r32) * PS + C_IQ + hh * 64 + ks * 16 + hi * 8);
    float w[4]; { const f32x4 wv = *(const f32x4*)(FW + (brow + t0 + r32) * 8 + 4); w[0] = wv.x; w[1] = wv.y; w[2] = wv.z; w[3] = wv.w; }
    const bf16* kbase = KIDX + brow * 64 + F.lane * 8;
    LAS unsigned char* ktile = F.lds + RING_OFF + DS_KT + F.wave * 4096;
    const int qlim = r32 - 4 * hi;
    LAS unsigned* hrow = HIST + r32 * 512;
#define DSA_ZERO_HIST() do { for (int e = F.tid; e < 4096; e += NWAVES * 64) ((LAS v4u*)HIST)[e] = (v4u){0u, 0u, 0u, 0u}; } while (0)
    DSA_ZERO_HIST();
    if (F.tid < 64) SM[128 + F.tid] = 0;
    __syncthreads();
    PROBE_END(1); PROBE_BEGIN(2);
#if REP_PHASE == 41
    { float dummy = 0.f; DSA_TILE_LOOP({ _Pragma("unroll") for (int r = 0; r < 16; ++r) dummy += sc[r]; }); if (dummy == 12345.678f) SM[170] = 1; }
#endif
#if REP_PHASE == 42
    { LAS unsigned* drow = EQ + (r32 & 7) * 512; DSA_TILE_LOOP({ _Pragma("unroll") for (int r = 0; r < 16; ++r) { const int kh = key28_(sc[r]) >> 19; if (DSA_VALID(r)) __hip_atomic_fetch_add(drow + kh, 1u, __ATOMIC_RELAXED, __HIP_MEMORY_SCOPE_WORKGROUP); } }); }
#endif
#if REP_PHASE == 43
    { DSA_ZERO_HIST(); __syncthreads(); for (int q = F.wave * 4; q < F.wave * 4 + 4; ++q) { int bin, above, inbin; hist_scan<2>(HIST + q * 512, 256, F.lane, bin, above, inbin); if (F.lane == 0) SM[171] = bin; } __syncthreads(); __syncthreads(); __syncthreads(); }
#endif
    DSA_TILE_LOOP({ _Pragma("unroll")
        for (int r = 0; r < 16; ++r) { const int kh = key9_(sc[r]); if (DSA_VALID(r)) __hip_atomic_fetch_add(hrow + kh, 1u, __ATOMIC_RELAXED, __HIP_MEMORY_SCOPE_WORKGROUP); } });
    __syncthreads();
    PROBE_END(2); PROBE_BEGIN(3);
#pragma unroll 1
    for (int q = F.wave * 4; q < F.wave * 4 + 4; ++q) { int bin, above, inbin; hist_scan<2>(HIST + q * 512, 256, F.lane, bin, above, inbin);
        if (F.lane == 0) { const int total = t0 + q + 1;
            if (total <= 256) { SM[q] = -1; SM[32 + q] = 0; SM[64 + q] = 0; SM[96 + q] = 0; }
            else { SM[q] = bin; SM[32 + q] = above; SM[64 + q] = inbin; SM[96 + q] = 256 - above; if (inbin > DS_CAP) SM[160] = 1; } } }
    __syncthreads();
    PROBE_END(3); PROBE_BEGIN(4);
    const int myb1 = SM[r32];
    if (SM[160] == 0) {
        const float lge = key28_lbound((long long)myb1 << 19), lgt = key28_lbound(((long long)myb1 + 1) << 19);
        LAS unsigned* lrow = HIST + r32 * DS_CAP;
        DSA_TILE_LOOP({ unsigned gtw = 0u; unsigned cw = 0u; _Pragma("unroll")
            for (int r = 0; r < 16; ++r) { const int bit = (r & 3) + 8 * (r >> 2); const bool valid = DSA_VALID(r);
                if (valid && sc[r] >= lgt) gtw |= 1u << bit; else if (valid && sc[r] >= lge) cw |= 1u << r; }
            if (cw) {
                LAS float* sl = (LAS float*)ktile + F.lane; _Pragma("unroll")
                for (int r = 0; r < 16; ++r) sl[r * 64] = sc[r];
                int slot = (int)__hip_atomic_fetch_add((LAS unsigned*)SM + 128 + r32, (unsigned)__popc(cw), __ATOMIC_RELAXED, __HIP_MEMORY_SCOPE_WORKGROUP);
                while (cw) { const int r = __builtin_ctz(cw); cw &= cw - 1u; const float sv = sl[r * 64]; const int bit = (r & 3) + 8 * (r >> 2);
                    if (slot < DS_CAP) lrow[slot] = ((unsigned)(key28_(sv) & 0x7FFFF) << 12) | (unsigned)(4095 - (i * 32 + bit + 4 * hi)); ++slot; } }
            gtw <<= 4 * hi; gtw |= (unsigned)__shfl_xor((int)gtw, 32);
            if (hi == 0) GT[i * 32 + r32] = gtw; });
        __syncthreads();
        PROBE_END(4); PROBE_BEGIN(5);
#pragma unroll 1
        for (int q = F.wave * 4; q < F.wave * 4 + 4; ++q) { const int n = SM[128 + q] < DS_CAP ? SM[128 + q] : DS_CAP, quota = SM[96 + q]; const LAS unsigned* lq = HIST + q * DS_CAP;
            for (int c0 = 0; c0 < n; c0 += 64) { const int ci = c0 + F.lane; const unsigned e = ci < n ? lq[ci] : 0xffffffffu; int rank = 0;
                int k = 0;
                for (; k + 16 <= n; k += 16) { const v4u c0 = *(const LAS v4u*)(lq + k), c1 = *(const LAS v4u*)(lq + k + 4), c2 = *(const LAS v4u*)(lq + k + 8), c3 = *(const LAS v4u*)(lq + k + 12);
                    rank += (c0.x > e ? 1 : 0) + (c0.y > e ? 1 : 0) + (c0.z > e ? 1 : 0) + (c0.w > e ? 1 : 0) + (c1.x > e ? 1 : 0) + (c1.y > e ? 1 : 0) + (c1.z > e ? 1 : 0) + (c1.w > e ? 1 : 0)
                          + (c2.x > e ? 1 : 0) + (c2.y > e ? 1 : 0) + (c2.z > e ? 1 : 0) + (c2.w > e ? 1 : 0) + (c3.x > e ? 1 : 0) + (c3.y > e ? 1 : 0) + (c3.z > e ? 1 : 0) + (c3.w > e ? 1 : 0); }
                for (; k < n; ++k) rank += (lq[k] > e) ? 1 : 0;
                if (ci < n && rank < quota) { const int idx = 4095 - (int)(e & 4095u); __hip_atomic_fetch_or(GT + (idx >> 5) * 32 + q, 1u << (idx & 31), __ATOMIC_RELAXED, __HIP_MEMORY_SCOPE_WORKGROUP); } } }
        __syncthreads();
    } else {
        DSA_ZERO_HIST();
        __syncthreads();
        DSA_TILE_LOOP({ _Pragma("unroll")
            for (int r = 0; r < 16; ++r) { const int k = key28_(sc[r]); if ((k >> 19) == myb1 && DSA_VALID(r)) __hip_atomic_fetch_add(hrow + ((k >> 11) & 255), 1u, __ATOMIC_RELAXED, __HIP_MEMORY_SCOPE_WORKGROUP); } });
        __syncthreads();
#pragma unroll 1
        for (int q = F.wave * 4; q < F.wave * 4 + 4; ++q) { int bin, above, inbin; const int b1 = SM[q], ab1 = SM[32 + q]; hist_scan<1>(HIST + q * 512, 256 - ab1, F.lane, bin, above, inbin);
            if (F.lane == 0) { if (b1 < 0) { SM[192 + q] = -1; SM[96 + q] = 0; SM[224 + q] = 0; }
                else { const int quota = 256 - (ab1 + above); SM[192 + q] = (b1 << 8) | bin; SM[96 + q] = quota; SM[224 + q] = inbin; if (quota < inbin) SM[161] = 1; } } }
        __syncthreads();
        const int thr = SM[192 + r32]; const bool allacc = SM[96 + r32] >= SM[224 + r32];
        const float lge = key28_lbound((long long)thr << 11), lgt = key28_lbound(((long long)thr + 1) << 11);
        DSA_TILE_LOOP({ unsigned gtw = 0u; unsigned gew = 0u; _Pragma("unroll")
            for (int r = 0; r < 16; ++r) { const int bit = (r & 3) + 8 * (r >> 2); const bool valid = DSA_VALID(r);
                if (valid && sc[r] >= lgt) gtw |= 1u << bit; if (valid && sc[r] >= lge) gew |= 1u << bit; }
            gtw <<= 4 * hi; gew <<= 4 * hi;
            gtw |= (unsigned)__shfl_xor((int)gtw, 32); gew |= (unsigned)__shfl_xor((int)gew, 32);
            unsigned eqw = gew & ~gtw;
            if (allacc) { gtw = gew; eqw = 0u; }
            if (hi == 0) GT[i * 32 + r32] = gtw; else EQ[i * 32 + r32] = eqw; });
        __syncthreads();
        if (SM[161] != 0 && F.tid < 32) { const int q = F.tid; const int quota = SM[96 + q]; if (quota < SM[224 + q]) { int run = 0;
                for (int i = 0; i <= j; ++i) { unsigned e = EQ[i * 32 + q]; if (e) { const int allowed = quota - run; if (allowed <= 0) e = 0u; else { int pc = __popc(e); while (pc > allowed) { e &= ~(0x80000000u >> __clz(e)); --pc; } }
                        run += __popc(e); GT[i * 32 + q] |= e; } } } }
        __syncthreads();
    }
    PROBE_END(5); PROBE_BEGIN(6);
    { const int ntile64 = 4 * (j / 8 + 1); unsigned long long* dst = selw + (size_t)b * 64 * SEQ + t0;
      for (int e = F.tid; e < ntile64 * 32; e += NWAVES * 64) { const int T = e >> 5, q = e & 31; const unsigned lo = (2 * T <= j) ? GT[(2 * T) * 32 + q] : 0u, up = (2 * T + 1 <= j) ? GT[(2 * T + 1) * 32 + q] : 0u;
          dst[(size_t)T * SEQ + q] = ((unsigned long long)up << 32) | lo; } }
    __syncthreads();
    PROBE_END(6);
}
#undef DSA_TILE_LOOP
#undef DSA_ZERO_HIST
#undef DSA_TILE_LOOP_S
#undef DSA_ONE_TILE
#undef DSA_VALID
__device__ __forceinline__ void ln1_router_phase(const Frame& F_, const Args& a, int l, bool dry = false) { Frame F = F_; F.lane = lane_id_(); F.tid = F.wave * 64 + F.lane;
    LAS float* RW = (LAS float*)(F.lds + RING_OFF);
    LAS int* LC = (LAS int*)(F.lds + RING_OFF + 81920);
    LAS int* LTOK = LC + 64;
    LAS int* LCLS = LTOK + 128; LAS int* LPOS = LCLS + 128; LAS float* LGA = (LAS float*)(LPOS + 128); LAS float* LGB = LGA + 128;
    volatile LAS unsigned* PRB = (volatile LAS unsigned*)(F.lds + LDSCTL_OFF + 512);
    PROBE_BEGIN(31);
    const float* rg = a.in[16] + (size_t)l * DM * 4; const float* re = a.in[18] + (size_t)l * DM * 16;
    for (int e = F.tid; e < DM * 4; e += NWAVES * 64) { const int k = e >> 2, c = e & 3, ln = (k & 255) >> 2, kidx = (k >> 8) * 4 + (k & 3); RW[((kidx * 5 + 0) * 64 + ln) * 4 + c] = rg[e]; }
    for (int e = F.tid; e < DM * 16; e += NWAVES * 64) { const int k = e >> 4, c = 4 + (e & 15), ln = (k & 255) >> 2, kidx = (k >> 8) * 4 + (k & 3); RW[((kidx * 5 + (c >> 2)) * 64 + ln) * 4 + (c & 3)] = re[e]; }
    if (F.tid < 64) LC[F.tid] = 0;
    __syncthreads();
    PROBE_END(31); PROBE_BEGIN(32);
    const float* rgb = a.in[17] + l * 4; const float* reb = a.in[19] + l * 16;
    const float* g1 = a.in[14] + (size_t)l * DM; const float* b1 = a.in[15] + (size_t)l * DM;
    int* list = (int*)(F.ws + WS_LIST); float* gwl = (float*)(F.ws + WS_GWL);
    const int rows_per_blk = NTOK / F.G;
    LnGB gb; ln_gb_load(F, g1, b1, gb);
    float rb[20];
#pragma unroll
    for (int c = 0; c < 4; ++c) rb[c] = rgb[c];
#pragma unroll
    for (int c = 0; c < 16; ++c) rb[4 + c] = reb[c];
    const bf16* V1 = wsb(F, WS_R2);
    f32x4 nx[4]; ln_load_bf(F, V1 + (size_t)(F.vcu * rows_per_blk + F.wave) * DM, nx);
    for (int rr = F.wave; rr < rows_per_blk; rr += NWAVES) { const int m = F.vcu * rows_per_blk + rr; f32x4 v[4];
#pragma unroll
        for (int j = 0; j < 4; ++j) v[j] = nx[j];
        if (rr + NWAVES < rows_per_blk) ln_load_bf(F, V1 + (size_t)(m + NWAVES) * DM, nx);
        ln_row(F, gb, nullptr, wsb(F, WS_HB) + (size_t)m * DM, v, dry);
        float gl[4] = {0.f, 0.f, 0.f, 0.f};
#pragma unroll
        for (int jj = 0; jj < 4; ++jj)
#pragma unroll
            for (int k = 0; k < 4; ++k) { const f32x4 wv = *(const LAS f32x4*)(RW + (((jj * 4 + k) * 5) * 64 + F.lane) * 4); const float xv = v[jj][k];
                gl[0] += xv * wv.x; gl[1] += xv * wv.y; gl[2] += xv * wv.z; gl[3] += xv * wv.w; }
        int gi = 0; float gm;
#pragma unroll
        for (int c = 0; c < 4; ++c) gl[c] = wave_sum(gl[c]) + rb[c];
        gm = gl[0];
#pragma unroll
        for (int c = 1; c < 4; ++c) if (gl[c] > gm) { gm = gl[c]; gi = c; }
        float gs = 0.f;
#pragma unroll
        for (int c = 0; c < 4; ++c) gs += expf(gl[c] - gm);
        const float pg = 1.f / gs;
        float el[4] = {0.f, 0.f, 0.f, 0.f};
        { const LAS float* wg = RW + ((1 + gi) * 64 + F.lane) * 4;
#pragma unroll
          for (int jj = 0; jj < 4; ++jj)
#pragma unroll
            for (int k = 0; k < 4; ++k) { const f32x4 wv = *(const LAS f32x4*)(wg + ((jj * 4 + k) * 5) * 256); const float xv = v[jj][k];
                el[0] += xv * wv.x; el[1] += xv * wv.y; el[2] += xv * wv.z; el[3] += xv * wv.w; } }
#pragma unroll
        for (int c = 0; c < 4; ++c) { float bsel = rb[4 + c];
#pragma unroll
            for (int g = 1; g < 4; ++g) if (gi == g) bsel = rb[4 + 4 * g + c];
            el[c] = wave_sum(el[c]) + bsel; }
        int i1 = 0; float m1 = el[0];
#pragma unroll
        for (int c = 1; c < 4; ++c) if (el[c] > m1) { m1 = el[c]; i1 = c; }
        int i2 = -1; float m2 = -INFINITY;
#pragma unroll
        for (int c = 0; c < 4; ++c) if (c != i1 && el[c] > m2) { m2 = el[c]; i2 = c; }
        const float e2 = expf(m2 - m1); const float p1 = 1.f / (1.f + e2), p2 = e2 / (1.f + e2);
        const int ia = i1 < i2 ? i1 : i2, ib = i1 < i2 ? i2 : i1; const float ga = pg * (i1 < i2 ? p1 : p2), gb = pg * (i1 < i2 ? p2 : p1);
        const int pidx = ia == 0 ? ib - 1 : (ia == 1 ? ib + 1 : 5); const int cls = gi * 6 + pidx;
        if (F.lane == 0) { const int pos = __hip_atomic_fetch_add(&LC[cls], 1, __ATOMIC_RELAXED, __HIP_MEMORY_SCOPE_WORKGROUP); LTOK[rr] = m; LCLS[rr] = cls; LPOS[rr] = pos; LGA[rr] = ga; LGB[rr] = gb; }
    }
    __syncthreads();
    PROBE_END(32);
    if (dry) return;
    PROBE_BEGIN(33);
    if (F.tid < NCLS) { const int n = LC[F.tid]; LC[32 + F.tid] = n ? (int)atomicAdd((unsigned*)(F.ctl + CW_CNT + (l * NCLS + F.tid) * 64), (unsigned)n) : 0; }
    __syncthreads();
    for (int rr = F.tid; rr < rows_per_blk; rr += NWAVES * 64) { const int cls = LCLS[rr], pos = LC[32 + cls] + LPOS[rr];
        list[(size_t)cls * NTOK + pos] = LTOK[rr]; gwl[((size_t)cls * NTOK + pos) * 2] = LGA[rr]; gwl[((size_t)cls * NTOK + pos) * 2 + 1] = LGB[rr]; }
    __syncthreads();
    PROBE_END(33);
}
__device__ __forceinline__ void ln2_phase(const Frame& F_, const Args& a, int l, bool dry = false) { Frame F = F_; F.lane = lane_id_(); F.tid = F.wave * 64 + F.lane;
    const float* g2 = a.in[23] + (size_t)l * DM; const float* b2 = a.in[24] + (size_t)l * DM; const bf16* V2 = wsb(F, WS_R1); const bool last = (l == DEPTH - 1);
    const int gw = F.vcu * NWAVES + F.wave, NGW = F.G * NWAVES;
    LnGB gb; ln_gb_load(F, g2, b2, gb);
    f32x4 nx[4]; ln_load_bf(F, V2 + (size_t)gw * DM, nx);
    for (int m = gw; m < NTOK; m += NGW) { f32x4 v[4];
#pragma unroll
        for (int j = 0; j < 4; ++j) v[j] = nx[j];
        if (m + NGW < NTOK) ln_load_bf(F, V2 + (size_t)(m + NGW) * DM, nx);
        ln_row(F, gb, last ? F.out + (size_t)m * DM : nullptr, wsb(F, WS_HB) + (size_t)m * DM, v, dry, last ? nullptr : F.ws + WS_HB8 + (size_t)m * DM); }
}
__device__ __forceinline__ void moe_table(const Frame& F, int l, LAS int* tab) {
    const int tid = F.wave * 64 + lane_id_();
    if (tid < NCLS) tab[tid] = (int)__hip_atomic_load(F.ctl + CW_CNT + (l * NCLS + tid) * 64, RLX_AGENT);
    __syncthreads();
    if (tid == 0) { int s = 0; for (int c = 0; c < NCLS; ++c) { tab[32 + c] = s; s += (tab[c] + 255) >> 8; } tab[32 + NCLS] = s; tab[57] = s; }
    __syncthreads();
}
#define NREP(k) (((REP_PHASE) == (k) || ((k) == 4 && ((REP_PHASE) == 60 || (REP_PHASE) == 61))) ? 2 : 1)
#define DRY(k) ((REP_PHASE) == (k) && rep_ == 0 && args.ph_hi != 7777)
#ifndef MK_PER_PHASE
#define MK_PER_PHASE 0
#endif
constexpr int PH_PER_LAYER = 9, N_PHASES = 1 + DEPTH * PH_PER_LAYER;
__global__ void __launch_bounds__(NWAVES * 64, 2) fwd_kernel(Args args) {
    extern __shared__ __attribute__((aligned(16))) unsigned char lds[];
    Frame F0; Frame& F = F0;
    F.lds = (LAS unsigned char*)lds; F.ldsg = lds;
    F.MISC = (volatile LAS unsigned*)(F.lds + MISC_OFF);
    F.wave = __builtin_amdgcn_readfirstlane((int)threadIdx.x >> 6); F.lane = lane_id_(); F.tid = F.wave * 64 + F.lane;
    F.G = gridDim.x; { const int bx = blockIdx.x; F.vcu = (F.G % 8 == 0) ? (bx % 8) * (F.G / 8) + bx / 8 : bx; }
    F.ws = args.ws; F.out = args.out; F.ctl = (gu32*)(args.ws + WS_CTL);
    for (int u = F0.tid; u < (LDS_BYTES - LDSCTL_OFF) / 4; u += NWAVES * 64) ((LAS unsigned*)(F.lds + LDSCTL_OFF))[u] = 0u;
    __syncthreads();
    XcdBarrier bar; bar.bar = (unsigned*)(F.ctl + CW_BAR); bar.x = 0; bar.st = nullptr;
    if (!MK_PER_PHASE) bar = xcd_barrier_post((unsigned*)(F.ctl + CW_BAR), F.MISC + 8);
    const int lo = MK_PER_PHASE ? args.ph_lo : 0, hi = MK_PER_PHASE ? args.ph_hi : N_PHASES;
#define IN(k) (lo <= (k) && (k) < hi)
#ifndef PH_ONLY
#define PH_ONLY -1
#endif
#define EN(k) (PH_ONLY < 0 || PH_ONLY == (k))
#define SEAM(k) do { if (IN(k) && IN((k) + 1)) { PROBE_BEGIN(20); xcd_barrier(bar, F0.wave); PROBE_END(20); } } while (0)
    volatile LAS unsigned* PRB = (volatile LAS unsigned*)(F0.lds + LDSCTL_OFF + 512);
    LAS int* TAB = (LAS int*)(F.lds + LDSCTL_OFF + 64);
    bf16* const HB = wsb(F, WS_HB); bf16* const P = wsb(F, WS_R1); bf16* const MIX = wsb(F, WS_R1); bf16* const BR = wsb(F, WS_R2); bf16* const ACT = wsb(F, WS_R2);
    float* const FW = (float*)(F.ws + WS_FW); float* const BIAS2 = (float*)(F.ws + WS_BIAS2); unsigned long long* const SELW = (unsigned long long*)(F.ws + WS_SELW);

#define FRESH(Fn) Frame Fn = F0; Fn.vcu = opaque_s(F0.vcu); Fn.wave = opaque_s(F0.wave); Fn.lane = lane_id_(); Fn.tid = Fn.wave * 64 + Fn.lane
    for (int rep_ = 0; rep_ < ((REP_PHASE) == 10 ? 2 : 1); ++rep_) if (EN(0) && IN(0)) { FRESH(Fp); p0_prologue(Fp, args); }
    SEAM(0);
#pragma unroll 1
    for (int l0 = 0; l0 < DEPTH; ++l0) {
        const int pb = 1 + PH_PER_LAYER * l0;
#define l opaque_s(l0)
#define W (wsb(F, WS_W + (size_t)l * W_LAYER))
        for (int rep_ = 0; rep_ < NREP(1); ++rep_) if (EN(1) && IN(pb)) { SchedA S; S.T.init(NTOK / 256, PS / 256, F.G, opaque_s((int)blockIdx.x)); S.A = (const char*)HB; S.B = (const char*)(W + W_SM / 2);
            EpiA E{P, FW, wsb(F, WS_KIDX)}; pg8::gemm_phase<EpiA, SchedA, false>(F.lds + RING_OFF, (LAS unsigned*)(F.lds + LDSCTL_OFF + 1024), F0.wave, S, E); }
        SEAM(pb);
        for (int rep_ = 0; rep_ < NREP(2); ++rep_) if (EN(2) && IN(pb + 1)) { FRESH(Fp);
#ifndef NO_CUMSUM
            if (Fp.vcu < 32 && Fp.wave == 0) fox_cumsum(Fp, Fp.vcu, FW, args.in[4] + l * 4, BIAS2);
#endif
#ifndef NO_POOL
            for (int rp_ = 0; rp_ < ((REP_PHASE) == 21 ? 2 : 1); ++rp_) for (int k = 0; k < 2; ++k) pool_unit(Fp, Fp.vcu * 2 + k, P, args.in[6] + (size_t)l * 4 * 64 * 64, args.in[7] + (size_t)l * 256, BR);
#endif
#ifndef NO_CONV
            for (int rp_ = 0; rp_ < ((REP_PHASE) == 22 ? 2 : 1); ++rp_) for (int k = 0; k < 4; ++k) conv_unit(Fp, Fp.vcu * 4 + k, P, args.in[8] + (size_t)l * 31 * 256, args.in[9] + (size_t)l * 256, args.in[10] + (size_t)l * 256, args.in[11] + (size_t)l * 256, BR);
#endif
#ifndef NO_DSA
            { const int b = Fp.vcu >> 5, s = Fp.vcu & 31;
#pragma unroll 1
              for (int k = 0; k < ((REP_PHASE) == 23 ? 8 : 4); ++k) { const int j = (k & 3) == 0 ? 127 - s : ((k & 3) == 1 ? 64 + s : ((k & 3) == 2 ? 63 - s : s)); dsa_mask_unit(Fp, b, j, P, wsb(F, WS_KIDX), FW, SELW); } }
#endif
        }
        SEAM(pb + 1);
        for (int rep_ = 0; rep_ < NREP(3); ++rep_) if (EN(3) && IN(pb + 2)) { const int vc_ = opaque_s(F0.vcu); const int sg = vc_ >> 3, s = vc_ & 7, b = sg >> 2, h = sg & 3; const size_t rb = (size_t)b * SEQ;
            const attn_body::bf16* Pb = (const attn_body::bf16*)P + rb * PS; attn_body::bf16* Ob = (attn_body::bf16*)BR + rb * DM;
#pragma unroll 1
            for (int k = 0; k < ((REP_PHASE) == 31 ? 4 : 2); ++k) { const int qb = (k & 1) == 0 ? 15 - s : s;
                attn_body::attn_unit<24, false>(qb * 256, Pb + C_FQ + h * 64, Pb + C_FK + h * 64, Pb + C_FV + h * 64, Ob + 256 + h * 64, BIAS2 + (size_t)(b * 4 + h) * SEQ, 0.f, nullptr, (char*)lds + RING_OFF, F0.wave); }
            const float slope2 = exp2f(-2.f * (float)(h + 1)) * LOG2E;
#pragma unroll 1
            for (int k = 0; k < ((REP_PHASE) == 32 ? 4 : 2); ++k) { const int qb = (k & 1) == 0 ? 15 - s : s;
                attn_body::attn_unit<24, true>(qb * 256, Pb + C_DQ + h * 64, Pb + C_DK, Pb + C_DV, Ob + 512 + h * 64, nullptr, slope2, SELW + (size_t)b * 64 * SEQ, (char*)lds + RING_OFF, F0.wave); }
        }
        SEAM(pb + 2);
        for (int rep_ = 0; rep_ < NREP(4); ++rep_) if (EN(4) && IN(pb + 3)) { SchedC S; S.T.init(NTOK / 256, DM / 128, F.G, opaque_s((int)blockIdx.x)); S.HBp = (const char*)(F.ws + WS_HB8); S.BRp = (const char*)BR; S.WGp = (const char*)(W + W_GT / 2); S.WBp = (const char*)(W + W_BR / 2); S.collapse = ((REP_PHASE) == 61 && rep_ == 0 && args.ph_hi != 7777);
            EpiC E; E.dry = (((REP_PHASE) == 60 || (REP_PHASE) == 61) && rep_ == 0 && args.ph_hi != 7777); E.MIX = MIX; E.bgate = args.in[5] + (size_t)l * 4 * DM; pg8::gemm_phase_c8<EpiC, SchedC>(F.lds + RING_OFF, F0.wave, S, E); }
        SEAM(pb + 3);
        for (int rep_ = 0; rep_ < NREP(5); ++rep_) if (EN(5) && IN(pb + 4)) { SchedC2 S; S.T.init(NTOK / 256, DM / 256, F.G, opaque_s((int)blockIdx.x)); S.A = (const char*)MIX; S.B = (const char*)(W + W_OUT / 2);
            EpiRes E{BR  , HB, DRY(5)}; pg8::gemm_phase<EpiRes, SchedC2, false>(F.lds + RING_OFF, (LAS unsigned*)(F.lds + LDSCTL_OFF + 1024), F0.wave, S, E); }
        SEAM(pb + 4);
        for (int rep_ = 0; rep_ < NREP(6); ++rep_) if (EN(6) && IN(pb + 5)) { FRESH(Fp); PROBE_BEGIN(21); ln1_router_phase(Fp, args, l, DRY(6)); PROBE_END(21); }
        SEAM(pb + 5);
        for (int rep_ = 0; rep_ < NREP(7); ++rep_) if (EN(7) && IN(pb + 6)) { moe_table(F, l, TAB);
            SchedD1 S{TAB, F.G, opaque_s((int)blockIdx.x), (const char*)HB, (const char*)(W + W_GU / 2), (const int*)(F.ws + WS_LIST)};
            EpiD1 E{ACT, (const float*)(F.ws + WS_GWL)}; pg8::gemm_phase<EpiD1, SchedD1, true>(F.lds + RING_OFF, (LAS unsigned*)(F.lds + LDSCTL_OFF + 1024), F0.wave, S, E); }
        SEAM(pb + 6);
        for (int rep_ = 0; rep_ < NREP(8); ++rep_) if (EN(8) && IN(pb + 7)) { moe_table(F, l, TAB);
            SchedD2 S{TAB, F.G, opaque_s((int)blockIdx.x), (const char*)ACT, (const char*)(W + W_D / 2), (const int*)(F.ws + WS_LIST)};
            EpiD2 E{wsb(F, WS_R1), HB, DRY(8)}; pg8::gemm_phase<EpiD2, SchedD2, false>(F.lds + RING_OFF, (LAS unsigned*)(F.lds + LDSCTL_OFF + 1024), F0.wave, S, E); }
        SEAM(pb + 7);
        for (int rep_ = 0; rep_ < NREP(9); ++rep_) if (EN(9) && IN(pb + 8)) { FRESH(Fp); PROBE_BEGIN(22); ln2_phase(Fp, args, l, DRY(9)); PROBE_END(22); }
        SEAM(pb + 8);
#undef l
#undef W
    }
#undef IN
#undef SEAM
    if ((REP_PHASE) >= 100 && blockIdx.x == 0 && F0.wave == 0 && lane_id_() == 0) { volatile LAS unsigned* PRB = (volatile LAS unsigned*)(F0.lds + LDSCTL_OFF + 512); const unsigned long long a_ = (((unsigned long long)PRB[1]) << 32) | PRB[0];
        const unsigned long long t0_ = __builtin_amdgcn_s_memrealtime(); while (__builtin_amdgcn_s_memrealtime() - t0_ < a_) __builtin_amdgcn_s_sleep(8); }
}

extern "C" void kernel_launch(void* const* d_in, const int* in_sizes, int n_in, void* d_out, int out_size, void* d_ws, size_t ws_size, hipStream_t stream) {
    static int grid = 0;
    if (grid == 0) {
        if (n_in != 25 || in_sizes[0] != NTOK * DM || out_size != NTOK * DM || ws_size < WS_END) { fprintf(stderr, "kernel_launch: unexpected shapes (n_in %d, in0 %d, out %d, ws %zu); nothing launched\n", n_in, n_in > 0 ? in_sizes[0] : -1, out_size, ws_size); grid = -1; return; }
        int dev = 0, cus = 0, per_cu = 0;
        if (hipGetDevice(&dev) != hipSuccess || hipDeviceGetAttribute(&cus, hipDeviceAttributeMultiprocessorCount, dev) != hipSuccess) { grid = -1; return; }
        if (hipFuncSetAttribute((const void*)fwd_kernel, hipFuncAttributeMaxDynamicSharedMemorySize, LDS_BYTES) != hipSuccess) { fprintf(stderr, "kernel_launch: hipFuncSetAttribute failed\n"); grid = -1; return; }
        if (hipOccupancyMaxActiveBlocksPerMultiprocessor(&per_cu, (const void*)fwd_kernel, NWAVES * 64, LDS_BYTES) != hipSuccess || per_cu < 1) fprintf(stderr, "kernel_launch: occupancy query reports %d\n", per_cu);
        (void)hipGetLastError();
        grid = cus;
        if (grid != 256) { fprintf(stderr, "kernel_launch: built for 256 CUs, device has %d; nothing launched\n", cus); grid = -1; return; }
    }
    if (grid < 0) return;
    if (hipMemsetAsync((char*)d_ws + WS_CTL, 0, CTL_ZERO_BYTES, stream) != hipSuccess) return;
    Args a{};
    for (int i = 0; i < 25; ++i) a.in[i] = (const float*)d_in[i];
    a.out = (float*)d_out; a.ws = (unsigned char*)d_ws;
#if MK_PER_PHASE
    for (int p = 0; p < N_PHASES; ++p) { a.ph_lo = p; a.ph_hi = p + 1; hipLaunchKernelGGL(fwd_kernel, dim3(grid), dim3(NWAVES * 64), LDS_BYTES, stream, a); }
#else
    a.ph_lo = 0; a.ph_hi = N_PHASES;
    hipLaunchKernelGGL(fwd_kernel, dim3(grid), dim3(NWAVES * 64), LDS_BYTES, stream, a);
#endif
}
```

```cpp
#include <hip/hip_runtime.h>
#include <hip/hip_bf16.h>
#include <cstdio>
#include <cstdint>
#include <cmath>

#ifndef REP_PHASE
#define REP_PHASE 0
#endif
#define PROBE_BEGIN(id) do { if ((REP_PHASE) == 100 + (id) && blockIdx.x == 0) { __syncthreads(); if (F.wave == 0 && lane_id_() == 0) { const unsigned long long t_ = __builtin_amdgcn_s_memrealtime(); PRB[2] = (unsigned)t_; PRB[3] = (unsigned)(t_ >> 32); } } } while (0)
#define PROBE_END(id) do { if ((REP_PHASE) == 100 + (id) && blockIdx.x == 0) { __syncthreads(); if (F.wave == 0 && lane_id_() == 0) { const unsigned long long t_ = __builtin_amdgcn_s_memrealtime() - (((unsigned long long)PRB[3] << 32) | PRB[2]); const unsigned long long a_ = ((((unsigned long long)PRB[1]) << 32) | PRB[0]) + t_; PRB[0] = (unsigned)a_; PRB[1] = (unsigned)(a_ >> 32); } } } while (0)
constexpr int BATCH = 8, SEQ = 4096, DM = 1024, NTOK = BATCH * SEQ, DEPTH = 2;
constexpr int P_TOTAL = 6344, PS = 2304;
constexpr int C_POOL = 0, C_FQ = 256, C_FK = 512, C_FV = 768, C_DQ = 1024, C_IQ = 1280, C_CONV = 1536, C_DK = 2048, C_DV = 2112, C_IK = 2176, C_FF = 2240, C_IW = 2244;
constexpr float LN_EPS = 1e-5f;
constexpr float ALPHA = 1.4142135623730951f;
constexpr float LOG2E = 1.4426950408889634f;
constexpr int NWAVES = 8;
constexpr int NCLS = 24;
constexpr int MAXTILES = NTOK / 256 + NCLS;

constexpr size_t MiB = 1u << 20;
constexpr size_t WS_CTL = 0, CTL_ZERO_BYTES = 1 * MiB;
constexpr size_t WS_FW = 1 * MiB;
constexpr size_t WS_BIAS2 = 2 * MiB;
constexpr size_t WS_LIST = 3 * MiB;
constexpr size_t WS_GWL = 6 * MiB;
constexpr size_t WS_SELW = 12 * MiB;
constexpr size_t WS_HB8 = 28 * MiB;
constexpr size_t WS_W = 60 * MiB;
constexpr size_t W_SM = 0, W_GT = 4718592, W_BR = W_GT + 8 * MiB, W_OUT = W_BR + 2 * MiB, W_GU = W_OUT + 2 * MiB, W_D = W_GU + 32 * MiB, W_LAYER = W_D + 16 * MiB;
constexpr size_t WS_HB = 190 * MiB;
constexpr size_t WS_R1 = 254 * MiB;
constexpr size_t WS_R2 = 398 * MiB;
constexpr size_t WS_KIDX = 474 * MiB;
constexpr size_t WS_END = 478 * MiB;
static_assert(WS_W + 2 * W_LAYER <= WS_HB && WS_R1 + (size_t)NTOK * PS * 2 <= WS_R2 && WS_R2 + (size_t)MAXTILES * 256 * DM * 2 <= WS_END, "d_ws map");
constexpr int CW_BAR = 4096;
constexpr int CW_SEAMC = 8192;
constexpr int CW_CNT = 16384;

constexpr int RING_OFF = 0, RING_BYTES = 131072;
constexpr int LDSCTL_OFF = RING_BYTES, MISC_OFF = LDSCTL_OFF + 320;
constexpr int LDS_BYTES = 147456;

#define GAS __attribute__((address_space(1)))
#define LAS __attribute__((address_space(3)))
typedef unsigned short bf16;
typedef unsigned v4u __attribute__((ext_vector_type(4)));
typedef unsigned v2u __attribute__((ext_vector_type(2)));
typedef float f32x4 __attribute__((ext_vector_type(4)));
typedef float f32x16 __attribute__((ext_vector_type(16)));
typedef short bf16x8 __attribute__((ext_vector_type(8)));
typedef GAS unsigned gu32;
#define RLX_AGENT __ATOMIC_RELAXED, __HIP_MEMORY_SCOPE_AGENT
#define LDS_WAIT() asm volatile("s_waitcnt lgkmcnt(0)" ::: "memory")
#define VM_WAIT() asm volatile("s_waitcnt vmcnt(0)" ::: "memory")
__device__ __forceinline__ int opaque_i(int x) { asm volatile("" : "+v"(x)); return x; }
__device__ __forceinline__ int lane_id_() { int x; asm volatile("v_mbcnt_lo_u32_b32 %0, -1, 0\n\tv_mbcnt_hi_u32_b32 %0, -1, %0" : "=v"(x)); return x; }
__device__ __forceinline__ float zero_() { int z = 0; asm volatile("" : "+v"(z)); return __builtin_bit_cast(float, z); }
__device__ __forceinline__ const char* sptr_(const char* p) { const unsigned long long v = (unsigned long long)p; const unsigned lo = (unsigned)__builtin_amdgcn_readfirstlane((int)(unsigned)v), hi = (unsigned)__builtin_amdgcn_readfirstlane((int)(unsigned)(v >> 32)); return (const char*)(((unsigned long long)hi << 32) | lo); }
__device__ __forceinline__ int shfl_i_(int v, int srclane) { return __builtin_amdgcn_ds_bpermute(srclane << 2, v); }
__device__ __forceinline__ int opaque_s(int x) { asm volatile("" : "+s"(x)); return x; }
__device__ __forceinline__ unsigned f2bf(float f) { unsigned u = __builtin_bit_cast(unsigned, f); return (u + 0x7fffu + ((u >> 16) & 1u)) >> 16; }
__device__ __forceinline__ unsigned pk2(float lo, float hi) { return f2bf(lo) | (f2bf(hi) << 16); }
__device__ __forceinline__ unsigned pk4_fp8(float a, float b, float c, float d) { int r = __builtin_amdgcn_cvt_pk_fp8_f32(a, b, 0, false); r = __builtin_amdgcn_cvt_pk_fp8_f32(c, d, r, true); return (unsigned)r; }
__device__ __forceinline__ float bfl(unsigned w) { return __uint_as_float(w << 16); }
__device__ __forceinline__ float bfh(unsigned w) { return __uint_as_float(w & 0xffff0000u); }
__device__ __forceinline__ float bf1(bf16 h) { return __uint_as_float((unsigned)h << 16); }
__device__ __forceinline__ float sigmoidf_(float x) { return __builtin_amdgcn_rcpf(1.f + __builtin_amdgcn_exp2f(-x * LOG2E)); }

#define XB_TMO      128
#define XB_XCNT(j)  (256  + 64 * (j))
#define XB_XSUB(j)  (1280 + 64 * (j))
#define XB_XGEN(j)  (2304 + 64 * (j))
#define XB_TOP      3328
#define XB_TOPGEN   3392
#define XCD_BAR_WORDS 3456
#define XB_SPIN_CAP (1u << 18)
__device__ __forceinline__ unsigned xb_ld(unsigned* p)              { return __hip_atomic_load(p, __ATOMIC_RELAXED, __HIP_MEMORY_SCOPE_AGENT); }
__device__ __forceinline__ unsigned xb_add(unsigned* p, unsigned v) { return __hip_atomic_fetch_add(p, v, __ATOMIC_RELAXED, __HIP_MEMORY_SCOPE_AGENT); }
__device__ __forceinline__ unsigned xb_xcc_id() { return (unsigned)__builtin_amdgcn_s_getreg((3 << 11) | 20) & 0xFu; }
#define XB_SPIN(cond, bar) do { unsigned _sp = 0; while (cond) { __builtin_amdgcn_s_sleep(1); \
    if ((++_sp & 255u) == 0u) { if (xb_ld(&(bar)[XB_TMO])) break; if (_sp > XB_SPIN_CAP) { atomicAdd(&(bar)[XB_TMO], 1u); break; } } } } while (0)
struct XcdBarrier { unsigned* bar; unsigned x; volatile LAS unsigned* st; };
__device__ __forceinline__ XcdBarrier xcd_barrier_post(unsigned* bar, volatile LAS unsigned* st) {
    XcdBarrier b; b.bar = bar; b.x = xb_xcc_id(); b.st = st;
    if (threadIdx.x == 0) (void)xb_add(&bar[XB_XCNT(b.x)], 1u);
    return b;
}
__device__ __forceinline__ void xcd_barrier_complete(unsigned* bar, unsigned x, unsigned& nloc, unsigned& nx) {
    const unsigned G = gridDim.x * gridDim.y * gridDim.z;
    unsigned sum, cnt, mine, sp = 0u;
    for (;;) {
        sum = 0u; cnt = 0u; mine = 0u;
#pragma unroll
        for (unsigned j = 0; j < 16; ++j) { const unsigned c = xb_ld(&bar[XB_XCNT(j)]); sum += c; cnt += (c > 0u) ? 1u : 0u; mine = (j == x) ? c : mine; }
        if (sum == G) break;
        __builtin_amdgcn_s_sleep(1);
        if ((++sp & 255u) == 0u) { if (xb_ld(&bar[XB_TMO])) break; if (sp > XB_SPIN_CAP) { atomicAdd(&bar[XB_TMO], 1u); break; } }
    }
    nloc = mine > 0u ? mine : 1u; nx = cnt > 0u ? cnt : 1u;
}
__device__ __forceinline__ void xcd_barrier(const XcdBarrier& b, int wave) {
    asm volatile("s_waitcnt vmcnt(0)" ::: "memory");
    __syncthreads();
    if (wave == 0 && lane_id_() == 0) {
        unsigned* bar = b.bar; const unsigned bx = (unsigned)opaque_s((int)xb_xcc_id());
        __builtin_amdgcn_s_waitcnt(0);
        unsigned nloc = b.st[0], nx = b.st[1];
        if (nloc == 0u) { xcd_barrier_complete(bar, bx, nloc, nx); b.st[0] = nloc; b.st[1] = nx; }
        const unsigned old = xb_add(&bar[XB_XSUB(bx)], 1u);
        const unsigned gen = old / nloc;
        if (old + 1u == (gen + 1u) * nloc) {
            __builtin_amdgcn_fence(__ATOMIC_RELEASE, "agent");
            asm volatile("s_waitcnt vmcnt(0)" ::: "memory");
            const unsigned og = xb_add(&bar[XB_TOP], 1u);
            const unsigned tg = og / nx;
            if (og + 1u == (tg + 1u) * nx) xb_add(&bar[XB_TOPGEN], 1u);
            else XB_SPIN(xb_ld(&bar[XB_TOPGEN]) == tg, bar);
            __builtin_amdgcn_fence(__ATOMIC_ACQUIRE, "agent");
            xb_add(&bar[XB_XGEN(bx)], 1u);
            asm volatile("s_waitcnt vmcnt(0)" ::: "memory");
        } else {
            XB_SPIN(xb_ld(&bar[XB_XGEN(bx)]) == gen, bar);
            __builtin_amdgcn_fence(__ATOMIC_ACQUIRE, "agent");
            asm volatile("s_waitcnt vmcnt(0)" ::: "memory");
        }
    }
    __syncthreads();
}
namespace pg8 {
#define PG8_LAS __attribute__((address_space(3)))
typedef unsigned short bf16_t;
typedef short bf16x8 __attribute__((ext_vector_type(8)));
typedef float f32x4 __attribute__((ext_vector_type(4)));
typedef float f32x2 __attribute__((ext_vector_type(2)));
typedef unsigned u32x4 __attribute__((ext_vector_type(4)));
typedef unsigned u32x2 __attribute__((ext_vector_type(2)));
constexpr int BM = 256, BK = 64, HALF = 128, HTB = HALF * BK * 2  , STAGE_BYTES = 8 * HTB, NXCD = 8, WGM = 8;
constexpr int LD = 1024;
constexpr size_t ROWB = 2048;
constexpr size_t HSTEP = (size_t)HALF * ROWB;
constexpr size_t TSTEP = 2 * HSTEP;

__host__ __device__ __forceinline__ int lds_byte(int r, int c) { const int st = (r >> 4) * 2 + (c >> 5), rr = r & 15, cc = c & 31, ob = rr * 64 + cc * 2; return st * 1024 + (ob ^ (((ob >> 9) & 1) << 5)); }
__host__ __device__ __forceinline__ void stage_rc(int b, int& R, int& C) { const int st = b / 1024, sb = b % 1024, swz = sb ^ (((sb >> 9) & 1) << 5); R = (st >> 1) * 16 + swz / 64; C = (st & 1) * 32 + (swz % 64) / 2; }
__host__ __device__ __forceinline__ int perm32(int rho) { const int n = rho >> 4, i = rho & 15; return 8 * (i >> 2) + 4 * n + (i & 3); }

struct GU {
    const char* A;
    const char* B0;
    const char* B1;
    int nt, ks;
    const int* rows;
    int rbase, rcnt;
    int pm, pn, a0, a1;
};

__device__ __forceinline__ unsigned cvt_pk_bf16(float lo, float hi) { unsigned r; asm volatile("v_cvt_pk_bf16_f32 %0, %1, %2" : "=v"(r) : "v"(lo), "v"(hi)); return r; }
__device__ __forceinline__ float bf_lo(unsigned w) { return __uint_as_float(w << 16); }
__device__ __forceinline__ float bf_hi(unsigned w) { return __uint_as_float(w & 0xffff0000u); }

__device__ __forceinline__ void glds16_s(const char* sbase, unsigned voff, unsigned lds_dst) { unsigned keep;
    asm volatile("s_mov_b32 %0, m0\n\ts_mov_b32 m0, %3\n\ts_nop 0\n\tglobal_load_lds_dwordx4 %1, %2\n\ts_mov_b32 m0, %0" : "=&s"(keep) : "v"(voff), "s"(sbase), "s"(lds_dst) : "memory"); }
typedef int v8i_t __attribute__((ext_vector_type(8)));
typedef int v4i_t __attribute__((ext_vector_type(4)));
__device__ __forceinline__ v8i_t cat8(bf16x8 lo, bf16x8 hi) { const v4i_t a = __builtin_bit_cast(v4i_t, lo), b = __builtin_bit_cast(v4i_t, hi); return __builtin_shufflevector(a, b, 0, 1, 2, 3, 4, 5, 6, 7); }
template <class Epi, class Sched, bool GATHER>
__device__ __forceinline__ void gemm_phase(PG8_LAS unsigned char* lds, PG8_LAS unsigned* xlds  , const int wid_in  , const Sched& S, Epi& E) {
    const int wid = opaque_s(wid_in), lane = lane_id_(), tid = wid * 64 + lane, wr = wid >> 2, wc = wid & 3, fr = lane & 15, fq = lane >> 4;
    constexpr bool F8 = Epi::F8;
    constexpr int RP = F8 ? 1024 : 2048;
    constexpr size_t HS = (size_t)HALF * RP;
    unsigned voffB[2], vA[2][2];
#pragma unroll
    for (int i = 0; i < 2; ++i) { int R, C; stage_rc(tid * 16 + i * 8192, R, C); const int Rb = Epi::PERM ? ((R & ~31) + perm32(R & 31)) : R;
        voffB[i] = (unsigned)(Rb * RP + C * 2);
        vA[0][i] = (unsigned)(R * RP + C * 2); vA[1][i] = vA[0][i]; }
    const size_t kstep = (size_t)(BK * 2);
    const unsigned ldsw = (unsigned)wid * 1024u;
    const unsigned ldsb = (unsigned)__builtin_amdgcn_readfirstlane((int)((unsigned)(size_t)lds + (unsigned)wid * 1024u));
    const int aoff8 = lds_byte(wr * 64 + fr, 16 * fq), boff8 = lds_byte(wc * 32 + fr, 16 * fq);
    const int aoff = lds_byte(wr * 64 + fr, fq * 8), boff = lds_byte(wc * 32 + fr, fq * 8);
#define PG8_SA(b, h) (((b) * 2 + (h)) * HTB)
#define PG8_SB(b, h) ((4 + (b) * 2 + (h)) * HTB)
#define PG8_STAGE(bufoff, gbase, voff) do { _Pragma("unroll") for (int _i = 0; _i < 2; ++_i) { \
        if constexpr (F8) glds16_s((const char*)(gbase), (voff)[_i], ldsb + (unsigned)((bufoff) + _i * 8192)); \
        else __builtin_amdgcn_global_load_lds((const unsigned*)((const char*)(gbase) + (voff)[_i]), (PG8_LAS unsigned*)(lds + (bufoff) + ldsw + _i * 8192), 16, 0, 0); } } while (0)
#define PG8_STAGEA(bufoff, gbase, h) do { if constexpr (GATHER) { PG8_STAGE(bufoff, gbase, vA[h]); } else { PG8_STAGE(bufoff, (gbase) + (h) * HS, vA[0]); } } while (0)
#define PG8_LDA(dst, b, h) do { _Pragma("unroll") for (int m = 0; m < 4; ++m) _Pragma("unroll") for (int k = 0; k < 2; ++k) dst[m][k] = *(const PG8_LAS bf16x8*)(lds + PG8_SA(b, h) + (F8 ? aoff8 + k * 16 : aoff + k * 1024) + m * 2048); } while (0)
#define PG8_LDB(dst, b, h) do { _Pragma("unroll") for (int n = 0; n < 2; ++n) _Pragma("unroll") for (int k = 0; k < 2; ++k) dst[n][k] = *(const PG8_LAS bf16x8*)(lds + PG8_SB(b, h) + (F8 ? boff8 + k * 16 : boff + k * 1024) + n * 2048); } while (0)
#define PG8_MMA(ai, bj, At, Bt) do { __builtin_amdgcn_s_setprio(1); _Pragma("unroll") for (int m = 0; m < 4; ++m) _Pragma("unroll") for (int n = 0; n < 2; ++n) { \
        if constexpr (F8) acc[ai][bj][m][n] = __builtin_amdgcn_mfma_scale_f32_16x16x128_f8f6f4(cat8(Bt[n][0], Bt[n][1]), cat8(At[m][0], At[m][1]), acc[ai][bj][m][n], 0, 0, 0, 0, 0, 0); \
        else { _Pragma("unroll") for (int k = 0; k < 2; ++k) acc[ai][bj][m][n] = __builtin_amdgcn_mfma_f32_16x16x32_bf16(Bt[n][k], At[m][k], acc[ai][bj][m][n], 0, 0, 0); } } __builtin_amdgcn_s_setprio(0); } while (0)
#define PG8_WAIT_V(n) asm volatile("s_waitcnt vmcnt(" #n ")" ::: "memory")
#define PG8_WAIT_L(n) asm volatile("s_waitcnt lgkmcnt(" #n ")" ::: "memory")
#define PG8_BAR __builtin_amdgcn_s_barrier()
#define PG8_SCHED __builtin_amdgcn_sched_barrier(0)
#define PG8_KS(u) (Sched::NT > 0 ? Sched::KS : (u).ks)
#define PG8_BP(u, tau) ((tau) < PG8_KS(u) ? (u).B0 + (size_t)(tau) * kstep : (u).B1 + (size_t)((tau) - PG8_KS(u)) * kstep)
#define PG8_GATHER_OFFS(dst, u) do { if constexpr (GATHER) { _Pragma("unroll") for (int _h = 0; _h < 2; ++_h) _Pragma("unroll") for (int _i = 0; _i < 2; ++_i) { \
        int _R, _C; stage_rc((wid * 64 + lane_id_()) * 16 + _i * 8192, _R, _C); int _p = (u).rbase + _h * HALF + _R; _p = _p < (u).rcnt ? _p : (u).rcnt - 1; dst[_h][_i] = (unsigned)(u).rows[_p] * (unsigned)RP + (unsigned)_C * 2u; } } } while (0)
    GU cur, nxt; int ui = 0;
    if (!S.next(0, cur)) return;
    f32x4 acc[2][2][4][2];
#pragma unroll
    for (int a = 0; a < 2; ++a)
#pragma unroll
        for (int b = 0; b < 2; ++b)
#pragma unroll
            for (int m = 0; m < 4; ++m)
#pragma unroll
                for (int n = 0; n < 2; ++n) { const float z_ = zero_(); acc[a][b][m][n] = (f32x4){z_, z_, z_, z_}; }
    bf16x8 At[4][2], B0[2][2], B1[2][2];
    PG8_GATHER_OFFS(vA, cur);
    const char* cA = cur.A;
    { const char* b0 = PG8_BP(cur, 0); const char* b1 = PG8_BP(cur, 1);
      PG8_STAGE(PG8_SB(0, 0), b0, voffB); PG8_STAGE(PG8_SB(0, 1), b0 + HS, voffB); PG8_STAGEA(PG8_SA(0, 0), cA, 0); PG8_STAGEA(PG8_SA(0, 1), cA, 1);
      if (wr == 1) PG8_BAR;
      PG8_WAIT_V(2); PG8_BAR;
      PG8_STAGE(PG8_SB(1, 0), b1, voffB); PG8_STAGEA(PG8_SA(1, 0), cA + kstep, 0); PG8_STAGE(PG8_SB(1, 1), b1 + HS, voffB);
      PG8_WAIT_V(6); PG8_BAR; }
    for (;;) {
        const bool has_next = S.next(ui + 1, nxt);
        if (!has_next) nxt = cur;
        if constexpr (GATHER) { unsigned vn[2][2];
#pragma unroll
            for (int h = 0; h < 2; ++h)
#pragma unroll
                for (int i = 0; i < 2; ++i) vn[h][i] = vA[h][i];
            if (has_next) { PG8_GATHER_OFFS(vn, nxt); }
#pragma unroll
            for (int h = 0; h < 2; ++h)
#pragma unroll
                for (int i = 0; i < 2; ++i) xlds[(h * 2 + i) * 512 + tid] = vn[h][i]; }
        const char* nA = nxt.A;
        const int nt = Sched::NT > 0 ? Sched::NT : cur.nt;
#pragma unroll (Sched::NT > 0 ? 2 : 1)
        for (int t = 0; t < nt; t += 2) {
            const bool last = (t == nt - 2);
            const char* a1 = cA + (size_t)(t + 1) * kstep;
            const char* a2 = last ? nA : cA + (size_t)(t + 2) * kstep;
            const char* b2 = last ? PG8_BP(nxt, 0) : PG8_BP(cur, t + 2);
            const char* a3 = a2 + kstep; const char* b3 = b2 + kstep;
            PG8_LDB(B0, 0, 0); PG8_LDB(B1, 0, 1); PG8_SCHED; PG8_LDA(At, 0, 0); PG8_STAGEA(PG8_SA(1, 1), a1, 1);
            if constexpr (GATHER) { if (last) {
#pragma unroll
                for (int h = 0; h < 2; ++h)
#pragma unroll
                    for (int i = 0; i < 2; ++i) vA[h][i] = xlds[(h * 2 + i) * 512 + tid]; } }
            PG8_WAIT_V(8); PG8_WAIT_L(0); PG8_BAR; PG8_MMA(0, 0, At, B0); PG8_MMA(0, 1, At, B1); PG8_BAR; PG8_SCHED;
            PG8_LDA(At, 0, 1); PG8_STAGE(PG8_SB(0, 0), b2, voffB); PG8_STAGE(PG8_SB(0, 1), b2 + HS, voffB); PG8_STAGEA(PG8_SA(0, 0), a2, 0);
            PG8_WAIT_V(8); PG8_WAIT_L(0); PG8_BAR; PG8_MMA(1, 0, At, B0); PG8_MMA(1, 1, At, B1); PG8_BAR; PG8_SCHED;
            PG8_LDB(B0, 1, 0); PG8_LDB(B1, 1, 1); PG8_SCHED; PG8_LDA(At, 1, 0); PG8_STAGEA(PG8_SA(0, 1), a2, 1);
            PG8_WAIT_V(8); PG8_WAIT_L(0); PG8_BAR; PG8_MMA(0, 0, At, B0); PG8_MMA(0, 1, At, B1); PG8_BAR; PG8_SCHED;
            PG8_LDA(At, 1, 1); PG8_STAGE(PG8_SB(1, 0), b3, voffB); PG8_STAGE(PG8_SB(1, 1), b3 + HS, voffB); PG8_STAGEA(PG8_SA(1, 0), a3, 0);
            PG8_WAIT_V(8); PG8_WAIT_L(0); PG8_BAR; PG8_MMA(1, 0, At, B0); PG8_MMA(1, 1, At, B1); PG8_BAR; PG8_SCHED;
        }
        if (wr == 0) PG8_BAR;
        { const int l2_ = lane_id_(); E(acc, cur, wr, wc, l2_ & 15, l2_ >> 4); }
        if (!has_next) break;
#pragma unroll
        for (int a = 0; a < 2; ++a)
#pragma unroll
            for (int b = 0; b < 2; ++b)
#pragma unroll
                for (int m = 0; m < 4; ++m)
#pragma unroll
                    for (int n = 0; n < 2; ++n) { const float z_ = zero_(); acc[a][b][m][n] = (f32x4){z_, z_, z_, z_}; }
        cur = nxt; cA = nA; ++ui;
        if (wr == 1) PG8_BAR;
    }
    PG8_WAIT_V(0);
    PG8_BAR;
#undef PG8_SA
#undef PG8_SB
#undef PG8_STAGE
#undef PG8_STAGEA
#undef PG8_LDA
#undef PG8_LDB
#undef PG8_MMA
#undef PG8_WAIT_V
#undef PG8_WAIT_L
#undef PG8_BAR
#undef PG8_SCHED
#undef PG8_BP
#undef PG8_KS
#undef PG8_GATHER_OFFS
}

template <class Epi, class Sched>
__device__ __forceinline__ void gemm_phase_n128(PG8_LAS unsigned char* lds, const int wid_in, const Sched& S, Epi& E) {
    const int wid = opaque_s(wid_in), lane = lane_id_(), tid = wid * 64 + lane, wr = wid >> 2, wc = wid & 3, fr = lane & 15, fq = lane >> 4;
    unsigned voffB[2], voffA[2];
#pragma unroll
    for (int i = 0; i < 2; ++i) { int R, C; stage_rc(tid * 16 + i * 8192, R, C); const int Rb = (R & ~31) + perm32(R & 31);
        voffB[i] = (unsigned)(Rb * LD + C) * 2u; voffA[i] = (unsigned)(R * LD + C) * 2u; }
    const size_t kstep = (size_t)(BK * 2);
    const unsigned ldsw = (unsigned)wid * 1024u;
    const int aoff = lds_byte(wr * 64 + fr, fq * 8), boff = lds_byte(wc * 32 + fr, fq * 8);
#define PG8_SA(b, h) (((b) * 2 + (h)) * HTB)
#define PG8_SB(b, h) ((4 + (b) * 2 + (h)) * HTB)
#define PG8_STAGE(bufoff, gbase, voff) do { _Pragma("unroll") for (int _i = 0; _i < 2; ++_i) \
        __builtin_amdgcn_global_load_lds((const unsigned*)((const char*)(gbase) + (voff)[_i]), (PG8_LAS unsigned*)(lds + (bufoff) + ldsw + _i * 8192), 16, 0, 0); } while (0)
#define PG8_LDA(dst, b, h) do { _Pragma("unroll") for (int m = 0; m < 4; ++m) _Pragma("unroll") for (int k = 0; k < 2; ++k) dst[m][k] = *(const PG8_LAS bf16x8*)(lds + PG8_SA(b, h) + aoff + m * 2048 + k * 1024); } while (0)
#define PG8_LDB(dst, b, h) do { _Pragma("unroll") for (int n = 0; n < 2; ++n) _Pragma("unroll") for (int k = 0; k < 2; ++k) dst[n][k] = *(const PG8_LAS bf16x8*)(lds + PG8_SB(b, h) + boff + n * 2048 + k * 1024); } while (0)
#define PG8_MMA(ai, At, Bt) do { __builtin_amdgcn_s_setprio(1); _Pragma("unroll") for (int m = 0; m < 4; ++m) _Pragma("unroll") for (int n = 0; n < 2; ++n) _Pragma("unroll") for (int k = 0; k < 2; ++k) \
        acc[ai][m][n] = __builtin_amdgcn_mfma_f32_16x16x32_bf16(Bt[n][k], At[m][k], acc[ai][m][n], 0, 0, 0); __builtin_amdgcn_s_setprio(0); } while (0)
#define PG8_WAIT_V(n) asm volatile("s_waitcnt vmcnt(" #n ")" ::: "memory")
#define PG8_WAIT_L(n) asm volatile("s_waitcnt lgkmcnt(" #n ")" ::: "memory")
#define PG8_BAR __builtin_amdgcn_s_barrier()
#define PG8_SCHED __builtin_amdgcn_sched_barrier(0)
    GU cur, nxt; int ui = 0;
    if (!S.next(0, cur)) return;
    f32x4 acc[2][4][2];
#pragma unroll
    for (int a = 0; a < 2; ++a)
#pragma unroll
        for (int m = 0; m < 4; ++m)
#pragma unroll
            for (int n = 0; n < 2; ++n) { const float z_ = zero_(); acc[a][m][n] = (f32x4){z_, z_, z_, z_}; }
    bf16x8 At[4][2], B0[2][2];
    u32x4 st_u[2][4], st_s[2][4];
    const char* cA = cur.A; const char* cB = cur.B0;
    PG8_STAGE(PG8_SB(0, 0), cB, voffB); PG8_STAGE(PG8_SA(0, 0), cA, voffA); PG8_STAGE(PG8_SA(0, 1), cA + HSTEP, voffA);
    if (wr == 1) PG8_BAR;
    PG8_WAIT_V(2); PG8_BAR;
    PG8_STAGE(PG8_SB(1, 0), cB + kstep, voffB); PG8_STAGE(PG8_SA(1, 0), cA + kstep, voffA);
    PG8_WAIT_V(4); PG8_BAR;
    for (;;) {
        const bool has_next = S.next(ui + 1, nxt);
        if (!has_next) nxt = cur;
        const char* nA = nxt.A; const char* nB = nxt.B0;
        const int nt = cur.nt;
        for (int t = 0; t < nt; t += 2) {
            const bool last = (t == nt - 2);
            const char* a1 = cA + (size_t)(t + 1) * kstep;
            const char* a2 = last ? nA : cA + (size_t)(t + 2) * kstep;
            const char* b2 = last ? nB : cB + (size_t)(t + 2) * kstep;
            const char* a3 = a2 + kstep; const char* b3 = b2 + kstep;
            PG8_LDB(B0, 0, 0); PG8_SCHED; PG8_LDA(At, 0, 0); PG8_STAGE(PG8_SA(1, 1), a1 + HSTEP, voffA);
            PG8_WAIT_V(6); PG8_WAIT_L(0); PG8_BAR; PG8_MMA(0, At, B0); PG8_BAR; PG8_SCHED;
            PG8_LDA(At, 0, 1); PG8_STAGE(PG8_SB(0, 0), b2, voffB); PG8_STAGE(PG8_SA(0, 0), a2, voffA);
            PG8_WAIT_V(6); PG8_WAIT_L(0); PG8_BAR; PG8_MMA(1, At, B0); PG8_BAR; PG8_SCHED;
            PG8_LDB(B0, 1, 0); PG8_SCHED; PG8_LDA(At, 1, 0); PG8_STAGE(PG8_SA(0, 1), a2 + HSTEP, voffA);
            PG8_WAIT_V(6); PG8_WAIT_L(0); PG8_BAR; PG8_MMA(0, At, B0); PG8_BAR; PG8_SCHED;
            PG8_LDA(At, 1, 1); PG8_STAGE(PG8_SB(1, 0), b3, voffB); PG8_STAGE(PG8_SA(1, 0), a3, voffA);
            PG8_WAIT_V(6); PG8_WAIT_L(0); PG8_BAR; PG8_MMA(1, At, B0); PG8_BAR; PG8_SCHED;
        }
        if (wr == 0) PG8_BAR;
        E(acc, st_u, st_s, cur, wr, wc, fr, fq);
        if (!has_next) break;
#pragma unroll
        for (int a = 0; a < 2; ++a)
#pragma unroll
            for (int m = 0; m < 4; ++m)
#pragma unroll
                for (int n = 0; n < 2; ++n) { const float z_ = zero_(); acc[a][m][n] = (f32x4){z_, z_, z_, z_}; }
        cur = nxt; cA = nA; cB = nB; ++ui;
        if (wr == 1) PG8_BAR;
    }
    PG8_WAIT_V(0);
    PG8_BAR;
#undef PG8_SA
#undef PG8_SB
#undef PG8_STAGE
#undef PG8_LDA
#undef PG8_LDB
#undef PG8_MMA
#undef PG8_WAIT_V
#undef PG8_WAIT_L
#undef PG8_BAR
#undef PG8_SCHED
}
template <class Epi, class Sched>
__device__ __forceinline__ void gemm_phase_c8(PG8_LAS unsigned char* lds, const int wid_in, const Sched& S, Epi& E) {
    const int wid = opaque_s(wid_in), lane = lane_id_(), tid = wid * 64 + lane, wr = wid >> 2, wc = wid & 3, fr = lane & 15, fq = lane >> 4;
    unsigned voffB[2], voffA[2];
#pragma unroll
    for (int i = 0; i < 2; ++i) { int R, C; stage_rc(tid * 16 + i * 8192, R, C); const int Rb = (R & ~31) + perm32(R & 31);
        voffB[i] = (unsigned)(Rb * LD + C) * 2u; voffA[i] = (unsigned)(R * LD + C) * 2u; }
    const size_t kstep = (size_t)(BK * 2);
    const unsigned ldsb = (unsigned)__builtin_amdgcn_readfirstlane((int)((unsigned)(size_t)lds + (unsigned)wid * 1024u));
    const int aoff = lds_byte(wr * 64 + fr, fq * 8), boff = lds_byte(wc * 32 + fr, fq * 8);
    const int aoff8 = lds_byte(wr * 64 + fr, 16 * fq), boff8 = lds_byte(wc * 32 + fr, 16 * fq);
#define PG8_SA(b, h) (((b) * 2 + (h)) * HTB)
#define PG8_SB(b, h) ((4 + (b) * 2 + (h)) * HTB)
#define PG8_STAGE(bufoff, gbase, voff) do { _Pragma("unroll") for (int _i = 0; _i < 2; ++_i) glds16_s((const char*)(gbase), (voff)[_i], ldsb + (unsigned)((bufoff) + _i * 8192)); } while (0)
#define PG8_STAGE8(bufoff, gbase, voff) do { _Pragma("unroll") for (int _i = 0; _i < 2; ++_i) { const unsigned _v = ((voff)[_i] + ((voff)[_i] & 2047u)) >> 1; glds16_s((const char*)(gbase), _v, ldsb + (unsigned)((bufoff) + _i * 8192)); } } while (0)
#define PG8_STB(bufoff, gbase, f8) do { if (f8) { PG8_STAGE8(bufoff, gbase, voffB); } else { PG8_STAGE(bufoff, gbase, voffB); } } while (0)
#define PG8_STA(bufoff, gbase, h, f8) do { if (f8) { PG8_STAGE8(bufoff, (gbase) + (h) * (HSTEP / 2), voffA); } else { PG8_STAGE(bufoff, (gbase) + (h) * HSTEP, voffA); } } while (0)
#define PG8_LDA(dst, b, h) do { _Pragma("unroll") for (int m = 0; m < 4; ++m) _Pragma("unroll") for (int k = 0; k < 2; ++k) dst[m][k] = *(const PG8_LAS bf16x8*)(lds + PG8_SA(b, h) + aoff + m * 2048 + k * 1024); } while (0)
#define PG8_LDB(dst, b, h) do { _Pragma("unroll") for (int n = 0; n < 2; ++n) _Pragma("unroll") for (int k = 0; k < 2; ++k) dst[n][k] = *(const PG8_LAS bf16x8*)(lds + PG8_SB(b, h) + boff + n * 2048 + k * 1024); } while (0)
#define PG8_LDA8(dst, b, h) do { _Pragma("unroll") for (int m = 0; m < 4; ++m) _Pragma("unroll") for (int k = 0; k < 2; ++k) dst[m][k] = *(const PG8_LAS bf16x8*)(lds + PG8_SA(b, h) + aoff8 + m * 2048 + k * 16); } while (0)
#define PG8_LDB8(dst, b, h) do { _Pragma("unroll") for (int n = 0; n < 2; ++n) _Pragma("unroll") for (int k = 0; k < 2; ++k) dst[n][k] = *(const PG8_LAS bf16x8*)(lds + PG8_SB(b, h) + boff8 + n * 2048 + k * 16); } while (0)
#define PG8_MMA(ai, At, Bt) do { __builtin_amdgcn_s_setprio(1); _Pragma("unroll") for (int m = 0; m < 4; ++m) _Pragma("unroll") for (int n = 0; n < 2; ++n) _Pragma("unroll") for (int k = 0; k < 2; ++k) \
        acc[ai][m][n] = __builtin_amdgcn_mfma_f32_16x16x32_bf16(Bt[n][k], At[m][k], acc[ai][m][n], 0, 0, 0); __builtin_amdgcn_s_setprio(0); } while (0)
#define PG8_MMA8(ai, At, Bt) do { __builtin_amdgcn_s_setprio(1); _Pragma("unroll") for (int m = 0; m < 4; ++m) _Pragma("unroll") for (int n = 0; n < 2; ++n) \
        acc[ai][m][n] = __builtin_amdgcn_mfma_scale_f32_16x16x128_f8f6f4(cat8(Bt[n][0], Bt[n][1]), cat8(At[m][0], At[m][1]), acc[ai][m][n], 0, 0, 0, 0, 0, 0); __builtin_amdgcn_s_setprio(0); } while (0)
#define PG8_WAIT_V(n) asm volatile("s_waitcnt vmcnt(" #n ")" ::: "memory")
#define PG8_WAIT_L(n) asm volatile("s_waitcnt lgkmcnt(" #n ")" ::: "memory")
#define PG8_BAR __builtin_amdgcn_s_barrier()
#define PG8_SCHED __builtin_amdgcn_sched_barrier(0)
    GU cu, cg, nxt; int ui = 0;
    if (!S.next(0, cu)) return;
    f32x4 acc[2][4][2];
#define PG8_ZACC() do { _Pragma("unroll") for (int a = 0; a < 2; ++a) _Pragma("unroll") for (int m = 0; m < 4; ++m) _Pragma("unroll") for (int n = 0; n < 2; ++n) { const float z_ = zero_(); acc[a][m][n] = (f32x4){z_, z_, z_, z_}; } } while (0)
    PG8_ZACC();
    bf16x8 At[4][2], B0[2][2];
    u32x4 st_u[2][4], st_s[2][4];
    PG8_STB(PG8_SB(0, 0), cu.B0, false); PG8_STA(PG8_SA(0, 0), cu.A, 0, false); PG8_STA(PG8_SA(0, 1), cu.A, 1, false);
    if (wr == 1) PG8_BAR;
    PG8_WAIT_V(2); PG8_BAR;
    PG8_STB(PG8_SB(1, 0), cu.B0 + kstep, false); PG8_STA(PG8_SA(1, 0), cu.A + kstep, 0, false);
    PG8_WAIT_V(4); PG8_BAR;
#define PG8_KLOOP(LDA_, LDB_, MMA_, C8, N8, cA, cB, nA, nB, nt) \
        for (int t = 0; t < (nt); t += 2) { \
            const bool last = (t == (nt) - 2); \
            const char* a1 = (cA) + (size_t)(t + 1) * kstep; \
            const char* a2 = last ? (nA) : (cA) + (size_t)(t + 2) * kstep; \
            const char* b2 = last ? (nB) : (cB) + (size_t)(t + 2) * kstep; \
            const char* a3 = a2 + kstep; const char* b3 = b2 + kstep; \
            LDB_(B0, 0, 0); PG8_SCHED; LDA_(At, 0, 0); PG8_STA(PG8_SA(1, 1), a1, 1, C8); \
            PG8_WAIT_V(6); PG8_WAIT_L(0); PG8_BAR; MMA_(0, At, B0); PG8_BAR; PG8_SCHED; \
            if (last) { LDA_(At, 0, 1); PG8_STB(PG8_SB(0, 0), b2, N8); PG8_STA(PG8_SA(0, 0), a2, 0, N8); } else { LDA_(At, 0, 1); PG8_STB(PG8_SB(0, 0), b2, C8); PG8_STA(PG8_SA(0, 0), a2, 0, C8); } \
            PG8_WAIT_V(6); PG8_WAIT_L(0); PG8_BAR; MMA_(1, At, B0); PG8_BAR; PG8_SCHED; \
            if (last) { LDB_(B0, 1, 0); PG8_SCHED; LDA_(At, 1, 0); PG8_STA(PG8_SA(0, 1), a2, 1, N8); } else { LDB_(B0, 1, 0); PG8_SCHED; LDA_(At, 1, 0); PG8_STA(PG8_SA(0, 1), a2, 1, C8); } \
            PG8_WAIT_V(6); PG8_WAIT_L(0); PG8_BAR; MMA_(0, At, B0); PG8_BAR; PG8_SCHED; \
            if (last) { LDA_(At, 1, 1); PG8_STB(PG8_SB(1, 0), b3, N8); PG8_STA(PG8_SA(1, 0), a3, 0, N8); } else { LDA_(At, 1, 1); PG8_STB(PG8_SB(1, 0), b3, C8); PG8_STA(PG8_SA(1, 0), a3, 0, C8); } \
            PG8_WAIT_V(6); PG8_WAIT_L(0); PG8_BAR; MMA_(1, At, B0); PG8_BAR; PG8_SCHED; \
        }
    for (;;) {
        S.next(ui + 1, cg);
        PG8_KLOOP(PG8_LDA, PG8_LDB, PG8_MMA, false, true, cu.A, cu.B0, cg.A, cg.B0, cu.nt)
        if (wr == 0) PG8_BAR;
        { const int l2_ = lane_id_(); E(acc, st_u, st_s, cu, wr, wc, l2_ & 15, l2_ >> 4); }
        PG8_ZACC();
        if (wr == 1) PG8_BAR;
        const bool has_next = S.next(ui + 2, nxt);
        if (!has_next) { nxt.A = S.BRp; nxt.B0 = S.WBp; }
        PG8_KLOOP(PG8_LDA8, PG8_LDB8, PG8_MMA8, true, false, cg.A, cg.B0, nxt.A, nxt.B0, cg.nt)
        if (wr == 0) PG8_BAR;
        { const int l2_ = lane_id_(); E(acc, st_u, st_s, cg, wr, wc, l2_ & 15, l2_ >> 4); }
        if (!has_next) break;
        PG8_ZACC();
        cu = nxt; ui += 2;
        if (wr == 1) PG8_BAR;
    }
#undef PG8_KLOOP
#undef PG8_ZACC
    PG8_WAIT_V(0);
    PG8_BAR;
#undef PG8_SA
#undef PG8_SB
#undef PG8_STAGE
#undef PG8_STAGE8
#undef PG8_STB
#undef PG8_STA
#undef PG8_LDA
#undef PG8_LDB
#undef PG8_LDA8
#undef PG8_LDB8
#undef PG8_MMA
#undef PG8_MMA8
#undef PG8_WAIT_V
#undef PG8_WAIT_L
#undef PG8_BAR
#undef PG8_SCHED
}
}
namespace attn_body {
using bf16=__hip_bfloat16;
using bf16x8=__attribute__((ext_vector_type(8)))short;
using s16x4=__attribute__((ext_vector_type(4)))short;
using f32x16=__attribute__((ext_vector_type(16)))float;
using f32x4=__attribute__((ext_vector_type(4)))float;
using u32x4=__attribute__((ext_vector_type(4)))unsigned;
constexpr int SEQ=4096,D=64;
constexpr int KVP=2304;
constexpr int OP=1024;
constexpr int NW=8,QBLK=32,QB=QBLK*NW,KVBLK=64,NQB=SEQ/QB;
__device__ __forceinline__ int crow(int r,int hi){return (r&3)+8*(r>>2)+4*hi;}
#define SBAR() __builtin_amdgcn_sched_barrier(0)
__device__ __forceinline__ void cmask(f32x16&p0,f32x16&p1,int jb,int qrel,int hi){
  const float NEG=-INFINITY; int kb=64*jb+4*hi;
  #pragma unroll
  for(int r=0;r<16;++r){int kv=kb+(r&3)+8*(r>>2); if(kv>qrel)p0[r]=NEG; if(kv+32>qrel)p1[r]=NEG;}
}
__device__ __forceinline__ void bmask(f32x16&p0,f32x16&p1,unsigned long long w,int hi){
  const float NEG=-INFINITY; const unsigned lo=((unsigned)w)>>(4*hi), up=((unsigned)(w>>32))>>(4*hi);
  #pragma unroll
  for(int r=0;r<16;++r){const int bit=(r&3)+8*(r>>2); if(!((lo>>bit)&1u))p0[r]=NEG; if(!((up>>bit)&1u))p1[r]=NEG;}
}
constexpr int NSLOT=3, SLOTB=8192;
constexpr int LDS_K=0, LDS_V=NSLOT*SLOTB, LDS_WS=2*NSLOT*SLOTB, LDS_OST=LDS_WS+NW*64*4, LDS_BIAS=LDS_OST+NW*4096, LDS_BYTES=LDS_BIAS+SEQ*4;
constexpr float C2=0.125f*1.4426950408889634f;
__device__ __forceinline__ void glds16(const void*gsrc,unsigned lds_dst){unsigned keep;
  asm volatile("s_mov_b32 %0, m0\n\ts_mov_b32 m0, %2\n\ts_nop 0\n\tglobal_load_lds_dwordx4 %1, off\n\ts_mov_b32 m0, %0":"=&s"(keep):"v"(gsrc),"s"(lds_dst):"memory");}
__device__ __forceinline__ float max3f(float a,float b,float c){float r;asm("v_max3_f32 %0, %1, %2, %3":"=v"(r):"v"(a),"v"(b),"v"(c));return r;}
__device__ __forceinline__ float max2f(float a,float b){float r;asm("v_max_f32_e32 %0, %1, %2":"=v"(r):"v"(a),"v"(b));return r;}
__device__ __forceinline__ float fadd_s(float a,float b){float r;asm("v_add_f32_e32 %0, %1, %2":"=v"(r):"v"(a),"v"(b));return r;}
__device__ __forceinline__ float fsub_s(float a,float b){float r;asm("v_sub_f32_e32 %0, %1, %2":"=v"(r):"v"(a),"v"(b));return r;}
typedef float f32x2_t __attribute__((ext_vector_type(2))); typedef __bf16 bf16x2_t __attribute__((ext_vector_type(2)));
__device__ __forceinline__ unsigned cvtpk_s(float lo,float hi){f32x2_t v={lo,hi};bf16x2_t b=__builtin_convertvector(v,bf16x2_t);return __builtin_bit_cast(unsigned,b);}
#define WAIT_BAR(N) asm volatile("s_waitcnt vmcnt(" #N ") lgkmcnt(0)\n\ts_barrier":::"memory")

typedef __attribute__((address_space(3))) const char* lds_cptr;
typedef short v4i16_t __attribute__((ext_vector_type(4)));
__device__ __forceinline__ void binit(f32x16&p0,f32x16&p1,lds_cptr bp,float mhat){
  typedef float f2_ __attribute__((ext_vector_type(2))); const f2_ m2={mhat,mhat};
  #pragma unroll
  for(int g=0;g<4;++g){ const f32x4 a=*(const __attribute__((address_space(3))) f32x4*)(bp+g*32); const f32x4 b=*(const __attribute__((address_space(3))) f32x4*)(bp+128+g*32);
    const f2_ a0=(f2_){a[0],a[1]}-m2,a1=(f2_){a[2],a[3]}-m2,b0=(f2_){b[0],b[1]}-m2,b1=(f2_){b[2],b[3]}-m2;
    p0[4*g]=a0.x;p0[4*g+1]=a0.y;p0[4*g+2]=a1.x;p0[4*g+3]=a1.y; p1[4*g]=b0.x;p1[4*g+1]=b0.y;p1[4*g+2]=b1.x;p1[4*g+3]=b1.y; }
}
__device__ __forceinline__ void qkt(f32x16&p0,f32x16&p1,const char*Kslot,const bf16x8*qr,int r32,int hi){
  const char*kb=Kslot+hi*1024+r32*16;
  #pragma unroll
  for(int d0=0;d0<4;++d0){
    const bf16x8 b0=*reinterpret_cast<const bf16x8*>(kb+d0*2048);
    const bf16x8 b1=*reinterpret_cast<const bf16x8*>(kb+d0*2048+512);
    p0=__builtin_amdgcn_mfma_f32_32x32x16_bf16(b0,qr[d0],p0,0,0,0);p1=__builtin_amdgcn_mfma_f32_32x32x16_bf16(b1,qr[d0],p1,0,0,0);}
}
__device__ __forceinline__ void kload8(bf16x8*kf,lds_cptr kp){
  kf[0]=*(const __attribute__((address_space(3))) bf16x8*)(kp);      kf[1]=*(const __attribute__((address_space(3))) bf16x8*)(kp+512);
  kf[2]=*(const __attribute__((address_space(3))) bf16x8*)(kp+2048); kf[3]=*(const __attribute__((address_space(3))) bf16x8*)(kp+2560);
  kf[4]=*(const __attribute__((address_space(3))) bf16x8*)(kp+4096); kf[5]=*(const __attribute__((address_space(3))) bf16x8*)(kp+4608);
  kf[6]=*(const __attribute__((address_space(3))) bf16x8*)(kp+6144); kf[7]=*(const __attribute__((address_space(3))) bf16x8*)(kp+6656);
}
__device__ __forceinline__ void kload2(bf16x8*kf,lds_cptr kp,int j){ kf[2*j]=*(const __attribute__((address_space(3))) bf16x8*)(kp+j*2048); kf[2*j+1]=*(const __attribute__((address_space(3))) bf16x8*)(kp+j*2048+512); }
__device__ __forceinline__ s16x4 vtr(lds_cptr p){ return __builtin_bit_cast(s16x4,__builtin_amdgcn_ds_read_tr16_b64_v4i16((__attribute__((address_space(3))) v4i16_t*)p)); }
__device__ __forceinline__ float rowmax(const f32x16&p0,const f32x16&p1){
  float a=max3f(p0[0],p0[1],p1[0]),b=max3f(p0[2],p0[3],p1[1]);a=max3f(a,p1[2],p1[3]);
  #pragma unroll
  for(int r=4;r<16;r+=4){a=max3f(a,p0[r],p0[r+1]);b=max3f(b,p0[r+2],p0[r+3]);a=max3f(a,p1[r],p1[r+1]);b=max3f(b,p1[r+2],p1[r+3]);}
  const float m=max2f(a,b);
  auto rr=__builtin_amdgcn_permlane32_swap(__float_as_uint(m),__float_as_uint(m),false,false);
  return max2f(__uint_as_float(rr[0]),__uint_as_float(rr[1]));
}
__device__ __forceinline__ void pv(f32x16*o,int vb,bf16x8 pa0,bf16x8 pa1,bf16x8 pa2,bf16x8 pa3){
  #pragma unroll
  for(int d0=0;d0<2;++d0){s16x4 lo[4],hi[4];
    #pragma unroll
    for(int ks=0;ks<4;++ks){
      asm volatile("ds_read_b64_tr_b16 %0,%1 offset:%c2":"=&v"(lo[ks]):"v"(vb),"i"(d0*4096+ks*1024):"memory");
      asm volatile("ds_read_b64_tr_b16 %0,%1 offset:%c2":"=&v"(hi[ks]):"v"(vb),"i"(d0*4096+ks*1024+512):"memory");}
    asm volatile("s_waitcnt lgkmcnt(0)":::"memory");SBAR();
    #define PK(k) (bf16x8){lo[k][0],lo[k][1],lo[k][2],lo[k][3],hi[k][0],hi[k][1],hi[k][2],hi[k][3]}
    o[d0]=__builtin_amdgcn_mfma_f32_32x32x16_bf16(pa0,PK(0),o[d0],0,0,0);
    o[d0]=__builtin_amdgcn_mfma_f32_32x32x16_bf16(pa1,PK(1),o[d0],0,0,0);
    o[d0]=__builtin_amdgcn_mfma_f32_32x32x16_bf16(pa2,PK(2),o[d0],0,0,0);
    o[d0]=__builtin_amdgcn_mfma_f32_32x32x16_bf16(pa3,PK(3),o[d0],0,0,0);
    #undef PK
  }
}

template<int THRL,bool MASK> __device__ __forceinline__ void attn_unit(int q0,const bf16*Qs,const bf16*__restrict__ Ks,const bf16*__restrict__ Vs,bf16*Os,
                                                                       const float*biasg,float slope2,const unsigned long long*maskw,char*shm,const int wid_in){
  const int wid=opaque_s(wid_in),lane=lane_id_(),tid=wid*64+lane,r32=lane&31,hi=lane>>5;
  const bf16*Qw=Qs+(long)(q0+wid*QBLK)*KVP;
  const unsigned lds0=(unsigned)(uintptr_t)shm;
  float*wsf=(float*)(shm+LDS_WS)+wid*64;
  unsigned long long mwA=0ull,mwB=0ull;
  { float*bl=(float*)(shm+LDS_BIAS); const int nk=q0+QB;
    if(biasg){ for(int s=tid;s<nk;s+=NW*64)bl[s]=biasg[s]; } else { for(int s=tid;s<nk;s+=NW*64)bl[s]=slope2*(float)s; }
    if(MASK){ const unsigned long long*mp0=maskw+(q0+wid*QBLK+(lane&31)); mwA=mp0[0]; mwB=mp0[SEQ]; asm volatile("":"+v"(mwA),"+v"(mwB)); }
    asm volatile("s_waitcnt vmcnt(0) lgkmcnt(0)":::"memory"); }
  const bf16*ksrc=Ks+(long)lane*KVP+wid*8;
  const bf16*vsrc=Vs+(long)(16*(wid&3)+(lane>>2))*KVP+(wid>>2)*32+(lane&3)*8;
  const unsigned kdst=lds0+LDS_K+wid*1024, vdst=lds0+LDS_V+wid*1024;
  #define DMA_K(t,slot) glds16(ksrc+(long)(t)*KVBLK*KVP,(unsigned)__builtin_amdgcn_readfirstlane(kdst+(slot)))
  #define DMA_V(t,slot) glds16(vsrc+(long)(t)*KVBLK*KVP,(unsigned)__builtin_amdgcn_readfirstlane(vdst+(slot)))
  const int vb0=(int)(lds0+LDS_V)+((lane>>4)&1)*32+(lane&3)*8+(4*hi+((lane&15)>>2))*64;
  const char*Kbase=shm+LDS_K; bf16x8 kf[8];
  const lds_cptr shm3=(lds_cptr)shm; const lds_cptr kp0=shm3+LDS_K+hi*1024+r32*16; const lds_cptr vp0=shm3+LDS_V+((lane>>4)&1)*32+(lane&3)*8+(4*hi+((lane&15)>>2))*64;
  const lds_cptr bp0=shm3+LDS_BIAS+hi*16;
  const int NT=(q0+QB)/KVBLK;
  DMA_K(0,0);DMA_V(0,0);DMA_K(1,SLOTB);
  bf16x8 qr[4];
  #pragma unroll
  for(int d0=0;d0<4;++d0)qr[d0]=*reinterpret_cast<const bf16x8*>(&Qw[(long)r32*KVP+d0*16+hi*8]);
  const unsigned long long*mwp=MASK?maskw+(q0+wid*QBLK+r32):nullptr;
  #define MLOAD(MW,t) do{ if(MASK){ MW=mwp[(long)(t)*SEQ]; } }while(0)
  #define MPIN(MW) do{}while(0)
  float mhat=0.f,l_reg=0.f;f32x16 o[2];o[0]=f32x16{};o[1]=f32x16{};
  const int qrel=wid*QBLK+r32;
  #define CMASK(P0,P1,t,MW) do{ if(MASK){ bmask(P0,P1,MW,hi); } else { int jb_=(t)-(NT-4); if(jb_>=0)cmask(P0,P1,jb_,qrel,hi); } }while(0)
  bool resc=false;
  #define START(P0,P1) do{ const float rm=rowmax(P0,P1); resc=false; \
    { const float dl=__builtin_fmaxf(rm,-60000.f); mhat=fadd_s(mhat,dl); \
      _Pragma("unroll") for(int r=0;r<16;++r){P0[r]=fsub_s(P0[r],dl);P1[r]=fsub_s(P1[r],dl);} } \
    _Pragma("unroll") for(int r=0;r<16;++r)P0[r]=__builtin_amdgcn_exp2f(P0[r]); }while(0)
  #define RESC() do{ if(resc){ asm volatile("s_waitcnt lgkmcnt(0)":::"memory"); \
      _Pragma("unroll") for(int d_=0;d_<2;++d_) _Pragma("unroll") for(int r=0;r<16;++r)o[d_][r]*=wsf[crow(r,hi)]; } }while(0)
  f32x16 pA0,pA1,pB0,pB1;
  int sl_prev=0,sl_cur=0,sl_next=SLOTB;
  #define ROT() do{sl_prev=sl_cur;sl_cur=sl_next;sl_next=(sl_next==(NSLOT-1)*SLOTB)?0:sl_next+SLOTB;}while(0)
  DMA_K(2,2*SLOTB);
  WAIT_BAR(3);
  binit(pA0,pA1,bp0,0.f);
  qkt(pA0,pA1,Kbase,qr,r32,hi);asm volatile("s_nop 15\n\ts_nop 7":"+v"(pA0),"+v"(pA1));CMASK(pA0,pA1,0,mwA);
  START(pA0,pA1);
  _Pragma("unroll") for(int r=0;r<16;++r)pA1[r]=__builtin_amdgcn_exp2f(pA1[r]);
  WAIT_BAR(0);
  DMA_K(3,0);DMA_V(1,SLOTB);MLOAD(mwA,2);
  ROT();
  kload8(kf,kp0+sl_cur);
  if(MASK){WAIT_BAR(3);}else{WAIT_BAR(2);}
  s16x4 vlo[8],vhi[8]; u32x4 pw0,pw1,pw2,pw3;
  #define PKW(P,B) cvtpk_s(P[B],P[B+1])
  #define PAF(k) __builtin_bit_cast(bf16x8,pw##k)
  #define VFR(i) (bf16x8){vlo[i][0],vlo[i][1],vlo[i][2],vlo[i][3],vhi[i][0],vhi[i][1],vhi[i][2],vhi[i][3]}
  #define PIN(x) asm volatile("":"+v"(x))
  #define MX3(a,b,c) __builtin_fmaxf(__builtin_fmaxf((a),(b)),(c))
  #define GAPA(MF,A0,A1,A2,A3,W0,W1,PW) do{ MF; sacc+=A0; sacc+=A1; sacc+=A2; sacc+=A3; PIN(sacc); W0; W1; PIN(PW); SBAR(); }while(0)
  #define EX(v) __builtin_amdgcn_exp2f(v)
  #define GAPB(MF,X,B) do{ MF; X[B]=EX(X[B]); X[B+1]=EX(X[B+1]); X[B+2]=EX(X[B+2]); X[B+3]=EX(X[B+3]); PIN(X); SBAR(); }while(0)
  #define VRD(i) do{ vlo[i]=vtr(vp_+(((i)>>2)*4096+((i)&3)*1024)); vhi[i]=vtr(vp_+(((i)>>2)*4096+((i)&3)*1024+512)); }while(0)
  #define KRD(G,j) do{ if(G){ kload2(kf,kp0+sl_next,j); SBAR(); } }while(0)
  #define STEP(C0,C1,P0,P1,t,GK,GV,GL,MW,GM,DOCM) do{ SBAR(); \
    const lds_cptr vp_=vp0+sl_prev; \
    binit(C0,C1,bp0+(t)*256,mhat); SBAR(); \
    VRD(0); SBAR(); float sacc=(P0[0]+P0[1]); \
    GAPA(C0=__builtin_amdgcn_mfma_f32_32x32x16_bf16(kf[0],qr[0],C0,0,0,0), P0[2],P0[3],P0[4],P0[5],     pw0[0]=PKW(P0,0), pw0[1]=PKW(P0,2), pw0); \
    VRD(4); SBAR(); GAPA(C1=__builtin_amdgcn_mfma_f32_32x32x16_bf16(kf[1],qr[0],C1,0,0,0), P0[6],P0[7],P0[8],P0[9],     pw0[2]=PKW(P0,4), pw0[3]=PKW(P0,6), pw0); \
    VRD(1); SBAR(); GAPA(C0=__builtin_amdgcn_mfma_f32_32x32x16_bf16(kf[2],qr[1],C0,0,0,0),   P0[10],P0[11],P0[12],P0[13], pw1[0]=PKW(P0,8), pw1[1]=PKW(P0,10), pw1); \
    VRD(5); SBAR(); GAPA(C1=__builtin_amdgcn_mfma_f32_32x32x16_bf16(kf[3],qr[1],C1,0,0,0),   P0[14],P0[15],P1[0],P1[1],   pw1[2]=PKW(P0,12),pw1[3]=PKW(P0,14), pw1); \
    VRD(2); SBAR(); GAPA(C0=__builtin_amdgcn_mfma_f32_32x32x16_bf16(kf[4],qr[2],C0,0,0,0),   P1[2],P1[3],P1[4],P1[5],     pw2[0]=PKW(P1,0), pw2[1]=PKW(P1,2), pw2); \
    VRD(6); SBAR(); GAPA(C1=__builtin_amdgcn_mfma_f32_32x32x16_bf16(kf[5],qr[2],C1,0,0,0),   P1[6],P1[7],P1[8],P1[9],     pw2[2]=PKW(P1,4), pw2[3]=PKW(P1,6), pw2); \
    VRD(3); SBAR(); GAPA(C0=__builtin_amdgcn_mfma_f32_32x32x16_bf16(kf[6],qr[3],C0,0,0,0),   P1[10],P1[11],P1[12],P1[13], pw3[0]=PKW(P1,8), pw3[1]=PKW(P1,10), pw3); \
    VRD(7); SBAR(); GAPA(C1=__builtin_amdgcn_mfma_f32_32x32x16_bf16(kf[7],qr[3],C1,0,0,0),   P1[14],P1[15],0.f,0.f,       pw3[2]=PKW(P1,12),pw3[3]=PKW(P1,14), pw3); \
    l_reg+=sacc; \
    if(MASK&&(DOCM)){ CMASK(C0,C1,t,MW); } \
    if(GK){DMA_K((t)+3,sl_cur);} if(GV){DMA_V((t)+1,sl_next);} \
    if(!MASK&&(DOCM)){ CMASK(C0,C1,t,MW); } \
    if(GM){ MLOAD(MW,(t)+2); } \
    { float a=MX3(C0[0],C0[1],C1[0]),b=MX3(C0[2],C0[3],C1[1]); a=MX3(a,C1[2],C1[3]); \
      _Pragma("unroll") for(int r=4;r<16;r+=4){a=MX3(a,C0[r],C0[r+1]);b=MX3(b,C0[r+2],C0[r+3]);a=MX3(a,C1[r],C1[r+1]);b=MX3(b,C1[r+2],C1[r+3]);} \
      float rm=__builtin_fmaxf(a,b); { auto rr=__builtin_amdgcn_permlane32_swap(__float_as_uint(rm),__float_as_uint(rm),false,false); rm=__builtin_fmaxf(__uint_as_float(rr[0]),__uint_as_float(rr[1])); } \
      resc=false; \
      if(__builtin_expect(__any(rm>(float)THRL),0)){ const float dl=__builtin_fmaxf(rm,0.f); mhat+=dl; \
        _Pragma("unroll") for(int r=0;r<16;++r){C0[r]-=dl;C1[r]-=dl;} \
        const float f=__builtin_amdgcn_exp2f(-dl); l_reg*=f; if(hi==0)wsf[r32]=f; resc=true; } } \
    SBAR(); \
    GAPB(o[0]=__builtin_amdgcn_mfma_f32_32x32x16_bf16(PAF(0),VFR(0),o[0],0,0,0), C0,0); \
    GAPB(o[1]=__builtin_amdgcn_mfma_f32_32x32x16_bf16(PAF(0),VFR(4),o[1],0,0,0), C0,4); \
    KRD(GL,0); GAPB(o[0]=__builtin_amdgcn_mfma_f32_32x32x16_bf16(PAF(1),VFR(1),o[0],0,0,0), C0,8); \
    KRD(GL,1); GAPB(o[1]=__builtin_amdgcn_mfma_f32_32x32x16_bf16(PAF(1),VFR(5),o[1],0,0,0), C0,12); \
    KRD(GL,2); GAPB(o[0]=__builtin_amdgcn_mfma_f32_32x32x16_bf16(PAF(2),VFR(2),o[0],0,0,0), C1,0); \
    KRD(GL,3); GAPB(o[1]=__builtin_amdgcn_mfma_f32_32x32x16_bf16(PAF(2),VFR(6),o[1],0,0,0), C1,4); \
    GAPB(o[0]=__builtin_amdgcn_mfma_f32_32x32x16_bf16(PAF(3),VFR(3),o[0],0,0,0), C1,8); \
    GAPB(o[1]=__builtin_amdgcn_mfma_f32_32x32x16_bf16(PAF(3),VFR(7),o[1],0,0,0), C1,12); \
    }while(0)
  int t=1;
  #define ENDW(tt) do{ if((tt)+3<NT){ if(MASK){WAIT_BAR(3);}else{WAIT_BAR(2);} } else if((tt)+2<NT){ if(MASK){WAIT_BAR(2);}else{WAIT_BAR(1);} } else {WAIT_BAR(0);} }while(0)
  for(;t+5<NT;t+=2){
    STEP(pB0,pB1,pA0,pA1,t,true,true,true,mwB,MASK,MASK);     if(MASK){WAIT_BAR(3);}else{WAIT_BAR(2);} MPIN(mwA); RESC(); ROT();
    STEP(pA0,pA1,pB0,pB1,t+1,true,true,true,mwA,MASK,MASK);   if(MASK){WAIT_BAR(3);}else{WAIT_BAR(2);} MPIN(mwB); RESC(); ROT();
  }
  for(;t+1<NT;t+=2){
    STEP(pB0,pB1,pA0,pA1,t,(t+3<NT),(t+1<NT),(t+1<NT),mwB,(MASK&&(t+2<NT)),true);       ENDW(t);   MPIN(mwA); RESC(); ROT();
    STEP(pA0,pA1,pB0,pB1,t+1,(t+4<NT),(t+2<NT),(t+2<NT),mwA,(MASK&&(t+3<NT)),true);     ENDW(t+1); MPIN(mwB); RESC(); ROT();
  }
  STEP(pB0,pB1,pA0,pA1,NT-1,false,false,false,mwB,false,true); RESC();
  { float sacc=pB0[0]+pB0[1]; _Pragma("unroll") for(int r=2;r<16;++r)sacc+=pB0[r]; _Pragma("unroll") for(int r=0;r<16;++r)sacc+=pB1[r]; l_reg+=sacc;
    pw0=(u32x4){PKW(pB0,0),PKW(pB0,2),PKW(pB0,4),PKW(pB0,6)};pw1=(u32x4){PKW(pB0,8),PKW(pB0,10),PKW(pB0,12),PKW(pB0,14)};pw2=(u32x4){PKW(pB1,0),PKW(pB1,2),PKW(pB1,4),PKW(pB1,6)};pw3=(u32x4){PKW(pB1,8),PKW(pB1,10),PKW(pB1,12),PKW(pB1,14)};
    SBAR(); pv(o,vb0+sl_cur,PAF(0),PAF(1),PAF(2),PAF(3)); }
  #undef PKW
  #undef PAF
  #undef VFR
  #undef PIN
  #undef MX3
  #undef GAPA
  #undef GAPB
  #undef EX
  #undef VRD
  #undef KRD
  #undef STEP
  #undef ENDW
  {auto rr=__builtin_amdgcn_permlane32_swap(__float_as_uint(l_reg),__float_as_uint(l_reg),false,false);l_reg=__uint_as_float(rr[0])+__uint_as_float(rr[1]);}
  if(hi==0)wsf[32+r32]=l_reg;asm volatile("s_waitcnt lgkmcnt(0)":::"memory");
  float rli[16];
  #pragma unroll
  for(int r=0;r<16;++r)rli[r]=__builtin_amdgcn_rcpf(wsf[32+crow(r,hi)]);
  bf16*Ow=Os+(long)(q0+wid*QBLK)*OP;
  { bf16*stg=(bf16*)(shm+LDS_OST)+wid*2048;
    #pragma unroll
    for(int r=0;r<16;++r){const int orow=crow(r,hi);
      #pragma unroll
      for(int d0=0;d0<2;++d0)stg[orow*64+d0*32+r32]=__float2bfloat16(o[d0][r]*rli[r]);}
    asm volatile("s_waitcnt lgkmcnt(0)":::"memory");
    #pragma unroll
    for(int i=0;i<4;++i){const int row=i*8+(lane>>3),ch=lane&7; const u32x4 v=*(const u32x4*)(stg+row*64+ch*8); *(u32x4*)(Ow+(long)row*OP+ch*8)=v;} }
  asm volatile("s_waitcnt lgkmcnt(0)\n\ts_barrier":::"memory");
  #undef DMA_K
  #undef MLOAD
  #undef MPIN
  #undef DMA_V
  #undef CMASK
  #undef START
  #undef RESC
  #undef ROT
}
#undef SBAR
#undef WAIT_BAR
}
struct Args { const float* in[25]; float* out; unsigned char* ws; int ph_lo, ph_hi; };
struct Frame {
    LAS unsigned char* lds; unsigned char* ldsg;
    volatile LAS unsigned* MISC;
    gu32* ctl;
    int tid, lane, wave, vcu, G;
    unsigned char* ws; float* out;
};
__device__ __forceinline__ float dpp_add_(float v, float acc_src, int) { return v; }
#define DPP_F(v, ctrl, rmask) __builtin_bit_cast(float, __builtin_amdgcn_update_dpp(0, __builtin_bit_cast(int, (v)), (ctrl), (rmask), 0xF, false))
__device__ __forceinline__ float wave_sum(float v) {
    v += DPP_F(v, 0xB1, 0xF);
    v += DPP_F(v, 0x4E, 0xF);
    v += DPP_F(v, 0x141, 0xF);
    v += DPP_F(v, 0x140, 0xF);
    v += DPP_F(v, 0x142, 0xA);
    v += DPP_F(v, 0x143, 0xC);
    return __builtin_bit_cast(float, __builtin_amdgcn_readlane(__builtin_bit_cast(int, v), 63));
}
__device__ __forceinline__ bf16* wsb(const Frame& F, size_t off) { return (bf16*)(F.ws + off); }

__device__ __forceinline__ int map_small(int r) {
    if (r < 1024) return r;
    if (r < 1280) return 1028 + (r - 1024);
    if (r < 1536) return 1412 + (r - 1280);
    if (r < 2048) return 1736 + (r - 1536);
    if (r < 2112) return 1284 + (r - 2048);
    if (r < 2176) return 1348 + (r - 2112);
    if (r < 2240) return 1668 + (r - 2176);
    if (r < 2244) return 1024 + (r - 2240);
    if (r < 2248) return 1732 + (r - 2244);
    return -1;
}
__device__ __forceinline__ void tr_item(const float* src, int ld_src, int k0, int srccol, bf16* dst, int ld_dst, LAS float* scr, int lane) {
    float tv[32];
#pragma unroll
    for (int i = 0; i < 32; ++i) { const int kk = 2 * i + (lane >> 5); tv[i] = src[(size_t)(k0 + kk) * ld_src + (srccol >= 0 ? srccol : 0)]; }
#pragma unroll
    for (int i = 0; i < 32; ++i) { const int kk = 2 * i + (lane >> 5); scr[kk * 33 + (lane & 31)] = srccol >= 0 ? tv[i] : 0.f; }
    LDS_WAIT(); asm volatile("" ::: "memory");
    const int c = lane & 7;
#pragma unroll
    for (int j = 0; j < 4; ++j) { const int n = (lane >> 3) + 8 * j; const LAS float* s = scr + (8 * c) * 33 + n;
        v4u o; o.x = pk2(s[0 * 33], s[1 * 33]); o.y = pk2(s[2 * 33], s[3 * 33]); o.z = pk2(s[4 * 33], s[5 * 33]); o.w = pk2(s[6 * 33], s[7 * 33]);
        *(GAS v4u*)(dst + (size_t)n * ld_dst + 8 * c) = o; }
    LDS_WAIT(); asm volatile("" ::: "memory");
}
constexpr float ACT_SCALE = 8.f;
constexpr float GATE_WSCALE = 32.f;
__device__ __forceinline__ void tr_item8(const float* src, int ld_src, int k0, int srccol, unsigned char* dst, int ld_dst, LAS float* scr, int lane) {
    float tv[32];
#pragma unroll
    for (int i = 0; i < 32; ++i) { const int kk = 2 * i + (lane >> 5); tv[i] = src[(size_t)(k0 + kk) * ld_src + srccol]; }
#pragma unroll
    for (int i = 0; i < 32; ++i) { const int kk = 2 * i + (lane >> 5); scr[kk * 33 + (lane & 31)] = tv[i] * GATE_WSCALE; }
    LDS_WAIT(); asm volatile("" ::: "memory");
    const int c = lane & 7;
#pragma unroll
    for (int j = 0; j < 4; ++j) { const int n = (lane >> 3) + 8 * j; const LAS float* s = scr + (8 * c) * 33 + n;
        v2u o; o.x = pk4_fp8(s[0 * 33], s[1 * 33], s[2 * 33], s[3 * 33]); o.y = pk4_fp8(s[4 * 33], s[5 * 33], s[6 * 33], s[7 * 33]);
        *(GAS v2u*)(dst + (size_t)n * ld_dst + 8 * c) = o; }
    LDS_WAIT(); asm volatile("" ::: "memory");
}
constexpr int IT_SM = 72 * 16, IT_GT = 128 * 16, IT_BR = 512, IT_OUT = 512, IT_GU = 16 * 512, IT_D = 16 * 256, IT_LAYER = IT_SM + IT_GT + IT_BR + IT_OUT + IT_GU + IT_D;
__device__ __forceinline__ void p0_item(const Frame& F, const Args& a, int it, LAS float* scr) {
    const int l = it / IT_LAYER; int j = it % IT_LAYER; const int n = F.lane & 31;
    bf16* W = wsb(F, WS_W + (size_t)l * W_LAYER);
    if (j < IT_SM) { const int g = j / 16, kb = j % 16; tr_item(a.in[3] + (size_t)l * DM * P_TOTAL, P_TOTAL, kb * 64, map_small(g * 32 + n), W + W_SM / 2 + (size_t)(g * 32) * DM + kb * 64, DM, scr, F.lane); return; } j -= IT_SM;
    if (j < IT_GT) { const int g = j / 16, kb = j % 16; tr_item8(a.in[3] + (size_t)l * DM * P_TOTAL, P_TOTAL, kb * 64, 2248 + g * 32 + n, (unsigned char*)W + W_GT + (size_t)(g * 32) * DM + kb * 64, DM, scr, F.lane); return; } j -= IT_GT;
    if (j < IT_BR) { const int nb = j / 128, jj = j % 128, g = jj / 4, kb = jj % 4;
        tr_item(a.in[12] + ((size_t)l * 4 + nb) * 256 * DM, DM, kb * 64, g * 32 + n, W + W_BR / 2 + (size_t)(g * 32) * DM + nb * 256 + kb * 64, DM, scr, F.lane); return; } j -= IT_BR;
    if (j < IT_OUT) { const int g = j / 16, kb = j % 16; tr_item(a.in[13] + (size_t)l * DM * DM, DM, kb * 64, g * 32 + n, W + W_OUT / 2 + (size_t)(g * 32) * DM + kb * 64, DM, scr, F.lane); return; } j -= IT_OUT;
    if (j < IT_GU) { const int e = j / 512, jj = j % 512, g = jj / 16, kb = jj % 16; const int r0 = g * 32, q = r0 >> 8, within = r0 & 255; const bool isup = within >= 128;
        const float* src = (isup ? a.in[21] : a.in[20]) + ((size_t)l * 16 + e) * DM * 512;
        tr_item8(src, 512, kb * 64, 128 * q + (within & 127) + n, (unsigned char*)W + W_GU + (size_t)e * DM * DM + (size_t)r0 * DM + kb * 64, DM, scr, F.lane); return; } j -= IT_GU;
    { const int e = j / 256, jj = j % 256, g = jj / 8, kb = jj % 8;
        tr_item8(a.in[22] + ((size_t)l * 16 + e) * 512 * DM, DM, kb * 64, g * 32 + n, (unsigned char*)W + W_D + (size_t)(e >> 1) * DM * DM + (size_t)(g * 32) * DM + (e & 1) * 512 + kb * 64, DM, scr, F.lane); }
}
__device__ __forceinline__ void ln_load(const Frame& F, const float* xrow, f32x4 (&v)[4]) {
    const GAS f32x4* xr = (const GAS f32x4*)xrow + F.lane;
#pragma unroll
    for (int j = 0; j < 4; ++j) v[j] = xr[64 * j];
}
struct LnGB { f32x4 g[4], b[4]; };
__device__ __forceinline__ void ln_gb_load(const Frame& F, const float* g, const float* b, LnGB& gb) {
#pragma unroll
    for (int j = 0; j < 4; ++j) { gb.g[j] = ((const GAS f32x4*)g)[F.lane + 64 * j]; gb.b[j] = ((const GAS f32x4*)b)[F.lane + 64 * j]; }
}
__device__ __forceinline__ void ln_load_bf(const Frame& F, const bf16* xrow, f32x4 (&v)[4]) {
    const GAS v2u* xr = (const GAS v2u*)xrow + F.lane;
#pragma unroll
    for (int j = 0; j < 4; ++j) { const v2u w = xr[64 * j]; v[j] = (f32x4){bfl(w.x), bfh(w.x), bfl(w.y), bfh(w.y)}; }
}
__device__ __forceinline__ void ln_row(const Frame& F, const LnGB& gb, float* orow  , bf16* brow  , f32x4 (&v)[4], bool dry = false, unsigned char* frow = nullptr  ) {
    float s = 0.f;
#pragma unroll
    for (int j = 0; j < 4; ++j) s += (v[j].x + v[j].y) + (v[j].z + v[j].w);
    const float mean = wave_sum(s) * (1.f / DM); float s2 = 0.f;
#pragma unroll
    for (int j = 0; j < 4; ++j) { v[j] = v[j] - mean; s2 += (v[j].x * v[j].x + v[j].y * v[j].y) + (v[j].z * v[j].z + v[j].w * v[j].w); }
    const float rstd = 1.f / sqrtf(wave_sum(s2) * (1.f / DM) + LN_EPS);
    GAS f32x4* o4 = (GAS f32x4*)orow + F.lane; GAS v2u* o8 = (GAS v2u*)brow + F.lane; GAS unsigned* o1 = (GAS unsigned*)frow + F.lane;
#pragma unroll
    for (int j = 0; j < 4; ++j) { v[j] = v[j] * rstd * gb.g[j] + gb.b[j]; v2u w; w.x = pk2(v[j].x, v[j].y); w.y = pk2(v[j].z, v[j].w); if (!dry) { if (orow) o4[64 * j] = v[j]; if (brow) o8[64 * j] = w; if (frow) o1[64 * j] = pk4_fp8(v[j].x, v[j].y, v[j].z, v[j].w); } }
}
__device__ __forceinline__ void p0_prologue(const Frame& F_, const Args& a) { Frame F = F_; F.lane = lane_id_(); F.tid = F.wave * 64 + F.lane;
    LAS float* scr = (LAS float*)(F.lds + RING_OFF + F.wave * 16384);
    const int gw = F.vcu * NWAVES + F.wave, NGW = F.G * NWAVES;
    for (int it = gw; it < DEPTH * IT_LAYER; it += NGW) p0_item(F, a, it, scr);
    { LnGB gb; ln_gb_load(F, a.in[1], a.in[2], gb); f32x4 nx[4]; ln_load(F, a.in[0] + (size_t)gw * DM, nx);
      for (int m = gw; m < NTOK; m += NGW) { f32x4 v[4];
#pragma unroll
          for (int j = 0; j < 4; ++j) v[j] = nx[j];
          if (m + NGW < NTOK) ln_load(F, a.in[0] + (size_t)(m + NGW) * DM, nx);
          ln_row(F, gb, nullptr, wsb(F, WS_HB) + (size_t)m * DM, v, false, F.ws + WS_HB8 + (size_t)m * DM); } }
}

#ifndef TO_WGM
#define TO_WGM 8
#endif
struct TileOrder {
    int nM, nN, nwg, G, c;
    __device__ void init(int nM_, int nN_, int G_, int c_) { nM = nM_; nN = nN_; nwg = nM * nN; G = G_; c = c_; }
    __device__ bool tile(int i, int& pm, int& pn) const {
        const long L = (long)i * G + c; if (L >= nwg) return false;
        int wgid = (int)L; { const int q = nwg / 8, r = nwg % 8, xcd = wgid % 8, off = wgid / 8; wgid = (xcd < r ? xcd * (q + 1) : r * (q + 1) + (xcd - r) * q) + off; }
        const int nig = TO_WGM * nN, gid = wgid / nig, fm = gid * TO_WGM, gsz = (nM - fm) < TO_WGM ? (nM - fm) : TO_WGM;
        pm = fm + ((wgid % nig) % gsz); pn = (wgid % nig) / gsz; return true;
    }
};
struct SchedA { static constexpr int NT = 0, KS = 0; TileOrder T; const char* A; const char* B;
    __device__ bool next(int i, pg8::GU& u) const { int pm, pn; if (!T.tile(i, pm, pn)) return false; u.A = A + (size_t)pm * pg8::TSTEP; u.B0 = B + (size_t)pn * pg8::TSTEP; u.B1 = u.B0; u.nt = 16; u.ks = 16; u.pm = pm; u.pn = pn; u.rows = nullptr; u.rbase = 0; u.rcnt = 0; u.a0 = 0; u.a1 = 0; return true; } };
struct EpiA { static constexpr bool F8 = false; static constexpr bool PERM = true; bf16* P; float* FW; bf16* KIDX;
    __device__ __forceinline__ void operator()(const pg8::f32x4 (&acc)[2][2][4][2], const pg8::GU& u, int wr, int wc, int fr, int fq) {
        const float sc = (u.pn == 1 || u.pn == 4) ? 0.125f * LOG2E : 1.f;
        const int row0 = u.pm * 256 + wr * 64 + fr, col0 = u.pn * 256 + wc * 32 + 8 * fq;
#pragma unroll
        for (int ai = 0; ai < 2; ++ai)
#pragma unroll
            for (int m = 0; m < 4; ++m) { const int row = row0 + ai * 128 + m * 16; bf16* rowp = P + (size_t)row * PS + col0;
#pragma unroll
                for (int bj = 0; bj < 2; ++bj) { const pg8::f32x4 v0 = acc[ai][bj][m][0] * sc, v1 = acc[ai][bj][m][1] * sc; v4u w;
                    w.x = pg8::cvt_pk_bf16(v0[0], v0[1]); w.y = pg8::cvt_pk_bf16(v0[2], v0[3]); w.z = pg8::cvt_pk_bf16(v1[0], v1[1]); w.w = pg8::cvt_pk_bf16(v1[2], v1[3]);
                    *(v4u*)(rowp + bj * 128) = w;
                    if (bj == 1 && u.pn == 8 && wc < 2) *(v4u*)(KIDX + (size_t)row * 64 + wc * 32 + 8 * fq) = w;
                    if (bj == 1 && u.pn == 8 && wc == 2 && fq == 0) { *(f32x4*)(FW + (size_t)row * 8) = v0; *(f32x4*)(FW + (size_t)row * 8 + 4) = v1; } } }
    } };
struct SchedC { TileOrder T; const char* HBp; const char* BRp; const char* WGp; const char* WBp; bool collapse;
    __device__ bool next(int i, pg8::GU& u) const { int pm, pd; if (!T.tile(i >> 3, pm, pd)) return false; const int sub = i & 7, n = sub >> 1, isg = sub & 1; const int pm_o = pm, pd_o = pd; if (collapse) { pm &= 7; pd = 0; }
        u.pm = pm; u.pn = pd; u.a0 = n; u.a1 = isg; u.rows = nullptr; u.rbase = 0; u.rcnt = 0;
        if (isg) { u.A = HBp + (size_t)pm * (pg8::TSTEP / 2); u.B0 = WGp + (size_t)(n * 8 + pd) * (pg8::HSTEP / 2); u.nt = 8; }
        else     { u.A = BRp + (size_t)pm * pg8::TSTEP + n * 512; u.B0 = WBp + (size_t)pd * pg8::HSTEP + n * 512; u.nt = 4; }
        u.B1 = u.B0; u.ks = u.nt; u.pm = pm_o; u.pn = pd_o; return true; } };
struct EpiC { static constexpr bool F8 = false; static constexpr bool PERM = true; bf16* MIX; const float* bgate; bool dry;
    __device__ __forceinline__ void operator()(const pg8::f32x4 (&acc)[2][4][2], pg8::u32x4 (&upk)[2][4], pg8::u32x4 (&sum)[2][4]  , const pg8::GU& u, int wr, int wc, int fr, int fq) {
        const int n = u.a0;
        if (!u.a1) {
#pragma unroll
            for (int ai = 0; ai < 2; ++ai)
#pragma unroll
                for (int m = 0; m < 4; ++m) { const pg8::f32x4 v0 = acc[ai][m][0], v1 = acc[ai][m][1]; v4u w;
                    w.x = pg8::cvt_pk_bf16(v0[0], v0[1]); w.y = pg8::cvt_pk_bf16(v0[2], v0[3]); w.z = pg8::cvt_pk_bf16(v1[0], v1[1]); w.w = pg8::cvt_pk_bf16(v1[2], v1[3]); upk[ai][m] = w; }
        } else {
            const int colt = u.pn * 128 + wc * 32 + 8 * fq; const float* bp = bgate + n * DM + colt; const f32x4 b0 = *(const f32x4*)bp, b1 = *(const f32x4*)(bp + 4);
#pragma unroll
            for (int ai = 0; ai < 2; ++ai)
#pragma unroll
                for (int m = 0; m < 4; ++m) { const v4u uw = upk[ai][m]; const pg8::f32x4 g0 = acc[ai][m][0] * (1.f / GATE_WSCALE) + b0, g1 = acc[ai][m][1] * (1.f / GATE_WSCALE) + b1;
                    pg8::f32x4 r0, r1; r0[0] = sigmoidf_(g0[0]) * bfl(uw.x); r0[1] = sigmoidf_(g0[1]) * bfh(uw.x); r0[2] = sigmoidf_(g0[2]) * bfl(uw.y); r0[3] = sigmoidf_(g0[3]) * bfh(uw.y);
                    r1[0] = sigmoidf_(g1[0]) * bfl(uw.z); r1[1] = sigmoidf_(g1[1]) * bfh(uw.z); r1[2] = sigmoidf_(g1[2]) * bfl(uw.w); r1[3] = sigmoidf_(g1[3]) * bfh(uw.w);
                    if (n > 0) { const v4u pw = sum[ai][m]; r0[0] += bfl(pw.x); r0[1] += bfh(pw.x); r0[2] += bfl(pw.y); r0[3] += bfh(pw.y); r1[0] += bfl(pw.z); r1[1] += bfh(pw.z); r1[2] += bfl(pw.w); r1[3] += bfh(pw.w); }
                    v4u o; o.x = pg8::cvt_pk_bf16(r0[0], r0[1]); o.y = pg8::cvt_pk_bf16(r0[2], r0[3]); o.z = pg8::cvt_pk_bf16(r1[0], r1[1]); o.w = pg8::cvt_pk_bf16(r1[2], r1[3]); sum[ai][m] = o; }
            if (n == 3) { const int row0 = u.pm * 256 + wr * 64 + fr;
#pragma unroll
                for (int ai = 0; ai < 2; ++ai)
#pragma unroll
                    for (int m = 0; m < 4; ++m) *(v4u*)(MIX + (size_t)(row0 + ai * 128 + m * 16) * DM + colt) = sum[ai][m]; }
        }
    } };
struct SchedC2 { static constexpr int NT = 0, KS = 0; TileOrder T; const char* A; const char* B;
    __device__ bool next(int i, pg8::GU& u) const { int pm, pn; if (!T.tile(i, pm, pn)) return false; u.A = A + (size_t)pm * pg8::TSTEP; u.B0 = B + (size_t)pn * pg8::TSTEP; u.B1 = u.B0; u.nt = 16; u.ks = 16; u.pm = pm; u.pn = pn; u.rows = nullptr; u.rbase = 0; u.rcnt = 0; u.a0 = 0; u.a1 = 0; return true; } };
struct EpiRes { static constexpr bool F8 = false; static constexpr bool PERM = false; bf16* V1; const bf16* HB; bool dry;
    __device__ __forceinline__ void operator()(const pg8::f32x4 (&acc)[2][2][4][2], const pg8::GU& u, int wr, int wc, int fr, int fq) {
        const int row0 = u.pm * 256 + wr * 64 + fr, col0 = u.pn * 256 + wc * 32 + 4 * fq;
#pragma unroll
        for (int ai = 0; ai < 2; ++ai)
#pragma unroll
            for (int m = 0; m < 4; ++m) { const size_t ro = (size_t)(row0 + ai * 128 + m * 16) * DM + col0;
#pragma unroll
                for (int bj = 0; bj < 2; ++bj)
#pragma unroll
                    for (int n = 0; n < 2; ++n) { const v2u hw = *(const v2u*)(HB + ro + bj * 128 + n * 16); const f32x4 hv = (f32x4){bfl(hw.x), bfh(hw.x), bfl(hw.y), bfh(hw.y)};
                        const f32x4 r_ = hv * ALPHA + acc[ai][bj][m][n]; v2u o; o.x = pk2(r_.x, r_.y); o.y = pk2(r_.z, r_.w); if (!dry) *(v2u*)(V1 + ro + bj * 128 + n * 16) = o; } }
    } };
__device__ __forceinline__ void cls_lookup(const LAS int* tab, int tau, int& c, int& j) {
    int cc = 0;
#pragma unroll 1
    for (int k = 1; k < NCLS; ++k) if (tab[32 + k] <= tau) cc = k;
    c = cc; j = tau - tab[32 + cc];
}
__device__ __forceinline__ void cls_experts(int c, int& ea, int& eb) { const int g = c / 6, p = c % 6; const int i = p < 3 ? 0 : (p < 5 ? 1 : 2); const int jj = p < 3 ? p + 1 : (p < 5 ? p - 1 : 3); ea = g * 4 + i; eb = g * 4 + jj; }
struct SchedD1 { static constexpr int NT = 0, KS = 0; const LAS int* tab; int G, c0; const char* HBp; const char* WGU; const int* list;
    __device__ bool next(int i, pg8::GU& u) const { const int L = i * G + c0; if (L >= tab[57] * 8) return false; const int tau = L >> 3, pn = L & 7; int c, j; cls_lookup(tab, tau, c, j); int ea, eb; cls_experts(c, ea, eb);
        const int e = (pn >> 2) ? eb : ea;
        u.A = HBp; u.B0 = WGU + (size_t)e * DM * DM + (size_t)(pn & 3) * (pg8::TSTEP / 2); u.B1 = u.B0; u.nt = 8; u.ks = 8;     u.rows = list + (size_t)c * NTOK; u.rbase = j * 256; u.rcnt = tab[c];
        u.pm = tau; u.pn = pn; u.a0 = c; u.a1 = j; return true; } };
struct EpiD1 { static constexpr bool F8 = true; static constexpr bool PERM = true; unsigned char* ACT; const float* gwl;
    __device__ __forceinline__ void operator()(const pg8::f32x4 (&acc)[2][2][4][2], const pg8::GU& u, int wr, int wc, int fr, int fq) {
        const int half = u.pn >> 2, col = half * 512 + (u.pn & 3) * 128 + wc * 32 + 8 * fq;
#pragma unroll
        for (int ai = 0; ai < 2; ++ai)
#pragma unroll
            for (int m = 0; m < 4; ++m) { const int r = ai * 128 + wr * 64 + m * 16 + opaque_i(fr), pos = u.rbase + r;
                const float gw = pos < u.rcnt ? gwl[((size_t)u.a0 * NTOK + pos) * 2 + half] * ACT_SCALE : 0.f;
                const pg8::f32x4 g0 = acc[ai][0][m][0] * (1.f / GATE_WSCALE), g1 = acc[ai][0][m][1] * (1.f / GATE_WSCALE), u0 = acc[ai][1][m][0] * (1.f / GATE_WSCALE), u1 = acc[ai][1][m][1] * (1.f / GATE_WSCALE); float r8[8];
#pragma unroll
                for (int k = 0; k < 4; ++k) { r8[k] = g0[k] * sigmoidf_(g0[k]) * u0[k] * gw; r8[4 + k] = g1[k] * sigmoidf_(g1[k]) * u1[k] * gw; }
                v2u o; o.x = pk4_fp8(r8[0], r8[1], r8[2], r8[3]); o.y = pk4_fp8(r8[4], r8[5], r8[6], r8[7]);
                *(v2u*)(ACT + ((size_t)u.pm * 256 + r) * DM + col) = o; asm volatile("" ::: "memory"); }
    } };
struct SchedD2 { static constexpr int NT = 8, KS = 4; const LAS int* tab; int G, c0; const char* ACTp; const char* WD; const int* list;
    __device__ bool next(int i, pg8::GU& u) const { const int L = i * G + c0; if (L >= __builtin_amdgcn_readfirstlane(tab[57]) * 4) return false; const int tau = L >> 2, pn = L & 3; int c, j; cls_lookup(tab, tau, c, j); c = __builtin_amdgcn_readfirstlane(c); j = __builtin_amdgcn_readfirstlane(j); int ea, eb; cls_experts(c, ea, eb);
        u.A = sptr_(ACTp + (size_t)tau * (pg8::TSTEP / 2)); u.B0 = sptr_(WD + (size_t)(ea >> 1) * DM * DM + (ea & 1) * 512 + (size_t)pn * (pg8::TSTEP / 2)); u.B1 = sptr_(WD + (size_t)(eb >> 1) * DM * DM + (eb & 1) * 512 + (size_t)pn * (pg8::TSTEP / 2));
        u.nt = 8; u.ks = 4;     u.rows = list + (size_t)c * NTOK; u.rbase = j * 256; u.rcnt = __builtin_amdgcn_readfirstlane(tab[c]); u.pm = tau; u.pn = pn; u.a0 = c; u.a1 = j; return true; } };
struct EpiD2 { static constexpr bool F8 = true; static constexpr bool PERM = false; bf16* V2; const bf16* HB; bool dry;
    __device__ __forceinline__ void operator()(const pg8::f32x4 (&acc)[2][2][4][2], const pg8::GU& u, int wr, int wc, int fr, int fq) {
        const int col0 = u.pn * 256 + wc * 32 + 4 * fq;
#pragma unroll
        for (int ai = 0; ai < 2; ++ai) { asm volatile("" ::: "memory");
#pragma unroll
            for (int m = 0; m < 4; ++m) { if (m == 2) asm volatile("" ::: "memory"); const int pos = u.rbase + ai * 128 + wr * 64 + m * 16 + opaque_i(fr);
                if (pos < u.rcnt) { const size_t ro = (size_t)u.rows[pos] * DM + col0;
#pragma unroll
                    for (int bj = 0; bj < 2; ++bj)
#pragma unroll
                        for (int n = 0; n < 2; ++n) { const v2u hw = *(const v2u*)(HB + ro + bj * 128 + n * 16); const f32x4 hv = (f32x4){bfl(hw.x), bfh(hw.x), bfl(hw.y), bfh(hw.y)};
                            const f32x4 r_ = hv * ALPHA + acc[ai][bj][m][n] * (1.f / (ACT_SCALE * GATE_WSCALE)); v2u o; o.x = pk2(r_.x, r_.y); o.y = pk2(r_.z, r_.w); if (!dry) *(v2u*)(V2 + ro + bj * 128 + n * 16) = o; } } } }
    } };
typedef float f32x2v __attribute__((ext_vector_type(2)));
__device__ __forceinline__ float log_sigmoid_(float x) { return fminf(x, 0.f) - __builtin_amdgcn_logf(1.f + __builtin_amdgcn_exp2f(-fabsf(x) * LOG2E)) * 0.6931471805599453f; }
__device__ __forceinline__ void fox_cumsum(const Frame& F_, int bh, const float* FW, const float* bfor, float* bias2) { Frame F = F_; F.lane = lane_id_(); F.tid = F.wave * 64 + F.lane;
    const int b = bh >> 2, h = bh & 3; const float bf = bfor[h]; const float* src = FW + ((size_t)b * SEQ + F.lane * 64) * 8 + h; float tot = 0.f;
    for (int i = 0; i < 64; ++i) tot += log_sigmoid_(src[(size_t)i * 8] + bf);
    float inc = tot;
#pragma unroll
    for (int o = 1; o < 64; o <<= 1) { const float t = __int_as_float(shfl_i_(__float_as_int(inc), F.lane - o)); if (F.lane >= o) inc += t; }
    float run = inc - tot; float* dst = bias2 + (size_t)bh * SEQ + F.lane * 64;
    for (int i = 0; i < 64; ++i) { run += log_sigmoid_(src[(size_t)i * 8] + bf); dst[i] = -run * LOG2E; }
}
template <int WIN> __device__ __forceinline__ void pool_frags(bf16x8 (&af)[4], const bf16* src0, int tb) {
    const int nrow = tb + 1 < WIN ? tb + 1 : WIN; const float inv = 1.f / (float)nrow;
#pragma unroll
    for (int ks = 0; ks < 4; ++ks) { const bf16* src = src0 + ks * 16; v4u wv[WIN];
#pragma unroll
        for (int j = 0; j < WIN; ++j) wv[j] = *(const v4u*)(src - (size_t)(j <= tb ? j : 0) * PS);
        float s[8];
#pragma unroll
        for (int k = 0; k < 8; ++k) s[k] = 0.f;
#pragma unroll
        for (int j = 0; j < WIN; ++j) { if (j <= tb) { const v4u w = wv[j];
            s[0] += bfl(w.x); s[1] += bfh(w.x); s[2] += bfl(w.y); s[3] += bfh(w.y); s[4] += bfl(w.z); s[5] += bfh(w.z); s[6] += bfl(w.w); s[7] += bfh(w.w); } }
        const v4u cur = wv[0];
        const float c[8] = {bfl(cur.x), bfh(cur.x), bfl(cur.y), bfh(cur.y), bfl(cur.z), bfh(cur.z), bfl(cur.w), bfh(cur.w)};
        v4u o; o.x = pk2(s[0] * inv - c[0], s[1] * inv - c[1]); o.y = pk2(s[2] * inv - c[2], s[3] * inv - c[3]); o.z = pk2(s[4] * inv - c[4], s[5] * inv - c[5]); o.w = pk2(s[6] * inv - c[6], s[7] * inv - c[7]);
        af[ks] = __builtin_bit_cast(bf16x8, o); }
}
__device__ __forceinline__ void pool_unit(const Frame& F_, int tile, const bf16* P, const float* pw, const float* pscale, bf16* BR) { Frame F = F_; F.lane = lane_id_(); F.tid = F.wave * 64 + F.lane;
    const int g = F.wave & 3, th = F.wave >> 2, r32 = F.lane & 31, hi = F.lane >> 5;
    const int tok = tile * 64 + th * 32 + r32, tb = tok & (SEQ - 1);
    const bf16* src0 = P + (size_t)tok * PS + C_POOL + g * 64 + hi * 8;
    bf16x8 af[4];
    if (g == 0) pool_frags<2>(af, src0, tb); else if (g == 1) pool_frags<4>(af, src0, tb); else if (g == 2) pool_frags<8>(af, src0, tb); else pool_frags<16>(af, src0, tb);
#pragma unroll
    for (int db = 0; db < 2; ++db) { f32x16 acc = {};
#pragma unroll
        for (int ks = 0; ks < 4; ++ks) { const float* wp = pw + ((size_t)g * 64 + ks * 16 + hi * 8) * 64 + db * 32 + r32;
            v4u o; o.x = pk2(wp[0], wp[64]); o.y = pk2(wp[128], wp[192]); o.z = pk2(wp[256], wp[320]); o.w = pk2(wp[384], wp[448]);
            acc = __builtin_amdgcn_mfma_f32_32x32x16_bf16(af[ks], __builtin_bit_cast(bf16x8, o), acc, 0, 0, 0); }
        const int col = g * 64 + db * 32 + r32; const float sc = pscale[col];
#pragma unroll
        for (int r = 0; r < 16; ++r) { const int row = tile * 64 + th * 32 + (r & 3) + 8 * (r >> 2) + 4 * hi; BR[(size_t)row * DM + col] = (bf16)f2bf(acc[r] * sc); } }
}
__device__ __forceinline__ void conv_unit(const Frame& F_, int tile, const bf16* P, const float* dw, const float* cb, const float* lg, const float* lb, bf16* BR) { Frame F = F_; F.lane = lane_id_(); F.tid = F.wave * 64 + F.lane;
    LAS float* hb = (LAS float*)(F.lds + RING_OFF);
    LAS float* yb = hb + 62 * 256;
    const int t0 = tile * 32, tb0 = t0 & (SEQ - 1);
    { v4u av[4], gv[4];
#pragma unroll
      for (int k = 0; k < 4; ++k) { const int e = F.tid + k * NWAVES * 64, rr = e >> 5, c8 = (e & 31) * 8, trel = rr - 30; const bool ok = e < 62 * 32 && tb0 + trel >= 0;
          const bf16* src = P + (size_t)(t0 + (ok ? trel : 0)) * PS + C_CONV + c8; av[k] = *(const v4u*)src; gv[k] = *(const v4u*)(src + 256); }
#pragma unroll
      for (int k = 0; k < 4; ++k) { const int e = F.tid + k * NWAVES * 64, rr = e >> 5, c8 = (e & 31) * 8, trel = rr - 30; const bool ok = tb0 + trel >= 0; const v4u a = av[k], gt = gv[k]; float h[8];
          h[0] = bfl(a.x) * sigmoidf_(bfl(gt.x)); h[1] = bfh(a.x) * sigmoidf_(bfh(gt.x)); h[2] = bfl(a.y) * sigmoidf_(bfl(gt.y)); h[3] = bfh(a.y) * sigmoidf_(bfh(gt.y));
          h[4] = bfl(a.z) * sigmoidf_(bfl(gt.z)); h[5] = bfh(a.z) * sigmoidf_(bfh(gt.z)); h[6] = bfl(a.w) * sigmoidf_(bfl(gt.w)); h[7] = bfh(a.w) * sigmoidf_(bfh(gt.w));
          if (!ok) {
#pragma unroll
              for (int q = 0; q < 8; ++q) h[q] = 0.f; }
          if (e < 62 * 32) { *(LAS f32x4*)(hb + rr * 256 + c8) = (f32x4){h[0], h[1], h[2], h[3]}; *(LAS f32x4*)(hb + rr * 256 + c8 + 4) = (f32x4){h[4], h[5], h[6], h[7]}; } } }
    __syncthreads();
    { const int c = F.tid & 255, hf = F.tid >> 8; float w[31];
#pragma unroll
      for (int j = 0; j < 31; ++j) w[j] = dw[j * 256 + c];
      const float bias = cb[c];
#pragma unroll 1
      for (int q4 = 0; q4 < 4; ++q4) { const int tt = hf * 16 + q4 * 4; float x[34];
#pragma unroll
          for (int j = 0; j < 34; ++j) x[j] = hb[(tt + j) * 256 + c];
#pragma unroll
          for (int o = 0; o < 4; ++o) { float a = bias;
#pragma unroll
              for (int j = 0; j < 31; ++j) a += x[o + j] * w[j];
              yb[(tt + o) * 256 + c] = a; } } }
    __syncthreads();
#pragma unroll 1
    for (int q = 0; q < 4; ++q) { const int tt = F.wave * 4 + q; const f32x4 v = *(const LAS f32x4*)(yb + tt * 256 + F.lane * 4);
        const float mean = wave_sum((v.x + v.y) + (v.z + v.w)) * (1.f / 256.f); const f32x4 d = v - mean;
        const float var = wave_sum((d.x * d.x + d.y * d.y) + (d.z * d.z + d.w * d.w)) * (1.f / 256.f); const float rstd = 1.f / sqrtf(var + LN_EPS);
        const f32x4 gg = *(const f32x4*)(lg + F.lane * 4), bb = *(const f32x4*)(lb + F.lane * 4); const f32x4 y = d * rstd * gg + bb;
        v2u o; o.x = pk2(y.x * sigmoidf_(y.x), y.y * sigmoidf_(y.y)); o.y = pk2(y.z * sigmoidf_(y.z), y.w * sigmoidf_(y.w));
        *(v2u*)(BR + (size_t)(t0 + tt) * DM + 768 + F.lane * 4) = o; }
    __syncthreads();
}
__device__ __forceinline__ int key28_(float s) { const int u = (int)__float_as_uint(s); int m = (u & 0x7fffffff) - 0x3B000000; m = m < 0 ? 0 : (m > 0x07FFFFFF ? 0x07FFFFFF : m); return 0x08000000 + (m ^ (u >> 31)); }
__device__ __forceinline__ int key9_(float s) { const int u = (int)__float_as_uint(s); int m = ((u >> 19) & 0xfff) - 0x760; m = m < 0 ? 0 : (m > 255 ? 255 : m); return 256 + (m ^ (u >> 31)); }
__device__ __forceinline__ float key28_lbound(long long kv) {
    if (kv <= 0) return -INFINITY; if (kv > 0x0FFFFFFFll) return INFINITY;
    if (kv > 0x08000000ll) return __uint_as_float((unsigned)(0x3B000000ll + (kv - 0x08000000ll)));
    if (kv == 0x08000000ll) return 0.f;
    return -__uint_as_float((unsigned)(0x3B000000ll + (0x07FFFFFFll - kv)));
}
constexpr int DS_HIST = 0, DS_GT = 65536, DS_EQ = 81920, DS_KT = 98304, DS_SM = LDSCTL_OFF + 1024 - RING_OFF, DS_CAP = 512;
typedef float f32x2p __attribute__((ext_vector_type(2)));
__device__ __forceinline__ float relu_(float x) { const int b = (int)__float_as_uint(x); return __uint_as_float((unsigned)(b > 0 ? b : 0)); }
__device__ __forceinline__ void dsa_ldk(bf16x8 (&kf)[4], const bf16* kp) {
#pragma unroll
    for (int m = 0; m < 4; ++m) kf[m] = *(const bf16x8*)(kp + m * 512);
}
__device__ __forceinline__ void dsa_kfrag(bf16x8 (&kf)[4], const bf16x8 (&raw)[4], LAS unsigned char* kt, int lane) {
    const int rw = lane >> 3, cw = lane & 7, r32 = lane & 31, hi = lane >> 5;
#pragma unroll
    for (int m = 0; m < 4; ++m) *(LAS bf16x8*)(kt + (8 * m + rw) * 128 + ((cw ^ rw) << 4)) = raw[m];
#pragma unroll
    for (int ks = 0; ks < 4; ++ks) kf[ks] = *(const LAS bf16x8*)(kt + r32 * 128 + (((2 * ks + hi) ^ (r32 & 7)) << 4));
}
__device__ __forceinline__ void dsa_scores(const bf16x8 (&qf)[4][4], const bf16x8 (&kf)[4], const float (&w)[4], float (&sc)[16]) {
    f32x16 a[4];
#pragma unroll
    for (int hh = 0; hh < 4; ++hh) { a[hh] = (f32x16){};
#pragma unroll
        for (int ks = 0; ks < 4; ++ks) a[hh] = __builtin_amdgcn_mfma_f32_32x32x16_bf16(kf[ks], qf[hh][ks], a[hh], 0, 0, 0); }
#pragma unroll
    for (int r = 0; r < 16; r += 2) { f32x2p s2 = (f32x2p){relu_(a[0][r]), relu_(a[0][r + 1])} * w[0];
#pragma unroll
        for (int hh = 1; hh < 4; ++hh) s2 = (f32x2p){relu_(a[hh][r]), relu_(a[hh][r + 1])} * w[hh] + s2;
        sc[r] = s2.x + 0.f; sc[r + 1] = s2.y + 0.f; }
}
template <int NB4> __device__ __forceinline__ void hist_scan(const LAS unsigned* h, int K, int lane, int& bin, int& above, int& inbin, int* total = nullptr) {
    unsigned hv[NB4 * 4]; int s = 0;
#pragma unroll
    for (int g = 0; g < NB4; ++g) { const v4u t = *(const LAS v4u*)(h + NB4 * 4 * lane + 4 * g); hv[4 * g] = t.x; hv[4 * g + 1] = t.y; hv[4 * g + 2] = t.z; hv[4 * g + 3] = t.w; s += (int)(t.x + t.y + t.z + t.w); }
    int suf = s;
#pragma unroll
    for (int o = 1; o < 64; o <<= 1) { const int t = shfl_i_(suf, lane + o); if (lane + o < 64) suf += t; }
    if (total) *total = __builtin_amdgcn_readfirstlane(suf);
    const int excl = suf - s; const bool hit = (excl < K) && (K <= suf);
    int b = 0, c = excl, nb = 0; bool done = false;
#pragma unroll
    for (int k = NB4 * 4 - 1; k >= 0; --k) { if (!done) { if (c + (int)hv[k] >= K) { b = k; nb = (int)hv[k]; done = true; } else c += (int)hv[k]; } }
    const unsigned long long m = __ballot(hit); const int src = m ? (int)__builtin_ctzll(m) : 0;
    bin = __builtin_amdgcn_readlane(NB4 * 4 * lane + b, src); above = __builtin_amdgcn_readlane(c, src); inbin = __builtin_amdgcn_readlane(nb, src);
    if (!m) { bin = 0; above = 0; inbin = 0; }
}
#define DSA_ONE_TILE(KF, I, ...) do { const int i = (I); float sc[16]; { bf16x8 kfr[4]; dsa_kfrag(kfr, KF, ktile, F.lane); dsa_scores(qf, kfr, w, sc); } \
        if (i == j) { constexpr bool DIAG = true; __VA_ARGS__ } else { constexpr bool DIAG = false; __VA_ARGS__ } } while (0)
#define DSA_TILE_LOOP_S(STRIDE, ...) do { bf16x8 ka[4], kb[4]; int i0 = F.wave; \
    { const int ia = i0 <= j ? i0 : 0, ib = i0 + (STRIDE) <= j ? i0 + (STRIDE) : ia; dsa_ldk(ka, kbase + (size_t)ia * 32 * 64); dsa_ldk(kb, kbase + (size_t)ib * 32 * 64); } \
    _Pragma("unroll 1") for (; i0 <= j; i0 += 2 * (STRIDE)) { bf16x8 na[4], nb[4]; \
        { const int ia = i0 + 2 * (STRIDE) <= j ? i0 + 2 * (STRIDE) : i0, ib = i0 + 3 * (STRIDE) <= j ? i0 + 3 * (STRIDE) : i0; dsa_ldk(na, kbase + (size_t)ia * 32 * 64); dsa_ldk(nb, kbase + (size_t)ib * 32 * 64); } \
        __builtin_amdgcn_sched_barrier(0); \
        DSA_ONE_TILE(ka, i0, __VA_ARGS__); \
        if (i0 + (STRIDE) <= j) DSA_ONE_TILE(kb, i0 + (STRIDE), __VA_ARGS__); \
        _Pragma("unroll") for (int ks = 0; ks < 4; ++ks) { ka[ks] = na[ks]; kb[ks] = nb[ks]; } } } while (0)
#define DSA_TILE_LOOP(...) DSA_TILE_LOOP_S(NWAVES, __VA_ARGS__)
#define DSA_VALID(r) (!DIAG || ((r) & 3) + 8 * ((r) >> 2) <= qlim)
__device__ __forceinline__ void dsa_mask_unit(const Frame& F_, int b, int j, const bf16* P, const bf16* KIDX, const float* FW, unsigned long long* selw) { Frame F = F_; F.lane = lane_id_(); F.tid = F.wave * 64 + F.lane;
    LAS unsigned* HIST = (LAS unsigned*)(F.lds + RING_OFF + DS_HIST);
    LAS unsigned* GT = (LAS unsigned*)(F.lds + RING_OFF + DS_GT);
    LAS unsigned* EQ = (LAS unsigned*)(F.lds + RING_OFF + DS_EQ);
    LAS int* SM = (LAS int*)(F.lds + RING_OFF + DS_SM); volatile LAS unsigned* PRB = (volatile LAS unsigned*)(F.lds + LDSCTL_OFF + 512);
    PROBE_BEGIN(1);
    const int r32 = F.lane & 31, hi = F.lane >> 5, t0 = j * 32; const size_t brow = (size_t)b * SEQ;
    bf16x8 qf[4][4];
#pragma unroll
    for (int hh = 0; hh < 4; ++hh)
#pragma unroll
        for (int ks = 0; ks < 4; ++ks) qf[hh][ks] = *(const bf16x8*)(P + (brow + t0 + r32) * PS + C_IQ + hh * 64 + ks * 16 + hi * 8);
    float w[4]; { const f32x4 wv = *(const f32x4*)(FW + (brow + t0 + r32) * 8 + 4); w[0] = wv.x; w[1] = wv.y; w[2] = wv.z; w[3] = wv.w; }
    const bf16* kbase = KIDX + brow * 64 + F.lane * 8;
    LAS unsigned char* ktile = F.lds + RING_OFF + DS_KT + F.wave * 4096;
    const int qlim = r32 - 4 * hi;
    LAS unsigned* hrow = HIST + r32 * 512;
#define DSA_ZERO_HIST() do { const unsigned z_ = (unsigned)opaque_i(0); for (int e = F.tid; e < 4096; e += NWAVES * 64) ((LAS v4u*)HIST)[e] = (v4u){z_, z_, z_, z_}; } while (0)
    DSA_ZERO_HIST();
    if (F.tid < 64) SM[128 + F.tid] = 0;
    __syncthreads();
    PROBE_END(1); PROBE_BEGIN(2);
#if REP_PHASE == 41
    { float dummy = 0.f; DSA_TILE_LOOP({ _Pragma("unroll") for (int r = 0; r < 16; ++r) dummy += sc[r]; }); if (dummy == 12345.678f) SM[170] = 1; }
#endif
#if REP_PHASE == 42
    { LAS unsigned* drow = EQ + (r32 & 7) * 512; DSA_TILE_LOOP({ _Pragma("unroll") for (int r = 0; r < 16; ++r) { const int kh = key28_(sc[r]) >> 19; if (DSA_VALID(r)) __hip_atomic_fetch_add(drow + kh, 1u, __ATOMIC_RELAXED, __HIP_MEMORY_SCOPE_WORKGROUP); } }); }
#endif
#if REP_PHASE == 43
    { DSA_ZERO_HIST(); __syncthreads(); for (int q = F.wave * 4; q < F.wave * 4 + 4; ++q) { int bin, above, inbin; hist_scan<2>(HIST + q * 512, 256, F.lane, bin, above, inbin); if (F.lane == 0) SM[171] = bin; } __syncthreads(); __syncthreads(); __syncthreads(); }
#endif
    DSA_TILE_LOOP({ _Pragma("unroll")
        for (int r = 0; r < 16; ++r) { const int kh = key9_(sc[r]); if (DSA_VALID(r)) __hip_atomic_fetch_add(hrow + kh, 1u, __ATOMIC_RELAXED, __HIP_MEMORY_SCOPE_WORKGROUP); } });
    __syncthreads();
    PROBE_END(2); PROBE_BEGIN(3);
#pragma unroll 1
    for (int q = F.wave * 4; q < F.wave * 4 + 4; ++q) { int bin, above, inbin; hist_scan<2>(HIST + q * 512, 256, F.lane, bin, above, inbin);
        if (F.lane == 0) { const int total = t0 + q + 1;
            if (total <= 256) { SM[q] = -1; SM[32 + q] = 0; SM[64 + q] = 0; SM[96 + q] = 0; }
            else { SM[q] = bin; SM[32 + q] = above; SM[64 + q] = inbin; SM[96 + q] = 256 - above; if (inbin > DS_CAP) SM[160] = 1; } } }
    __syncthreads();
    PROBE_END(3); PROBE_BEGIN(4);
    const int myb1 = SM[r32];
    if (SM[160] == 0) {
        const float lge = key28_lbound((long long)myb1 << 19), lgt = key28_lbound(((long long)myb1 + 1) << 19);
        LAS unsigned* lrow = HIST + r32 * DS_CAP;
        DSA_TILE_LOOP({ unsigned gtw = 0u; unsigned cw = 0u; _Pragma("unroll")
            for (int r = 0; r < 16; ++r) { const int bit = (r & 3) + 8 * (r >> 2); const bool valid = DSA_VALID(r);
                if (valid && sc[r] >= lgt) gtw |= 1u << bit; else if (valid && sc[r] >= lge) cw |= 1u << r; }
            if (cw) {
                LAS float* sl = (LAS float*)ktile + F.lane; _Pragma("unroll")
                for (int r = 0; r < 16; ++r) sl[r * 64] = sc[r];
                int slot = (int)__hip_atomic_fetch_add((LAS unsigned*)SM + 128 + r32, (unsigned)__popc(cw), __ATOMIC_RELAXED, __HIP_MEMORY_SCOPE_WORKGROUP);
                while (cw) { const int r = __builtin_ctz(cw); cw &= cw - 1u; const float sv = sl[r * 64]; const int bit = (r & 3) + 8 * (r >> 2);
                    if (slot < DS_CAP) lrow[slot] = ((unsigned)(key28_(sv) & 0x7FFFF) << 12) | (unsigned)(4095 - (i * 32 + bit + 4 * hi)); ++slot; } }
            gtw <<= 4 * hi; gtw |= (unsigned)shfl_i_((int)gtw, F.lane ^ 32);
            if (hi == 0) GT[i * 32 + r32] = gtw; });
        __syncthreads();
        PROBE_END(4); PROBE_BEGIN(5);
#pragma unroll 1
        for (int q = F.wave * 4; q < F.wave * 4 + 4; ++q) { const int n = SM[128 + q] < DS_CAP ? SM[128 + q] : DS_CAP, quota = SM[96 + q]; const LAS unsigned* lq = HIST + q * DS_CAP;
            for (int c0 = 0; c0 < n; c0 += 64) { const int ci = c0 + F.lane; const unsigned e = ci < n ? lq[ci] : 0xffffffffu; int rank = 0;
                int k = 0;
                for (; k + 16 <= n; k += 16) { const v4u c0 = *(const LAS v4u*)(lq + k), c1 = *(const LAS v4u*)(lq + k + 4), c2 = *(const LAS v4u*)(lq + k + 8), c3 = *(const LAS v4u*)(lq + k + 12);
                    rank += (c0.x > e ? 1 : 0) + (c0.y > e ? 1 : 0) + (c0.z > e ? 1 : 0) + (c0.w > e ? 1 : 0) + (c1.x > e ? 1 : 0) + (c1.y > e ? 1 : 0) + (c1.z > e ? 1 : 0) + (c1.w > e ? 1 : 0)
                          + (c2.x > e ? 1 : 0) + (c2.y > e ? 1 : 0) + (c2.z > e ? 1 : 0) + (c2.w > e ? 1 : 0) + (c3.x > e ? 1 : 0) + (c3.y > e ? 1 : 0) + (c3.z > e ? 1 : 0) + (c3.w > e ? 1 : 0); }
                for (; k < n; ++k) rank += (lq[k] > e) ? 1 : 0;
                if (ci < n && rank < quota) { const int idx = 4095 - (int)(e & 4095u); __hip_atomic_fetch_or(GT + (idx >> 5) * 32 + q, 1u << (idx & 31), __ATOMIC_RELAXED, __HIP_MEMORY_SCOPE_WORKGROUP); } } }
        __syncthreads();
    } else {
        DSA_ZERO_HIST();
        __syncthreads();
        DSA_TILE_LOOP({ _Pragma("unroll")
            for (int r = 0; r < 16; ++r) { const int k = key28_(sc[r]); if ((k >> 19) == myb1 && DSA_VALID(r)) __hip_atomic_fetch_add(hrow + ((k >> 11) & 255), 1u, __ATOMIC_RELAXED, __HIP_MEMORY_SCOPE_WORKGROUP); } });
        __syncthreads();
#pragma unroll 1
        for (int q = F.wave * 4; q < F.wave * 4 + 4; ++q) { int bin, above, inbin; const int b1 = SM[q], ab1 = SM[32 + q]; hist_scan<1>(HIST + q * 512, 256 - ab1, F.lane, bin, above, inbin);
            if (F.lane == 0) { if (b1 < 0) { SM[192 + q] = -1; SM[96 + q] = 0; SM[224 + q] = 0; }
                else { const int quota = 256 - (ab1 + above); SM[192 + q] = (b1 << 8) | bin; SM[96 + q] = quota; SM[224 + q] = inbin; if (quota < inbin) SM[161] = 1; } } }
        __syncthreads();
        const int thr = SM[192 + r32]; const bool allacc = SM[96 + r32] >= SM[224 + r32];
        const float lge = key28_lbound((long long)thr << 11), lgt = key28_lbound(((long long)thr + 1) << 11);
        DSA_TILE_LOOP({ unsigned gtw = 0u; unsigned gew = 0u; _Pragma("unroll")
            for (int r = 0; r < 16; ++r) { const int bit = (r & 3) + 8 * (r >> 2); const bool valid = DSA_VALID(r);
                if (valid && sc[r] >= lgt) gtw |= 1u << bit; if (valid && sc[r] >= lge) gew |= 1u << bit; }
            gtw <<= 4 * hi; gew <<= 4 * hi;
            gtw |= (unsigned)shfl_i_((int)gtw, F.lane ^ 32); gew |= (unsigned)shfl_i_((int)gew, F.lane ^ 32);
            unsigned eqw = gew & ~gtw;
            if (allacc) { gtw = gew; eqw = 0u; }
            if (hi == 0) GT[i * 32 + r32] = gtw; else EQ[i * 32 + r32] = eqw; });
        __syncthreads();
        if (SM[161] != 0 && F.tid < 32) { const int q = F.tid; const int quota = SM[96 + q]; if (quota < SM[224 + q]) { int run = 0;
                for (int i = 0; i <= j; ++i) { unsigned e = EQ[i * 32 + q]; if (e) { const int allowed = quota - run; if (allowed <= 0) e = 0u; else { int pc = __popc(e); while (pc > allowed) { e &= ~(0x80000000u >> __clz(e)); --pc; } }
                        run += __popc(e); GT[i * 32 + q] |= e; } } } }
        __syncthreads();
    }
    PROBE_END(5); PROBE_BEGIN(6);
    { const int ntile64 = 4 * (j / 8 + 1); unsigned long long* dst = selw + (size_t)b * 64 * SEQ + t0;
      for (int e = F.tid; e < ntile64 * 32; e += NWAVES * 64) { const int T = e >> 5, q = e & 31; const unsigned lo = (2 * T <= j) ? GT[(2 * T) * 32 + q] : 0u, up = (2 * T + 1 <= j) ? GT[(2 * T + 1) * 32 + q] : 0u;
          dst[(size_t)T * SEQ + q] = ((unsigned long long)up << 32) | lo; } }
    __syncthreads();
    PROBE_END(6);
}
#undef DSA_TILE_LOOP
#undef DSA_ZERO_HIST
#undef DSA_TILE_LOOP_S
#undef DSA_ONE_TILE
#undef DSA_VALID
__device__ __forceinline__ void ln1_router_phase(const Frame& F_, const Args& a, int l, bool dry = false) { Frame F = F_; F.lane = lane_id_(); F.tid = F.wave * 64 + F.lane;
    LAS float* RW = (LAS float*)(F.lds + RING_OFF);
    LAS int* LC = (LAS int*)(F.lds + RING_OFF + 81920);
    LAS int* LTOK = LC + 64;
    LAS int* LCLS = LTOK + 128; LAS int* LPOS = LCLS + 128; LAS float* LGA = (LAS float*)(LPOS + 128); LAS float* LGB = LGA + 128;
    volatile LAS unsigned* PRB = (volatile LAS unsigned*)(F.lds + LDSCTL_OFF + 512);
    PROBE_BEGIN(31);
    const float* rg = a.in[16] + (size_t)l * DM * 4; const float* re = a.in[18] + (size_t)l * DM * 16;
    for (int e = F.tid; e < DM * 4; e += NWAVES * 64) { const int k = e >> 2, c = e & 3, ln = (k & 255) >> 2, kidx = (k >> 8) * 4 + (k & 3); RW[((kidx * 5 + 0) * 64 + ln) * 4 + c] = rg[e]; }
    for (int e = F.tid; e < DM * 16; e += NWAVES * 64) { const int k = e >> 4, c = 4 + (e & 15), ln = (k & 255) >> 2, kidx = (k >> 8) * 4 + (k & 3); RW[((kidx * 5 + (c >> 2)) * 64 + ln) * 4 + (c & 3)] = re[e]; }
    if (F.tid < 64) LC[F.tid] = 0;
    __syncthreads();
    PROBE_END(31); PROBE_BEGIN(32);
    const float* rgb = a.in[17] + l * 4; const float* reb = a.in[19] + l * 16;
    const float* g1 = a.in[14] + (size_t)l * DM; const float* b1 = a.in[15] + (size_t)l * DM;
    int* list = (int*)(F.ws + WS_LIST); float* gwl = (float*)(F.ws + WS_GWL);
    const int rows_per_blk = NTOK / F.G;
    LnGB gb; ln_gb_load(F, g1, b1, gb);
    float rb[20];
#pragma unroll
    for (int c = 0; c < 4; ++c) rb[c] = rgb[c];
#pragma unroll
    for (int c = 0; c < 16; ++c) rb[4 + c] = reb[c];
    const bf16* V1 = wsb(F, WS_R2);
    f32x4 nx[4]; ln_load_bf(F, V1 + (size_t)(F.vcu * rows_per_blk + F.wave) * DM, nx);
    for (int rr = F.wave; rr < rows_per_blk; rr += NWAVES) { const int m = F.vcu * rows_per_blk + rr; f32x4 v[4];
#pragma unroll
        for (int j = 0; j < 4; ++j) v[j] = nx[j];
        if (rr + NWAVES < rows_per_blk) ln_load_bf(F, V1 + (size_t)(m + NWAVES) * DM, nx);
        ln_row(F, gb, nullptr, wsb(F, WS_HB) + (size_t)m * DM, v, dry, F.ws + WS_HB8 + (size_t)m * DM);
        float gl[4] = {0.f, 0.f, 0.f, 0.f};
#pragma unroll
        for (int jj = 0; jj < 4; ++jj)
#pragma unroll
            for (int k = 0; k < 4; ++k) { const f32x4 wv = *(const LAS f32x4*)(RW + (((jj * 4 + k) * 5) * 64 + F.lane) * 4); const float xv = v[jj][k];
                gl[0] += xv * wv.x; gl[1] += xv * wv.y; gl[2] += xv * wv.z; gl[3] += xv * wv.w; }
        int gi = 0; float gm;
#pragma unroll
        for (int c = 0; c < 4; ++c) gl[c] = wave_sum(gl[c]) + rb[c];
        gm = gl[0];
#pragma unroll
        for (int c = 1; c < 4; ++c) if (gl[c] > gm) { gm = gl[c]; gi = c; }
        float gs = 0.f;
#pragma unroll
        for (int c = 0; c < 4; ++c) gs += expf(gl[c] - gm);
        const float pg = 1.f / gs;
        float el[4] = {0.f, 0.f, 0.f, 0.f};
        { const LAS float* wg = RW + ((1 + gi) * 64 + F.lane) * 4;
#pragma unroll
          for (int jj = 0; jj < 4; ++jj)
#pragma unroll
            for (int k = 0; k < 4; ++k) { const f32x4 wv = *(const LAS f32x4*)(wg + ((jj * 4 + k) * 5) * 256); const float xv = v[jj][k];
                el[0] += xv * wv.x; el[1] += xv * wv.y; el[2] += xv * wv.z; el[3] += xv * wv.w; } }
#pragma unroll
        for (int c = 0; c < 4; ++c) { float bsel = rb[4 + c];
#pragma unroll
            for (int g = 1; g < 4; ++g) if (gi == g) bsel = rb[4 + 4 * g + c];
            el[c] = wave_sum(el[c]) + bsel; }
        int i1 = 0; float m1 = el[0];
#pragma unroll
        for (int c = 1; c < 4; ++c) if (el[c] > m1) { m1 = el[c]; i1 = c; }
        int i2 = -1; float m2 = -INFINITY;
#pragma unroll
        for (int c = 0; c < 4; ++c) if (c != i1 && el[c] > m2) { m2 = el[c]; i2 = c; }
        const float e2 = expf(m2 - m1); const float p1 = 1.f / (1.f + e2), p2 = e2 / (1.f + e2);
        const int ia = i1 < i2 ? i1 : i2, ib = i1 < i2 ? i2 : i1; const float ga = pg * (i1 < i2 ? p1 : p2), gb = pg * (i1 < i2 ? p2 : p1);
        const int pidx = ia == 0 ? ib - 1 : (ia == 1 ? ib + 1 : 5); const int cls = gi * 6 + pidx;
        if (F.lane == 0) { const int pos = __hip_atomic_fetch_add(&LC[cls], 1, __ATOMIC_RELAXED, __HIP_MEMORY_SCOPE_WORKGROUP); LTOK[rr] = m; LCLS[rr] = cls; LPOS[rr] = pos; LGA[rr] = ga; LGB[rr] = gb; }
    }
    __syncthreads();
    PROBE_END(32);
    if (dry) return;
    PROBE_BEGIN(33);
    if (F.tid < NCLS) { const int n = LC[F.tid]; LC[32 + F.tid] = n ? (int)atomicAdd((unsigned*)(F.ctl + CW_CNT + (l * NCLS + F.tid) * 64), (unsigned)n) : 0; }
    __syncthreads();
    for (int rr = F.tid; rr < rows_per_blk; rr += NWAVES * 64) { const int cls = LCLS[rr], pos = LC[32 + cls] + LPOS[rr];
        list[(size_t)cls * NTOK + pos] = LTOK[rr]; gwl[((size_t)cls * NTOK + pos) * 2] = LGA[rr]; gwl[((size_t)cls * NTOK + pos) * 2 + 1] = LGB[rr]; }
    __syncthreads();
    PROBE_END(33);
}
__device__ __forceinline__ void ln2_phase(const Frame& F_, const Args& a, int l, bool dry = false) { Frame F = F_; F.lane = lane_id_(); F.tid = F.wave * 64 + F.lane;
    const float* g2 = a.in[23] + (size_t)l * DM; const float* b2 = a.in[24] + (size_t)l * DM; const bf16* V2 = wsb(F, WS_R1); const bool last = (l == DEPTH - 1);
    const int gw = F.vcu * NWAVES + F.wave, NGW = F.G * NWAVES;
    LnGB gb; ln_gb_load(F, g2, b2, gb);
    f32x4 nx[4]; ln_load_bf(F, V2 + (size_t)gw * DM, nx);
    for (int m = gw; m < NTOK; m += NGW) { f32x4 v[4];
#pragma unroll
        for (int j = 0; j < 4; ++j) v[j] = nx[j];
        if (m + NGW < NTOK) ln_load_bf(F, V2 + (size_t)(m + NGW) * DM, nx);
        ln_row(F, gb, last ? F.out + (size_t)m * DM : nullptr, wsb(F, WS_HB) + (size_t)m * DM, v, dry, last ? nullptr : F.ws + WS_HB8 + (size_t)m * DM); }
}
__device__ __forceinline__ void moe_table(const Frame& F, int l, LAS int* tab) {
    const int tid = F.wave * 64 + lane_id_();
    if (tid < NCLS) tab[tid] = (int)__hip_atomic_load(F.ctl + CW_CNT + (l * NCLS + tid) * 64, RLX_AGENT);
    __syncthreads();
    if (tid == 0) { int s = 0; for (int c = 0; c < NCLS; ++c) { tab[32 + c] = s; s += (tab[c] + 255) >> 8; } tab[32 + NCLS] = s; tab[57] = s; }
    __syncthreads();
}
#define NREP(k) (((REP_PHASE) == (k) || ((k) == 4 && ((REP_PHASE) == 60 || (REP_PHASE) == 61))) ? 2 : 1)
#define DRY(k) ((REP_PHASE) == (k) && rep_ == 0 && args.ph_hi != 7777)
#ifndef MK_PER_PHASE
#define MK_PER_PHASE 0
#endif
constexpr int PH_PER_LAYER = 9, N_PHASES = 1 + DEPTH * PH_PER_LAYER;
__global__ void __launch_bounds__(NWAVES * 64, 2) fwd_kernel(Args args) {
    extern __shared__ __attribute__((aligned(16))) unsigned char lds[];
    Frame F0; Frame& F = F0;
    F.lds = (LAS unsigned char*)lds; F.ldsg = lds;
    F.MISC = (volatile LAS unsigned*)(F.lds + MISC_OFF);
    F.wave = __builtin_amdgcn_readfirstlane((int)threadIdx.x >> 6); F.lane = lane_id_(); F.tid = F.wave * 64 + F.lane;
    F.G = gridDim.x; { const int bx = blockIdx.x; F.vcu = (F.G % 8 == 0) ? (bx % 8) * (F.G / 8) + bx / 8 : bx; }
    F.ws = args.ws; F.out = args.out; F.ctl = (gu32*)(args.ws + WS_CTL);
    for (int u = F0.tid; u < (LDS_BYTES - LDSCTL_OFF) / 4; u += NWAVES * 64) ((LAS unsigned*)(F.lds + LDSCTL_OFF))[u] = 0u;
    __syncthreads();
    XcdBarrier bar; bar.bar = (unsigned*)(F.ctl + CW_BAR); bar.x = 0; bar.st = nullptr;
    if (!MK_PER_PHASE) bar = xcd_barrier_post((unsigned*)(F.ctl + CW_BAR), F.MISC + 8);
    const int lo = MK_PER_PHASE ? args.ph_lo : 0, hi = MK_PER_PHASE ? args.ph_hi : N_PHASES;
#define IN(k) (lo <= (k) && (k) < hi)
#ifndef PH_ONLY
#define PH_ONLY -1
#endif
#define EN(k) (PH_ONLY < 0 || PH_ONLY == (k))
#define SEAM(k) do { if (IN(k) && IN((k) + 1)) { PROBE_BEGIN(20); xcd_barrier(bar, F0.wave); PROBE_END(20); } } while (0)
    volatile LAS unsigned* PRB = (volatile LAS unsigned*)(F0.lds + LDSCTL_OFF + 512);
    LAS int* TAB = (LAS int*)(F.lds + LDSCTL_OFF + 64);
    bf16* const HB = wsb(F, WS_HB); bf16* const P = wsb(F, WS_R1); bf16* const MIX = wsb(F, WS_R1); bf16* const BR = wsb(F, WS_R2); bf16* const ACT = wsb(F, WS_R2);
    float* const FW = (float*)(F.ws + WS_FW); float* const BIAS2 = (float*)(F.ws + WS_BIAS2); unsigned long long* const SELW = (unsigned long long*)(F.ws + WS_SELW);

#define FRESH(Fn) Frame Fn = F0; Fn.vcu = opaque_s(F0.vcu); Fn.wave = opaque_s(F0.wave); Fn.lane = lane_id_(); Fn.tid = Fn.wave * 64 + Fn.lane
    for (int rep_ = 0; rep_ < ((REP_PHASE) == 10 ? 2 : 1); ++rep_) if (EN(0) && IN(0)) { FRESH(Fp); p0_prologue(Fp, args); }
    SEAM(0);
#pragma unroll 1
    for (int l0 = 0; l0 < DEPTH; ++l0) {
        const int pb = 1 + PH_PER_LAYER * l0;
#define l opaque_s(l0)
#define W (wsb(F, WS_W + (size_t)l * W_LAYER))
        for (int rep_ = 0; rep_ < NREP(1); ++rep_) if (EN(1) && IN(pb)) { SchedA S; S.T.init(NTOK / 256, PS / 256, F.G, opaque_s((int)blockIdx.x)); S.A = (const char*)HB; S.B = (const char*)(W + W_SM / 2);
            EpiA E{P, FW, wsb(F, WS_KIDX)}; pg8::gemm_phase<EpiA, SchedA, false>(F.lds + RING_OFF, (LAS unsigned*)(F.lds + LDSCTL_OFF + 1024), F0.wave, S, E); }
        SEAM(pb);
        for (int rep_ = 0; rep_ < NREP(2); ++rep_) if (EN(2) && IN(pb + 1)) { FRESH(Fp);
#ifndef NO_CUMSUM
            if (Fp.vcu < 32 && Fp.wave == 0) fox_cumsum(Fp, Fp.vcu, FW, args.in[4] + l * 4, BIAS2);
#endif
#ifndef NO_POOL
            for (int rp_ = 0; rp_ < ((REP_PHASE) == 21 ? 2 : 1); ++rp_) for (int k = 0; k < 2; ++k) pool_unit(Fp, Fp.vcu * 2 + k, P, args.in[6] + (size_t)l * 4 * 64 * 64, args.in[7] + (size_t)l * 256, BR);
#endif
#ifndef NO_CONV
            for (int rp_ = 0; rp_ < ((REP_PHASE) == 22 ? 2 : 1); ++rp_) for (int k = 0; k < 4; ++k) conv_unit(Fp, Fp.vcu * 4 + k, P, args.in[8] + (size_t)l * 31 * 256, args.in[9] + (size_t)l * 256, args.in[10] + (size_t)l * 256, args.in[11] + (size_t)l * 256, BR);
#endif
#ifndef NO_DSA
            { const int b = Fp.vcu >> 5, s = Fp.vcu & 31;
#pragma unroll 1
              for (int k = 0; k < ((REP_PHASE) == 23 ? 8 : 4); ++k) { const int j = (k & 3) == 0 ? 127 - s : ((k & 3) == 1 ? 64 + s : ((k & 3) == 2 ? 63 - s : s)); dsa_mask_unit(Fp, b, j, P, wsb(F, WS_KIDX), FW, SELW); } }
#endif
        }
        SEAM(pb + 1);
        for (int rep_ = 0; rep_ < NREP(3); ++rep_) if (EN(3) && IN(pb + 2)) { const int vc_ = opaque_s(F0.vcu); const int sg = vc_ >> 3, s = vc_ & 7, b = sg >> 2, h = sg & 3; const size_t rb = (size_t)b * SEQ;
            const attn_body::bf16* Pb = (const attn_body::bf16*)P + rb * PS; attn_body::bf16* Ob = (attn_body::bf16*)BR + rb * DM;
#pragma unroll 1
            for (int k = 0; k < ((REP_PHASE) == 31 ? 4 : 2); ++k) { const int qb = (k & 1) == 0 ? 15 - s : s;
                attn_body::attn_unit<24, false>(qb * 256, Pb + C_FQ + h * 64, Pb + C_FK + h * 64, Pb + C_FV + h * 64, Ob + 256 + h * 64, BIAS2 + (size_t)(b * 4 + h) * SEQ, 0.f, nullptr, (char*)lds + RING_OFF, F0.wave); }
            const float slope2 = exp2f(-2.f * (float)(h + 1)) * LOG2E;
#pragma unroll 1
            for (int k = 0; k < ((REP_PHASE) == 32 ? 4 : 2); ++k) { const int qb = (k & 1) == 0 ? 15 - s : s;
                attn_body::attn_unit<24, true>(qb * 256, Pb + C_DQ + h * 64, Pb + C_DK, Pb + C_DV, Ob + 512 + h * 64, nullptr, slope2, SELW + (size_t)b * 64 * SEQ, (char*)lds + RING_OFF, F0.wave); }
        }
        SEAM(pb + 2);
        for (int rep_ = 0; rep_ < NREP(4); ++rep_) if (EN(4) && IN(pb + 3)) { SchedC S; S.T.init(NTOK / 256, DM / 128, F.G, opaque_s((int)blockIdx.x)); S.HBp = (const char*)(F.ws + WS_HB8); S.BRp = (const char*)BR; S.WGp = (const char*)(W + W_GT / 2); S.WBp = (const char*)(W + W_BR / 2); S.collapse = ((REP_PHASE) == 61 && rep_ == 0 && args.ph_hi != 7777);
            EpiC E; E.dry = (((REP_PHASE) == 60 || (REP_PHASE) == 61) && rep_ == 0 && args.ph_hi != 7777); E.MIX = MIX; E.bgate = args.in[5] + (size_t)l * 4 * DM; pg8::gemm_phase_c8<EpiC, SchedC>(F.lds + RING_OFF, F0.wave, S, E); }
        SEAM(pb + 3);
        for (int rep_ = 0; rep_ < NREP(5); ++rep_) if (EN(5) && IN(pb + 4)) { SchedC2 S; S.T.init(NTOK / 256, DM / 256, F.G, opaque_s((int)blockIdx.x)); S.A = (const char*)MIX; S.B = (const char*)(W + W_OUT / 2);
            EpiRes E{BR  , HB, DRY(5)}; pg8::gemm_phase<EpiRes, SchedC2, false>(F.lds + RING_OFF, (LAS unsigned*)(F.lds + LDSCTL_OFF + 1024), F0.wave, S, E); }
        SEAM(pb + 4);
        for (int rep_ = 0; rep_ < NREP(6); ++rep_) if (EN(6) && IN(pb + 5)) { FRESH(Fp); PROBE_BEGIN(21); ln1_router_phase(Fp, args, l, DRY(6)); PROBE_END(21); }
        SEAM(pb + 5);
        for (int rep_ = 0; rep_ < NREP(7); ++rep_) if (EN(7) && IN(pb + 6)) { moe_table(F, l, TAB);
            SchedD1 S{TAB, F.G, opaque_s((int)blockIdx.x), (const char*)(F.ws + WS_HB8), (const char*)(W + W_GU / 2), (const int*)(F.ws + WS_LIST)};
            EpiD1 E{(unsigned char*)ACT, (const float*)(F.ws + WS_GWL)}; pg8::gemm_phase<EpiD1, SchedD1, true>(F.lds + RING_OFF, (LAS unsigned*)(F.lds + LDSCTL_OFF + 1024), F0.wave, S, E); }
        SEAM(pb + 6);
        for (int rep_ = 0; rep_ < NREP(8); ++rep_) if (EN(8) && IN(pb + 7)) { moe_table(F, l, TAB);
            SchedD2 S{TAB, F.G, opaque_s((int)blockIdx.x), (const char*)ACT, (const char*)(W + W_D / 2), (const int*)(F.ws + WS_LIST)};
            EpiD2 E{wsb(F, WS_R1), HB, DRY(8)}; pg8::gemm_phase<EpiD2, SchedD2, false>(F.lds + RING_OFF, (LAS unsigned*)(F.lds + LDSCTL_OFF + 1024), F0.wave, S, E); }
        SEAM(pb + 7);
        for (int rep_ = 0; rep_ < NREP(9); ++rep_) if (EN(9) && IN(pb + 8)) { FRESH(Fp); PROBE_BEGIN(22); ln2_phase(Fp, args, l, DRY(9)); PROBE_END(22); }
        SEAM(pb + 8);
#undef l
#undef W
    }
#undef IN
#undef SEAM
    if ((REP_PHASE) >= 100 && blockIdx.x == 0 && F0.wave == 0 && lane_id_() == 0) { volatile LAS unsigned* PRB = (volatile LAS unsigned*)(F0.lds + LDSCTL_OFF + 512); const unsigned long long a_ = (((unsigned long long)PRB[1]) << 32) | PRB[0];
        const unsigned long long t0_ = __builtin_amdgcn_s_memrealtime(); while (__builtin_amdgcn_s_memrealtime() - t0_ < a_) __builtin_amdgcn_s_sleep(8); }
}

extern "C" void kernel_launch(void* const* d_in, const int* in_sizes, int n_in, void* d_out, int out_size, void* d_ws, size_t ws_size, hipStream_t stream) {
    static int grid = 0;
    if (grid == 0) {
        if (n_in != 25 || in_sizes[0] != NTOK * DM || out_size != NTOK * DM || ws_size < WS_END) { fprintf(stderr, "kernel_launch: unexpected shapes (n_in %d, in0 %d, out %d, ws %zu); nothing launched\n", n_in, n_in > 0 ? in_sizes[0] : -1, out_size, ws_size); grid = -1; return; }
        int dev = 0, cus = 0, per_cu = 0;
        if (hipGetDevice(&dev) != hipSuccess || hipDeviceGetAttribute(&cus, hipDeviceAttributeMultiprocessorCount, dev) != hipSuccess) { grid = -1; return; }
        if (hipFuncSetAttribute((const void*)fwd_kernel, hipFuncAttributeMaxDynamicSharedMemorySize, LDS_BYTES) != hipSuccess) { fprintf(stderr, "kernel_launch: hipFuncSetAttribute failed\n"); grid = -1; return; }
        if (hipOccupancyMaxActiveBlocksPerMultiprocessor(&per_cu, (const void*)fwd_kernel, NWAVES * 64, LDS_BYTES) != hipSuccess || per_cu < 1) fprintf(stderr, "kernel_launch: occupancy query reports %d\n", per_cu);
        (void)hipGetLastError();
        grid = cus;
        if (grid != 256) { fprintf(stderr, "kernel_launch: built for 256 CUs, device has %d; nothing launched\n", cus); grid = -1; return; }
    }
    if (grid < 0) return;
    if (hipMemsetAsync((char*)d_ws + WS_CTL, 0, CTL_ZERO_BYTES, stream) != hipSuccess) return;
    Args a{};
    for (int i = 0; i < 25; ++i) a.in[i] = (const float*)d_in[i];
    a.out = (float*)d_out; a.ws = (unsigned char*)d_ws;
#if MK_PER_PHASE
    for (int p = 0; p < N_PHASES; ++p) { a.ph_lo = p; a.ph_hi = p + 1; hipLaunchKernelGGL(fwd_kernel, dim3(grid), dim3(NWAVES * 64), LDS_BYTES, stream, a); }
#else
    a.ph_lo = 0; a.ph_hi = N_PHASES;
    hipLaunchKernelGGL(fwd_kernel, dim3(grid), dim3(NWAVES * 64), LDS_BYTES, stream, a);
#endif
}
```

```cpp
#include <hip/hip_runtime.h>
#include <hip/hip_bf16.h>
#include <cstdio>
#include <cstdint>
#include <cmath>

#ifndef REP_PHASE
#define REP_PHASE 0
#endif
#define PROBE_BEGIN(id) do { if ((REP_PHASE) == 100 + (id) && blockIdx.x == 0) { __syncthreads(); if (F.wave == 0 && lane_id_() == 0) { const unsigned long long t_ = __builtin_amdgcn_s_memrealtime(); PRB[2] = (unsigned)t_; PRB[3] = (unsigned)(t_ >> 32); } } } while (0)
#define PROBE_END(id) do { if ((REP_PHASE) == 100 + (id) && blockIdx.x == 0) { __syncthreads(); if (F.wave == 0 && lane_id_() == 0) { const unsigned long long t_ = __builtin_amdgcn_s_memrealtime() - (((unsigned long long)PRB[3] << 32) | PRB[2]); const unsigned long long a_ = ((((unsigned long long)PRB[1]) << 32) | PRB[0]) + t_; PRB[0] = (unsigned)a_; PRB[1] = (unsigned)(a_ >> 32); } } } while (0)
constexpr int BATCH = 8, SEQ = 4096, DM = 1024, NTOK = BATCH * SEQ, DEPTH = 2;
constexpr int P_TOTAL = 6344, PS = 2304;
constexpr int C_POOL = 0, C_FQ = 256, C_FK = 512, C_FV = 768, C_DQ = 1024, C_IQ = 1280, C_CONV = 1536, C_DK = 2048, C_DV = 2112, C_IK = 2176, C_FF = 2240, C_IW = 2244;
constexpr float LN_EPS = 1e-5f;
constexpr float ALPHA = 1.4142135623730951f;
constexpr float LOG2E = 1.4426950408889634f;
constexpr int NWAVES = 8;
constexpr int NCLS = 24;
constexpr int MAXTILES = NTOK / 256 + NCLS;

constexpr size_t MiB = 1u << 20;
constexpr size_t WS_CTL = 0, CTL_ZERO_BYTES = 1 * MiB;
constexpr size_t WS_FW = 1 * MiB;
constexpr size_t WS_BIAS2 = 2 * MiB;
constexpr size_t WS_LIST = 3 * MiB;
constexpr size_t WS_GWL = 6 * MiB;
constexpr size_t WS_SELW = 12 * MiB;
constexpr size_t WS_HB8 = 28 * MiB;
constexpr size_t WS_W = 60 * MiB;
constexpr size_t W_SM = 0, W_GT = 4718592, W_BR = W_GT + 8 * MiB, W_OUT = W_BR + 2 * MiB, W_GU = W_OUT + 2 * MiB, W_D = W_GU + 32 * MiB, W_LAYER = W_D + 16 * MiB;
constexpr size_t WS_HB = 190 * MiB;
constexpr size_t WS_R1 = 254 * MiB;
constexpr size_t WS_R2 = 398 * MiB;
constexpr size_t WS_KIDX = 474 * MiB;
constexpr size_t WS_END = 478 * MiB;
static_assert(WS_W + 2 * W_LAYER <= WS_HB && WS_R1 + (size_t)NTOK * PS * 2 <= WS_R2 && WS_R2 + (size_t)MAXTILES * 256 * DM * 2 <= WS_END, "d_ws map");
constexpr int CW_BAR = 4096;
constexpr int CW_SEAMC = 8192;
constexpr int CW_CNT = 16384;

constexpr int RING_OFF = 0, RING_BYTES = 131072;
constexpr int LDSCTL_OFF = RING_BYTES, MISC_OFF = LDSCTL_OFF + 320;
constexpr int LDS_BYTES = 147456;

#define GAS __attribute__((address_space(1)))
#define LAS __attribute__((address_space(3)))
typedef unsigned short bf16;
typedef unsigned v4u __attribute__((ext_vector_type(4)));
typedef unsigned v2u __attribute__((ext_vector_type(2)));
typedef float f32x4 __attribute__((ext_vector_type(4)));
typedef float f32x16 __attribute__((ext_vector_type(16)));
typedef short bf16x8 __attribute__((ext_vector_type(8)));
typedef GAS unsigned gu32;
#define RLX_AGENT __ATOMIC_RELAXED, __HIP_MEMORY_SCOPE_AGENT
#define LDS_WAIT() asm volatile("s_waitcnt lgkmcnt(0)" ::: "memory")
#define VM_WAIT() asm volatile("s_waitcnt vmcnt(0)" ::: "memory")
__device__ __forceinline__ int opaque_i(int x) { asm volatile("" : "+v"(x)); return x; }
__device__ __forceinline__ int lane_id_() { int x; asm volatile("v_mbcnt_lo_u32_b32 %0, -1, 0\n\tv_mbcnt_hi_u32_b32 %0, -1, %0" : "=v"(x)); return x; }
__device__ __forceinline__ float zero_() { int z = 0; asm volatile("" : "+v"(z)); return __builtin_bit_cast(float, z); }
__device__ __forceinline__ const char* sptr_(const char* p) { const unsigned long long v = (unsigned long long)p; const unsigned lo = (unsigned)__builtin_amdgcn_readfirstlane((int)(unsigned)v), hi = (unsigned)__builtin_amdgcn_readfirstlane((int)(unsigned)(v >> 32)); return (const char*)(((unsigned long long)hi << 32) | lo); }
__device__ __forceinline__ int shfl_i_(int v, int srclane) { return __builtin_amdgcn_ds_bpermute(srclane << 2, v); }
__device__ __forceinline__ int opaque_s(int x) { asm volatile("" : "+s"(x)); return x; }
__device__ __forceinline__ unsigned f2bf(float f) { unsigned u = __builtin_bit_cast(unsigned, f); return (u + 0x7fffu + ((u >> 16) & 1u)) >> 16; }
__device__ __forceinline__ unsigned pk2(float lo, float hi) { return f2bf(lo) | (f2bf(hi) << 16); }
__device__ __forceinline__ unsigned pk4_fp8(float a, float b, float c, float d) { int r = __builtin_amdgcn_cvt_pk_fp8_f32(a, b, 0, false); r = __builtin_amdgcn_cvt_pk_fp8_f32(c, d, r, true); return (unsigned)r; }
__device__ __forceinline__ float bfl(unsigned w) { return __uint_as_float(w << 16); }
__device__ __forceinline__ float bfh(unsigned w) { return __uint_as_float(w & 0xffff0000u); }
__device__ __forceinline__ float bf1(bf16 h) { return __uint_as_float((unsigned)h << 16); }
__device__ __forceinline__ float sigmoidf_(float x) { return __builtin_amdgcn_rcpf(1.f + __builtin_amdgcn_exp2f(-x * LOG2E)); }

#define XB_TMO      128
#define XB_XCNT(j)  (256  + 64 * (j))
#define XB_XSUB(j)  (1280 + 64 * (j))
#define XB_XGEN(j)  (2304 + 64 * (j))
#define XB_TOP      3328
#define XB_TOPGEN   3392
#define XCD_BAR_WORDS 3456
#define XB_SPIN_CAP (1u << 18)
__device__ __forceinline__ unsigned xb_ld(unsigned* p)              { return __hip_atomic_load(p, __ATOMIC_RELAXED, __HIP_MEMORY_SCOPE_AGENT); }
__device__ __forceinline__ unsigned xb_add(unsigned* p, unsigned v) { return __hip_atomic_fetch_add(p, v, __ATOMIC_RELAXED, __HIP_MEMORY_SCOPE_AGENT); }
__device__ __forceinline__ unsigned xb_xcc_id() { return (unsigned)__builtin_amdgcn_s_getreg((3 << 11) | 20) & 0xFu; }
#define XB_SPIN(cond, bar) do { unsigned _sp = 0; while (cond) { __builtin_amdgcn_s_sleep(1); \
    if ((++_sp & 255u) == 0u) { if (xb_ld(&(bar)[XB_TMO])) break; if (_sp > XB_SPIN_CAP) { atomicAdd(&(bar)[XB_TMO], 1u); break; } } } } while (0)
struct XcdBarrier { unsigned* bar; unsigned x; volatile LAS unsigned* st; };
__device__ __forceinline__ XcdBarrier xcd_barrier_post(unsigned* bar, volatile LAS unsigned* st) {
    XcdBarrier b; b.bar = bar; b.x = xb_xcc_id(); b.st = st;
    if (threadIdx.x == 0) (void)xb_add(&bar[XB_XCNT(b.x)], 1u);
    return b;
}
__device__ __forceinline__ void xcd_barrier_complete(unsigned* bar, unsigned x, unsigned& nloc, unsigned& nx) {
    const unsigned G = gridDim.x * gridDim.y * gridDim.z;
    unsigned sum, cnt, mine, sp = 0u;
    for (;;) {
        sum = 0u; cnt = 0u; mine = 0u;
#pragma unroll
        for (unsigned j = 0; j < 16; ++j) { const unsigned c = xb_ld(&bar[XB_XCNT(j)]); sum += c; cnt += (c > 0u) ? 1u : 0u; mine = (j == x) ? c : mine; }
        if (sum == G) break;
        __builtin_amdgcn_s_sleep(1);
        if ((++sp & 255u) == 0u) { if (xb_ld(&bar[XB_TMO])) break; if (sp > XB_SPIN_CAP) { atomicAdd(&bar[XB_TMO], 1u); break; } }
    }
    nloc = mine > 0u ? mine : 1u; nx = cnt > 0u ? cnt : 1u;
}
__device__ __forceinline__ void xcd_barrier(const XcdBarrier& b, int wave) {
    asm volatile("s_waitcnt vmcnt(0)" ::: "memory");
    __syncthreads();
    if (wave == 0 && lane_id_() == 0) {
        unsigned* bar = b.bar; const unsigned bx = (unsigned)opaque_s((int)xb_xcc_id());
        __builtin_amdgcn_s_waitcnt(0);
        unsigned nloc = b.st[0], nx = b.st[1];
        if (nloc == 0u) { xcd_barrier_complete(bar, bx, nloc, nx); b.st[0] = nloc; b.st[1] = nx; }
        const unsigned old = xb_add(&bar[XB_XSUB(bx)], 1u);
        const unsigned gen = old / nloc;
        if (old + 1u == (gen + 1u) * nloc) {
            __builtin_amdgcn_fence(__ATOMIC_RELEASE, "agent");
            asm volatile("s_waitcnt vmcnt(0)" ::: "memory");
            const unsigned og = xb_add(&bar[XB_TOP], 1u);
            const unsigned tg = og / nx;
            if (og + 1u == (tg + 1u) * nx) xb_add(&bar[XB_TOPGEN], 1u);
            else XB_SPIN(xb_ld(&bar[XB_TOPGEN]) == tg, bar);
            __builtin_amdgcn_fence(__ATOMIC_ACQUIRE, "agent");
            xb_add(&bar[XB_XGEN(bx)], 1u);
            asm volatile("s_waitcnt vmcnt(0)" ::: "memory");
        } else {
            XB_SPIN(xb_ld(&bar[XB_XGEN(bx)]) == gen, bar);
            __builtin_amdgcn_fence(__ATOMIC_ACQUIRE, "agent");
            asm volatile("s_waitcnt vmcnt(0)" ::: "memory");
        }
    }
    __syncthreads();
}
namespace pg8 {
#define PG8_LAS __attribute__((address_space(3)))
typedef unsigned short bf16_t;
typedef short bf16x8 __attribute__((ext_vector_type(8)));
typedef float f32x4 __attribute__((ext_vector_type(4)));
typedef float f32x2 __attribute__((ext_vector_type(2)));
typedef unsigned u32x4 __attribute__((ext_vector_type(4)));
typedef unsigned u32x2 __attribute__((ext_vector_type(2)));
constexpr int BM = 256, BK = 64, HALF = 128, HTB = HALF * BK * 2  , STAGE_BYTES = 8 * HTB, NXCD = 8, WGM = 8;
constexpr int LD = 1024;
constexpr size_t ROWB = 2048;
constexpr size_t HSTEP = (size_t)HALF * ROWB;
constexpr size_t TSTEP = 2 * HSTEP;

__host__ __device__ __forceinline__ int lds_byte(int r, int c) { const int st = (r >> 4) * 2 + (c >> 5), rr = r & 15, cc = c & 31, ob = rr * 64 + cc * 2; return st * 1024 + (ob ^ (((ob >> 9) & 1) << 5)); }
__host__ __device__ __forceinline__ void stage_rc(int b, int& R, int& C) { const int st = b / 1024, sb = b % 1024, swz = sb ^ (((sb >> 9) & 1) << 5); R = (st >> 1) * 16 + swz / 64; C = (st & 1) * 32 + (swz % 64) / 2; }
__host__ __device__ __forceinline__ int perm32(int rho) { const int n = rho >> 4, i = rho & 15; return 8 * (i >> 2) + 4 * n + (i & 3); }

struct GU {
    const char* A;
    const char* B0;
    const char* B1;
    int nt, ks;
    const int* rows;
    int rbase, rcnt;
    int pm, pn, a0, a1;
};

__device__ __forceinline__ unsigned cvt_pk_bf16(float lo, float hi) { unsigned r; asm volatile("v_cvt_pk_bf16_f32 %0, %1, %2" : "=v"(r) : "v"(lo), "v"(hi)); return r; }
__device__ __forceinline__ float bf_lo(unsigned w) { return __uint_as_float(w << 16); }
__device__ __forceinline__ float bf_hi(unsigned w) { return __uint_as_float(w & 0xffff0000u); }

__device__ __forceinline__ void glds16_s(const char* sbase, unsigned voff, unsigned lds_dst) { unsigned keep;
    asm volatile("s_mov_b32 %0, m0\n\ts_mov_b32 m0, %3\n\ts_nop 0\n\tglobal_load_lds_dwordx4 %1, %2\n\ts_mov_b32 m0, %0" : "=&s"(keep) : "v"(voff), "s"(sbase), "s"(lds_dst) : "memory"); }
typedef int v8i_t __attribute__((ext_vector_type(8)));
typedef int v4i_t __attribute__((ext_vector_type(4)));
__device__ __forceinline__ v8i_t cat8(bf16x8 lo, bf16x8 hi) { const v4i_t a = __builtin_bit_cast(v4i_t, lo), b = __builtin_bit_cast(v4i_t, hi); return __builtin_shufflevector(a, b, 0, 1, 2, 3, 4, 5, 6, 7); }
template <class Epi, class Sched, bool GATHER>
__device__ __forceinline__ void gemm_phase(PG8_LAS unsigned char* lds, PG8_LAS unsigned* xlds  , const int wid_in  , const Sched& S, Epi& E) {
    const int wid = opaque_s(wid_in), lane = lane_id_(), tid = wid * 64 + lane, wr = wid >> 2, wc = wid & 3, fr = lane & 15, fq = lane >> 4;
    constexpr bool F8 = Epi::F8;
    constexpr int RP = F8 ? 1024 : 2048;
    constexpr size_t HS = (size_t)HALF * RP;
    unsigned voffB[2], vA[2][2];
#pragma unroll
    for (int i = 0; i < 2; ++i) { int R, C; stage_rc(tid * 16 + i * 8192, R, C); const int Rb = Epi::PERM ? ((R & ~31) + perm32(R & 31)) : R;
        voffB[i] = (unsigned)(Rb * RP + C * 2);
        vA[0][i] = (unsigned)(R * RP + C * 2); vA[1][i] = vA[0][i]; }
    const size_t kstep = (size_t)(BK * 2);
    const unsigned ldsw = (unsigned)wid * 1024u;
    const unsigned ldsb = (unsigned)__builtin_amdgcn_readfirstlane((int)((unsigned)(size_t)lds + (unsigned)wid * 1024u));
    const int aoff8 = lds_byte(wr * 64 + fr, 16 * fq), boff8 = lds_byte(wc * 32 + fr, 16 * fq);
    const int aoff = lds_byte(wr * 64 + fr, fq * 8), boff = lds_byte(wc * 32 + fr, fq * 8);
#define PG8_SA(b, h) (((b) * 2 + (h)) * HTB)
#define PG8_SB(b, h) ((4 + (b) * 2 + (h)) * HTB)
#define PG8_STAGE(bufoff, gbase, voff) do { _Pragma("unroll") for (int _i = 0; _i < 2; ++_i) { \
        if constexpr (F8) glds16_s((const char*)(gbase), (voff)[_i], ldsb + (unsigned)((bufoff) + _i * 8192)); \
        else __builtin_amdgcn_global_load_lds((const unsigned*)((const char*)(gbase) + (voff)[_i]), (PG8_LAS unsigned*)(lds + (bufoff) + ldsw + _i * 8192), 16, 0, 0); } } while (0)
#define PG8_STAGEA(bufoff, gbase, h) do { if constexpr (GATHER) { PG8_STAGE(bufoff, gbase, vA[h]); } else { PG8_STAGE(bufoff, (gbase) + (h) * HS, vA[0]); } } while (0)
#define PG8_LDA(dst, b, h) do { _Pragma("unroll") for (int m = 0; m < 4; ++m) _Pragma("unroll") for (int k = 0; k < 2; ++k) dst[m][k] = *(const PG8_LAS bf16x8*)(lds + PG8_SA(b, h) + (F8 ? aoff8 + k * 16 : aoff + k * 1024) + m * 2048); } while (0)
#define PG8_LDB(dst, b, h) do { _Pragma("unroll") for (int n = 0; n < 2; ++n) _Pragma("unroll") for (int k = 0; k < 2; ++k) dst[n][k] = *(const PG8_LAS bf16x8*)(lds + PG8_SB(b, h) + (F8 ? boff8 + k * 16 : boff + k * 1024) + n * 2048); } while (0)
#define PG8_MMA(ai, bj, At, Bt) do { __builtin_amdgcn_s_setprio(1); _Pragma("unroll") for (int m = 0; m < 4; ++m) _Pragma("unroll") for (int n = 0; n < 2; ++n) { \
        if constexpr (F8) acc[ai][bj][m][n] = __builtin_amdgcn_mfma_scale_f32_16x16x128_f8f6f4(cat8(Bt[n][0], Bt[n][1]), cat8(At[m][0], At[m][1]), acc[ai][bj][m][n], 0, 0, 0, 0, 0, 0); \
        else { _Pragma("unroll") for (int k = 0; k < 2; ++k) acc[ai][bj][m][n] = __builtin_amdgcn_mfma_f32_16x16x32_bf16(Bt[n][k], At[m][k], acc[ai][bj][m][n], 0, 0, 0); } } __builtin_amdgcn_s_setprio(0); } while (0)
#define PG8_WAIT_V(n) asm volatile("s_waitcnt vmcnt(" #n ")" ::: "memory")
#define PG8_WAIT_L(n) asm volatile("s_waitcnt lgkmcnt(" #n ")" ::: "memory")
#define PG8_BAR __builtin_amdgcn_s_barrier()
#define PG8_SCHED __builtin_amdgcn_sched_barrier(0)
#define PG8_KS(u) (Sched::NT > 0 ? Sched::KS : (u).ks)
#define PG8_BP(u, tau) ((tau) < PG8_KS(u) ? (u).B0 + (size_t)(tau) * kstep : (u).B1 + (size_t)((tau) - PG8_KS(u)) * kstep)
#define PG8_GATHER_OFFS(dst, u) do { if constexpr (GATHER) { _Pragma("unroll") for (int _h = 0; _h < 2; ++_h) _Pragma("unroll") for (int _i = 0; _i < 2; ++_i) { \
        int _R, _C; stage_rc((wid * 64 + lane_id_()) * 16 + _i * 8192, _R, _C); int _p = (u).rbase + _h * HALF + _R; _p = _p < (u).rcnt ? _p : (u).rcnt - 1; dst[_h][_i] = (unsigned)(u).rows[_p] * (unsigned)RP + (unsigned)_C * 2u; } } } while (0)
    GU cur, nxt; int ui = 0;
    if (!S.next(0, cur)) return;
    f32x4 acc[2][2][4][2];
#pragma unroll
    for (int a = 0; a < 2; ++a)
#pragma unroll
        for (int b = 0; b < 2; ++b)
#pragma unroll
            for (int m = 0; m < 4; ++m)
#pragma unroll
                for (int n = 0; n < 2; ++n) { const float z_ = zero_(); acc[a][b][m][n] = (f32x4){z_, z_, z_, z_}; }
    bf16x8 At[4][2], B0[2][2], B1[2][2];
    PG8_GATHER_OFFS(vA, cur);
    const char* cA = cur.A;
    { const char* b0 = PG8_BP(cur, 0); const char* b1 = PG8_BP(cur, 1);
      PG8_STAGE(PG8_SB(0, 0), b0, voffB); PG8_STAGE(PG8_SB(0, 1), b0 + HS, voffB); PG8_STAGEA(PG8_SA(0, 0), cA, 0); PG8_STAGEA(PG8_SA(0, 1), cA, 1);
      if (wr == 1) PG8_BAR;
      PG8_WAIT_V(2); PG8_BAR;
      PG8_STAGE(PG8_SB(1, 0), b1, voffB); PG8_STAGEA(PG8_SA(1, 0), cA + kstep, 0); PG8_STAGE(PG8_SB(1, 1), b1 + HS, voffB);
      PG8_WAIT_V(6); PG8_BAR; }
    for (;;) {
        const bool has_next = S.next(ui + 1, nxt);
        if (!has_next) nxt = cur;
        if constexpr (GATHER) { unsigned vn[2][2];
#pragma unroll
            for (int h = 0; h < 2; ++h)
#pragma unroll
                for (int i = 0; i < 2; ++i) vn[h][i] = vA[h][i];
            if (has_next) { PG8_GATHER_OFFS(vn, nxt); }
#pragma unroll
            for (int h = 0; h < 2; ++h)
#pragma unroll
                for (int i = 0; i < 2; ++i) xlds[(h * 2 + i) * 512 + tid] = vn[h][i]; }
        const char* nA = nxt.A;
        const int nt = Sched::NT > 0 ? Sched::NT : cur.nt;
#pragma unroll (Sched::NT > 0 ? 2 : 1)
        for (int t = 0; t < nt; t += 2) {
            const bool last = (t == nt - 2);
            const char* a1 = cA + (size_t)(t + 1) * kstep;
            const char* a2 = last ? nA : cA + (size_t)(t + 2) * kstep;
            const char* b2 = last ? PG8_BP(nxt, 0) : PG8_BP(cur, t + 2);
            const char* a3 = a2 + kstep; const char* b3 = b2 + kstep;
            PG8_LDB(B0, 0, 0); PG8_LDB(B1, 0, 1); PG8_SCHED; PG8_LDA(At, 0, 0); PG8_STAGEA(PG8_SA(1, 1), a1, 1);
            if constexpr (GATHER) { if (last) {
#pragma unroll
                for (int h = 0; h < 2; ++h)
#pragma unroll
                    for (int i = 0; i < 2; ++i) vA[h][i] = xlds[(h * 2 + i) * 512 + tid]; } }
            PG8_WAIT_V(8); PG8_WAIT_L(0); PG8_BAR; PG8_MMA(0, 0, At, B0); PG8_MMA(0, 1, At, B1); PG8_BAR; PG8_SCHED;
            PG8_LDA(At, 0, 1); PG8_STAGE(PG8_SB(0, 0), b2, voffB); PG8_STAGE(PG8_SB(0, 1), b2 + HS, voffB); PG8_STAGEA(PG8_SA(0, 0), a2, 0);
            PG8_WAIT_V(8); PG8_WAIT_L(0); PG8_BAR; PG8_MMA(1, 0, At, B0); PG8_MMA(1, 1, At, B1); PG8_BAR; PG8_SCHED;
            PG8_LDB(B0, 1, 0); PG8_LDB(B1, 1, 1); PG8_SCHED; PG8_LDA(At, 1, 0); PG8_STAGEA(PG8_SA(0, 1), a2, 1);
            PG8_WAIT_V(8); PG8_WAIT_L(0); PG8_BAR; PG8_MMA(0, 0, At, B0); PG8_MMA(0, 1, At, B1); PG8_BAR; PG8_SCHED;
            PG8_LDA(At, 1, 1); PG8_STAGE(PG8_SB(1, 0), b3, voffB); PG8_STAGE(PG8_SB(1, 1), b3 + HS, voffB); PG8_STAGEA(PG8_SA(1, 0), a3, 0);
            PG8_WAIT_V(8); PG8_WAIT_L(0); PG8_BAR; PG8_MMA(1, 0, At, B0); PG8_MMA(1, 1, At, B1); PG8_BAR; PG8_SCHED;
        }
        if (wr == 0) PG8_BAR;
        { const int l2_ = lane_id_(); E(acc, cur, wr, wc, l2_ & 15, l2_ >> 4); }
        if (!has_next) break;
#pragma unroll
        for (int a = 0; a < 2; ++a)
#pragma unroll
            for (int b = 0; b < 2; ++b)
#pragma unroll
                for (int m = 0; m < 4; ++m)
#pragma unroll
                    for (int n = 0; n < 2; ++n) { const float z_ = zero_(); acc[a][b][m][n] = (f32x4){z_, z_, z_, z_}; }
        cur = nxt; cA = nA; ++ui;
        if (wr == 1) PG8_BAR;
    }
    PG8_WAIT_V(0);
    PG8_BAR;
#undef PG8_SA
#undef PG8_SB
#undef PG8_STAGE
#undef PG8_STAGEA
#undef PG8_LDA
#undef PG8_LDB
#undef PG8_MMA
#undef PG8_WAIT_V
#undef PG8_WAIT_L
#undef PG8_BAR
#undef PG8_SCHED
#undef PG8_BP
#undef PG8_KS
#undef PG8_GATHER_OFFS
}

template <class Epi, class Sched>
__device__ __forceinline__ void gemm_phase_n128(PG8_LAS unsigned char* lds, const int wid_in, const Sched& S, Epi& E) {
    const int wid = opaque_s(wid_in), lane = lane_id_(), tid = wid * 64 + lane, wr = wid >> 2, wc = wid & 3, fr = lane & 15, fq = lane >> 4;
    unsigned voffB[2], voffA[2];
#pragma unroll
    for (int i = 0; i < 2; ++i) { int R, C; stage_rc(tid * 16 + i * 8192, R, C); const int Rb = (R & ~31) + perm32(R & 31);
        voffB[i] = (unsigned)(Rb * LD + C) * 2u; voffA[i] = (unsigned)(R * LD + C) * 2u; }
    const size_t kstep = (size_t)(BK * 2);
    const unsigned ldsw = (unsigned)wid * 1024u;
    const int aoff = lds_byte(wr * 64 + fr, fq * 8), boff = lds_byte(wc * 32 + fr, fq * 8);
#define PG8_SA(b, h) (((b) * 2 + (h)) * HTB)
#define PG8_SB(b, h) ((4 + (b) * 2 + (h)) * HTB)
#define PG8_STAGE(bufoff, gbase, voff) do { _Pragma("unroll") for (int _i = 0; _i < 2; ++_i) \
        __builtin_amdgcn_global_load_lds((const unsigned*)((const char*)(gbase) + (voff)[_i]), (PG8_LAS unsigned*)(lds + (bufoff) + ldsw + _i * 8192), 16, 0, 0); } while (0)
#define PG8_LDA(dst, b, h) do { _Pragma("unroll") for (int m = 0; m < 4; ++m) _Pragma("unroll") for (int k = 0; k < 2; ++k) dst[m][k] = *(const PG8_LAS bf16x8*)(lds + PG8_SA(b, h) + aoff + m * 2048 + k * 1024); } while (0)
#define PG8_LDB(dst, b, h) do { _Pragma("unroll") for (int n = 0; n < 2; ++n) _Pragma("unroll") for (int k = 0; k < 2; ++k) dst[n][k] = *(const PG8_LAS bf16x8*)(lds + PG8_SB(b, h) + boff + n * 2048 + k * 1024); } while (0)
#define PG8_MMA(ai, At, Bt) do { __builtin_amdgcn_s_setprio(1); _Pragma("unroll") for (int m = 0; m < 4; ++m) _Pragma("unroll") for (int n = 0; n < 2; ++n) _Pragma("unroll") for (int k = 0; k < 2; ++k) \
        acc[ai][m][n] = __builtin_amdgcn_mfma_f32_16x16x32_bf16(Bt[n][k], At[m][k], acc[ai][m][n], 0, 0, 0); __builtin_amdgcn_s_setprio(0); } while (0)
#define PG8_WAIT_V(n) asm volatile("s_waitcnt vmcnt(" #n ")" ::: "memory")
#define PG8_WAIT_L(n) asm volatile("s_waitcnt lgkmcnt(" #n ")" ::: "memory")
#define PG8_BAR __builtin_amdgcn_s_barrier()
#define PG8_SCHED __builtin_amdgcn_sched_barrier(0)
    GU cur, nxt; int ui = 0;
    if (!S.next(0, cur)) return;
    f32x4 acc[2][4][2];
#pragma unroll
    for (int a = 0; a < 2; ++a)
#pragma unroll
        for (int m = 0; m < 4; ++m)
#pragma unroll
            for (int n = 0; n < 2; ++n) { const float z_ = zero_(); acc[a][m][n] = (f32x4){z_, z_, z_, z_}; }
    bf16x8 At[4][2], B0[2][2];
    u32x4 st_u[2][4], st_s[2][4];
    const char* cA = cur.A; const char* cB = cur.B0;
    PG8_STAGE(PG8_SB(0, 0), cB, voffB); PG8_STAGE(PG8_SA(0, 0), cA, voffA); PG8_STAGE(PG8_SA(0, 1), cA + HSTEP, voffA);
    if (wr == 1) PG8_BAR;
    PG8_WAIT_V(2); PG8_BAR;
    PG8_STAGE(PG8_SB(1, 0), cB + kstep, voffB); PG8_STAGE(PG8_SA(1, 0), cA + kstep, voffA);
    PG8_WAIT_V(4); PG8_BAR;
    for (;;) {
        const bool has_next = S.next(ui + 1, nxt);
        if (!has_next) nxt = cur;
        const char* nA = nxt.A; const char* nB = nxt.B0;
        const int nt = cur.nt;
        for (int t = 0; t < nt; t += 2) {
            const bool last = (t == nt - 2);
            const char* a1 = cA + (size_t)(t + 1) * kstep;
            const char* a2 = last ? nA : cA + (size_t)(t + 2) * kstep;
            const char* b2 = last ? nB : cB + (size_t)(t + 2) * kstep;
            const char* a3 = a2 + kstep; const char* b3 = b2 + kstep;
            PG8_LDB(B0, 0, 0); PG8_SCHED; PG8_LDA(At, 0, 0); PG8_STAGE(PG8_SA(1, 1), a1 + HSTEP, voffA);
            PG8_WAIT_V(6); PG8_WAIT_L(0); PG8_BAR; PG8_MMA(0, At, B0); PG8_BAR; PG8_SCHED;
            PG8_LDA(At, 0, 1); PG8_STAGE(PG8_SB(0, 0), b2, voffB); PG8_STAGE(PG8_SA(0, 0), a2, voffA);
            PG8_WAIT_V(6); PG8_WAIT_L(0); PG8_BAR; PG8_MMA(1, At, B0); PG8_BAR; PG8_SCHED;
            PG8_LDB(B0, 1, 0); PG8_SCHED; PG8_LDA(At, 1, 0); PG8_STAGE(PG8_SA(0, 1), a2 + HSTEP, voffA);
            PG8_WAIT_V(6); PG8_WAIT_L(0); PG8_BAR; PG8_MMA(0, At, B0); PG8_BAR; PG8_SCHED;
            PG8_LDA(At, 1, 1); PG8_STAGE(PG8_SB(1, 0), b3, voffB); PG8_STAGE(PG8_SA(1, 0), a3, voffA);
            PG8_WAIT_V(6); PG8_WAIT_L(0); PG8_BAR; PG8_MMA(1, At, B0); PG8_BAR; PG8_SCHED;
        }
        if (wr == 0) PG8_BAR;
        E(acc, st_u, st_s, cur, wr, wc, fr, fq);
        if (!has_next) break;
#pragma unroll
        for (int a = 0; a < 2; ++a)
#pragma unroll
            for (int m = 0; m < 4; ++m)
#pragma unroll
                for (int n = 0; n < 2; ++n) { const float z_ = zero_(); acc[a][m][n] = (f32x4){z_, z_, z_, z_}; }
        cur = nxt; cA = nA; cB = nB; ++ui;
        if (wr == 1) PG8_BAR;
    }
    PG8_WAIT_V(0);
    PG8_BAR;
#undef PG8_SA
#undef PG8_SB
#undef PG8_STAGE
#undef PG8_LDA
#undef PG8_LDB
#undef PG8_MMA
#undef PG8_WAIT_V
#undef PG8_WAIT_L
#undef PG8_BAR
#undef PG8_SCHED
}
template <class Epi, class Sched>
__device__ __forceinline__ void gemm_phase_c8(PG8_LAS unsigned char* lds, const int wid_in, const Sched& S, Epi& E) {
    const int wid = opaque_s(wid_in), lane = lane_id_(), tid = wid * 64 + lane, wr = wid >> 2, wc = wid & 3, fr = lane & 15, fq = lane >> 4;
    unsigned voffB[2], voffA[2];
#pragma unroll
    for (int i = 0; i < 2; ++i) { int R, C; stage_rc(tid * 16 + i * 8192, R, C); const int Rb = (R & ~31) + perm32(R & 31);
        voffB[i] = (unsigned)(Rb * LD + C) * 2u; voffA[i] = (unsigned)(R * LD + C) * 2u; }
    const size_t kstep = (size_t)(BK * 2);
    const unsigned ldsb = (unsigned)__builtin_amdgcn_readfirstlane((int)((unsigned)(size_t)lds + (unsigned)wid * 1024u));
    const int aoff = lds_byte(wr * 64 + fr, fq * 8), boff = lds_byte(wc * 32 + fr, fq * 8);
    const int aoff8 = lds_byte(wr * 64 + fr, 16 * fq), boff8 = lds_byte(wc * 32 + fr, 16 * fq);
#define PG8_SA(b, h) (((b) * 2 + (h)) * HTB)
#define PG8_SB(b, h) ((4 + (b) * 2 + (h)) * HTB)
#define PG8_STAGE(bufoff, gbase, voff) do { _Pragma("unroll") for (int _i = 0; _i < 2; ++_i) glds16_s((const char*)(gbase), (voff)[_i], ldsb + (unsigned)((bufoff) + _i * 8192)); } while (0)
#define PG8_STAGE8(bufoff, gbase, voff) do { _Pragma("unroll") for (int _i = 0; _i < 2; ++_i) { const unsigned _v = ((voff)[_i] + ((voff)[_i] & 2047u)) >> 1; glds16_s((const char*)(gbase), _v, ldsb + (unsigned)((bufoff) + _i * 8192)); } } while (0)
#define PG8_STB(bufoff, gbase, f8) do { if (f8) { PG8_STAGE8(bufoff, gbase, voffB); } else { PG8_STAGE(bufoff, gbase, voffB); } } while (0)
#define PG8_STA(bufoff, gbase, h, f8) do { if (f8) { PG8_STAGE8(bufoff, (gbase) + (h) * (HSTEP / 2), voffA); } else { PG8_STAGE(bufoff, (gbase) + (h) * HSTEP, voffA); } } while (0)
#define PG8_LDA(dst, b, h) do { _Pragma("unroll") for (int m = 0; m < 4; ++m) _Pragma("unroll") for (int k = 0; k < 2; ++k) dst[m][k] = *(const PG8_LAS bf16x8*)(lds + PG8_SA(b, h) + aoff + m * 2048 + k * 1024); } while (0)
#define PG8_LDB(dst, b, h) do { _Pragma("unroll") for (int n = 0; n < 2; ++n) _Pragma("unroll") for (int k = 0; k < 2; ++k) dst[n][k] = *(const PG8_LAS bf16x8*)(lds + PG8_SB(b, h) + boff + n * 2048 + k * 1024); } while (0)
#define PG8_LDA8(dst, b, h) do { _Pragma("unroll") for (int m = 0; m < 4; ++m) _Pragma("unroll") for (int k = 0; k < 2; ++k) dst[m][k] = *(const PG8_LAS bf16x8*)(lds + PG8_SA(b, h) + aoff8 + m * 2048 + k * 16); } while (0)
#define PG8_LDB8(dst, b, h) do { _Pragma("unroll") for (int n = 0; n < 2; ++n) _Pragma("unroll") for (int k = 0; k < 2; ++k) dst[n][k] = *(const PG8_LAS bf16x8*)(lds + PG8_SB(b, h) + boff8 + n * 2048 + k * 16); } while (0)
#define PG8_MMA(ai, At, Bt) do { __builtin_amdgcn_s_setprio(1); _Pragma("unroll") for (int m = 0; m < 4; ++m) _Pragma("unroll") for (int n = 0; n < 2; ++n) _Pragma("unroll") for (int k = 0; k < 2; ++k) \
        acc[ai][m][n] = __builtin_amdgcn_mfma_f32_16x16x32_bf16(Bt[n][k], At[m][k], acc[ai][m][n], 0, 0, 0); __builtin_amdgcn_s_setprio(0); } while (0)
#define PG8_MMA8(ai, At, Bt) do { __builtin_amdgcn_s_setprio(1); _Pragma("unroll") for (int m = 0; m < 4; ++m) _Pragma("unroll") for (int n = 0; n < 2; ++n) \
        acc[ai][m][n] = __builtin_amdgcn_mfma_scale_f32_16x16x128_f8f6f4(cat8(Bt[n][0], Bt[n][1]), cat8(At[m][0], At[m][1]), acc[ai][m][n], 0, 0, 0, 0, 0, 0); __builtin_amdgcn_s_setprio(0); } while (0)
#define PG8_WAIT_V(n) asm volatile("s_waitcnt vmcnt(" #n ")" ::: "memory")
#define PG8_WAIT_L(n) asm volatile("s_waitcnt lgkmcnt(" #n ")" ::: "memory")
#define PG8_BAR __builtin_amdgcn_s_barrier()
#define PG8_SCHED __builtin_amdgcn_sched_barrier(0)
    GU cu, cg, nxt; int ui = 0;
    if (!S.next(0, cu)) return;
    f32x4 acc[2][4][2];
#define PG8_ZACC() do { _Pragma("unroll") for (int a = 0; a < 2; ++a) _Pragma("unroll") for (int m = 0; m < 4; ++m) _Pragma("unroll") for (int n = 0; n < 2; ++n) { const float z_ = zero_(); acc[a][m][n] = (f32x4){z_, z_, z_, z_}; } } while (0)
    PG8_ZACC();
    bf16x8 At[4][2], B0[2][2];
    u32x4 st_u[2][4], st_s[2][4];
    PG8_STB(PG8_SB(0, 0), cu.B0, false); PG8_STA(PG8_SA(0, 0), cu.A, 0, false); PG8_STA(PG8_SA(0, 1), cu.A, 1, false);
    if (wr == 1) PG8_BAR;
    PG8_WAIT_V(2); PG8_BAR;
    PG8_STB(PG8_SB(1, 0), cu.B0 + kstep, false); PG8_STA(PG8_SA(1, 0), cu.A + kstep, 0, false);
    PG8_WAIT_V(4); PG8_BAR;
#define PG8_KLOOP(LDA_, LDB_, MMA_, C8, N8, cA, cB, nA, nB, nt) \
        for (int t = 0; t < (nt); t += 2) { \
            const bool last = (t == (nt) - 2); \
            const char* a1 = (cA) + (size_t)(t + 1) * kstep; \
            const char* a2 = last ? (nA) : (cA) + (size_t)(t + 2) * kstep; \
            const char* b2 = last ? (nB) : (cB) + (size_t)(t + 2) * kstep; \
            const char* a3 = a2 + kstep; const char* b3 = b2 + kstep; \
            LDB_(B0, 0, 0); PG8_SCHED; LDA_(At, 0, 0); PG8_STA(PG8_SA(1, 1), a1, 1, C8); \
            PG8_WAIT_V(6); PG8_WAIT_L(0); PG8_BAR; MMA_(0, At, B0); PG8_BAR; PG8_SCHED; \
            if (last) { LDA_(At, 0, 1); PG8_STB(PG8_SB(0, 0), b2, N8); PG8_STA(PG8_SA(0, 0), a2, 0, N8); } else { LDA_(At, 0, 1); PG8_STB(PG8_SB(0, 0), b2, C8); PG8_STA(PG8_SA(0, 0), a2, 0, C8); } \
            PG8_WAIT_V(6); PG8_WAIT_L(0); PG8_BAR; MMA_(1, At, B0); PG8_BAR; PG8_SCHED; \
            if (last) { LDB_(B0, 1, 0); PG8_SCHED; LDA_(At, 1, 0); PG8_STA(PG8_SA(0, 1), a2, 1, N8); } else { LDB_(B0, 1, 0); PG8_SCHED; LDA_(At, 1, 0); PG8_STA(PG8_SA(0, 1), a2, 1, C8); } \
            PG8_WAIT_V(6); PG8_WAIT_L(0); PG8_BAR; MMA_(0, At, B0); PG8_BAR; PG8_SCHED; \
            if (last) { LDA_(At, 1, 1); PG8_STB(PG8_SB(1, 0), b3, N8); PG8_STA(PG8_SA(1, 0), a3, 0, N8); } else { LDA_(At, 1, 1); PG8_STB(PG8_SB(1, 0), b3, C8); PG8_STA(PG8_SA(1, 0), a3, 0, C8); } \
            PG8_WAIT_V(6); PG8_WAIT_L(0); PG8_BAR; MMA_(1, At, B0); PG8_BAR; PG8_SCHED; \
        }
    for (;;) {
        S.next(ui + 1, cg);
        PG8_KLOOP(PG8_LDA, PG8_LDB, PG8_MMA, false, true, cu.A, cu.B0, cg.A, cg.B0, cu.nt)
        if (wr == 0) PG8_BAR;
        { const int l2_ = lane_id_(); E(acc, st_u, st_s, cu, wr, wc, l2_ & 15, l2_ >> 4); }
        PG8_ZACC();
        if (wr == 1) PG8_BAR;
        const bool has_next = S.next(ui + 2, nxt);
        if (!has_next) { nxt.A = S.BRp; nxt.B0 = S.WBp; }
        PG8_KLOOP(PG8_LDA8, PG8_LDB8, PG8_MMA8, true, false, cg.A, cg.B0, nxt.A, nxt.B0, cg.nt)
        if (wr == 0) PG8_BAR;
        { const int l2_ = lane_id_(); E(acc, st_u, st_s, cg, wr, wc, l2_ & 15, l2_ >> 4); }
        if (!has_next) break;
        PG8_ZACC();
        cu = nxt; ui += 2;
        if (wr == 1) PG8_BAR;
    }
#undef PG8_KLOOP
#undef PG8_ZACC
    PG8_WAIT_V(0);
    PG8_BAR;
#undef PG8_SA
#undef PG8_SB
#undef PG8_STAGE
#undef PG8_STAGE8
#undef PG8_STB
#undef PG8_STA
#undef PG8_LDA
#undef PG8_LDB
#undef PG8_LDA8
#undef PG8_LDB8
#undef PG8_MMA
#undef PG8_MMA8
#undef PG8_WAIT_V
#undef PG8_WAIT_L
#undef PG8_BAR
#undef PG8_SCHED
}
}
namespace attn_body {
using bf16=__hip_bfloat16;
using bf16x8=__attribute__((ext_vector_type(8)))short;
using s16x4=__attribute__((ext_vector_type(4)))short;
using f32x16=__attribute__((ext_vector_type(16)))float;
using f32x4=__attribute__((ext_vector_type(4)))float;
using u32x4=__attribute__((ext_vector_type(4)))unsigned;
constexpr int SEQ=4096,D=64;
constexpr int KVP=2304;
constexpr int OP=1024;
constexpr int NW=8,QBLK=32,QB=QBLK*NW,KVBLK=64,NQB=SEQ/QB;
__device__ __forceinline__ int crow(int r,int hi){return (r&3)+8*(r>>2)+4*hi;}
#define SBAR() __builtin_amdgcn_sched_barrier(0)
__device__ __forceinline__ void cmask(f32x16&p0,f32x16&p1,int jb,int qrel,int hi){
  const float NEG=-INFINITY; int kb=64*jb+4*hi;
  #pragma unroll
  for(int r=0;r<16;++r){int kv=kb+(r&3)+8*(r>>2); if(kv>qrel)p0[r]=NEG; if(kv+32>qrel)p1[r]=NEG;}
}
__device__ __forceinline__ void bmask(f32x16&p0,f32x16&p1,unsigned long long w,int hi){
  const float NEG=-INFINITY; const unsigned lo=((unsigned)w)>>(4*hi), up=((unsigned)(w>>32))>>(4*hi);
  #pragma unroll
  for(int r=0;r<16;++r){const int bit=(r&3)+8*(r>>2); if(!((lo>>bit)&1u))p0[r]=NEG; if(!((up>>bit)&1u))p1[r]=NEG;}
}
constexpr int NSLOT=3, SLOTB=8192;
constexpr int LDS_K=0, LDS_V=NSLOT*SLOTB, LDS_WS=2*NSLOT*SLOTB, LDS_OST=LDS_WS+NW*64*4, LDS_BIAS=LDS_OST+NW*4096, LDS_BYTES=LDS_BIAS+SEQ*4;
constexpr float C2=0.125f*1.4426950408889634f;
__device__ __forceinline__ void glds16(const void*gsrc,unsigned lds_dst){unsigned keep;
  asm volatile("s_mov_b32 %0, m0\n\ts_mov_b32 m0, %2\n\ts_nop 0\n\tglobal_load_lds_dwordx4 %1, off\n\ts_mov_b32 m0, %0":"=&s"(keep):"v"(gsrc),"s"(lds_dst):"memory");}
__device__ __forceinline__ float max3f(float a,float b,float c){float r;asm("v_max3_f32 %0, %1, %2, %3":"=v"(r):"v"(a),"v"(b),"v"(c));return r;}
__device__ __forceinline__ float max2f(float a,float b){float r;asm("v_max_f32_e32 %0, %1, %2":"=v"(r):"v"(a),"v"(b));return r;}
__device__ __forceinline__ float fadd_s(float a,float b){float r;asm("v_add_f32_e32 %0, %1, %2":"=v"(r):"v"(a),"v"(b));return r;}
__device__ __forceinline__ float fsub_s(float a,float b){float r;asm("v_sub_f32_e32 %0, %1, %2":"=v"(r):"v"(a),"v"(b));return r;}
typedef float f32x2_t __attribute__((ext_vector_type(2))); typedef __bf16 bf16x2_t __attribute__((ext_vector_type(2)));
__device__ __forceinline__ unsigned cvtpk_s(float lo,float hi){f32x2_t v={lo,hi};bf16x2_t b=__builtin_convertvector(v,bf16x2_t);return __builtin_bit_cast(unsigned,b);}
#define WAIT_BAR(N) asm volatile("s_waitcnt vmcnt(" #N ") lgkmcnt(0)\n\ts_barrier":::"memory")

typedef __attribute__((address_space(3))) const char* lds_cptr;
typedef short v4i16_t __attribute__((ext_vector_type(4)));
__device__ __forceinline__ void binit(f32x16&p0,f32x16&p1,lds_cptr bp,float mhat){
  typedef float f2_ __attribute__((ext_vector_type(2))); const f2_ m2={mhat,mhat};
  #pragma unroll
  for(int g=0;g<4;++g){ const f32x4 a=*(const __attribute__((address_space(3))) f32x4*)(bp+g*32); const f32x4 b=*(const __attribute__((address_space(3))) f32x4*)(bp+128+g*32);
    const f2_ a0=(f2_){a[0],a[1]}-m2,a1=(f2_){a[2],a[3]}-m2,b0=(f2_){b[0],b[1]}-m2,b1=(f2_){b[2],b[3]}-m2;
    p0[4*g]=a0.x;p0[4*g+1]=a0.y;p0[4*g+2]=a1.x;p0[4*g+3]=a1.y; p1[4*g]=b0.x;p1[4*g+1]=b0.y;p1[4*g+2]=b1.x;p1[4*g+3]=b1.y; }
}
__device__ __forceinline__ void qkt(f32x16&p0,f32x16&p1,const char*Kslot,const bf16x8*qr,int r32,int hi){
  const char*kb=Kslot+hi*1024+r32*16;
  #pragma unroll
  for(int d0=0;d0<4;++d0){
    const bf16x8 b0=*reinterpret_cast<const bf16x8*>(kb+d0*2048);
    const bf16x8 b1=*reinterpret_cast<const bf16x8*>(kb+d0*2048+512);
    p0=__builtin_amdgcn_mfma_f32_32x32x16_bf16(b0,qr[d0],p0,0,0,0);p1=__builtin_amdgcn_mfma_f32_32x32x16_bf16(b1,qr[d0],p1,0,0,0);}
}
__device__ __forceinline__ void kload8(bf16x8*kf,lds_cptr kp){
  kf[0]=*(const __attribute__((address_space(3))) bf16x8*)(kp);      kf[1]=*(const __attribute__((address_space(3))) bf16x8*)(kp+512);
  kf[2]=*(const __attribute__((address_space(3))) bf16x8*)(kp+2048); kf[3]=*(const __attribute__((address_space(3))) bf16x8*)(kp+2560);
  kf[4]=*(const __attribute__((address_space(3))) bf16x8*)(kp+4096); kf[5]=*(const __attribute__((address_space(3))) bf16x8*)(kp+4608);
  kf[6]=*(const __attribute__((address_space(3))) bf16x8*)(kp+6144); kf[7]=*(const __attribute__((address_space(3))) bf16x8*)(kp+6656);
}
__device__ __forceinline__ void kload2(bf16x8*kf,lds_cptr kp,int j){ kf[2*j]=*(const __attribute__((address_space(3))) bf16x8*)(kp+j*2048); kf[2*j+1]=*(const __attribute__((address_space(3))) bf16x8*)(kp+j*2048+512); }
__device__ __forceinline__ s16x4 vtr(lds_cptr p){ return __builtin_bit_cast(s16x4,__builtin_amdgcn_ds_read_tr16_b64_v4i16((__attribute__((address_space(3))) v4i16_t*)p)); }
__device__ __forceinline__ float rowmax(const f32x16&p0,const f32x16&p1){
  float a=max3f(p0[0],p0[1],p1[0]),b=max3f(p0[2],p0[3],p1[1]);a=max3f(a,p1[2],p1[3]);
  #pragma unroll
  for(int r=4;r<16;r+=4){a=max3f(a,p0[r],p0[r+1]);b=max3f(b,p0[r+2],p0[r+3]);a=max3f(a,p1[r],p1[r+1]);b=max3f(b,p1[r+2],p1[r+3]);}
  const float m=max2f(a,b);
  auto rr=__builtin_amdgcn_permlane32_swap(__float_as_uint(m),__float_as_uint(m),false,false);
  return max2f(__uint_as_float(rr[0]),__uint_as_float(rr[1]));
}
__device__ __forceinline__ void pv(f32x16*o,int vb,bf16x8 pa0,bf16x8 pa1,bf16x8 pa2,bf16x8 pa3){
  #pragma unroll
  for(int d0=0;d0<2;++d0){s16x4 lo[4],hi[4];
    #pragma unroll
    for(int ks=0;ks<4;++ks){
      asm volatile("ds_read_b64_tr_b16 %0,%1 offset:%c2":"=&v"(lo[ks]):"v"(vb),"i"(d0*4096+ks*1024):"memory");
      asm volatile("ds_read_b64_tr_b16 %0,%1 offset:%c2":"=&v"(hi[ks]):"v"(vb),"i"(d0*4096+ks*1024+512):"memory");}
    asm volatile("s_waitcnt lgkmcnt(0)":::"memory");SBAR();
    #define PK(k) (bf16x8){lo[k][0],lo[k][1],lo[k][2],lo[k][3],hi[k][0],hi[k][1],hi[k][2],hi[k][3]}
    o[d0]=__builtin_amdgcn_mfma_f32_32x32x16_bf16(pa0,PK(0),o[d0],0,0,0);
    o[d0]=__builtin_amdgcn_mfma_f32_32x32x16_bf16(pa1,PK(1),o[d0],0,0,0);
    o[d0]=__builtin_amdgcn_mfma_f32_32x32x16_bf16(pa2,PK(2),o[d0],0,0,0);
    o[d0]=__builtin_amdgcn_mfma_f32_32x32x16_bf16(pa3,PK(3),o[d0],0,0,0);
    #undef PK
  }
}

template<int THRL,bool MASK> __device__ __forceinline__ void attn_unit(int q0,const bf16*Qs,const bf16*__restrict__ Ks,const bf16*__restrict__ Vs,bf16*Os,
                                                                       const float*biasg,float slope2,const unsigned long long*maskw,char*shm,const int wid_in){
  const int wid=opaque_s(wid_in),lane=lane_id_(),tid=wid*64+lane,r32=lane&31,hi=lane>>5;
  const bf16*Qw=Qs+(long)(q0+wid*QBLK)*KVP;
  const unsigned lds0=(unsigned)(uintptr_t)shm;
  float*wsf=(float*)(shm+LDS_WS)+wid*64;
  unsigned long long mwA=0ull,mwB=0ull;
  { float*bl=(float*)(shm+LDS_BIAS); const int nk=q0+QB;
    if(biasg){ for(int s=tid;s<nk;s+=NW*64)bl[s]=biasg[s]; } else { for(int s=tid;s<nk;s+=NW*64)bl[s]=slope2*(float)s; }
    if(MASK){ const unsigned long long*mp0=maskw+(q0+wid*QBLK+(lane&31)); mwA=mp0[0]; mwB=mp0[SEQ]; asm volatile("":"+v"(mwA),"+v"(mwB)); }
    asm volatile("s_waitcnt vmcnt(0) lgkmcnt(0)":::"memory"); }
  const bf16*ksrc=Ks+(long)lane*KVP+wid*8;
  const bf16*vsrc=Vs+(long)(16*(wid&3)+(lane>>2))*KVP+(wid>>2)*32+(lane&3)*8;
  const unsigned kdst=lds0+LDS_K+wid*1024, vdst=lds0+LDS_V+wid*1024;
  #define DMA_K(t,slot) glds16(ksrc+(long)(t)*KVBLK*KVP,(unsigned)__builtin_amdgcn_readfirstlane(kdst+(slot)))
  #define DMA_V(t,slot) glds16(vsrc+(long)(t)*KVBLK*KVP,(unsigned)__builtin_amdgcn_readfirstlane(vdst+(slot)))
  const int vb0=(int)(lds0+LDS_V)+((lane>>4)&1)*32+(lane&3)*8+(4*hi+((lane&15)>>2))*64;
  const char*Kbase=shm+LDS_K; bf16x8 kf[8];
  const lds_cptr shm3=(lds_cptr)shm; const lds_cptr kp0=shm3+LDS_K+hi*1024+r32*16; const lds_cptr vp0=shm3+LDS_V+((lane>>4)&1)*32+(lane&3)*8+(4*hi+((lane&15)>>2))*64;
  const lds_cptr bp0=shm3+LDS_BIAS+hi*16;
  const int NT=(q0+QB)/KVBLK;
  DMA_K(0,0);DMA_V(0,0);DMA_K(1,SLOTB);
  bf16x8 qr[4];
  #pragma unroll
  for(int d0=0;d0<4;++d0)qr[d0]=*reinterpret_cast<const bf16x8*>(&Qw[(long)r32*KVP+d0*16+hi*8]);
  const unsigned long long*mwp=MASK?maskw+(q0+wid*QBLK+r32):nullptr;
  #define MLOAD(MW,t) do{ if(MASK){ MW=mwp[(long)(t)*SEQ]; } }while(0)
  #define MPIN(MW) do{}while(0)
  float mhat=0.f,l_reg=0.f;f32x16 o[2];o[0]=f32x16{};o[1]=f32x16{};
  const int qrel=wid*QBLK+r32;
  #define CMASK(P0,P1,t,MW) do{ if(MASK){ bmask(P0,P1,MW,hi); } else { int jb_=(t)-(NT-4); if(jb_>=0)cmask(P0,P1,jb_,qrel,hi); } }while(0)
  bool resc=false;
  #define START(P0,P1) do{ const float rm=rowmax(P0,P1); resc=false; \
    { const float dl=__builtin_fmaxf(rm,-60000.f); mhat=fadd_s(mhat,dl); \
      _Pragma("unroll") for(int r=0;r<16;++r){P0[r]=fsub_s(P0[r],dl);P1[r]=fsub_s(P1[r],dl);} } \
    _Pragma("unroll") for(int r=0;r<16;++r)P0[r]=__builtin_amdgcn_exp2f(P0[r]); }while(0)
  #define RESC() do{ if(resc){ asm volatile("s_waitcnt lgkmcnt(0)":::"memory"); \
      _Pragma("unroll") for(int d_=0;d_<2;++d_) _Pragma("unroll") for(int r=0;r<16;++r)o[d_][r]*=wsf[crow(r,hi)]; } }while(0)
  f32x16 pA0,pA1,pB0,pB1;
  int sl_prev=0,sl_cur=0,sl_next=SLOTB;
  #define ROT() do{sl_prev=sl_cur;sl_cur=sl_next;sl_next=(sl_next==(NSLOT-1)*SLOTB)?0:sl_next+SLOTB;}while(0)
  DMA_K(2,2*SLOTB);
  WAIT_BAR(3);
  binit(pA0,pA1,bp0,0.f);
  qkt(pA0,pA1,Kbase,qr,r32,hi);asm volatile("s_nop 15\n\ts_nop 7":"+v"(pA0),"+v"(pA1));CMASK(pA0,pA1,0,mwA);
  START(pA0,pA1);
  _Pragma("unroll") for(int r=0;r<16;++r)pA1[r]=__builtin_amdgcn_exp2f(pA1[r]);
  WAIT_BAR(0);
  DMA_K(3,0);DMA_V(1,SLOTB);MLOAD(mwA,2);
  ROT();
  kload8(kf,kp0+sl_cur);
  if(MASK){WAIT_BAR(3);}else{WAIT_BAR(2);}
  s16x4 vlo[8],vhi[8]; u32x4 pw0,pw1,pw2,pw3;
  #define PKW(P,B) cvtpk_s(P[B],P[B+1])
  #define PAF(k) __builtin_bit_cast(bf16x8,pw##k)
  #define VFR(i) (bf16x8){vlo[i][0],vlo[i][1],vlo[i][2],vlo[i][3],vhi[i][0],vhi[i][1],vhi[i][2],vhi[i][3]}
  #define PIN(x) asm volatile("":"+v"(x))
  #define MX3(a,b,c) __builtin_fmaxf(__builtin_fmaxf((a),(b)),(c))
  #define GAPA(MF,A0,A1,A2,A3,W0,W1,PW) do{ MF; sacc+=A0; sacc+=A1; sacc+=A2; sacc+=A3; PIN(sacc); W0; W1; PIN(PW); SBAR(); }while(0)
  #define EX(v) __builtin_amdgcn_exp2f(v)
  #define GAPB(MF,X,B) do{ MF; X[B]=EX(X[B]); X[B+1]=EX(X[B+1]); X[B+2]=EX(X[B+2]); X[B+3]=EX(X[B+3]); PIN(X); SBAR(); }while(0)
  #define VRD(i) do{ vlo[i]=vtr(vp_+(((i)>>2)*4096+((i)&3)*1024)); vhi[i]=vtr(vp_+(((i)>>2)*4096+((i)&3)*1024+512)); }while(0)
  #define KRD(G,j) do{ if(G){ kload2(kf,kp0+sl_next,j); SBAR(); } }while(0)
  #define STEP(C0,C1,P0,P1,t,GK,GV,GL,MW,GM,DOCM) do{ SBAR(); \
    const lds_cptr vp_=vp0+sl_prev; \
    binit(C0,C1,bp0+(t)*256,mhat); SBAR(); \
    VRD(0); SBAR(); float sacc=(P0[0]+P0[1]); \
    GAPA(C0=__builtin_amdgcn_mfma_f32_32x32x16_bf16(kf[0],qr[0],C0,0,0,0), P0[2],P0[3],P0[4],P0[5],     pw0[0]=PKW(P0,0), pw0[1]=PKW(P0,2), pw0); \
    VRD(4); SBAR(); GAPA(C1=__builtin_amdgcn_mfma_f32_32x32x16_bf16(kf[1],qr[0],C1,0,0,0), P0[6],P0[7],P0[8],P0[9],     pw0[2]=PKW(P0,4), pw0[3]=PKW(P0,6), pw0); \
    VRD(1); SBAR(); GAPA(C0=__builtin_amdgcn_mfma_f32_32x32x16_bf16(kf[2],qr[1],C0,0,0,0),   P0[10],P0[11],P0[12],P0[13], pw1[0]=PKW(P0,8), pw1[1]=PKW(P0,10), pw1); \
    VRD(5); SBAR(); GAPA(C1=__builtin_amdgcn_mfma_f32_32x32x16_bf16(kf[3],qr[1],C1,0,0,0),   P0[14],P0[15],P1[0],P1[1],   pw1[2]=PKW(P0,12),pw1[3]=PKW(P0,14), pw1); \
    VRD(2); SBAR(); GAPA(C0=__builtin_amdgcn_mfma_f32_32x32x16_bf16(kf[4],qr[2],C0,0,0,0),   P1[2],P1[3],P1[4],P1[5],     pw2[0]=PKW(P1,0), pw2[1]=PKW(P1,2), pw2); \
    VRD(6); SBAR(); GAPA(C1=__builtin_amdgcn_mfma_f32_32x32x16_bf16(kf[5],qr[2],C1,0,0,0),   P1[6],P1[7],P1[8],P1[9],     pw2[2]=PKW(P1,4), pw2[3]=PKW(P1,6), pw2); \
    VRD(3); SBAR(); GAPA(C0=__builtin_amdgcn_mfma_f32_32x32x16_bf16(kf[6],qr[3],C0,0,0,0),   P1[10],P1[11],P1[12],P1[13], pw3[0]=PKW(P1,8), pw3[1]=PKW(P1,10), pw3); \
    VRD(7); SBAR(); GAPA(C1=__builtin_amdgcn_mfma_f32_32x32x16_bf16(kf[7],qr[3],C1,0,0,0),   P1[14],P1[15],0.f,0.f,       pw3[2]=PKW(P1,12),pw3[3]=PKW(P1,14), pw3); \
    l_reg+=sacc; \
    if(MASK&&(DOCM)){ CMASK(C0,C1,t,MW); } \
    if(GK){DMA_K((t)+3,sl_cur);} if(GV){DMA_V((t)+1,sl_next);} \
    if(!MASK&&(DOCM)){ CMASK(C0,C1,t,MW); } \
    if(GM){ MLOAD(MW,(t)+2); } \
    { float a=MX3(C0[0],C0[1],C1[0]),b=MX3(C0[2],C0[3],C1[1]); a=MX3(a,C1[2],C1[3]); \
      _Pragma("unroll") for(int r=4;r<16;r+=4){a=MX3(a,C0[r],C0[r+1]);b=MX3(b,C0[r+2],C0[r+3]);a=MX3(a,C1[r],C1[r+1]);b=MX3(b,C1[r+2],C1[r+3]);} \
      float rm=__builtin_fmaxf(a,b); { auto rr=__builtin_amdgcn_permlane32_swap(__float_as_uint(rm),__float_as_uint(rm),false,false); rm=__builtin_fmaxf(__uint_as_float(rr[0]),__uint_as_float(rr[1])); } \
      resc=false; \
      if(__builtin_expect(__any(rm>(float)THRL),0)){ const float dl=__builtin_fmaxf(rm,0.f); mhat+=dl; \
        _Pragma("unroll") for(int r=0;r<16;++r){C0[r]-=dl;C1[r]-=dl;} \
        const float f=__builtin_amdgcn_exp2f(-dl); l_reg*=f; if(hi==0)wsf[r32]=f; resc=true; } } \
    SBAR(); \
    GAPB(o[0]=__builtin_amdgcn_mfma_f32_32x32x16_bf16(PAF(0),VFR(0),o[0],0,0,0), C0,0); \
    GAPB(o[1]=__builtin_amdgcn_mfma_f32_32x32x16_bf16(PAF(0),VFR(4),o[1],0,0,0), C0,4); \
    KRD(GL,0); GAPB(o[0]=__builtin_amdgcn_mfma_f32_32x32x16_bf16(PAF(1),VFR(1),o[0],0,0,0), C0,8); \
    KRD(GL,1); GAPB(o[1]=__builtin_amdgcn_mfma_f32_32x32x16_bf16(PAF(1),VFR(5),o[1],0,0,0), C0,12); \
    KRD(GL,2); GAPB(o[0]=__builtin_amdgcn_mfma_f32_32x32x16_bf16(PAF(2),VFR(2),o[0],0,0,0), C1,0); \
    KRD(GL,3); GAPB(o[1]=__builtin_amdgcn_mfma_f32_32x32x16_bf16(PAF(2),VFR(6),o[1],0,0,0), C1,4); \
    GAPB(o[0]=__builtin_amdgcn_mfma_f32_32x32x16_bf16(PAF(3),VFR(3),o[0],0,0,0), C1,8); \
    GAPB(o[1]=__builtin_amdgcn_mfma_f32_32x32x16_bf16(PAF(3),VFR(7),o[1],0,0,0), C1,12); \
    }while(0)
  int t=1;
  #define ENDW(tt) do{ if((tt)+3<NT){ if(MASK){WAIT_BAR(3);}else{WAIT_BAR(2);} } else if((tt)+2<NT){ if(MASK){WAIT_BAR(2);}else{WAIT_BAR(1);} } else {WAIT_BAR(0);} }while(0)
  for(;t+5<NT;t+=2){
    STEP(pB0,pB1,pA0,pA1,t,true,true,true,mwB,MASK,MASK);     if(MASK){WAIT_BAR(3);}else{WAIT_BAR(2);} MPIN(mwA); RESC(); ROT();
    STEP(pA0,pA1,pB0,pB1,t+1,true,true,true,mwA,MASK,MASK);   if(MASK){WAIT_BAR(3);}else{WAIT_BAR(2);} MPIN(mwB); RESC(); ROT();
  }
  for(;t+1<NT;t+=2){
    STEP(pB0,pB1,pA0,pA1,t,(t+3<NT),(t+1<NT),(t+1<NT),mwB,(MASK&&(t+2<NT)),true);       ENDW(t);   MPIN(mwA); RESC(); ROT();
    STEP(pA0,pA1,pB0,pB1,t+1,(t+4<NT),(t+2<NT),(t+2<NT),mwA,(MASK&&(t+3<NT)),true);     ENDW(t+1); MPIN(mwB); RESC(); ROT();
  }
  STEP(pB0,pB1,pA0,pA1,NT-1,false,false,false,mwB,false,true); RESC();
  { float sacc=pB0[0]+pB0[1]; _Pragma("unroll") for(int r=2;r<16;++r)sacc+=pB0[r]; _Pragma("unroll") for(int r=0;r<16;++r)sacc+=pB1[r]; l_reg+=sacc;
    pw0=(u32x4){PKW(pB0,0),PKW(pB0,2),PKW(pB0,4),PKW(pB0,6)};pw1=(u32x4){PKW(pB0,8),PKW(pB0,10),PKW(pB0,12),PKW(pB0,14)};pw2=(u32x4){PKW(pB1,0),PKW(pB1,2),PKW(pB1,4),PKW(pB1,6)};pw3=(u32x4){PKW(pB1,8),PKW(pB1,10),PKW(pB1,12),PKW(pB1,14)};
    SBAR(); pv(o,vb0+sl_cur,PAF(0),PAF(1),PAF(2),PAF(3)); }
  #undef PKW
  #undef PAF
  #undef VFR
  #undef PIN
  #undef MX3
  #undef GAPA
  #undef GAPB
  #undef EX
  #undef VRD
  #undef KRD
  #undef STEP
  #undef ENDW
  {auto rr=__builtin_amdgcn_permlane32_swap(__float_as_uint(l_reg),__float_as_uint(l_reg),false,false);l_reg=__uint_as_float(rr[0])+__uint_as_float(rr[1]);}
  if(hi==0)wsf[32+r32]=l_reg;asm volatile("s_waitcnt lgkmcnt(0)":::"memory");
  float rli[16];
  #pragma unroll
  for(int r=0;r<16;++r)rli[r]=__builtin_amdgcn_rcpf(wsf[32+crow(r,hi)]);
  bf16*Ow=Os+(long)(q0+wid*QBLK)*OP;
  { bf16*stg=(bf16*)(shm+LDS_OST)+wid*2048;
    #pragma unroll
    for(int r=0;r<16;++r){const int orow=crow(r,hi);
      #pragma unroll
      for(int d0=0;d0<2;++d0)stg[orow*64+d0*32+r32]=__float2bfloat16(o[d0][r]*rli[r]);}
    asm volatile("s_waitcnt lgkmcnt(0)":::"memory");
    #pragma unroll
    for(int i=0;i<4;++i){const int row=i*8+(lane>>3),ch=lane&7; const u32x4 v=*(const u32x4*)(stg+row*64+ch*8); *(u32x4*)(Ow+(long)row*OP+ch*8)=v;} }
  asm volatile("s_waitcnt lgkmcnt(0)\n\ts_barrier":::"memory");
  #undef DMA_K
  #undef MLOAD
  #undef MPIN
  #undef DMA_V
  #undef CMASK
  #undef START
  #undef RESC
  #undef ROT
}
#undef SBAR
#undef WAIT_BAR
}
struct Args { const float* in[25]; float* out; unsigned char* ws; int ph_lo, ph_hi; };
struct Frame {
    LAS unsigned char* lds; unsigned char* ldsg;
    volatile LAS unsigned* MISC;
    gu32* ctl;
    int tid, lane, wave, vcu, G;
    unsigned char* ws; float* out;
};
__device__ __forceinline__ float dpp_add_(float v, float acc_src, int) { return v; }
#define DPP_F(v, ctrl, rmask) __builtin_bit_cast(float, __builtin_amdgcn_update_dpp(0, __builtin_bit_cast(int, (v)), (ctrl), (rmask), 0xF, false))
__device__ __forceinline__ float wave_sum(float v) {
    v += DPP_F(v, 0xB1, 0xF);
    v += DPP_F(v, 0x4E, 0xF);
    v += DPP_F(v, 0x141, 0xF);
    v += DPP_F(v, 0x140, 0xF);
    v += DPP_F(v, 0x142, 0xA);
    v += DPP_F(v, 0x143, 0xC);
    return __builtin_bit_cast(float, __builtin_amdgcn_readlane(__builtin_bit_cast(int, v), 63));
}
__device__ __forceinline__ bf16* wsb(const Frame& F, size_t off) { return (bf16*)(F.ws + off); }

__device__ __forceinline__ int map_small(int r) {
    if (r < 1024) return r;
    if (r < 1280) return 1028 + (r - 1024);
    if (r < 1536) return 1412 + (r - 1280);
    if (r < 2048) return 1736 + (r - 1536);
    if (r < 2112) return 1284 + (r - 2048);
    if (r < 2176) return 1348 + (r - 2112);
    if (r < 2240) return 1668 + (r - 2176);
    if (r < 2244) return 1024 + (r - 2240);
    if (r < 2248) return 1732 + (r - 2244);
    return -1;
}
__device__ __forceinline__ void tr_item(const float* src, int ld_src, int k0, int srccol, bf16* dst, int ld_dst, LAS float* scr, int lane) {
    float tv[32];
#pragma unroll
    for (int i = 0; i < 32; ++i) { const int kk = 2 * i + (lane >> 5); tv[i] = src[(size_t)(k0 + kk) * ld_src + (srccol >= 0 ? srccol : 0)]; }
#pragma unroll
    for (int i = 0; i < 32; ++i) { const int kk = 2 * i + (lane >> 5); scr[kk * 33 + (lane & 31)] = srccol >= 0 ? tv[i] : 0.f; }
    LDS_WAIT(); asm volatile("" ::: "memory");
    const int c = lane & 7;
#pragma unroll
    for (int j = 0; j < 4; ++j) { const int n = (lane >> 3) + 8 * j; const LAS float* s = scr + (8 * c) * 33 + n;
        v4u o; o.x = pk2(s[0 * 33], s[1 * 33]); o.y = pk2(s[2 * 33], s[3 * 33]); o.z = pk2(s[4 * 33], s[5 * 33]); o.w = pk2(s[6 * 33], s[7 * 33]);
        *(GAS v4u*)(dst + (size_t)n * ld_dst + 8 * c) = o; }
    LDS_WAIT(); asm volatile("" ::: "memory");
}
#ifndef A_F8_TILES
#define A_F8_TILES 0x0DF
#endif
constexpr size_t W_SM8 = 4718592 + 4 * MiB;
constexpr float ACT_SCALE = 8.f;
constexpr float GATE_WSCALE = 32.f;
__device__ __forceinline__ void tr_item8(const float* src, int ld_src, int k0, int srccol, unsigned char* dst, int ld_dst, LAS float* scr, int lane) {
    float tv[32];
#pragma unroll
    for (int i = 0; i < 32; ++i) { const int kk = 2 * i + (lane >> 5); tv[i] = src[(size_t)(k0 + kk) * ld_src + (srccol >= 0 ? srccol : 0)]; }
#pragma unroll
    for (int i = 0; i < 32; ++i) { const int kk = 2 * i + (lane >> 5); scr[kk * 33 + (lane & 31)] = srccol >= 0 ? tv[i] * GATE_WSCALE : 0.f; }
    LDS_WAIT(); asm volatile("" ::: "memory");
    const int c = lane & 7;
#pragma unroll
    for (int j = 0; j < 4; ++j) { const int n = (lane >> 3) + 8 * j; const LAS float* s = scr + (8 * c) * 33 + n;
        v2u o; o.x = pk4_fp8(s[0 * 33], s[1 * 33], s[2 * 33], s[3 * 33]); o.y = pk4_fp8(s[4 * 33], s[5 * 33], s[6 * 33], s[7 * 33]);
        *(GAS v2u*)(dst + (size_t)n * ld_dst + 8 * c) = o; }
    LDS_WAIT(); asm volatile("" ::: "memory");
}
constexpr int IT_SM = 72 * 16, IT_GT = 128 * 16, IT_BR = 512, IT_OUT = 512, IT_GU = 16 * 512, IT_D = 16 * 256, IT_LAYER = IT_SM + IT_GT + IT_BR + IT_OUT + IT_GU + IT_D;
__device__ __forceinline__ void p0_item(const Frame& F, const Args& a, int it, LAS float* scr) {
    const int l = it / IT_LAYER; int j = it % IT_LAYER; const int n = F.lane & 31;
    bf16* W = wsb(F, WS_W + (size_t)l * W_LAYER);
    if (j < IT_SM) { const int g = j / 16, kb = j % 16;
        if ((A_F8_TILES >> (g / 8)) & 1) tr_item8(a.in[3] + (size_t)l * DM * P_TOTAL, P_TOTAL, kb * 64, map_small(g * 32 + n), (unsigned char*)W + W_SM8 + (size_t)(g * 32) * DM + kb * 64, DM, scr, F.lane);
        else tr_item(a.in[3] + (size_t)l * DM * P_TOTAL, P_TOTAL, kb * 64, map_small(g * 32 + n), W + W_SM / 2 + (size_t)(g * 32) * DM + kb * 64, DM, scr, F.lane);
        return; } j -= IT_SM;
    if (j < IT_GT) { const int g = j / 16, kb = j % 16; tr_item8(a.in[3] + (size_t)l * DM * P_TOTAL, P_TOTAL, kb * 64, 2248 + g * 32 + n, (unsigned char*)W + W_GT + (size_t)(g * 32) * DM + kb * 64, DM, scr, F.lane); return; } j -= IT_GT;
    if (j < IT_BR) { const int nb = j / 128, jj = j % 128, g = jj / 4, kb = jj % 4;
        tr_item(a.in[12] + ((size_t)l * 4 + nb) * 256 * DM, DM, kb * 64, g * 32 + n, W + W_BR / 2 + (size_t)(g * 32) * DM + nb * 256 + kb * 64, DM, scr, F.lane); return; } j -= IT_BR;
    if (j < IT_OUT) { const int g = j / 16, kb = j % 16; tr_item(a.in[13] + (size_t)l * DM * DM, DM, kb * 64, g * 32 + n, W + W_OUT / 2 + (size_t)(g * 32) * DM + kb * 64, DM, scr, F.lane); return; } j -= IT_OUT;
    if (j < IT_GU) { const int e = j / 512, jj = j % 512, g = jj / 16, kb = jj % 16; const int r0 = g * 32, q = r0 >> 8, within = r0 & 255; const bool isup = within >= 128;
        const float* src = (isup ? a.in[21] : a.in[20]) + ((size_t)l * 16 + e) * DM * 512;
        tr_item8(src, 512, kb * 64, 128 * q + (within & 127) + n, (unsigned char*)W + W_GU + (size_t)e * DM * DM + (size_t)r0 * DM + kb * 64, DM, scr, F.lane); return; } j -= IT_GU;
    { const int e = j / 256, jj = j % 256, g = jj / 8, kb = jj % 8;
        tr_item8(a.in[22] + ((size_t)l * 16 + e) * 512 * DM, DM, kb * 64, g * 32 + n, (unsigned char*)W + W_D + (size_t)(e >> 1) * DM * DM + (size_t)(g * 32) * DM + (e & 1) * 512 + kb * 64, DM, scr, F.lane); }
}
__device__ __forceinline__ void ln_load(const Frame& F, const float* xrow, f32x4 (&v)[4]) {
    const GAS f32x4* xr = (const GAS f32x4*)xrow + F.lane;
#pragma unroll
    for (int j = 0; j < 4; ++j) v[j] = xr[64 * j];
}
struct LnGB { f32x4 g[4], b[4]; };
__device__ __forceinline__ void ln_gb_load(const Frame& F, const float* g, const float* b, LnGB& gb) {
#pragma unroll
    for (int j = 0; j < 4; ++j) { gb.g[j] = ((const GAS f32x4*)g)[F.lane + 64 * j]; gb.b[j] = ((const GAS f32x4*)b)[F.lane + 64 * j]; }
}
__device__ __forceinline__ void ln_load_bf(const Frame& F, const bf16* xrow, f32x4 (&v)[4]) {
    const GAS v2u* xr = (const GAS v2u*)xrow + F.lane;
#pragma unroll
    for (int j = 0; j < 4; ++j) { const v2u w = xr[64 * j]; v[j] = (f32x4){bfl(w.x), bfh(w.x), bfl(w.y), bfh(w.y)}; }
}
__device__ __forceinline__ void ln_row(const Frame& F, const LnGB& gb, float* orow  , bf16* brow  , f32x4 (&v)[4], bool dry = false, unsigned char* frow = nullptr  ) {
    float s = 0.f;
#pragma unroll
    for (int j = 0; j < 4; ++j) s += (v[j].x + v[j].y) + (v[j].z + v[j].w);
    const float mean = wave_sum(s) * (1.f / DM); float s2 = 0.f;
#pragma unroll
    for (int j = 0; j < 4; ++j) { v[j] = v[j] - mean; s2 += (v[j].x * v[j].x + v[j].y * v[j].y) + (v[j].z * v[j].z + v[j].w * v[j].w); }
    const float rstd = 1.f / sqrtf(wave_sum(s2) * (1.f / DM) + LN_EPS);
    GAS f32x4* o4 = (GAS f32x4*)orow + F.lane; GAS v2u* o8 = (GAS v2u*)brow + F.lane; GAS unsigned* o1 = (GAS unsigned*)frow + F.lane;
#pragma unroll
    for (int j = 0; j < 4; ++j) { v[j] = v[j] * rstd * gb.g[j] + gb.b[j]; v2u w; w.x = pk2(v[j].x, v[j].y); w.y = pk2(v[j].z, v[j].w); if (!dry) { if (orow) o4[64 * j] = v[j]; if (brow) o8[64 * j] = w; if (frow) o1[64 * j] = pk4_fp8(v[j].x, v[j].y, v[j].z, v[j].w); } }
}
__device__ __forceinline__ void p0_prologue(const Frame& F_, const Args& a) { Frame F = F_; F.lane = lane_id_(); F.tid = F.wave * 64 + F.lane;
    LAS float* scr = (LAS float*)(F.lds + RING_OFF + F.wave * 16384);
    const int gw = F.vcu * NWAVES + F.wave, NGW = F.G * NWAVES;
    for (int it = gw; it < DEPTH * IT_LAYER; it += NGW) p0_item(F, a, it, scr);
    { LnGB gb; ln_gb_load(F, a.in[1], a.in[2], gb); f32x4 nx[4]; ln_load(F, a.in[0] + (size_t)gw * DM, nx);
      for (int m = gw; m < NTOK; m += NGW) { f32x4 v[4];
#pragma unroll
          for (int j = 0; j < 4; ++j) v[j] = nx[j];
          if (m + NGW < NTOK) ln_load(F, a.in[0] + (size_t)(m + NGW) * DM, nx);
          ln_row(F, gb, nullptr, wsb(F, WS_HB) + (size_t)m * DM, v, false, F.ws + WS_HB8 + (size_t)m * DM); } }
}

#ifndef TO_WGM
#define TO_WGM 8
#endif
struct TileOrder {
    int nM, nN, nwg, G, c;
    __device__ void init(int nM_, int nN_, int G_, int c_) { nM = nM_; nN = nN_; nwg = nM * nN; G = G_; c = c_; }
    __device__ bool tile(int i, int& pm, int& pn) const {
        const long L = (long)i * G + c; if (L >= nwg) return false;
        int wgid = (int)L; { const int q = nwg / 8, r = nwg % 8, xcd = wgid % 8, off = wgid / 8; wgid = (xcd < r ? xcd * (q + 1) : r * (q + 1) + (xcd - r) * q) + off; }
        const int nig = TO_WGM * nN, gid = wgid / nig, fm = gid * TO_WGM, gsz = (nM - fm) < TO_WGM ? (nM - fm) : TO_WGM;
        pm = fm + ((wgid % nig) % gsz); pn = (wgid % nig) / gsz; return true;
    }
};
template <bool F8_> struct SchedAT { static constexpr int NT = 0, KS = 0; TileOrder T; const char* A; const char* B; unsigned map;
    __device__ bool next(int i, pg8::GU& u) const { int pm, pq; if (!T.tile(i, pm, pq)) return false; const int pn = (int)((map >> (4 * pq)) & 15u); constexpr size_t TS = F8_ ? pg8::TSTEP / 2 : pg8::TSTEP;
        u.A = A + (size_t)pm * TS; u.B0 = B + (size_t)pn * TS; u.B1 = u.B0; u.nt = F8_ ? 8 : 16; u.ks = u.nt; u.pm = pm; u.pn = pn; u.rows = nullptr; u.rbase = 0; u.rcnt = 0; u.a0 = 0; u.a1 = 0; return true; } };
template <bool F8_> struct EpiAT { static constexpr bool F8 = F8_; static constexpr bool PERM = true; bf16* P; float* FW; bf16* KIDX;
    __device__ __forceinline__ void operator()(const pg8::f32x4 (&acc)[2][2][4][2], const pg8::GU& u, int wr, int wc, int fr, int fq) {
        const float sc = ((u.pn == 1 || u.pn == 4) ? 0.125f * LOG2E : 1.f) * (F8_ ? 1.f / GATE_WSCALE : 1.f);
        const int row0 = u.pm * 256 + wr * 64 + fr, col0 = u.pn * 256 + wc * 32 + 8 * fq;
#pragma unroll
        for (int ai = 0; ai < 2; ++ai)
#pragma unroll
            for (int m = 0; m < 4; ++m) { const int row = row0 + ai * 128 + m * 16; bf16* rowp = P + (size_t)row * PS + col0;
#pragma unroll
                for (int bj = 0; bj < 2; ++bj) { const pg8::f32x4 v0 = acc[ai][bj][m][0] * sc, v1 = acc[ai][bj][m][1] * sc; v4u w;
                    w.x = pg8::cvt_pk_bf16(v0[0], v0[1]); w.y = pg8::cvt_pk_bf16(v0[2], v0[3]); w.z = pg8::cvt_pk_bf16(v1[0], v1[1]); w.w = pg8::cvt_pk_bf16(v1[2], v1[3]);
                    *(v4u*)(rowp + bj * 128) = w;
                    if (bj == 1 && u.pn == 8 && wc < 2) *(v4u*)(KIDX + (size_t)row * 64 + wc * 32 + 8 * fq) = w;
                    if (bj == 1 && u.pn == 8 && wc == 2 && fq == 0) { *(f32x4*)(FW + (size_t)row * 8) = v0; *(f32x4*)(FW + (size_t)row * 8 + 4) = v1; } } }
    } };
struct SchedC { TileOrder T; const char* HBp; const char* BRp; const char* WGp; const char* WBp; bool collapse;
    __device__ bool next(int i, pg8::GU& u) const { int pm, pd; if (!T.tile(i >> 3, pm, pd)) return false; const int sub = i & 7, n = sub >> 1, isg = sub & 1; const int pm_o = pm, pd_o = pd; if (collapse) { pm &= 7; pd = 0; }
        u.pm = pm; u.pn = pd; u.a0 = n; u.a1 = isg; u.rows = nullptr; u.rbase = 0; u.rcnt = 0;
        if (isg) { u.A = HBp + (size_t)pm * (pg8::TSTEP / 2); u.B0 = WGp + (size_t)(n * 8 + pd) * (pg8::HSTEP / 2); u.nt = 8; }
        else     { u.A = BRp + (size_t)pm * pg8::TSTEP + n * 512; u.B0 = WBp + (size_t)pd * pg8::HSTEP + n * 512; u.nt = 4; }
        u.B1 = u.B0; u.ks = u.nt; u.pm = pm_o; u.pn = pd_o; return true; } };
struct EpiC { static constexpr bool F8 = false; static constexpr bool PERM = true; bf16* MIX; const float* bgate; bool dry;
    __device__ __forceinline__ void operator()(const pg8::f32x4 (&acc)[2][4][2], pg8::u32x4 (&upk)[2][4], pg8::u32x4 (&sum)[2][4]  , const pg8::GU& u, int wr, int wc, int fr, int fq) {
        const int n = u.a0;
        if (!u.a1) {
#pragma unroll
            for (int ai = 0; ai < 2; ++ai)
#pragma unroll
                for (int m = 0; m < 4; ++m) { const pg8::f32x4 v0 = acc[ai][m][0], v1 = acc[ai][m][1]; v4u w;
                    w.x = pg8::cvt_pk_bf16(v0[0], v0[1]); w.y = pg8::cvt_pk_bf16(v0[2], v0[3]); w.z = pg8::cvt_pk_bf16(v1[0], v1[1]); w.w = pg8::cvt_pk_bf16(v1[2], v1[3]); upk[ai][m] = w; }
        } else {
            const int colt = u.pn * 128 + wc * 32 + 8 * fq; const float* bp = bgate + n * DM + colt; const f32x4 b0 = *(const f32x4*)bp, b1 = *(const f32x4*)(bp + 4);
#pragma unroll
            for (int ai = 0; ai < 2; ++ai)
#pragma unroll
                for (int m = 0; m < 4; ++m) { const v4u uw = upk[ai][m]; const pg8::f32x4 g0 = acc[ai][m][0] * (1.f / GATE_WSCALE) + b0, g1 = acc[ai][m][1] * (1.f / GATE_WSCALE) + b1;
                    pg8::f32x4 r0, r1; r0[0] = sigmoidf_(g0[0]) * bfl(uw.x); r0[1] = sigmoidf_(g0[1]) * bfh(uw.x); r0[2] = sigmoidf_(g0[2]) * bfl(uw.y); r0[3] = sigmoidf_(g0[3]) * bfh(uw.y);
                    r1[0] = sigmoidf_(g1[0]) * bfl(uw.z); r1[1] = sigmoidf_(g1[1]) * bfh(uw.z); r1[2] = sigmoidf_(g1[2]) * bfl(uw.w); r1[3] = sigmoidf_(g1[3]) * bfh(uw.w);
                    if (n > 0) { const v4u pw = sum[ai][m]; r0[0] += bfl(pw.x); r0[1] += bfh(pw.x); r0[2] += bfl(pw.y); r0[3] += bfh(pw.y); r1[0] += bfl(pw.z); r1[1] += bfh(pw.z); r1[2] += bfl(pw.w); r1[3] += bfh(pw.w); }
                    v4u o; o.x = pg8::cvt_pk_bf16(r0[0], r0[1]); o.y = pg8::cvt_pk_bf16(r0[2], r0[3]); o.z = pg8::cvt_pk_bf16(r1[0], r1[1]); o.w = pg8::cvt_pk_bf16(r1[2], r1[3]); sum[ai][m] = o; }
            if (n == 3) { const int row0 = u.pm * 256 + wr * 64 + fr;
#pragma unroll
                for (int ai = 0; ai < 2; ++ai)
#pragma unroll
                    for (int m = 0; m < 4; ++m) *(v4u*)(MIX + (size_t)(row0 + ai * 128 + m * 16) * DM + colt) = sum[ai][m]; }
        }
    } };
struct SchedC2 { static constexpr int NT = 0, KS = 0; TileOrder T; const char* A; const char* B;
    __device__ bool next(int i, pg8::GU& u) const { int pm, pn; if (!T.tile(i, pm, pn)) return false; u.A = A + (size_t)pm * pg8::TSTEP; u.B0 = B + (size_t)pn * pg8::TSTEP; u.B1 = u.B0; u.nt = 16; u.ks = 16; u.pm = pm; u.pn = pn; u.rows = nullptr; u.rbase = 0; u.rcnt = 0; u.a0 = 0; u.a1 = 0; return true; } };
struct EpiRes { static constexpr bool F8 = false; static constexpr bool PERM = false; bf16* V1; const bf16* HB; bool dry;
    __device__ __forceinline__ void operator()(const pg8::f32x4 (&acc)[2][2][4][2], const pg8::GU& u, int wr, int wc, int fr, int fq) {
        const int row0 = u.pm * 256 + wr * 64 + fr, col0 = u.pn * 256 + wc * 32 + 4 * fq;
#pragma unroll
        for (int ai = 0; ai < 2; ++ai)
#pragma unroll
            for (int m = 0; m < 4; ++m) { const size_t ro = (size_t)(row0 + ai * 128 + m * 16) * DM + col0;
#pragma unroll
                for (int bj = 0; bj < 2; ++bj)
#pragma unroll
                    for (int n = 0; n < 2; ++n) { const v2u hw = *(const v2u*)(HB + ro + bj * 128 + n * 16); const f32x4 hv = (f32x4){bfl(hw.x), bfh(hw.x), bfl(hw.y), bfh(hw.y)};
                        const f32x4 r_ = hv * ALPHA + acc[ai][bj][m][n]; v2u o; o.x = pk2(r_.x, r_.y); o.y = pk2(r_.z, r_.w); if (!dry) *(v2u*)(V1 + ro + bj * 128 + n * 16) = o; } }
    } };
__device__ __forceinline__ void cls_lookup(const LAS int* tab, int tau, int& c, int& j) {
    int cc = 0;
#pragma unroll 1
    for (int k = 1; k < NCLS; ++k) if (tab[32 + k] <= tau) cc = k;
    c = cc; j = tau - tab[32 + cc];
}
__device__ __forceinline__ void cls_experts(int c, int& ea, int& eb) { const int g = c / 6, p = c % 6; const int i = p < 3 ? 0 : (p < 5 ? 1 : 2); const int jj = p < 3 ? p + 1 : (p < 5 ? p - 1 : 3); ea = g * 4 + i; eb = g * 4 + jj; }
struct SchedD1 { static constexpr int NT = 0, KS = 0; const LAS int* tab; int G, c0; const char* HBp; const char* WGU; const int* list;
    __device__ bool next(int i, pg8::GU& u) const { const int L = i * G + c0; if (L >= tab[57] * 8) return false; const int tau = L >> 3, pn = L & 7; int c, j; cls_lookup(tab, tau, c, j); int ea, eb; cls_experts(c, ea, eb);
        const int e = (pn >> 2) ? eb : ea;
        u.A = HBp; u.B0 = WGU + (size_t)e * DM * DM + (size_t)(pn & 3) * (pg8::TSTEP / 2); u.B1 = u.B0; u.nt = 8; u.ks = 8;     u.rows = list + (size_t)c * NTOK; u.rbase = j * 256; u.rcnt = tab[c];
        u.pm = tau; u.pn = pn; u.a0 = c; u.a1 = j; return true; } };
struct EpiD1 { static constexpr bool F8 = true; static constexpr bool PERM = true; unsigned char* ACT; const float* gwl;
    __device__ __forceinline__ void operator()(const pg8::f32x4 (&acc)[2][2][4][2], const pg8::GU& u, int wr, int wc, int fr, int fq) {
        const int half = u.pn >> 2, col = half * 512 + (u.pn & 3) * 128 + wc * 32 + 8 * fq;
#pragma unroll
        for (int ai = 0; ai < 2; ++ai)
#pragma unroll
            for (int m = 0; m < 4; ++m) { const int r = ai * 128 + wr * 64 + m * 16 + opaque_i(fr), pos = u.rbase + r;
                const float gw = pos < u.rcnt ? gwl[((size_t)u.a0 * NTOK + pos) * 2 + half] * ACT_SCALE : 0.f;
                const pg8::f32x4 g0 = acc[ai][0][m][0] * (1.f / GATE_WSCALE), g1 = acc[ai][0][m][1] * (1.f / GATE_WSCALE), u0 = acc[ai][1][m][0] * (1.f / GATE_WSCALE), u1 = acc[ai][1][m][1] * (1.f / GATE_WSCALE); float r8[8];
#pragma unroll
                for (int k = 0; k < 4; ++k) { r8[k] = g0[k] * sigmoidf_(g0[k]) * u0[k] * gw; r8[4 + k] = g1[k] * sigmoidf_(g1[k]) * u1[k] * gw; }
                v2u o; o.x = pk4_fp8(r8[0], r8[1], r8[2], r8[3]); o.y = pk4_fp8(r8[4], r8[5], r8[6], r8[7]);
                *(v2u*)(ACT + ((size_t)u.pm * 256 + r) * DM + col) = o; asm volatile("" ::: "memory"); }
    } };
struct SchedD2 { static constexpr int NT = 8, KS = 4; const LAS int* tab; int G, c0; const char* ACTp; const char* WD; const int* list;
    __device__ bool next(int i, pg8::GU& u) const { const int L = i * G + c0; if (L >= __builtin_amdgcn_readfirstlane(tab[57]) * 4) return false; const int tau = L >> 2, pn = L & 3; int c, j; cls_lookup(tab, tau, c, j); c = __builtin_amdgcn_readfirstlane(c); j = __builtin_amdgcn_readfirstlane(j); int ea, eb; cls_experts(c, ea, eb);
        u.A = sptr_(ACTp + (size_t)tau * (pg8::TSTEP / 2)); u.B0 = sptr_(WD + (size_t)(ea >> 1) * DM * DM + (ea & 1) * 512 + (size_t)pn * (pg8::TSTEP / 2)); u.B1 = sptr_(WD + (size_t)(eb >> 1) * DM * DM + (eb & 1) * 512 + (size_t)pn * (pg8::TSTEP / 2));
        u.nt = 8; u.ks = 4;     u.rows = list + (size_t)c * NTOK; u.rbase = j * 256; u.rcnt = __builtin_amdgcn_readfirstlane(tab[c]); u.pm = tau; u.pn = pn; u.a0 = c; u.a1 = j; return true; } };
struct EpiD2 { static constexpr bool F8 = true; static constexpr bool PERM = false; bf16* V2; const bf16* HB; bool dry;
    __device__ __forceinline__ void operator()(const pg8::f32x4 (&acc)[2][2][4][2], const pg8::GU& u, int wr, int wc, int fr, int fq) {
        const int col0 = u.pn * 256 + wc * 32 + 4 * fq;
#pragma unroll
        for (int ai = 0; ai < 2; ++ai) { asm volatile("" ::: "memory");
#pragma unroll
            for (int m = 0; m < 4; ++m) { if (m == 2) asm volatile("" ::: "memory"); const int pos = u.rbase + ai * 128 + wr * 64 + m * 16 + opaque_i(fr);
                if (pos < u.rcnt) { const size_t ro = (size_t)u.rows[pos] * DM + col0;
#pragma unroll
                    for (int bj = 0; bj < 2; ++bj)
#pragma unroll
                        for (int n = 0; n < 2; ++n) { const v2u hw = *(const v2u*)(HB + ro + bj * 128 + n * 16); const f32x4 hv = (f32x4){bfl(hw.x), bfh(hw.x), bfl(hw.y), bfh(hw.y)};
                            const f32x4 r_ = hv * ALPHA + acc[ai][bj][m][n] * (1.f / (ACT_SCALE * GATE_WSCALE)); v2u o; o.x = pk2(r_.x, r_.y); o.y = pk2(r_.z, r_.w); if (!dry) *(v2u*)(V2 + ro + bj * 128 + n * 16) = o; } } } }
    } };
typedef float f32x2v __attribute__((ext_vector_type(2)));
__device__ __forceinline__ float log_sigmoid_(float x) { return fminf(x, 0.f) - __builtin_amdgcn_logf(1.f + __builtin_amdgcn_exp2f(-fabsf(x) * LOG2E)) * 0.6931471805599453f; }
__device__ __forceinline__ void fox_cumsum(const Frame& F_, int bh, const float* FW, const float* bfor, float* bias2) { Frame F = F_; F.lane = lane_id_(); F.tid = F.wave * 64 + F.lane;
    const int b = bh >> 2, h = bh & 3; const float bf = bfor[h]; const float* src = FW + ((size_t)b * SEQ + F.lane * 64) * 8 + h; float tot = 0.f;
    for (int i = 0; i < 64; ++i) tot += log_sigmoid_(src[(size_t)i * 8] + bf);
    float inc = tot;
#pragma unroll
    for (int o = 1; o < 64; o <<= 1) { const float t = __int_as_float(shfl_i_(__float_as_int(inc), F.lane - o)); if (F.lane >= o) inc += t; }
    float run = inc - tot; float* dst = bias2 + (size_t)bh * SEQ + F.lane * 64;
    for (int i = 0; i < 64; ++i) { run += log_sigmoid_(src[(size_t)i * 8] + bf); dst[i] = -run * LOG2E; }
}
template <int WIN> __device__ __forceinline__ void pool_frags(bf16x8 (&af)[4], const bf16* src0, int tb) {
    const int nrow = tb + 1 < WIN ? tb + 1 : WIN; const float inv = 1.f / (float)nrow;
#pragma unroll
    for (int ks = 0; ks < 4; ++ks) { const bf16* src = src0 + ks * 16; v4u wv[WIN];
#pragma unroll
        for (int j = 0; j < WIN; ++j) wv[j] = *(const v4u*)(src - (size_t)(j <= tb ? j : 0) * PS);
        float s[8];
#pragma unroll
        for (int k = 0; k < 8; ++k) s[k] = 0.f;
#pragma unroll
        for (int j = 0; j < WIN; ++j) { if (j <= tb) { const v4u w = wv[j];
            s[0] += bfl(w.x); s[1] += bfh(w.x); s[2] += bfl(w.y); s[3] += bfh(w.y); s[4] += bfl(w.z); s[5] += bfh(w.z); s[6] += bfl(w.w); s[7] += bfh(w.w); } }
        const v4u cur = wv[0];
        const float c[8] = {bfl(cur.x), bfh(cur.x), bfl(cur.y), bfh(cur.y), bfl(cur.z), bfh(cur.z), bfl(cur.w), bfh(cur.w)};
        v4u o; o.x = pk2(s[0] * inv - c[0], s[1] * inv - c[1]); o.y = pk2(s[2] * inv - c[2], s[3] * inv - c[3]); o.z = pk2(s[4] * inv - c[4], s[5] * inv - c[5]); o.w = pk2(s[6] * inv - c[6], s[7] * inv - c[7]);
        af[ks] = __builtin_bit_cast(bf16x8, o); }
}
__device__ __forceinline__ void pool_unit(const Frame& F_, int tile, const bf16* P, const float* pw, const float* pscale, bf16* BR) { Frame F = F_; F.lane = lane_id_(); F.tid = F.wave * 64 + F.lane;
    const int g = F.wave & 3, th = F.wave >> 2, r32 = F.lane & 31, hi = F.lane >> 5;
    const int tok = tile * 64 + th * 32 + r32, tb = tok & (SEQ - 1);
    const bf16* src0 = P + (size_t)tok * PS + C_POOL + g * 64 + hi * 8;
    bf16x8 af[4];
    if (g == 0) pool_frags<2>(af, src0, tb); else if (g == 1) pool_frags<4>(af, src0, tb); else if (g == 2) pool_frags<8>(af, src0, tb); else pool_frags<16>(af, src0, tb);
#pragma unroll
    for (int db = 0; db < 2; ++db) { f32x16 acc = {};
#pragma unroll
        for (int ks = 0; ks < 4; ++ks) { const float* wp = pw + ((size_t)g * 64 + ks * 16 + hi * 8) * 64 + db * 32 + r32;
            v4u o; o.x = pk2(wp[0], wp[64]); o.y = pk2(wp[128], wp[192]); o.z = pk2(wp[256], wp[320]); o.w = pk2(wp[384], wp[448]);
            acc = __builtin_amdgcn_mfma_f32_32x32x16_bf16(af[ks], __builtin_bit_cast(bf16x8, o), acc, 0, 0, 0); }
        const int col = g * 64 + db * 32 + r32; const float sc = pscale[col];
#pragma unroll
        for (int r = 0; r < 16; ++r) { const int row = tile * 64 + th * 32 + (r & 3) + 8 * (r >> 2) + 4 * hi; BR[(size_t)row * DM + col] = (bf16)f2bf(acc[r] * sc); } }
}
__device__ __forceinline__ void conv_unit(const Frame& F_, int tile, const bf16* P, const float* dw, const float* cb, const float* lg, const float* lb, bf16* BR) { Frame F = F_; F.lane = lane_id_(); F.tid = F.wave * 64 + F.lane;
    LAS float* hb = (LAS float*)(F.lds + RING_OFF);
    LAS float* yb = hb + 62 * 256;
    const int t0 = tile * 32, tb0 = t0 & (SEQ - 1);
    { v4u av[4], gv[4];
#pragma unroll
      for (int k = 0; k < 4; ++k) { const int e = F.tid + k * NWAVES * 64, rr = e >> 5, c8 = (e & 31) * 8, trel = rr - 30; const bool ok = e < 62 * 32 && tb0 + trel >= 0;
          const bf16* src = P + (size_t)(t0 + (ok ? trel : 0)) * PS + C_CONV + c8; av[k] = *(const v4u*)src; gv[k] = *(const v4u*)(src + 256); }
#pragma unroll
      for (int k = 0; k < 4; ++k) { const int e = F.tid + k * NWAVES * 64, rr = e >> 5, c8 = (e & 31) * 8, trel = rr - 30; const bool ok = tb0 + trel >= 0; const v4u a = av[k], gt = gv[k]; float h[8];
          h[0] = bfl(a.x) * sigmoidf_(bfl(gt.x)); h[1] = bfh(a.x) * sigmoidf_(bfh(gt.x)); h[2] = bfl(a.y) * sigmoidf_(bfl(gt.y)); h[3] = bfh(a.y) * sigmoidf_(bfh(gt.y));
          h[4] = bfl(a.z) * sigmoidf_(bfl(gt.z)); h[5] = bfh(a.z) * sigmoidf_(bfh(gt.z)); h[6] = bfl(a.w) * sigmoidf_(bfl(gt.w)); h[7] = bfh(a.w) * sigmoidf_(bfh(gt.w));
          if (!ok) {
#pragma unroll
              for (int q = 0; q < 8; ++q) h[q] = 0.f; }
          if (e < 62 * 32) { *(LAS f32x4*)(hb + rr * 256 + c8) = (f32x4){h[0], h[1], h[2], h[3]}; *(LAS f32x4*)(hb + rr * 256 + c8 + 4) = (f32x4){h[4], h[5], h[6], h[7]}; } } }
    __syncthreads();
    { const int c = F.tid & 255, hf = F.tid >> 8; float w[31];
#pragma unroll
      for (int j = 0; j < 31; ++j) w[j] = dw[j * 256 + c];
      const float bias = cb[c];
#pragma unroll 1
      for (int q4 = 0; q4 < 4; ++q4) { const int tt = hf * 16 + q4 * 4; float x[34];
#pragma unroll
          for (int j = 0; j < 34; ++j) x[j] = hb[(tt + j) * 256 + c];
#pragma unroll
          for (int o = 0; o < 4; ++o) { float a = bias;
#pragma unroll
              for (int j = 0; j < 31; ++j) a += x[o + j] * w[j];
              yb[(tt + o) * 256 + c] = a; } } }
    __syncthreads();
#pragma unroll 1
    for (int q = 0; q < 4; ++q) { const int tt = F.wave * 4 + q; const f32x4 v = *(const LAS f32x4*)(yb + tt * 256 + F.lane * 4);
        const float mean = wave_sum((v.x + v.y) + (v.z + v.w)) * (1.f / 256.f); const f32x4 d = v - mean;
        const float var = wave_sum((d.x * d.x + d.y * d.y) + (d.z * d.z + d.w * d.w)) * (1.f / 256.f); const float rstd = 1.f / sqrtf(var + LN_EPS);
        const f32x4 gg = *(const f32x4*)(lg + F.lane * 4), bb = *(const f32x4*)(lb + F.lane * 4); const f32x4 y = d * rstd * gg + bb;
        v2u o; o.x = pk2(y.x * sigmoidf_(y.x), y.y * sigmoidf_(y.y)); o.y = pk2(y.z * sigmoidf_(y.z), y.w * sigmoidf_(y.w));
        *(v2u*)(BR + (size_t)(t0 + tt) * DM + 768 + F.lane * 4) = o; }
    __syncthreads();
}
__device__ __forceinline__ int key28_(float s) { const int u = (int)__float_as_uint(s); int m = (u & 0x7fffffff) - 0x3B000000; m = m < 0 ? 0 : (m > 0x07FFFFFF ? 0x07FFFFFF : m); return 0x08000000 + (m ^ (u >> 31)); }
__device__ __forceinline__ int key9_(float s) { const int u = (int)__float_as_uint(s); int m = ((u >> 19) & 0xfff) - 0x760; m = m < 0 ? 0 : (m > 255 ? 255 : m); return 256 + (m ^ (u >> 31)); }
__device__ __forceinline__ float key28_lbound(long long kv) {
    if (kv <= 0) return -INFINITY; if (kv > 0x0FFFFFFFll) return INFINITY;
    if (kv > 0x08000000ll) return __uint_as_float((unsigned)(0x3B000000ll + (kv - 0x08000000ll)));
    if (kv == 0x08000000ll) return 0.f;
    return -__uint_as_float((unsigned)(0x3B000000ll + (0x07FFFFFFll - kv)));
}
constexpr int DS_HIST = 0, DS_GT = 65536, DS_EQ = 81920, DS_KT = 98304, DS_SM = LDSCTL_OFF + 1024 - RING_OFF, DS_CAP = 512;
typedef float f32x2p __attribute__((ext_vector_type(2)));
__device__ __forceinline__ float relu_(float x) { const int b = (int)__float_as_uint(x); return __uint_as_float((unsigned)(b > 0 ? b : 0)); }
__device__ __forceinline__ void dsa_ldk(bf16x8 (&kf)[4], const bf16* kp) {
#pragma unroll
    for (int m = 0; m < 4; ++m) kf[m] = *(const bf16x8*)(kp + m * 512);
}
__device__ __forceinline__ void dsa_kfrag(bf16x8 (&kf)[4], const bf16x8 (&raw)[4], LAS unsigned char* kt, int lane) {
    const int rw = lane >> 3, cw = lane & 7, r32 = lane & 31, hi = lane >> 5;
#pragma unroll
    for (int m = 0; m < 4; ++m) *(LAS bf16x8*)(kt + (8 * m + rw) * 128 + ((cw ^ rw) << 4)) = raw[m];
#pragma unroll
    for (int ks = 0; ks < 4; ++ks) kf[ks] = *(const LAS bf16x8*)(kt + r32 * 128 + (((2 * ks + hi) ^ (r32 & 7)) << 4));
}
__device__ __forceinline__ void dsa_scores(const bf16x8 (&qf)[4][4], const bf16x8 (&kf)[4], const float (&w)[4], float (&sc)[16]) {
    f32x16 a[4];
#pragma unroll
    for (int hh = 0; hh < 4; ++hh) { a[hh] = (f32x16){};
#pragma unroll
        for (int ks = 0; ks < 4; ++ks) a[hh] = __builtin_amdgcn_mfma_f32_32x32x16_bf16(kf[ks], qf[hh][ks], a[hh], 0, 0, 0); }
#pragma unroll
    for (int r = 0; r < 16; r += 2) { f32x2p s2 = (f32x2p){relu_(a[0][r]), relu_(a[0][r + 1])} * w[0];
#pragma unroll
        for (int hh = 1; hh < 4; ++hh) s2 = (f32x2p){relu_(a[hh][r]), relu_(a[hh][r + 1])} * w[hh] + s2;
        sc[r] = s2.x + 0.f; sc[r + 1] = s2.y + 0.f; }
}
template <int NB4> __device__ __forceinline__ void hist_scan(const LAS unsigned* h, int K, int lane, int& bin, int& above, int& inbin, int* total = nullptr) {
    unsigned hv[NB4 * 4]; int s = 0;
#pragma unroll
    for (int g = 0; g < NB4; ++g) { const v4u t = *(const LAS v4u*)(h + NB4 * 4 * lane + 4 * g); hv[4 * g] = t.x; hv[4 * g + 1] = t.y; hv[4 * g + 2] = t.z; hv[4 * g + 3] = t.w; s += (int)(t.x + t.y + t.z + t.w); }
    int suf = s;
#pragma unroll
    for (int o = 1; o < 64; o <<= 1) { const int t = shfl_i_(suf, lane + o); if (lane + o < 64) suf += t; }
    if (total) *total = __builtin_amdgcn_readfirstlane(suf);
    const int excl = suf - s; const bool hit = (excl < K) && (K <= suf);
    int b = 0, c = excl, nb = 0; bool done = false;
#pragma unroll
    for (int k = NB4 * 4 - 1; k >= 0; --k) { if (!done) { if (c + (int)hv[k] >= K) { b = k; nb = (int)hv[k]; done = true; } else c += (int)hv[k]; } }
    const unsigned long long m = __ballot(hit); const int src = m ? (int)__builtin_ctzll(m) : 0;
    bin = __builtin_amdgcn_readlane(NB4 * 4 * lane + b, src); above = __builtin_amdgcn_readlane(c, src); inbin = __builtin_amdgcn_readlane(nb, src);
    if (!m) { bin = 0; above = 0; inbin = 0; }
}
#define DSA_ONE_TILE(KF, I, ...) do { const int i = (I); float sc[16]; { bf16x8 kfr[4]; dsa_kfrag(kfr, KF, ktile, F.lane); dsa_scores(qf, kfr, w, sc); } \
        if (i == j) { constexpr bool DIAG = true; __VA_ARGS__ } else { constexpr bool DIAG = false; __VA_ARGS__ } } while (0)
#define DSA_TILE_LOOP_S(STRIDE, ...) do { bf16x8 ka[4], kb[4]; int i0 = F.wave; \
    { const int ia = i0 <= j ? i0 : 0, ib = i0 + (STRIDE) <= j ? i0 + (STRIDE) : ia; dsa_ldk(ka, kbase + (size_t)ia * 32 * 64); dsa_ldk(kb, kbase + (size_t)ib * 32 * 64); } \
    _Pragma("unroll 1") for (; i0 <= j; i0 += 2 * (STRIDE)) { bf16x8 na[4], nb[4]; \
        { const int ia = i0 + 2 * (STRIDE) <= j ? i0 + 2 * (STRIDE) : i0, ib = i0 + 3 * (STRIDE) <= j ? i0 + 3 * (STRIDE) : i0; dsa_ldk(na, kbase + (size_t)ia * 32 * 64); dsa_ldk(nb, kbase + (size_t)ib * 32 * 64); } \
        __builtin_amdgcn_sched_barrier(0); \
        DSA_ONE_TILE(ka, i0, __VA_ARGS__); \
        if (i0 + (STRIDE) <= j) DSA_ONE_TILE(kb, i0 + (STRIDE), __VA_ARGS__); \
        _Pragma("unroll") for (int ks = 0; ks < 4; ++ks) { ka[ks] = na[ks]; kb[ks] = nb[ks]; } } } while (0)
#define DSA_TILE_LOOP(...) DSA_TILE_LOOP_S(NWAVES, __VA_ARGS__)
#define DSA_VALID(r) (!DIAG || ((r) & 3) + 8 * ((r) >> 2) <= qlim)
__device__ __forceinline__ void dsa_mask_unit(const Frame& F_, int b, int j, const bf16* P, const bf16* KIDX, const float* FW, unsigned long long* selw) { Frame F = F_; F.lane = lane_id_(); F.tid = F.wave * 64 + F.lane;
    LAS unsigned* HIST = (LAS unsigned*)(F.lds + RING_OFF + DS_HIST);
    LAS unsigned* GT = (LAS unsigned*)(F.lds + RING_OFF + DS_GT);
    LAS unsigned* EQ = (LAS unsigned*)(F.lds + RING_OFF + DS_EQ);
    LAS int* SM = (LAS int*)(F.lds + RING_OFF + DS_SM); volatile LAS unsigned* PRB = (volatile LAS unsigned*)(F.lds + LDSCTL_OFF + 512);
    PROBE_BEGIN(1);
    const int r32 = F.lane & 31, hi = F.lane >> 5, t0 = j * 32; const size_t brow = (size_t)b * SEQ;
    bf16x8 qf[4][4];
#pragma unroll
    for (int hh = 0; hh < 4; ++hh)
#pragma unroll
        for (int ks = 0; ks < 4; ++ks) qf[hh][ks] = *(const bf16x8*)(P + (brow + t0 + r32) * PS + C_IQ + hh * 64 + ks * 16 + hi * 8);
    float w[4]; { const f32x4 wv = *(const f32x4*)(FW + (brow + t0 + r32) * 8 + 4); w[0] = wv.x; w[1] = wv.y; w[2] = wv.z; w[3] = wv.w; }
    const bf16* kbase = KIDX + brow * 64 + F.lane * 8;
    LAS unsigned char* ktile = F.lds + RING_OFF + DS_KT + F.wave * 4096;
    const int qlim = r32 - 4 * hi;
    LAS unsigned* hrow = HIST + r32 * 512;
#define DSA_ZERO_HIST() do { const unsigned z_ = (unsigned)opaque_i(0); for (int e = F.tid; e < 4096; e += NWAVES * 64) ((LAS v4u*)HIST)[e] = (v4u){z_, z_, z_, z_}; } while (0)
    DSA_ZERO_HIST();
    if (F.tid < 64) SM[128 + F.tid] = 0;
    __syncthreads();
    PROBE_END(1); PROBE_BEGIN(2);
#if REP_PHASE == 41
    { float dummy = 0.f; DSA_TILE_LOOP({ _Pragma("unroll") for (int r = 0; r < 16; ++r) dummy += sc[r]; }); if (dummy == 12345.678f) SM[170] = 1; }
#endif
#if REP_PHASE == 42
    { LAS unsigned* drow = EQ + (r32 & 7) * 512; DSA_TILE_LOOP({ _Pragma("unroll") for (int r = 0; r < 16; ++r) { const int kh = key28_(sc[r]) >> 19; if (DSA_VALID(r)) __hip_atomic_fetch_add(drow + kh, 1u, __ATOMIC_RELAXED, __HIP_MEMORY_SCOPE_WORKGROUP); } }); }
#endif
#if REP_PHASE == 43
    { DSA_ZERO_HIST(); __syncthreads(); for (int q = F.wave * 4; q < F.wave * 4 + 4; ++q) { int bin, above, inbin; hist_scan<2>(HIST + q * 512, 256, F.lane, bin, above, inbin); if (F.lane == 0) SM[171] = bin; } __syncthreads(); __syncthreads(); __syncthreads(); }
#endif
    DSA_TILE_LOOP({ _Pragma("unroll")
        for (int r = 0; r < 16; ++r) { const int kh = key9_(sc[r]); if (DSA_VALID(r)) __hip_atomic_fetch_add(hrow + kh, 1u, __ATOMIC_RELAXED, __HIP_MEMORY_SCOPE_WORKGROUP); } });
    __syncthreads();
    PROBE_END(2); PROBE_BEGIN(3);
#pragma unroll 1
    for (int q = F.wave * 4; q < F.wave * 4 + 4; ++q) { int bin, above, inbin; hist_scan<2>(HIST + q * 512, 256, F.lane, bin, above, inbin);
        if (F.lane == 0) { const int total = t0 + q + 1;
            if (total <= 256) { SM[q] = -1; SM[32 + q] = 0; SM[64 + q] = 0; SM[96 + q] = 0; }
            else { SM[q] = bin; SM[32 + q] = above; SM[64 + q] = inbin; SM[96 + q] = 256 - above; if (inbin > DS_CAP) SM[160] = 1; } } }
    __syncthreads();
    PROBE_END(3); PROBE_BEGIN(4);
    const int myb1 = SM[r32];
    if (SM[160] == 0) {
        const float lge = key28_lbound((long long)myb1 << 19), lgt = key28_lbound(((long long)myb1 + 1) << 19);
        LAS unsigned* lrow = HIST + r32 * DS_CAP;
        DSA_TILE_LOOP({ unsigned gtw = 0u; unsigned cw = 0u; _Pragma("unroll")
            for (int r = 0; r < 16; ++r) { const int bit = (r & 3) + 8 * (r >> 2); const bool valid = DSA_VALID(r);
                if (valid && sc[r] >= lgt) gtw |= 1u << bit; else if (valid && sc[r] >= lge) cw |= 1u << r; }
            if (cw) {
                LAS float* sl = (LAS float*)ktile + F.lane; _Pragma("unroll")
                for (int r = 0; r < 16; ++r) sl[r * 64] = sc[r];
                int slot = (int)__hip_atomic_fetch_add((LAS unsigned*)SM + 128 + r32, (unsigned)__popc(cw), __ATOMIC_RELAXED, __HIP_MEMORY_SCOPE_WORKGROUP);
                while (cw) { const int r = __builtin_ctz(cw); cw &= cw - 1u; const float sv = sl[r * 64]; const int bit = (r & 3) + 8 * (r >> 2);
                    if (slot < DS_CAP) lrow[slot] = ((unsigned)(key28_(sv) & 0x7FFFF) << 12) | (unsigned)(4095 - (i * 32 + bit + 4 * hi)); ++slot; } }
            gtw <<= 4 * hi; gtw |= (unsigned)shfl_i_((int)gtw, F.lane ^ 32);
            if (hi == 0) GT[i * 32 + r32] = gtw; });
        __syncthreads();
        PROBE_END(4); PROBE_BEGIN(5);
#pragma unroll 1
        for (int q = F.wave * 4; q < F.wave * 4 + 4; ++q) { const int n = SM[128 + q] < DS_CAP ? SM[128 + q] : DS_CAP, quota = SM[96 + q]; const LAS unsigned* lq = HIST + q * DS_CAP;
            for (int c0 = 0; c0 < n; c0 += 64) { const int ci = c0 + F.lane; const unsigned e = ci < n ? lq[ci] : 0xffffffffu; int rank = 0;
                int k = 0;
                for (; k + 16 <= n; k += 16) { const v4u c0 = *(const LAS v4u*)(lq + k), c1 = *(const LAS v4u*)(lq + k + 4), c2 = *(const LAS v4u*)(lq + k + 8), c3 = *(const LAS v4u*)(lq + k + 12);
                    rank += (c0.x > e ? 1 : 0) + (c0.y > e ? 1 : 0) + (c0.z > e ? 1 : 0) + (c0.w > e ? 1 : 0) + (c1.x > e ? 1 : 0) + (c1.y > e ? 1 : 0) + (c1.z > e ? 1 : 0) + (c1.w > e ? 1 : 0)
                          + (c2.x > e ? 1 : 0) + (c2.y > e ? 1 : 0) + (c2.z > e ? 1 : 0) + (c2.w > e ? 1 : 0) + (c3.x > e ? 1 : 0) + (c3.y > e ? 1 : 0) + (c3.z > e ? 1 : 0) + (c3.w > e ? 1 : 0); }
                for (; k < n; ++k) rank += (lq[k] > e) ? 1 : 0;
                if (ci < n && rank < quota) { const int idx = 4095 - (int)(e & 4095u); __hip_atomic_fetch_or(GT + (idx >> 5) * 32 + q, 1u << (idx & 31), __ATOMIC_RELAXED, __HIP_MEMORY_SCOPE_WORKGROUP); } } }
        __syncthreads();
    } else {
        DSA_ZERO_HIST();
        __syncthreads();
        DSA_TILE_LOOP({ _Pragma("unroll")
            for (int r = 0; r < 16; ++r) { const int k = key28_(sc[r]); if ((k >> 19) == myb1 && DSA_VALID(r)) __hip_atomic_fetch_add(hrow + ((k >> 11) & 255), 1u, __ATOMIC_RELAXED, __HIP_MEMORY_SCOPE_WORKGROUP); } });
        __syncthreads();
#pragma unroll 1
        for (int q = F.wave * 4; q < F.wave * 4 + 4; ++q) { int bin, above, inbin; const int b1 = SM[q], ab1 = SM[32 + q]; hist_scan<1>(HIST + q * 512, 256 - ab1, F.lane, bin, above, inbin);
            if (F.lane == 0) { if (b1 < 0) { SM[192 + q] = -1; SM[96 + q] = 0; SM[224 + q] = 0; }
                else { const int quota = 256 - (ab1 + above); SM[192 + q] = (b1 << 8) | bin; SM[96 + q] = quota; SM[224 + q] = inbin; if (quota < inbin) SM[161] = 1; } } }
        __syncthreads();
        const int thr = SM[192 + r32]; const bool allacc = SM[96 + r32] >= SM[224 + r32];
        const float lge = key28_lbound((long long)thr << 11), lgt = key28_lbound(((long long)thr + 1) << 11);
        DSA_TILE_LOOP({ unsigned gtw = 0u; unsigned gew = 0u; _Pragma("unroll")
            for (int r = 0; r < 16; ++r) { const int bit = (r & 3) + 8 * (r >> 2); const bool valid = DSA_VALID(r);
                if (valid && sc[r] >= lgt) gtw |= 1u << bit; if (valid && sc[r] >= lge) gew |= 1u << bit; }
            gtw <<= 4 * hi; gew <<= 4 * hi;
            gtw |= (unsigned)shfl_i_((int)gtw, F.lane ^ 32); gew |= (unsigned)shfl_i_((int)gew, F.lane ^ 32);
            unsigned eqw = gew & ~gtw;
            if (allacc) { gtw = gew; eqw = 0u; }
            if (hi == 0) GT[i * 32 + r32] = gtw; else EQ[i * 32 + r32] = eqw; });
        __syncthreads();
        if (SM[161] != 0 && F.tid < 32) { const int q = F.tid; const int quota = SM[96 + q]; if (quota < SM[224 + q]) { int run = 0;
                for (int i = 0; i <= j; ++i) { unsigned e = EQ[i * 32 + q]; if (e) { const int allowed = quota - run; if (allowed <= 0) e = 0u; else { int pc = __popc(e); while (pc > allowed) { e &= ~(0x80000000u >> __clz(e)); --pc; } }
                        run += __popc(e); GT[i * 32 + q] |= e; } } } }
        __syncthreads();
    }
    PROBE_END(5); PROBE_BEGIN(6);
    { const int ntile64 = 4 * (j / 8 + 1); unsigned long long* dst = selw + (size_t)b * 64 * SEQ + t0;
      for (int e = F.tid; e < ntile64 * 32; e += NWAVES * 64) { const int T = e >> 5, q = e & 31; const unsigned lo = (2 * T <= j) ? GT[(2 * T) * 32 + q] : 0u, up = (2 * T + 1 <= j) ? GT[(2 * T + 1) * 32 + q] : 0u;
          dst[(size_t)T * SEQ + q] = ((unsigned long long)up << 32) | lo; } }
    __syncthreads();
    PROBE_END(6);
}
#undef DSA_TILE_LOOP
#undef DSA_ZERO_HIST
#undef DSA_TILE_LOOP_S
#undef DSA_ONE_TILE
#undef DSA_VALID
__device__ __forceinline__ void ln1_router_phase(const Frame& F_, const Args& a, int l, bool dry = false) { Frame F = F_; F.lane = lane_id_(); F.tid = F.wave * 64 + F.lane;
    LAS float* RW = (LAS float*)(F.lds + RING_OFF);
    LAS int* LC = (LAS int*)(F.lds + RING_OFF + 81920);
    LAS int* LTOK = LC + 64;
    LAS int* LCLS = LTOK + 128; LAS int* LPOS = LCLS + 128; LAS float* LGA = (LAS float*)(LPOS + 128); LAS float* LGB = LGA + 128;
    volatile LAS unsigned* PRB = (volatile LAS unsigned*)(F.lds + LDSCTL_OFF + 512);
    PROBE_BEGIN(31);
    const float* rg = a.in[16] + (size_t)l * DM * 4; const float* re = a.in[18] + (size_t)l * DM * 16;
    for (int e = F.tid; e < DM * 4; e += NWAVES * 64) { const int k = e >> 2, c = e & 3, ln = (k & 255) >> 2, kidx = (k >> 8) * 4 + (k & 3); RW[((kidx * 5 + 0) * 64 + ln) * 4 + c] = rg[e]; }
    for (int e = F.tid; e < DM * 16; e += NWAVES * 64) { const int k = e >> 4, c = 4 + (e & 15), ln = (k & 255) >> 2, kidx = (k >> 8) * 4 + (k & 3); RW[((kidx * 5 + (c >> 2)) * 64 + ln) * 4 + (c & 3)] = re[e]; }
    if (F.tid < 64) LC[F.tid] = 0;
    __syncthreads();
    PROBE_END(31); PROBE_BEGIN(32);
    const float* rgb = a.in[17] + l * 4; const float* reb = a.in[19] + l * 16;
    const float* g1 = a.in[14] + (size_t)l * DM; const float* b1 = a.in[15] + (size_t)l * DM;
    int* list = (int*)(F.ws + WS_LIST); float* gwl = (float*)(F.ws + WS_GWL);
    const int rows_per_blk = NTOK / F.G;
    LnGB gb; ln_gb_load(F, g1, b1, gb);
    float rb[20];
#pragma unroll
    for (int c = 0; c < 4; ++c) rb[c] = rgb[c];
#pragma unroll
    for (int c = 0; c < 16; ++c) rb[4 + c] = reb[c];
    const bf16* V1 = wsb(F, WS_R2);
    f32x4 nx[4]; ln_load_bf(F, V1 + (size_t)(F.vcu * rows_per_blk + F.wave) * DM, nx);
    for (int rr = F.wave; rr < rows_per_blk; rr += NWAVES) { const int m = F.vcu * rows_per_blk + rr; f32x4 v[4];
#pragma unroll
        for (int j = 0; j < 4; ++j) v[j] = nx[j];
        if (rr + NWAVES < rows_per_blk) ln_load_bf(F, V1 + (size_t)(m + NWAVES) * DM, nx);
        ln_row(F, gb, nullptr, wsb(F, WS_HB) + (size_t)m * DM, v, dry, F.ws + WS_HB8 + (size_t)m * DM);
        float gl[4] = {0.f, 0.f, 0.f, 0.f};
#pragma unroll
        for (int jj = 0; jj < 4; ++jj)
#pragma unroll
            for (int k = 0; k < 4; ++k) { const f32x4 wv = *(const LAS f32x4*)(RW + (((jj * 4 + k) * 5) * 64 + F.lane) * 4); const float xv = v[jj][k];
                gl[0] += xv * wv.x; gl[1] += xv * wv.y; gl[2] += xv * wv.z; gl[3] += xv * wv.w; }
        int gi = 0; float gm;
#pragma unroll
        for (int c = 0; c < 4; ++c) gl[c] = wave_sum(gl[c]) + rb[c];
        gm = gl[0];
#pragma unroll
        for (int c = 1; c < 4; ++c) if (gl[c] > gm) { gm = gl[c]; gi = c; }
        float gs = 0.f;
#pragma unroll
        for (int c = 0; c < 4; ++c) gs += expf(gl[c] - gm);
        const float pg = 1.f / gs;
        float el[4] = {0.f, 0.f, 0.f, 0.f};
        { const LAS float* wg = RW + ((1 + gi) * 64 + F.lane) * 4;
#pragma unroll
          for (int jj = 0; jj < 4; ++jj)
#pragma unroll
            for (int k = 0; k < 4; ++k) { const f32x4 wv = *(const LAS f32x4*)(wg + ((jj * 4 + k) * 5) * 256); const float xv = v[jj][k];
                el[0] += xv * wv.x; el[1] += xv * wv.y; el[2] += xv * wv.z; el[3] += xv * wv.w; } }
#pragma unroll
        for (int c = 0; c < 4; ++c) { float bsel = rb[4 + c];
#pragma unroll
            for (int g = 1; g < 4; ++g) if (gi == g) bsel = rb[4 + 4 * g + c];
            el[c] = wave_sum(el[c]) + bsel; }
        int i1 = 0; float m1 = el[0];
#pragma unroll
        for (int c = 1; c < 4; ++c) if (el[c] > m1) { m1 = el[c]; i1 = c; }
        int i2 = -1; float m2 = -INFINITY;
#pragma unroll
        for (int c = 0; c < 4; ++c) if (c != i1 && el[c] > m2) { m2 = el[c]; i2 = c; }
        const float e2 = expf(m2 - m1); const float p1 = 1.f / (1.f + e2), p2 = e2 / (1.f + e2);
        const int ia = i1 < i2 ? i1 : i2, ib = i1 < i2 ? i2 : i1; const float ga = pg * (i1 < i2 ? p1 : p2), gb = pg * (i1 < i2 ? p2 : p1);
        const int pidx = ia == 0 ? ib - 1 : (ia == 1 ? ib + 1 : 5); const int cls = gi * 6 + pidx;
        if (F.lane == 0) { const int pos = __hip_atomic_fetch_add(&LC[cls], 1, __ATOMIC_RELAXED, __HIP_MEMORY_SCOPE_WORKGROUP); LTOK[rr] = m; LCLS[rr] = cls; LPOS[rr] = pos; LGA[rr] = ga; LGB[rr] = gb; }
    }
    __syncthreads();
    PROBE_END(32);
    if (dry) return;
    PROBE_BEGIN(33);
    if (F.tid < NCLS) { const int n = LC[F.tid]; LC[32 + F.tid] = n ? (int)atomicAdd((unsigned*)(F.ctl + CW_CNT + (l * NCLS + F.tid) * 64), (unsigned)n) : 0; }
    __syncthreads();
    for (int rr = F.tid; rr < rows_per_blk; rr += NWAVES * 64) { const int cls = LCLS[rr], pos = LC[32 + cls] + LPOS[rr];
        list[(size_t)cls * NTOK + pos] = LTOK[rr]; gwl[((size_t)cls * NTOK + pos) * 2] = LGA[rr]; gwl[((size_t)cls * NTOK + pos) * 2 + 1] = LGB[rr]; }
    __syncthreads();
    PROBE_END(33);
}
__device__ __forceinline__ void ln2_phase(const Frame& F_, const Args& a, int l, bool dry = false) { Frame F = F_; F.lane = lane_id_(); F.tid = F.wave * 64 + F.lane;
    const float* g2 = a.in[23] + (size_t)l * DM; const float* b2 = a.in[24] + (size_t)l * DM; const bf16* V2 = wsb(F, WS_R1); const bool last = (l == DEPTH - 1);
    const int gw = F.vcu * NWAVES + F.wave, NGW = F.G * NWAVES;
    LnGB gb; ln_gb_load(F, g2, b2, gb);
    f32x4 nx[4]; ln_load_bf(F, V2 + (size_t)gw * DM, nx);
    for (int m = gw; m < NTOK; m += NGW) { f32x4 v[4];
#pragma unroll
        for (int j = 0; j < 4; ++j) v[j] = nx[j];
        if (m + NGW < NTOK) ln_load_bf(F, V2 + (size_t)(m + NGW) * DM, nx);
        ln_row(F, gb, last ? F.out + (size_t)m * DM : nullptr, wsb(F, WS_HB) + (size_t)m * DM, v, dry, last ? nullptr : F.ws + WS_HB8 + (size_t)m * DM); }
}
__device__ __forceinline__ void moe_table(const Frame& F, int l, LAS int* tab) {
    const int tid = F.wave * 64 + lane_id_();
    if (tid < NCLS) tab[tid] = (int)__hip_atomic_load(F.ctl + CW_CNT + (l * NCLS + tid) * 64, RLX_AGENT);
    __syncthreads();
    if (tid == 0) { int s = 0; for (int c = 0; c < NCLS; ++c) { tab[32 + c] = s; s += (tab[c] + 255) >> 8; } tab[32 + NCLS] = s; tab[57] = s; }
    __syncthreads();
}
#define NREP(k) (((REP_PHASE) == (k) || ((k) == 4 && ((REP_PHASE) == 60 || (REP_PHASE) == 61))) ? 2 : 1)
#define DRY(k) ((REP_PHASE) == (k) && rep_ == 0 && args.ph_hi != 7777)
#ifndef MK_PER_PHASE
#define MK_PER_PHASE 0
#endif
constexpr int PH_PER_LAYER = 9, N_PHASES = 1 + DEPTH * PH_PER_LAYER;
__global__ void __launch_bounds__(NWAVES * 64, 2) fwd_kernel(Args args) {
    extern __shared__ __attribute__((aligned(16))) unsigned char lds[];
    Frame F0; Frame& F = F0;
    F.lds = (LAS unsigned char*)lds; F.ldsg = lds;
    F.MISC = (volatile LAS unsigned*)(F.lds + MISC_OFF);
    F.wave = __builtin_amdgcn_readfirstlane((int)threadIdx.x >> 6); F.lane = lane_id_(); F.tid = F.wave * 64 + F.lane;
    F.G = gridDim.x; { const int bx = blockIdx.x; F.vcu = (F.G % 8 == 0) ? (bx % 8) * (F.G / 8) + bx / 8 : bx; }
    F.ws = args.ws; F.out = args.out; F.ctl = (gu32*)(args.ws + WS_CTL);
    for (int u = F0.tid; u < (LDS_BYTES - LDSCTL_OFF) / 4; u += NWAVES * 64) ((LAS unsigned*)(F.lds + LDSCTL_OFF))[u] = 0u;
    __syncthreads();
    XcdBarrier bar; bar.bar = (unsigned*)(F.ctl + CW_BAR); bar.x = 0; bar.st = nullptr;
    if (!MK_PER_PHASE) bar = xcd_barrier_post((unsigned*)(F.ctl + CW_BAR), F.MISC + 8);
    const int lo = MK_PER_PHASE ? args.ph_lo : 0, hi = MK_PER_PHASE ? args.ph_hi : N_PHASES;
#define IN(k) (lo <= (k) && (k) < hi)
#ifndef PH_ONLY
#define PH_ONLY -1
#endif
#define EN(k) (PH_ONLY < 0 || PH_ONLY == (k))
#define SEAM(k) do { if (IN(k) && IN((k) + 1)) { PROBE_BEGIN(20); xcd_barrier(bar, F0.wave); PROBE_END(20); } } while (0)
    volatile LAS unsigned* PRB = (volatile LAS unsigned*)(F0.lds + LDSCTL_OFF + 512);
    LAS int* TAB = (LAS int*)(F.lds + LDSCTL_OFF + 64);
    bf16* const HB = wsb(F, WS_HB); bf16* const P = wsb(F, WS_R1); bf16* const MIX = wsb(F, WS_R1); bf16* const BR = wsb(F, WS_R2); bf16* const ACT = wsb(F, WS_R2);
    float* const FW = (float*)(F.ws + WS_FW); float* const BIAS2 = (float*)(F.ws + WS_BIAS2); unsigned long long* const SELW = (unsigned long long*)(F.ws + WS_SELW);

#define FRESH(Fn) Frame Fn = F0; Fn.vcu = opaque_s(F0.vcu); Fn.wave = opaque_s(F0.wave); Fn.lane = lane_id_(); Fn.tid = Fn.wave * 64 + Fn.lane
    for (int rep_ = 0; rep_ < ((REP_PHASE) == 10 ? 2 : 1); ++rep_) if (EN(0) && IN(0)) { FRESH(Fp); p0_prologue(Fp, args); }
    SEAM(0);
#pragma unroll 1
    for (int l0 = 0; l0 < DEPTH; ++l0) {
        const int pb = 1 + PH_PER_LAYER * l0;
#define l opaque_s(l0)
#define W (wsb(F, WS_W + (size_t)l * W_LAYER))
        for (int rep_ = 0; rep_ < NREP(1); ++rep_) if (EN(1) && IN(pb)) {
            constexpr unsigned M8 = A_F8_TILES; unsigned map8 = 0, map16 = 0; int n8 = 0, n16 = 0;
            for (int q = 0; q < 9; ++q) { if ((M8 >> q) & 1) { map8 |= (unsigned)q << (4 * n8); ++n8; } else { map16 |= (unsigned)q << (4 * n16); ++n16; } }
            const int bx_ = opaque_s((int)blockIdx.x);
            if (n8 > 0) { SchedAT<true> S; S.T.init(NTOK / 256, n8, F.G, bx_); S.A = (const char*)(F.ws + WS_HB8); S.B = (const char*)W + W_SM8; S.map = map8;
                EpiAT<true> E{P, FW, wsb(F, WS_KIDX)}; pg8::gemm_phase<EpiAT<true>, SchedAT<true>, false>(F.lds + RING_OFF, (LAS unsigned*)(F.lds + LDSCTL_OFF + 1024), F0.wave, S, E); }
            if (n16 > 0) { SchedAT<false> S; S.T.init(NTOK / 256, n16, F.G, (bx_ + F.G - ((NTOK / 256) * n8) % F.G) % F.G);
                S.A = (const char*)HB; S.B = (const char*)(W + W_SM / 2); S.map = map16;
                EpiAT<false> E{P, FW, wsb(F, WS_KIDX)}; pg8::gemm_phase<EpiAT<false>, SchedAT<false>, false>(F.lds + RING_OFF, (LAS unsigned*)(F.lds + LDSCTL_OFF + 1024), F0.wave, S, E); } }
        SEAM(pb);
        for (int rep_ = 0; rep_ < NREP(2); ++rep_) if (EN(2) && IN(pb + 1)) { FRESH(Fp);
#ifndef NO_CUMSUM
            if (Fp.vcu < 32 && Fp.wave == 0) fox_cumsum(Fp, Fp.vcu, FW, args.in[4] + l * 4, BIAS2);
#endif
#ifndef NO_POOL
            for (int rp_ = 0; rp_ < ((REP_PHASE) == 21 ? 2 : 1); ++rp_) for (int k = 0; k < 2; ++k) pool_unit(Fp, Fp.vcu * 2 + k, P, args.in[6] + (size_t)l * 4 * 64 * 64, args.in[7] + (size_t)l * 256, BR);
#endif
#ifndef NO_CONV
            for (int rp_ = 0; rp_ < ((REP_PHASE) == 22 ? 2 : 1); ++rp_) for (int k = 0; k < 4; ++k) conv_unit(Fp, Fp.vcu * 4 + k, P, args.in[8] + (size_t)l * 31 * 256, args.in[9] + (size_t)l * 256, args.in[10] + (size_t)l * 256, args.in[11] + (size_t)l * 256, BR);
#endif
#ifndef NO_DSA
            { const int b = Fp.vcu >> 5, s = Fp.vcu & 31;
#pragma unroll 1
              for (int k = 0; k < ((REP_PHASE) == 23 ? 8 : 4); ++k) { const int j = (k & 3) == 0 ? 127 - s : ((k & 3) == 1 ? 64 + s : ((k & 3) == 2 ? 63 - s : s)); dsa_mask_unit(Fp, b, j, P, wsb(F, WS_KIDX), FW, SELW); } }
#endif
        }
        SEAM(pb + 1);
        for (int rep_ = 0; rep_ < NREP(3); ++rep_) if (EN(3) && IN(pb + 2)) { const int vc_ = opaque_s(F0.vcu); const int sg = vc_ >> 3, s = vc_ & 7, b = sg >> 2, h = sg & 3; const size_t rb = (size_t)b * SEQ;
            const attn_body::bf16* Pb = (const attn_body::bf16*)P + rb * PS; attn_body::bf16* Ob = (attn_body::bf16*)BR + rb * DM;
#pragma unroll 1
            for (int k = 0; k < ((REP_PHASE) == 31 ? 4 : 2); ++k) { const int qb = (k & 1) == 0 ? 15 - s : s;
                attn_body::attn_unit<24, false>(qb * 256, Pb + C_FQ + h * 64, Pb + C_FK + h * 64, Pb + C_FV + h * 64, Ob + 256 + h * 64, BIAS2 + (size_t)(b * 4 + h) * SEQ, 0.f, nullptr, (char*)lds + RING_OFF, F0.wave); }
            const float slope2 = exp2f(-2.f * (float)(h + 1)) * LOG2E;
#pragma unroll 1
            for (int k = 0; k < ((REP_PHASE) == 32 ? 4 : 2); ++k) { const int qb = (k & 1) == 0 ? 15 - s : s;
                attn_body::attn_unit<24, true>(qb * 256, Pb + C_DQ + h * 64, Pb + C_DK, Pb + C_DV, Ob + 512 + h * 64, nullptr, slope2, SELW + (size_t)b * 64 * SEQ, (char*)lds + RING_OFF, F0.wave); }
        }
        SEAM(pb + 2);
        for (int rep_ = 0; rep_ < NREP(4); ++rep_) if (EN(4) && IN(pb + 3)) { SchedC S; S.T.init(NTOK / 256, DM / 128, F.G, opaque_s((int)blockIdx.x)); S.HBp = (const char*)(F.ws + WS_HB8); S.BRp = (const char*)BR; S.WGp = (const char*)(W + W_GT / 2); S.WBp = (const char*)(W + W_BR / 2); S.collapse = ((REP_PHASE) == 61 && rep_ == 0 && args.ph_hi != 7777);
            EpiC E; E.dry = (((REP_PHASE) == 60 || (REP_PHASE) == 61) && rep_ == 0 && args.ph_hi != 7777); E.MIX = MIX; E.bgate = args.in[5] + (size_t)l * 4 * DM; pg8::gemm_phase_c8<EpiC, SchedC>(F.lds + RING_OFF, F0.wave, S, E); }
        SEAM(pb + 3);
        for (int rep_ = 0; rep_ < NREP(5); ++rep_) if (EN(5) && IN(pb + 4)) { SchedC2 S; S.T.init(NTOK / 256, DM / 256, F.G, opaque_s((int)blockIdx.x)); S.A = (const char*)MIX; S.B = (const char*)(W + W_OUT / 2);
            EpiRes E{BR  , HB, DRY(5)}; pg8::gemm_phase<EpiRes, SchedC2, false>(F.lds + RING_OFF, (LAS unsigned*)(F.lds + LDSCTL_OFF + 1024), F0.wave, S, E); }
        SEAM(pb + 4);
        for (int rep_ = 0; rep_ < NREP(6); ++rep_) if (EN(6) && IN(pb + 5)) { FRESH(Fp); PROBE_BEGIN(21); ln1_router_phase(Fp, args, l, DRY(6)); PROBE_END(21); }
        SEAM(pb + 5);
        for (int rep_ = 0; rep_ < NREP(7); ++rep_) if (EN(7) && IN(pb + 6)) { moe_table(F, l, TAB);
            SchedD1 S{TAB, F.G, opaque_s((int)blockIdx.x), (const char*)(F.ws + WS_HB8), (const char*)(W + W_GU / 2), (const int*)(F.ws + WS_LIST)};
            EpiD1 E{(unsigned char*)ACT, (const float*)(F.ws + WS_GWL)}; pg8::gemm_phase<EpiD1, SchedD1, true>(F.lds + RING_OFF, (LAS unsigned*)(F.lds + LDSCTL_OFF + 1024), F0.wave, S, E); }
        SEAM(pb + 6);
        for (int rep_ = 0; rep_ < NREP(8); ++rep_) if (EN(8) && IN(pb + 7)) { moe_table(F, l, TAB);
            SchedD2 S{TAB, F.G, opaque_s((int)blockIdx.x), (const char*)ACT, (const char*)(W + W_D / 2), (const int*)(F.ws + WS_LIST)};
            EpiD2 E{wsb(F, WS_R1), HB, DRY(8)}; pg8::gemm_phase<EpiD2, SchedD2, false>(F.lds + RING_OFF, (LAS unsigned*)(F.lds + LDSCTL_OFF + 1024), F0.wave, S, E); }
        SEAM(pb + 7);
        for (int rep_ = 0; rep_ < NREP(9); ++rep_) if (EN(9) && IN(pb + 8)) { FRESH(Fp); PROBE_BEGIN(22); ln2_phase(Fp, args, l, DRY(9)); PROBE_END(22); }
        SEAM(pb + 8);
#undef l
#undef W
    }
#undef IN
#undef SEAM
    if ((REP_PHASE) >= 100 && blockIdx.x == 0 && F0.wave == 0 && lane_id_() == 0) { volatile LAS unsigned* PRB = (volatile LAS unsigned*)(F0.lds + LDSCTL_OFF + 512); const unsigned long long a_ = (((unsigned long long)PRB[1]) << 32) | PRB[0];
        const unsigned long long t0_ = __builtin_amdgcn_s_memrealtime(); while (__builtin_amdgcn_s_memrealtime() - t0_ < a_) __builtin_amdgcn_s_sleep(8); }
}

extern "C" void kernel_launch(void* const* d_in, const int* in_sizes, int n_in, void* d_out, int out_size, void* d_ws, size_t ws_size, hipStream_t stream) {
    static int grid = 0;
    if (grid == 0) {
        if (n_in != 25 || in_sizes[0] != NTOK * DM || out_size != NTOK * DM || ws_size < WS_END) { fprintf(stderr, "kernel_launch: unexpected shapes (n_in %d, in0 %d, out %d, ws %zu); nothing launched\n", n_in, n_in > 0 ? in_sizes[0] : -1, out_size, ws_size); grid = -1; return; }
        int dev = 0, cus = 0, per_cu = 0;
        if (hipGetDevice(&dev) != hipSuccess || hipDeviceGetAttribute(&cus, hipDeviceAttributeMultiprocessorCount, dev) != hipSuccess) { grid = -1; return; }
        if (hipFuncSetAttribute((const void*)fwd_kernel, hipFuncAttributeMaxDynamicSharedMemorySize, LDS_BYTES) != hipSuccess) { fprintf(stderr, "kernel_launch: hipFuncSetAttribute failed\n"); grid = -1; return; }
        if (hipOccupancyMaxActiveBlocksPerMultiprocessor(&per_cu, (const void*)fwd_kernel, NWAVES * 64, LDS_BYTES) != hipSuccess || per_cu < 1) fprintf(stderr, "kernel_launch: occupancy query reports %d\n", per_cu);
        (void)hipGetLastError();
        grid = cus;
        if (grid != 256) { fprintf(stderr, "kernel_launch: built for 256 CUs, device has %d; nothing launched\n", cus); grid = -1; return; }
    }
    if (grid < 0) return;
    if (hipMemsetAsync((char*)d_ws + WS_CTL, 0, CTL_ZERO_BYTES, stream) != hipSuccess) return;
    Args a{};
    for (int i = 0; i < 25; ++i) a.in[i] = (const float*)d_in[i];
    a.out = (float*)d_out; a.ws = (unsigned char*)d_ws;
#if MK_PER_PHASE
    for (int p = 0; p < N_PHASES; ++p) { a.ph_lo = p; a.ph_hi = p + 1; hipLaunchKernelGGL(fwd_kernel, dim3(grid), dim3(NWAVES * 64), LDS_BYTES, stream, a); }
#else
    a.ph_lo = 0; a.ph_hi = N_PHASES;
    hipLaunchKernelGGL(fwd_kernel, dim3(grid), dim3(NWAVES * 64), LDS_BYTES, stream, a);
#endif
}
```

```cpp
#include <hip/hip_runtime.h>
#include <hip/hip_bf16.h>
#include <cstdio>
#include <cstdint>
#include <cmath>

#ifndef REP_PHASE
#define REP_PHASE 0
#endif
#define PROBE_BEGIN(id) do { if ((REP_PHASE) == 100 + (id) && blockIdx.x == 0) { __syncthreads(); if (F.wave == 0 && lane_id_() == 0) { const unsigned long long t_ = __builtin_amdgcn_s_memrealtime(); PRB[2] = (unsigned)t_; PRB[3] = (unsigned)(t_ >> 32); } } } while (0)
#define PROBE_END(id) do { if ((REP_PHASE) == 100 + (id) && blockIdx.x == 0) { __syncthreads(); if (F.wave == 0 && lane_id_() == 0) { const unsigned long long t_ = __builtin_amdgcn_s_memrealtime() - (((unsigned long long)PRB[3] << 32) | PRB[2]); const unsigned long long a_ = ((((unsigned long long)PRB[1]) << 32) | PRB[0]) + t_; PRB[0] = (unsigned)a_; PRB[1] = (unsigned)(a_ >> 32); } } } while (0)
constexpr int BATCH = 8, SEQ = 4096, DM = 1024, NTOK = BATCH * SEQ, DEPTH = 2;
constexpr int P_TOTAL = 6344, PS = 2304;
constexpr int C_POOL = 0, C_FQ = 256, C_FK = 512, C_FV = 768, C_DQ = 1024, C_IQ = 1280, C_CONV = 1536, C_DK = 2048, C_DV = 2112, C_IK = 2176, C_FF = 2240, C_IW = 2244;
constexpr float LN_EPS = 1e-5f;
constexpr float ALPHA = 1.4142135623730951f;
constexpr float LOG2E = 1.4426950408889634f;
constexpr int NWAVES = 8;
constexpr int NCLS = 24;
constexpr int MAXTILES = NTOK / 256 + NCLS;

constexpr size_t MiB = 1u << 20;
constexpr size_t WS_CTL = 0, CTL_ZERO_BYTES = 1 * MiB;
constexpr size_t WS_FW = 1 * MiB;
constexpr size_t WS_BIAS2 = 2 * MiB;
constexpr size_t WS_LIST = 3 * MiB;
constexpr size_t WS_GWL = 6 * MiB;
constexpr size_t WS_SELW = 12 * MiB;
constexpr size_t WS_HB8 = 28 * MiB;
constexpr size_t WS_W = 60 * MiB;
constexpr size_t W_SM = 0, W_GT = 4718592, W_BR = W_GT + 8 * MiB, W_OUT = W_BR + 2 * MiB, W_GU = W_OUT + 2 * MiB, W_D = W_GU + 32 * MiB, W_LAYER = W_D + 16 * MiB;
constexpr size_t WS_HB = 190 * MiB;
constexpr size_t WS_R1 = 254 * MiB;
constexpr size_t WS_R2 = 398 * MiB;
constexpr size_t WS_KIDX = 474 * MiB;
constexpr size_t WS_END = 478 * MiB;
static_assert(WS_W + 2 * W_LAYER <= WS_HB && WS_R1 + (size_t)NTOK * PS * 2 <= WS_R2 && WS_R2 + (size_t)MAXTILES * 256 * DM * 2 <= WS_END, "d_ws map");
constexpr int CW_BAR = 4096;
constexpr int CW_SEAMC = 8192;
constexpr int CW_CNT = 16384;

constexpr int RING_OFF = 0, RING_BYTES = 131072;
constexpr int LDSCTL_OFF = RING_BYTES, MISC_OFF = LDSCTL_OFF + 320;
constexpr int LDS_BYTES = 147456;

#define GAS __attribute__((address_space(1)))
#define LAS __attribute__((address_space(3)))
typedef unsigned short bf16;
typedef unsigned v4u __attribute__((ext_vector_type(4)));
typedef unsigned v2u __attribute__((ext_vector_type(2)));
typedef float f32x4 __attribute__((ext_vector_type(4)));
typedef float f32x16 __attribute__((ext_vector_type(16)));
typedef short bf16x8 __attribute__((ext_vector_type(8)));
typedef GAS unsigned gu32;
#define RLX_AGENT __ATOMIC_RELAXED, __HIP_MEMORY_SCOPE_AGENT
#define LDS_WAIT() asm volatile("s_waitcnt lgkmcnt(0)" ::: "memory")
#define VM_WAIT() asm volatile("s_waitcnt vmcnt(0)" ::: "memory")
__device__ __forceinline__ int opaque_i(int x) { asm volatile("" : "+v"(x)); return x; }
__device__ __forceinline__ int lane_id_() { int x; asm volatile("v_mbcnt_lo_u32_b32 %0, -1, 0\n\tv_mbcnt_hi_u32_b32 %0, -1, %0" : "=v"(x)); return x; }
__device__ __forceinline__ float zero_() { int z = 0; asm volatile("" : "+v"(z)); return __builtin_bit_cast(float, z); }
__device__ __forceinline__ const char* sptr_(const char* p) { const unsigned long long v = (unsigned long long)p; const unsigned lo = (unsigned)__builtin_amdgcn_readfirstlane((int)(unsigned)v), hi = (unsigned)__builtin_amdgcn_readfirstlane((int)(unsigned)(v >> 32)); return (const char*)(((unsigned long long)hi << 32) | lo); }
__device__ __forceinline__ int shfl_i_(int v, int srclane) { return __builtin_amdgcn_ds_bpermute(srclane << 2, v); }
__device__ __forceinline__ int opaque_s(int x) { asm volatile("" : "+s"(x)); return x; }
__device__ __forceinline__ unsigned f2bf(float f) { unsigned u = __builtin_bit_cast(unsigned, f); return (u + 0x7fffu + ((u >> 16) & 1u)) >> 16; }
__device__ __forceinline__ unsigned pk2(float lo, float hi) { return f2bf(lo) | (f2bf(hi) << 16); }
__device__ __forceinline__ unsigned pk4_fp8(float a, float b, float c, float d) { int r = __builtin_amdgcn_cvt_pk_fp8_f32(a, b, 0, false); r = __builtin_amdgcn_cvt_pk_fp8_f32(c, d, r, true); return (unsigned)r; }
__device__ __forceinline__ float bfl(unsigned w) { return __uint_as_float(w << 16); }
__device__ __forceinline__ float bfh(unsigned w) { return __uint_as_float(w & 0xffff0000u); }
__device__ __forceinline__ float bf1(bf16 h) { return __uint_as_float((unsigned)h << 16); }
__device__ __forceinline__ float sigmoidf_(float x) { return __builtin_amdgcn_rcpf(1.f + __builtin_amdgcn_exp2f(-x * LOG2E)); }

#define XB_TMO      128
#define XB_XCNT(j)  (256  + 64 * (j))
#define XB_XSUB(j)  (1280 + 64 * (j))
#define XB_XGEN(j)  (2304 + 64 * (j))
#define XB_TOP      3328
#define XB_TOPGEN   3392
#define XCD_BAR_WORDS 3456
#define XB_SPIN_CAP (1u << 18)
__device__ __forceinline__ unsigned xb_ld(unsigned* p)              { return __hip_atomic_load(p, __ATOMIC_RELAXED, __HIP_MEMORY_SCOPE_AGENT); }
__device__ __forceinline__ unsigned xb_add(unsigned* p, unsigned v) { return __hip_atomic_fetch_add(p, v, __ATOMIC_RELAXED, __HIP_MEMORY_SCOPE_AGENT); }
__device__ __forceinline__ unsigned xb_xcc_id() { return (unsigned)__builtin_amdgcn_s_getreg((3 << 11) | 20) & 0xFu; }
#define XB_SPIN(cond, bar) do { unsigned _sp = 0; while (cond) { __builtin_amdgcn_s_sleep(1); \
    if ((++_sp & 255u) == 0u) { if (xb_ld(&(bar)[XB_TMO])) break; if (_sp > XB_SPIN_CAP) { atomicAdd(&(bar)[XB_TMO], 1u); break; } } } } while (0)
struct XcdBarrier { unsigned* bar; unsigned x; volatile LAS unsigned* st; };
__device__ __forceinline__ XcdBarrier xcd_barrier_post(unsigned* bar, volatile LAS unsigned* st) {
    XcdBarrier b; b.bar = bar; b.x = xb_xcc_id(); b.st = st;
    if (threadIdx.x == 0) (void)xb_add(&bar[XB_XCNT(b.x)], 1u);
    return b;
}
__device__ __forceinline__ void xcd_barrier_complete(unsigned* bar, unsigned x, unsigned& nloc, unsigned& nx) {
    const unsigned G = gridDim.x * gridDim.y * gridDim.z;
    unsigned sum, cnt, mine, sp = 0u;
    for (;;) {
        sum = 0u; cnt = 0u; mine = 0u;
#pragma unroll
        for (unsigned j = 0; j < 16; ++j) { const unsigned c = xb_ld(&bar[XB_XCNT(j)]); sum += c; cnt += (c > 0u) ? 1u : 0u; mine = (j == x) ? c : mine; }
        if (sum == G) break;
        __builtin_amdgcn_s_sleep(1);
        if ((++sp & 255u) == 0u) { if (xb_ld(&bar[XB_TMO])) break; if (sp > XB_SPIN_CAP) { atomicAdd(&bar[XB_TMO], 1u); break; } }
    }
    nloc = mine > 0u ? mine : 1u; nx = cnt > 0u ? cnt : 1u;
}
__device__ __forceinline__ void xcd_barrier(const XcdBarrier& b, int wave) {
    asm volatile("s_waitcnt vmcnt(0)" ::: "memory");
    __syncthreads();
    if (wave == 0 && lane_id_() == 0) {
        unsigned* bar = b.bar; const unsigned bx = (unsigned)opaque_s((int)xb_xcc_id());
        __builtin_amdgcn_s_waitcnt(0);
        unsigned nloc = b.st[0], nx = b.st[1];
        if (nloc == 0u) { xcd_barrier_complete(bar, bx, nloc, nx); b.st[0] = nloc; b.st[1] = nx; }
        const unsigned old = xb_add(&bar[XB_XSUB(bx)], 1u);
        const unsigned gen = old / nloc;
        if (old + 1u == (gen + 1u) * nloc) {
            __builtin_amdgcn_fence(__ATOMIC_RELEASE, "agent");
            asm volatile("s_waitcnt vmcnt(0)" ::: "memory");
            const unsigned og = xb_add(&bar[XB_TOP], 1u);
            const unsigned tg = og / nx;
            if (og + 1u == (tg + 1u) * nx) xb_add(&bar[XB_TOPGEN], 1u);
            else XB_SPIN(xb_ld(&bar[XB_TOPGEN]) == tg, bar);
            __builtin_amdgcn_fence(__ATOMIC_ACQUIRE, "agent");
            xb_add(&bar[XB_XGEN(bx)], 1u);
            asm volatile("s_waitcnt vmcnt(0)" ::: "memory");
        } else {
            XB_SPIN(xb_ld(&bar[XB_XGEN(bx)]) == gen, bar);
            __builtin_amdgcn_fence(__ATOMIC_ACQUIRE, "agent");
            asm volatile("s_waitcnt vmcnt(0)" ::: "memory");
        }
    }
    __syncthreads();
}
namespace pg8 {
#define PG8_LAS __attribute__((address_space(3)))
typedef unsigned short bf16_t;
typedef short bf16x8 __attribute__((ext_vector_type(8)));
typedef float f32x4 __attribute__((ext_vector_type(4)));
typedef float f32x2 __attribute__((ext_vector_type(2)));
typedef unsigned u32x4 __attribute__((ext_vector_type(4)));
typedef unsigned u32x2 __attribute__((ext_vector_type(2)));
constexpr int BM = 256, BK = 64, HALF = 128, HTB = HALF * BK * 2  , STAGE_BYTES = 8 * HTB, NXCD = 8, WGM = 8;
constexpr int LD = 1024;
constexpr size_t ROWB = 2048;
constexpr size_t HSTEP = (size_t)HALF * ROWB;
constexpr size_t TSTEP = 2 * HSTEP;

__host__ __device__ __forceinline__ int lds_byte(int r, int c) { const int st = (r >> 4) * 2 + (c >> 5), rr = r & 15, cc = c & 31, ob = rr * 64 + cc * 2; return st * 1024 + (ob ^ (((ob >> 9) & 1) << 5)); }
__host__ __device__ __forceinline__ void stage_rc(int b, int& R, int& C) { const int st = b / 1024, sb = b % 1024, swz = sb ^ (((sb >> 9) & 1) << 5); R = (st >> 1) * 16 + swz / 64; C = (st & 1) * 32 + (swz % 64) / 2; }
__host__ __device__ __forceinline__ int perm32(int rho) { const int n = rho >> 4, i = rho & 15; return 8 * (i >> 2) + 4 * n + (i & 3); }

struct GU {
    const char* A;
    const char* B0;
    const char* B1;
    int nt, ks;
    const int* rows;
    int rbase, rcnt;
    int pm, pn, a0, a1;
};

__device__ __forceinline__ unsigned cvt_pk_bf16(float lo, float hi) { unsigned r; asm volatile("v_cvt_pk_bf16_f32 %0, %1, %2" : "=v"(r) : "v"(lo), "v"(hi)); return r; }
__device__ __forceinline__ float bf_lo(unsigned w) { return __uint_as_float(w << 16); }
__device__ __forceinline__ float bf_hi(unsigned w) { return __uint_as_float(w & 0xffff0000u); }

__device__ __forceinline__ void glds16_s(const char* sbase, unsigned voff, unsigned lds_dst) { unsigned keep;
    asm volatile("s_mov_b32 %0, m0\n\ts_mov_b32 m0, %3\n\ts_nop 0\n\tglobal_load_lds_dwordx4 %1, %2\n\ts_mov_b32 m0, %0" : "=&s"(keep) : "v"(voff), "s"(sbase), "s"(lds_dst) : "memory"); }
typedef int v8i_t __attribute__((ext_vector_type(8)));
typedef int v4i_t __attribute__((ext_vector_type(4)));
__device__ __forceinline__ v8i_t cat8(bf16x8 lo, bf16x8 hi) { const v4i_t a = __builtin_bit_cast(v4i_t, lo), b = __builtin_bit_cast(v4i_t, hi); return __builtin_shufflevector(a, b, 0, 1, 2, 3, 4, 5, 6, 7); }
template <class Epi, class Sched, bool GATHER>
__device__ __forceinline__ void gemm_phase(PG8_LAS unsigned char* lds, PG8_LAS unsigned* xlds  , const int wid_in  , const Sched& S, Epi& E) {
    const int wid = opaque_s(wid_in), lane = lane_id_(), tid = wid * 64 + lane, wr = wid >> 2, wc = wid & 3, fr = lane & 15, fq = lane >> 4;
    constexpr bool F8 = Epi::F8;
    constexpr int RP = F8 ? 1024 : 2048;
    constexpr size_t HS = (size_t)HALF * RP;
    unsigned voffB[2], vA[2][2];
#pragma unroll
    for (int i = 0; i < 2; ++i) { int R, C; stage_rc(tid * 16 + i * 8192, R, C); const int Rb = Epi::PERM ? ((R & ~31) + perm32(R & 31)) : R;
        voffB[i] = (unsigned)(Rb * RP + C * 2);
        vA[0][i] = (unsigned)(R * RP + C * 2); vA[1][i] = vA[0][i]; }
    const size_t kstep = (size_t)(BK * 2);
    const unsigned ldsw = (unsigned)wid * 1024u;
    const unsigned ldsb = (unsigned)__builtin_amdgcn_readfirstlane((int)((unsigned)(size_t)lds + (unsigned)wid * 1024u));
    const int aoff8 = lds_byte(wr * 64 + fr, 16 * fq), boff8 = lds_byte(wc * 32 + fr, 16 * fq);
    const int aoff = lds_byte(wr * 64 + fr, fq * 8), boff = lds_byte(wc * 32 + fr, fq * 8);
#define PG8_SA(b, h) (((b) * 2 + (h)) * HTB)
#define PG8_SB(b, h) ((4 + (b) * 2 + (h)) * HTB)
#define PG8_STAGE(bufoff, gbase, voff) do { _Pragma("unroll") for (int _i = 0; _i < 2; ++_i) { \
        if constexpr (F8) glds16_s((const char*)(gbase), (voff)[_i], ldsb + (unsigned)((bufoff) + _i * 8192)); \
        else __builtin_amdgcn_global_load_lds((const unsigned*)((const char*)(gbase) + (voff)[_i]), (PG8_LAS unsigned*)(lds + (bufoff) + ldsw + _i * 8192), 16, 0, 0); } } while (0)
#define PG8_STAGEA(bufoff, gbase, h) do { if constexpr (GATHER) { PG8_STAGE(bufoff, gbase, vA[h]); } else { PG8_STAGE(bufoff, (gbase) + (h) * HS, vA[0]); } } while (0)
#define PG8_LDA(dst, b, h) do { _Pragma("unroll") for (int m = 0; m < 4; ++m) _Pragma("unroll") for (int k = 0; k < 2; ++k) dst[m][k] = *(const PG8_LAS bf16x8*)(lds + PG8_SA(b, h) + (F8 ? aoff8 + k * 16 : aoff + k * 1024) + m * 2048); } while (0)
#define PG8_LDB(dst, b, h) do { _Pragma("unroll") for (int n = 0; n < 2; ++n) _Pragma("unroll") for (int k = 0; k < 2; ++k) dst[n][k] = *(const PG8_LAS bf16x8*)(lds + PG8_SB(b, h) + (F8 ? boff8 + k * 16 : boff + k * 1024) + n * 2048); } while (0)
#define PG8_MMA(ai, bj, At, Bt) do { __builtin_amdgcn_s_setprio(1); _Pragma("unroll") for (int m = 0; m < 4; ++m) _Pragma("unroll") for (int n = 0; n < 2; ++n) { \
        if constexpr (F8) acc[ai][bj][m][n] = __builtin_amdgcn_mfma_scale_f32_16x16x128_f8f6f4(cat8(Bt[n][0], Bt[n][1]), cat8(At[m][0], At[m][1]), acc[ai][bj][m][n], 0, 0, 0, 0, 0, 0); \
        else { _Pragma("unroll") for (int k = 0; k < 2; ++k) acc[ai][bj][m][n] = __builtin_amdgcn_mfma_f32_16x16x32_bf16(Bt[n][k], At[m][k], acc[ai][bj][m][n], 0, 0, 0); } } __builtin_amdgcn_s_setprio(0); } while (0)
#define PG8_WAIT_V(n) asm volatile("s_waitcnt vmcnt(" #n ")" ::: "memory")
#define PG8_WAIT_L(n) asm volatile("s_waitcnt lgkmcnt(" #n ")" ::: "memory")
#define PG8_BAR __builtin_amdgcn_s_barrier()
#define PG8_SCHED __builtin_amdgcn_sched_barrier(0)
#define PG8_KS(u) (Sched::NT > 0 ? Sched::KS : (u).ks)
#define PG8_BP(u, tau) ((tau) < PG8_KS(u) ? (u).B0 + (size_t)(tau) * kstep : (u).B1 + (size_t)((tau) - PG8_KS(u)) * kstep)
#define PG8_GATHER_OFFS(dst, u) do { if constexpr (GATHER) { _Pragma("unroll") for (int _h = 0; _h < 2; ++_h) _Pragma("unroll") for (int _i = 0; _i < 2; ++_i) { \
        int _R, _C; stage_rc((wid * 64 + lane_id_()) * 16 + _i * 8192, _R, _C); int _p = (u).rbase + _h * HALF + _R; _p = _p < (u).rcnt ? _p : (u).rcnt - 1; dst[_h][_i] = (unsigned)(u).rows[_p] * (unsigned)RP + (unsigned)_C * 2u; } } } while (0)
    GU cur, nxt; int ui = 0;
    if (!S.next(0, cur)) return;
    f32x4 acc[2][2][4][2];
#pragma unroll
    for (int a = 0; a < 2; ++a)
#pragma unroll
        for (int b = 0; b < 2; ++b)
#pragma unroll
            for (int m = 0; m < 4; ++m)
#pragma unroll
                for (int n = 0; n < 2; ++n) { const float z_ = zero_(); acc[a][b][m][n] = (f32x4){z_, z_, z_, z_}; }
    bf16x8 At[4][2], B0[2][2], B1[2][2];
    PG8_GATHER_OFFS(vA, cur);
    const char* cA = cur.A;
    { const char* b0 = PG8_BP(cur, 0); const char* b1 = PG8_BP(cur, 1);
      PG8_STAGE(PG8_SB(0, 0), b0, voffB); PG8_STAGE(PG8_SB(0, 1), b0 + HS, voffB); PG8_STAGEA(PG8_SA(0, 0), cA, 0); PG8_STAGEA(PG8_SA(0, 1), cA, 1);
      if (wr == 1) PG8_BAR;
      PG8_WAIT_V(2); PG8_BAR;
      PG8_STAGE(PG8_SB(1, 0), b1, voffB); PG8_STAGEA(PG8_SA(1, 0), cA + kstep, 0); PG8_STAGE(PG8_SB(1, 1), b1 + HS, voffB);
      PG8_WAIT_V(6); PG8_BAR; }
    for (;;) {
        const bool has_next = S.next(ui + 1, nxt);
        if (!has_next) nxt = cur;
        if constexpr (GATHER) { unsigned vn[2][2];
#pragma unroll
            for (int h = 0; h < 2; ++h)
#pragma unroll
                for (int i = 0; i < 2; ++i) vn[h][i] = vA[h][i];
            if (has_next) { PG8_GATHER_OFFS(vn, nxt); }
#pragma unroll
            for (int h = 0; h < 2; ++h)
#pragma unroll
                for (int i = 0; i < 2; ++i) xlds[(h * 2 + i) * 512 + tid] = vn[h][i]; }
        const char* nA = nxt.A;
        const int nt = Sched::NT > 0 ? Sched::NT : cur.nt;
#pragma unroll (Sched::NT > 0 ? 2 : 1)
        for (int t = 0; t < nt; t += 2) {
            const bool last = (t == nt - 2);
            const char* a1 = cA + (size_t)(t + 1) * kstep;
            const char* a2 = last ? nA : cA + (size_t)(t + 2) * kstep;
            const char* b2 = last ? PG8_BP(nxt, 0) : PG8_BP(cur, t + 2);
            const char* a3 = a2 + kstep; const char* b3 = b2 + kstep;
            PG8_LDB(B0, 0, 0); PG8_LDB(B1, 0, 1); PG8_SCHED; PG8_LDA(At, 0, 0); PG8_STAGEA(PG8_SA(1, 1), a1, 1);
            if constexpr (GATHER) { if (last) {
#pragma unroll
                for (int h = 0; h < 2; ++h)
#pragma unroll
                    for (int i = 0; i < 2; ++i) vA[h][i] = xlds[(h * 2 + i) * 512 + tid]; } }
            PG8_WAIT_V(8); PG8_WAIT_L(0); PG8_BAR; PG8_MMA(0, 0, At, B0); PG8_MMA(0, 1, At, B1); PG8_BAR; PG8_SCHED;
            PG8_LDA(At, 0, 1); PG8_STAGE(PG8_SB(0, 0), b2, voffB); PG8_STAGE(PG8_SB(0, 1), b2 + HS, voffB); PG8_STAGEA(PG8_SA(0, 0), a2, 0);
            PG8_WAIT_V(8); PG8_WAIT_L(0); PG8_BAR; PG8_MMA(1, 0, At, B0); PG8_MMA(1, 1, At, B1); PG8_BAR; PG8_SCHED;
            PG8_LDB(B0, 1, 0); PG8_LDB(B1, 1, 1); PG8_SCHED; PG8_LDA(At, 1, 0); PG8_STAGEA(PG8_SA(0, 1), a2, 1);
            PG8_WAIT_V(8); PG8_WAIT_L(0); PG8_BAR; PG8_MMA(0, 0, At, B0); PG8_MMA(0, 1, At, B1); PG8_BAR; PG8_SCHED;
            PG8_LDA(At, 1, 1); PG8_STAGE(PG8_SB(1, 0), b3, voffB); PG8_STAGE(PG8_SB(1, 1), b3 + HS, voffB); PG8_STAGEA(PG8_SA(1, 0), a3, 0);
            PG8_WAIT_V(8); PG8_WAIT_L(0); PG8_BAR; PG8_MMA(1, 0, At, B0); PG8_MMA(1, 1, At, B1); PG8_BAR; PG8_SCHED;
        }
        if (wr == 0) PG8_BAR;
        { const int l2_ = lane_id_(); E(acc, cur, wr, wc, l2_ & 15, l2_ >> 4); }
        if (!has_next) break;
#pragma unroll
        for (int a = 0; a < 2; ++a)
#pragma unroll
            for (int b = 0; b < 2; ++b)
#pragma unroll
                for (int m = 0; m < 4; ++m)
#pragma unroll
                    for (int n = 0; n < 2; ++n) { const float z_ = zero_(); acc[a][b][m][n] = (f32x4){z_, z_, z_, z_}; }
        cur = nxt; cA = nA; ++ui;
        if (wr == 1) PG8_BAR;
    }
    PG8_WAIT_V(0);
    PG8_BAR;
#undef PG8_SA
#undef PG8_SB
#undef PG8_STAGE
#undef PG8_STAGEA
#undef PG8_LDA
#undef PG8_LDB
#undef PG8_MMA
#undef PG8_WAIT_V
#undef PG8_WAIT_L
#undef PG8_BAR
#undef PG8_SCHED
#undef PG8_BP
#undef PG8_KS
#undef PG8_GATHER_OFFS
}

template <class Epi, class Sched>
__device__ __forceinline__ void gemm_phase_n128(PG8_LAS unsigned char* lds, const int wid_in, const Sched& S, Epi& E) {
    const int wid = opaque_s(wid_in), lane = lane_id_(), tid = wid * 64 + lane, wr = wid >> 2, wc = wid & 3, fr = lane & 15, fq = lane >> 4;
    unsigned voffB[2], voffA[2];
#pragma unroll
    for (int i = 0; i < 2; ++i) { int R, C; stage_rc(tid * 16 + i * 8192, R, C); const int Rb = (R & ~31) + perm32(R & 31);
        voffB[i] = (unsigned)(Rb * LD + C) * 2u; voffA[i] = (unsigned)(R * LD + C) * 2u; }
    const size_t kstep = (size_t)(BK * 2);
    const unsigned ldsw = (unsigned)wid * 1024u;
    const int aoff = lds_byte(wr * 64 + fr, fq * 8), boff = lds_byte(wc * 32 + fr, fq * 8);
#define PG8_SA(b, h) (((b) * 2 + (h)) * HTB)
#define PG8_SB(b, h) ((4 + (b) * 2 + (h)) * HTB)
#define PG8_STAGE(bufoff, gbase, voff) do { _Pragma("unroll") for (int _i = 0; _i < 2; ++_i) \
        __builtin_amdgcn_global_load_lds((const unsigned*)((const char*)(gbase) + (voff)[_i]), (PG8_LAS unsigned*)(lds + (bufoff) + ldsw + _i * 8192), 16, 0, 0); } while (0)
#define PG8_LDA(dst, b, h) do { _Pragma("unroll") for (int m = 0; m < 4; ++m) _Pragma("unroll") for (int k = 0; k < 2; ++k) dst[m][k] = *(const PG8_LAS bf16x8*)(lds + PG8_SA(b, h) + aoff + m * 2048 + k * 1024); } while (0)
#define PG8_LDB(dst, b, h) do { _Pragma("unroll") for (int n = 0; n < 2; ++n) _Pragma("unroll") for (int k = 0; k < 2; ++k) dst[n][k] = *(const PG8_LAS bf16x8*)(lds + PG8_SB(b, h) + boff + n * 2048 + k * 1024); } while (0)
#define PG8_MMA(ai, At, Bt) do { __builtin_amdgcn_s_setprio(1); _Pragma("unroll") for (int m = 0; m < 4; ++m) _Pragma("unroll") for (int n = 0; n < 2; ++n) _Pragma("unroll") for (int k = 0; k < 2; ++k) \
        acc[ai][m][n] = __builtin_amdgcn_mfma_f32_16x16x32_bf16(Bt[n][k], At[m][k], acc[ai][m][n], 0, 0, 0); __builtin_amdgcn_s_setprio(0); } while (0)
#define PG8_WAIT_V(n) asm volatile("s_waitcnt vmcnt(" #n ")" ::: "memory")
#define PG8_WAIT_L(n) asm volatile("s_waitcnt lgkmcnt(" #n ")" ::: "memory")
#define PG8_BAR __builtin_amdgcn_s_barrier()
#define PG8_SCHED __builtin_amdgcn_sched_barrier(0)
    GU cur, nxt; int ui = 0;
    if (!S.next(0, cur)) return;
    f32x4 acc[2][4][2];
#pragma unroll
    for (int a = 0; a < 2; ++a)
#pragma unroll
        for (int m = 0; m < 4; ++m)
#pragma unroll
            for (int n = 0; n < 2; ++n) { const float z_ = zero_(); acc[a][m][n] = (f32x4){z_, z_, z_, z_}; }
    bf16x8 At[4][2], B0[2][2];
    u32x4 st_u[2][4], st_s[2][4];
    const char* cA = cur.A; const char* cB = cur.B0;
    PG8_STAGE(PG8_SB(0, 0), cB, voffB); PG8_STAGE(PG8_SA(0, 0), cA, voffA); PG8_STAGE(PG8_SA(0, 1), cA + HSTEP, voffA);
    if (wr == 1) PG8_BAR;
    PG8_WAIT_V(2); PG8_BAR;
    PG8_STAGE(PG8_SB(1, 0), cB + kstep, voffB); PG8_STAGE(PG8_SA(1, 0), cA + kstep, voffA);
    PG8_WAIT_V(4); PG8_BAR;
    for (;;) {
        const bool has_next = S.next(ui + 1, nxt);
        if (!has_next) nxt = cur;
        const char* nA = nxt.A; const char* nB = nxt.B0;
        const int nt = cur.nt;
        for (int t = 0; t < nt; t += 2) {
            const bool last = (t == nt - 2);
            const char* a1 = cA + (size_t)(t + 1) * kstep;
            const char* a2 = last ? nA : cA + (size_t)(t + 2) * kstep;
            const char* b2 = last ? nB : cB + (size_t)(t + 2) * kstep;
            const char* a3 = a2 + kstep; const char* b3 = b2 + kstep;
            PG8_LDB(B0, 0, 0); PG8_SCHED; PG8_LDA(At, 0, 0); PG8_STAGE(PG8_SA(1, 1), a1 + HSTEP, voffA);
            PG8_WAIT_V(6); PG8_WAIT_L(0); PG8_BAR; PG8_MMA(0, At, B0); PG8_BAR; PG8_SCHED;
            PG8_LDA(At, 0, 1); PG8_STAGE(PG8_SB(0, 0), b2, voffB); PG8_STAGE(PG8_SA(0, 0), a2, voffA);
            PG8_WAIT_V(6); PG8_WAIT_L(0); PG8_BAR; PG8_MMA(1, At, B0); PG8_BAR; PG8_SCHED;
            PG8_LDB(B0, 1, 0); PG8_SCHED; PG8_LDA(At, 1, 0); PG8_STAGE(PG8_SA(0, 1), a2 + HSTEP, voffA);
            PG8_WAIT_V(6); PG8_WAIT_L(0); PG8_BAR; PG8_MMA(0, At, B0); PG8_BAR; PG8_SCHED;
            PG8_LDA(At, 1, 1); PG8_STAGE(PG8_SB(1, 0), b3, voffB); PG8_STAGE(PG8_SA(1, 0), a3, voffA);
            PG8_WAIT_V(6); PG8_WAIT_L(0); PG8_BAR; PG8_MMA(1, At, B0); PG8_BAR; PG8_SCHED;
        }
        if (wr == 0) PG8_BAR;
        E(acc, st_u, st_s, cur, wr, wc, fr, fq);
        if (!has_next) break;
#pragma unroll
        for (int a = 0; a < 2; ++a)
#pragma unroll
            for (int m = 0; m < 4; ++m)
#pragma unroll
                for (int n = 0; n < 2; ++n) { const float z_ = zero_(); acc[a][m][n] = (f32x4){z_, z_, z_, z_}; }
        cur = nxt; cA = nA; cB = nB; ++ui;
        if (wr == 1) PG8_BAR;
    }
    PG8_WAIT_V(0);
    PG8_BAR;
#undef PG8_SA
#undef PG8_SB
#undef PG8_STAGE
#undef PG8_LDA
#undef PG8_LDB
#undef PG8_MMA
#undef PG8_WAIT_V
#undef PG8_WAIT_L
#undef PG8_BAR
#undef PG8_SCHED
}
template <class Epi, class Sched>
__device__ __forceinline__ void gemm_phase_c8(PG8_LAS unsigned char* lds, const int wid_in, const Sched& S, Epi& E) {
    const int wid = opaque_s(wid_in), lane = lane_id_(), tid = wid * 64 + lane, wr = wid >> 2, wc = wid & 3, fr = lane & 15, fq = lane >> 4;
    unsigned voffB[2], voffA[2];
#pragma unroll
    for (int i = 0; i < 2; ++i) { int R, C; stage_rc(tid * 16 + i * 8192, R, C); const int Rb = (R & ~31) + perm32(R & 31);
        voffB[i] = (unsigned)(Rb * LD + C) * 2u; voffA[i] = (unsigned)(R * LD + C) * 2u; }
    const size_t kstep = (size_t)(BK * 2);
    const unsigned ldsb = (unsigned)__builtin_amdgcn_readfirstlane((int)((unsigned)(size_t)lds + (unsigned)wid * 1024u));
    const int aoff = lds_byte(wr * 64 + fr, fq * 8), boff = lds_byte(wc * 32 + fr, fq * 8);
    const int aoff8 = lds_byte(wr * 64 + fr, 16 * fq), boff8 = lds_byte(wc * 32 + fr, 16 * fq);
#define PG8_SA(b, h) (((b) * 2 + (h)) * HTB)
#define PG8_SB(b, h) ((4 + (b) * 2 + (h)) * HTB)
#define PG8_STAGE(bufoff, gbase, voff) do { _Pragma("unroll") for (int _i = 0; _i < 2; ++_i) glds16_s((const char*)(gbase), (voff)[_i], ldsb + (unsigned)((bufoff) + _i * 8192)); } while (0)
#define PG8_STAGE8(bufoff, gbase, voff) do { _Pragma("unroll") for (int _i = 0; _i < 2; ++_i) { const unsigned _v = ((voff)[_i] + ((voff)[_i] & 2047u)) >> 1; glds16_s((const char*)(gbase), _v, ldsb + (unsigned)((bufoff) + _i * 8192)); } } while (0)
#define PG8_STB(bufoff, gbase, f8) do { if (f8) { PG8_STAGE8(bufoff, gbase, voffB); } else { PG8_STAGE(bufoff, gbase, voffB); } } while (0)
#define PG8_STA(bufoff, gbase, h, f8) do { if (f8) { PG8_STAGE8(bufoff, (gbase) + (h) * (HSTEP / 2), voffA); } else { PG8_STAGE(bufoff, (gbase) + (h) * HSTEP, voffA); } } while (0)
#define PG8_LDA(dst, b, h) do { _Pragma("unroll") for (int m = 0; m < 4; ++m) _Pragma("unroll") for (int k = 0; k < 2; ++k) dst[m][k] = *(const PG8_LAS bf16x8*)(lds + PG8_SA(b, h) + aoff + m * 2048 + k * 1024); } while (0)
#define PG8_LDB(dst, b, h) do { _Pragma("unroll") for (int n = 0; n < 2; ++n) _Pragma("unroll") for (int k = 0; k < 2; ++k) dst[n][k] = *(const PG8_LAS bf16x8*)(lds + PG8_SB(b, h) + boff + n * 2048 + k * 1024); } while (0)
#define PG8_LDA8(dst, b, h) do { _Pragma("unroll") for (int m = 0; m < 4; ++m) _Pragma("unroll") for (int k = 0; k < 2; ++k) dst[m][k] = *(const PG8_LAS bf16x8*)(lds + PG8_SA(b, h) + aoff8 + m * 2048 + k * 16); } while (0)
#define PG8_LDB8(dst, b, h) do { _Pragma("unroll") for (int n = 0; n < 2; ++n) _Pragma("unroll") for (int k = 0; k < 2; ++k) dst[n][k] = *(const PG8_LAS bf16x8*)(lds + PG8_SB(b, h) + boff8 + n * 2048 + k * 16); } while (0)
#define PG8_MMA(ai, At, Bt) do { __builtin_amdgcn_s_setprio(1); _Pragma("unroll") for (int m = 0; m < 4; ++m) _Pragma("unroll") for (int n = 0; n < 2; ++n) _Pragma("unroll") for (int k = 0; k < 2; ++k) \
        acc[ai][m][n] = __builtin_amdgcn_mfma_f32_16x16x32_bf16(Bt[n][k], At[m][k], acc[ai][m][n], 0, 0, 0); __builtin_amdgcn_s_setprio(0); } while (0)
#define PG8_MMA8(ai, At, Bt) do { __builtin_amdgcn_s_setprio(1); _Pragma("unroll") for (int m = 0; m < 4; ++m) _Pragma("unroll") for (int n = 0; n < 2; ++n) \
        acc[ai][m][n] = __builtin_amdgcn_mfma_scale_f32_16x16x128_f8f6f4(cat8(Bt[n][0], Bt[n][1]), cat8(At[m][0], At[m][1]), acc[ai][m][n], 0, 0, 0, 0, 0, 0); __builtin_amdgcn_s_setprio(0); } while (0)
#define PG8_WAIT_V(n) asm volatile("s_waitcnt vmcnt(" #n ")" ::: "memory")
#define PG8_WAIT_L(n) asm volatile("s_waitcnt lgkmcnt(" #n ")" ::: "memory")
#define PG8_BAR __builtin_amdgcn_s_barrier()
#define PG8_SCHED __builtin_amdgcn_sched_barrier(0)
    GU cu, cg, nxt; int ui = 0;
    if (!S.next(0, cu)) return;
    f32x4 acc[2][4][2];
#define PG8_ZACC() do { _Pragma("unroll") for (int a = 0; a < 2; ++a) _Pragma("unroll") for (int m = 0; m < 4; ++m) _Pragma("unroll") for (int n = 0; n < 2; ++n) { const float z_ = zero_(); acc[a][m][n] = (f32x4){z_, z_, z_, z_}; } } while (0)
    PG8_ZACC();
    bf16x8 At[4][2], B0[2][2];
    u32x4 st_u[2][4], st_s[2][4];
    PG8_STB(PG8_SB(0, 0), cu.B0, false); PG8_STA(PG8_SA(0, 0), cu.A, 0, false); PG8_STA(PG8_SA(0, 1), cu.A, 1, false);
    if (wr == 1) PG8_BAR;
    PG8_WAIT_V(2); PG8_BAR;
    PG8_STB(PG8_SB(1, 0), cu.B0 + kstep, false); PG8_STA(PG8_SA(1, 0), cu.A + kstep, 0, false);
    PG8_WAIT_V(4); PG8_BAR;
#define PG8_KLOOP(LDA_, LDB_, MMA_, C8, N8, cA, cB, nA, nB, nt) \
        for (int t = 0; t < (nt); t += 2) { \
            const bool last = (t == (nt) - 2); \
            const char* a1 = (cA) + (size_t)(t + 1) * kstep; \
            const char* a2 = last ? (nA) : (cA) + (size_t)(t + 2) * kstep; \
            const char* b2 = last ? (nB) : (cB) + (size_t)(t + 2) * kstep; \
            const char* a3 = a2 + kstep; const char* b3 = b2 + kstep; \
            LDB_(B0, 0, 0); PG8_SCHED; LDA_(At, 0, 0); PG8_STA(PG8_SA(1, 1), a1, 1, C8); \
            PG8_WAIT_V(6); PG8_WAIT_L(0); PG8_BAR; MMA_(0, At, B0); PG8_BAR; PG8_SCHED; \
            if (last) { LDA_(At, 0, 1); PG8_STB(PG8_SB(0, 0), b2, N8); PG8_STA(PG8_SA(0, 0), a2, 0, N8); } else { LDA_(At, 0, 1); PG8_STB(PG8_SB(0, 0), b2, C8); PG8_STA(PG8_SA(0, 0), a2, 0, C8); } \
            PG8_WAIT_V(6); PG8_WAIT_L(0); PG8_BAR; MMA_(1, At, B0); PG8_BAR; PG8_SCHED; \
            if (last) { LDB_(B0, 1, 0); PG8_SCHED; LDA_(At, 1, 0); PG8_STA(PG8_SA(0, 1), a2, 1, N8); } else { LDB_(B0, 1, 0); PG8_SCHED; LDA_(At, 1, 0); PG8_STA(PG8_SA(0, 1), a2, 1, C8); } \
            PG8_WAIT_V(6); PG8_WAIT_L(0); PG8_BAR; MMA_(0, At, B0); PG8_BAR; PG8_SCHED; \
            if (last) { LDA_(At, 1, 1); PG8_STB(PG8_SB(1, 0), b3, N8); PG8_STA(PG8_SA(1, 0), a3, 0, N8); } else { LDA_(At, 1, 1); PG8_STB(PG8_SB(1, 0), b3, C8); PG8_STA(PG8_SA(1, 0), a3, 0, C8); } \
            PG8_WAIT_V(6); PG8_WAIT_L(0); PG8_BAR; MMA_(1, At, B0); PG8_BAR; PG8_SCHED; \
        }
    for (;;) {
        S.next(ui + 1, cg);
        PG8_KLOOP(PG8_LDA, PG8_LDB, PG8_MMA, false, true, cu.A, cu.B0, cg.A, cg.B0, cu.nt)
        if (wr == 0) PG8_BAR;
        { const int l2_ = lane_id_(); E(acc, st_u, st_s, cu, wr, wc, l2_ & 15, l2_ >> 4); }
        PG8_ZACC();
        if (wr == 1) PG8_BAR;
        const bool has_next = S.next(ui + 2, nxt);
        if (!has_next) { nxt.A = S.BRp; nxt.B0 = S.WBp; }
        PG8_KLOOP(PG8_LDA8, PG8_LDB8, PG8_MMA8, true, false, cg.A, cg.B0, nxt.A, nxt.B0, cg.nt)
        if (wr == 0) PG8_BAR;
        { const int l2_ = lane_id_(); E(acc, st_u, st_s, cg, wr, wc, l2_ & 15, l2_ >> 4); }
        if (!has_next) break;
        PG8_ZACC();
        cu = nxt; ui += 2;
        if (wr == 1) PG8_BAR;
    }
#undef PG8_KLOOP
#undef PG8_ZACC
    PG8_WAIT_V(0);
    PG8_BAR;
#undef PG8_SA
#undef PG8_SB
#undef PG8_STAGE
#undef PG8_STAGE8
#undef PG8_STB
#undef PG8_STA
#undef PG8_LDA
#undef PG8_LDB
#undef PG8_LDA8
#undef PG8_LDB8
#undef PG8_MMA
#undef PG8_MMA8
#undef PG8_WAIT_V
#undef PG8_WAIT_L
#undef PG8_BAR
#undef PG8_SCHED
}
}
namespace attn_body {
using bf16=__hip_bfloat16;
using bf16x8=__attribute__((ext_vector_type(8)))short;
using s16x4=__attribute__((ext_vector_type(4)))short;
using f32x16=__attribute__((ext_vector_type(16)))float;
using f32x4=__attribute__((ext_vector_type(4)))float;
using u32x4=__attribute__((ext_vector_type(4)))unsigned;
constexpr int SEQ=4096,D=64;
constexpr int KVP=2304;
constexpr int OP=1024;
constexpr int NW=8,QBLK=32,QB=QBLK*NW,KVBLK=64,NQB=SEQ/QB;
__device__ __forceinline__ int crow(int r,int hi){return (r&3)+8*(r>>2)+4*hi;}
#define SBAR() __builtin_amdgcn_sched_barrier(0)
__device__ __forceinline__ void cmask(f32x16&p0,f32x16&p1,int jb,int qrel,int hi){
  const float NEG=-INFINITY; int kb=64*jb+4*hi;
  #pragma unroll
  for(int r=0;r<16;++r){int kv=kb+(r&3)+8*(r>>2); if(kv>qrel)p0[r]=NEG; if(kv+32>qrel)p1[r]=NEG;}
}
__device__ __forceinline__ void bmask(f32x16&p0,f32x16&p1,unsigned long long w,int hi){
  const float NEG=-INFINITY; const unsigned lo=((unsigned)w)>>(4*hi), up=((unsigned)(w>>32))>>(4*hi);
  #pragma unroll
  for(int r=0;r<16;++r){const int bit=(r&3)+8*(r>>2); if(!((lo>>bit)&1u))p0[r]=NEG; if(!((up>>bit)&1u))p1[r]=NEG;}
}
constexpr int NSLOT=3, SLOTB=8192;
constexpr int LDS_K=0, LDS_V=NSLOT*SLOTB, LDS_WS=2*NSLOT*SLOTB, LDS_OST=LDS_WS+NW*64*4, LDS_BIAS=LDS_OST+NW*4096, LDS_BYTES=LDS_BIAS+SEQ*4;
constexpr float C2=0.125f*1.4426950408889634f;
__device__ __forceinline__ void glds16(const void*gsrc,unsigned lds_dst){unsigned keep;
  asm volatile("s_mov_b32 %0, m0\n\ts_mov_b32 m0, %2\n\ts_nop 0\n\tglobal_load_lds_dwordx4 %1, off\n\ts_mov_b32 m0, %0":"=&s"(keep):"v"(gsrc),"s"(lds_dst):"memory");}
__device__ __forceinline__ float max3f(float a,float b,float c){float r;asm("v_max3_f32 %0, %1, %2, %3":"=v"(r):"v"(a),"v"(b),"v"(c));return r;}
__device__ __forceinline__ float max2f(float a,float b){float r;asm("v_max_f32_e32 %0, %1, %2":"=v"(r):"v"(a),"v"(b));return r;}
__device__ __forceinline__ float fadd_s(float a,float b){float r;asm("v_add_f32_e32 %0, %1, %2":"=v"(r):"v"(a),"v"(b));return r;}
__device__ __forceinline__ float fsub_s(float a,float b){float r;asm("v_sub_f32_e32 %0, %1, %2":"=v"(r):"v"(a),"v"(b));return r;}
typedef float f32x2_t __attribute__((ext_vector_type(2))); typedef __bf16 bf16x2_t __attribute__((ext_vector_type(2)));
__device__ __forceinline__ unsigned cvtpk_s(float lo,float hi){f32x2_t v={lo,hi};bf16x2_t b=__builtin_convertvector(v,bf16x2_t);return __builtin_bit_cast(unsigned,b);}
#define WAIT_BAR(N) asm volatile("s_waitcnt vmcnt(" #N ") lgkmcnt(0)\n\ts_barrier":::"memory")

typedef __attribute__((address_space(3))) const char* lds_cptr;
typedef short v4i16_t __attribute__((ext_vector_type(4)));
__device__ __forceinline__ void binit(f32x16&p0,f32x16&p1,lds_cptr bp,float mhat){
  typedef float f2_ __attribute__((ext_vector_type(2))); const f2_ m2={mhat,mhat};
  #pragma unroll
  for(int g=0;g<4;++g){ const f32x4 a=*(const __attribute__((address_space(3))) f32x4*)(bp+g*32); const f32x4 b=*(const __attribute__((address_space(3))) f32x4*)(bp+128+g*32);
    const f2_ a0=(f2_){a[0],a[1]}-m2,a1=(f2_){a[2],a[3]}-m2,b0=(f2_){b[0],b[1]}-m2,b1=(f2_){b[2],b[3]}-m2;
    p0[4*g]=a0.x;p0[4*g+1]=a0.y;p0[4*g+2]=a1.x;p0[4*g+3]=a1.y; p1[4*g]=b0.x;p1[4*g+1]=b0.y;p1[4*g+2]=b1.x;p1[4*g+3]=b1.y; }
}
__device__ __forceinline__ void qkt(f32x16&p0,f32x16&p1,const char*Kslot,const bf16x8*qr,int r32,int hi){
  const char*kb=Kslot+hi*1024+r32*16;
  #pragma unroll
  for(int d0=0;d0<4;++d0){
    const bf16x8 b0=*reinterpret_cast<const bf16x8*>(kb+d0*2048);
    const bf16x8 b1=*reinterpret_cast<const bf16x8*>(kb+d0*2048+512);
    p0=__builtin_amdgcn_mfma_f32_32x32x16_bf16(b0,qr[d0],p0,0,0,0);p1=__builtin_amdgcn_mfma_f32_32x32x16_bf16(b1,qr[d0],p1,0,0,0);}
}
__device__ __forceinline__ void kload8(bf16x8*kf,lds_cptr kp){
  kf[0]=*(const __attribute__((address_space(3))) bf16x8*)(kp);      kf[1]=*(const __attribute__((address_space(3))) bf16x8*)(kp+512);
  kf[2]=*(const __attribute__((address_space(3))) bf16x8*)(kp+2048); kf[3]=*(const __attribute__((address_space(3))) bf16x8*)(kp+2560);
  kf[4]=*(const __attribute__((address_space(3))) bf16x8*)(kp+4096); kf[5]=*(const __attribute__((address_space(3))) bf16x8*)(kp+4608);
  kf[6]=*(const __attribute__((address_space(3))) bf16x8*)(kp+6144); kf[7]=*(const __attribute__((address_space(3))) bf16x8*)(kp+6656);
}
__device__ __forceinline__ void kload2(bf16x8*kf,lds_cptr kp,int j){ kf[2*j]=*(const __attribute__((address_space(3))) bf16x8*)(kp+j*2048); kf[2*j+1]=*(const __attribute__((address_space(3))) bf16x8*)(kp+j*2048+512); }
__device__ __forceinline__ s16x4 vtr(lds_cptr p){ return __builtin_bit_cast(s16x4,__builtin_amdgcn_ds_read_tr16_b64_v4i16((__attribute__((address_space(3))) v4i16_t*)p)); }
__device__ __forceinline__ float rowmax(const f32x16&p0,const f32x16&p1){
  float a=max3f(p0[0],p0[1],p1[0]),b=max3f(p0[2],p0[3],p1[1]);a=max3f(a,p1[2],p1[3]);
  #pragma unroll
  for(int r=4;r<16;r+=4){a=max3f(a,p0[r],p0[r+1]);b=max3f(b,p0[r+2],p0[r+3]);a=max3f(a,p1[r],p1[r+1]);b=max3f(b,p1[r+2],p1[r+3]);}
  const float m=max2f(a,b);
  auto rr=__builtin_amdgcn_permlane32_swap(__float_as_uint(m),__float_as_uint(m),false,false);
  return max2f(__uint_as_float(rr[0]),__uint_as_float(rr[1]));
}
__device__ __forceinline__ void pv(f32x16*o,int vb,bf16x8 pa0,bf16x8 pa1,bf16x8 pa2,bf16x8 pa3){
  #pragma unroll
  for(int d0=0;d0<2;++d0){s16x4 lo[4],hi[4];
    #pragma unroll
    for(int ks=0;ks<4;++ks){
      asm volatile("ds_read_b64_tr_b16 %0,%1 offset:%c2":"=&v"(lo[ks]):"v"(vb),"i"(d0*4096+ks*1024):"memory");
      asm volatile("ds_read_b64_tr_b16 %0,%1 offset:%c2":"=&v"(hi[ks]):"v"(vb),"i"(d0*4096+ks*1024+512):"memory");}
    asm volatile("s_waitcnt lgkmcnt(0)":::"memory");SBAR();
    #define PK(k) (bf16x8){lo[k][0],lo[k][1],lo[k][2],lo[k][3],hi[k][0],hi[k][1],hi[k][2],hi[k][3]}
    o[d0]=__builtin_amdgcn_mfma_f32_32x32x16_bf16(pa0,PK(0),o[d0],0,0,0);
    o[d0]=__builtin_amdgcn_mfma_f32_32x32x16_bf16(pa1,PK(1),o[d0],0,0,0);
    o[d0]=__builtin_amdgcn_mfma_f32_32x32x16_bf16(pa2,PK(2),o[d0],0,0,0);
    o[d0]=__builtin_amdgcn_mfma_f32_32x32x16_bf16(pa3,PK(3),o[d0],0,0,0);
    #undef PK
  }
}

template<int THRL,bool MASK> __device__ __forceinline__ void attn_unit(int q0,const bf16*Qs,const bf16*__restrict__ Ks,const bf16*__restrict__ Vs,bf16*Os,
                                                                       const float*biasg,float slope2,const unsigned long long*maskw,char*shm,const int wid_in){
  const int wid=opaque_s(wid_in),lane=lane_id_(),tid=wid*64+lane,r32=lane&31,hi=lane>>5;
  const bf16*Qw=Qs+(long)(q0+wid*QBLK)*KVP;
  const unsigned lds0=(unsigned)(uintptr_t)shm;
  float*wsf=(float*)(shm+LDS_WS)+wid*64;
  unsigned long long mwA=0ull,mwB=0ull;
  { float*bl=(float*)(shm+LDS_BIAS); const int nk=q0+QB;
    if(biasg){ for(int s=tid;s<nk;s+=NW*64)bl[s]=biasg[s]; } else { for(int s=tid;s<nk;s+=NW*64)bl[s]=slope2*(float)s; }
    if(MASK){ const unsigned long long*mp0=maskw+(q0+wid*QBLK+(lane&31)); mwA=mp0[0]; mwB=mp0[SEQ]; asm volatile("":"+v"(mwA),"+v"(mwB)); }
    asm volatile("s_waitcnt vmcnt(0) lgkmcnt(0)":::"memory"); }
  const bf16*ksrc=Ks+(long)lane*KVP+wid*8;
  const bf16*vsrc=Vs+(long)(16*(wid&3)+(lane>>2))*KVP+(wid>>2)*32+(lane&3)*8;
  const unsigned kdst=lds0+LDS_K+wid*1024, vdst=lds0+LDS_V+wid*1024;
  #define DMA_K(t,slot) glds16(ksrc+(long)(t)*KVBLK*KVP,(unsigned)__builtin_amdgcn_readfirstlane(kdst+(slot)))
  #define DMA_V(t,slot) glds16(vsrc+(long)(t)*KVBLK*KVP,(unsigned)__builtin_amdgcn_readfirstlane(vdst+(slot)))
  const int vb0=(int)(lds0+LDS_V)+((lane>>4)&1)*32+(lane&3)*8+(4*hi+((lane&15)>>2))*64;
  const char*Kbase=shm+LDS_K; bf16x8 kf[8];
  const lds_cptr shm3=(lds_cptr)shm; const lds_cptr kp0=shm3+LDS_K+hi*1024+r32*16; const lds_cptr vp0=shm3+LDS_V+((lane>>4)&1)*32+(lane&3)*8+(4*hi+((lane&15)>>2))*64;
  const lds_cptr bp0=shm3+LDS_BIAS+hi*16;
  const int NT=(q0+QB)/KVBLK;
  DMA_K(0,0);DMA_V(0,0);DMA_K(1,SLOTB);
  bf16x8 qr[4];
  #pragma unroll
  for(int d0=0;d0<4;++d0)qr[d0]=*reinterpret_cast<const bf16x8*>(&Qw[(long)r32*KVP+d0*16+hi*8]);
  const unsigned long long*mwp=MASK?maskw+(q0+wid*QBLK+r32):nullptr;
  #define MLOAD(MW,t) do{ if(MASK){ MW=mwp[(long)(t)*SEQ]; } }while(0)
  #define MPIN(MW) do{}while(0)
  float mhat=0.f,l_reg=0.f;f32x16 o[2];o[0]=f32x16{};o[1]=f32x16{};
  const int qrel=wid*QBLK+r32;
  #define CMASK(P0,P1,t,MW) do{ if(MASK){ bmask(P0,P1,MW,hi); } else { int jb_=(t)-(NT-4); if(jb_>=0)cmask(P0,P1,jb_,qrel,hi); } }while(0)
  bool resc=false;
  #define START(P0,P1) do{ const float rm=rowmax(P0,P1); resc=false; \
    { const float dl=__builtin_fmaxf(rm,-60000.f); mhat=fadd_s(mhat,dl); \
      _Pragma("unroll") for(int r=0;r<16;++r){P0[r]=fsub_s(P0[r],dl);P1[r]=fsub_s(P1[r],dl);} } \
    _Pragma("unroll") for(int r=0;r<16;++r)P0[r]=__builtin_amdgcn_exp2f(P0[r]); }while(0)
  #define RESC() do{ if(resc){ asm volatile("s_waitcnt lgkmcnt(0)":::"memory"); \
      _Pragma("unroll") for(int d_=0;d_<2;++d_) _Pragma("unroll") for(int r=0;r<16;++r)o[d_][r]*=wsf[crow(r,hi)]; } }while(0)
  f32x16 pA0,pA1,pB0,pB1;
  int sl_prev=0,sl_cur=0,sl_next=SLOTB;
  #define ROT() do{sl_prev=sl_cur;sl_cur=sl_next;sl_next=(sl_next==(NSLOT-1)*SLOTB)?0:sl_next+SLOTB;}while(0)
  DMA_K(2,2*SLOTB);
  WAIT_BAR(3);
  binit(pA0,pA1,bp0,0.f);
  qkt(pA0,pA1,Kbase,qr,r32,hi);asm volatile("s_nop 15\n\ts_nop 7":"+v"(pA0),"+v"(pA1));CMASK(pA0,pA1,0,mwA);
  START(pA0,pA1);
  _Pragma("unroll") for(int r=0;r<16;++r)pA1[r]=__builtin_amdgcn_exp2f(pA1[r]);
  WAIT_BAR(0);
  DMA_K(3,0);DMA_V(1,SLOTB);MLOAD(mwA,2);
  ROT();
  kload8(kf,kp0+sl_cur);
  if(MASK){WAIT_BAR(3);}else{WAIT_BAR(2);}
  s16x4 vlo[8],vhi[8]; u32x4 pw0,pw1,pw2,pw3;
  #define PKW(P,B) cvtpk_s(P[B],P[B+1])
  #define PAF(k) __builtin_bit_cast(bf16x8,pw##k)
  #define VFR(i) (bf16x8){vlo[i][0],vlo[i][1],vlo[i][2],vlo[i][3],vhi[i][0],vhi[i][1],vhi[i][2],vhi[i][3]}
  #define PIN(x) asm volatile("":"+v"(x))
  #define MX3(a,b,c) __builtin_fmaxf(__builtin_fmaxf((a),(b)),(c))
  #define GAPA(MF,A0,A1,A2,A3,W0,W1,PW) do{ MF; sacc+=A0; sacc+=A1; sacc+=A2; sacc+=A3; PIN(sacc); W0; W1; PIN(PW); SBAR(); }while(0)
  #define EX(v) __builtin_amdgcn_exp2f(v)
  #define GAPB(MF,X,B) do{ MF; X[B]=EX(X[B]); X[B+1]=EX(X[B+1]); X[B+2]=EX(X[B+2]); X[B+3]=EX(X[B+3]); PIN(X); SBAR(); }while(0)
  #define VRD(i) do{ vlo[i]=vtr(vp_+(((i)>>2)*4096+((i)&3)*1024)); vhi[i]=vtr(vp_+(((i)>>2)*4096+((i)&3)*1024+512)); }while(0)
  #define KRD(G,j) do{ if(G){ kload2(kf,kp0+sl_next,j); SBAR(); } }while(0)
  #define STEP(C0,C1,P0,P1,t,GK,GV,GL,MW,GM,DOCM) do{ SBAR(); \
    const lds_cptr vp_=vp0+sl_prev; \
    binit(C0,C1,bp0+(t)*256,mhat); SBAR(); \
    VRD(0); SBAR(); float sacc=(P0[0]+P0[1]); \
    GAPA(C0=__builtin_amdgcn_mfma_f32_32x32x16_bf16(kf[0],qr[0],C0,0,0,0), P0[2],P0[3],P0[4],P0[5],     pw0[0]=PKW(P0,0), pw0[1]=PKW(P0,2), pw0); \
    VRD(4); SBAR(); GAPA(C1=__builtin_amdgcn_mfma_f32_32x32x16_bf16(kf[1],qr[0],C1,0,0,0), P0[6],P0[7],P0[8],P0[9],     pw0[2]=PKW(P0,4), pw0[3]=PKW(P0,6), pw0); \
    VRD(1); SBAR(); GAPA(C0=__builtin_amdgcn_mfma_f32_32x32x16_bf16(kf[2],qr[1],C0,0,0,0),   P0[10],P0[11],P0[12],P0[13], pw1[0]=PKW(P0,8), pw1[1]=PKW(P0,10), pw1); \
    VRD(5); SBAR(); GAPA(C1=__builtin_amdgcn_mfma_f32_32x32x16_bf16(kf[3],qr[1],C1,0,0,0),   P0[14],P0[15],P1[0],P1[1],   pw1[2]=PKW(P0,12),pw1[3]=PKW(P0,14), pw1); \
    VRD(2); SBAR(); GAPA(C0=__builtin_amdgcn_mfma_f32_32x32x16_bf16(kf[4],qr[2],C0,0,0,0),   P1[2],P1[3],P1[4],P1[5],     pw2[0]=PKW(P1,0), pw2[1]=PKW(P1,2), pw2); \
    VRD(6); SBAR(); GAPA(C1=__builtin_amdgcn_mfma_f32_32x32x16_bf16(kf[5],qr[2],C1,0,0,0),   P1[6],P1[7],P1[8],P1[9],     pw2[2]=PKW(P1,4), pw2[3]=PKW(P1,6), pw2); \
    VRD(3); SBAR(); GAPA(C0=__builtin_amdgcn_mfma_f32_32x32x16_bf16(kf[6],qr[3],C0,0,0,0),   P1[10],P1[11],P1[12],P1[13], pw3[0]=PKW(P1,8), pw3[1]=PKW(P1,10), pw3); \
    VRD(7); SBAR(); GAPA(C1=__builtin_amdgcn_mfma_f32_32x32x16_bf16(kf[7],qr[3],C1,0,0,0),   P1[14],P1[15],0.f,0.f,       pw3[2]=PKW(P1,12),pw3[3]=PKW(P1,14), pw3); \
    l_reg+=sacc; \
    if(MASK&&(DOCM)){ CMASK(C0,C1,t,MW); } \
    if(GK){DMA_K((t)+3,sl_cur);} if(GV){DMA_V((t)+1,sl_next);} \
    if(!MASK&&(DOCM)){ CMASK(C0,C1,t,MW); } \
    if(GM){ MLOAD(MW,(t)+2); } \
    { float a=MX3(C0[0],C0[1],C1[0]),b=MX3(C0[2],C0[3],C1[1]); a=MX3(a,C1[2],C1[3]); \
      _Pragma("unroll") for(int r=4;r<16;r+=4){a=MX3(a,C0[r],C0[r+1]);b=MX3(b,C0[r+2],C0[r+3]);a=MX3(a,C1[r],C1[r+1]);b=MX3(b,C1[r+2],C1[r+3]);} \
      float rm=__builtin_fmaxf(a,b); { auto rr=__builtin_amdgcn_permlane32_swap(__float_as_uint(rm),__float_as_uint(rm),false,false); rm=__builtin_fmaxf(__uint_as_float(rr[0]),__uint_as_float(rr[1])); } \
      resc=false; \
      if(__builtin_expect(__any(rm>(float)THRL),0)){ const float dl=__builtin_fmaxf(rm,0.f); mhat+=dl; \
        _Pragma("unroll") for(int r=0;r<16;++r){C0[r]-=dl;C1[r]-=dl;} \
        const float f=__builtin_amdgcn_exp2f(-dl); l_reg*=f; if(hi==0)wsf[r32]=f; resc=true; } } \
    SBAR(); \
    GAPB(o[0]=__builtin_amdgcn_mfma_f32_32x32x16_bf16(PAF(0),VFR(0),o[0],0,0,0), C0,0); \
    GAPB(o[1]=__builtin_amdgcn_mfma_f32_32x32x16_bf16(PAF(0),VFR(4),o[1],0,0,0), C0,4); \
    KRD(GL,0); GAPB(o[0]=__builtin_amdgcn_mfma_f32_32x32x16_bf16(PAF(1),VFR(1),o[0],0,0,0), C0,8); \
    KRD(GL,1); GAPB(o[1]=__builtin_amdgcn_mfma_f32_32x32x16_bf16(PAF(1),VFR(5),o[1],0,0,0), C0,12); \
    KRD(GL,2); GAPB(o[0]=__builtin_amdgcn_mfma_f32_32x32x16_bf16(PAF(2),VFR(2),o[0],0,0,0), C1,0); \
    KRD(GL,3); GAPB(o[1]=__builtin_amdgcn_mfma_f32_32x32x16_bf16(PAF(2),VFR(6),o[1],0,0,0), C1,4); \
    GAPB(o[0]=__builtin_amdgcn_mfma_f32_32x32x16_bf16(PAF(3),VFR(3),o[0],0,0,0), C1,8); \
    GAPB(o[1]=__builtin_amdgcn_mfma_f32_32x32x16_bf16(PAF(3),VFR(7),o[1],0,0,0), C1,12); \
    }while(0)
  int t=1;
  #define ENDW(tt) do{ if((tt)+3<NT){ if(MASK){WAIT_BAR(3);}else{WAIT_BAR(2);} } else if((tt)+2<NT){ if(MASK){WAIT_BAR(2);}else{WAIT_BAR(1);} } else {WAIT_BAR(0);} }while(0)
  for(;t+5<NT;t+=2){
    STEP(pB0,pB1,pA0,pA1,t,true,true,true,mwB,MASK,MASK);     if(MASK){WAIT_BAR(3);}else{WAIT_BAR(2);} MPIN(mwA); RESC(); ROT();
    STEP(pA0,pA1,pB0,pB1,t+1,true,true,true,mwA,MASK,MASK);   if(MASK){WAIT_BAR(3);}else{WAIT_BAR(2);} MPIN(mwB); RESC(); ROT();
  }
  for(;t+1<NT;t+=2){
    STEP(pB0,pB1,pA0,pA1,t,(t+3<NT),(t+1<NT),(t+1<NT),mwB,(MASK&&(t+2<NT)),true);       ENDW(t);   MPIN(mwA); RESC(); ROT();
    STEP(pA0,pA1,pB0,pB1,t+1,(t+4<NT),(t+2<NT),(t+2<NT),mwA,(MASK&&(t+3<NT)),true);     ENDW(t+1); MPIN(mwB); RESC(); ROT();
  }
  STEP(pB0,pB1,pA0,pA1,NT-1,false,false,false,mwB,false,true); RESC();
  { float sacc=pB0[0]+pB0[1]; _Pragma("unroll") for(int r=2;r<16;++r)sacc+=pB0[r]; _Pragma("unroll") for(int r=0;r<16;++r)sacc+=pB1[r]; l_reg+=sacc;
    pw0=(u32x4){PKW(pB0,0),PKW(pB0,2),PKW(pB0,4),PKW(pB0,6)};pw1=(u32x4){PKW(pB0,8),PKW(pB0,10),PKW(pB0,12),PKW(pB0,14)};pw2=(u32x4){PKW(pB1,0),PKW(pB1,2),PKW(pB1,4),PKW(pB1,6)};pw3=(u32x4){PKW(pB1,8),PKW(pB1,10),PKW(pB1,12),PKW(pB1,14)};
    SBAR(); pv(o,vb0+sl_cur,PAF(0),PAF(1),PAF(2),PAF(3)); }
  #undef PKW
  #undef PAF
  #undef VFR
  #undef PIN
  #undef MX3
  #undef GAPA
  #undef GAPB
  #undef EX
  #undef VRD
  #undef KRD
  #undef STEP
  #undef ENDW
  {auto rr=__builtin_amdgcn_permlane32_swap(__float_as_uint(l_reg),__float_as_uint(l_reg),false,false);l_reg=__uint_as_float(rr[0])+__uint_as_float(rr[1]);}
  if(hi==0)wsf[32+r32]=l_reg;asm volatile("s_waitcnt lgkmcnt(0)":::"memory");
  float rli[16];
  #pragma unroll
  for(int r=0;r<16;++r)rli[r]=__builtin_amdgcn_rcpf(wsf[32+crow(r,hi)]);
  bf16*Ow=Os+(long)(q0+wid*QBLK)*OP;
  { bf16*stg=(bf16*)(shm+LDS_OST)+wid*2048;
    #pragma unroll
    for(int r=0;r<16;++r){const int orow=crow(r,hi);
      #pragma unroll
      for(int d0=0;d0<2;++d0)stg[orow*64+d0*32+r32]=__float2bfloat16(o[d0][r]*rli[r]);}
    asm volatile("s_waitcnt lgkmcnt(0)":::"memory");
    #pragma unroll
    for(int i=0;i<4;++i){const int row=i*8+(lane>>3),ch=lane&7; const u32x4 v=*(const u32x4*)(stg+row*64+ch*8); *(u32x4*)(Ow+(long)row*OP+ch*8)=v;} }
  asm volatile("s_waitcnt lgkmcnt(0)\n\ts_barrier":::"memory");
  #undef DMA_K
  #undef MLOAD
  #undef MPIN
  #undef DMA_V
  #undef CMASK
  #undef START
  #undef RESC
  #undef ROT
}
#undef SBAR
#undef WAIT_BAR
}
struct Args { const float* in[25]; float* out; unsigned char* ws; int ph_lo, ph_hi; };
struct Frame {
    LAS unsigned char* lds; unsigned char* ldsg;
    volatile LAS unsigned* MISC;
    gu32* ctl;
    int tid, lane, wave, vcu, G;
    unsigned char* ws; float* out;
};
__device__ __forceinline__ float dpp_add_(float v, float acc_src, int) { return v; }
#define DPP_F(v, ctrl, rmask) __builtin_bit_cast(float, __builtin_amdgcn_update_dpp(0, __builtin_bit_cast(int, (v)), (ctrl), (rmask), 0xF, false))
__device__ __forceinline__ float wave_sum(float v) {
    v += DPP_F(v, 0xB1, 0xF);
    v += DPP_F(v, 0x4E, 0xF);
    v += DPP_F(v, 0x141, 0xF);
    v += DPP_F(v, 0x140, 0xF);
    v += DPP_F(v, 0x142, 0xA);
    v += DPP_F(v, 0x143, 0xC);
    return __builtin_bit_cast(float, __builtin_amdgcn_readlane(__builtin_bit_cast(int, v), 63));
}
__device__ __forceinline__ bf16* wsb(const Frame& F, size_t off) { return (bf16*)(F.ws + off); }

__device__ __forceinline__ int map_small(int r) {
    if (r < 1024) return r;
    if (r < 1280) return 1028 + (r - 1024);
    if (r < 1536) return 1412 + (r - 1280);
    if (r < 2048) return 1736 + (r - 1536);
    if (r < 2112) return 1284 + (r - 2048);
    if (r < 2176) return 1348 + (r - 2112);
    if (r < 2240) return 1668 + (r - 2176);
    if (r < 2244) return 1024 + (r - 2240);
    if (r < 2248) return 1732 + (r - 2244);
    return -1;
}
__device__ __forceinline__ void tr_item(const float* src, int ld_src, int k0, int srccol, bf16* dst, int ld_dst, LAS float* scr, int lane) {
    float tv[32];
#pragma unroll
    for (int i = 0; i < 32; ++i) { const int kk = 2 * i + (lane >> 5); tv[i] = src[(size_t)(k0 + kk) * ld_src + (srccol >= 0 ? srccol : 0)]; }
#pragma unroll
    for (int i = 0; i < 32; ++i) { const int kk = 2 * i + (lane >> 5); scr[kk * 33 + (lane & 31)] = srccol >= 0 ? tv[i] : 0.f; }
    LDS_WAIT(); asm volatile("" ::: "memory");
    const int c = lane & 7;
#pragma unroll
    for (int j = 0; j < 4; ++j) { const int n = (lane >> 3) + 8 * j; const LAS float* s = scr + (8 * c) * 33 + n;
        v4u o; o.x = pk2(s[0 * 33], s[1 * 33]); o.y = pk2(s[2 * 33], s[3 * 33]); o.z = pk2(s[4 * 33], s[5 * 33]); o.w = pk2(s[6 * 33], s[7 * 33]);
        *(GAS v4u*)(dst + (size_t)n * ld_dst + 8 * c) = o; }
    LDS_WAIT(); asm volatile("" ::: "memory");
}
#ifndef A_F8_TILES
#define A_F8_TILES 0x0DF
#endif
constexpr size_t W_SM8 = 4718592 + 4 * MiB;
constexpr float MIX_SCALE = 8.f;
constexpr float ACT_SCALE = 8.f;
constexpr float GATE_WSCALE = 32.f;
__device__ __forceinline__ void tr_item8(const float* src, int ld_src, int k0, int srccol, unsigned char* dst, int ld_dst, LAS float* scr, int lane) {
    float tv[32];
#pragma unroll
    for (int i = 0; i < 32; ++i) { const int kk = 2 * i + (lane >> 5); tv[i] = src[(size_t)(k0 + kk) * ld_src + (srccol >= 0 ? srccol : 0)]; }
#pragma unroll
    for (int i = 0; i < 32; ++i) { const int kk = 2 * i + (lane >> 5); scr[kk * 33 + (lane & 31)] = srccol >= 0 ? tv[i] * GATE_WSCALE : 0.f; }
    LDS_WAIT(); asm volatile("" ::: "memory");
    const int c = lane & 7;
#pragma unroll
    for (int j = 0; j < 4; ++j) { const int n = (lane >> 3) + 8 * j; const LAS float* s = scr + (8 * c) * 33 + n;
        v2u o; o.x = pk4_fp8(s[0 * 33], s[1 * 33], s[2 * 33], s[3 * 33]); o.y = pk4_fp8(s[4 * 33], s[5 * 33], s[6 * 33], s[7 * 33]);
        *(GAS v2u*)(dst + (size_t)n * ld_dst + 8 * c) = o; }
    LDS_WAIT(); asm volatile("" ::: "memory");
}
constexpr int IT_SM = 72 * 16, IT_GT = 128 * 16, IT_BR = 512, IT_OUT = 512, IT_GU = 16 * 512, IT_D = 16 * 256, IT_LAYER = IT_SM + IT_GT + IT_BR + IT_OUT + IT_GU + IT_D;
__device__ __forceinline__ void p0_item(const Frame& F, const Args& a, int it, LAS float* scr) {
    const int l = it / IT_LAYER; int j = it % IT_LAYER; const int n = F.lane & 31;
    bf16* W = wsb(F, WS_W + (size_t)l * W_LAYER);
    if (j < IT_SM) { const int g = j / 16, kb = j % 16;
        if ((A_F8_TILES >> (g / 8)) & 1) tr_item8(a.in[3] + (size_t)l * DM * P_TOTAL, P_TOTAL, kb * 64, map_small(g * 32 + n), (unsigned char*)W + W_SM8 + (size_t)(g * 32) * DM + kb * 64, DM, scr, F.lane);
        else tr_item(a.in[3] + (size_t)l * DM * P_TOTAL, P_TOTAL, kb * 64, map_small(g * 32 + n), W + W_SM / 2 + (size_t)(g * 32) * DM + kb * 64, DM, scr, F.lane);
        return; } j -= IT_SM;
    if (j < IT_GT) { const int g = j / 16, kb = j % 16; tr_item8(a.in[3] + (size_t)l * DM * P_TOTAL, P_TOTAL, kb * 64, 2248 + g * 32 + n, (unsigned char*)W + W_GT + (size_t)(g * 32) * DM + kb * 64, DM, scr, F.lane); return; } j -= IT_GT;
    if (j < IT_BR) { const int nb = j / 128, jj = j % 128, g = jj / 4, kb = jj % 4;
        tr_item(a.in[12] + ((size_t)l * 4 + nb) * 256 * DM, DM, kb * 64, g * 32 + n, W + W_BR / 2 + (size_t)(g * 32) * DM + nb * 256 + kb * 64, DM, scr, F.lane); return; } j -= IT_BR;
    if (j < IT_OUT) { const int g = j / 16, kb = j % 16; tr_item8(a.in[13] + (size_t)l * DM * DM, DM, kb * 64, g * 32 + n, (unsigned char*)W + W_OUT + (size_t)(g * 32) * DM + kb * 64, DM, scr, F.lane); return; } j -= IT_OUT;
    if (j < IT_GU) { const int e = j / 512, jj = j % 512, g = jj / 16, kb = jj % 16; const int r0 = g * 32, q = r0 >> 8, within = r0 & 255; const bool isup = within >= 128;
        const float* src = (isup ? a.in[21] : a.in[20]) + ((size_t)l * 16 + e) * DM * 512;
        tr_item8(src, 512, kb * 64, 128 * q + (within & 127) + n, (unsigned char*)W + W_GU + (size_t)e * DM * DM + (size_t)r0 * DM + kb * 64, DM, scr, F.lane); return; } j -= IT_GU;
    { const int e = j / 256, jj = j % 256, g = jj / 8, kb = jj % 8;
        tr_item8(a.in[22] + ((size_t)l * 16 + e) * 512 * DM, DM, kb * 64, g * 32 + n, (unsigned char*)W + W_D + (size_t)(e >> 1) * DM * DM + (size_t)(g * 32) * DM + (e & 1) * 512 + kb * 64, DM, scr, F.lane); }
}
__device__ __forceinline__ void ln_load(const Frame& F, const float* xrow, f32x4 (&v)[4]) {
    const GAS f32x4* xr = (const GAS f32x4*)xrow + F.lane;
#pragma unroll
    for (int j = 0; j < 4; ++j) v[j] = xr[64 * j];
}
struct LnGB { f32x4 g[4], b[4]; };
__device__ __forceinline__ void ln_gb_load(const Frame& F, const float* g, const float* b, LnGB& gb) {
#pragma unroll
    for (int j = 0; j < 4; ++j) { gb.g[j] = ((const GAS f32x4*)g)[F.lane + 64 * j]; gb.b[j] = ((const GAS f32x4*)b)[F.lane + 64 * j]; }
}
__device__ __forceinline__ void ln_load_bf(const Frame& F, const bf16* xrow, f32x4 (&v)[4]) {
    const GAS v2u* xr = (const GAS v2u*)xrow + F.lane;
#pragma unroll
    for (int j = 0; j < 4; ++j) { const v2u w = xr[64 * j]; v[j] = (f32x4){bfl(w.x), bfh(w.x), bfl(w.y), bfh(w.y)}; }
}
__device__ __forceinline__ void ln_row(const Frame& F, const LnGB& gb, float* orow  , bf16* brow  , f32x4 (&v)[4], bool dry = false, unsigned char* frow = nullptr  ) {
    float s = 0.f;
#pragma unroll
    for (int j = 0; j < 4; ++j) s += (v[j].x + v[j].y) + (v[j].z + v[j].w);
    const float mean = wave_sum(s) * (1.f / DM); float s2 = 0.f;
#pragma unroll
    for (int j = 0; j < 4; ++j) { v[j] = v[j] - mean; s2 += (v[j].x * v[j].x + v[j].y * v[j].y) + (v[j].z * v[j].z + v[j].w * v[j].w); }
    const float rstd = 1.f / sqrtf(wave_sum(s2) * (1.f / DM) + LN_EPS);
    GAS f32x4* o4 = (GAS f32x4*)orow + F.lane; GAS v2u* o8 = (GAS v2u*)brow + F.lane; GAS unsigned* o1 = (GAS unsigned*)frow + F.lane;
#pragma unroll
    for (int j = 0; j < 4; ++j) { v[j] = v[j] * rstd * gb.g[j] + gb.b[j]; v2u w; w.x = pk2(v[j].x, v[j].y); w.y = pk2(v[j].z, v[j].w); if (!dry) { if (orow) o4[64 * j] = v[j]; if (brow) o8[64 * j] = w; if (frow) o1[64 * j] = pk4_fp8(v[j].x, v[j].y, v[j].z, v[j].w); } }
}
__device__ __forceinline__ void p0_prologue(const Frame& F_, const Args& a) { Frame F = F_; F.lane = lane_id_(); F.tid = F.wave * 64 + F.lane;
    LAS float* scr = (LAS float*)(F.lds + RING_OFF + F.wave * 16384);
    const int gw = F.vcu * NWAVES + F.wave, NGW = F.G * NWAVES;
    for (int it = gw; it < DEPTH * IT_LAYER; it += NGW) p0_item(F, a, it, scr);
    { LnGB gb; ln_gb_load(F, a.in[1], a.in[2], gb); f32x4 nx[4]; ln_load(F, a.in[0] + (size_t)gw * DM, nx);
      for (int m = gw; m < NTOK; m += NGW) { f32x4 v[4];
#pragma unroll
          for (int j = 0; j < 4; ++j) v[j] = nx[j];
          if (m + NGW < NTOK) ln_load(F, a.in[0] + (size_t)(m + NGW) * DM, nx);
          ln_row(F, gb, nullptr, wsb(F, WS_HB) + (size_t)m * DM, v, false, F.ws + WS_HB8 + (size_t)m * DM); } }
}

#ifndef TO_WGM
#define TO_WGM 8
#endif
struct TileOrder {
    int nM, nN, nwg, G, c;
    __device__ void init(int nM_, int nN_, int G_, int c_) { nM = nM_; nN = nN_; nwg = nM * nN; G = G_; c = c_; }
    __device__ bool tile(int i, int& pm, int& pn) const {
        const long L = (long)i * G + c; if (L >= nwg) return false;
        int wgid = (int)L; { const int q = nwg / 8, r = nwg % 8, xcd = wgid % 8, off = wgid / 8; wgid = (xcd < r ? xcd * (q + 1) : r * (q + 1) + (xcd - r) * q) + off; }
        const int nig = TO_WGM * nN, gid = wgid / nig, fm = gid * TO_WGM, gsz = (nM - fm) < TO_WGM ? (nM - fm) : TO_WGM;
        pm = fm + ((wgid % nig) % gsz); pn = (wgid % nig) / gsz; return true;
    }
};
template <bool F8_> struct SchedAT { static constexpr int NT = 0, KS = 0; TileOrder T; const char* A; const char* B; unsigned map;
    __device__ bool next(int i, pg8::GU& u) const { int pm, pq; if (!T.tile(i, pm, pq)) return false; const int pn = (int)((map >> (4 * pq)) & 15u); constexpr size_t TS = F8_ ? pg8::TSTEP / 2 : pg8::TSTEP;
        u.A = A + (size_t)pm * TS; u.B0 = B + (size_t)pn * TS; u.B1 = u.B0; u.nt = F8_ ? 8 : 16; u.ks = u.nt; u.pm = pm; u.pn = pn; u.rows = nullptr; u.rbase = 0; u.rcnt = 0; u.a0 = 0; u.a1 = 0; return true; } };
template <bool F8_> struct EpiAT { static constexpr bool F8 = F8_; static constexpr bool PERM = true; bf16* P; float* FW; bf16* KIDX;
    __device__ __forceinline__ void operator()(const pg8::f32x4 (&acc)[2][2][4][2], const pg8::GU& u, int wr, int wc, int fr, int fq) {
        const float sc = ((u.pn == 1 || u.pn == 4) ? 0.125f * LOG2E : 1.f) * (F8_ ? 1.f / GATE_WSCALE : 1.f);
        const int row0 = u.pm * 256 + wr * 64 + fr, col0 = u.pn * 256 + wc * 32 + 8 * fq;
#pragma unroll
        for (int ai = 0; ai < 2; ++ai)
#pragma unroll
            for (int m = 0; m < 4; ++m) { const int row = row0 + ai * 128 + m * 16; bf16* rowp = P + (size_t)row * PS + col0;
#pragma unroll
                for (int bj = 0; bj < 2; ++bj) { const pg8::f32x4 v0 = acc[ai][bj][m][0] * sc, v1 = acc[ai][bj][m][1] * sc; v4u w;
                    w.x = pg8::cvt_pk_bf16(v0[0], v0[1]); w.y = pg8::cvt_pk_bf16(v0[2], v0[3]); w.z = pg8::cvt_pk_bf16(v1[0], v1[1]); w.w = pg8::cvt_pk_bf16(v1[2], v1[3]);
                    *(v4u*)(rowp + bj * 128) = w;
                    if (bj == 1 && u.pn == 8 && wc < 2) *(v4u*)(KIDX + (size_t)row * 64 + wc * 32 + 8 * fq) = w;
                    if (bj == 1 && u.pn == 8 && wc == 2 && fq == 0) { *(f32x4*)(FW + (size_t)row * 8) = v0; *(f32x4*)(FW + (size_t)row * 8 + 4) = v1; } } }
    } };
struct SchedC { TileOrder T; const char* HBp; const char* BRp; const char* WGp; const char* WBp; bool collapse;
    __device__ bool next(int i, pg8::GU& u) const { int pm, pd; if (!T.tile(i >> 3, pm, pd)) return false; const int sub = i & 7, n = sub >> 1, isg = sub & 1; const int pm_o = pm, pd_o = pd; if (collapse) { pm &= 7; pd = 0; }
        u.pm = pm; u.pn = pd; u.a0 = n; u.a1 = isg; u.rows = nullptr; u.rbase = 0; u.rcnt = 0;
        if (isg) { u.A = HBp + (size_t)pm * (pg8::TSTEP / 2); u.B0 = WGp + (size_t)(n * 8 + pd) * (pg8::HSTEP / 2); u.nt = 8; }
        else     { u.A = BRp + (size_t)pm * pg8::TSTEP + n * 512; u.B0 = WBp + (size_t)pd * pg8::HSTEP + n * 512; u.nt = 4; }
        u.B1 = u.B0; u.ks = u.nt; u.pm = pm_o; u.pn = pd_o; return true; } };
struct EpiC { static constexpr bool F8 = false; static constexpr bool PERM = true; bf16* MIX; const float* bgate; bool dry;
    __device__ __forceinline__ void operator()(const pg8::f32x4 (&acc)[2][4][2], pg8::u32x4 (&upk)[2][4], pg8::u32x4 (&sum)[2][4]  , const pg8::GU& u, int wr, int wc, int fr, int fq) {
        const int n = u.a0;
        if (!u.a1) {
#pragma unroll
            for (int ai = 0; ai < 2; ++ai)
#pragma unroll
                for (int m = 0; m < 4; ++m) { const pg8::f32x4 v0 = acc[ai][m][0], v1 = acc[ai][m][1]; v4u w;
                    w.x = pg8::cvt_pk_bf16(v0[0], v0[1]); w.y = pg8::cvt_pk_bf16(v0[2], v0[3]); w.z = pg8::cvt_pk_bf16(v1[0], v1[1]); w.w = pg8::cvt_pk_bf16(v1[2], v1[3]); upk[ai][m] = w; }
        } else {
            const int colt = u.pn * 128 + wc * 32 + 8 * fq; const float* bp = bgate + n * DM + colt; const f32x4 b0 = *(const f32x4*)bp, b1 = *(const f32x4*)(bp + 4);
#pragma unroll
            for (int ai = 0; ai < 2; ++ai)
#pragma unroll
                for (int m = 0; m < 4; ++m) { const v4u uw = upk[ai][m]; const pg8::f32x4 g0 = acc[ai][m][0] * (1.f / GATE_WSCALE) + b0, g1 = acc[ai][m][1] * (1.f / GATE_WSCALE) + b1;
                    pg8::f32x4 r0, r1; r0[0] = sigmoidf_(g0[0]) * bfl(uw.x); r0[1] = sigmoidf_(g0[1]) * bfh(uw.x); r0[2] = sigmoidf_(g0[2]) * bfl(uw.y); r0[3] = sigmoidf_(g0[3]) * bfh(uw.y);
                    r1[0] = sigmoidf_(g1[0]) * bfl(uw.z); r1[1] = sigmoidf_(g1[1]) * bfh(uw.z); r1[2] = sigmoidf_(g1[2]) * bfl(uw.w); r1[3] = sigmoidf_(g1[3]) * bfh(uw.w);
                    if (n > 0) { const v4u pw = sum[ai][m]; r0[0] += bfl(pw.x); r0[1] += bfh(pw.x); r0[2] += bfl(pw.y); r0[3] += bfh(pw.y); r1[0] += bfl(pw.z); r1[1] += bfh(pw.z); r1[2] += bfl(pw.w); r1[3] += bfh(pw.w); }
                    v4u o; o.x = pg8::cvt_pk_bf16(r0[0], r0[1]); o.y = pg8::cvt_pk_bf16(r0[2], r0[3]); o.z = pg8::cvt_pk_bf16(r1[0], r1[1]); o.w = pg8::cvt_pk_bf16(r1[2], r1[3]); sum[ai][m] = o; }
            if (n == 3) { const int row0 = u.pm * 256 + wr * 64 + fr; unsigned char* M8 = (unsigned char*)MIX;
#pragma unroll
                for (int ai = 0; ai < 2; ++ai)
#pragma unroll
                    for (int m = 0; m < 4; ++m) { const v4u pw = sum[ai][m]; v2u o;
                        o.x = pk4_fp8(bfl(pw.x) * MIX_SCALE, bfh(pw.x) * MIX_SCALE, bfl(pw.y) * MIX_SCALE, bfh(pw.y) * MIX_SCALE); o.y = pk4_fp8(bfl(pw.z) * MIX_SCALE, bfh(pw.z) * MIX_SCALE, bfl(pw.w) * MIX_SCALE, bfh(pw.w) * MIX_SCALE);
                        *(v2u*)(M8 + (size_t)(row0 + ai * 128 + m * 16) * DM + colt) = o; } }
        }
    } };
struct SchedC2 { static constexpr int NT = 0, KS = 0; TileOrder T; const char* A; const char* B;
    __device__ bool next(int i, pg8::GU& u) const { int pm, pn; if (!T.tile(i, pm, pn)) return false; u.A = A + (size_t)pm * (pg8::TSTEP / 2); u.B0 = B + (size_t)pn * (pg8::TSTEP / 2); u.B1 = u.B0; u.nt = 8; u.ks = 8; u.pm = pm; u.pn = pn; u.rows = nullptr; u.rbase = 0; u.rcnt = 0; u.a0 = 0; u.a1 = 0; return true; } };
struct EpiRes { static constexpr bool F8 = true; static constexpr bool PERM = false; bf16* V1; const bf16* HB; bool dry;
    __device__ __forceinline__ void operator()(const pg8::f32x4 (&acc)[2][2][4][2], const pg8::GU& u, int wr, int wc, int fr, int fq) {
        const int row0 = u.pm * 256 + wr * 64 + fr, col0 = u.pn * 256 + wc * 32 + 4 * fq;
#pragma unroll
        for (int ai = 0; ai < 2; ++ai)
#pragma unroll
            for (int m = 0; m < 4; ++m) { const size_t ro = (size_t)(row0 + ai * 128 + m * 16) * DM + col0;
#pragma unroll
                for (int bj = 0; bj < 2; ++bj)
#pragma unroll
                    for (int n = 0; n < 2; ++n) { const v2u hw = *(const v2u*)(HB + ro + bj * 128 + n * 16); const f32x4 hv = (f32x4){bfl(hw.x), bfh(hw.x), bfl(hw.y), bfh(hw.y)};
                        const f32x4 r_ = hv * ALPHA + acc[ai][bj][m][n] * (1.f / (MIX_SCALE * GATE_WSCALE)); v2u o; o.x = pk2(r_.x, r_.y); o.y = pk2(r_.z, r_.w); if (!dry) *(v2u*)(V1 + ro + bj * 128 + n * 16) = o; } }
    } };
__device__ __forceinline__ void cls_lookup(const LAS int* tab, int tau, int& c, int& j) {
    int cc = 0;
#pragma unroll 1
    for (int k = 1; k < NCLS; ++k) if (tab[32 + k] <= tau) cc = k;
    c = cc; j = tau - tab[32 + cc];
}
__device__ __forceinline__ void cls_experts(int c, int& ea, int& eb) { const int g = c / 6, p = c % 6; const int i = p < 3 ? 0 : (p < 5 ? 1 : 2); const int jj = p < 3 ? p + 1 : (p < 5 ? p - 1 : 3); ea = g * 4 + i; eb = g * 4 + jj; }
struct SchedD1 { static constexpr int NT = 0, KS = 0; const LAS int* tab; int G, c0; const char* HBp; const char* WGU; const int* list;
    __device__ bool next(int i, pg8::GU& u) const { const int L = i * G + c0; if (L >= tab[57] * 8) return false; const int tau = L >> 3, pn = L & 7; int c, j; cls_lookup(tab, tau, c, j); int ea, eb; cls_experts(c, ea, eb);
        const int e = (pn >> 2) ? eb : ea;
        u.A = HBp; u.B0 = WGU + (size_t)e * DM * DM + (size_t)(pn & 3) * (pg8::TSTEP / 2); u.B1 = u.B0; u.nt = 8; u.ks = 8;     u.rows = list + (size_t)c * NTOK; u.rbase = j * 256; u.rcnt = tab[c];
        u.pm = tau; u.pn = pn; u.a0 = c; u.a1 = j; return true; } };
struct EpiD1 { static constexpr bool F8 = true; static constexpr bool PERM = true; unsigned char* ACT; const float* gwl;
    __device__ __forceinline__ void operator()(const pg8::f32x4 (&acc)[2][2][4][2], const pg8::GU& u, int wr, int wc, int fr, int fq) {
        const int half = u.pn >> 2, col = half * 512 + (u.pn & 3) * 128 + wc * 32 + 8 * fq;
#pragma unroll
        for (int ai = 0; ai < 2; ++ai)
#pragma unroll
            for (int m = 0; m < 4; ++m) { const int r = ai * 128 + wr * 64 + m * 16 + opaque_i(fr), pos = u.rbase + r;
                const float gw = pos < u.rcnt ? gwl[((size_t)u.a0 * NTOK + pos) * 2 + half] * ACT_SCALE : 0.f;
                const pg8::f32x4 g0 = acc[ai][0][m][0] * (1.f / GATE_WSCALE), g1 = acc[ai][0][m][1] * (1.f / GATE_WSCALE), u0 = acc[ai][1][m][0] * (1.f / GATE_WSCALE), u1 = acc[ai][1][m][1] * (1.f / GATE_WSCALE); float r8[8];
#pragma unroll
                for (int k = 0; k < 4; ++k) { r8[k] = g0[k] * sigmoidf_(g0[k]) * u0[k] * gw; r8[4 + k] = g1[k] * sigmoidf_(g1[k]) * u1[k] * gw; }
                v2u o; o.x = pk4_fp8(r8[0], r8[1], r8[2], r8[3]); o.y = pk4_fp8(r8[4], r8[5], r8[6], r8[7]);
                *(v2u*)(ACT + ((size_t)u.pm * 256 + r) * DM + col) = o; asm volatile("" ::: "memory"); }
    } };
struct SchedD2 { static constexpr int NT = 8, KS = 4; const LAS int* tab; int G, c0; const char* ACTp; const char* WD; const int* list;
    __device__ bool next(int i, pg8::GU& u) const { const int L = i * G + c0; if (L >= __builtin_amdgcn_readfirstlane(tab[57]) * 4) return false; const int tau = L >> 2, pn = L & 3; int c, j; cls_lookup(tab, tau, c, j); c = __builtin_amdgcn_readfirstlane(c); j = __builtin_amdgcn_readfirstlane(j); int ea, eb; cls_experts(c, ea, eb);
        u.A = sptr_(ACTp + (size_t)tau * (pg8::TSTEP / 2)); u.B0 = sptr_(WD + (size_t)(ea >> 1) * DM * DM + (ea & 1) * 512 + (size_t)pn * (pg8::TSTEP / 2)); u.B1 = sptr_(WD + (size_t)(eb >> 1) * DM * DM + (eb & 1) * 512 + (size_t)pn * (pg8::TSTEP / 2));
        u.nt = 8; u.ks = 4;     u.rows = list + (size_t)c * NTOK; u.rbase = j * 256; u.rcnt = __builtin_amdgcn_readfirstlane(tab[c]); u.pm = tau; u.pn = pn; u.a0 = c; u.a1 = j; return true; } };
struct EpiD2 { static constexpr bool F8 = true; static constexpr bool PERM = false; bf16* V2; const bf16* HB; bool dry;
    __device__ __forceinline__ void operator()(const pg8::f32x4 (&acc)[2][2][4][2], const pg8::GU& u, int wr, int wc, int fr, int fq) {
        const int col0 = u.pn * 256 + wc * 32 + 4 * fq;
#pragma unroll
        for (int ai = 0; ai < 2; ++ai) { asm volatile("" ::: "memory");
#pragma unroll
            for (int m = 0; m < 4; ++m) { if (m == 2) asm volatile("" ::: "memory"); const int pos = u.rbase + ai * 128 + wr * 64 + m * 16 + opaque_i(fr);
                if (pos < u.rcnt) { const size_t ro = (size_t)u.rows[pos] * DM + col0;
#pragma unroll
                    for (int bj = 0; bj < 2; ++bj)
#pragma unroll
                        for (int n = 0; n < 2; ++n) { const v2u hw = *(const v2u*)(HB + ro + bj * 128 + n * 16); const f32x4 hv = (f32x4){bfl(hw.x), bfh(hw.x), bfl(hw.y), bfh(hw.y)};
                            const f32x4 r_ = hv * ALPHA + acc[ai][bj][m][n] * (1.f / (ACT_SCALE * GATE_WSCALE)); v2u o; o.x = pk2(r_.x, r_.y); o.y = pk2(r_.z, r_.w); if (!dry) *(v2u*)(V2 + ro + bj * 128 + n * 16) = o; } } } }
    } };
typedef float f32x2v __attribute__((ext_vector_type(2)));
__device__ __forceinline__ float log_sigmoid_(float x) { return fminf(x, 0.f) - __builtin_amdgcn_logf(1.f + __builtin_amdgcn_exp2f(-fabsf(x) * LOG2E)) * 0.6931471805599453f; }
__device__ __forceinline__ void fox_cumsum(const Frame& F_, int bh, const float* FW, const float* bfor, float* bias2) { Frame F = F_; F.lane = lane_id_(); F.tid = F.wave * 64 + F.lane;
    const int b = bh >> 2, h = bh & 3; const float bf = bfor[h]; const float* src = FW + ((size_t)b * SEQ + F.lane * 64) * 8 + h; float tot = 0.f;
    for (int i = 0; i < 64; ++i) tot += log_sigmoid_(src[(size_t)i * 8] + bf);
    float inc = tot;
#pragma unroll
    for (int o = 1; o < 64; o <<= 1) { const float t = __int_as_float(shfl_i_(__float_as_int(inc), F.lane - o)); if (F.lane >= o) inc += t; }
    float run = inc - tot; float* dst = bias2 + (size_t)bh * SEQ + F.lane * 64;
    for (int i = 0; i < 64; ++i) { run += log_sigmoid_(src[(size_t)i * 8] + bf); dst[i] = -run * LOG2E; }
}
template <int WIN> __device__ __forceinline__ void pool_frags(bf16x8 (&af)[4], const bf16* src0, int tb) {
    const int nrow = tb + 1 < WIN ? tb + 1 : WIN; const float inv = 1.f / (float)nrow;
#pragma unroll
    for (int ks = 0; ks < 4; ++ks) { const bf16* src = src0 + ks * 16; v4u wv[WIN];
#pragma unroll
        for (int j = 0; j < WIN; ++j) wv[j] = *(const v4u*)(src - (size_t)(j <= tb ? j : 0) * PS);
        float s[8];
#pragma unroll
        for (int k = 0; k < 8; ++k) s[k] = 0.f;
#pragma unroll
        for (int j = 0; j < WIN; ++j) { if (j <= tb) { const v4u w = wv[j];
            s[0] += bfl(w.x); s[1] += bfh(w.x); s[2] += bfl(w.y); s[3] += bfh(w.y); s[4] += bfl(w.z); s[5] += bfh(w.z); s[6] += bfl(w.w); s[7] += bfh(w.w); } }
        const v4u cur = wv[0];
        const float c[8] = {bfl(cur.x), bfh(cur.x), bfl(cur.y), bfh(cur.y), bfl(cur.z), bfh(cur.z), bfl(cur.w), bfh(cur.w)};
        v4u o; o.x = pk2(s[0] * inv - c[0], s[1] * inv - c[1]); o.y = pk2(s[2] * inv - c[2], s[3] * inv - c[3]); o.z = pk2(s[4] * inv - c[4], s[5] * inv - c[5]); o.w = pk2(s[6] * inv - c[6], s[7] * inv - c[7]);
        af[ks] = __builtin_bit_cast(bf16x8, o); }
}
__device__ __forceinline__ void pool_unit(const Frame& F_, int tile, const bf16* P, const float* pw, const float* pscale, bf16* BR) { Frame F = F_; F.lane = lane_id_(); F.tid = F.wave * 64 + F.lane;
    const int g = F.wave & 3, th = F.wave >> 2, r32 = F.lane & 31, hi = F.lane >> 5;
    const int tok = tile * 64 + th * 32 + r32, tb = tok & (SEQ - 1);
    const bf16* src0 = P + (size_t)tok * PS + C_POOL + g * 64 + hi * 8;
    bf16x8 af[4];
    if (g == 0) pool_frags<2>(af, src0, tb); else if (g == 1) pool_frags<4>(af, src0, tb); else if (g == 2) pool_frags<8>(af, src0, tb); else pool_frags<16>(af, src0, tb);
#pragma unroll
    for (int db = 0; db < 2; ++db) { f32x16 acc = {};
#pragma unroll
        for (int ks = 0; ks < 4; ++ks) { const float* wp = pw + ((size_t)g * 64 + ks * 16 + hi * 8) * 64 + db * 32 + r32;
            v4u o; o.x = pk2(wp[0], wp[64]); o.y = pk2(wp[128], wp[192]); o.z = pk2(wp[256], wp[320]); o.w = pk2(wp[384], wp[448]);
            acc = __builtin_amdgcn_mfma_f32_32x32x16_bf16(af[ks], __builtin_bit_cast(bf16x8, o), acc, 0, 0, 0); }
        const int col = g * 64 + db * 32 + r32; const float sc = pscale[col];
#pragma unroll
        for (int r = 0; r < 16; ++r) { const int row = tile * 64 + th * 32 + (r & 3) + 8 * (r >> 2) + 4 * hi; BR[(size_t)row * DM + col] = (bf16)f2bf(acc[r] * sc); } }
}
__device__ __forceinline__ void conv_unit(const Frame& F_, int tile, const bf16* P, const float* dw, const float* cb, const float* lg, const float* lb, bf16* BR) { Frame F = F_; F.lane = lane_id_(); F.tid = F.wave * 64 + F.lane;
    LAS float* hb = (LAS float*)(F.lds + RING_OFF);
    LAS float* yb = hb + 62 * 256;
    const int t0 = tile * 32, tb0 = t0 & (SEQ - 1);
    { v4u av[4], gv[4];
#pragma unroll
      for (int k = 0; k < 4; ++k) { const int e = F.tid + k * NWAVES * 64, rr = e >> 5, c8 = (e & 31) * 8, trel = rr - 30; const bool ok = e < 62 * 32 && tb0 + trel >= 0;
          const bf16* src = P + (size_t)(t0 + (ok ? trel : 0)) * PS + C_CONV + c8; av[k] = *(const v4u*)src; gv[k] = *(const v4u*)(src + 256); }
#pragma unroll
      for (int k = 0; k < 4; ++k) { const int e = F.tid + k * NWAVES * 64, rr = e >> 5, c8 = (e & 31) * 8, trel = rr - 30; const bool ok = tb0 + trel >= 0; const v4u a = av[k], gt = gv[k]; float h[8];
          h[0] = bfl(a.x) * sigmoidf_(bfl(gt.x)); h[1] = bfh(a.x) * sigmoidf_(bfh(gt.x)); h[2] = bfl(a.y) * sigmoidf_(bfl(gt.y)); h[3] = bfh(a.y) * sigmoidf_(bfh(gt.y));
          h[4] = bfl(a.z) * sigmoidf_(bfl(gt.z)); h[5] = bfh(a.z) * sigmoidf_(bfh(gt.z)); h[6] = bfl(a.w) * sigmoidf_(bfl(gt.w)); h[7] = bfh(a.w) * sigmoidf_(bfh(gt.w));
          if (!ok) {
#pragma unroll
              for (int q = 0; q < 8; ++q) h[q] = 0.f; }
          if (e < 62 * 32) { *(LAS f32x4*)(hb + rr * 256 + c8) = (f32x4){h[0], h[1], h[2], h[3]}; *(LAS f32x4*)(hb + rr * 256 + c8 + 4) = (f32x4){h[4], h[5], h[6], h[7]}; } } }
    __syncthreads();
    { const int c = F.tid & 255, hf = F.tid >> 8; float w[31];
#pragma unroll
      for (int j = 0; j < 31; ++j) w[j] = dw[j * 256 + c];
      const float bias = cb[c];
#pragma unroll 1
      for (int q4 = 0; q4 < 4; ++q4) { const int tt = hf * 16 + q4 * 4; float x[34];
#pragma unroll
          for (int j = 0; j < 34; ++j) x[j] = hb[(tt + j) * 256 + c];
#pragma unroll
          for (int o = 0; o < 4; ++o) { float a = bias;
#pragma unroll
              for (int j = 0; j < 31; ++j) a += x[o + j] * w[j];
              yb[(tt + o) * 256 + c] = a; } } }
    __syncthreads();
#pragma unroll 1
    for (int q = 0; q < 4; ++q) { const int tt = F.wave * 4 + q; const f32x4 v = *(const LAS f32x4*)(yb + tt * 256 + F.lane * 4);
        const float mean = wave_sum((v.x + v.y) + (v.z + v.w)) * (1.f / 256.f); const f32x4 d = v - mean;
        const float var = wave_sum((d.x * d.x + d.y * d.y) + (d.z * d.z + d.w * d.w)) * (1.f / 256.f); const float rstd = 1.f / sqrtf(var + LN_EPS);
        const f32x4 gg = *(const f32x4*)(lg + F.lane * 4), bb = *(const f32x4*)(lb + F.lane * 4); const f32x4 y = d * rstd * gg + bb;
        v2u o; o.x = pk2(y.x * sigmoidf_(y.x), y.y * sigmoidf_(y.y)); o.y = pk2(y.z * sigmoidf_(y.z), y.w * sigmoidf_(y.w));
        *(v2u*)(BR + (size_t)(t0 + tt) * DM + 768 + F.lane * 4) = o; }
    __syncthreads();
}
__device__ __forceinline__ int key28_(float s) { const int u = (int)__float_as_uint(s); int m = (u & 0x7fffffff) - 0x3B000000; m = m < 0 ? 0 : (m > 0x07FFFFFF ? 0x07FFFFFF : m); return 0x08000000 + (m ^ (u >> 31)); }
__device__ __forceinline__ int key9_(float s) { const int u = (int)__float_as_uint(s); int m = ((u >> 19) & 0xfff) - 0x760; m = m < 0 ? 0 : (m > 255 ? 255 : m); return 256 + (m ^ (u >> 31)); }
__device__ __forceinline__ float key28_lbound(long long kv) {
    if (kv <= 0) return -INFINITY; if (kv > 0x0FFFFFFFll) return INFINITY;
    if (kv > 0x08000000ll) return __uint_as_float((unsigned)(0x3B000000ll + (kv - 0x08000000ll)));
    if (kv == 0x08000000ll) return 0.f;
    return -__uint_as_float((unsigned)(0x3B000000ll + (0x07FFFFFFll - kv)));
}
constexpr int DS_HIST = 0, DS_GT = 65536, DS_EQ = 81920, DS_KT = 98304, DS_SM = LDSCTL_OFF + 1024 - RING_OFF, DS_CAP = 512;
typedef float f32x2p __attribute__((ext_vector_type(2)));
__device__ __forceinline__ float relu_(float x) { const int b = (int)__float_as_uint(x); return __uint_as_float((unsigned)(b > 0 ? b : 0)); }
__device__ __forceinline__ void dsa_ldk(bf16x8 (&kf)[4], const bf16* kp) {
#pragma unroll
    for (int m = 0; m < 4; ++m) kf[m] = *(const bf16x8*)(kp + m * 512);
}
__device__ __forceinline__ void dsa_kfrag(bf16x8 (&kf)[4], const bf16x8 (&raw)[4], LAS unsigned char* kt, int lane) {
    const int rw = lane >> 3, cw = lane & 7, r32 = lane & 31, hi = lane >> 5;
#pragma unroll
    for (int m = 0; m < 4; ++m) *(LAS bf16x8*)(kt + (8 * m + rw) * 128 + ((cw ^ rw) << 4)) = raw[m];
#pragma unroll
    for (int ks = 0; ks < 4; ++ks) kf[ks] = *(const LAS bf16x8*)(kt + r32 * 128 + (((2 * ks + hi) ^ (r32 & 7)) << 4));
}
__device__ __forceinline__ void dsa_scores(const bf16x8 (&qf)[4][4], const bf16x8 (&kf)[4], const float (&w)[4], float (&sc)[16]) {
    f32x16 a[4];
#pragma unroll
    for (int hh = 0; hh < 4; ++hh) { a[hh] = (f32x16){};
#pragma unroll
        for (int ks = 0; ks < 4; ++ks) a[hh] = __builtin_amdgcn_mfma_f32_32x32x16_bf16(kf[ks], qf[hh][ks], a[hh], 0, 0, 0); }
#pragma unroll
    for (int r = 0; r < 16; r += 2) { f32x2p s2 = (f32x2p){relu_(a[0][r]), relu_(a[0][r + 1])} * w[0];
#pragma unroll
        for (int hh = 1; hh < 4; ++hh) s2 = (f32x2p){relu_(a[hh][r]), relu_(a[hh][r + 1])} * w[hh] + s2;
        sc[r] = s2.x + 0.f; sc[r + 1] = s2.y + 0.f; }
}
template <int NB4> __device__ __forceinline__ void hist_scan(const LAS unsigned* h, int K, int lane, int& bin, int& above, int& inbin, int* total = nullptr) {
    unsigned hv[NB4 * 4]; int s = 0;
#pragma unroll
    for (int g = 0; g < NB4; ++g) { const v4u t = *(const LAS v4u*)(h + NB4 * 4 * lane + 4 * g); hv[4 * g] = t.x; hv[4 * g + 1] = t.y; hv[4 * g + 2] = t.z; hv[4 * g + 3] = t.w; s += (int)(t.x + t.y + t.z + t.w); }
    int suf = s;
#pragma unroll
    for (int o = 1; o < 64; o <<= 1) { const int t = shfl_i_(suf, lane + o); if (lane + o < 64) suf += t; }
    if (total) *total = __builtin_amdgcn_readfirstlane(suf);
    const int excl = suf - s; const bool hit = (excl < K) && (K <= suf);
    int b = 0, c = excl, nb = 0; bool done = false;
#pragma unroll
    for (int k = NB4 * 4 - 1; k >= 0; --k) { if (!done) { if (c + (int)hv[k] >= K) { b = k; nb = (int)hv[k]; done = true; } else c += (int)hv[k]; } }
    const unsigned long long m = __ballot(hit); const int src = m ? (int)__builtin_ctzll(m) : 0;
    bin = __builtin_amdgcn_readlane(NB4 * 4 * lane + b, src); above = __builtin_amdgcn_readlane(c, src); inbin = __builtin_amdgcn_readlane(nb, src);
    if (!m) { bin = 0; above = 0; inbin = 0; }
}
#define DSA_ONE_TILE(KF, I, ...) do { const int i = (I); float sc[16]; { bf16x8 kfr[4]; dsa_kfrag(kfr, KF, ktile, F.lane); dsa_scores(qf, kfr, w, sc); } \
        if (i == j) { constexpr bool DIAG = true; __VA_ARGS__ } else { constexpr bool DIAG = false; __VA_ARGS__ } } while (0)
#define DSA_TILE_LOOP_S(STRIDE, ...) do { bf16x8 ka[4], kb[4]; int i0 = F.wave; \
    { const int ia = i0 <= j ? i0 : 0, ib = i0 + (STRIDE) <= j ? i0 + (STRIDE) : ia; dsa_ldk(ka, kbase + (size_t)ia * 32 * 64); dsa_ldk(kb, kbase + (size_t)ib * 32 * 64); } \
    _Pragma("unroll 1") for (; i0 <= j; i0 += 2 * (STRIDE)) { bf16x8 na[4], nb[4]; \
        { const int ia = i0 + 2 * (STRIDE) <= j ? i0 + 2 * (STRIDE) : i0, ib = i0 + 3 * (STRIDE) <= j ? i0 + 3 * (STRIDE) : i0; dsa_ldk(na, kbase + (size_t)ia * 32 * 64); dsa_ldk(nb, kbase + (size_t)ib * 32 * 64); } \
        __builtin_amdgcn_sched_barrier(0); \
        DSA_ONE_TILE(ka, i0, __VA_ARGS__); \
        if (i0 + (STRIDE) <= j) DSA_ONE_TILE(kb, i0 + (STRIDE), __VA_ARGS__); \
        _Pragma("unroll") for (int ks = 0; ks < 4; ++ks) { ka[ks] = na[ks]; kb[ks] = nb[ks]; } } } while (0)
#define DSA_TILE_LOOP(...) DSA_TILE_LOOP_S(NWAVES, __VA_ARGS__)
#define DSA_VALID(r) (!DIAG || ((r) & 3) + 8 * ((r) >> 2) <= qlim)
__device__ __forceinline__ void dsa_mask_unit(const Frame& F_, int b, int j, const bf16* P, const bf16* KIDX, const float* FW, unsigned long long* selw) { Frame F = F_; F.lane = lane_id_(); F.tid = F.wave * 64 + F.lane;
    LAS unsigned* HIST = (LAS unsigned*)(F.lds + RING_OFF + DS_HIST);
    LAS unsigned* GT = (LAS unsigned*)(F.lds + RING_OFF + DS_GT);
    LAS unsigned* EQ = (LAS unsigned*)(F.lds + RING_OFF + DS_EQ);
    LAS int* SM = (LAS int*)(F.lds + RING_OFF + DS_SM); volatile LAS unsigned* PRB = (volatile LAS unsigned*)(F.lds + LDSCTL_OFF + 512);
    PROBE_BEGIN(1);
    const int r32 = F.lane & 31, hi = F.lane >> 5, t0 = j * 32; const size_t brow = (size_t)b * SEQ;
    bf16x8 qf[4][4];
#pragma unroll
    for (int hh = 0; hh < 4; ++hh)
#pragma unroll
        for (int ks = 0; ks < 4; ++ks) qf[hh][ks] = *(const bf16x8*)(P + (brow + t0 + r32) * PS + C_IQ + hh * 64 + ks * 16 + hi * 8);
    float w[4]; { const f32x4 wv = *(const f32x4*)(FW + (brow + t0 + r32) * 8 + 4); w[0] = wv.x; w[1] = wv.y; w[2] = wv.z; w[3] = wv.w; }
    const bf16* kbase = KIDX + brow * 64 + F.lane * 8;
    LAS unsigned char* ktile = F.lds + RING_OFF + DS_KT + F.wave * 4096;
    const int qlim = r32 - 4 * hi;
    LAS unsigned* hrow = HIST + r32 * 512;
#define DSA_ZERO_HIST() do { const unsigned z_ = (unsigned)opaque_i(0); for (int e = F.tid; e < 4096; e += NWAVES * 64) ((LAS v4u*)HIST)[e] = (v4u){z_, z_, z_, z_}; } while (0)
    DSA_ZERO_HIST();
    if (F.tid < 64) SM[128 + F.tid] = 0;
    __syncthreads();
    PROBE_END(1); PROBE_BEGIN(2);
#if REP_PHASE == 41
    { float dummy = 0.f; DSA_TILE_LOOP({ _Pragma("unroll") for (int r = 0; r < 16; ++r) dummy += sc[r]; }); if (dummy == 12345.678f) SM[170] = 1; }
#endif
#if REP_PHASE == 42
    { LAS unsigned* drow = EQ + (r32 & 7) * 512; DSA_TILE_LOOP({ _Pragma("unroll") for (int r = 0; r < 16; ++r) { const int kh = key28_(sc[r]) >> 19; if (DSA_VALID(r)) __hip_atomic_fetch_add(drow + kh, 1u, __ATOMIC_RELAXED, __HIP_MEMORY_SCOPE_WORKGROUP); } }); }
#endif
#if REP_PHASE == 43
    { DSA_ZERO_HIST(); __syncthreads(); for (int q = F.wave * 4; q < F.wave * 4 + 4; ++q) { int bin, above, inbin; hist_scan<2>(HIST + q * 512, 256, F.lane, bin, above, inbin); if (F.lane == 0) SM[171] = bin; } __syncthreads(); __syncthreads(); __syncthreads(); }
#endif
    DSA_TILE_LOOP({ _Pragma("unroll")
        for (int r = 0; r < 16; ++r) { const int kh = key9_(sc[r]); if (DSA_VALID(r)) __hip_atomic_fetch_add(hrow + kh, 1u, __ATOMIC_RELAXED, __HIP_MEMORY_SCOPE_WORKGROUP); } });
    __syncthreads();
    PROBE_END(2); PROBE_BEGIN(3);
#pragma unroll 1
    for (int q = F.wave * 4; q < F.wave * 4 + 4; ++q) { int bin, above, inbin; hist_scan<2>(HIST + q * 512, 256, F.lane, bin, above, inbin);
        if (F.lane == 0) { const int total = t0 + q + 1;
            if (total <= 256) { SM[q] = -1; SM[32 + q] = 0; SM[64 + q] = 0; SM[96 + q] = 0; }
            else { SM[q] = bin; SM[32 + q] = above; SM[64 + q] = inbin; SM[96 + q] = 256 - above; if (inbin > DS_CAP) SM[160] = 1; } } }
    __syncthreads();
    PROBE_END(3); PROBE_BEGIN(4);
    const int myb1 = SM[r32];
    if (SM[160] == 0) {
        const float lge = key28_lbound((long long)myb1 << 19), lgt = key28_lbound(((long long)myb1 + 1) << 19);
        LAS unsigned* lrow = HIST + r32 * DS_CAP;
        DSA_TILE_LOOP({ unsigned gtw = 0u; unsigned cw = 0u; _Pragma("unroll")
            for (int r = 0; r < 16; ++r) { const int bit = (r & 3) + 8 * (r >> 2); const bool valid = DSA_VALID(r);
                if (valid && sc[r] >= lgt) gtw |= 1u << bit; else if (valid && sc[r] >= lge) cw |= 1u << r; }
            if (cw) {
                LAS float* sl = (LAS float*)ktile + F.lane; _Pragma("unroll")
                for (int r = 0; r < 16; ++r) sl[r * 64] = sc[r];
                int slot = (int)__hip_atomic_fetch_add((LAS unsigned*)SM + 128 + r32, (unsigned)__popc(cw), __ATOMIC_RELAXED, __HIP_MEMORY_SCOPE_WORKGROUP);
                while (cw) { const int r = __builtin_ctz(cw); cw &= cw - 1u; const float sv = sl[r * 64]; const int bit = (r & 3) + 8 * (r >> 2);
                    if (slot < DS_CAP) lrow[slot] = ((unsigned)(key28_(sv) & 0x7FFFF) << 12) | (unsigned)(4095 - (i * 32 + bit + 4 * hi)); ++slot; } }
            gtw <<= 4 * hi; gtw |= (unsigned)shfl_i_((int)gtw, F.lane ^ 32);
            if (hi == 0) GT[i * 32 + r32] = gtw; });
        __syncthreads();
        PROBE_END(4); PROBE_BEGIN(5);
#pragma unroll 1
        for (int q = F.wave * 4; q < F.wave * 4 + 4; ++q) { const int n = SM[128 + q] < DS_CAP ? SM[128 + q] : DS_CAP, quota = SM[96 + q]; const LAS unsigned* lq = HIST + q * DS_CAP;
            for (int c0 = 0; c0 < n; c0 += 64) { const int ci = c0 + F.lane; const unsigned e = ci < n ? lq[ci] : 0xffffffffu; int rank = 0;
                int k = 0;
                for (; k + 16 <= n; k += 16) { const v4u c0 = *(const LAS v4u*)(lq + k), c1 = *(const LAS v4u*)(lq + k + 4), c2 = *(const LAS v4u*)(lq + k + 8), c3 = *(const LAS v4u*)(lq + k + 12);
                    rank += (c0.x > e ? 1 : 0) + (c0.y > e ? 1 : 0) + (c0.z > e ? 1 : 0) + (c0.w > e ? 1 : 0) + (c1.x > e ? 1 : 0) + (c1.y > e ? 1 : 0) + (c1.z > e ? 1 : 0) + (c1.w > e ? 1 : 0)
                          + (c2.x > e ? 1 : 0) + (c2.y > e ? 1 : 0) + (c2.z > e ? 1 : 0) + (c2.w > e ? 1 : 0) + (c3.x > e ? 1 : 0) + (c3.y > e ? 1 : 0) + (c3.z > e ? 1 : 0) + (c3.w > e ? 1 : 0); }
                for (; k < n; ++k) rank += (lq[k] > e) ? 1 : 0;
                if (ci < n && rank < quota) { const int idx = 4095 - (int)(e & 4095u); __hip_atomic_fetch_or(GT + (idx >> 5) * 32 + q, 1u << (idx & 31), __ATOMIC_RELAXED, __HIP_MEMORY_SCOPE_WORKGROUP); } } }
        __syncthreads();
    } else {
        DSA_ZERO_HIST();
        __syncthreads();
        DSA_TILE_LOOP({ _Pragma("unroll")
            for (int r = 0; r < 16; ++r) { const int k = key28_(sc[r]); if ((k >> 19) == myb1 && DSA_VALID(r)) __hip_atomic_fetch_add(hrow + ((k >> 11) & 255), 1u, __ATOMIC_RELAXED, __HIP_MEMORY_SCOPE_WORKGROUP); } });
        __syncthreads();
#pragma unroll 1
        for (int q = F.wave * 4; q < F.wave * 4 + 4; ++q) { int bin, above, inbin; const int b1 = SM[q], ab1 = SM[32 + q]; hist_scan<1>(HIST + q * 512, 256 - ab1, F.lane, bin, above, inbin);
            if (F.lane == 0) { if (b1 < 0) { SM[192 + q] = -1; SM[96 + q] = 0; SM[224 + q] = 0; }
                else { const int quota = 256 - (ab1 + above); SM[192 + q] = (b1 << 8) | bin; SM[96 + q] = quota; SM[224 + q] = inbin; if (quota < inbin) SM[161] = 1; } } }
        __syncthreads();
        const int thr = SM[192 + r32]; const bool allacc = SM[96 + r32] >= SM[224 + r32];
        const float lge = key28_lbound((long long)thr << 11), lgt = key28_lbound(((long long)thr + 1) << 11);
        DSA_TILE_LOOP({ unsigned gtw = 0u; unsigned gew = 0u; _Pragma("unroll")
            for (int r = 0; r < 16; ++r) { const int bit = (r & 3) + 8 * (r >> 2); const bool valid = DSA_VALID(r);
                if (valid && sc[r] >= lgt) gtw |= 1u << bit; if (valid && sc[r] >= lge) gew |= 1u << bit; }
            gtw <<= 4 * hi; gew <<= 4 * hi;
            gtw |= (unsigned)shfl_i_((int)gtw, F.lane ^ 32); gew |= (unsigned)shfl_i_((int)gew, F.lane ^ 32);
            unsigned eqw = gew & ~gtw;
            if (allacc) { gtw = gew; eqw = 0u; }
            if (hi == 0) GT[i * 32 + r32] = gtw; else EQ[i * 32 + r32] = eqw; });
        __syncthreads();
        if (SM[161] != 0 && F.tid < 32) { const int q = F.tid; const int quota = SM[96 + q]; if (quota < SM[224 + q]) { int run = 0;
                for (int i = 0; i <= j; ++i) { unsigned e = EQ[i * 32 + q]; if (e) { const int allowed = quota - run; if (allowed <= 0) e = 0u; else { int pc = __popc(e); while (pc > allowed) { e &= ~(0x80000000u >> __clz(e)); --pc; } }
                        run += __popc(e); GT[i * 32 + q] |= e; } } } }
        __syncthreads();
    }
    PROBE_END(5); PROBE_BEGIN(6);
    { const int ntile64 = 4 * (j / 8 + 1); unsigned long long* dst = selw + (size_t)b * 64 * SEQ + t0;
      for (int e = F.tid; e < ntile64 * 32; e += NWAVES * 64) { const int T = e >> 5, q = e & 31; const unsigned lo = (2 * T <= j) ? GT[(2 * T) * 32 + q] : 0u, up = (2 * T + 1 <= j) ? GT[(2 * T + 1) * 32 + q] : 0u;
          dst[(size_t)T * SEQ + q] = ((unsigned long long)up << 32) | lo; } }
    __syncthreads();
    PROBE_END(6);
}
#undef DSA_TILE_LOOP
#undef DSA_ZERO_HIST
#undef DSA_TILE_LOOP_S
#undef DSA_ONE_TILE
#undef DSA_VALID
__device__ __forceinline__ void ln1_router_phase(const Frame& F_, const Args& a, int l, bool dry = false) { Frame F = F_; F.lane = lane_id_(); F.tid = F.wave * 64 + F.lane;
    LAS float* RW = (LAS float*)(F.lds + RING_OFF);
    LAS int* LC = (LAS int*)(F.lds + RING_OFF + 81920);
    LAS int* LTOK = LC + 64;
    LAS int* LCLS = LTOK + 128; LAS int* LPOS = LCLS + 128; LAS float* LGA = (LAS float*)(LPOS + 128); LAS float* LGB = LGA + 128;
    volatile LAS unsigned* PRB = (volatile LAS unsigned*)(F.lds + LDSCTL_OFF + 512);
    PROBE_BEGIN(31);
    const float* rg = a.in[16] + (size_t)l * DM * 4; const float* re = a.in[18] + (size_t)l * DM * 16;
    for (int e = F.tid; e < DM * 4; e += NWAVES * 64) { const int k = e >> 2, c = e & 3, ln = (k & 255) >> 2, kidx = (k >> 8) * 4 + (k & 3); RW[((kidx * 5 + 0) * 64 + ln) * 4 + c] = rg[e]; }
    for (int e = F.tid; e < DM * 16; e += NWAVES * 64) { const int k = e >> 4, c = 4 + (e & 15), ln = (k & 255) >> 2, kidx = (k >> 8) * 4 + (k & 3); RW[((kidx * 5 + (c >> 2)) * 64 + ln) * 4 + (c & 3)] = re[e]; }
    if (F.tid < 64) LC[F.tid] = 0;
    __syncthreads();
    PROBE_END(31); PROBE_BEGIN(32);
    const float* rgb = a.in[17] + l * 4; const float* reb = a.in[19] + l * 16;
    const float* g1 = a.in[14] + (size_t)l * DM; const float* b1 = a.in[15] + (size_t)l * DM;
    int* list = (int*)(F.ws + WS_LIST); float* gwl = (float*)(F.ws + WS_GWL);
    const int rows_per_blk = NTOK / F.G;
    LnGB gb; ln_gb_load(F, g1, b1, gb);
    float rb[20];
#pragma unroll
    for (int c = 0; c < 4; ++c) rb[c] = rgb[c];
#pragma unroll
    for (int c = 0; c < 16; ++c) rb[4 + c] = reb[c];
    const bf16* V1 = wsb(F, WS_R2);
    f32x4 nx[4]; ln_load_bf(F, V1 + (size_t)(F.vcu * rows_per_blk + F.wave) * DM, nx);
    for (int rr = F.wave; rr < rows_per_blk; rr += NWAVES) { const int m = F.vcu * rows_per_blk + rr; f32x4 v[4];
#pragma unroll
        for (int j = 0; j < 4; ++j) v[j] = nx[j];
        if (rr + NWAVES < rows_per_blk) ln_load_bf(F, V1 + (size_t)(m + NWAVES) * DM, nx);
        ln_row(F, gb, nullptr, wsb(F, WS_HB) + (size_t)m * DM, v, dry, F.ws + WS_HB8 + (size_t)m * DM);
        float gl[4] = {0.f, 0.f, 0.f, 0.f};
#pragma unroll
        for (int jj = 0; jj < 4; ++jj)
#pragma unroll
            for (int k = 0; k < 4; ++k) { const f32x4 wv = *(const LAS f32x4*)(RW + (((jj * 4 + k) * 5) * 64 + F.lane) * 4); const float xv = v[jj][k];
                gl[0] += xv * wv.x; gl[1] += xv * wv.y; gl[2] += xv * wv.z; gl[3] += xv * wv.w; }
        int gi = 0; float gm;
#pragma unroll
        for (int c = 0; c < 4; ++c) gl[c] = wave_sum(gl[c]) + rb[c];
        gm = gl[0];
#pragma unroll
        for (int c = 1; c < 4; ++c) if (gl[c] > gm) { gm = gl[c]; gi = c; }
        float gs = 0.f;
#pragma unroll
        for (int c = 0; c < 4; ++c) gs += expf(gl[c] - gm);
        const float pg = 1.f / gs;
        float el[4] = {0.f, 0.f, 0.f, 0.f};
        { const LAS float* wg = RW + ((1 + gi) * 64 + F.lane) * 4;
#pragma unroll
          for (int jj = 0; jj < 4; ++jj)
#pragma unroll
            for (int k = 0; k < 4; ++k) { const f32x4 wv = *(const LAS f32x4*)(wg + ((jj * 4 + k) * 5) * 256); const float xv = v[jj][k];
                el[0] += xv * wv.x; el[1] += xv * wv.y; el[2] += xv * wv.z; el[3] += xv * wv.w; } }
#pragma unroll
        for (int c = 0; c < 4; ++c) { float bsel = rb[4 + c];
#pragma unroll
            for (int g = 1; g < 4; ++g) if (gi == g) bsel = rb[4 + 4 * g + c];
            el[c] = wave_sum(el[c]) + bsel; }
        int i1 = 0; float m1 = el[0];
#pragma unroll
        for (int c = 1; c < 4; ++c) if (el[c] > m1) { m1 = el[c]; i1 = c; }
        int i2 = -1; float m2 = -INFINITY;
#pragma unroll
        for (int c = 0; c < 4; ++c) if (c != i1 && el[c] > m2) { m2 = el[c]; i2 = c; }
        const float e2 = expf(m2 - m1); const float p1 = 1.f / (1.f + e2), p2 = e2 / (1.f + e2);
        const int ia = i1 < i2 ? i1 : i2, ib = i1 < i2 ? i2 : i1; const float ga = pg * (i1 < i2 ? p1 : p2), gb = pg * (i1 < i2 ? p2 : p1);
        const int pidx = ia == 0 ? ib - 1 : (ia == 1 ? ib + 1 : 5); const int cls = gi * 6 + pidx;
        if (F.lane == 0) { const int pos = __hip_atomic_fetch_add(&LC[cls], 1, __ATOMIC_RELAXED, __HIP_MEMORY_SCOPE_WORKGROUP); LTOK[rr] = m; LCLS[rr] = cls; LPOS[rr] = pos; LGA[rr] = ga; LGB[rr] = gb; }
    }
    __syncthreads();
    PROBE_END(32);
    if (dry) return;
    PROBE_BEGIN(33);
    if (F.tid < NCLS) { const int n = LC[F.tid]; LC[32 + F.tid] = n ? (int)atomicAdd((unsigned*)(F.ctl + CW_CNT + (l * NCLS + F.tid) * 64), (unsigned)n) : 0; }
    __syncthreads();
    for (int rr = F.tid; rr < rows_per_blk; rr += NWAVES * 64) { const int cls = LCLS[rr], pos = LC[32 + cls] + LPOS[rr];
        list[(size_t)cls * NTOK + pos] = LTOK[rr]; gwl[((size_t)cls * NTOK + pos) * 2] = LGA[rr]; gwl[((size_t)cls * NTOK + pos) * 2 + 1] = LGB[rr]; }
    __syncthreads();
    PROBE_END(33);
}
__device__ __forceinline__ void ln2_phase(const Frame& F_, const Args& a, int l, bool dry = false) { Frame F = F_; F.lane = lane_id_(); F.tid = F.wave * 64 + F.lane;
    const float* g2 = a.in[23] + (size_t)l * DM; const float* b2 = a.in[24] + (size_t)l * DM; const bf16* V2 = wsb(F, WS_R1); const bool last = (l == DEPTH - 1);
    const int gw = F.vcu * NWAVES + F.wave, NGW = F.G * NWAVES;
    LnGB gb; ln_gb_load(F, g2, b2, gb);
    f32x4 nx[4]; ln_load_bf(F, V2 + (size_t)gw * DM, nx);
    for (int m = gw; m < NTOK; m += NGW) { f32x4 v[4];
#pragma unroll
        for (int j = 0; j < 4; ++j) v[j] = nx[j];
        if (m + NGW < NTOK) ln_load_bf(F, V2 + (size_t)(m + NGW) * DM, nx);
        ln_row(F, gb, last ? F.out + (size_t)m * DM : nullptr, wsb(F, WS_HB) + (size_t)m * DM, v, dry, last ? nullptr : F.ws + WS_HB8 + (size_t)m * DM); }
}
__device__ __forceinline__ void moe_table(const Frame& F, int l, LAS int* tab) {
    const int tid = F.wave * 64 + lane_id_();
    if (tid < NCLS) tab[tid] = (int)__hip_atomic_load(F.ctl + CW_CNT + (l * NCLS + tid) * 64, RLX_AGENT);
    __syncthreads();
    if (tid == 0) { int s = 0; for (int c = 0; c < NCLS; ++c) { tab[32 + c] = s; s += (tab[c] + 255) >> 8; } tab[32 + NCLS] = s; tab[57] = s; }
    __syncthreads();
}
#define NREP(k) (((REP_PHASE) == (k) || ((k) == 4 && ((REP_PHASE) == 60 || (REP_PHASE) == 61))) ? 2 : 1)
#define DRY(k) ((REP_PHASE) == (k) && rep_ == 0 && args.ph_hi != 7777)
#ifndef MK_PER_PHASE
#define MK_PER_PHASE 0
#endif
constexpr int PH_PER_LAYER = 9, N_PHASES = 1 + DEPTH * PH_PER_LAYER;
__global__ void __launch_bounds__(NWAVES * 64, 2) fwd_kernel(Args args) {
    extern __shared__ __attribute__((aligned(16))) unsigned char lds[];
    Frame F0; Frame& F = F0;
    F.lds = (LAS unsigned char*)lds; F.ldsg = lds;
    F.MISC = (volatile LAS unsigned*)(F.lds + MISC_OFF);
    F.wave = __builtin_amdgcn_readfirstlane((int)threadIdx.x >> 6); F.lane = lane_id_(); F.tid = F.wave * 64 + F.lane;
    F.G = gridDim.x; { const int bx = blockIdx.x; F.vcu = (F.G % 8 == 0) ? (bx % 8) * (F.G / 8) + bx / 8 : bx; }
    F.ws = args.ws; F.out = args.out; F.ctl = (gu32*)(args.ws + WS_CTL);
    for (int u = F0.tid; u < (LDS_BYTES - LDSCTL_OFF) / 4; u += NWAVES * 64) ((LAS unsigned*)(F.lds + LDSCTL_OFF))[u] = 0u;
    __syncthreads();
    XcdBarrier bar; bar.bar = (unsigned*)(F.ctl + CW_BAR); bar.x = 0; bar.st = nullptr;
    if (!MK_PER_PHASE) bar = xcd_barrier_post((unsigned*)(F.ctl + CW_BAR), F.MISC + 8);
    const int lo = MK_PER_PHASE ? args.ph_lo : 0, hi = MK_PER_PHASE ? args.ph_hi : N_PHASES;
#define IN(k) (lo <= (k) && (k) < hi)
#ifndef PH_ONLY
#define PH_ONLY -1
#endif
#define EN(k) (PH_ONLY < 0 || PH_ONLY == (k))
#define SEAM(k) do { if (IN(k) && IN((k) + 1)) { PROBE_BEGIN(20); xcd_barrier(bar, F0.wave); PROBE_END(20); } } while (0)
    volatile LAS unsigned* PRB = (volatile LAS unsigned*)(F0.lds + LDSCTL_OFF + 512);
    LAS int* TAB = (LAS int*)(F.lds + LDSCTL_OFF + 64);
    bf16* const HB = wsb(F, WS_HB); bf16* const P = wsb(F, WS_R1); bf16* const MIX = wsb(F, WS_R1); bf16* const BR = wsb(F, WS_R2); bf16* const ACT = wsb(F, WS_R2);
    float* const FW = (float*)(F.ws + WS_FW); float* const BIAS2 = (float*)(F.ws + WS_BIAS2); unsigned long long* const SELW = (unsigned long long*)(F.ws + WS_SELW);

#define FRESH(Fn) Frame Fn = F0; Fn.vcu = opaque_s(F0.vcu); Fn.wave = opaque_s(F0.wave); Fn.lane = lane_id_(); Fn.tid = Fn.wave * 64 + Fn.lane
    for (int rep_ = 0; rep_ < ((REP_PHASE) == 10 ? 2 : 1); ++rep_) if (EN(0) && IN(0)) { FRESH(Fp); p0_prologue(Fp, args); }
    SEAM(0);
#pragma unroll 1
    for (int l0 = 0; l0 < DEPTH; ++l0) {
        const int pb = 1 + PH_PER_LAYER * l0;
#define l opaque_s(l0)
#define W (wsb(F, WS_W + (size_t)l * W_LAYER))
        for (int rep_ = 0; rep_ < NREP(1); ++rep_) if (EN(1) && IN(pb)) {
            constexpr unsigned M8 = A_F8_TILES; unsigned map8 = 0, map16 = 0; int n8 = 0, n16 = 0;
            for (int q = 0; q < 9; ++q) { if ((M8 >> q) & 1) { map8 |= (unsigned)q << (4 * n8); ++n8; } else { map16 |= (unsigned)q << (4 * n16); ++n16; } }
            const int bx_ = opaque_s((int)blockIdx.x);
            if (n8 > 0) { SchedAT<true> S; S.T.init(NTOK / 256, n8, F.G, bx_); S.A = (const char*)(F.ws + WS_HB8); S.B = (const char*)W + W_SM8; S.map = map8;
                EpiAT<true> E{P, FW, wsb(F, WS_KIDX)}; pg8::gemm_phase<EpiAT<true>, SchedAT<true>, false>(F.lds + RING_OFF, (LAS unsigned*)(F.lds + LDSCTL_OFF + 1024), F0.wave, S, E); }
            if (n16 > 0) { SchedAT<false> S; S.T.init(NTOK / 256, n16, F.G, (bx_ + F.G - ((NTOK / 256) * n8) % F.G) % F.G);
                S.A = (const char*)HB; S.B = (const char*)(W + W_SM / 2); S.map = map16;
                EpiAT<false> E{P, FW, wsb(F, WS_KIDX)}; pg8::gemm_phase<EpiAT<false>, SchedAT<false>, false>(F.lds + RING_OFF, (LAS unsigned*)(F.lds + LDSCTL_OFF + 1024), F0.wave, S, E); } }
        SEAM(pb);
        for (int rep_ = 0; rep_ < NREP(2); ++rep_) if (EN(2) && IN(pb + 1)) { FRESH(Fp);
#ifndef NO_CUMSUM
            if (Fp.vcu < 32 && Fp.wave == 0) fox_cumsum(Fp, Fp.vcu, FW, args.in[4] + l * 4, BIAS2);
#endif
#ifndef NO_POOL
            for (int rp_ = 0; rp_ < ((REP_PHASE) == 21 ? 2 : 1); ++rp_) for (int k = 0; k < 2; ++k) pool_unit(Fp, Fp.vcu * 2 + k, P, args.in[6] + (size_t)l * 4 * 64 * 64, args.in[7] + (size_t)l * 256, BR);
#endif
#ifndef NO_CONV
            for (int rp_ = 0; rp_ < ((REP_PHASE) == 22 ? 2 : 1); ++rp_) for (int k = 0; k < 4; ++k) conv_unit(Fp, Fp.vcu * 4 + k, P, args.in[8] + (size_t)l * 31 * 256, args.in[9] + (size_t)l * 256, args.in[10] + (size_t)l * 256, args.in[11] + (size_t)l * 256, BR);
#endif
#ifndef NO_DSA
            { const int b = Fp.vcu >> 5, s = Fp.vcu & 31;
#pragma unroll 1
              for (int k = 0; k < ((REP_PHASE) == 23 ? 8 : 4); ++k) { const int j = (k & 3) == 0 ? 127 - s : ((k & 3) == 1 ? 64 + s : ((k & 3) == 2 ? 63 - s : s)); dsa_mask_unit(Fp, b, j, P, wsb(F, WS_KIDX), FW, SELW); } }
#endif
        }
        SEAM(pb + 1);
        for (int rep_ = 0; rep_ < NREP(3); ++rep_) if (EN(3) && IN(pb + 2)) { const int vc_ = opaque_s(F0.vcu); const int sg = vc_ >> 3, s = vc_ & 7, b = sg >> 2, h = sg & 3; const size_t rb = (size_t)b * SEQ;
            const attn_body::bf16* Pb = (const attn_body::bf16*)P + rb * PS; attn_body::bf16* Ob = (attn_body::bf16*)BR + rb * DM;
#pragma unroll 1
            for (int k = 0; k < ((REP_PHASE) == 31 ? 4 : 2); ++k) { const int qb = (k & 1) == 0 ? 15 - s : s;
                attn_body::attn_unit<24, false>(qb * 256, Pb + C_FQ + h * 64, Pb + C_FK + h * 64, Pb + C_FV + h * 64, Ob + 256 + h * 64, BIAS2 + (size_t)(b * 4 + h) * SEQ, 0.f, nullptr, (char*)lds + RING_OFF, F0.wave); }
            const float slope2 = exp2f(-2.f * (float)(h + 1)) * LOG2E;
#pragma unroll 1
            for (int k = 0; k < ((REP_PHASE) == 32 ? 4 : 2); ++k) { const int qb = (k & 1) == 0 ? 15 - s : s;
                attn_body::attn_unit<24, true>(qb * 256, Pb + C_DQ + h * 64, Pb + C_DK, Pb + C_DV, Ob + 512 + h * 64, nullptr, slope2, SELW + (size_t)b * 64 * SEQ, (char*)lds + RING_OFF, F0.wave); }
        }
        SEAM(pb + 2);
        for (int rep_ = 0; rep_ < NREP(4); ++rep_) if (EN(4) && IN(pb + 3)) { SchedC S; S.T.init(NTOK / 256, DM / 128, F.G, opaque_s((int)blockIdx.x)); S.HBp = (const char*)(F.ws + WS_HB8); S.BRp = (const char*)BR; S.WGp = (const char*)(W + W_GT / 2); S.WBp = (const char*)(W + W_BR / 2); S.collapse = ((REP_PHASE) == 61 && rep_ == 0 && args.ph_hi != 7777);
            EpiC E; E.dry = (((REP_PHASE) == 60 || (REP_PHASE) == 61) && rep_ == 0 && args.ph_hi != 7777); E.MIX = MIX; E.bgate = args.in[5] + (size_t)l * 4 * DM; pg8::gemm_phase_c8<EpiC, SchedC>(F.lds + RING_OFF, F0.wave, S, E); }
        SEAM(pb + 3);
        for (int rep_ = 0; rep_ < NREP(5); ++rep_) if (EN(5) && IN(pb + 4)) { SchedC2 S; S.T.init(NTOK / 256, DM / 256, F.G, opaque_s((int)blockIdx.x)); S.A = (const char*)MIX; S.B = (const char*)(W + W_OUT / 2);
            EpiRes E{BR  , HB, DRY(5)}; pg8::gemm_phase<EpiRes, SchedC2, false>(F.lds + RING_OFF, (LAS unsigned*)(F.lds + LDSCTL_OFF + 1024), F0.wave, S, E); }
        SEAM(pb + 4);
        for (int rep_ = 0; rep_ < NREP(6); ++rep_) if (EN(6) && IN(pb + 5)) { FRESH(Fp); PROBE_BEGIN(21); ln1_router_phase(Fp, args, l, DRY(6)); PROBE_END(21); }
        SEAM(pb + 5);
        for (int rep_ = 0; rep_ < NREP(7); ++rep_) if (EN(7) && IN(pb + 6)) { moe_table(F, l, TAB);
            SchedD1 S{TAB, F.G, opaque_s((int)blockIdx.x), (const char*)(F.ws + WS_HB8), (const char*)(W + W_GU / 2), (const int*)(F.ws + WS_LIST)};
            EpiD1 E{(unsigned char*)ACT, (const float*)(F.ws + WS_GWL)}; pg8::gemm_phase<EpiD1, SchedD1, true>(F.lds + RING_OFF, (LAS unsigned*)(F.lds + LDSCTL_OFF + 1024), F0.wave, S, E); }
        SEAM(pb + 6);
        for (int rep_ = 0; rep_ < NREP(8); ++rep_) if (EN(8) && IN(pb + 7)) { moe_table(F, l, TAB);
            SchedD2 S{TAB, F.G, opaque_s((int)blockIdx.x), (const char*)ACT, (const char*)(W + W_D / 2), (const int*)(F.ws + WS_LIST)};
            EpiD2 E{wsb(F, WS_R1), HB, DRY(8)}; pg8::gemm_phase<EpiD2, SchedD2, false>(F.lds + RING_OFF, (LAS unsigned*)(F.lds + LDSCTL_OFF + 1024), F0.wave, S, E); }
        SEAM(pb + 7);
        for (int rep_ = 0; rep_ < NREP(9); ++rep_) if (EN(9) && IN(pb + 8)) { FRESH(Fp); PROBE_BEGIN(22); ln2_phase(Fp, args, l, DRY(9)); PROBE_END(22); }
        SEAM(pb + 8);
#undef l
#undef W
    }
#undef IN
#undef SEAM
    if ((REP_PHASE) >= 100 && blockIdx.x == 0 && F0.wave == 0 && lane_id_() == 0) { volatile LAS unsigned* PRB = (volatile LAS unsigned*)(F0.lds + LDSCTL_OFF + 512); const unsigned long long a_ = (((unsigned long long)PRB[1]) << 32) | PRB[0];
        const unsigned long long t0_ = __builtin_amdgcn_s_memrealtime(); while (__builtin_amdgcn_s_memrealtime() - t0_ < a_) __builtin_amdgcn_s_sleep(8); }
}

extern "C" void kernel_launch(void* const* d_in, const int* in_sizes, int n_in, void* d_out, int out_size, void* d_ws, size_t ws_size, hipStream_t stream) {
    static int grid = 0;
    if (grid == 0) {
        if (n_in != 25 || in_sizes[0] != NTOK * DM || out_size != NTOK * DM || ws_size < WS_END) { fprintf(stderr, "kernel_launch: unexpected shapes (n_in %d, in0 %d, out %d, ws %zu); nothing launched\n", n_in, n_in > 0 ? in_sizes[0] : -1, out_size, ws_size); grid = -1; return; }
        int dev = 0, cus = 0, per_cu = 0;
        if (hipGetDevice(&dev) != hipSuccess || hipDeviceGetAttribute(&cus, hipDeviceAttributeMultiprocessorCount, dev) != hipSuccess) { grid = -1; return; }
        if (hipFuncSetAttribute((const void*)fwd_kernel, hipFuncAttributeMaxDynamicSharedMemorySize, LDS_BYTES) != hipSuccess) { fprintf(stderr, "kernel_launch: hipFuncSetAttribute failed\n"); grid = -1; return; }
        if (hipOccupancyMaxActiveBlocksPerMultiprocessor(&per_cu, (const void*)fwd_kernel, NWAVES * 64, LDS_BYTES) != hipSuccess || per_cu < 1) fprintf(stderr, "kernel_launch: occupancy query reports %d\n", per_cu);
        (void)hipGetLastError();
        grid = cus;
        if (grid != 256) { fprintf(stderr, "kernel_launch: built for 256 CUs, device has %d; nothing launched\n", cus); grid = -1; return; }
    }
    if (grid < 0) return;
    if (hipMemsetAsync((char*)d_ws + WS_CTL, 0, CTL_ZERO_BYTES, stream) != hipSuccess) return;
    Args a{};
    for (int i = 0; i < 25; ++i) a.in[i] = (const float*)d_in[i];
    a.out = (float*)d_out; a.ws = (unsigned char*)d_ws;
#if MK_PER_PHASE
    for (int p = 0; p < N_PHASES; ++p) { a.ph_lo = p; a.ph_hi = p + 1; hipLaunchKernelGGL(fwd_kernel, dim3(grid), dim3(NWAVES * 64), LDS_BYTES, stream, a); }
#else
    a.ph_lo = 0; a.ph_hi = N_PHASES;
    hipLaunchKernelGGL(fwd_kernel, dim3(grid), dim3(NWAVES * 64), LDS_BYTES, stream, a);
#endif
}
```

```cpp
#include <hip/hip_runtime.h>
#include <hip/hip_bf16.h>
#include <cstdio>
#include <cstdint>
#include <cmath>

#ifndef REP_PHASE
#define REP_PHASE 0
#endif
#define PROBE_BEGIN(id) do { if ((REP_PHASE) == 100 + (id) && blockIdx.x == 0) { __syncthreads(); if (F.wave == 0 && lane_id_() == 0) { const unsigned long long t_ = __builtin_amdgcn_s_memrealtime(); PRB[2] = (unsigned)t_; PRB[3] = (unsigned)(t_ >> 32); } } } while (0)
#define PROBE_END(id) do { if ((REP_PHASE) == 100 + (id) && blockIdx.x == 0) { __syncthreads(); if (F.wave == 0 && lane_id_() == 0) { const unsigned long long t_ = __builtin_amdgcn_s_memrealtime() - (((unsigned long long)PRB[3] << 32) | PRB[2]); const unsigned long long a_ = ((((unsigned long long)PRB[1]) << 32) | PRB[0]) + t_; PRB[0] = (unsigned)a_; PRB[1] = (unsigned)(a_ >> 32); } } } while (0)
constexpr int BATCH = 8, SEQ = 4096, DM = 1024, NTOK = BATCH * SEQ, DEPTH = 2;
constexpr int P_TOTAL = 6344, PS = 2304;
constexpr int C_POOL = 0, C_FQ = 256, C_FK = 512, C_FV = 768, C_DQ = 1024, C_IQ = 1280, C_CONV = 1536, C_DK = 2048, C_DV = 2112, C_IK = 2176, C_FF = 2240, C_IW = 2244;
constexpr float LN_EPS = 1e-5f;
constexpr float ALPHA = 1.4142135623730951f;
constexpr float LOG2E = 1.4426950408889634f;
constexpr int NWAVES = 8;
constexpr int NCLS = 24;
constexpr int MAXTILES = NTOK / 256 + NCLS;

constexpr size_t MiB = 1u << 20;
constexpr size_t WS_CTL = 0, CTL_ZERO_BYTES = 1 * MiB;
constexpr size_t WS_FW = 1 * MiB;
constexpr size_t WS_BIAS2 = 2 * MiB;
constexpr size_t WS_LIST = 3 * MiB;
constexpr size_t WS_GWL = 6 * MiB;
constexpr size_t WS_SELW = 12 * MiB;
constexpr size_t WS_HB8 = 28 * MiB;
constexpr size_t WS_W = 60 * MiB;
constexpr size_t W_SM = 0, W_GT = 4718592, W_BR = W_GT + 8 * MiB, W_OUT = W_BR + 2 * MiB, W_GU = W_OUT + 2 * MiB, W_D = W_GU + 32 * MiB, W_LAYER = W_D + 16 * MiB;
constexpr size_t WS_HB = 190 * MiB;
constexpr size_t WS_R1 = 254 * MiB;
constexpr size_t WS_R2 = 398 * MiB;
constexpr size_t WS_KIDX = 474 * MiB;
constexpr size_t WS_END = 478 * MiB;
static_assert(WS_W + 2 * W_LAYER <= WS_HB && WS_R1 + (size_t)NTOK * PS * 2 <= WS_R2 && WS_R2 + (size_t)MAXTILES * 256 * DM * 2 <= WS_END, "d_ws map");
constexpr int CW_BAR = 4096;
constexpr int CW_SEAMC = 8192;
constexpr int CW_CNT = 16384;

constexpr int RING_OFF = 0, RING_BYTES = 131072;
constexpr int LDSCTL_OFF = RING_BYTES, MISC_OFF = LDSCTL_OFF + 320;
constexpr int LDS_BYTES = 147456;

#define GAS __attribute__((address_space(1)))
#define LAS __attribute__((address_space(3)))
typedef unsigned short bf16;
typedef unsigned v4u __attribute__((ext_vector_type(4)));
typedef unsigned v2u __attribute__((ext_vector_type(2)));
typedef float f32x4 __attribute__((ext_vector_type(4)));
typedef float f32x16 __attribute__((ext_vector_type(16)));
typedef short bf16x8 __attribute__((ext_vector_type(8)));
typedef GAS unsigned gu32;
#define RLX_AGENT __ATOMIC_RELAXED, __HIP_MEMORY_SCOPE_AGENT
#define LDS_WAIT() asm volatile("s_waitcnt lgkmcnt(0)" ::: "memory")
#define VM_WAIT() asm volatile("s_waitcnt vmcnt(0)" ::: "memory")
__device__ __forceinline__ int opaque_i(int x) { asm volatile("" : "+v"(x)); return x; }
__device__ __forceinline__ int lane_id_() { int x; asm volatile("v_mbcnt_lo_u32_b32 %0, -1, 0\n\tv_mbcnt_hi_u32_b32 %0, -1, %0" : "=v"(x)); return x; }
__device__ __forceinline__ float zero_() { int z = 0; asm volatile("" : "+v"(z)); return __builtin_bit_cast(float, z); }
__device__ __forceinline__ const char* sptr_(const char* p) { const unsigned long long v = (unsigned long long)p; const unsigned lo = (unsigned)__builtin_amdgcn_readfirstlane((int)(unsigned)v), hi = (unsigned)__builtin_amdgcn_readfirstlane((int)(unsigned)(v >> 32)); return (const char*)(((unsigned long long)hi << 32) | lo); }
__device__ __forceinline__ int shfl_i_(int v, int srclane) { return __builtin_amdgcn_ds_bpermute(srclane << 2, v); }
__device__ __forceinline__ int opaque_s(int x) { asm volatile("" : "+s"(x)); return x; }
__device__ __forceinline__ unsigned f2bf(float f) { unsigned u = __builtin_bit_cast(unsigned, f); return (u + 0x7fffu + ((u >> 16) & 1u)) >> 16; }
__device__ __forceinline__ unsigned pk2(float lo, float hi) { return f2bf(lo) | (f2bf(hi) << 16); }
__device__ __forceinline__ unsigned pk4_fp8(float a, float b, float c, float d) { int r = __builtin_amdgcn_cvt_pk_fp8_f32(a, b, 0, false); r = __builtin_amdgcn_cvt_pk_fp8_f32(c, d, r, true); return (unsigned)r; }
__device__ __forceinline__ float bfl(unsigned w) { return __uint_as_float(w << 16); }
__device__ __forceinline__ float bfh(unsigned w) { return __uint_as_float(w & 0xffff0000u); }
__device__ __forceinline__ float bf1(bf16 h) { return __uint_as_float((unsigned)h << 16); }
__device__ __forceinline__ float sigmoidf_(float x) { return __builtin_amdgcn_rcpf(1.f + __builtin_amdgcn_exp2f(-x * LOG2E)); }

#define XB_TMO      128
#define XB_XCNT(j)  (256  + 64 * (j))
#define XB_XSUB(j)  (1280 + 64 * (j))
#define XB_XGEN(j)  (2304 + 64 * (j))
#define XB_TOP      3328
#define XB_TOPGEN   3392
#define XCD_BAR_WORDS 3456
#define XB_SPIN_CAP (1u << 18)
__device__ __forceinline__ unsigned xb_ld(unsigned* p)              { return __hip_atomic_load(p, __ATOMIC_RELAXED, __HIP_MEMORY_SCOPE_AGENT); }
__device__ __forceinline__ unsigned xb_add(unsigned* p, unsigned v) { return __hip_atomic_fetch_add(p, v, __ATOMIC_RELAXED, __HIP_MEMORY_SCOPE_AGENT); }
__device__ __forceinline__ unsigned xb_xcc_id() { return (unsigned)__builtin_amdgcn_s_getreg((3 << 11) | 20) & 0xFu; }
#define XB_SPIN(cond, bar) do { unsigned _sp = 0; while (cond) { __builtin_amdgcn_s_sleep(1); \
    if ((++_sp & 255u) == 0u) { if (xb_ld(&(bar)[XB_TMO])) break; if (_sp > XB_SPIN_CAP) { atomicAdd(&(bar)[XB_TMO], 1u); break; } } } } while (0)
struct XcdBarrier { unsigned* bar; unsigned x; volatile LAS unsigned* st; };
__device__ __forceinline__ XcdBarrier xcd_barrier_post(unsigned* bar, volatile LAS unsigned* st) {
    XcdBarrier b; b.bar = bar; b.x = xb_xcc_id(); b.st = st;
    if (threadIdx.x == 0) (void)xb_add(&bar[XB_XCNT(b.x)], 1u);
    return b;
}
__device__ __forceinline__ void xcd_barrier_complete(unsigned* bar, unsigned x, unsigned& nloc, unsigned& nx) {
    const unsigned G = gridDim.x * gridDim.y * gridDim.z;
    unsigned sum, cnt, mine, sp = 0u;
    for (;;) {
        sum = 0u; cnt = 0u; mine = 0u;
#pragma unroll
        for (unsigned j = 0; j < 16; ++j) { const unsigned c = xb_ld(&bar[XB_XCNT(j)]); sum += c; cnt += (c > 0u) ? 1u : 0u; mine = (j == x) ? c : mine; }
        if (sum == G) break;
        __builtin_amdgcn_s_sleep(1);
        if ((++sp & 255u) == 0u) { if (xb_ld(&bar[XB_TMO])) break; if (sp > XB_SPIN_CAP) { atomicAdd(&bar[XB_TMO], 1u); break; } }
    }
    nloc = mine > 0u ? mine : 1u; nx = cnt > 0u ? cnt : 1u;
}
__device__ __forceinline__ void xcd_barrier(const XcdBarrier& b, int wave) {
    asm volatile("s_waitcnt vmcnt(0)" ::: "memory");
    __syncthreads();
    if (wave == 0 && lane_id_() == 0) {
        unsigned* bar = b.bar; const unsigned bx = (unsigned)opaque_s((int)xb_xcc_id());
        __builtin_amdgcn_s_waitcnt(0);
        unsigned nloc = b.st[0], nx = b.st[1];
        if (nloc == 0u) { xcd_barrier_complete(bar, bx, nloc, nx); b.st[0] = nloc; b.st[1] = nx; }
        const unsigned old = xb_add(&bar[XB_XSUB(bx)], 1u);
        const unsigned gen = old / nloc;
        if (old + 1u == (gen + 1u) * nloc) {
            __builtin_amdgcn_fence(__ATOMIC_RELEASE, "agent");
            asm volatile("s_waitcnt vmcnt(0)" ::: "memory");
            const unsigned og = xb_add(&bar[XB_TOP], 1u);
            const unsigned tg = og / nx;
            if (og + 1u == (tg + 1u) * nx) xb_add(&bar[XB_TOPGEN], 1u);
            else XB_SPIN(xb_ld(&bar[XB_TOPGEN]) == tg, bar);
            __builtin_amdgcn_fence(__ATOMIC_ACQUIRE, "agent");
            xb_add(&bar[XB_XGEN(bx)], 1u);
            asm volatile("s_waitcnt vmcnt(0)" ::: "memory");
        } else {
            XB_SPIN(xb_ld(&bar[XB_XGEN(bx)]) == gen, bar);
            __builtin_amdgcn_fence(__ATOMIC_ACQUIRE, "agent");
            asm volatile("s_waitcnt vmcnt(0)" ::: "memory");
        }
    }
    __syncthreads();
}
namespace pg8 {
#define PG8_LAS __attribute__((address_space(3)))
typedef unsigned short bf16_t;
typedef short bf16x8 __attribute__((ext_vector_type(8)));
typedef float f32x4 __attribute__((ext_vector_type(4)));
typedef float f32x2 __attribute__((ext_vector_type(2)));
typedef unsigned u32x4 __attribute__((ext_vector_type(4)));
typedef unsigned u32x2 __attribute__((ext_vector_type(2)));
constexpr int BM = 256, BK = 64, HALF = 128, HTB = HALF * BK * 2  , STAGE_BYTES = 8 * HTB, NXCD = 8, WGM = 8;
constexpr int LD = 1024;
constexpr size_t ROWB = 2048;
constexpr size_t HSTEP = (size_t)HALF * ROWB;
constexpr size_t TSTEP = 2 * HSTEP;

__host__ __device__ __forceinline__ int lds_byte(int r, int c) { const int st = (r >> 4) * 2 + (c >> 5), rr = r & 15, cc = c & 31, ob = rr * 64 + cc * 2; return st * 1024 + (ob ^ (((ob >> 9) & 1) << 5)); }
__host__ __device__ __forceinline__ void stage_rc(int b, int& R, int& C) { const int st = b / 1024, sb = b % 1024, swz = sb ^ (((sb >> 9) & 1) << 5); R = (st >> 1) * 16 + swz / 64; C = (st & 1) * 32 + (swz % 64) / 2; }
__host__ __device__ __forceinline__ int perm32(int rho) { const int n = rho >> 4, i = rho & 15; return 8 * (i >> 2) + 4 * n + (i & 3); }

struct GU {
    const char* A;
    const char* B0;
    const char* B1;
    int nt, ks;
    const int* rows;
    int rbase, rcnt;
    int pm, pn, a0, a1;
};

__device__ __forceinline__ unsigned cvt_pk_bf16(float lo, float hi) { unsigned r; asm volatile("v_cvt_pk_bf16_f32 %0, %1, %2" : "=v"(r) : "v"(lo), "v"(hi)); return r; }
__device__ __forceinline__ float bf_lo(unsigned w) { return __uint_as_float(w << 16); }
__device__ __forceinline__ float bf_hi(unsigned w) { return __uint_as_float(w & 0xffff0000u); }

__device__ __forceinline__ void glds16_s(const char* sbase, unsigned voff, unsigned lds_dst) { unsigned keep;
    asm volatile("s_mov_b32 %0, m0\n\ts_mov_b32 m0, %3\n\ts_nop 0\n\tglobal_load_lds_dwordx4 %1, %2\n\ts_mov_b32 m0, %0" : "=&s"(keep) : "v"(voff), "s"(sbase), "s"(lds_dst) : "memory"); }
typedef int v8i_t __attribute__((ext_vector_type(8)));
typedef int v4i_t __attribute__((ext_vector_type(4)));
__device__ __forceinline__ v8i_t cat8(bf16x8 lo, bf16x8 hi) { const v4i_t a = __builtin_bit_cast(v4i_t, lo), b = __builtin_bit_cast(v4i_t, hi); return __builtin_shufflevector(a, b, 0, 1, 2, 3, 4, 5, 6, 7); }
template <class Epi, class Sched, bool GATHER>
__device__ __forceinline__ void gemm_phase(PG8_LAS unsigned char* lds, PG8_LAS unsigned* xlds  , const int wid_in  , const Sched& S, Epi& E) {
    const int wid = opaque_s(wid_in), lane = lane_id_(), tid = wid * 64 + lane, wr = wid >> 2, wc = wid & 3, fr = lane & 15, fq = lane >> 4;
    constexpr bool F8 = Epi::F8;
    constexpr int RP = F8 ? 1024 : 2048;
    constexpr size_t HS = (size_t)HALF * RP;
    unsigned voffB[2], vA[2][2];
#pragma unroll
    for (int i = 0; i < 2; ++i) { int R, C; stage_rc(tid * 16 + i * 8192, R, C); const int Rb = Epi::PERM ? ((R & ~31) + perm32(R & 31)) : R;
        voffB[i] = (unsigned)(Rb * RP + C * 2);
        vA[0][i] = (unsigned)(R * RP + C * 2); vA[1][i] = vA[0][i]; }
    const size_t kstep = (size_t)(BK * 2);
    const unsigned ldsw = (unsigned)wid * 1024u;
    const unsigned ldsb = (unsigned)__builtin_amdgcn_readfirstlane((int)((unsigned)(size_t)lds + (unsigned)wid * 1024u));
    const int aoff8 = lds_byte(wr * 64 + fr, 16 * fq), boff8 = lds_byte(wc * 32 + fr, 16 * fq);
    const int aoff = lds_byte(wr * 64 + fr, fq * 8), boff = lds_byte(wc * 32 + fr, fq * 8);
#define PG8_SA(b, h) (((b) * 2 + (h)) * HTB)
#define PG8_SB(b, h) ((4 + (b) * 2 + (h)) * HTB)
#define PG8_STAGE(bufoff, gbase, voff) do { _Pragma("unroll") for (int _i = 0; _i < 2; ++_i) { \
        if constexpr (F8) glds16_s((const char*)(gbase), (voff)[_i], ldsb + (unsigned)((bufoff) + _i * 8192)); \
        else __builtin_amdgcn_global_load_lds((const unsigned*)((const char*)(gbase) + (voff)[_i]), (PG8_LAS unsigned*)(lds + (bufoff) + ldsw + _i * 8192), 16, 0, 0); } } while (0)
#define PG8_STAGEA(bufoff, gbase, h) do { if constexpr (GATHER) { PG8_STAGE(bufoff, gbase, vA[h]); } else { PG8_STAGE(bufoff, (gbase) + (h) * HS, vA[0]); } } while (0)
#define PG8_LDA(dst, b, h) do { _Pragma("unroll") for (int m = 0; m < 4; ++m) _Pragma("unroll") for (int k = 0; k < 2; ++k) dst[m][k] = *(const PG8_LAS bf16x8*)(lds + PG8_SA(b, h) + (F8 ? aoff8 + k * 16 : aoff + k * 1024) + m * 2048); } while (0)
#define PG8_LDB(dst, b, h) do { _Pragma("unroll") for (int n = 0; n < 2; ++n) _Pragma("unroll") for (int k = 0; k < 2; ++k) dst[n][k] = *(const PG8_LAS bf16x8*)(lds + PG8_SB(b, h) + (F8 ? boff8 + k * 16 : boff + k * 1024) + n * 2048); } while (0)
#define PG8_MMA(ai, bj, At, Bt) do { __builtin_amdgcn_s_setprio(1); _Pragma("unroll") for (int m = 0; m < 4; ++m) _Pragma("unroll") for (int n = 0; n < 2; ++n) { \
        if constexpr (F8) acc[ai][bj][m][n] = __builtin_amdgcn_mfma_scale_f32_16x16x128_f8f6f4(cat8(Bt[n][0], Bt[n][1]), cat8(At[m][0], At[m][1]), acc[ai][bj][m][n], 0, 0, 0, 0, 0, 0); \
        else { _Pragma("unroll") for (int k = 0; k < 2; ++k) acc[ai][bj][m][n] = __builtin_amdgcn_mfma_f32_16x16x32_bf16(Bt[n][k], At[m][k], acc[ai][bj][m][n], 0, 0, 0); } } __builtin_amdgcn_s_setprio(0); } while (0)
#define PG8_WAIT_V(n) asm volatile("s_waitcnt vmcnt(" #n ")" ::: "memory")
#define PG8_WAIT_L(n) asm volatile("s_waitcnt lgkmcnt(" #n ")" ::: "memory")
#define PG8_BAR __builtin_amdgcn_s_barrier()
#define PG8_SCHED __builtin_amdgcn_sched_barrier(0)
#define PG8_KS(u) (Sched::NT > 0 ? Sched::KS : (u).ks)
#define PG8_BP(u, tau) ((tau) < PG8_KS(u) ? (u).B0 + (size_t)(tau) * kstep : (u).B1 + (size_t)((tau) - PG8_KS(u)) * kstep)
#define PG8_GATHER_OFFS(dst, u) do { if constexpr (GATHER) { _Pragma("unroll") for (int _h = 0; _h < 2; ++_h) _Pragma("unroll") for (int _i = 0; _i < 2; ++_i) { \
        int _R, _C; stage_rc((wid * 64 + lane_id_()) * 16 + _i * 8192, _R, _C); int _p = (u).rbase + _h * HALF + _R; _p = _p < (u).rcnt ? _p : (u).rcnt - 1; dst[_h][_i] = (unsigned)(u).rows[_p] * (unsigned)RP + (unsigned)_C * 2u; } } } while (0)
    GU cur, nxt; int ui = 0;
    if (!S.next(0, cur)) return;
    f32x4 acc[2][2][4][2];
#pragma unroll
    for (int a = 0; a < 2; ++a)
#pragma unroll
        for (int b = 0; b < 2; ++b)
#pragma unroll
            for (int m = 0; m < 4; ++m)
#pragma unroll
                for (int n = 0; n < 2; ++n) { const float z_ = zero_(); acc[a][b][m][n] = (f32x4){z_, z_, z_, z_}; }
    bf16x8 At[4][2], B0[2][2], B1[2][2];
    PG8_GATHER_OFFS(vA, cur);
    const char* cA = cur.A;
    { const char* b0 = PG8_BP(cur, 0); const char* b1 = PG8_BP(cur, 1);
      PG8_STAGE(PG8_SB(0, 0), b0, voffB); PG8_STAGE(PG8_SB(0, 1), b0 + HS, voffB); PG8_STAGEA(PG8_SA(0, 0), cA, 0); PG8_STAGEA(PG8_SA(0, 1), cA, 1);
      if (wr == 1) PG8_BAR;
      PG8_WAIT_V(2); PG8_BAR;
      PG8_STAGE(PG8_SB(1, 0), b1, voffB); PG8_STAGEA(PG8_SA(1, 0), cA + kstep, 0); PG8_STAGE(PG8_SB(1, 1), b1 + HS, voffB);
      PG8_WAIT_V(6); PG8_BAR; }
    for (;;) {
        const bool has_next = S.next(ui + 1, nxt);
        if (!has_next) nxt = cur;
        if constexpr (GATHER) { unsigned vn[2][2];
#pragma unroll
            for (int h = 0; h < 2; ++h)
#pragma unroll
                for (int i = 0; i < 2; ++i) vn[h][i] = vA[h][i];
            if (has_next) { PG8_GATHER_OFFS(vn, nxt); }
#pragma unroll
            for (int h = 0; h < 2; ++h)
#pragma unroll
                for (int i = 0; i < 2; ++i) xlds[(h * 2 + i) * 512 + tid] = vn[h][i]; }
        const char* nA = nxt.A;
        const int nt = Sched::NT > 0 ? Sched::NT : cur.nt;
#pragma unroll (Sched::NT > 0 ? 2 : 1)
        for (int t = 0; t < nt; t += 2) {
            const bool last = (t == nt - 2);
            const char* a1 = cA + (size_t)(t + 1) * kstep;
            const char* a2 = last ? nA : cA + (size_t)(t + 2) * kstep;
            const char* b2 = last ? PG8_BP(nxt, 0) : PG8_BP(cur, t + 2);
            const char* a3 = a2 + kstep; const char* b3 = b2 + kstep;
            PG8_LDB(B0, 0, 0); PG8_LDB(B1, 0, 1); PG8_SCHED; PG8_LDA(At, 0, 0); PG8_STAGEA(PG8_SA(1, 1), a1, 1);
            if constexpr (GATHER) { if (last) {
#pragma unroll
                for (int h = 0; h < 2; ++h)
#pragma unroll
                    for (int i = 0; i < 2; ++i) vA[h][i] = xlds[(h * 2 + i) * 512 + tid]; } }
            PG8_WAIT_V(8); PG8_WAIT_L(0); PG8_BAR; PG8_MMA(0, 0, At, B0); PG8_MMA(0, 1, At, B1); PG8_BAR; PG8_SCHED;
            PG8_LDA(At, 0, 1); PG8_STAGE(PG8_SB(0, 0), b2, voffB); PG8_STAGE(PG8_SB(0, 1), b2 + HS, voffB); PG8_STAGEA(PG8_SA(0, 0), a2, 0);
            PG8_WAIT_V(8); PG8_WAIT_L(0); PG8_BAR; PG8_MMA(1, 0, At, B0); PG8_MMA(1, 1, At, B1); PG8_BAR; PG8_SCHED;
            PG8_LDB(B0, 1, 0); PG8_LDB(B1, 1, 1); PG8_SCHED; PG8_LDA(At, 1, 0); PG8_STAGEA(PG8_SA(0, 1), a2, 1);
            PG8_WAIT_V(8); PG8_WAIT_L(0); PG8_BAR; PG8_MMA(0, 0, At, B0); PG8_MMA(0, 1, At, B1); PG8_BAR; PG8_SCHED;
            PG8_LDA(At, 1, 1); PG8_STAGE(PG8_SB(1, 0), b3, voffB); PG8_STAGE(PG8_SB(1, 1), b3 + HS, voffB); PG8_STAGEA(PG8_SA(1, 0), a3, 0);
            PG8_WAIT_V(8); PG8_WAIT_L(0); PG8_BAR; PG8_MMA(1, 0, At, B0); PG8_MMA(1, 1, At, B1); PG8_BAR; PG8_SCHED;
        }
        if (wr == 0) PG8_BAR;
        { const int l2_ = lane_id_(); E(acc, cur, wr, wc, l2_ & 15, l2_ >> 4); }
        if (!has_next) break;
#pragma unroll
        for (int a = 0; a < 2; ++a)
#pragma unroll
            for (int b = 0; b < 2; ++b)
#pragma unroll
                for (int m = 0; m < 4; ++m)
#pragma unroll
                    for (int n = 0; n < 2; ++n) { const float z_ = zero_(); acc[a][b][m][n] = (f32x4){z_, z_, z_, z_}; }
        cur = nxt; cA = nA; ++ui;
        if (wr == 1) PG8_BAR;
    }
    PG8_WAIT_V(0);
    PG8_BAR;
#undef PG8_SA
#undef PG8_SB
#undef PG8_STAGE
#undef PG8_STAGEA
#undef PG8_LDA
#undef PG8_LDB
#undef PG8_MMA
#undef PG8_WAIT_V
#undef PG8_WAIT_L
#undef PG8_BAR
#undef PG8_SCHED
#undef PG8_BP
#undef PG8_KS
#undef PG8_GATHER_OFFS
}

template <class Epi, class Sched>
__device__ __forceinline__ void gemm_phase_n128(PG8_LAS unsigned char* lds, const int wid_in, const Sched& S, Epi& E) {
    const int wid = opaque_s(wid_in), lane = lane_id_(), tid = wid * 64 + lane, wr = wid >> 2, wc = wid & 3, fr = lane & 15, fq = lane >> 4;
    unsigned voffB[2], voffA[2];
#pragma unroll
    for (int i = 0; i < 2; ++i) { int R, C; stage_rc(tid * 16 + i * 8192, R, C); const int Rb = (R & ~31) + perm32(R & 31);
        voffB[i] = (unsigned)(Rb * LD + C) * 2u; voffA[i] = (unsigned)(R * LD + C) * 2u; }
    const size_t kstep = (size_t)(BK * 2);
    const unsigned ldsw = (unsigned)wid * 1024u;
    const int aoff = lds_byte(wr * 64 + fr, fq * 8), boff = lds_byte(wc * 32 + fr, fq * 8);
#define PG8_SA(b, h) (((b) * 2 + (h)) * HTB)
#define PG8_SB(b, h) ((4 + (b) * 2 + (h)) * HTB)
#define PG8_STAGE(bufoff, gbase, voff) do { _Pragma("unroll") for (int _i = 0; _i < 2; ++_i) \
        __builtin_amdgcn_global_load_lds((const unsigned*)((const char*)(gbase) + (voff)[_i]), (PG8_LAS unsigned*)(lds + (bufoff) + ldsw + _i * 8192), 16, 0, 0); } while (0)
#define PG8_LDA(dst, b, h) do { _Pragma("unroll") for (int m = 0; m < 4; ++m) _Pragma("unroll") for (int k = 0; k < 2; ++k) dst[m][k] = *(const PG8_LAS bf16x8*)(lds + PG8_SA(b, h) + aoff + m * 2048 + k * 1024); } while (0)
#define PG8_LDB(dst, b, h) do { _Pragma("unroll") for (int n = 0; n < 2; ++n) _Pragma("unroll") for (int k = 0; k < 2; ++k) dst[n][k] = *(const PG8_LAS bf16x8*)(lds + PG8_SB(b, h) + boff + n * 2048 + k * 1024); } while (0)
#define PG8_MMA(ai, At, Bt) do { __builtin_amdgcn_s_setprio(1); _Pragma("unroll") for (int m = 0; m < 4; ++m) _Pragma("unroll") for (int n = 0; n < 2; ++n) _Pragma("unroll") for (int k = 0; k < 2; ++k) \
        acc[ai][m][n] = __builtin_amdgcn_mfma_f32_16x16x32_bf16(Bt[n][k], At[m][k], acc[ai][m][n], 0, 0, 0); __builtin_amdgcn_s_setprio(0); } while (0)
#define PG8_WAIT_V(n) asm volatile("s_waitcnt vmcnt(" #n ")" ::: "memory")
#define PG8_WAIT_L(n) asm volatile("s_waitcnt lgkmcnt(" #n ")" ::: "memory")
#define PG8_BAR __builtin_amdgcn_s_barrier()
#define PG8_SCHED __builtin_amdgcn_sched_barrier(0)
    GU cur, nxt; int ui = 0;
    if (!S.next(0, cur)) return;
    f32x4 acc[2][4][2];
#pragma unroll
    for (int a = 0; a < 2; ++a)
#pragma unroll
        for (int m = 0; m < 4; ++m)
#pragma unroll
            for (int n = 0; n < 2; ++n) { const float z_ = zero_(); acc[a][m][n] = (f32x4){z_, z_, z_, z_}; }
    bf16x8 At[4][2], B0[2][2];
    u32x4 st_u[2][4], st_s[2][4];
    const char* cA = cur.A; const char* cB = cur.B0;
    PG8_STAGE(PG8_SB(0, 0), cB, voffB); PG8_STAGE(PG8_SA(0, 0), cA, voffA); PG8_STAGE(PG8_SA(0, 1), cA + HSTEP, voffA);
    if (wr == 1) PG8_BAR;
    PG8_WAIT_V(2); PG8_BAR;
    PG8_STAGE(PG8_SB(1, 0), cB + kstep, voffB); PG8_STAGE(PG8_SA(1, 0), cA + kstep, voffA);
    PG8_WAIT_V(4); PG8_BAR;
    for (;;) {
        const bool has_next = S.next(ui + 1, nxt);
        if (!has_next) nxt = cur;
        const char* nA = nxt.A; const char* nB = nxt.B0;
        const int nt = cur.nt;
        for (int t = 0; t < nt; t += 2) {
            const bool last = (t == nt - 2);
            const char* a1 = cA + (size_t)(t + 1) * kstep;
            const char* a2 = last ? nA : cA + (size_t)(t + 2) * kstep;
            const char* b2 = last ? nB : cB + (size_t)(t + 2) * kstep;
            const char* a3 = a2 + kstep; const char* b3 = b2 + kstep;
            PG8_LDB(B0, 0, 0); PG8_SCHED; PG8_LDA(At, 0, 0); PG8_STAGE(PG8_SA(1, 1), a1 + HSTEP, voffA);
            PG8_WAIT_V(6); PG8_WAIT_L(0); PG8_BAR; PG8_MMA(0, At, B0); PG8_BAR; PG8_SCHED;
            PG8_LDA(At, 0, 1); PG8_STAGE(PG8_SB(0, 0), b2, voffB); PG8_STAGE(PG8_SA(0, 0), a2, voffA);
            PG8_WAIT_V(6); PG8_WAIT_L(0); PG8_BAR; PG8_MMA(1, At, B0); PG8_BAR; PG8_SCHED;
            PG8_LDB(B0, 1, 0); PG8_SCHED; PG8_LDA(At, 1, 0); PG8_STAGE(PG8_SA(0, 1), a2 + HSTEP, voffA);
            PG8_WAIT_V(6); PG8_WAIT_L(0); PG8_BAR; PG8_MMA(0, At, B0); PG8_BAR; PG8_SCHED;
            PG8_LDA(At, 1, 1); PG8_STAGE(PG8_SB(1, 0), b3, voffB); PG8_STAGE(PG8_SA(1, 0), a3, voffA);
            PG8_WAIT_V(6); PG8_WAIT_L(0); PG8_BAR; PG8_MMA(1, At, B0); PG8_BAR; PG8_SCHED;
        }
        if (wr == 0) PG8_BAR;
        E(acc, st_u, st_s, cur, wr, wc, fr, fq);
        if (!has_next) break;
#pragma unroll
        for (int a = 0; a < 2; ++a)
#pragma unroll
            for (int m = 0; m < 4; ++m)
#pragma unroll
                for (int n = 0; n < 2; ++n) { const float z_ = zero_(); acc[a][m][n] = (f32x4){z_, z_, z_, z_}; }
        cur = nxt; cA = nA; cB = nB; ++ui;
        if (wr == 1) PG8_BAR;
    }
    PG8_WAIT_V(0);
    PG8_BAR;
#undef PG8_SA
#undef PG8_SB
#undef PG8_STAGE
#undef PG8_LDA
#undef PG8_LDB
#undef PG8_MMA
#undef PG8_WAIT_V
#undef PG8_WAIT_L
#undef PG8_BAR
#undef PG8_SCHED
}
template <class Epi, class Sched>
__device__ __forceinline__ void gemm_phase_c8(PG8_LAS unsigned char* lds, const int wid_in, const Sched& S, Epi& E) {
    const int wid = opaque_s(wid_in), lane = lane_id_(), tid = wid * 64 + lane, wr = wid >> 2, wc = wid & 3, fr = lane & 15, fq = lane >> 4;
    unsigned voffB[2], voffA[2];
#pragma unroll
    for (int i = 0; i < 2; ++i) { int R, C; stage_rc(tid * 16 + i * 8192, R, C); const int Rb = (R & ~31) + perm32(R & 31);
        voffB[i] = (unsigned)(Rb * LD + C) * 2u; voffA[i] = (unsigned)(R * LD + C) * 2u; }
    const size_t kstep = (size_t)(BK * 2);
    const unsigned ldsb = (unsigned)__builtin_amdgcn_readfirstlane((int)((unsigned)(size_t)lds + (unsigned)wid * 1024u));
    const int aoff = lds_byte(wr * 64 + fr, fq * 8), boff = lds_byte(wc * 32 + fr, fq * 8);
    const int aoff8 = lds_byte(wr * 64 + fr, 16 * fq), boff8 = lds_byte(wc * 32 + fr, 16 * fq);
#define PG8_SA(b, h) (((b) * 2 + (h)) * HTB)
#define PG8_SB(b, h) ((4 + (b) * 2 + (h)) * HTB)
#define PG8_STAGE(bufoff, gbase, voff) do { _Pragma("unroll") for (int _i = 0; _i < 2; ++_i) glds16_s((const char*)(gbase), (voff)[_i], ldsb + (unsigned)((bufoff) + _i * 8192)); } while (0)
#define PG8_STAGE8(bufoff, gbase, voff) do { _Pragma("unroll") for (int _i = 0; _i < 2; ++_i) { const unsigned _v = ((voff)[_i] + ((voff)[_i] & 2047u)) >> 1; glds16_s((const char*)(gbase), _v, ldsb + (unsigned)((bufoff) + _i * 8192)); } } while (0)
#define PG8_STB(bufoff, gbase, f8) do { if (f8) { PG8_STAGE8(bufoff, gbase, voffB); } else { PG8_STAGE(bufoff, gbase, voffB); } } while (0)
#define PG8_STA(bufoff, gbase, h, f8) do { if (f8) { PG8_STAGE8(bufoff, (gbase) + (h) * (HSTEP / 2), voffA); } else { PG8_STAGE(bufoff, (gbase) + (h) * HSTEP, voffA); } } while (0)
#define PG8_LDA(dst, b, h) do { _Pragma("unroll") for (int m = 0; m < 4; ++m) _Pragma("unroll") for (int k = 0; k < 2; ++k) dst[m][k] = *(const PG8_LAS bf16x8*)(lds + PG8_SA(b, h) + aoff + m * 2048 + k * 1024); } while (0)
#define PG8_LDB(dst, b, h) do { _Pragma("unroll") for (int n = 0; n < 2; ++n) _Pragma("unroll") for (int k = 0; k < 2; ++k) dst[n][k] = *(const PG8_LAS bf16x8*)(lds + PG8_SB(b, h) + boff + n * 2048 + k * 1024); } while (0)
#define PG8_LDA8(dst, b, h) do { _Pragma("unroll") for (int m = 0; m < 4; ++m) _Pragma("unroll") for (int k = 0; k < 2; ++k) dst[m][k] = *(const PG8_LAS bf16x8*)(lds + PG8_SA(b, h) + aoff8 + m * 2048 + k * 16); } while (0)
#define PG8_LDB8(dst, b, h) do { _Pragma("unroll") for (int n = 0; n < 2; ++n) _Pragma("unroll") for (int k = 0; k < 2; ++k) dst[n][k] = *(const PG8_LAS bf16x8*)(lds + PG8_SB(b, h) + boff8 + n * 2048 + k * 16); } while (0)
#define PG8_MMA(ai, At, Bt) do { __builtin_amdgcn_s_setprio(1); _Pragma("unroll") for (int m = 0; m < 4; ++m) _Pragma("unroll") for (int n = 0; n < 2; ++n) _Pragma("unroll") for (int k = 0; k < 2; ++k) \
        acc[ai][m][n] = __builtin_amdgcn_mfma_f32_16x16x32_bf16(Bt[n][k], At[m][k], acc[ai][m][n], 0, 0, 0); __builtin_amdgcn_s_setprio(0); } while (0)
#define PG8_MMA8(ai, At, Bt) do { __builtin_amdgcn_s_setprio(1); _Pragma("unroll") for (int m = 0; m < 4; ++m) _Pragma("unroll") for (int n = 0; n < 2; ++n) \
        acc[ai][m][n] = __builtin_amdgcn_mfma_scale_f32_16x16x128_f8f6f4(cat8(Bt[n][0], Bt[n][1]), cat8(At[m][0], At[m][1]), acc[ai][m][n], 0, 0, 0, 0, 0, 0); __builtin_amdgcn_s_setprio(0); } while (0)
#define PG8_WAIT_V(n) asm volatile("s_waitcnt vmcnt(" #n ")" ::: "memory")
#define PG8_WAIT_L(n) asm volatile("s_waitcnt lgkmcnt(" #n ")" ::: "memory")
#define PG8_BAR __builtin_amdgcn_s_barrier()
#define PG8_SCHED __builtin_amdgcn_sched_barrier(0)
    GU cu, cg, nxt; int ui = 0;
    if (!S.next(0, cu)) return;
    f32x4 acc[2][4][2];
#define PG8_ZACC() do { _Pragma("unroll") for (int a = 0; a < 2; ++a) _Pragma("unroll") for (int m = 0; m < 4; ++m) _Pragma("unroll") for (int n = 0; n < 2; ++n) { const float z_ = zero_(); acc[a][m][n] = (f32x4){z_, z_, z_, z_}; } } while (0)
    PG8_ZACC();
    bf16x8 At[4][2], B0[2][2];
    u32x4 st_u[2][4], st_s[2][4];
    PG8_STB(PG8_SB(0, 0), cu.B0, true); PG8_STA(PG8_SA(0, 0), cu.A, 0, true); PG8_STA(PG8_SA(0, 1), cu.A, 1, true);
    if (wr == 1) PG8_BAR;
    PG8_WAIT_V(2); PG8_BAR;
    PG8_STB(PG8_SB(1, 0), cu.B0 + kstep, true); PG8_STA(PG8_SA(1, 0), cu.A + kstep, 0, true);
    PG8_WAIT_V(4); PG8_BAR;
#define PG8_KLOOP(LDA_, LDB_, MMA_, C8, N8, cA, cB, nA, nB, nt) \
        for (int t = 0; t < (nt); t += 2) { \
            const bool last = (t == (nt) - 2); \
            const char* a1 = (cA) + (size_t)(t + 1) * kstep; \
            const char* a2 = last ? (nA) : (cA) + (size_t)(t + 2) * kstep; \
            const char* b2 = last ? (nB) : (cB) + (size_t)(t + 2) * kstep; \
            const char* a3 = a2 + kstep; const char* b3 = b2 + kstep; \
            LDB_(B0, 0, 0); PG8_SCHED; LDA_(At, 0, 0); PG8_STA(PG8_SA(1, 1), a1, 1, C8); \
            PG8_WAIT_V(6); PG8_WAIT_L(0); PG8_BAR; MMA_(0, At, B0); PG8_BAR; PG8_SCHED; \
            if (last) { LDA_(At, 0, 1); PG8_STB(PG8_SB(0, 0), b2, N8); PG8_STA(PG8_SA(0, 0), a2, 0, N8); } else { LDA_(At, 0, 1); PG8_STB(PG8_SB(0, 0), b2, C8); PG8_STA(PG8_SA(0, 0), a2, 0, C8); } \
            PG8_WAIT_V(6); PG8_WAIT_L(0); PG8_BAR; MMA_(1, At, B0); PG8_BAR; PG8_SCHED; \
            if (last) { LDB_(B0, 1, 0); PG8_SCHED; LDA_(At, 1, 0); PG8_STA(PG8_SA(0, 1), a2, 1, N8); } else { LDB_(B0, 1, 0); PG8_SCHED; LDA_(At, 1, 0); PG8_STA(PG8_SA(0, 1), a2, 1, C8); } \
            PG8_WAIT_V(6); PG8_WAIT_L(0); PG8_BAR; MMA_(0, At, B0); PG8_BAR; PG8_SCHED; \
            if (last) { LDA_(At, 1, 1); PG8_STB(PG8_SB(1, 0), b3, N8); PG8_STA(PG8_SA(1, 0), a3, 0, N8); } else { LDA_(At, 1, 1); PG8_STB(PG8_SB(1, 0), b3, C8); PG8_STA(PG8_SA(1, 0), a3, 0, C8); } \
            PG8_WAIT_V(6); PG8_WAIT_L(0); PG8_BAR; MMA_(1, At, B0); PG8_BAR; PG8_SCHED; \
        }
    for (;;) {
        S.next(ui + 1, cg);
        PG8_KLOOP(PG8_LDA8, PG8_LDB8, PG8_MMA8, true, true, cu.A, cu.B0, cg.A, cg.B0, cu.nt)
        if (wr == 0) PG8_BAR;
        { const int l2_ = lane_id_(); E(acc, st_u, st_s, cu, wr, wc, l2_ & 15, l2_ >> 4); }
        PG8_ZACC();
        if (wr == 1) PG8_BAR;
        const bool has_next = S.next(ui + 2, nxt);
        if (!has_next) { nxt.A = S.BRp; nxt.B0 = S.WBp; }
        PG8_KLOOP(PG8_LDA8, PG8_LDB8, PG8_MMA8, true, true, cg.A, cg.B0, nxt.A, nxt.B0, cg.nt)
        if (wr == 0) PG8_BAR;
        { const int l2_ = lane_id_(); E(acc, st_u, st_s, cg, wr, wc, l2_ & 15, l2_ >> 4); }
        if (!has_next) break;
        PG8_ZACC();
        cu = nxt; ui += 2;
        if (wr == 1) PG8_BAR;
    }
#undef PG8_KLOOP
#undef PG8_ZACC
    PG8_WAIT_V(0);
    PG8_BAR;
#undef PG8_SA
#undef PG8_SB
#undef PG8_STAGE
#undef PG8_STAGE8
#undef PG8_STB
#undef PG8_STA
#undef PG8_LDA
#undef PG8_LDB
#undef PG8_LDA8
#undef PG8_LDB8
#undef PG8_MMA
#undef PG8_MMA8
#undef PG8_WAIT_V
#undef PG8_WAIT_L
#undef PG8_BAR
#undef PG8_SCHED
}
}
namespace attn_body {
using bf16=__hip_bfloat16;
using bf16x8=__attribute__((ext_vector_type(8)))short;
using s16x4=__attribute__((ext_vector_type(4)))short;
using f32x16=__attribute__((ext_vector_type(16)))float;
using f32x4=__attribute__((ext_vector_type(4)))float;
using u32x4=__attribute__((ext_vector_type(4)))unsigned;
constexpr int SEQ=4096,D=64;
constexpr int KVP=2304;
constexpr int OP=1024;
constexpr int NW=8,QBLK=32,QB=QBLK*NW,KVBLK=64,NQB=SEQ/QB;
__device__ __forceinline__ int crow(int r,int hi){return (r&3)+8*(r>>2)+4*hi;}
#define SBAR() __builtin_amdgcn_sched_barrier(0)
__device__ __forceinline__ void cmask(f32x16&p0,f32x16&p1,int jb,int qrel,int hi){
  const float NEG=-INFINITY; int kb=64*jb+4*hi;
  #pragma unroll
  for(int r=0;r<16;++r){int kv=kb+(r&3)+8*(r>>2); if(kv>qrel)p0[r]=NEG; if(kv+32>qrel)p1[r]=NEG;}
}
__device__ __forceinline__ void bmask(f32x16&p0,f32x16&p1,unsigned long long w,int hi){
  const float NEG=-INFINITY; const unsigned lo=((unsigned)w)>>(4*hi), up=((unsigned)(w>>32))>>(4*hi);
  #pragma unroll
  for(int r=0;r<16;++r){const int bit=(r&3)+8*(r>>2); if(!((lo>>bit)&1u))p0[r]=NEG; if(!((up>>bit)&1u))p1[r]=NEG;}
}
constexpr int NSLOT=3, SLOTB=8192;
constexpr int LDS_K=0, LDS_V=NSLOT*SLOTB, LDS_WS=2*NSLOT*SLOTB, LDS_OST=LDS_WS+NW*64*4, LDS_BIAS=LDS_OST+NW*4096, LDS_BYTES=LDS_BIAS+SEQ*4;
constexpr float C2=0.125f*1.4426950408889634f;
__device__ __forceinline__ void glds16(const void*gsrc,unsigned lds_dst){unsigned keep;
  asm volatile("s_mov_b32 %0, m0\n\ts_mov_b32 m0, %2\n\ts_nop 0\n\tglobal_load_lds_dwordx4 %1, off\n\ts_mov_b32 m0, %0":"=&s"(keep):"v"(gsrc),"s"(lds_dst):"memory");}
__device__ __forceinline__ float max3f(float a,float b,float c){float r;asm("v_max3_f32 %0, %1, %2, %3":"=v"(r):"v"(a),"v"(b),"v"(c));return r;}
__device__ __forceinline__ float max2f(float a,float b){float r;asm("v_max_f32_e32 %0, %1, %2":"=v"(r):"v"(a),"v"(b));return r;}
__device__ __forceinline__ float fadd_s(float a,float b){float r;asm("v_add_f32_e32 %0, %1, %2":"=v"(r):"v"(a),"v"(b));return r;}
__device__ __forceinline__ float fsub_s(float a,float b){float r;asm("v_sub_f32_e32 %0, %1, %2":"=v"(r):"v"(a),"v"(b));return r;}
typedef float f32x2_t __attribute__((ext_vector_type(2))); typedef __bf16 bf16x2_t __attribute__((ext_vector_type(2)));
__device__ __forceinline__ unsigned cvtpk_s(float lo,float hi){f32x2_t v={lo,hi};bf16x2_t b=__builtin_convertvector(v,bf16x2_t);return __builtin_bit_cast(unsigned,b);}
#define WAIT_BAR(N) asm volatile("s_waitcnt vmcnt(" #N ") lgkmcnt(0)\n\ts_barrier":::"memory")

typedef __attribute__((address_space(3))) const char* lds_cptr;
typedef short v4i16_t __attribute__((ext_vector_type(4)));
__device__ __forceinline__ void binit(f32x16&p0,f32x16&p1,lds_cptr bp,float mhat){
  typedef float f2_ __attribute__((ext_vector_type(2))); const f2_ m2={mhat,mhat};
  #pragma unroll
  for(int g=0;g<4;++g){ const f32x4 a=*(const __attribute__((address_space(3))) f32x4*)(bp+g*32); const f32x4 b=*(const __attribute__((address_space(3))) f32x4*)(bp+128+g*32);
    const f2_ a0=(f2_){a[0],a[1]}-m2,a1=(f2_){a[2],a[3]}-m2,b0=(f2_){b[0],b[1]}-m2,b1=(f2_){b[2],b[3]}-m2;
    p0[4*g]=a0.x;p0[4*g+1]=a0.y;p0[4*g+2]=a1.x;p0[4*g+3]=a1.y; p1[4*g]=b0.x;p1[4*g+1]=b0.y;p1[4*g+2]=b1.x;p1[4*g+3]=b1.y; }
}
__device__ __forceinline__ void qkt(f32x16&p0,f32x16&p1,const char*Kslot,const bf16x8*qr,int r32,int hi){
  const char*kb=Kslot+hi*1024+r32*16;
  #pragma unroll
  for(int d0=0;d0<4;++d0){
    const bf16x8 b0=*reinterpret_cast<const bf16x8*>(kb+d0*2048);
    const bf16x8 b1=*reinterpret_cast<const bf16x8*>(kb+d0*2048+512);
    p0=__builtin_amdgcn_mfma_f32_32x32x16_bf16(b0,qr[d0],p0,0,0,0);p1=__builtin_amdgcn_mfma_f32_32x32x16_bf16(b1,qr[d0],p1,0,0,0);}
}
__device__ __forceinline__ void kload8(bf16x8*kf,lds_cptr kp){
  kf[0]=*(const __attribute__((address_space(3))) bf16x8*)(kp);      kf[1]=*(const __attribute__((address_space(3))) bf16x8*)(kp+512);
  kf[2]=*(const __attribute__((address_space(3))) bf16x8*)(kp+2048); kf[3]=*(const __attribute__((address_space(3))) bf16x8*)(kp+2560);
  kf[4]=*(const __attribute__((address_space(3))) bf16x8*)(kp+4096); kf[5]=*(const __attribute__((address_space(3))) bf16x8*)(kp+4608);
  kf[6]=*(const __attribute__((address_space(3))) bf16x8*)(kp+6144); kf[7]=*(const __attribute__((address_space(3))) bf16x8*)(kp+6656);
}
__device__ __forceinline__ void kload2(bf16x8*kf,lds_cptr kp,int j){ kf[2*j]=*(const __attribute__((address_space(3))) bf16x8*)(kp+j*2048); kf[2*j+1]=*(const __attribute__((address_space(3))) bf16x8*)(kp+j*2048+512); }
__device__ __forceinline__ s16x4 vtr(lds_cptr p){ return __builtin_bit_cast(s16x4,__builtin_amdgcn_ds_read_tr16_b64_v4i16((__attribute__((address_space(3))) v4i16_t*)p)); }
__device__ __forceinline__ float rowmax(const f32x16&p0,const f32x16&p1){
  float a=max3f(p0[0],p0[1],p1[0]),b=max3f(p0[2],p0[3],p1[1]);a=max3f(a,p1[2],p1[3]);
  #pragma unroll
  for(int r=4;r<16;r+=4){a=max3f(a,p0[r],p0[r+1]);b=max3f(b,p0[r+2],p0[r+3]);a=max3f(a,p1[r],p1[r+1]);b=max3f(b,p1[r+2],p1[r+3]);}
  const float m=max2f(a,b);
  auto rr=__builtin_amdgcn_permlane32_swap(__float_as_uint(m),__float_as_uint(m),false,false);
  return max2f(__uint_as_float(rr[0]),__uint_as_float(rr[1]));
}
__device__ __forceinline__ void pv(f32x16*o,int vb,bf16x8 pa0,bf16x8 pa1,bf16x8 pa2,bf16x8 pa3){
  #pragma unroll
  for(int d0=0;d0<2;++d0){s16x4 lo[4],hi[4];
    #pragma unroll
    for(int ks=0;ks<4;++ks){
      asm volatile("ds_read_b64_tr_b16 %0,%1 offset:%c2":"=&v"(lo[ks]):"v"(vb),"i"(d0*4096+ks*1024):"memory");
      asm volatile("ds_read_b64_tr_b16 %0,%1 offset:%c2":"=&v"(hi[ks]):"v"(vb),"i"(d0*4096+ks*1024+512):"memory");}
    asm volatile("s_waitcnt lgkmcnt(0)":::"memory");SBAR();
    #define PK(k) (bf16x8){lo[k][0],lo[k][1],lo[k][2],lo[k][3],hi[k][0],hi[k][1],hi[k][2],hi[k][3]}
    o[d0]=__builtin_amdgcn_mfma_f32_32x32x16_bf16(pa0,PK(0),o[d0],0,0,0);
    o[d0]=__builtin_amdgcn_mfma_f32_32x32x16_bf16(pa1,PK(1),o[d0],0,0,0);
    o[d0]=__builtin_amdgcn_mfma_f32_32x32x16_bf16(pa2,PK(2),o[d0],0,0,0);
    o[d0]=__builtin_amdgcn_mfma_f32_32x32x16_bf16(pa3,PK(3),o[d0],0,0,0);
    #undef PK
  }
}

template<int THRL,bool MASK> __device__ __forceinline__ void attn_unit(int q0,const bf16*Qs,const bf16*__restrict__ Ks,const bf16*__restrict__ Vs,bf16*Os,
                                                                       const float*biasg,float slope2,const unsigned long long*maskw,char*shm,const int wid_in){
  const int wid=opaque_s(wid_in),lane=lane_id_(),tid=wid*64+lane,r32=lane&31,hi=lane>>5;
  const bf16*Qw=Qs+(long)(q0+wid*QBLK)*KVP;
  const unsigned lds0=(unsigned)(uintptr_t)shm;
  float*wsf=(float*)(shm+LDS_WS)+wid*64;
  unsigned long long mwA=0ull,mwB=0ull;
  { float*bl=(float*)(shm+LDS_BIAS); const int nk=q0+QB;
    if(biasg){ for(int s=tid;s<nk;s+=NW*64)bl[s]=biasg[s]; } else { for(int s=tid;s<nk;s+=NW*64)bl[s]=slope2*(float)s; }
    if(MASK){ const unsigned long long*mp0=maskw+(q0+wid*QBLK+(lane&31)); mwA=mp0[0]; mwB=mp0[SEQ]; asm volatile("":"+v"(mwA),"+v"(mwB)); }
    asm volatile("s_waitcnt vmcnt(0) lgkmcnt(0)":::"memory"); }
  const bf16*ksrc=Ks+(long)lane*KVP+wid*8;
  const bf16*vsrc=Vs+(long)(16*(wid&3)+(lane>>2))*KVP+(wid>>2)*32+(lane&3)*8;
  const unsigned kdst=lds0+LDS_K+wid*1024, vdst=lds0+LDS_V+wid*1024;
  #define DMA_K(t,slot) glds16(ksrc+(long)(t)*KVBLK*KVP,(unsigned)__builtin_amdgcn_readfirstlane(kdst+(slot)))
  #define DMA_V(t,slot) glds16(vsrc+(long)(t)*KVBLK*KVP,(unsigned)__builtin_amdgcn_readfirstlane(vdst+(slot)))
  const int vb0=(int)(lds0+LDS_V)+((lane>>4)&1)*32+(lane&3)*8+(4*hi+((lane&15)>>2))*64;
  const char*Kbase=shm+LDS_K; bf16x8 kf[8];
  const lds_cptr shm3=(lds_cptr)shm; const lds_cptr kp0=shm3+LDS_K+hi*1024+r32*16; const lds_cptr vp0=shm3+LDS_V+((lane>>4)&1)*32+(lane&3)*8+(4*hi+((lane&15)>>2))*64;
  const lds_cptr bp0=shm3+LDS_BIAS+hi*16;
  const int NT=(q0+QB)/KVBLK;
  DMA_K(0,0);DMA_V(0,0);DMA_K(1,SLOTB);
  bf16x8 qr[4];
  #pragma unroll
  for(int d0=0;d0<4;++d0)qr[d0]=*reinterpret_cast<const bf16x8*>(&Qw[(long)r32*KVP+d0*16+hi*8]);
  const unsigned long long*mwp=MASK?maskw+(q0+wid*QBLK+r32):nullptr;
  #define MLOAD(MW,t) do{ if(MASK){ MW=mwp[(long)(t)*SEQ]; } }while(0)
  #define MPIN(MW) do{}while(0)
  float mhat=0.f,l_reg=0.f;f32x16 o[2];o[0]=f32x16{};o[1]=f32x16{};
  const int qrel=wid*QBLK+r32;
  #define CMASK(P0,P1,t,MW) do{ if(MASK){ bmask(P0,P1,MW,hi); } else { int jb_=(t)-(NT-4); if(jb_>=0)cmask(P0,P1,jb_,qrel,hi); } }while(0)
  bool resc=false;
  #define START(P0,P1) do{ const float rm=rowmax(P0,P1); resc=false; \
    { const float dl=__builtin_fmaxf(rm,-60000.f); mhat=fadd_s(mhat,dl); \
      _Pragma("unroll") for(int r=0;r<16;++r){P0[r]=fsub_s(P0[r],dl);P1[r]=fsub_s(P1[r],dl);} } \
    _Pragma("unroll") for(int r=0;r<16;++r)P0[r]=__builtin_amdgcn_exp2f(P0[r]); }while(0)
  #define RESC() do{ if(resc){ asm volatile("s_waitcnt lgkmcnt(0)":::"memory"); \
      _Pragma("unroll") for(int d_=0;d_<2;++d_) _Pragma("unroll") for(int r=0;r<16;++r)o[d_][r]*=wsf[crow(r,hi)]; } }while(0)
  f32x16 pA0,pA1,pB0,pB1;
  int sl_prev=0,sl_cur=0,sl_next=SLOTB;
  #define ROT() do{sl_prev=sl_cur;sl_cur=sl_next;sl_next=(sl_next==(NSLOT-1)*SLOTB)?0:sl_next+SLOTB;}while(0)
  DMA_K(2,2*SLOTB);
  WAIT_BAR(3);
  binit(pA0,pA1,bp0,0.f);
  qkt(pA0,pA1,Kbase,qr,r32,hi);asm volatile("s_nop 15\n\ts_nop 7":"+v"(pA0),"+v"(pA1));CMASK(pA0,pA1,0,mwA);
  START(pA0,pA1);
  _Pragma("unroll") for(int r=0;r<16;++r)pA1[r]=__builtin_amdgcn_exp2f(pA1[r]);
  WAIT_BAR(0);
  DMA_K(3,0);DMA_V(1,SLOTB);MLOAD(mwA,2);
  ROT();
  kload8(kf,kp0+sl_cur);
  if(MASK){WAIT_BAR(3);}else{WAIT_BAR(2);}
  s16x4 vlo[8],vhi[8]; u32x4 pw0,pw1,pw2,pw3;
  #define PKW(P,B) cvtpk_s(P[B],P[B+1])
  #define PAF(k) __builtin_bit_cast(bf16x8,pw##k)
  #define VFR(i) (bf16x8){vlo[i][0],vlo[i][1],vlo[i][2],vlo[i][3],vhi[i][0],vhi[i][1],vhi[i][2],vhi[i][3]}
  #define PIN(x) asm volatile("":"+v"(x))
  #define MX3(a,b,c) __builtin_fmaxf(__builtin_fmaxf((a),(b)),(c))
  #define GAPA(MF,A0,A1,A2,A3,W0,W1,PW) do{ MF; sacc+=A0; sacc+=A1; sacc+=A2; sacc+=A3; PIN(sacc); W0; W1; PIN(PW); SBAR(); }while(0)
  #define EX(v) __builtin_amdgcn_exp2f(v)
  #define GAPB(MF,X,B) do{ MF; X[B]=EX(X[B]); X[B+1]=EX(X[B+1]); X[B+2]=EX(X[B+2]); X[B+3]=EX(X[B+3]); PIN(X); SBAR(); }while(0)
  #define VRD(i) do{ vlo[i]=vtr(vp_+(((i)>>2)*4096+((i)&3)*1024)); vhi[i]=vtr(vp_+(((i)>>2)*4096+((i)&3)*1024+512)); }while(0)
  #define KRD(G,j) do{ if(G){ kload2(kf,kp0+sl_next,j); SBAR(); } }while(0)
  #define STEP(C0,C1,P0,P1,t,GK,GV,GL,MW,GM,DOCM) do{ SBAR(); \
    const lds_cptr vp_=vp0+sl_prev; \
    binit(C0,C1,bp0+(t)*256,mhat); SBAR(); \
    VRD(0); SBAR(); float sacc=(P0[0]+P0[1]); \
    GAPA(C0=__builtin_amdgcn_mfma_f32_32x32x16_bf16(kf[0],qr[0],C0,0,0,0), P0[2],P0[3],P0[4],P0[5],     pw0[0]=PKW(P0,0), pw0[1]=PKW(P0,2), pw0); \
    VRD(4); SBAR(); GAPA(C1=__builtin_amdgcn_mfma_f32_32x32x16_bf16(kf[1],qr[0],C1,0,0,0), P0[6],P0[7],P0[8],P0[9],     pw0[2]=PKW(P0,4), pw0[3]=PKW(P0,6), pw0); \
    VRD(1); SBAR(); GAPA(C0=__builtin_amdgcn_mfma_f32_32x32x16_bf16(kf[2],qr[1],C0,0,0,0),   P0[10],P0[11],P0[12],P0[13], pw1[0]=PKW(P0,8), pw1[1]=PKW(P0,10), pw1); \
    VRD(5); SBAR(); GAPA(C1=__builtin_amdgcn_mfma_f32_32x32x16_bf16(kf[3],qr[1],C1,0,0,0),   P0[14],P0[15],P1[0],P1[1],   pw1[2]=PKW(P0,12),pw1[3]=PKW(P0,14), pw1); \
    VRD(2); SBAR(); GAPA(C0=__builtin_amdgcn_mfma_f32_32x32x16_bf16(kf[4],qr[2],C0,0,0,0),   P1[2],P1[3],P1[4],P1[5],     pw2[0]=PKW(P1,0), pw2[1]=PKW(P1,2), pw2); \
    VRD(6); SBAR(); GAPA(C1=__builtin_amdgcn_mfma_f32_32x32x16_bf16(kf[5],qr[2],C1,0,0,0),   P1[6],P1[7],P1[8],P1[9],     pw2[2]=PKW(P1,4), pw2[3]=PKW(P1,6), pw2); \
    VRD(3); SBAR(); GAPA(C0=__builtin_amdgcn_mfma_f32_32x32x16_bf16(kf[6],qr[3],C0,0,0,0),   P1[10],P1[11],P1[12],P1[13], pw3[0]=PKW(P1,8), pw3[1]=PKW(P1,10), pw3); \
    VRD(7); SBAR(); GAPA(C1=__builtin_amdgcn_mfma_f32_32x32x16_bf16(kf[7],qr[3],C1,0,0,0),   P1[14],P1[15],0.f,0.f,       pw3[2]=PKW(P1,12),pw3[3]=PKW(P1,14), pw3); \
    l_reg+=sacc; \
    if(MASK&&(DOCM)){ CMASK(C0,C1,t,MW); } \
    if(GK){DMA_K((t)+3,sl_cur);} if(GV){DMA_V((t)+1,sl_next);} \
    if(!MASK&&(DOCM)){ CMASK(C0,C1,t,MW); } \
    if(GM){ MLOAD(MW,(t)+2); } \
    { float a=MX3(C0[0],C0[1],C1[0]),b=MX3(C0[2],C0[3],C1[1]); a=MX3(a,C1[2],C1[3]); \
      _Pragma("unroll") for(int r=4;r<16;r+=4){a=MX3(a,C0[r],C0[r+1]);b=MX3(b,C0[r+2],C0[r+3]);a=MX3(a,C1[r],C1[r+1]);b=MX3(b,C1[r+2],C1[r+3]);} \
      float rm=__builtin_fmaxf(a,b); { auto rr=__builtin_amdgcn_permlane32_swap(__float_as_uint(rm),__float_as_uint(rm),false,false); rm=__builtin_fmaxf(__uint_as_float(rr[0]),__uint_as_float(rr[1])); } \
      resc=false; \
      if(__builtin_expect(__any(rm>(float)THRL),0)){ const float dl=__builtin_fmaxf(rm,0.f); mhat+=dl; \
        _Pragma("unroll") for(int r=0;r<16;++r){C0[r]-=dl;C1[r]-=dl;} \
        const float f=__builtin_amdgcn_exp2f(-dl); l_reg*=f; if(hi==0)wsf[r32]=f; resc=true; } } \
    SBAR(); \
    GAPB(o[0]=__builtin_amdgcn_mfma_f32_32x32x16_bf16(PAF(0),VFR(0),o[0],0,0,0), C0,0); \
    GAPB(o[1]=__builtin_amdgcn_mfma_f32_32x32x16_bf16(PAF(0),VFR(4),o[1],0,0,0), C0,4); \
    KRD(GL,0); GAPB(o[0]=__builtin_amdgcn_mfma_f32_32x32x16_bf16(PAF(1),VFR(1),o[0],0,0,0), C0,8); \
    KRD(GL,1); GAPB(o[1]=__builtin_amdgcn_mfma_f32_32x32x16_bf16(PAF(1),VFR(5),o[1],0,0,0), C0,12); \
    KRD(GL,2); GAPB(o[0]=__builtin_amdgcn_mfma_f32_32x32x16_bf16(PAF(2),VFR(2),o[0],0,0,0), C1,0); \
    KRD(GL,3); GAPB(o[1]=__builtin_amdgcn_mfma_f32_32x32x16_bf16(PAF(2),VFR(6),o[1],0,0,0), C1,4); \
    GAPB(o[0]=__builtin_amdgcn_mfma_f32_32x32x16_bf16(PAF(3),VFR(3),o[0],0,0,0), C1,8); \
    GAPB(o[1]=__builtin_amdgcn_mfma_f32_32x32x16_bf16(PAF(3),VFR(7),o[1],0,0,0), C1,12); \
    }while(0)
  int t=1;
  #define ENDW(tt) do{ if((tt)+3<NT){ if(MASK){WAIT_BAR(3);}else{WAIT_BAR(2);} } else if((tt)+2<NT){ if(MASK){WAIT_BAR(2);}else{WAIT_BAR(1);} } else {WAIT_BAR(0);} }while(0)
  for(;t+5<NT;t+=2){
    STEP(pB0,pB1,pA0,pA1,t,true,true,true,mwB,MASK,MASK);     if(MASK){WAIT_BAR(3);}else{WAIT_BAR(2);} MPIN(mwA); RESC(); ROT();
    STEP(pA0,pA1,pB0,pB1,t+1,true,true,true,mwA,MASK,MASK);   if(MASK){WAIT_BAR(3);}else{WAIT_BAR(2);} MPIN(mwB); RESC(); ROT();
  }
  for(;t+1<NT;t+=2){
    STEP(pB0,pB1,pA0,pA1,t,(t+3<NT),(t+1<NT),(t+1<NT),mwB,(MASK&&(t+2<NT)),true);       ENDW(t);   MPIN(mwA); RESC(); ROT();
    STEP(pA0,pA1,pB0,pB1,t+1,(t+4<NT),(t+2<NT),(t+2<NT),mwA,(MASK&&(t+3<NT)),true);     ENDW(t+1); MPIN(mwB); RESC(); ROT();
  }
  STEP(pB0,pB1,pA0,pA1,NT-1,false,false,false,mwB,false,true); RESC();
  { float sacc=pB0[0]+pB0[1]; _Pragma("unroll") for(int r=2;r<16;++r)sacc+=pB0[r]; _Pragma("unroll") for(int r=0;r<16;++r)sacc+=pB1[r]; l_reg+=sacc;
    pw0=(u32x4){PKW(pB0,0),PKW(pB0,2),PKW(pB0,4),PKW(pB0,6)};pw1=(u32x4){PKW(pB0,8),PKW(pB0,10),PKW(pB0,12),PKW(pB0,14)};pw2=(u32x4){PKW(pB1,0),PKW(pB1,2),PKW(pB1,4),PKW(pB1,6)};pw3=(u32x4){PKW(pB1,8),PKW(pB1,10),PKW(pB1,12),PKW(pB1,14)};
    SBAR(); pv(o,vb0+sl_cur,PAF(0),PAF(1),PAF(2),PAF(3)); }
  #undef PKW
  #undef PAF
  #undef VFR
  #undef PIN
  #undef MX3
  #undef GAPA
  #undef GAPB
  #undef EX
  #undef VRD
  #undef KRD
  #undef STEP
  #undef ENDW
  {auto rr=__builtin_amdgcn_permlane32_swap(__float_as_uint(l_reg),__float_as_uint(l_reg),false,false);l_reg=__uint_as_float(rr[0])+__uint_as_float(rr[1]);}
  if(hi==0)wsf[32+r32]=l_reg;asm volatile("s_waitcnt lgkmcnt(0)":::"memory");
  float rli[16];
  #pragma unroll
  for(int r=0;r<16;++r)rli[r]=__builtin_amdgcn_rcpf(wsf[32+crow(r,hi)]);
  unsigned char*Ow=(unsigned char*)Os+(long)(q0+wid*QBLK)*OP;
  { unsigned char*stg=(unsigned char*)(shm+LDS_OST)+wid*4096;
    #pragma unroll
    for(int r=0;r<16;++r){const int orow=crow(r,hi); const float sc8=rli[r]*8.f;
      #pragma unroll
      for(int d0=0;d0<2;++d0){const float x=o[d0][r]*sc8; stg[orow*64+d0*32+r32]=(unsigned char)(__builtin_amdgcn_cvt_pk_fp8_f32(x,x,0,false)&0xff);}}
    asm volatile("s_waitcnt lgkmcnt(0)":::"memory");
    #pragma unroll
    for(int i=0;i<4;++i){const int row=i*8+(lane>>3),ch=lane&7; typedef unsigned u32x2_ __attribute__((ext_vector_type(2))); const u32x2_ v=*(const u32x2_*)(stg+row*64+ch*8); *(u32x2_*)(Ow+(long)row*OP+ch*8)=v;} }
  asm volatile("s_waitcnt lgkmcnt(0)\n\ts_barrier":::"memory");
  #undef DMA_K
  #undef MLOAD
  #undef MPIN
  #undef DMA_V
  #undef CMASK
  #undef START
  #undef RESC
  #undef ROT
}
#undef SBAR
#undef WAIT_BAR
}
struct Args { const float* in[25]; float* out; unsigned char* ws; int ph_lo, ph_hi; };
struct Frame {
    LAS unsigned char* lds; unsigned char* ldsg;
    volatile LAS unsigned* MISC;
    gu32* ctl;
    int tid, lane, wave, vcu, G;
    unsigned char* ws; float* out;
};
__device__ __forceinline__ float dpp_add_(float v, float acc_src, int) { return v; }
#define DPP_F(v, ctrl, rmask) __builtin_bit_cast(float, __builtin_amdgcn_update_dpp(0, __builtin_bit_cast(int, (v)), (ctrl), (rmask), 0xF, false))
__device__ __forceinline__ float wave_sum(float v) {
    v += DPP_F(v, 0xB1, 0xF);
    v += DPP_F(v, 0x4E, 0xF);
    v += DPP_F(v, 0x141, 0xF);
    v += DPP_F(v, 0x140, 0xF);
    v += DPP_F(v, 0x142, 0xA);
    v += DPP_F(v, 0x143, 0xC);
    return __builtin_bit_cast(float, __builtin_amdgcn_readlane(__builtin_bit_cast(int, v), 63));
}
__device__ __forceinline__ bf16* wsb(const Frame& F, size_t off) { return (bf16*)(F.ws + off); }

__device__ __forceinline__ int map_small(int r) {
    if (r < 1024) return r;
    if (r < 1280) return 1028 + (r - 1024);
    if (r < 1536) return 1412 + (r - 1280);
    if (r < 2048) return 1736 + (r - 1536);
    if (r < 2112) return 1284 + (r - 2048);
    if (r < 2176) return 1348 + (r - 2112);
    if (r < 2240) return 1668 + (r - 2176);
    if (r < 2244) return 1024 + (r - 2240);
    if (r < 2248) return 1732 + (r - 2244);
    return -1;
}
__device__ __forceinline__ void tr_item(const float* src, int ld_src, int k0, int srccol, bf16* dst, int ld_dst, LAS float* scr, int lane) {
    float tv[32];
#pragma unroll
    for (int i = 0; i < 32; ++i) { const int kk = 2 * i + (lane >> 5); tv[i] = src[(size_t)(k0 + kk) * ld_src + (srccol >= 0 ? srccol : 0)]; }
#pragma unroll
    for (int i = 0; i < 32; ++i) { const int kk = 2 * i + (lane >> 5); scr[kk * 33 + (lane & 31)] = srccol >= 0 ? tv[i] : 0.f; }
    LDS_WAIT(); asm volatile("" ::: "memory");
    const int c = lane & 7;
#pragma unroll
    for (int j = 0; j < 4; ++j) { const int n = (lane >> 3) + 8 * j; const LAS float* s = scr + (8 * c) * 33 + n;
        v4u o; o.x = pk2(s[0 * 33], s[1 * 33]); o.y = pk2(s[2 * 33], s[3 * 33]); o.z = pk2(s[4 * 33], s[5 * 33]); o.w = pk2(s[6 * 33], s[7 * 33]);
        *(GAS v4u*)(dst + (size_t)n * ld_dst + 8 * c) = o; }
    LDS_WAIT(); asm volatile("" ::: "memory");
}
#ifndef A_F8_TILES
#define A_F8_TILES 0x0DF
#endif
constexpr size_t W_SM8 = 4718592 + 4 * MiB;
constexpr float BR_SCALE = 8.f;
constexpr float MIX_SCALE = 8.f;
constexpr float ACT_SCALE = 8.f;
constexpr float GATE_WSCALE = 32.f;
__device__ __forceinline__ void tr_item8(const float* src, int ld_src, int k0, int srccol, unsigned char* dst, int ld_dst, LAS float* scr, int lane) {
    float tv[32];
#pragma unroll
    for (int i = 0; i < 32; ++i) { const int kk = 2 * i + (lane >> 5); tv[i] = src[(size_t)(k0 + kk) * ld_src + (srccol >= 0 ? srccol : 0)]; }
#pragma unroll
    for (int i = 0; i < 32; ++i) { const int kk = 2 * i + (lane >> 5); scr[kk * 33 + (lane & 31)] = srccol >= 0 ? tv[i] * GATE_WSCALE : 0.f; }
    LDS_WAIT(); asm volatile("" ::: "memory");
    const int c = lane & 7;
#pragma unroll
    for (int j = 0; j < 4; ++j) { const int n = (lane >> 3) + 8 * j; const LAS float* s = scr + (8 * c) * 33 + n;
        v2u o; o.x = pk4_fp8(s[0 * 33], s[1 * 33], s[2 * 33], s[3 * 33]); o.y = pk4_fp8(s[4 * 33], s[5 * 33], s[6 * 33], s[7 * 33]);
        *(GAS v2u*)(dst + (size_t)n * ld_dst + 8 * c) = o; }
    LDS_WAIT(); asm volatile("" ::: "memory");
}
constexpr int IT_SM = 72 * 16, IT_GT = 128 * 16, IT_BR = 512, IT_OUT = 512, IT_GU = 16 * 512, IT_D = 16 * 256, IT_LAYER = IT_SM + IT_GT + IT_BR + IT_OUT + IT_GU + IT_D;
__device__ __forceinline__ void p0_item(const Frame& F, const Args& a, int it, LAS float* scr) {
    const int l = it / IT_LAYER; int j = it % IT_LAYER; const int n = F.lane & 31;
    bf16* W = wsb(F, WS_W + (size_t)l * W_LAYER);
    if (j < IT_SM) { const int g = j / 16, kb = j % 16;
        if ((A_F8_TILES >> (g / 8)) & 1) tr_item8(a.in[3] + (size_t)l * DM * P_TOTAL, P_TOTAL, kb * 64, map_small(g * 32 + n), (unsigned char*)W + W_SM8 + (size_t)(g * 32) * DM + kb * 64, DM, scr, F.lane);
        else tr_item(a.in[3] + (size_t)l * DM * P_TOTAL, P_TOTAL, kb * 64, map_small(g * 32 + n), W + W_SM / 2 + (size_t)(g * 32) * DM + kb * 64, DM, scr, F.lane);
        return; } j -= IT_SM;
    if (j < IT_GT) { const int g = j / 16, kb = j % 16; tr_item8(a.in[3] + (size_t)l * DM * P_TOTAL, P_TOTAL, kb * 64, 2248 + g * 32 + n, (unsigned char*)W + W_GT + (size_t)(g * 32) * DM + kb * 64, DM, scr, F.lane); return; } j -= IT_GT;
    if (j < IT_BR) { const int nb = j / 128, jj = j % 128, g = jj / 4, kb = jj % 4;
        tr_item8(a.in[12] + ((size_t)l * 4 + nb) * 256 * DM, DM, kb * 64, g * 32 + n, (unsigned char*)W + W_BR + (size_t)(g * 32) * DM + nb * 256 + kb * 64, DM, scr, F.lane); return; } j -= IT_BR;
    if (j < IT_OUT) { const int g = j / 16, kb = j % 16; tr_item8(a.in[13] + (size_t)l * DM * DM, DM, kb * 64, g * 32 + n, (unsigned char*)W + W_OUT + (size_t)(g * 32) * DM + kb * 64, DM, scr, F.lane); return; } j -= IT_OUT;
    if (j < IT_GU) { const int e = j / 512, jj = j % 512, g = jj / 16, kb = jj % 16; const int r0 = g * 32, q = r0 >> 8, within = r0 & 255; const bool isup = within >= 128;
        const float* src = (isup ? a.in[21] : a.in[20]) + ((size_t)l * 16 + e) * DM * 512;
        tr_item8(src, 512, kb * 64, 128 * q + (within & 127) + n, (unsigned char*)W + W_GU + (size_t)e * DM * DM + (size_t)r0 * DM + kb * 64, DM, scr, F.lane); return; } j -= IT_GU;
    { const int e = j / 256, jj = j % 256, g = jj / 8, kb = jj % 8;
        tr_item8(a.in[22] + ((size_t)l * 16 + e) * 512 * DM, DM, kb * 64, g * 32 + n, (unsigned char*)W + W_D + (size_t)(e >> 1) * DM * DM + (size_t)(g * 32) * DM + (e & 1) * 512 + kb * 64, DM, scr, F.lane); }
}
__device__ __forceinline__ void ln_load(const Frame& F, const float* xrow, f32x4 (&v)[4]) {
    const GAS f32x4* xr = (const GAS f32x4*)xrow + F.lane;
#pragma unroll
    for (int j = 0; j < 4; ++j) v[j] = xr[64 * j];
}
struct LnGB { f32x4 g[4], b[4]; };
__device__ __forceinline__ void ln_gb_load(const Frame& F, const float* g, const float* b, LnGB& gb) {
#pragma unroll
    for (int j = 0; j < 4; ++j) { gb.g[j] = ((const GAS f32x4*)g)[F.lane + 64 * j]; gb.b[j] = ((const GAS f32x4*)b)[F.lane + 64 * j]; }
}
__device__ __forceinline__ void ln_load_bf(const Frame& F, const bf16* xrow, f32x4 (&v)[4]) {
    const GAS v2u* xr = (const GAS v2u*)xrow + F.lane;
#pragma unroll
    for (int j = 0; j < 4; ++j) { const v2u w = xr[64 * j]; v[j] = (f32x4){bfl(w.x), bfh(w.x), bfl(w.y), bfh(w.y)}; }
}
__device__ __forceinline__ void ln_row(const Frame& F, const LnGB& gb, float* orow  , bf16* brow  , f32x4 (&v)[4], bool dry = false, unsigned char* frow = nullptr  ) {
    float s = 0.f;
#pragma unroll
    for (int j = 0; j < 4; ++j) s += (v[j].x + v[j].y) + (v[j].z + v[j].w);
    const float mean = wave_sum(s) * (1.f / DM); float s2 = 0.f;
#pragma unroll
    for (int j = 0; j < 4; ++j) { v[j] = v[j] - mean; s2 += (v[j].x * v[j].x + v[j].y * v[j].y) + (v[j].z * v[j].z + v[j].w * v[j].w); }
    const float rstd = 1.f / sqrtf(wave_sum(s2) * (1.f / DM) + LN_EPS);
    GAS f32x4* o4 = (GAS f32x4*)orow + F.lane; GAS v2u* o8 = (GAS v2u*)brow + F.lane; GAS unsigned* o1 = (GAS unsigned*)frow + F.lane;
#pragma unroll
    for (int j = 0; j < 4; ++j) { v[j] = v[j] * rstd * gb.g[j] + gb.b[j]; v2u w; w.x = pk2(v[j].x, v[j].y); w.y = pk2(v[j].z, v[j].w); if (!dry) { if (orow) o4[64 * j] = v[j]; if (brow) o8[64 * j] = w; if (frow) o1[64 * j] = pk4_fp8(v[j].x, v[j].y, v[j].z, v[j].w); } }
}
__device__ __forceinline__ void p0_prologue(const Frame& F_, const Args& a) { Frame F = F_; F.lane = lane_id_(); F.tid = F.wave * 64 + F.lane;
    LAS float* scr = (LAS float*)(F.lds + RING_OFF + F.wave * 16384);
    const int gw = F.vcu * NWAVES + F.wave, NGW = F.G * NWAVES;
    for (int it = gw; it < DEPTH * IT_LAYER; it += NGW) p0_item(F, a, it, scr);
    { LnGB gb; ln_gb_load(F, a.in[1], a.in[2], gb); f32x4 nx[4]; ln_load(F, a.in[0] + (size_t)gw * DM, nx);
      for (int m = gw; m < NTOK; m += NGW) { f32x4 v[4];
#pragma unroll
          for (int j = 0; j < 4; ++j) v[j] = nx[j];
          if (m + NGW < NTOK) ln_load(F, a.in[0] + (size_t)(m + NGW) * DM, nx);
          ln_row(F, gb, nullptr, wsb(F, WS_HB) + (size_t)m * DM, v, false, F.ws + WS_HB8 + (size_t)m * DM); } }
}

#ifndef TO_WGM
#define TO_WGM 8
#endif
struct TileOrder {
    int nM, nN, nwg, G, c;
    __device__ void init(int nM_, int nN_, int G_, int c_) { nM = nM_; nN = nN_; nwg = nM * nN; G = G_; c = c_; }
    __device__ bool tile(int i, int& pm, int& pn) const {
        const long L = (long)i * G + c; if (L >= nwg) return false;
        int wgid = (int)L; { const int q = nwg / 8, r = nwg % 8, xcd = wgid % 8, off = wgid / 8; wgid = (xcd < r ? xcd * (q + 1) : r * (q + 1) + (xcd - r) * q) + off; }
        const int nig = TO_WGM * nN, gid = wgid / nig, fm = gid * TO_WGM, gsz = (nM - fm) < TO_WGM ? (nM - fm) : TO_WGM;
        pm = fm + ((wgid % nig) % gsz); pn = (wgid % nig) / gsz; return true;
    }
};
template <bool F8_> struct SchedAT { static constexpr int NT = 0, KS = 0; TileOrder T; const char* A; const char* B; unsigned map;
    __device__ bool next(int i, pg8::GU& u) const { int pm, pq; if (!T.tile(i, pm, pq)) return false; const int pn = (int)((map >> (4 * pq)) & 15u); constexpr size_t TS = F8_ ? pg8::TSTEP / 2 : pg8::TSTEP;
        u.A = A + (size_t)pm * TS; u.B0 = B + (size_t)pn * TS; u.B1 = u.B0; u.nt = F8_ ? 8 : 16; u.ks = u.nt; u.pm = pm; u.pn = pn; u.rows = nullptr; u.rbase = 0; u.rcnt = 0; u.a0 = 0; u.a1 = 0; return true; } };
template <bool F8_> struct EpiAT { static constexpr bool F8 = F8_; static constexpr bool PERM = true; bf16* P; float* FW; bf16* KIDX;
    __device__ __forceinline__ void operator()(const pg8::f32x4 (&acc)[2][2][4][2], const pg8::GU& u, int wr, int wc, int fr, int fq) {
        const float sc = ((u.pn == 1 || u.pn == 4) ? 0.125f * LOG2E : 1.f) * (F8_ ? 1.f / GATE_WSCALE : 1.f);
        const int row0 = u.pm * 256 + wr * 64 + fr, col0 = u.pn * 256 + wc * 32 + 8 * fq;
#pragma unroll
        for (int ai = 0; ai < 2; ++ai)
#pragma unroll
            for (int m = 0; m < 4; ++m) { const int row = row0 + ai * 128 + m * 16; bf16* rowp = P + (size_t)row * PS + col0;
#pragma unroll
                for (int bj = 0; bj < 2; ++bj) { const pg8::f32x4 v0 = acc[ai][bj][m][0] * sc, v1 = acc[ai][bj][m][1] * sc; v4u w;
                    w.x = pg8::cvt_pk_bf16(v0[0], v0[1]); w.y = pg8::cvt_pk_bf16(v0[2], v0[3]); w.z = pg8::cvt_pk_bf16(v1[0], v1[1]); w.w = pg8::cvt_pk_bf16(v1[2], v1[3]);
                    *(v4u*)(rowp + bj * 128) = w;
                    if (bj == 1 && u.pn == 8 && wc < 2) *(v4u*)(KIDX + (size_t)row * 64 + wc * 32 + 8 * fq) = w;
                    if (bj == 1 && u.pn == 8 && wc == 2 && fq == 0) { *(f32x4*)(FW + (size_t)row * 8) = v0; *(f32x4*)(FW + (size_t)row * 8 + 4) = v1; } } }
    } };
struct SchedC { TileOrder T; const char* HBp; const char* BRp; const char* WGp; const char* WBp; bool collapse;
    __device__ bool next(int i, pg8::GU& u) const { int pm, pd; if (!T.tile(i >> 3, pm, pd)) return false; const int sub = i & 7, n = sub >> 1, isg = sub & 1; const int pm_o = pm, pd_o = pd; if (collapse) { pm &= 7; pd = 0; }
        u.pm = pm; u.pn = pd; u.a0 = n; u.a1 = isg; u.rows = nullptr; u.rbase = 0; u.rcnt = 0;
        if (isg) { u.A = HBp + (size_t)pm * (pg8::TSTEP / 2); u.B0 = WGp + (size_t)(n * 8 + pd) * (pg8::HSTEP / 2); u.nt = 8; }
        else     { u.A = BRp + (size_t)pm * (pg8::TSTEP / 2) + n * 256; u.B0 = WBp + (size_t)pd * (pg8::HSTEP / 2) + n * 256; u.nt = 2; }
        u.B1 = u.B0; u.ks = u.nt; u.pm = pm_o; u.pn = pd_o; return true; } };
struct EpiC { static constexpr bool F8 = false; static constexpr bool PERM = true; bf16* MIX; const float* bgate; bool dry;
    __device__ __forceinline__ void operator()(const pg8::f32x4 (&acc)[2][4][2], pg8::u32x4 (&upk)[2][4], pg8::u32x4 (&sum)[2][4]  , const pg8::GU& u, int wr, int wc, int fr, int fq) {
        const int n = u.a0;
        if (!u.a1) {
#pragma unroll
            for (int ai = 0; ai < 2; ++ai)
#pragma unroll
                for (int m = 0; m < 4; ++m) { const pg8::f32x4 v0 = acc[ai][m][0] * (1.f / (BR_SCALE * GATE_WSCALE)), v1 = acc[ai][m][1] * (1.f / (BR_SCALE * GATE_WSCALE)); v4u w;
                    w.x = pg8::cvt_pk_bf16(v0[0], v0[1]); w.y = pg8::cvt_pk_bf16(v0[2], v0[3]); w.z = pg8::cvt_pk_bf16(v1[0], v1[1]); w.w = pg8::cvt_pk_bf16(v1[2], v1[3]); upk[ai][m] = w; }
        } else {
            const int colt = u.pn * 128 + wc * 32 + 8 * fq; const float* bp = bgate + n * DM + colt; const f32x4 b0 = *(const f32x4*)bp, b1 = *(const f32x4*)(bp + 4);
#pragma unroll
            for (int ai = 0; ai < 2; ++ai)
#pragma unroll
                for (int m = 0; m < 4; ++m) { const v4u uw = upk[ai][m]; const pg8::f32x4 g0 = acc[ai][m][0] * (1.f / GATE_WSCALE) + b0, g1 = acc[ai][m][1] * (1.f / GATE_WSCALE) + b1;
                    pg8::f32x4 r0, r1; r0[0] = sigmoidf_(g0[0]) * bfl(uw.x); r0[1] = sigmoidf_(g0[1]) * bfh(uw.x); r0[2] = sigmoidf_(g0[2]) * bfl(uw.y); r0[3] = sigmoidf_(g0[3]) * bfh(uw.y);
                    r1[0] = sigmoidf_(g1[0]) * bfl(uw.z); r1[1] = sigmoidf_(g1[1]) * bfh(uw.z); r1[2] = sigmoidf_(g1[2]) * bfl(uw.w); r1[3] = sigmoidf_(g1[3]) * bfh(uw.w);
                    if (n > 0) { const v4u pw = sum[ai][m]; r0[0] += bfl(pw.x); r0[1] += bfh(pw.x); r0[2] += bfl(pw.y); r0[3] += bfh(pw.y); r1[0] += bfl(pw.z); r1[1] += bfh(pw.z); r1[2] += bfl(pw.w); r1[3] += bfh(pw.w); }
                    v4u o; o.x = pg8::cvt_pk_bf16(r0[0], r0[1]); o.y = pg8::cvt_pk_bf16(r0[2], r0[3]); o.z = pg8::cvt_pk_bf16(r1[0], r1[1]); o.w = pg8::cvt_pk_bf16(r1[2], r1[3]); sum[ai][m] = o; }
            if (n == 3) { const int row0 = u.pm * 256 + wr * 64 + fr; unsigned char* M8 = (unsigned char*)MIX;
#pragma unroll
                for (int ai = 0; ai < 2; ++ai)
#pragma unroll
                    for (int m = 0; m < 4; ++m) { const v4u pw = sum[ai][m]; v2u o;
                        o.x = pk4_fp8(bfl(pw.x) * MIX_SCALE, bfh(pw.x) * MIX_SCALE, bfl(pw.y) * MIX_SCALE, bfh(pw.y) * MIX_SCALE); o.y = pk4_fp8(bfl(pw.z) * MIX_SCALE, bfh(pw.z) * MIX_SCALE, bfl(pw.w) * MIX_SCALE, bfh(pw.w) * MIX_SCALE);
                        *(v2u*)(M8 + (size_t)(row0 + ai * 128 + m * 16) * DM + colt) = o; } }
        }
    } };
struct SchedC2 { static constexpr int NT = 0, KS = 0; TileOrder T; const char* A; const char* B;
    __device__ bool next(int i, pg8::GU& u) const { int pm, pn; if (!T.tile(i, pm, pn)) return false; u.A = A + (size_t)pm * (pg8::TSTEP / 2); u.B0 = B + (size_t)pn * (pg8::TSTEP / 2); u.B1 = u.B0; u.nt = 8; u.ks = 8; u.pm = pm; u.pn = pn; u.rows = nullptr; u.rbase = 0; u.rcnt = 0; u.a0 = 0; u.a1 = 0; return true; } };
struct EpiRes { static constexpr bool F8 = true; static constexpr bool PERM = false; bf16* V1; const bf16* HB; bool dry;
    __device__ __forceinline__ void operator()(const pg8::f32x4 (&acc)[2][2][4][2], const pg8::GU& u, int wr, int wc, int fr, int fq) {
        const int row0 = u.pm * 256 + wr * 64 + fr, col0 = u.pn * 256 + wc * 32 + 4 * fq;
#pragma unroll
        for (int ai = 0; ai < 2; ++ai)
#pragma unroll
            for (int m = 0; m < 4; ++m) { const size_t ro = (size_t)(row0 + ai * 128 + m * 16) * DM + col0;
#pragma unroll
                for (int bj = 0; bj < 2; ++bj)
#pragma unroll
                    for (int n = 0; n < 2; ++n) { const v2u hw = *(const v2u*)(HB + ro + bj * 128 + n * 16); const f32x4 hv = (f32x4){bfl(hw.x), bfh(hw.x), bfl(hw.y), bfh(hw.y)};
                        const f32x4 r_ = hv * ALPHA + acc[ai][bj][m][n] * (1.f / (MIX_SCALE * GATE_WSCALE)); v2u o; o.x = pk2(r_.x, r_.y); o.y = pk2(r_.z, r_.w); if (!dry) *(v2u*)(V1 + ro + bj * 128 + n * 16) = o; } }
    } };
__device__ __forceinline__ void cls_lookup(const LAS int* tab, int tau, int& c, int& j) {
    int cc = 0;
#pragma unroll 1
    for (int k = 1; k < NCLS; ++k) if (tab[32 + k] <= tau) cc = k;
    c = cc; j = tau - tab[32 + cc];
}
__device__ __forceinline__ void cls_experts(int c, int& ea, int& eb) { const int g = c / 6, p = c % 6; const int i = p < 3 ? 0 : (p < 5 ? 1 : 2); const int jj = p < 3 ? p + 1 : (p < 5 ? p - 1 : 3); ea = g * 4 + i; eb = g * 4 + jj; }
struct SchedD1 { static constexpr int NT = 0, KS = 0; const LAS int* tab; int G, c0; const char* HBp; const char* WGU; const int* list;
    __device__ bool next(int i, pg8::GU& u) const { const int L = i * G + c0; if (L >= tab[57] * 8) return false; const int tau = L >> 3, pn = L & 7; int c, j; cls_lookup(tab, tau, c, j); int ea, eb; cls_experts(c, ea, eb);
        const int e = (pn >> 2) ? eb : ea;
        u.A = HBp; u.B0 = WGU + (size_t)e * DM * DM + (size_t)(pn & 3) * (pg8::TSTEP / 2); u.B1 = u.B0; u.nt = 8; u.ks = 8;     u.rows = list + (size_t)c * NTOK; u.rbase = j * 256; u.rcnt = tab[c];
        u.pm = tau; u.pn = pn; u.a0 = c; u.a1 = j; return true; } };
struct EpiD1 { static constexpr bool F8 = true; static constexpr bool PERM = true; unsigned char* ACT; const float* gwl;
    __device__ __forceinline__ void operator()(const pg8::f32x4 (&acc)[2][2][4][2], const pg8::GU& u, int wr, int wc, int fr, int fq) {
        const int half = u.pn >> 2, col = half * 512 + (u.pn & 3) * 128 + wc * 32 + 8 * fq;
#pragma unroll
        for (int ai = 0; ai < 2; ++ai)
#pragma unroll
            for (int m = 0; m < 4; ++m) { const int r = ai * 128 + wr * 64 + m * 16 + opaque_i(fr), pos = u.rbase + r;
                const float gw = pos < u.rcnt ? gwl[((size_t)u.a0 * NTOK + pos) * 2 + half] * ACT_SCALE : 0.f;
                const pg8::f32x4 g0 = acc[ai][0][m][0] * (1.f / GATE_WSCALE), g1 = acc[ai][0][m][1] * (1.f / GATE_WSCALE), u0 = acc[ai][1][m][0] * (1.f / GATE_WSCALE), u1 = acc[ai][1][m][1] * (1.f / GATE_WSCALE); float r8[8];
#pragma unroll
                for (int k = 0; k < 4; ++k) { r8[k] = g0[k] * sigmoidf_(g0[k]) * u0[k] * gw; r8[4 + k] = g1[k] * sigmoidf_(g1[k]) * u1[k] * gw; }
                v2u o; o.x = pk4_fp8(r8[0], r8[1], r8[2], r8[3]); o.y = pk4_fp8(r8[4], r8[5], r8[6], r8[7]);
                *(v2u*)(ACT + ((size_t)u.pm * 256 + r) * DM + col) = o; asm volatile("" ::: "memory"); }
    } };
struct SchedD2 { static constexpr int NT = 8, KS = 4; const LAS int* tab; int G, c0; const char* ACTp; const char* WD; const int* list;
    __device__ bool next(int i, pg8::GU& u) const { const int L = i * G + c0; if (L >= __builtin_amdgcn_readfirstlane(tab[57]) * 4) return false; const int tau = L >> 2, pn = L & 3; int c, j; cls_lookup(tab, tau, c, j); c = __builtin_amdgcn_readfirstlane(c); j = __builtin_amdgcn_readfirstlane(j); int ea, eb; cls_experts(c, ea, eb);
        u.A = sptr_(ACTp + (size_t)tau * (pg8::TSTEP / 2)); u.B0 = sptr_(WD + (size_t)(ea >> 1) * DM * DM + (ea & 1) * 512 + (size_t)pn * (pg8::TSTEP / 2)); u.B1 = sptr_(WD + (size_t)(eb >> 1) * DM * DM + (eb & 1) * 512 + (size_t)pn * (pg8::TSTEP / 2));
        u.nt = 8; u.ks = 4;     u.rows = list + (size_t)c * NTOK; u.rbase = j * 256; u.rcnt = __builtin_amdgcn_readfirstlane(tab[c]); u.pm = tau; u.pn = pn; u.a0 = c; u.a1 = j; return true; } };
struct EpiD2 { static constexpr bool F8 = true; static constexpr bool PERM = false; bf16* V2; const bf16* HB; bool dry;
    __device__ __forceinline__ void operator()(const pg8::f32x4 (&acc)[2][2][4][2], const pg8::GU& u, int wr, int wc, int fr, int fq) {
        const int col0 = u.pn * 256 + wc * 32 + 4 * fq;
#pragma unroll
        for (int ai = 0; ai < 2; ++ai) { asm volatile("" ::: "memory");
#pragma unroll
            for (int m = 0; m < 4; ++m) { if (m == 2) asm volatile("" ::: "memory"); const int pos = u.rbase + ai * 128 + wr * 64 + m * 16 + opaque_i(fr);
                if (pos < u.rcnt) { const size_t ro = (size_t)u.rows[pos] * DM + col0;
#pragma unroll
                    for (int bj = 0; bj < 2; ++bj)
#pragma unroll
                        for (int n = 0; n < 2; ++n) { const v2u hw = *(const v2u*)(HB + ro + bj * 128 + n * 16); const f32x4 hv = (f32x4){bfl(hw.x), bfh(hw.x), bfl(hw.y), bfh(hw.y)};
                            const f32x4 r_ = hv * ALPHA + acc[ai][bj][m][n] * (1.f / (ACT_SCALE * GATE_WSCALE)); v2u o; o.x = pk2(r_.x, r_.y); o.y = pk2(r_.z, r_.w); if (!dry) *(v2u*)(V2 + ro + bj * 128 + n * 16) = o; } } } }
    } };
typedef float f32x2v __attribute__((ext_vector_type(2)));
__device__ __forceinline__ float log_sigmoid_(float x) { return fminf(x, 0.f) - __builtin_amdgcn_logf(1.f + __builtin_amdgcn_exp2f(-fabsf(x) * LOG2E)) * 0.6931471805599453f; }
__device__ __forceinline__ void fox_cumsum(const Frame& F_, int bh, const float* FW, const float* bfor, float* bias2) { Frame F = F_; F.lane = lane_id_(); F.tid = F.wave * 64 + F.lane;
    const int b = bh >> 2, h = bh & 3; const float bf = bfor[h]; const float* src = FW + ((size_t)b * SEQ + F.lane * 64) * 8 + h; float tot = 0.f;
    for (int i = 0; i < 64; ++i) tot += log_sigmoid_(src[(size_t)i * 8] + bf);
    float inc = tot;
#pragma unroll
    for (int o = 1; o < 64; o <<= 1) { const float t = __int_as_float(shfl_i_(__float_as_int(inc), F.lane - o)); if (F.lane >= o) inc += t; }
    float run = inc - tot; float* dst = bias2 + (size_t)bh * SEQ + F.lane * 64;
    for (int i = 0; i < 64; ++i) { run += log_sigmoid_(src[(size_t)i * 8] + bf); dst[i] = -run * LOG2E; }
}
template <int WIN> __device__ __forceinline__ void pool_frags(bf16x8 (&af)[4], const bf16* src0, int tb) {
    const int nrow = tb + 1 < WIN ? tb + 1 : WIN; const float inv = 1.f / (float)nrow;
#pragma unroll
    for (int ks = 0; ks < 4; ++ks) { const bf16* src = src0 + ks * 16; v4u wv[WIN];
#pragma unroll
        for (int j = 0; j < WIN; ++j) wv[j] = *(const v4u*)(src - (size_t)(j <= tb ? j : 0) * PS);
        float s[8];
#pragma unroll
        for (int k = 0; k < 8; ++k) s[k] = 0.f;
#pragma unroll
        for (int j = 0; j < WIN; ++j) { if (j <= tb) { const v4u w = wv[j];
            s[0] += bfl(w.x); s[1] += bfh(w.x); s[2] += bfl(w.y); s[3] += bfh(w.y); s[4] += bfl(w.z); s[5] += bfh(w.z); s[6] += bfl(w.w); s[7] += bfh(w.w); } }
        const v4u cur = wv[0];
        const float c[8] = {bfl(cur.x), bfh(cur.x), bfl(cur.y), bfh(cur.y), bfl(cur.z), bfh(cur.z), bfl(cur.w), bfh(cur.w)};
        v4u o; o.x = pk2(s[0] * inv - c[0], s[1] * inv - c[1]); o.y = pk2(s[2] * inv - c[2], s[3] * inv - c[3]); o.z = pk2(s[4] * inv - c[4], s[5] * inv - c[5]); o.w = pk2(s[6] * inv - c[6], s[7] * inv - c[7]);
        af[ks] = __builtin_bit_cast(bf16x8, o); }
}
__device__ __forceinline__ void pool_unit(const Frame& F_, int tile, const bf16* P, const float* pw, const float* pscale, bf16* BR) { Frame F = F_; F.lane = lane_id_(); F.tid = F.wave * 64 + F.lane;
    const int g = F.wave & 3, th = F.wave >> 2, r32 = F.lane & 31, hi = F.lane >> 5;
    const int tok = tile * 64 + th * 32 + r32, tb = tok & (SEQ - 1);
    const bf16* src0 = P + (size_t)tok * PS + C_POOL + g * 64 + hi * 8;
    bf16x8 af[4];
    if (g == 0) pool_frags<2>(af, src0, tb); else if (g == 1) pool_frags<4>(af, src0, tb); else if (g == 2) pool_frags<8>(af, src0, tb); else pool_frags<16>(af, src0, tb);
#pragma unroll
    for (int db = 0; db < 2; ++db) { f32x16 acc = {};
#pragma unroll
        for (int ks = 0; ks < 4; ++ks) { const float* wp = pw + ((size_t)g * 64 + ks * 16 + hi * 8) * 64 + db * 32 + r32;
            v4u o; o.x = pk2(wp[0], wp[64]); o.y = pk2(wp[128], wp[192]); o.z = pk2(wp[256], wp[320]); o.w = pk2(wp[384], wp[448]);
            acc = __builtin_amdgcn_mfma_f32_32x32x16_bf16(af[ks], __builtin_bit_cast(bf16x8, o), acc, 0, 0, 0); }
        const int col = g * 64 + db * 32 + r32; const float sc = pscale[col];
#pragma unroll
        for (int r = 0; r < 16; ++r) { const int row = tile * 64 + th * 32 + (r & 3) + 8 * (r >> 2) + 4 * hi; { const float x_ = acc[r] * sc * BR_SCALE; ((unsigned char*)BR)[(size_t)row * DM + col] = (unsigned char)(__builtin_amdgcn_cvt_pk_fp8_f32(x_, x_, 0, false) & 0xff); } } }
}
__device__ __forceinline__ void conv_unit(const Frame& F_, int tile, const bf16* P, const float* dw, const float* cb, const float* lg, const float* lb, bf16* BR) { Frame F = F_; F.lane = lane_id_(); F.tid = F.wave * 64 + F.lane;
    LAS float* hb = (LAS float*)(F.lds + RING_OFF);
    LAS float* yb = hb + 62 * 256;
    const int t0 = tile * 32, tb0 = t0 & (SEQ - 1);
    { v4u av[4], gv[4];
#pragma unroll
      for (int k = 0; k < 4; ++k) { const int e = F.tid + k * NWAVES * 64, rr = e >> 5, c8 = (e & 31) * 8, trel = rr - 30; const bool ok = e < 62 * 32 && tb0 + trel >= 0;
          const bf16* src = P + (size_t)(t0 + (ok ? trel : 0)) * PS + C_CONV + c8; av[k] = *(const v4u*)src; gv[k] = *(const v4u*)(src + 256); }
#pragma unroll
      for (int k = 0; k < 4; ++k) { const int e = F.tid + k * NWAVES * 64, rr = e >> 5, c8 = (e & 31) * 8, trel = rr - 30; const bool ok = tb0 + trel >= 0; const v4u a = av[k], gt = gv[k]; float h[8];
          h[0] = bfl(a.x) * sigmoidf_(bfl(gt.x)); h[1] = bfh(a.x) * sigmoidf_(bfh(gt.x)); h[2] = bfl(a.y) * sigmoidf_(bfl(gt.y)); h[3] = bfh(a.y) * sigmoidf_(bfh(gt.y));
          h[4] = bfl(a.z) * sigmoidf_(bfl(gt.z)); h[5] = bfh(a.z) * sigmoidf_(bfh(gt.z)); h[6] = bfl(a.w) * sigmoidf_(bfl(gt.w)); h[7] = bfh(a.w) * sigmoidf_(bfh(gt.w));
          if (!ok) {
#pragma unroll
              for (int q = 0; q < 8; ++q) h[q] = 0.f; }
          if (e < 62 * 32) { *(LAS f32x4*)(hb + rr * 256 + c8) = (f32x4){h[0], h[1], h[2], h[3]}; *(LAS f32x4*)(hb + rr * 256 + c8 + 4) = (f32x4){h[4], h[5], h[6], h[7]}; } } }
    __syncthreads();
    { const int c = F.tid & 255, hf = F.tid >> 8; float w[31];
#pragma unroll
      for (int j = 0; j < 31; ++j) w[j] = dw[j * 256 + c];
      const float bias = cb[c];
#pragma unroll 1
      for (int q4 = 0; q4 < 4; ++q4) { const int tt = hf * 16 + q4 * 4; float x[34];
#pragma unroll
          for (int j = 0; j < 34; ++j) x[j] = hb[(tt + j) * 256 + c];
#pragma unroll
          for (int o = 0; o < 4; ++o) { float a = bias;
#pragma unroll
              for (int j = 0; j < 31; ++j) a += x[o + j] * w[j];
              yb[(tt + o) * 256 + c] = a; } } }
    __syncthreads();
#pragma unroll 1
    for (int q = 0; q < 4; ++q) { const int tt = F.wave * 4 + q; const f32x4 v = *(const LAS f32x4*)(yb + tt * 256 + F.lane * 4);
        const float mean = wave_sum((v.x + v.y) + (v.z + v.w)) * (1.f / 256.f); const f32x4 d = v - mean;
        const float var = wave_sum((d.x * d.x + d.y * d.y) + (d.z * d.z + d.w * d.w)) * (1.f / 256.f); const float rstd = 1.f / sqrtf(var + LN_EPS);
        const f32x4 gg = *(const f32x4*)(lg + F.lane * 4), bb = *(const f32x4*)(lb + F.lane * 4); const f32x4 y = d * rstd * gg + bb;
        *(unsigned*)((unsigned char*)BR + (size_t)(t0 + tt) * DM + 768 + F.lane * 4) = pk4_fp8(y.x * sigmoidf_(y.x) * BR_SCALE, y.y * sigmoidf_(y.y) * BR_SCALE, y.z * sigmoidf_(y.z) * BR_SCALE, y.w * sigmoidf_(y.w) * BR_SCALE); }
    __syncthreads();
}
__device__ __forceinline__ int key28_(float s) { const int u = (int)__float_as_uint(s); int m = (u & 0x7fffffff) - 0x3B000000; m = m < 0 ? 0 : (m > 0x07FFFFFF ? 0x07FFFFFF : m); return 0x08000000 + (m ^ (u >> 31)); }
__device__ __forceinline__ int key9_(float s) { const int u = (int)__float_as_uint(s); int m = ((u >> 19) & 0xfff) - 0x760; m = m < 0 ? 0 : (m > 255 ? 255 : m); return 256 + (m ^ (u >> 31)); }
__device__ __forceinline__ float key28_lbound(long long kv) {
    if (kv <= 0) return -INFINITY; if (kv > 0x0FFFFFFFll) return INFINITY;
    if (kv > 0x08000000ll) return __uint_as_float((unsigned)(0x3B000000ll + (kv - 0x08000000ll)));
    if (kv == 0x08000000ll) return 0.f;
    return -__uint_as_float((unsigned)(0x3B000000ll + (0x07FFFFFFll - kv)));
}
constexpr int DS_HIST = 0, DS_GT = 65536, DS_EQ = 81920, DS_KT = 98304, DS_SM = LDSCTL_OFF + 1024 - RING_OFF, DS_CAP = 512;
typedef float f32x2p __attribute__((ext_vector_type(2)));
__device__ __forceinline__ float relu_(float x) { const int b = (int)__float_as_uint(x); return __uint_as_float((unsigned)(b > 0 ? b : 0)); }
__device__ __forceinline__ void dsa_ldk(bf16x8 (&kf)[4], const bf16* kp) {
#pragma unroll
    for (int m = 0; m < 4; ++m) kf[m] = *(const bf16x8*)(kp + m * 512);
}
__device__ __forceinline__ void dsa_kfrag(bf16x8 (&kf)[4], const bf16x8 (&raw)[4], LAS unsigned char* kt, int lane) {
    const int rw = lane >> 3, cw = lane & 7, r32 = lane & 31, hi = lane >> 5;
#pragma unroll
    for (int m = 0; m < 4; ++m) *(LAS bf16x8*)(kt + (8 * m + rw) * 128 + ((cw ^ rw) << 4)) = raw[m];
#pragma unroll
    for (int ks = 0; ks < 4; ++ks) kf[ks] = *(const LAS bf16x8*)(kt + r32 * 128 + (((2 * ks + hi) ^ (r32 & 7)) << 4));
}
__device__ __forceinline__ void dsa_scores(const bf16x8 (&qf)[4][4], const bf16x8 (&kf)[4], const float (&w)[4], float (&sc)[16]) {
    f32x16 a[4];
#pragma unroll
    for (int hh = 0; hh < 4; ++hh) { a[hh] = (f32x16){};
#pragma unroll
        for (int ks = 0; ks < 4; ++ks) a[hh] = __builtin_amdgcn_mfma_f32_32x32x16_bf16(kf[ks], qf[hh][ks], a[hh], 0, 0, 0); }
#pragma unroll
    for (int r = 0; r < 16; r += 2) { f32x2p s2 = (f32x2p){relu_(a[0][r]), relu_(a[0][r + 1])} * w[0];
#pragma unroll
        for (int hh = 1; hh < 4; ++hh) s2 = (f32x2p){relu_(a[hh][r]), relu_(a[hh][r + 1])} * w[hh] + s2;
        sc[r] = s2.x + 0.f; sc[r + 1] = s2.y + 0.f; }
}
template <int NB4> __device__ __forceinline__ void hist_scan(const LAS unsigned* h, int K, int lane, int& bin, int& above, int& inbin, int* total = nullptr) {
    unsigned hv[NB4 * 4]; int s = 0;
#pragma unroll
    for (int g = 0; g < NB4; ++g) { const v4u t = *(const LAS v4u*)(h + NB4 * 4 * lane + 4 * g); hv[4 * g] = t.x; hv[4 * g + 1] = t.y; hv[4 * g + 2] = t.z; hv[4 * g + 3] = t.w; s += (int)(t.x + t.y + t.z + t.w); }
    int suf = s;
#pragma unroll
    for (int o = 1; o < 64; o <<= 1) { const int t = shfl_i_(suf, lane + o); if (lane + o < 64) suf += t; }
    if (total) *total = __builtin_amdgcn_readfirstlane(suf);
    const int excl = suf - s; const bool hit = (excl < K) && (K <= suf);
    int b = 0, c = excl, nb = 0; bool done = false;
#pragma unroll
    for (int k = NB4 * 4 - 1; k >= 0; --k) { if (!done) { if (c + (int)hv[k] >= K) { b = k; nb = (int)hv[k]; done = true; } else c += (int)hv[k]; } }
    const unsigned long long m = __ballot(hit); const int src = m ? (int)__builtin_ctzll(m) : 0;
    bin = __builtin_amdgcn_readlane(NB4 * 4 * lane + b, src); above = __builtin_amdgcn_readlane(c, src); inbin = __builtin_amdgcn_readlane(nb, src);
    if (!m) { bin = 0; above = 0; inbin = 0; }
}
#define DSA_ONE_TILE(KF, I, ...) do { const int i = (I); float sc[16]; { bf16x8 kfr[4]; dsa_kfrag(kfr, KF, ktile, F.lane); dsa_scores(qf, kfr, w, sc); } \
        if (i == j) { constexpr bool DIAG = true; __VA_ARGS__ } else { constexpr bool DIAG = false; __VA_ARGS__ } } while (0)
#define DSA_TILE_LOOP_S(STRIDE, ...) do { bf16x8 ka[4], kb[4]; int i0 = F.wave; \
    { const int ia = i0 <= j ? i0 : 0, ib = i0 + (STRIDE) <= j ? i0 + (STRIDE) : ia; dsa_ldk(ka, kbase + (size_t)ia * 32 * 64); dsa_ldk(kb, kbase + (size_t)ib * 32 * 64); } \
    _Pragma("unroll 1") for (; i0 <= j; i0 += 2 * (STRIDE)) { bf16x8 na[4], nb[4]; \
        { const int ia = i0 + 2 * (STRIDE) <= j ? i0 + 2 * (STRIDE) : i0, ib = i0 + 3 * (STRIDE) <= j ? i0 + 3 * (STRIDE) : i0; dsa_ldk(na, kbase + (size_t)ia * 32 * 64); dsa_ldk(nb, kbase + (size_t)ib * 32 * 64); } \
        __builtin_amdgcn_sched_barrier(0); \
        DSA_ONE_TILE(ka, i0, __VA_ARGS__); \
        if (i0 + (STRIDE) <= j) DSA_ONE_TILE(kb, i0 + (STRIDE), __VA_ARGS__); \
        _Pragma("unroll") for (int ks = 0; ks < 4; ++ks) { ka[ks] = na[ks]; kb[ks] = nb[ks]; } } } while (0)
#define DSA_TILE_LOOP(...) DSA_TILE_LOOP_S(NWAVES, __VA_ARGS__)
#define DSA_VALID(r) (!DIAG || ((r) & 3) + 8 * ((r) >> 2) <= qlim)
__device__ __forceinline__ void dsa_mask_unit(const Frame& F_, int b, int j, const bf16* P, const bf16* KIDX, const float* FW, unsigned long long* selw) { Frame F = F_; F.lane = lane_id_(); F.tid = F.wave * 64 + F.lane;
    LAS unsigned* HIST = (LAS unsigned*)(F.lds + RING_OFF + DS_HIST);
    LAS unsigned* GT = (LAS unsigned*)(F.lds + RING_OFF + DS_GT);
    LAS unsigned* EQ = (LAS unsigned*)(F.lds + RING_OFF + DS_EQ);
    LAS int* SM = (LAS int*)(F.lds + RING_OFF + DS_SM); volatile LAS unsigned* PRB = (volatile LAS unsigned*)(F.lds + LDSCTL_OFF + 512);
    PROBE_BEGIN(1);
    const int r32 = F.lane & 31, hi = F.lane >> 5, t0 = j * 32; const size_t brow = (size_t)b * SEQ;
    bf16x8 qf[4][4];
#pragma unroll
    for (int hh = 0; hh < 4; ++hh)
#pragma unroll
        for (int ks = 0; ks < 4; ++ks) qf[hh][ks] = *(const bf16x8*)(P + (brow + t0 + r32) * PS + C_IQ + hh * 64 + ks * 16 + hi * 8);
    float w[4]; { const f32x4 wv = *(const f32x4*)(FW + (brow + t0 + r32) * 8 + 4); w[0] = wv.x; w[1] = wv.y; w[2] = wv.z; w[3] = wv.w; }
    const bf16* kbase = KIDX + brow * 64 + F.lane * 8;
    LAS unsigned char* ktile = F.lds + RING_OFF + DS_KT + F.wave * 4096;
    const int qlim = r32 - 4 * hi;
    LAS unsigned* hrow = HIST + r32 * 512;
#define DSA_ZERO_HIST() do { const unsigned z_ = (unsigned)opaque_i(0); for (int e = F.tid; e < 4096; e += NWAVES * 64) ((LAS v4u*)HIST)[e] = (v4u){z_, z_, z_, z_}; } while (0)
    DSA_ZERO_HIST();
    if (F.tid < 64) SM[128 + F.tid] = 0;
    __syncthreads();
    PROBE_END(1); PROBE_BEGIN(2);
#if REP_PHASE == 41
    { float dummy = 0.f; DSA_TILE_LOOP({ _Pragma("unroll") for (int r = 0; r < 16; ++r) dummy += sc[r]; }); if (dummy == 12345.678f) SM[170] = 1; }
#endif
#if REP_PHASE == 42
    { LAS unsigned* drow = EQ + (r32 & 7) * 512; DSA_TILE_LOOP({ _Pragma("unroll") for (int r = 0; r < 16; ++r) { const int kh = key28_(sc[r]) >> 19; if (DSA_VALID(r)) __hip_atomic_fetch_add(drow + kh, 1u, __ATOMIC_RELAXED, __HIP_MEMORY_SCOPE_WORKGROUP); } }); }
#endif
#if REP_PHASE == 43
    { DSA_ZERO_HIST(); __syncthreads(); for (int q = F.wave * 4; q < F.wave * 4 + 4; ++q) { int bin, above, inbin; hist_scan<2>(HIST + q * 512, 256, F.lane, bin, above, inbin); if (F.lane == 0) SM[171] = bin; } __syncthreads(); __syncthreads(); __syncthreads(); }
#endif
    DSA_TILE_LOOP({ _Pragma("unroll")
        for (int r = 0; r < 16; ++r) { const int kh = key9_(sc[r]); if (DSA_VALID(r)) __hip_atomic_fetch_add(hrow + kh, 1u, __ATOMIC_RELAXED, __HIP_MEMORY_SCOPE_WORKGROUP); } });
    __syncthreads();
    PROBE_END(2); PROBE_BEGIN(3);
#pragma unroll 1
    for (int q = F.wave * 4; q < F.wave * 4 + 4; ++q) { int bin, above, inbin; hist_scan<2>(HIST + q * 512, 256, F.lane, bin, above, inbin);
        if (F.lane == 0) { const int total = t0 + q + 1;
            if (total <= 256) { SM[q] = -1; SM[32 + q] = 0; SM[64 + q] = 0; SM[96 + q] = 0; }
            else { SM[q] = bin; SM[32 + q] = above; SM[64 + q] = inbin; SM[96 + q] = 256 - above; if (inbin > DS_CAP) SM[160] = 1; } } }
    __syncthreads();
    PROBE_END(3); PROBE_BEGIN(4);
    const int myb1 = SM[r32];
    if (SM[160] == 0) {
        const float lge = key28_lbound((long long)myb1 << 19), lgt = key28_lbound(((long long)myb1 + 1) << 19);
        LAS unsigned* lrow = HIST + r32 * DS_CAP;
        DSA_TILE_LOOP({ unsigned gtw = 0u; unsigned cw = 0u; _Pragma("unroll")
            for (int r = 0; r < 16; ++r) { const int bit = (r & 3) + 8 * (r >> 2); const bool valid = DSA_VALID(r);
                if (valid && sc[r] >= lgt) gtw |= 1u << bit; else if (valid && sc[r] >= lge) cw |= 1u << r; }
            if (cw) {
                LAS float* sl = (LAS float*)ktile + F.lane; _Pragma("unroll")
                for (int r = 0; r < 16; ++r) sl[r * 64] = sc[r];
                int slot = (int)__hip_atomic_fetch_add((LAS unsigned*)SM + 128 + r32, (unsigned)__popc(cw), __ATOMIC_RELAXED, __HIP_MEMORY_SCOPE_WORKGROUP);
                while (cw) { const int r = __builtin_ctz(cw); cw &= cw - 1u; const float sv = sl[r * 64]; const int bit = (r & 3) + 8 * (r >> 2);
                    if (slot < DS_CAP) lrow[slot] = ((unsigned)(key28_(sv) & 0x7FFFF) << 12) | (unsigned)(4095 - (i * 32 + bit + 4 * hi)); ++slot; } }
            gtw <<= 4 * hi; gtw |= (unsigned)shfl_i_((int)gtw, F.lane ^ 32);
            if (hi == 0) GT[i * 32 + r32] = gtw; });
        __syncthreads();
        PROBE_END(4); PROBE_BEGIN(5);
#pragma unroll 1
        for (int q = F.wave * 4; q < F.wave * 4 + 4; ++q) { const int n = SM[128 + q] < DS_CAP ? SM[128 + q] : DS_CAP, quota = SM[96 + q]; const LAS unsigned* lq = HIST + q * DS_CAP;
            for (int c0 = 0; c0 < n; c0 += 64) { const int ci = c0 + F.lane; const unsigned e = ci < n ? lq[ci] : 0xffffffffu; int rank = 0;
                int k = 0;
                for (; k + 16 <= n; k += 16) { const v4u c0 = *(const LAS v4u*)(lq + k), c1 = *(const LAS v4u*)(lq + k + 4), c2 = *(const LAS v4u*)(lq + k + 8), c3 = *(const LAS v4u*)(lq + k + 12);
                    rank += (c0.x > e ? 1 : 0) + (c0.y > e ? 1 : 0) + (c0.z > e ? 1 : 0) + (c0.w > e ? 1 : 0) + (c1.x > e ? 1 : 0) + (c1.y > e ? 1 : 0) + (c1.z > e ? 1 : 0) + (c1.w > e ? 1 : 0)
                          + (c2.x > e ? 1 : 0) + (c2.y > e ? 1 : 0) + (c2.z > e ? 1 : 0) + (c2.w > e ? 1 : 0) + (c3.x > e ? 1 : 0) + (c3.y > e ? 1 : 0) + (c3.z > e ? 1 : 0) + (c3.w > e ? 1 : 0); }
                for (; k < n; ++k) rank += (lq[k] > e) ? 1 : 0;
                if (ci < n && rank < quota) { const int idx = 4095 - (int)(e & 4095u); __hip_atomic_fetch_or(GT + (idx >> 5) * 32 + q, 1u << (idx & 31), __ATOMIC_RELAXED, __HIP_MEMORY_SCOPE_WORKGROUP); } } }
        __syncthreads();
    } else {
        DSA_ZERO_HIST();
        __syncthreads();
        DSA_TILE_LOOP({ _Pragma("unroll")
            for (int r = 0; r < 16; ++r) { const int k = key28_(sc[r]); if ((k >> 19) == myb1 && DSA_VALID(r)) __hip_atomic_fetch_add(hrow + ((k >> 11) & 255), 1u, __ATOMIC_RELAXED, __HIP_MEMORY_SCOPE_WORKGROUP); } });
        __syncthreads();
#pragma unroll 1
        for (int q = F.wave * 4; q < F.wave * 4 + 4; ++q) { int bin, above, inbin; const int b1 = SM[q], ab1 = SM[32 + q]; hist_scan<1>(HIST + q * 512, 256 - ab1, F.lane, bin, above, inbin);
            if (F.lane == 0) { if (b1 < 0) { SM[192 + q] = -1; SM[96 + q] = 0; SM[224 + q] = 0; }
                else { const int quota = 256 - (ab1 + above); SM[192 + q] = (b1 << 8) | bin; SM[96 + q] = quota; SM[224 + q] = inbin; if (quota < inbin) SM[161] = 1; } } }
        __syncthreads();
        const int thr = SM[192 + r32]; const bool allacc = SM[96 + r32] >= SM[224 + r32];
        const float lge = key28_lbound((long long)thr << 11), lgt = key28_lbound(((long long)thr + 1) << 11);
        DSA_TILE_LOOP({ unsigned gtw = 0u; unsigned gew = 0u; _Pragma("unroll")
            for (int r = 0; r < 16; ++r) { const int bit = (r & 3) + 8 * (r >> 2); const bool valid = DSA_VALID(r);
                if (valid && sc[r] >= lgt) gtw |= 1u << bit; if (valid && sc[r] >= lge) gew |= 1u << bit; }
            gtw <<= 4 * hi; gew <<= 4 * hi;
            gtw |= (unsigned)shfl_i_((int)gtw, F.lane ^ 32); gew |= (unsigned)shfl_i_((int)gew, F.lane ^ 32);
            unsigned eqw = gew & ~gtw;
            if (allacc) { gtw = gew; eqw = 0u; }
            if (hi == 0) GT[i * 32 + r32] = gtw; else EQ[i * 32 + r32] = eqw; });
        __syncthreads();
        if (SM[161] != 0 && F.tid < 32) { const int q = F.tid; const int quota = SM[96 + q]; if (quota < SM[224 + q]) { int run = 0;
                for (int i = 0; i <= j; ++i) { unsigned e = EQ[i * 32 + q]; if (e) { const int allowed = quota - run; if (allowed <= 0) e = 0u; else { int pc = __popc(e); while (pc > allowed) { e &= ~(0x80000000u >> __clz(e)); --pc; } }
                        run += __popc(e); GT[i * 32 + q] |= e; } } } }
        __syncthreads();
    }
    PROBE_END(5); PROBE_BEGIN(6);
    { const int ntile64 = 4 * (j / 8 + 1); unsigned long long* dst = selw + (size_t)b * 64 * SEQ + t0;
      for (int e = F.tid; e < ntile64 * 32; e += NWAVES * 64) { const int T = e >> 5, q = e & 31; const unsigned lo = (2 * T <= j) ? GT[(2 * T) * 32 + q] : 0u, up = (2 * T + 1 <= j) ? GT[(2 * T + 1) * 32 + q] : 0u;
          dst[(size_t)T * SEQ + q] = ((unsigned long long)up << 32) | lo; } }
    __syncthreads();
    PROBE_END(6);
}
#undef DSA_TILE_LOOP
#undef DSA_ZERO_HIST
#undef DSA_TILE_LOOP_S
#undef DSA_ONE_TILE
#undef DSA_VALID
__device__ __forceinline__ void ln1_router_phase(const Frame& F_, const Args& a, int l, bool dry = false) { Frame F = F_; F.lane = lane_id_(); F.tid = F.wave * 64 + F.lane;
    LAS float* RW = (LAS float*)(F.lds + RING_OFF);
    LAS int* LC = (LAS int*)(F.lds + RING_OFF + 81920);
    LAS int* LTOK = LC + 64;
    LAS int* LCLS = LTOK + 128; LAS int* LPOS = LCLS + 128; LAS float* LGA = (LAS float*)(LPOS + 128); LAS float* LGB = LGA + 128;
    volatile LAS unsigned* PRB = (volatile LAS unsigned*)(F.lds + LDSCTL_OFF + 512);
    PROBE_BEGIN(31);
    const float* rg = a.in[16] + (size_t)l * DM * 4; const float* re = a.in[18] + (size_t)l * DM * 16;
    for (int e = F.tid; e < DM * 4; e += NWAVES * 64) { const int k = e >> 2, c = e & 3, ln = (k & 255) >> 2, kidx = (k >> 8) * 4 + (k & 3); RW[((kidx * 5 + 0) * 64 + ln) * 4 + c] = rg[e]; }
    for (int e = F.tid; e < DM * 16; e += NWAVES * 64) { const int k = e >> 4, c = 4 + (e & 15), ln = (k & 255) >> 2, kidx = (k >> 8) * 4 + (k & 3); RW[((kidx * 5 + (c >> 2)) * 64 + ln) * 4 + (c & 3)] = re[e]; }
    if (F.tid < 64) LC[F.tid] = 0;
    __syncthreads();
    PROBE_END(31); PROBE_BEGIN(32);
    const float* rgb = a.in[17] + l * 4; const float* reb = a.in[19] + l * 16;
    const float* g1 = a.in[14] + (size_t)l * DM; const float* b1 = a.in[15] + (size_t)l * DM;
    int* list = (int*)(F.ws + WS_LIST); float* gwl = (float*)(F.ws + WS_GWL);
    const int rows_per_blk = NTOK / F.G;
    LnGB gb; ln_gb_load(F, g1, b1, gb);
    float rb[20];
#pragma unroll
    for (int c = 0; c < 4; ++c) rb[c] = rgb[c];
#pragma unroll
    for (int c = 0; c < 16; ++c) rb[4 + c] = reb[c];
    const bf16* V1 = wsb(F, WS_R2);
    f32x4 nx[4]; ln_load_bf(F, V1 + (size_t)(F.vcu * rows_per_blk + F.wave) * DM, nx);
    for (int rr = F.wave; rr < rows_per_blk; rr += NWAVES) { const int m = F.vcu * rows_per_blk + rr; f32x4 v[4];
#pragma unroll
        for (int j = 0; j < 4; ++j) v[j] = nx[j];
        if (rr + NWAVES < rows_per_blk) ln_load_bf(F, V1 + (size_t)(m + NWAVES) * DM, nx);
        ln_row(F, gb, nullptr, wsb(F, WS_HB) + (size_t)m * DM, v, dry, F.ws + WS_HB8 + (size_t)m * DM);
        float gl[4] = {0.f, 0.f, 0.f, 0.f};
#pragma unroll
        for (int jj = 0; jj < 4; ++jj)
#pragma unroll
            for (int k = 0; k < 4; ++k) { const f32x4 wv = *(const LAS f32x4*)(RW + (((jj * 4 + k) * 5) * 64 + F.lane) * 4); const float xv = v[jj][k];
                gl[0] += xv * wv.x; gl[1] += xv * wv.y; gl[2] += xv * wv.z; gl[3] += xv * wv.w; }
        int gi = 0; float gm;
#pragma unroll
        for (int c = 0; c < 4; ++c) gl[c] = wave_sum(gl[c]) + rb[c];
        gm = gl[0];
#pragma unroll
        for (int c = 1; c < 4; ++c) if (gl[c] > gm) { gm = gl[c]; gi = c; }
        float gs = 0.f;
#pragma unroll
        for (int c = 0; c < 4; ++c) gs += expf(gl[c] - gm);
        const float pg = 1.f / gs;
        float el[4] = {0.f, 0.f, 0.f, 0.f};
        { const LAS float* wg = RW + ((1 + gi) * 64 + F.lane) * 4;
#pragma unroll
          for (int jj = 0; jj < 4; ++jj)
#pragma unroll
            for (int k = 0; k < 4; ++k) { const f32x4 wv = *(const LAS f32x4*)(wg + ((jj * 4 + k) * 5) * 256); const float xv = v[jj][k];
                el[0] += xv * wv.x; el[1] += xv * wv.y; el[2] += xv * wv.z; el[3] += xv * wv.w; } }
#pragma unroll
        for (int c = 0; c < 4; ++c) { float bsel = rb[4 + c];
#pragma unroll
            for (int g = 1; g < 4; ++g) if (gi == g) bsel = rb[4 + 4 * g + c];
            el[c] = wave_sum(el[c]) + bsel; }
        int i1 = 0; float m1 = el[0];
#pragma unroll
        for (int c = 1; c < 4; ++c) if (el[c] > m1) { m1 = el[c]; i1 = c; }
        int i2 = -1; float m2 = -INFINITY;
#pragma unroll
        for (int c = 0; c < 4; ++c) if (c != i1 && el[c] > m2) { m2 = el[c]; i2 = c; }
        const float e2 = expf(m2 - m1); const float p1 = 1.f / (1.f + e2), p2 = e2 / (1.f + e2);
        const int ia = i1 < i2 ? i1 : i2, ib = i1 < i2 ? i2 : i1; const float ga = pg * (i1 < i2 ? p1 : p2), gb = pg * (i1 < i2 ? p2 : p1);
        const int pidx = ia == 0 ? ib - 1 : (ia == 1 ? ib + 1 : 5); const int cls = gi * 6 + pidx;
        if (F.lane == 0) { const int pos = __hip_atomic_fetch_add(&LC[cls], 1, __ATOMIC_RELAXED, __HIP_MEMORY_SCOPE_WORKGROUP); LTOK[rr] = m; LCLS[rr] = cls; LPOS[rr] = pos; LGA[rr] = ga; LGB[rr] = gb; }
    }
    __syncthreads();
    PROBE_END(32);
    if (dry) return;
    PROBE_BEGIN(33);
    if (F.tid < NCLS) { const int n = LC[F.tid]; LC[32 + F.tid] = n ? (int)atomicAdd((unsigned*)(F.ctl + CW_CNT + (l * NCLS + F.tid) * 64), (unsigned)n) : 0; }
    __syncthreads();
    for (int rr = F.tid; rr < rows_per_blk; rr += NWAVES * 64) { const int cls = LCLS[rr], pos = LC[32 + cls] + LPOS[rr];
        list[(size_t)cls * NTOK + pos] = LTOK[rr]; gwl[((size_t)cls * NTOK + pos) * 2] = LGA[rr]; gwl[((size_t)cls * NTOK + pos) * 2 + 1] = LGB[rr]; }
    __syncthreads();
    PROBE_END(33);
}
__device__ __forceinline__ void ln2_phase(const Frame& F_, const Args& a, int l, bool dry = false) { Frame F = F_; F.lane = lane_id_(); F.tid = F.wave * 64 + F.lane;
    const float* g2 = a.in[23] + (size_t)l * DM; const float* b2 = a.in[24] + (size_t)l * DM; const bf16* V2 = wsb(F, WS_R1); const bool last = (l == DEPTH - 1);
    const int gw = F.vcu * NWAVES + F.wave, NGW = F.G * NWAVES;
    LnGB gb; ln_gb_load(F, g2, b2, gb);
    f32x4 nx[4]; ln_load_bf(F, V2 + (size_t)gw * DM, nx);
    for (int m = gw; m < NTOK; m += NGW) { f32x4 v[4];
#pragma unroll
        for (int j = 0; j < 4; ++j) v[j] = nx[j];
        if (m + NGW < NTOK) ln_load_bf(F, V2 + (size_t)(m + NGW) * DM, nx);
        ln_row(F, gb, last ? F.out + (size_t)m * DM : nullptr, wsb(F, WS_HB) + (size_t)m * DM, v, dry, last ? nullptr : F.ws + WS_HB8 + (size_t)m * DM); }
}
__device__ __forceinline__ void moe_table(const Frame& F, int l, LAS int* tab) {
    const int tid = F.wave * 64 + lane_id_();
    if (tid < NCLS) tab[tid] = (int)__hip_atomic_load(F.ctl + CW_CNT + (l * NCLS + tid) * 64, RLX_AGENT);
    __syncthreads();
    if (tid == 0) { int s = 0; for (int c = 0; c < NCLS; ++c) { tab[32 + c] = s; s += (tab[c] + 255) >> 8; } tab[32 + NCLS] = s; tab[57] = s; }
    __syncthreads();
}
#define NREP(k) (((REP_PHASE) == (k) || ((k) == 4 && ((REP_PHASE) == 60 || (REP_PHASE) == 61))) ? 2 : 1)
#define DRY(k) ((REP_PHASE) == (k) && rep_ == 0 && args.ph_hi != 7777)
#ifndef MK_PER_PHASE
#define MK_PER_PHASE 0
#endif
constexpr int PH_PER_LAYER = 9, N_PHASES = 1 + DEPTH * PH_PER_LAYER;
__global__ void __launch_bounds__(NWAVES * 64, 2) fwd_kernel(Args args) {
    extern __shared__ __attribute__((aligned(16))) unsigned char lds[];
    Frame F0; Frame& F = F0;
    F.lds = (LAS unsigned char*)lds; F.ldsg = lds;
    F.MISC = (volatile LAS unsigned*)(F.lds + MISC_OFF);
    F.wave = __builtin_amdgcn_readfirstlane((int)threadIdx.x >> 6); F.lane = lane_id_(); F.tid = F.wave * 64 + F.lane;
    F.G = gridDim.x; { const int bx = blockIdx.x; F.vcu = (F.G % 8 == 0) ? (bx % 8) * (F.G / 8) + bx / 8 : bx; }
    F.ws = args.ws; F.out = args.out; F.ctl = (gu32*)(args.ws + WS_CTL);
    for (int u = F0.tid; u < (LDS_BYTES - LDSCTL_OFF) / 4; u += NWAVES * 64) ((LAS unsigned*)(F.lds + LDSCTL_OFF))[u] = 0u;
    __syncthreads();
    XcdBarrier bar; bar.bar = (unsigned*)(F.ctl + CW_BAR); bar.x = 0; bar.st = nullptr;
    if (!MK_PER_PHASE) bar = xcd_barrier_post((unsigned*)(F.ctl + CW_BAR), F.MISC + 8);
    const int lo = MK_PER_PHASE ? args.ph_lo : 0, hi = MK_PER_PHASE ? args.ph_hi : N_PHASES;
#define IN(k) (lo <= (k) && (k) < hi)
#ifndef PH_ONLY
#define PH_ONLY -1
#endif
#define EN(k) (PH_ONLY < 0 || PH_ONLY == (k))
#define SEAM(k) do { if (IN(k) && IN((k) + 1)) { PROBE_BEGIN(20); xcd_barrier(bar, F0.wave); PROBE_END(20); } } while (0)
    volatile LAS unsigned* PRB = (volatile LAS unsigned*)(F0.lds + LDSCTL_OFF + 512);
    LAS int* TAB = (LAS int*)(F.lds + LDSCTL_OFF + 64);
    bf16* const HB = wsb(F, WS_HB); bf16* const P = wsb(F, WS_R1); bf16* const MIX = wsb(F, WS_R1); bf16* const BR = wsb(F, WS_R2); bf16* const ACT = wsb(F, WS_R2);
    float* const FW = (float*)(F.ws + WS_FW); float* const BIAS2 = (float*)(F.ws + WS_BIAS2); unsigned long long* const SELW = (unsigned long long*)(F.ws + WS_SELW);

#define FRESH(Fn) Frame Fn = F0; Fn.vcu = opaque_s(F0.vcu); Fn.wave = opaque_s(F0.wave); Fn.lane = lane_id_(); Fn.tid = Fn.wave * 64 + Fn.lane
    for (int rep_ = 0; rep_ < ((REP_PHASE) == 10 ? 2 : 1); ++rep_) if (EN(0) && IN(0)) { FRESH(Fp); p0_prologue(Fp, args); }
    SEAM(0);
#pragma unroll 1
    for (int l0 = 0; l0 < DEPTH; ++l0) {
        const int pb = 1 + PH_PER_LAYER * l0;
#define l opaque_s(l0)
#define W (wsb(F, WS_W + (size_t)l * W_LAYER))
        for (int rep_ = 0; rep_ < NREP(1); ++rep_) if (EN(1) && IN(pb)) {
            constexpr unsigned M8 = A_F8_TILES; unsigned map8 = 0, map16 = 0; int n8 = 0, n16 = 0;
            for (int q = 0; q < 9; ++q) { if ((M8 >> q) & 1) { map8 |= (unsigned)q << (4 * n8); ++n8; } else { map16 |= (unsigned)q << (4 * n16); ++n16; } }
            const int bx_ = opaque_s((int)blockIdx.x);
            if (n8 > 0) { SchedAT<true> S; S.T.init(NTOK / 256, n8, F.G, bx_); S.A = (const char*)(F.ws + WS_HB8); S.B = (const char*)W + W_SM8; S.map = map8;
                EpiAT<true> E{P, FW, wsb(F, WS_KIDX)}; pg8::gemm_phase<EpiAT<true>, SchedAT<true>, false>(F.lds + RING_OFF, (LAS unsigned*)(F.lds + LDSCTL_OFF + 1024), F0.wave, S, E); }
            if (n16 > 0) { SchedAT<false> S; S.T.init(NTOK / 256, n16, F.G, (bx_ + F.G - ((NTOK / 256) * n8) % F.G) % F.G);
                S.A = (const char*)HB; S.B = (const char*)(W + W_SM / 2); S.map = map16;
                EpiAT<false> E{P, FW, wsb(F, WS_KIDX)}; pg8::gemm_phase<EpiAT<false>, SchedAT<false>, false>(F.lds + RING_OFF, (LAS unsigned*)(F.lds + LDSCTL_OFF + 1024), F0.wave, S, E); } }
        SEAM(pb);
        for (int rep_ = 0; rep_ < NREP(2); ++rep_) if (EN(2) && IN(pb + 1)) { FRESH(Fp);
#ifndef NO_CUMSUM
            if (Fp.vcu < 32 && Fp.wave == 0) fox_cumsum(Fp, Fp.vcu, FW, args.in[4] + l * 4, BIAS2);
#endif
#ifndef NO_POOL
            for (int rp_ = 0; rp_ < ((REP_PHASE) == 21 ? 2 : 1); ++rp_) for (int k = 0; k < 2; ++k) pool_unit(Fp, Fp.vcu * 2 + k, P, args.in[6] + (size_t)l * 4 * 64 * 64, args.in[7] + (size_t)l * 256, BR);
#endif
#ifndef NO_CONV
            for (int rp_ = 0; rp_ < ((REP_PHASE) == 22 ? 2 : 1); ++rp_) for (int k = 0; k < 4; ++k) conv_unit(Fp, Fp.vcu * 4 + k, P, args.in[8] + (size_t)l * 31 * 256, args.in[9] + (size_t)l * 256, args.in[10] + (size_t)l * 256, args.in[11] + (size_t)l * 256, BR);
#endif
#ifndef NO_DSA
            { const int b = Fp.vcu >> 5, s = Fp.vcu & 31;
#pragma unroll 1
              for (int k = 0; k < ((REP_PHASE) == 23 ? 8 : 4); ++k) { const int j = (k & 3) == 0 ? 127 - s : ((k & 3) == 1 ? 64 + s : ((k & 3) == 2 ? 63 - s : s)); dsa_mask_unit(Fp, b, j, P, wsb(F, WS_KIDX), FW, SELW); } }
#endif
        }
        SEAM(pb + 1);
        for (int rep_ = 0; rep_ < NREP(3); ++rep_) if (EN(3) && IN(pb + 2)) { const int vc_ = opaque_s(F0.vcu); const int sg = vc_ >> 3, s = vc_ & 7, b = sg >> 2, h = sg & 3; const size_t rb = (size_t)b * SEQ;
            const attn_body::bf16* Pb = (const attn_body::bf16*)P + rb * PS; unsigned char* Ob = (unsigned char*)BR + rb * DM;
#pragma unroll 1
            for (int k = 0; k < ((REP_PHASE) == 31 ? 4 : 2); ++k) { const int qb = (k & 1) == 0 ? 15 - s : s;
                attn_body::attn_unit<24, false>(qb * 256, Pb + C_FQ + h * 64, Pb + C_FK + h * 64, Pb + C_FV + h * 64, (attn_body::bf16*)(Ob + 256 + h * 64), BIAS2 + (size_t)(b * 4 + h) * SEQ, 0.f, nullptr, (char*)lds + RING_OFF, F0.wave); }
            const float slope2 = exp2f(-2.f * (float)(h + 1)) * LOG2E;
#pragma unroll 1
            for (int k = 0; k < ((REP_PHASE) == 32 ? 4 : 2); ++k) { const int qb = (k & 1) == 0 ? 15 - s : s;
                attn_body::attn_unit<24, true>(qb * 256, Pb + C_DQ + h * 64, Pb + C_DK, Pb + C_DV, (attn_body::bf16*)(Ob + 512 + h * 64), nullptr, slope2, SELW + (size_t)b * 64 * SEQ, (char*)lds + RING_OFF, F0.wave); }
        }
        SEAM(pb + 2);
        for (int rep_ = 0; rep_ < NREP(4); ++rep_) if (EN(4) && IN(pb + 3)) { SchedC S; S.T.init(NTOK / 256, DM / 128, F.G, opaque_s((int)blockIdx.x)); S.HBp = (const char*)(F.ws + WS_HB8); S.BRp = (const char*)BR; S.WGp = (const char*)(W + W_GT / 2); S.WBp = (const char*)(W + W_BR / 2); S.collapse = ((REP_PHASE) == 61 && rep_ == 0 && args.ph_hi != 7777);
            EpiC E; E.dry = (((REP_PHASE) == 60 || (REP_PHASE) == 61) && rep_ == 0 && args.ph_hi != 7777); E.MIX = MIX; E.bgate = args.in[5] + (size_t)l * 4 * DM; pg8::gemm_phase_c8<EpiC, SchedC>(F.lds + RING_OFF, F0.wave, S, E); }
        SEAM(pb + 3);
        for (int rep_ = 0; rep_ < NREP(5); ++rep_) if (EN(5) && IN(pb + 4)) { SchedC2 S; S.T.init(NTOK / 256, DM / 256, F.G, opaque_s((int)blockIdx.x)); S.A = (const char*)MIX; S.B = (const char*)(W + W_OUT / 2);
            EpiRes E{BR  , HB, DRY(5)}; pg8::gemm_phase<EpiRes, SchedC2, false>(F.lds + RING_OFF, (LAS unsigned*)(F.lds + LDSCTL_OFF + 1024), F0.wave, S, E); }
        SEAM(pb + 4);
        for (int rep_ = 0; rep_ < NREP(6); ++rep_) if (EN(6) && IN(pb + 5)) { FRESH(Fp); PROBE_BEGIN(21); ln1_router_phase(Fp, args, l, DRY(6)); PROBE_END(21); }
        SEAM(pb + 5);
        for (int rep_ = 0; rep_ < NREP(7); ++rep_) if (EN(7) && IN(pb + 6)) { moe_table(F, l, TAB);
            SchedD1 S{TAB, F.G, opaque_s((int)blockIdx.x), (const char*)(F.ws + WS_HB8), (const char*)(W + W_GU / 2), (const int*)(F.ws + WS_LIST)};
            EpiD1 E{(unsigned char*)ACT, (const float*)(F.ws + WS_GWL)}; pg8::gemm_phase<EpiD1, SchedD1, true>(F.lds + RING_OFF, (LAS unsigned*)(F.lds + LDSCTL_OFF + 1024), F0.wave, S, E); }
        SEAM(pb + 6);
        for (int rep_ = 0; rep_ < NREP(8); ++rep_) if (EN(8) && IN(pb + 7)) { moe_table(F, l, TAB);
            SchedD2 S{TAB, F.G, opaque_s((int)blockIdx.x), (const char*)ACT, (const char*)(W + W_D / 2), (const int*)(F.ws + WS_LIST)};
            EpiD2 E{wsb(F, WS_R1), HB, DRY(8)}; pg8::gemm_phase<EpiD2, SchedD2, false>(F.lds + RING_OFF, (LAS unsigned*)(F.lds + LDSCTL_OFF + 1024), F0.wave, S, E); }
        SEAM(pb + 7);
        for (int rep_ = 0; rep_ < NREP(9); ++rep_) if (EN(9) && IN(pb + 8)) { FRESH(Fp); PROBE_BEGIN(22); ln2_phase(Fp, args, l, DRY(9)); PROBE_END(22); }
        SEAM(pb + 8);
#undef l
#undef W
    }
#undef IN
#undef SEAM
    if ((REP_PHASE) >= 100 && blockIdx.x == 0 && F0.wave == 0 && lane_id_() == 0) { volatile LAS unsigned* PRB = (volatile LAS unsigned*)(F0.lds + LDSCTL_OFF + 512); const unsigned long long a_ = (((unsigned long long)PRB[1]) << 32) | PRB[0];
        const unsigned long long t0_ = __builtin_amdgcn_s_memrealtime(); while (__builtin_amdgcn_s_memrealtime() - t0_ < a_) __builtin_amdgcn_s_sleep(8); }
}

extern "C" void kernel_launch(void* const* d_in, const int* in_sizes, int n_in, void* d_out, int out_size, void* d_ws, size_t ws_size, hipStream_t stream) {
    static int grid = 0;
    if (grid == 0) {
        if (n_in != 25 || in_sizes[0] != NTOK * DM || out_size != NTOK * DM || ws_size < WS_END) { fprintf(stderr, "kernel_launch: unexpected shapes (n_in %d, in0 %d, out %d, ws %zu); nothing launched\n", n_in, n_in > 0 ? in_sizes[0] : -1, out_size, ws_size); grid = -1; return; }
        int dev = 0, cus = 0, per_cu = 0;
        if (hipGetDevice(&dev) != hipSuccess || hipDeviceGetAttribute(&cus, hipDeviceAttributeMultiprocessorCount, dev) != hipSuccess) { grid = -1; return; }
        if (hipFuncSetAttribute((const void*)fwd_kernel, hipFuncAttributeMaxDynamicSharedMemorySize, LDS_BYTES) != hipSuccess) { fprintf(stderr, "kernel_launch: hipFuncSetAttribute failed\n"); grid = -1; return; }
        if (hipOccupancyMaxActiveBlocksPerMultiprocessor(&per_cu, (const void*)fwd_kernel, NWAVES * 64, LDS_BYTES) != hipSuccess || per_cu < 1) fprintf(stderr, "kernel_launch: occupancy query reports %d\n", per_cu);
        (void)hipGetLastError();
        grid = cus;
        if (grid != 256) { fprintf(stderr, "kernel_launch: built for 256 CUs, device has %d; nothing launched\n", cus); grid = -1; return; }
    }
    if (grid < 0) return;
    if (hipMemsetAsync((char*)d_ws + WS_CTL, 0, CTL_ZERO_BYTES, stream) != hipSuccess) return;
    Args a{};
    for (int i = 0; i < 25; ++i) a.in[i] = (const float*)d_in[i];
    a.out = (float*)d_out; a.ws = (unsigned char*)d_ws;
#if MK_PER_PHASE
    for (int p = 0; p < N_PHASES; ++p) { a.ph_lo = p; a.ph_hi = p + 1; hipLaunchKernelGGL(fwd_kernel, dim3(grid), dim3(NWAVES * 64), LDS_BYTES, stream, a); }
#else
    a.ph_lo = 0; a.ph_hi = N_PHASES;
    hipLaunchKernelGGL(fwd_kernel, dim3(grid), dim3(NWAVES * 64), LDS_BYTES, stream, a);
#endif
}
```

```cpp
#include <hip/hip_runtime.h>
#include <hip/hip_bf16.h>
#include <cstdio>
#include <cstdint>
#include <cmath>

#ifndef REP_PHASE
#define REP_PHASE 0
#endif
#define PROBE_BEGIN(id) do { if ((REP_PHASE) == 100 + (id) && blockIdx.x == 0) { __syncthreads(); if (F.wave == 0 && lane_id_() == 0) { const unsigned long long t_ = __builtin_amdgcn_s_memrealtime(); PRB[2] = (unsigned)t_; PRB[3] = (unsigned)(t_ >> 32); } } } while (0)
#define PROBE_END(id) do { if ((REP_PHASE) == 100 + (id) && blockIdx.x == 0) { __syncthreads(); if (F.wave == 0 && lane_id_() == 0) { const unsigned long long t_ = __builtin_amdgcn_s_memrealtime() - (((unsigned long long)PRB[3] << 32) | PRB[2]); const unsigned long long a_ = ((((unsigned long long)PRB[1]) << 32) | PRB[0]) + t_; PRB[0] = (unsigned)a_; PRB[1] = (unsigned)(a_ >> 32); } } } while (0)
constexpr int BATCH = 8, SEQ = 4096, DM = 1024, NTOK = BATCH * SEQ, DEPTH = 2;
constexpr int P_TOTAL = 6344, PS = 2304;
constexpr int C_POOL = 0, C_FQ = 256, C_FK = 512, C_FV = 768, C_DQ = 1024, C_IQ = 1280, C_CONV = 1536, C_DK = 2048, C_DV = 2112, C_IK = 2176, C_FF = 2240, C_IW = 2244;
constexpr float LN_EPS = 1e-5f;
constexpr float ALPHA = 1.4142135623730951f;
constexpr float LOG2E = 1.4426950408889634f;
constexpr int NWAVES = 8;
constexpr int NCLS = 24;
constexpr int MAXTILES = NTOK / 256 + NCLS;

constexpr size_t MiB = 1u << 20;
constexpr size_t WS_CTL = 0, CTL_ZERO_BYTES = 1 * MiB;
constexpr size_t WS_FW = 1 * MiB;
constexpr size_t WS_BIAS2 = 2 * MiB;
constexpr size_t WS_LIST = 3 * MiB;
constexpr size_t WS_GWL = 6 * MiB;
constexpr size_t WS_SELW = 12 * MiB;
constexpr size_t WS_HB8 = 28 * MiB;
constexpr size_t WS_W = 60 * MiB;
constexpr size_t W_SM = 0, W_GT = 4718592, W_BR = W_GT + 8 * MiB, W_OUT = W_BR + 2 * MiB, W_GU = W_OUT + 2 * MiB, W_D = W_GU + 32 * MiB, W_LAYER = W_D + 16 * MiB;
constexpr size_t WS_HB = 190 * MiB;
constexpr size_t WS_R1 = 254 * MiB;
constexpr size_t WS_R2 = 398 * MiB;
constexpr size_t WS_KIDX = 474 * MiB;
constexpr size_t WS_DK0 = 430 * MiB, WS_DK1 = 478 * MiB;
constexpr size_t WS_END = 498 * MiB;
static_assert(WS_W + 2 * W_LAYER <= WS_HB && WS_R1 + (size_t)NTOK * PS * 2 <= WS_R2 && WS_R2 + (size_t)MAXTILES * 256 * DM * 2 <= WS_END, "d_ws map");
constexpr int CW_BAR = 4096;
constexpr int CW_SEAMC = 8192;
constexpr int CW_CNT = 16384;

constexpr int RING_OFF = 0, RING_BYTES = 131072;
constexpr int LDSCTL_OFF = RING_BYTES, MISC_OFF = LDSCTL_OFF + 320;
constexpr int LDS_BYTES = 147456;

#define GAS __attribute__((address_space(1)))
#define LAS __attribute__((address_space(3)))
typedef unsigned short bf16;
typedef unsigned v4u __attribute__((ext_vector_type(4)));
typedef unsigned v2u __attribute__((ext_vector_type(2)));
typedef float f32x4 __attribute__((ext_vector_type(4)));
typedef float f32x16 __attribute__((ext_vector_type(16)));
typedef short bf16x8 __attribute__((ext_vector_type(8)));
typedef GAS unsigned gu32;
#define RLX_AGENT __ATOMIC_RELAXED, __HIP_MEMORY_SCOPE_AGENT
#define LDS_WAIT() asm volatile("s_waitcnt lgkmcnt(0)" ::: "memory")
#define VM_WAIT() asm volatile("s_waitcnt vmcnt(0)" ::: "memory")
__device__ __forceinline__ int opaque_i(int x) { asm volatile("" : "+v"(x)); return x; }
__device__ __forceinline__ int lane_id_() { int x; asm volatile("v_mbcnt_lo_u32_b32 %0, -1, 0\n\tv_mbcnt_hi_u32_b32 %0, -1, %0" : "=v"(x)); return x; }
__device__ __forceinline__ float zero_() { int z = 0; asm volatile("" : "+v"(z)); return __builtin_bit_cast(float, z); }
__device__ __forceinline__ const char* sptr_(const char* p) { const unsigned long long v = (unsigned long long)p; const unsigned lo = (unsigned)__builtin_amdgcn_readfirstlane((int)(unsigned)v), hi = (unsigned)__builtin_amdgcn_readfirstlane((int)(unsigned)(v >> 32)); return (const char*)(((unsigned long long)hi << 32) | lo); }
__device__ __forceinline__ int shfl_i_(int v, int srclane) { return __builtin_amdgcn_ds_bpermute(srclane << 2, v); }
__device__ __forceinline__ int opaque_s(int x) { asm volatile("" : "+s"(x)); return x; }
__device__ __forceinline__ unsigned f2bf(float f) { unsigned u = __builtin_bit_cast(unsigned, f); return (u + 0x7fffu + ((u >> 16) & 1u)) >> 16; }
__device__ __forceinline__ unsigned pk2(float lo, float hi) { return f2bf(lo) | (f2bf(hi) << 16); }
__device__ __forceinline__ unsigned pk4_fp8(float a, float b, float c, float d) { int r = __builtin_amdgcn_cvt_pk_fp8_f32(a, b, 0, false); r = __builtin_amdgcn_cvt_pk_fp8_f32(c, d, r, true); return (unsigned)r; }
__device__ __forceinline__ float bfl(unsigned w) { return __uint_as_float(w << 16); }
__device__ __forceinline__ float bfh(unsigned w) { return __uint_as_float(w & 0xffff0000u); }
__device__ __forceinline__ float bf1(bf16 h) { return __uint_as_float((unsigned)h << 16); }
__device__ __forceinline__ float sigmoidf_(float x) { return __builtin_amdgcn_rcpf(1.f + __builtin_amdgcn_exp2f(-x * LOG2E)); }

#define XB_TMO      128
#define XB_XCNT(j)  (256  + 64 * (j))
#define XB_XSUB(j)  (1280 + 64 * (j))
#define XB_XGEN(j)  (2304 + 64 * (j))
#define XB_TOP      3328
#define XB_TOPGEN   3392
#define XCD_BAR_WORDS 3456
#define XB_SPIN_CAP (1u << 18)
__device__ __forceinline__ unsigned xb_ld(unsigned* p)              { return __hip_atomic_load(p, __ATOMIC_RELAXED, __HIP_MEMORY_SCOPE_AGENT); }
__device__ __forceinline__ unsigned xb_add(unsigned* p, unsigned v) { return __hip_atomic_fetch_add(p, v, __ATOMIC_RELAXED, __HIP_MEMORY_SCOPE_AGENT); }
__device__ __forceinline__ unsigned xb_xcc_id() { return (unsigned)__builtin_amdgcn_s_getreg((3 << 11) | 20) & 0xFu; }
#define XB_SPIN(cond, bar) do { unsigned _sp = 0; while (cond) { __builtin_amdgcn_s_sleep(1); \
    if ((++_sp & 255u) == 0u) { if (xb_ld(&(bar)[XB_TMO])) break; if (_sp > XB_SPIN_CAP) { atomicAdd(&(bar)[XB_TMO], 1u); break; } } } } while (0)
struct XcdBarrier { unsigned* bar; unsigned x; volatile LAS unsigned* st; };
__device__ __forceinline__ XcdBarrier xcd_barrier_post(unsigned* bar, volatile LAS unsigned* st) {
    XcdBarrier b; b.bar = bar; b.x = xb_xcc_id(); b.st = st;
    if (threadIdx.x == 0) (void)xb_add(&bar[XB_XCNT(b.x)], 1u);
    return b;
}
__device__ __forceinline__ void xcd_barrier_complete(unsigned* bar, unsigned x, unsigned& nloc, unsigned& nx) {
    const unsigned G = gridDim.x * gridDim.y * gridDim.z;
    unsigned sum, cnt, mine, sp = 0u;
    for (;;) {
        sum = 0u; cnt = 0u; mine = 0u;
#pragma unroll
        for (unsigned j = 0; j < 16; ++j) { const unsigned c = xb_ld(&bar[XB_XCNT(j)]); sum += c; cnt += (c > 0u) ? 1u : 0u; mine = (j == x) ? c : mine; }
        if (sum == G) break;
        __builtin_amdgcn_s_sleep(1);
        if ((++sp & 255u) == 0u) { if (xb_ld(&bar[XB_TMO])) break; if (sp > XB_SPIN_CAP) { atomicAdd(&bar[XB_TMO], 1u); break; } }
    }
    nloc = mine > 0u ? mine : 1u; nx = cnt > 0u ? cnt : 1u;
}
__device__ __forceinline__ void xcd_barrier(const XcdBarrier& b, int wave) {
    asm volatile("s_waitcnt vmcnt(0)" ::: "memory");
    __syncthreads();
    if (wave == 0 && lane_id_() == 0) {
        unsigned* bar = b.bar; const unsigned bx = (unsigned)opaque_s((int)xb_xcc_id());
        __builtin_amdgcn_s_waitcnt(0);
        unsigned nloc = b.st[0], nx = b.st[1];
        if (nloc == 0u) { xcd_barrier_complete(bar, bx, nloc, nx); b.st[0] = nloc; b.st[1] = nx; }
        const unsigned old = xb_add(&bar[XB_XSUB(bx)], 1u);
        const unsigned gen = old / nloc;
        if (old + 1u == (gen + 1u) * nloc) {
            __builtin_amdgcn_fence(__ATOMIC_RELEASE, "agent");
            asm volatile("s_waitcnt vmcnt(0)" ::: "memory");
            const unsigned og = xb_add(&bar[XB_TOP], 1u);
            const unsigned tg = og / nx;
            if (og + 1u == (tg + 1u) * nx) xb_add(&bar[XB_TOPGEN], 1u);
            else XB_SPIN(xb_ld(&bar[XB_TOPGEN]) == tg, bar);
            __builtin_amdgcn_fence(__ATOMIC_ACQUIRE, "agent");
            xb_add(&bar[XB_XGEN(bx)], 1u);
            asm volatile("s_waitcnt vmcnt(0)" ::: "memory");
        } else {
            XB_SPIN(xb_ld(&bar[XB_XGEN(bx)]) == gen, bar);
            __builtin_amdgcn_fence(__ATOMIC_ACQUIRE, "agent");
            asm volatile("s_waitcnt vmcnt(0)" ::: "memory");
        }
    }
    __syncthreads();
}
namespace pg8 {
#define PG8_LAS __attribute__((address_space(3)))
typedef unsigned short bf16_t;
typedef short bf16x8 __attribute__((ext_vector_type(8)));
typedef float f32x4 __attribute__((ext_vector_type(4)));
typedef float f32x2 __attribute__((ext_vector_type(2)));
typedef unsigned u32x4 __attribute__((ext_vector_type(4)));
typedef unsigned u32x2 __attribute__((ext_vector_type(2)));
constexpr int BM = 256, BK = 64, HALF = 128, HTB = HALF * BK * 2  , STAGE_BYTES = 8 * HTB, NXCD = 8, WGM = 8;
constexpr int LD = 1024;
constexpr size_t ROWB = 2048;
constexpr size_t HSTEP = (size_t)HALF * ROWB;
constexpr size_t TSTEP = 2 * HSTEP;

__host__ __device__ __forceinline__ int lds_byte(int r, int c) { const int st = (r >> 4) * 2 + (c >> 5), rr = r & 15, cc = c & 31, ob = rr * 64 + cc * 2; return st * 1024 + (ob ^ (((ob >> 9) & 1) << 5)); }
__host__ __device__ __forceinline__ void stage_rc(int b, int& R, int& C) { const int st = b / 1024, sb = b % 1024, swz = sb ^ (((sb >> 9) & 1) << 5); R = (st >> 1) * 16 + swz / 64; C = (st & 1) * 32 + (swz % 64) / 2; }
__host__ __device__ __forceinline__ int perm32(int rho) { const int n = rho >> 4, i = rho & 15; return 8 * (i >> 2) + 4 * n + (i & 3); }

struct GU {
    const char* A;
    const char* B0;
    const char* B1;
    int nt, ks;
    const int* rows;
    int rbase, rcnt;
    int pm, pn, a0, a1;
};

__device__ __forceinline__ unsigned cvt_pk_bf16(float lo, float hi) { unsigned r; asm volatile("v_cvt_pk_bf16_f32 %0, %1, %2" : "=v"(r) : "v"(lo), "v"(hi)); return r; }
__device__ __forceinline__ float bf_lo(unsigned w) { return __uint_as_float(w << 16); }
__device__ __forceinline__ float bf_hi(unsigned w) { return __uint_as_float(w & 0xffff0000u); }

__device__ __forceinline__ void glds16_s(const char* sbase, unsigned voff, unsigned lds_dst) { unsigned keep;
    asm volatile("s_mov_b32 %0, m0\n\ts_mov_b32 m0, %3\n\ts_nop 0\n\tglobal_load_lds_dwordx4 %1, %2\n\ts_mov_b32 m0, %0" : "=&s"(keep) : "v"(voff), "s"(sbase), "s"(lds_dst) : "memory"); }
typedef int v8i_t __attribute__((ext_vector_type(8)));
typedef int v4i_t __attribute__((ext_vector_type(4)));
__device__ __forceinline__ v8i_t cat8(bf16x8 lo, bf16x8 hi) { const v4i_t a = __builtin_bit_cast(v4i_t, lo), b = __builtin_bit_cast(v4i_t, hi); return __builtin_shufflevector(a, b, 0, 1, 2, 3, 4, 5, 6, 7); }
template <class Epi, class Sched, bool GATHER>
__device__ __forceinline__ void gemm_phase(PG8_LAS unsigned char* lds, PG8_LAS unsigned* xlds  , const int wid_in  , const Sched& S, Epi& E) {
    const int wid = opaque_s(wid_in), lane = lane_id_(), tid = wid * 64 + lane, wr = wid >> 2, wc = wid & 3, fr = lane & 15, fq = lane >> 4;
    constexpr bool F8 = Epi::F8;
    constexpr int RP = F8 ? 1024 : 2048;
    constexpr size_t HS = (size_t)HALF * RP;
    unsigned voffB[2], vA[2][2];
#pragma unroll
    for (int i = 0; i < 2; ++i) { int R, C; stage_rc(tid * 16 + i * 8192, R, C); const int Rb = Epi::PERM ? ((R & ~31) + perm32(R & 31)) : R;
        voffB[i] = (unsigned)(Rb * RP + C * 2);
        vA[0][i] = (unsigned)(R * RP + C * 2); vA[1][i] = vA[0][i]; }
    const size_t kstep = (size_t)(BK * 2);
    const unsigned ldsw = (unsigned)wid * 1024u;
    const unsigned ldsb = (unsigned)__builtin_amdgcn_readfirstlane((int)((unsigned)(size_t)lds + (unsigned)wid * 1024u));
    const int aoff8 = lds_byte(wr * 64 + fr, 16 * fq), boff8 = lds_byte(wc * 32 + fr, 16 * fq);
    const int aoff = lds_byte(wr * 64 + fr, fq * 8), boff = lds_byte(wc * 32 + fr, fq * 8);
#define PG8_SA(b, h) (((b) * 2 + (h)) * HTB)
#define PG8_SB(b, h) ((4 + (b) * 2 + (h)) * HTB)
#define PG8_STAGE(bufoff, gbase, voff) do { _Pragma("unroll") for (int _i = 0; _i < 2; ++_i) { \
        if constexpr (F8) glds16_s((const char*)(gbase), (voff)[_i], ldsb + (unsigned)((bufoff) + _i * 8192)); \
        else __builtin_amdgcn_global_load_lds((const unsigned*)((const char*)(gbase) + (voff)[_i]), (PG8_LAS unsigned*)(lds + (bufoff) + ldsw + _i * 8192), 16, 0, 0); } } while (0)
#define PG8_STAGEA(bufoff, gbase, h) do { if constexpr (GATHER) { PG8_STAGE(bufoff, gbase, vA[h]); } else { PG8_STAGE(bufoff, (gbase) + (h) * HS, vA[0]); } } while (0)
#define PG8_LDA(dst, b, h) do { _Pragma("unroll") for (int m = 0; m < 4; ++m) _Pragma("unroll") for (int k = 0; k < 2; ++k) dst[m][k] = *(const PG8_LAS bf16x8*)(lds + PG8_SA(b, h) + (F8 ? aoff8 + k * 16 : aoff + k * 1024) + m * 2048); } while (0)
#define PG8_LDB(dst, b, h) do { _Pragma("unroll") for (int n = 0; n < 2; ++n) _Pragma("unroll") for (int k = 0; k < 2; ++k) dst[n][k] = *(const PG8_LAS bf16x8*)(lds + PG8_SB(b, h) + (F8 ? boff8 + k * 16 : boff + k * 1024) + n * 2048); } while (0)
#define PG8_MMA(ai, bj, At, Bt) do { __builtin_amdgcn_s_setprio(1); _Pragma("unroll") for (int m = 0; m < 4; ++m) _Pragma("unroll") for (int n = 0; n < 2; ++n) { \
        if constexpr (F8) acc[ai][bj][m][n] = __builtin_amdgcn_mfma_scale_f32_16x16x128_f8f6f4(cat8(Bt[n][0], Bt[n][1]), cat8(At[m][0], At[m][1]), acc[ai][bj][m][n], 0, 0, 0, 0, 0, 0); \
        else { _Pragma("unroll") for (int k = 0; k < 2; ++k) acc[ai][bj][m][n] = __builtin_amdgcn_mfma_f32_16x16x32_bf16(Bt[n][k], At[m][k], acc[ai][bj][m][n], 0, 0, 0); } } __builtin_amdgcn_s_setprio(0); } while (0)
#define PG8_WAIT_V(n) asm volatile("s_waitcnt vmcnt(" #n ")" ::: "memory")
#define PG8_WAIT_L(n) asm volatile("s_waitcnt lgkmcnt(" #n ")" ::: "memory")
#define PG8_BAR __builtin_amdgcn_s_barrier()
#define PG8_SCHED __builtin_amdgcn_sched_barrier(0)
#define PG8_KS(u) (Sched::NT > 0 ? Sched::KS : (u).ks)
#define PG8_BP(u, tau) ((tau) < PG8_KS(u) ? (u).B0 + (size_t)(tau) * kstep : (u).B1 + (size_t)((tau) - PG8_KS(u)) * kstep)
#define PG8_GATHER_OFFS(dst, u) do { if constexpr (GATHER) { _Pragma("unroll") for (int _h = 0; _h < 2; ++_h) _Pragma("unroll") for (int _i = 0; _i < 2; ++_i) { \
        int _R, _C; stage_rc((wid * 64 + lane_id_()) * 16 + _i * 8192, _R, _C); int _p = (u).rbase + _h * HALF + _R; _p = _p < (u).rcnt ? _p : (u).rcnt - 1; dst[_h][_i] = (unsigned)(u).rows[_p] * (unsigned)RP + (unsigned)_C * 2u; } } } while (0)
    GU cur, nxt; int ui = 0;
    if (!S.next(0, cur)) return;
    f32x4 acc[2][2][4][2];
#pragma unroll
    for (int a = 0; a < 2; ++a)
#pragma unroll
        for (int b = 0; b < 2; ++b)
#pragma unroll
            for (int m = 0; m < 4; ++m)
#pragma unroll
                for (int n = 0; n < 2; ++n) { const float z_ = zero_(); acc[a][b][m][n] = (f32x4){z_, z_, z_, z_}; }
    bf16x8 At[4][2], B0[2][2], B1[2][2];
    PG8_GATHER_OFFS(vA, cur);
    const char* cA = cur.A;
    { const char* b0 = PG8_BP(cur, 0); const char* b1 = PG8_BP(cur, 1);
      PG8_STAGE(PG8_SB(0, 0), b0, voffB); PG8_STAGE(PG8_SB(0, 1), b0 + HS, voffB); PG8_STAGEA(PG8_SA(0, 0), cA, 0); PG8_STAGEA(PG8_SA(0, 1), cA, 1);
      if (wr == 1) PG8_BAR;
      PG8_WAIT_V(2); PG8_BAR;
      PG8_STAGE(PG8_SB(1, 0), b1, voffB); PG8_STAGEA(PG8_SA(1, 0), cA + kstep, 0); PG8_STAGE(PG8_SB(1, 1), b1 + HS, voffB);
      PG8_WAIT_V(6); PG8_BAR; }
    for (;;) {
        const bool has_next = S.next(ui + 1, nxt);
        if (!has_next) nxt = cur;
        if constexpr (GATHER) { unsigned vn[2][2];
#pragma unroll
            for (int h = 0; h < 2; ++h)
#pragma unroll
                for (int i = 0; i < 2; ++i) vn[h][i] = vA[h][i];
            if (has_next) { PG8_GATHER_OFFS(vn, nxt); }
#pragma unroll
            for (int h = 0; h < 2; ++h)
#pragma unroll
                for (int i = 0; i < 2; ++i) xlds[(h * 2 + i) * 512 + tid] = vn[h][i]; }
        const char* nA = nxt.A;
        const int nt = Sched::NT > 0 ? Sched::NT : cur.nt;
#pragma unroll (Sched::NT > 0 ? 2 : 1)
        for (int t = 0; t < nt; t += 2) {
            const bool last = (t == nt - 2);
            const char* a1 = cA + (size_t)(t + 1) * kstep;
            const char* a2 = last ? nA : cA + (size_t)(t + 2) * kstep;
            const char* b2 = last ? PG8_BP(nxt, 0) : PG8_BP(cur, t + 2);
            const char* a3 = a2 + kstep; const char* b3 = b2 + kstep;
            PG8_LDB(B0, 0, 0); PG8_LDB(B1, 0, 1); PG8_SCHED; PG8_LDA(At, 0, 0); PG8_STAGEA(PG8_SA(1, 1), a1, 1);
            if constexpr (GATHER) { if (last) {
#pragma unroll
                for (int h = 0; h < 2; ++h)
#pragma unroll
                    for (int i = 0; i < 2; ++i) vA[h][i] = xlds[(h * 2 + i) * 512 + tid]; } }
            PG8_WAIT_V(8); PG8_WAIT_L(0); PG8_BAR; PG8_MMA(0, 0, At, B0); PG8_MMA(0, 1, At, B1); PG8_BAR; PG8_SCHED;
            PG8_LDA(At, 0, 1); PG8_STAGE(PG8_SB(0, 0), b2, voffB); PG8_STAGE(PG8_SB(0, 1), b2 + HS, voffB); PG8_STAGEA(PG8_SA(0, 0), a2, 0);
            PG8_WAIT_V(8); PG8_WAIT_L(0); PG8_BAR; PG8_MMA(1, 0, At, B0); PG8_MMA(1, 1, At, B1); PG8_BAR; PG8_SCHED;
            PG8_LDB(B0, 1, 0); PG8_LDB(B1, 1, 1); PG8_SCHED; PG8_LDA(At, 1, 0); PG8_STAGEA(PG8_SA(0, 1), a2, 1);
            PG8_WAIT_V(8); PG8_WAIT_L(0); PG8_BAR; PG8_MMA(0, 0, At, B0); PG8_MMA(0, 1, At, B1); PG8_BAR; PG8_SCHED;
            PG8_LDA(At, 1, 1); PG8_STAGE(PG8_SB(1, 0), b3, voffB); PG8_STAGE(PG8_SB(1, 1), b3 + HS, voffB); PG8_STAGEA(PG8_SA(1, 0), a3, 0);
            PG8_WAIT_V(8); PG8_WAIT_L(0); PG8_BAR; PG8_MMA(1, 0, At, B0); PG8_MMA(1, 1, At, B1); PG8_BAR; PG8_SCHED;
        }
        if (wr == 0) PG8_BAR;
        { const int l2_ = lane_id_(); E(acc, cur, wr, wc, l2_ & 15, l2_ >> 4); }
        if (!has_next) break;
#pragma unroll
        for (int a = 0; a < 2; ++a)
#pragma unroll
            for (int b = 0; b < 2; ++b)
#pragma unroll
                for (int m = 0; m < 4; ++m)
#pragma unroll
                    for (int n = 0; n < 2; ++n) { const float z_ = zero_(); acc[a][b][m][n] = (f32x4){z_, z_, z_, z_}; }
        cur = nxt; cA = nA; ++ui;
        if (wr == 1) PG8_BAR;
    }
    PG8_WAIT_V(0);
    PG8_BAR;
#undef PG8_SA
#undef PG8_SB
#undef PG8_STAGE
#undef PG8_STAGEA
#undef PG8_LDA
#undef PG8_LDB
#undef PG8_MMA
#undef PG8_WAIT_V
#undef PG8_WAIT_L
#undef PG8_BAR
#undef PG8_SCHED
#undef PG8_BP
#undef PG8_KS
#undef PG8_GATHER_OFFS
}

template <class Epi, class Sched>
__device__ __forceinline__ void gemm_phase_n128(PG8_LAS unsigned char* lds, const int wid_in, const Sched& S, Epi& E) {
    const int wid = opaque_s(wid_in), lane = lane_id_(), tid = wid * 64 + lane, wr = wid >> 2, wc = wid & 3, fr = lane & 15, fq = lane >> 4;
    unsigned voffB[2], voffA[2];
#pragma unroll
    for (int i = 0; i < 2; ++i) { int R, C; stage_rc(tid * 16 + i * 8192, R, C); const int Rb = (R & ~31) + perm32(R & 31);
        voffB[i] = (unsigned)(Rb * LD + C) * 2u; voffA[i] = (unsigned)(R * LD + C) * 2u; }
    const size_t kstep = (size_t)(BK * 2);
    const unsigned ldsw = (unsigned)wid * 1024u;
    const int aoff = lds_byte(wr * 64 + fr, fq * 8), boff = lds_byte(wc * 32 + fr, fq * 8);
#define PG8_SA(b, h) (((b) * 2 + (h)) * HTB)
#define PG8_SB(b, h) ((4 + (b) * 2 + (h)) * HTB)
#define PG8_STAGE(bufoff, gbase, voff) do { _Pragma("unroll") for (int _i = 0; _i < 2; ++_i) \
        __builtin_amdgcn_global_load_lds((const unsigned*)((const char*)(gbase) + (voff)[_i]), (PG8_LAS unsigned*)(lds + (bufoff) + ldsw + _i * 8192), 16, 0, 0); } while (0)
#define PG8_LDA(dst, b, h) do { _Pragma("unroll") for (int m = 0; m < 4; ++m) _Pragma("unroll") for (int k = 0; k < 2; ++k) dst[m][k] = *(const PG8_LAS bf16x8*)(lds + PG8_SA(b, h) + aoff + m * 2048 + k * 1024); } while (0)
#define PG8_LDB(dst, b, h) do { _Pragma("unroll") for (int n = 0; n < 2; ++n) _Pragma("unroll") for (int k = 0; k < 2; ++k) dst[n][k] = *(const PG8_LAS bf16x8*)(lds + PG8_SB(b, h) + boff + n * 2048 + k * 1024); } while (0)
#define PG8_MMA(ai, At, Bt) do { __builtin_amdgcn_s_setprio(1); _Pragma("unroll") for (int m = 0; m < 4; ++m) _Pragma("unroll") for (int n = 0; n < 2; ++n) _Pragma("unroll") for (int k = 0; k < 2; ++k) \
        acc[ai][m][n] = __builtin_amdgcn_mfma_f32_16x16x32_bf16(Bt[n][k], At[m][k], acc[ai][m][n], 0, 0, 0); __builtin_amdgcn_s_setprio(0); } while (0)
#define PG8_WAIT_V(n) asm volatile("s_waitcnt vmcnt(" #n ")" ::: "memory")
#define PG8_WAIT_L(n) asm volatile("s_waitcnt lgkmcnt(" #n ")" ::: "memory")
#define PG8_BAR __builtin_amdgcn_s_barrier()
#define PG8_SCHED __builtin_amdgcn_sched_barrier(0)
    GU cur, nxt; int ui = 0;
    if (!S.next(0, cur)) return;
    f32x4 acc[2][4][2];
#pragma unroll
    for (int a = 0; a < 2; ++a)
#pragma unroll
        for (int m = 0; m < 4; ++m)
#pragma unroll
            for (int n = 0; n < 2; ++n) { const float z_ = zero_(); acc[a][m][n] = (f32x4){z_, z_, z_, z_}; }
    bf16x8 At[4][2], B0[2][2];
    u32x4 st_u[2][4], st_s[2][4];
    const char* cA = cur.A; const char* cB = cur.B0;
    PG8_STAGE(PG8_SB(0, 0), cB, voffB); PG8_STAGE(PG8_SA(0, 0), cA, voffA); PG8_STAGE(PG8_SA(0, 1), cA + HSTEP, voffA);
    if (wr == 1) PG8_BAR;
    PG8_WAIT_V(2); PG8_BAR;
    PG8_STAGE(PG8_SB(1, 0), cB + kstep, voffB); PG8_STAGE(PG8_SA(1, 0), cA + kstep, voffA);
    PG8_WAIT_V(4); PG8_BAR;
    for (;;) {
        const bool has_next = S.next(ui + 1, nxt);
        if (!has_next) nxt = cur;
        const char* nA = nxt.A; const char* nB = nxt.B0;
        const int nt = cur.nt;
        for (int t = 0; t < nt; t += 2) {
            const bool last = (t == nt - 2);
            const char* a1 = cA + (size_t)(t + 1) * kstep;
            const char* a2 = last ? nA : cA + (size_t)(t + 2) * kstep;
            const char* b2 = last ? nB : cB + (size_t)(t + 2) * kstep;
            const char* a3 = a2 + kstep; const char* b3 = b2 + kstep;
            PG8_LDB(B0, 0, 0); PG8_SCHED; PG8_LDA(At, 0, 0); PG8_STAGE(PG8_SA(1, 1), a1 + HSTEP, voffA);
            PG8_WAIT_V(6); PG8_WAIT_L(0); PG8_BAR; PG8_MMA(0, At, B0); PG8_BAR; PG8_SCHED;
            PG8_LDA(At, 0, 1); PG8_STAGE(PG8_SB(0, 0), b2, voffB); PG8_STAGE(PG8_SA(0, 0), a2, voffA);
            PG8_WAIT_V(6); PG8_WAIT_L(0); PG8_BAR; PG8_MMA(1, At, B0); PG8_BAR; PG8_SCHED;
            PG8_LDB(B0, 1, 0); PG8_SCHED; PG8_LDA(At, 1, 0); PG8_STAGE(PG8_SA(0, 1), a2 + HSTEP, voffA);
            PG8_WAIT_V(6); PG8_WAIT_L(0); PG8_BAR; PG8_MMA(0, At, B0); PG8_BAR; PG8_SCHED;
            PG8_LDA(At, 1, 1); PG8_STAGE(PG8_SB(1, 0), b3, voffB); PG8_STAGE(PG8_SA(1, 0), a3, voffA);
            PG8_WAIT_V(6); PG8_WAIT_L(0); PG8_BAR; PG8_MMA(1, At, B0); PG8_BAR; PG8_SCHED;
        }
        if (wr == 0) PG8_BAR;
        E(acc, st_u, st_s, cur, wr, wc, fr, fq);
        if (!has_next) break;
#pragma unroll
        for (int a = 0; a < 2; ++a)
#pragma unroll
            for (int m = 0; m < 4; ++m)
#pragma unroll
                for (int n = 0; n < 2; ++n) { const float z_ = zero_(); acc[a][m][n] = (f32x4){z_, z_, z_, z_}; }
        cur = nxt; cA = nA; cB = nB; ++ui;
        if (wr == 1) PG8_BAR;
    }
    PG8_WAIT_V(0);
    PG8_BAR;
#undef PG8_SA
#undef PG8_SB
#undef PG8_STAGE
#undef PG8_LDA
#undef PG8_LDB
#undef PG8_MMA
#undef PG8_WAIT_V
#undef PG8_WAIT_L
#undef PG8_BAR
#undef PG8_SCHED
}
template <class Epi, class Sched>
__device__ __forceinline__ void gemm_phase_c8(PG8_LAS unsigned char* lds, const int wid_in, const Sched& S, Epi& E) {
    const int wid = opaque_s(wid_in), lane = lane_id_(), tid = wid * 64 + lane, wr = wid >> 2, wc = wid & 3, fr = lane & 15, fq = lane >> 4;
    unsigned voffB[2], voffA[2];
#pragma unroll
    for (int i = 0; i < 2; ++i) { int R, C; stage_rc(tid * 16 + i * 8192, R, C); const int Rb = (R & ~31) + perm32(R & 31);
        voffB[i] = (unsigned)(Rb * LD + C) * 2u; voffA[i] = (unsigned)(R * LD + C) * 2u; }
    const size_t kstep = (size_t)(BK * 2);
    const unsigned ldsb = (unsigned)__builtin_amdgcn_readfirstlane((int)((unsigned)(size_t)lds + (unsigned)wid * 1024u));
    const int aoff = lds_byte(wr * 64 + fr, fq * 8), boff = lds_byte(wc * 32 + fr, fq * 8);
    const int aoff8 = lds_byte(wr * 64 + fr, 16 * fq), boff8 = lds_byte(wc * 32 + fr, 16 * fq);
#define PG8_SA(b, h) (((b) * 2 + (h)) * HTB)
#define PG8_SB(b, h) ((4 + (b) * 2 + (h)) * HTB)
#define PG8_STAGE(bufoff, gbase, voff) do { _Pragma("unroll") for (int _i = 0; _i < 2; ++_i) glds16_s((const char*)(gbase), (voff)[_i], ldsb + (unsigned)((bufoff) + _i * 8192)); } while (0)
#define PG8_STAGE8(bufoff, gbase, voff) do { _Pragma("unroll") for (int _i = 0; _i < 2; ++_i) { const unsigned _v = ((voff)[_i] + ((voff)[_i] & 2047u)) >> 1; glds16_s((const char*)(gbase), _v, ldsb + (unsigned)((bufoff) + _i * 8192)); } } while (0)
#define PG8_STB(bufoff, gbase, f8) do { if (f8) { PG8_STAGE8(bufoff, gbase, voffB); } else { PG8_STAGE(bufoff, gbase, voffB); } } while (0)
#define PG8_STA(bufoff, gbase, h, f8) do { if (f8) { PG8_STAGE8(bufoff, (gbase) + (h) * (HSTEP / 2), voffA); } else { PG8_STAGE(bufoff, (gbase) + (h) * HSTEP, voffA); } } while (0)
#define PG8_LDA(dst, b, h) do { _Pragma("unroll") for (int m = 0; m < 4; ++m) _Pragma("unroll") for (int k = 0; k < 2; ++k) dst[m][k] = *(const PG8_LAS bf16x8*)(lds + PG8_SA(b, h) + aoff + m * 2048 + k * 1024); } while (0)
#define PG8_LDB(dst, b, h) do { _Pragma("unroll") for (int n = 0; n < 2; ++n) _Pragma("unroll") for (int k = 0; k < 2; ++k) dst[n][k] = *(const PG8_LAS bf16x8*)(lds + PG8_SB(b, h) + boff + n * 2048 + k * 1024); } while (0)
#define PG8_LDA8(dst, b, h) do { _Pragma("unroll") for (int m = 0; m < 4; ++m) _Pragma("unroll") for (int k = 0; k < 2; ++k) dst[m][k] = *(const PG8_LAS bf16x8*)(lds + PG8_SA(b, h) + aoff8 + m * 2048 + k * 16); } while (0)
#define PG8_LDB8(dst, b, h) do { _Pragma("unroll") for (int n = 0; n < 2; ++n) _Pragma("unroll") for (int k = 0; k < 2; ++k) dst[n][k] = *(const PG8_LAS bf16x8*)(lds + PG8_SB(b, h) + boff8 + n * 2048 + k * 16); } while (0)
#define PG8_MMA(ai, At, Bt) do { __builtin_amdgcn_s_setprio(1); _Pragma("unroll") for (int m = 0; m < 4; ++m) _Pragma("unroll") for (int n = 0; n < 2; ++n) _Pragma("unroll") for (int k = 0; k < 2; ++k) \
        acc[ai][m][n] = __builtin_amdgcn_mfma_f32_16x16x32_bf16(Bt[n][k], At[m][k], acc[ai][m][n], 0, 0, 0); __builtin_amdgcn_s_setprio(0); } while (0)
#define PG8_MMA8(ai, At, Bt) do { __builtin_amdgcn_s_setprio(1); _Pragma("unroll") for (int m = 0; m < 4; ++m) _Pragma("unroll") for (int n = 0; n < 2; ++n) \
        acc[ai][m][n] = __builtin_amdgcn_mfma_scale_f32_16x16x128_f8f6f4(cat8(Bt[n][0], Bt[n][1]), cat8(At[m][0], At[m][1]), acc[ai][m][n], 0, 0, 0, 0, 0, 0); __builtin_amdgcn_s_setprio(0); } while (0)
#define PG8_WAIT_V(n) asm volatile("s_waitcnt vmcnt(" #n ")" ::: "memory")
#define PG8_WAIT_L(n) asm volatile("s_waitcnt lgkmcnt(" #n ")" ::: "memory")
#define PG8_BAR __builtin_amdgcn_s_barrier()
#define PG8_SCHED __builtin_amdgcn_sched_barrier(0)
    GU cu, cg, nxt; int ui = 0;
    if (!S.next(0, cu)) return;
    f32x4 acc[2][4][2];
#define PG8_ZACC() do { _Pragma("unroll") for (int a = 0; a < 2; ++a) _Pragma("unroll") for (int m = 0; m < 4; ++m) _Pragma("unroll") for (int n = 0; n < 2; ++n) { const float z_ = zero_(); acc[a][m][n] = (f32x4){z_, z_, z_, z_}; } } while (0)
    PG8_ZACC();
    bf16x8 At[4][2], B0[2][2];
    u32x4 st_u[2][4], st_s[2][4];
    PG8_STB(PG8_SB(0, 0), cu.B0, true); PG8_STA(PG8_SA(0, 0), cu.A, 0, true); PG8_STA(PG8_SA(0, 1), cu.A, 1, true);
    if (wr == 1) PG8_BAR;
    PG8_WAIT_V(2); PG8_BAR;
    PG8_STB(PG8_SB(1, 0), cu.B0 + kstep, true); PG8_STA(PG8_SA(1, 0), cu.A + kstep, 0, true);
    PG8_WAIT_V(4); PG8_BAR;
#define PG8_KLOOP(LDA_, LDB_, MMA_, C8, N8, cA, cB, nA, nB, nt) \
        for (int t = 0; t < (nt); t += 2) { \
            const bool last = (t == (nt) - 2); \
            const char* a1 = (cA) + (size_t)(t + 1) * kstep; \
            const char* a2 = last ? (nA) : (cA) + (size_t)(t + 2) * kstep; \
            const char* b2 = last ? (nB) : (cB) + (size_t)(t + 2) * kstep; \
            const char* a3 = a2 + kstep; const char* b3 = b2 + kstep; \
            LDB_(B0, 0, 0); PG8_SCHED; LDA_(At, 0, 0); PG8_STA(PG8_SA(1, 1), a1, 1, C8); \
            PG8_WAIT_V(6); PG8_WAIT_L(0); PG8_BAR; MMA_(0, At, B0); PG8_BAR; PG8_SCHED; \
            if (last) { LDA_(At, 0, 1); PG8_STB(PG8_SB(0, 0), b2, N8); PG8_STA(PG8_SA(0, 0), a2, 0, N8); } else { LDA_(At, 0, 1); PG8_STB(PG8_SB(0, 0), b2, C8); PG8_STA(PG8_SA(0, 0), a2, 0, C8); } \
            PG8_WAIT_V(6); PG8_WAIT_L(0); PG8_BAR; MMA_(1, At, B0); PG8_BAR; PG8_SCHED; \
            if (last) { LDB_(B0, 1, 0); PG8_SCHED; LDA_(At, 1, 0); PG8_STA(PG8_SA(0, 1), a2, 1, N8); } else { LDB_(B0, 1, 0); PG8_SCHED; LDA_(At, 1, 0); PG8_STA(PG8_SA(0, 1), a2, 1, C8); } \
            PG8_WAIT_V(6); PG8_WAIT_L(0); PG8_BAR; MMA_(0, At, B0); PG8_BAR; PG8_SCHED; \
            if (last) { LDA_(At, 1, 1); PG8_STB(PG8_SB(1, 0), b3, N8); PG8_STA(PG8_SA(1, 0), a3, 0, N8); } else { LDA_(At, 1, 1); PG8_STB(PG8_SB(1, 0), b3, C8); PG8_STA(PG8_SA(1, 0), a3, 0, C8); } \
            PG8_WAIT_V(6); PG8_WAIT_L(0); PG8_BAR; MMA_(1, At, B0); PG8_BAR; PG8_SCHED; \
        }
    for (;;) {
        S.next(ui + 1, cg);
        PG8_KLOOP(PG8_LDA8, PG8_LDB8, PG8_MMA8, true, true, cu.A, cu.B0, cg.A, cg.B0, cu.nt)
        if (wr == 0) PG8_BAR;
        { const int l2_ = lane_id_(); E(acc, st_u, st_s, cu, wr, wc, l2_ & 15, l2_ >> 4); }
        PG8_ZACC();
        if (wr == 1) PG8_BAR;
        const bool has_next = S.next(ui + 2, nxt);
        if (!has_next) { nxt.A = S.BRp; nxt.B0 = S.WBp; }
        PG8_KLOOP(PG8_LDA8, PG8_LDB8, PG8_MMA8, true, true, cg.A, cg.B0, nxt.A, nxt.B0, cg.nt)
        if (wr == 0) PG8_BAR;
        { const int l2_ = lane_id_(); E(acc, st_u, st_s, cg, wr, wc, l2_ & 15, l2_ >> 4); }
        if (!has_next) break;
        PG8_ZACC();
        cu = nxt; ui += 2;
        if (wr == 1) PG8_BAR;
    }
#undef PG8_KLOOP
#undef PG8_ZACC
    PG8_WAIT_V(0);
    PG8_BAR;
#undef PG8_SA
#undef PG8_SB
#undef PG8_STAGE
#undef PG8_STAGE8
#undef PG8_STB
#undef PG8_STA
#undef PG8_LDA
#undef PG8_LDB
#undef PG8_LDA8
#undef PG8_LDB8
#undef PG8_MMA
#undef PG8_MMA8
#undef PG8_WAIT_V
#undef PG8_WAIT_L
#undef PG8_BAR
#undef PG8_SCHED
}
}
namespace attn_body {
using bf16=__hip_bfloat16;
using bf16x8=__attribute__((ext_vector_type(8)))short;
using s16x4=__attribute__((ext_vector_type(4)))short;
using f32x16=__attribute__((ext_vector_type(16)))float;
using f32x4=__attribute__((ext_vector_type(4)))float;
using u32x4=__attribute__((ext_vector_type(4)))unsigned;
constexpr int SEQ=4096,D=64;
constexpr int KVP=2304;
constexpr int OP=1024;
constexpr int NW=8,QBLK=32,QB=QBLK*NW,KVBLK=64,NQB=SEQ/QB;
__device__ __forceinline__ int crow(int r,int hi){return (r&3)+8*(r>>2)+4*hi;}
#define SBAR() __builtin_amdgcn_sched_barrier(0)
__device__ __forceinline__ void cmask(f32x16&p0,f32x16&p1,int jb,int qrel,int hi){
  const float NEG=-INFINITY; int kb=64*jb+4*hi;
  #pragma unroll
  for(int r=0;r<16;++r){int kv=kb+(r&3)+8*(r>>2); if(kv>qrel)p0[r]=NEG; if(kv+32>qrel)p1[r]=NEG;}
}
__device__ __forceinline__ void bmask(f32x16&p0,f32x16&p1,unsigned long long w,int hi){
  const float NEG=-INFINITY; const unsigned lo=((unsigned)w)>>(4*hi), up=((unsigned)(w>>32))>>(4*hi);
  #pragma unroll
  for(int r=0;r<16;++r){const int bit=(r&3)+8*(r>>2); if(!((lo>>bit)&1u))p0[r]=NEG; if(!((up>>bit)&1u))p1[r]=NEG;}
}
constexpr int NSLOT=3, SLOTB=8192;
constexpr int LDS_K=0, LDS_V=NSLOT*SLOTB, LDS_WS=2*NSLOT*SLOTB, LDS_OST=LDS_WS+NW*64*4, LDS_BIAS=LDS_OST+NW*4096, LDS_BYTES=LDS_BIAS+SEQ*4;
constexpr float C2=0.125f*1.4426950408889634f;
__device__ __forceinline__ void glds16(const void*gsrc,unsigned lds_dst){unsigned keep;
  asm volatile("s_mov_b32 %0, m0\n\ts_mov_b32 m0, %2\n\ts_nop 0\n\tglobal_load_lds_dwordx4 %1, off\n\ts_mov_b32 m0, %0":"=&s"(keep):"v"(gsrc),"s"(lds_dst):"memory");}
__device__ __forceinline__ float max3f(float a,float b,float c){float r;asm("v_max3_f32 %0, %1, %2, %3":"=v"(r):"v"(a),"v"(b),"v"(c));return r;}
__device__ __forceinline__ float max2f(float a,float b){float r;asm("v_max_f32_e32 %0, %1, %2":"=v"(r):"v"(a),"v"(b));return r;}
__device__ __forceinline__ float fadd_s(float a,float b){float r;asm("v_add_f32_e32 %0, %1, %2":"=v"(r):"v"(a),"v"(b));return r;}
__device__ __forceinline__ float fsub_s(float a,float b){float r;asm("v_sub_f32_e32 %0, %1, %2":"=v"(r):"v"(a),"v"(b));return r;}
typedef float f32x2_t __attribute__((ext_vector_type(2))); typedef __bf16 bf16x2_t __attribute__((ext_vector_type(2)));
__device__ __forceinline__ unsigned cvtpk_s(float lo,float hi){f32x2_t v={lo,hi};bf16x2_t b=__builtin_convertvector(v,bf16x2_t);return __builtin_bit_cast(unsigned,b);}
#define WAIT_BAR(N) asm volatile("s_waitcnt vmcnt(" #N ") lgkmcnt(0)\n\ts_barrier":::"memory")

typedef __attribute__((address_space(3))) const char* lds_cptr;
typedef short v4i16_t __attribute__((ext_vector_type(4)));
__device__ __forceinline__ void binit(f32x16&p0,f32x16&p1,lds_cptr bp,float mhat){
  typedef float f2_ __attribute__((ext_vector_type(2))); const f2_ m2={mhat,mhat};
  #pragma unroll
  for(int g=0;g<4;++g){ const f32x4 a=*(const __attribute__((address_space(3))) f32x4*)(bp+g*32); const f32x4 b=*(const __attribute__((address_space(3))) f32x4*)(bp+128+g*32);
    const f2_ a0=(f2_){a[0],a[1]}-m2,a1=(f2_){a[2],a[3]}-m2,b0=(f2_){b[0],b[1]}-m2,b1=(f2_){b[2],b[3]}-m2;
    p0[4*g]=a0.x;p0[4*g+1]=a0.y;p0[4*g+2]=a1.x;p0[4*g+3]=a1.y; p1[4*g]=b0.x;p1[4*g+1]=b0.y;p1[4*g+2]=b1.x;p1[4*g+3]=b1.y; }
}
__device__ __forceinline__ void qkt(f32x16&p0,f32x16&p1,const char*Kslot,const bf16x8*qr,int r32,int hi){
  const char*kb=Kslot+hi*1024+r32*16;
  #pragma unroll
  for(int d0=0;d0<4;++d0){
    const bf16x8 b0=*reinterpret_cast<const bf16x8*>(kb+d0*2048);
    const bf16x8 b1=*reinterpret_cast<const bf16x8*>(kb+d0*2048+512);
    p0=__builtin_amdgcn_mfma_f32_32x32x16_bf16(b0,qr[d0],p0,0,0,0);p1=__builtin_amdgcn_mfma_f32_32x32x16_bf16(b1,qr[d0],p1,0,0,0);}
}
__device__ __forceinline__ void kload8(bf16x8*kf,lds_cptr kp){
  kf[0]=*(const __attribute__((address_space(3))) bf16x8*)(kp);      kf[1]=*(const __attribute__((address_space(3))) bf16x8*)(kp+512);
  kf[2]=*(const __attribute__((address_space(3))) bf16x8*)(kp+2048); kf[3]=*(const __attribute__((address_space(3))) bf16x8*)(kp+2560);
  kf[4]=*(const __attribute__((address_space(3))) bf16x8*)(kp+4096); kf[5]=*(const __attribute__((address_space(3))) bf16x8*)(kp+4608);
  kf[6]=*(const __attribute__((address_space(3))) bf16x8*)(kp+6144); kf[7]=*(const __attribute__((address_space(3))) bf16x8*)(kp+6656);
}
__device__ __forceinline__ void kload2(bf16x8*kf,lds_cptr kp,int j){ kf[2*j]=*(const __attribute__((address_space(3))) bf16x8*)(kp+j*2048); kf[2*j+1]=*(const __attribute__((address_space(3))) bf16x8*)(kp+j*2048+512); }
__device__ __forceinline__ s16x4 vtr(lds_cptr p){ return __builtin_bit_cast(s16x4,__builtin_amdgcn_ds_read_tr16_b64_v4i16((__attribute__((address_space(3))) v4i16_t*)p)); }
__device__ __forceinline__ float rowmax(const f32x16&p0,const f32x16&p1){
  float a=max3f(p0[0],p0[1],p1[0]),b=max3f(p0[2],p0[3],p1[1]);a=max3f(a,p1[2],p1[3]);
  #pragma unroll
  for(int r=4;r<16;r+=4){a=max3f(a,p0[r],p0[r+1]);b=max3f(b,p0[r+2],p0[r+3]);a=max3f(a,p1[r],p1[r+1]);b=max3f(b,p1[r+2],p1[r+3]);}
  const float m=max2f(a,b);
  auto rr=__builtin_amdgcn_permlane32_swap(__float_as_uint(m),__float_as_uint(m),false,false);
  return max2f(__uint_as_float(rr[0]),__uint_as_float(rr[1]));
}
__device__ __forceinline__ void pv(f32x16*o,int vb,bf16x8 pa0,bf16x8 pa1,bf16x8 pa2,bf16x8 pa3){
  #pragma unroll
  for(int d0=0;d0<2;++d0){s16x4 lo[4],hi[4];
    #pragma unroll
    for(int ks=0;ks<4;++ks){
      asm volatile("ds_read_b64_tr_b16 %0,%1 offset:%c2":"=&v"(lo[ks]):"v"(vb),"i"(d0*4096+ks*1024):"memory");
      asm volatile("ds_read_b64_tr_b16 %0,%1 offset:%c2":"=&v"(hi[ks]):"v"(vb),"i"(d0*4096+ks*1024+512):"memory");}
    asm volatile("s_waitcnt lgkmcnt(0)":::"memory");SBAR();
    #define PK(k) (bf16x8){lo[k][0],lo[k][1],lo[k][2],lo[k][3],hi[k][0],hi[k][1],hi[k][2],hi[k][3]}
    o[d0]=__builtin_amdgcn_mfma_f32_32x32x16_bf16(pa0,PK(0),o[d0],0,0,0);
    o[d0]=__builtin_amdgcn_mfma_f32_32x32x16_bf16(pa1,PK(1),o[d0],0,0,0);
    o[d0]=__builtin_amdgcn_mfma_f32_32x32x16_bf16(pa2,PK(2),o[d0],0,0,0);
    o[d0]=__builtin_amdgcn_mfma_f32_32x32x16_bf16(pa3,PK(3),o[d0],0,0,0);
    #undef PK
  }
}

template<int THRL,bool MASK> __device__ __forceinline__ void attn_unit(int q0,const bf16*Qs,const bf16*__restrict__ Ks,const bf16*__restrict__ Vs,bf16*Os,
                                                                       const float*biasg,float slope2,const unsigned long long*maskw,char*shm,const int wid_in){
  const int wid=opaque_s(wid_in),lane=lane_id_(),tid=wid*64+lane,r32=lane&31,hi=lane>>5;
  const bf16*Qw=Qs+(long)(q0+wid*QBLK)*KVP;
  const unsigned lds0=(unsigned)(uintptr_t)shm;
  float*wsf=(float*)(shm+LDS_WS)+wid*64;
  unsigned long long mwA=0ull,mwB=0ull;
  { float*bl=(float*)(shm+LDS_BIAS); const int nk=q0+QB;
    if(biasg){ for(int s=tid;s<nk;s+=NW*64)bl[s]=biasg[s]; } else { for(int s=tid;s<nk;s+=NW*64)bl[s]=slope2*(float)s; }
    if(MASK){ const unsigned long long*mp0=maskw+(q0+wid*QBLK+(lane&31)); mwA=mp0[0]; mwB=mp0[SEQ]; asm volatile("":"+v"(mwA),"+v"(mwB)); }
    asm volatile("s_waitcnt vmcnt(0) lgkmcnt(0)":::"memory"); }
  const bf16*ksrc=Ks+(long)lane*KVP+wid*8;
  const bf16*vsrc=Vs+(long)(16*(wid&3)+(lane>>2))*KVP+(wid>>2)*32+(lane&3)*8;
  const unsigned kdst=lds0+LDS_K+wid*1024, vdst=lds0+LDS_V+wid*1024;
  #define DMA_K(t,slot) glds16(ksrc+(long)(t)*KVBLK*KVP,(unsigned)__builtin_amdgcn_readfirstlane(kdst+(slot)))
  #define DMA_V(t,slot) glds16(vsrc+(long)(t)*KVBLK*KVP,(unsigned)__builtin_amdgcn_readfirstlane(vdst+(slot)))
  const int vb0=(int)(lds0+LDS_V)+((lane>>4)&1)*32+(lane&3)*8+(4*hi+((lane&15)>>2))*64;
  const char*Kbase=shm+LDS_K; bf16x8 kf[8];
  const lds_cptr shm3=(lds_cptr)shm; const lds_cptr kp0=shm3+LDS_K+hi*1024+r32*16; const lds_cptr vp0=shm3+LDS_V+((lane>>4)&1)*32+(lane&3)*8+(4*hi+((lane&15)>>2))*64;
  const lds_cptr bp0=shm3+LDS_BIAS+hi*16;
  const int NT=(q0+QB)/KVBLK;
  DMA_K(0,0);DMA_V(0,0);DMA_K(1,SLOTB);
  bf16x8 qr[4];
  #pragma unroll
  for(int d0=0;d0<4;++d0)qr[d0]=*reinterpret_cast<const bf16x8*>(&Qw[(long)r32*KVP+d0*16+hi*8]);
  const unsigned long long*mwp=MASK?maskw+(q0+wid*QBLK+r32):nullptr;
  #define MLOAD(MW,t) do{ if(MASK){ MW=mwp[(long)(t)*SEQ]; } }while(0)
  #define MPIN(MW) do{}while(0)
  float mhat=0.f,l_reg=0.f;f32x16 o[2];o[0]=f32x16{};o[1]=f32x16{};
  const int qrel=wid*QBLK+r32;
  #define CMASK(P0,P1,t,MW) do{ if(MASK){ bmask(P0,P1,MW,hi); } else { int jb_=(t)-(NT-4); if(jb_>=0)cmask(P0,P1,jb_,qrel,hi); } }while(0)
  bool resc=false;
  #define START(P0,P1) do{ const float rm=rowmax(P0,P1); resc=false; \
    { const float dl=__builtin_fmaxf(rm,-60000.f); mhat=fadd_s(mhat,dl); \
      _Pragma("unroll") for(int r=0;r<16;++r){P0[r]=fsub_s(P0[r],dl);P1[r]=fsub_s(P1[r],dl);} } \
    _Pragma("unroll") for(int r=0;r<16;++r)P0[r]=__builtin_amdgcn_exp2f(P0[r]); }while(0)
  #define RESC() do{ if(resc){ asm volatile("s_waitcnt lgkmcnt(0)":::"memory"); \
      _Pragma("unroll") for(int d_=0;d_<2;++d_) _Pragma("unroll") for(int r=0;r<16;++r)o[d_][r]*=wsf[crow(r,hi)]; } }while(0)
  f32x16 pA0,pA1,pB0,pB1;
  int sl_prev=0,sl_cur=0,sl_next=SLOTB;
  #define ROT() do{sl_prev=sl_cur;sl_cur=sl_next;sl_next=(sl_next==(NSLOT-1)*SLOTB)?0:sl_next+SLOTB;}while(0)
  DMA_K(2,2*SLOTB);
  WAIT_BAR(3);
  binit(pA0,pA1,bp0,0.f);
  qkt(pA0,pA1,Kbase,qr,r32,hi);asm volatile("s_nop 15\n\ts_nop 7":"+v"(pA0),"+v"(pA1));CMASK(pA0,pA1,0,mwA);
  START(pA0,pA1);
  _Pragma("unroll") for(int r=0;r<16;++r)pA1[r]=__builtin_amdgcn_exp2f(pA1[r]);
  WAIT_BAR(0);
  DMA_K(3,0);DMA_V(1,SLOTB);MLOAD(mwA,2);
  ROT();
  kload8(kf,kp0+sl_cur);
  if(MASK){WAIT_BAR(3);}else{WAIT_BAR(2);}
  s16x4 vlo[8],vhi[8]; u32x4 pw0,pw1,pw2,pw3;
  #define PKW(P,B) cvtpk_s(P[B],P[B+1])
  #define PAF(k) __builtin_bit_cast(bf16x8,pw##k)
  #define VFR(i) (bf16x8){vlo[i][0],vlo[i][1],vlo[i][2],vlo[i][3],vhi[i][0],vhi[i][1],vhi[i][2],vhi[i][3]}
  #define PIN(x) asm volatile("":"+v"(x))
  #define MX3(a,b,c) __builtin_fmaxf(__builtin_fmaxf((a),(b)),(c))
  #define GAPA(MF,A0,A1,A2,A3,W0,W1,PW) do{ MF; sacc+=A0; sacc+=A1; sacc+=A2; sacc+=A3; PIN(sacc); W0; W1; PIN(PW); SBAR(); }while(0)
  #define EX(v) __builtin_amdgcn_exp2f(v)
  #define GAPB(MF,X,B) do{ MF; X[B]=EX(X[B]); X[B+1]=EX(X[B+1]); X[B+2]=EX(X[B+2]); X[B+3]=EX(X[B+3]); PIN(X); SBAR(); }while(0)
  #define VRD(i) do{ vlo[i]=vtr(vp_+(((i)>>2)*4096+((i)&3)*1024)); vhi[i]=vtr(vp_+(((i)>>2)*4096+((i)&3)*1024+512)); }while(0)
  #define KRD(G,j) do{ if(G){ kload2(kf,kp0+sl_next,j); SBAR(); } }while(0)
  #define STEP(C0,C1,P0,P1,t,GK,GV,GL,MW,GM,DOCM) do{ SBAR(); \
    const lds_cptr vp_=vp0+sl_prev; \
    binit(C0,C1,bp0+(t)*256,mhat); SBAR(); \
    VRD(0); SBAR(); float sacc=(P0[0]+P0[1]); \
    GAPA(C0=__builtin_amdgcn_mfma_f32_32x32x16_bf16(kf[0],qr[0],C0,0,0,0), P0[2],P0[3],P0[4],P0[5],     pw0[0]=PKW(P0,0), pw0[1]=PKW(P0,2), pw0); \
    VRD(4); SBAR(); GAPA(C1=__builtin_amdgcn_mfma_f32_32x32x16_bf16(kf[1],qr[0],C1,0,0,0), P0[6],P0[7],P0[8],P0[9],     pw0[2]=PKW(P0,4), pw0[3]=PKW(P0,6), pw0); \
    VRD(1); SBAR(); GAPA(C0=__builtin_amdgcn_mfma_f32_32x32x16_bf16(kf[2],qr[1],C0,0,0,0),   P0[10],P0[11],P0[12],P0[13], pw1[0]=PKW(P0,8), pw1[1]=PKW(P0,10), pw1); \
    VRD(5); SBAR(); GAPA(C1=__builtin_amdgcn_mfma_f32_32x32x16_bf16(kf[3],qr[1],C1,0,0,0),   P0[14],P0[15],P1[0],P1[1],   pw1[2]=PKW(P0,12),pw1[3]=PKW(P0,14), pw1); \
    VRD(2); SBAR(); GAPA(C0=__builtin_amdgcn_mfma_f32_32x32x16_bf16(kf[4],qr[2],C0,0,0,0),   P1[2],P1[3],P1[4],P1[5],     pw2[0]=PKW(P1,0), pw2[1]=PKW(P1,2), pw2); \
    VRD(6); SBAR(); GAPA(C1=__builtin_amdgcn_mfma_f32_32x32x16_bf16(kf[5],qr[2],C1,0,0,0),   P1[6],P1[7],P1[8],P1[9],     pw2[2]=PKW(P1,4), pw2[3]=PKW(P1,6), pw2); \
    VRD(3); SBAR(); GAPA(C0=__builtin_amdgcn_mfma_f32_32x32x16_bf16(kf[6],qr[3],C0,0,0,0),   P1[10],P1[11],P1[12],P1[13], pw3[0]=PKW(P1,8), pw3[1]=PKW(P1,10), pw3); \
    VRD(7); SBAR(); GAPA(C1=__builtin_amdgcn_mfma_f32_32x32x16_bf16(kf[7],qr[3],C1,0,0,0),   P1[14],P1[15],0.f,0.f,       pw3[2]=PKW(P1,12),pw3[3]=PKW(P1,14), pw3); \
    l_reg+=sacc; \
    if(MASK&&(DOCM)){ CMASK(C0,C1,t,MW); } \
    if(GK){DMA_K((t)+3,sl_cur);} if(GV){DMA_V((t)+1,sl_next);} \
    if(!MASK&&(DOCM)){ CMASK(C0,C1,t,MW); } \
    if(GM){ MLOAD(MW,(t)+2); } \
    { float a=MX3(C0[0],C0[1],C1[0]),b=MX3(C0[2],C0[3],C1[1]); a=MX3(a,C1[2],C1[3]); \
      _Pragma("unroll") for(int r=4;r<16;r+=4){a=MX3(a,C0[r],C0[r+1]);b=MX3(b,C0[r+2],C0[r+3]);a=MX3(a,C1[r],C1[r+1]);b=MX3(b,C1[r+2],C1[r+3]);} \
      float rm=__builtin_fmaxf(a,b); { auto rr=__builtin_amdgcn_permlane32_swap(__float_as_uint(rm),__float_as_uint(rm),false,false); rm=__builtin_fmaxf(__uint_as_float(rr[0]),__uint_as_float(rr[1])); } \
      resc=false; \
      if(__builtin_expect(__any(rm>(float)THRL),0)){ const float dl=__builtin_fmaxf(rm,0.f); mhat+=dl; \
        _Pragma("unroll") for(int r=0;r<16;++r){C0[r]-=dl;C1[r]-=dl;} \
        const float f=__builtin_amdgcn_exp2f(-dl); l_reg*=f; if(hi==0)wsf[r32]=f; resc=true; } } \
    SBAR(); \
    GAPB(o[0]=__builtin_amdgcn_mfma_f32_32x32x16_bf16(PAF(0),VFR(0),o[0],0,0,0), C0,0); \
    GAPB(o[1]=__builtin_amdgcn_mfma_f32_32x32x16_bf16(PAF(0),VFR(4),o[1],0,0,0), C0,4); \
    KRD(GL,0); GAPB(o[0]=__builtin_amdgcn_mfma_f32_32x32x16_bf16(PAF(1),VFR(1),o[0],0,0,0), C0,8); \
    KRD(GL,1); GAPB(o[1]=__builtin_amdgcn_mfma_f32_32x32x16_bf16(PAF(1),VFR(5),o[1],0,0,0), C0,12); \
    KRD(GL,2); GAPB(o[0]=__builtin_amdgcn_mfma_f32_32x32x16_bf16(PAF(2),VFR(2),o[0],0,0,0), C1,0); \
    KRD(GL,3); GAPB(o[1]=__builtin_amdgcn_mfma_f32_32x32x16_bf16(PAF(2),VFR(6),o[1],0,0,0), C1,4); \
    GAPB(o[0]=__builtin_amdgcn_mfma_f32_32x32x16_bf16(PAF(3),VFR(3),o[0],0,0,0), C1,8); \
    GAPB(o[1]=__builtin_amdgcn_mfma_f32_32x32x16_bf16(PAF(3),VFR(7),o[1],0,0,0), C1,12); \
    }while(0)
  int t=1;
  #define ENDW(tt) do{ if((tt)+3<NT){ if(MASK){WAIT_BAR(3);}else{WAIT_BAR(2);} } else if((tt)+2<NT){ if(MASK){WAIT_BAR(2);}else{WAIT_BAR(1);} } else {WAIT_BAR(0);} }while(0)
  for(;t+5<NT;t+=2){
    STEP(pB0,pB1,pA0,pA1,t,true,true,true,mwB,MASK,MASK);     if(MASK){WAIT_BAR(3);}else{WAIT_BAR(2);} MPIN(mwA); RESC(); ROT();
    STEP(pA0,pA1,pB0,pB1,t+1,true,true,true,mwA,MASK,MASK);   if(MASK){WAIT_BAR(3);}else{WAIT_BAR(2);} MPIN(mwB); RESC(); ROT();
  }
  for(;t+1<NT;t+=2){
    STEP(pB0,pB1,pA0,pA1,t,(t+3<NT),(t+1<NT),(t+1<NT),mwB,(MASK&&(t+2<NT)),true);       ENDW(t);   MPIN(mwA); RESC(); ROT();
    STEP(pA0,pA1,pB0,pB1,t+1,(t+4<NT),(t+2<NT),(t+2<NT),mwA,(MASK&&(t+3<NT)),true);     ENDW(t+1); MPIN(mwB); RESC(); ROT();
  }
  STEP(pB0,pB1,pA0,pA1,NT-1,false,false,false,mwB,false,true); RESC();
  { float sacc=pB0[0]+pB0[1]; _Pragma("unroll") for(int r=2;r<16;++r)sacc+=pB0[r]; _Pragma("unroll") for(int r=0;r<16;++r)sacc+=pB1[r]; l_reg+=sacc;
    pw0=(u32x4){PKW(pB0,0),PKW(pB0,2),PKW(pB0,4),PKW(pB0,6)};pw1=(u32x4){PKW(pB0,8),PKW(pB0,10),PKW(pB0,12),PKW(pB0,14)};pw2=(u32x4){PKW(pB1,0),PKW(pB1,2),PKW(pB1,4),PKW(pB1,6)};pw3=(u32x4){PKW(pB1,8),PKW(pB1,10),PKW(pB1,12),PKW(pB1,14)};
    SBAR(); pv(o,vb0+sl_cur,PAF(0),PAF(1),PAF(2),PAF(3)); }
  #undef PKW
  #undef PAF
  #undef VFR
  #undef PIN
  #undef MX3
  #undef GAPA
  #undef GAPB
  #undef EX
  #undef VRD
  #undef KRD
  #undef STEP
  #undef ENDW
  {auto rr=__builtin_amdgcn_permlane32_swap(__float_as_uint(l_reg),__float_as_uint(l_reg),false,false);l_reg=__uint_as_float(rr[0])+__uint_as_float(rr[1]);}
  if(hi==0)wsf[32+r32]=l_reg;asm volatile("s_waitcnt lgkmcnt(0)":::"memory");
  float rli[16];
  #pragma unroll
  for(int r=0;r<16;++r)rli[r]=__builtin_amdgcn_rcpf(wsf[32+crow(r,hi)]);
  unsigned char*Ow=(unsigned char*)Os+(long)(q0+wid*QBLK)*OP;
  { unsigned char*stg=(unsigned char*)(shm+LDS_OST)+wid*4096;
    #pragma unroll
    for(int r=0;r<16;++r){const int orow=crow(r,hi); const float sc8=rli[r]*8.f;
      #pragma unroll
      for(int d0=0;d0<2;++d0){const float x=o[d0][r]*sc8; stg[orow*64+d0*32+r32]=(unsigned char)(__builtin_amdgcn_cvt_pk_fp8_f32(x,x,0,false)&0xff);}}
    asm volatile("s_waitcnt lgkmcnt(0)":::"memory");
    #pragma unroll
    for(int i=0;i<4;++i){const int row=i*8+(lane>>3),ch=lane&7; typedef unsigned u32x2_ __attribute__((ext_vector_type(2))); const u32x2_ v=*(const u32x2_*)(stg+row*64+ch*8); *(u32x2_*)(Ow+(long)row*OP+ch*8)=v;} }
  asm volatile("s_waitcnt lgkmcnt(0)\n\ts_barrier":::"memory");
  #undef DMA_K
  #undef MLOAD
  #undef MPIN
  #undef DMA_V
  #undef CMASK
  #undef START
  #undef RESC
  #undef ROT
}
#undef SBAR
#undef WAIT_BAR
}
struct Args { const float* in[25]; float* out; unsigned char* ws; int ph_lo, ph_hi; };
struct Frame {
    LAS unsigned char* lds; unsigned char* ldsg;
    volatile LAS unsigned* MISC;
    gu32* ctl;
    int tid, lane, wave, vcu, G;
    unsigned char* ws; float* out;
};
__device__ __forceinline__ float dpp_add_(float v, float acc_src, int) { return v; }
#define DPP_F(v, ctrl, rmask) __builtin_bit_cast(float, __builtin_amdgcn_update_dpp(0, __builtin_bit_cast(int, (v)), (ctrl), (rmask), 0xF, false))
__device__ __forceinline__ float wave_sum(float v) {
    v += DPP_F(v, 0xB1, 0xF);
    v += DPP_F(v, 0x4E, 0xF);
    v += DPP_F(v, 0x141, 0xF);
    v += DPP_F(v, 0x140, 0xF);
    v += DPP_F(v, 0x142, 0xA);
    v += DPP_F(v, 0x143, 0xC);
    return __builtin_bit_cast(float, __builtin_amdgcn_readlane(__builtin_bit_cast(int, v), 63));
}
__device__ __forceinline__ bf16* wsb(const Frame& F, size_t off) { return (bf16*)(F.ws + off); }

__device__ __forceinline__ int map_small(int r) {
    if (r < 1024) return r;
    if (r < 1280) return 1028 + (r - 1024);
    if (r < 1536) return 1412 + (r - 1280);
    if (r < 2048) return 1736 + (r - 1536);
    if (r < 2112) return 1284 + (r - 2048);
    if (r < 2176) return 1348 + (r - 2112);
    if (r < 2240) return 1668 + (r - 2176);
    if (r < 2244) return 1024 + (r - 2240);
    if (r < 2248) return 1732 + (r - 2244);
    return -1;
}
__device__ __forceinline__ void tr_item(const float* src, int ld_src, int k0, int srccol, bf16* dst, int ld_dst, LAS float* scr, int lane) {
    float tv[32];
#pragma unroll
    for (int i = 0; i < 32; ++i) { const int kk = 2 * i + (lane >> 5); tv[i] = src[(size_t)(k0 + kk) * ld_src + (srccol >= 0 ? srccol : 0)]; }
#pragma unroll
    for (int i = 0; i < 32; ++i) { const int kk = 2 * i + (lane >> 5); scr[kk * 33 + (lane & 31)] = srccol >= 0 ? tv[i] : 0.f; }
    LDS_WAIT(); asm volatile("" ::: "memory");
    const int c = lane & 7;
#pragma unroll
    for (int j = 0; j < 4; ++j) { const int n = (lane >> 3) + 8 * j; const LAS float* s = scr + (8 * c) * 33 + n;
        v4u o; o.x = pk2(s[0 * 33], s[1 * 33]); o.y = pk2(s[2 * 33], s[3 * 33]); o.z = pk2(s[4 * 33], s[5 * 33]); o.w = pk2(s[6 * 33], s[7 * 33]);
        *(GAS v4u*)(dst + (size_t)n * ld_dst + 8 * c) = o; }
    LDS_WAIT(); asm volatile("" ::: "memory");
}
#ifndef A_F8_TILES
#define A_F8_TILES 0x0DF
#endif
constexpr size_t W_SM8 = 4718592 + 4 * MiB;
constexpr float BR_SCALE = 8.f;
constexpr float MIX_SCALE = 8.f;
constexpr float ACT_SCALE = 8.f;
constexpr float GATE_WSCALE = 32.f;
__device__ __forceinline__ void tr_item8(const float* src, int ld_src, int k0, int srccol, unsigned char* dst, int ld_dst, LAS float* scr, int lane) {
    float tv[32];
#pragma unroll
    for (int i = 0; i < 32; ++i) { const int kk = 2 * i + (lane >> 5); tv[i] = src[(size_t)(k0 + kk) * ld_src + (srccol >= 0 ? srccol : 0)]; }
#pragma unroll
    for (int i = 0; i < 32; ++i) { const int kk = 2 * i + (lane >> 5); scr[kk * 33 + (lane & 31)] = srccol >= 0 ? tv[i] * GATE_WSCALE : 0.f; }
    LDS_WAIT(); asm volatile("" ::: "memory");
    const int c = lane & 7;
#pragma unroll
    for (int j = 0; j < 4; ++j) { const int n = (lane >> 3) + 8 * j; const LAS float* s = scr + (8 * c) * 33 + n;
        v2u o; o.x = pk4_fp8(s[0 * 33], s[1 * 33], s[2 * 33], s[3 * 33]); o.y = pk4_fp8(s[4 * 33], s[5 * 33], s[6 * 33], s[7 * 33]);
        *(GAS v2u*)(dst + (size_t)n * ld_dst + 8 * c) = o; }
    LDS_WAIT(); asm volatile("" ::: "memory");
}
constexpr int IT_SM = 72 * 16, IT_GT = 128 * 16, IT_BR = 512, IT_OUT = 512, IT_GU = 16 * 512, IT_D = 16 * 256, IT_LAYER = IT_SM + IT_GT + IT_BR + IT_OUT + IT_GU + IT_D;
__device__ __forceinline__ void p0_item(const Frame& F, const Args& a, int it, LAS float* scr) {
    const int l = it / IT_LAYER; int j = it % IT_LAYER; const int n = F.lane & 31;
    bf16* W = wsb(F, WS_W + (size_t)l * W_LAYER);
    if (j < IT_SM) { const int g = j / 16, kb = j % 16;
        if ((A_F8_TILES >> (g / 8)) & 1) tr_item8(a.in[3] + (size_t)l * DM * P_TOTAL, P_TOTAL, kb * 64, map_small(g * 32 + n), (unsigned char*)W + W_SM8 + (size_t)(g * 32) * DM + kb * 64, DM, scr, F.lane);
        else tr_item(a.in[3] + (size_t)l * DM * P_TOTAL, P_TOTAL, kb * 64, map_small(g * 32 + n), W + W_SM / 2 + (size_t)(g * 32) * DM + kb * 64, DM, scr, F.lane);
        return; } j -= IT_SM;
    if (j < IT_GT) { const int g = j / 16, kb = j % 16; tr_item8(a.in[3] + (size_t)l * DM * P_TOTAL, P_TOTAL, kb * 64, 2248 + g * 32 + n, (unsigned char*)W + W_GT + (size_t)(g * 32) * DM + kb * 64, DM, scr, F.lane); return; } j -= IT_GT;
    if (j < IT_BR) { const int nb = j / 128, jj = j % 128, g = jj / 4, kb = jj % 4;
        tr_item8(a.in[12] + ((size_t)l * 4 + nb) * 256 * DM, DM, kb * 64, g * 32 + n, (unsigned char*)W + W_BR + (size_t)(g * 32) * DM + nb * 256 + kb * 64, DM, scr, F.lane); return; } j -= IT_BR;
    if (j < IT_OUT) { const int g = j / 16, kb = j % 16; tr_item8(a.in[13] + (size_t)l * DM * DM, DM, kb * 64, g * 32 + n, (unsigned char*)W + W_OUT + (size_t)(g * 32) * DM + kb * 64, DM, scr, F.lane); return; } j -= IT_OUT;
    if (j < IT_GU) { const int e = j / 512, jj = j % 512, g = jj / 16, kb = jj % 16; const int r0 = g * 32, q = r0 >> 8, within = r0 & 255; const bool isup = within >= 128;
        const float* src = (isup ? a.in[21] : a.in[20]) + ((size_t)l * 16 + e) * DM * 512;
        tr_item8(src, 512, kb * 64, 128 * q + (within & 127) + n, (unsigned char*)W + W_GU + (size_t)e * DM * DM + (size_t)r0 * DM + kb * 64, DM, scr, F.lane); return; } j -= IT_GU;
    { const int e = j / 256, jj = j % 256, g = jj / 8, kb = jj % 8;
        tr_item8(a.in[22] + ((size_t)l * 16 + e) * 512 * DM, DM, kb * 64, g * 32 + n, (unsigned char*)W + W_D + (size_t)(e >> 1) * DM * DM + (size_t)(g * 32) * DM + (e & 1) * 512 + kb * 64, DM, scr, F.lane); }
}
__device__ __forceinline__ void ln_load(const Frame& F, const float* xrow, f32x4 (&v)[4]) {
    const GAS f32x4* xr = (const GAS f32x4*)xrow + F.lane;
#pragma unroll
    for (int j = 0; j < 4; ++j) v[j] = xr[64 * j];
}
struct LnGB { f32x4 g[4], b[4]; };
__device__ __forceinline__ void ln_gb_load(const Frame& F, const float* g, const float* b, LnGB& gb) {
#pragma unroll
    for (int j = 0; j < 4; ++j) { gb.g[j] = ((const GAS f32x4*)g)[F.lane + 64 * j]; gb.b[j] = ((const GAS f32x4*)b)[F.lane + 64 * j]; }
}
__device__ __forceinline__ void ln_load_bf(const Frame& F, const bf16* xrow, f32x4 (&v)[4]) {
    const GAS v2u* xr = (const GAS v2u*)xrow + F.lane;
#pragma unroll
    for (int j = 0; j < 4; ++j) { const v2u w = xr[64 * j]; v[j] = (f32x4){bfl(w.x), bfh(w.x), bfl(w.y), bfh(w.y)}; }
}
__device__ __forceinline__ void ln_row(const Frame& F, const LnGB& gb, float* orow  , bf16* brow  , f32x4 (&v)[4], bool dry = false, unsigned char* frow = nullptr  ) {
    float s = 0.f;
#pragma unroll
    for (int j = 0; j < 4; ++j) s += (v[j].x + v[j].y) + (v[j].z + v[j].w);
    const float mean = wave_sum(s) * (1.f / DM); float s2 = 0.f;
#pragma unroll
    for (int j = 0; j < 4; ++j) { v[j] = v[j] - mean; s2 += (v[j].x * v[j].x + v[j].y * v[j].y) + (v[j].z * v[j].z + v[j].w * v[j].w); }
    const float rstd = 1.f / sqrtf(wave_sum(s2) * (1.f / DM) + LN_EPS);
    GAS f32x4* o4 = (GAS f32x4*)orow + F.lane; GAS v2u* o8 = (GAS v2u*)brow + F.lane; GAS unsigned* o1 = (GAS unsigned*)frow + F.lane;
#pragma unroll
    for (int j = 0; j < 4; ++j) { v[j] = v[j] * rstd * gb.g[j] + gb.b[j]; v2u w; w.x = pk2(v[j].x, v[j].y); w.y = pk2(v[j].z, v[j].w); if (!dry) { if (orow) o4[64 * j] = v[j]; if (brow) o8[64 * j] = w; if (frow) o1[64 * j] = pk4_fp8(v[j].x, v[j].y, v[j].z, v[j].w); } }
}
__device__ __forceinline__ void p0_prologue(const Frame& F_, const Args& a) { Frame F = F_; F.lane = lane_id_(); F.tid = F.wave * 64 + F.lane;
    LAS float* scr = (LAS float*)(F.lds + RING_OFF + F.wave * 16384);
    const int gw = F.vcu * NWAVES + F.wave, NGW = F.G * NWAVES;
    for (int it = gw; it < DEPTH * IT_LAYER; it += NGW) p0_item(F, a, it, scr);
    { LnGB gb; ln_gb_load(F, a.in[1], a.in[2], gb); f32x4 nx[4]; ln_load(F, a.in[0] + (size_t)gw * DM, nx);
      for (int m = gw; m < NTOK; m += NGW) { f32x4 v[4];
#pragma unroll
          for (int j = 0; j < 4; ++j) v[j] = nx[j];
          if (m + NGW < NTOK) ln_load(F, a.in[0] + (size_t)(m + NGW) * DM, nx);
          ln_row(F, gb, nullptr, wsb(F, WS_HB) + (size_t)m * DM, v, false, F.ws + WS_HB8 + (size_t)m * DM); } }
}

#ifndef TO_WGM
#define TO_WGM 8
#endif
struct TileOrder {
    int nM, nN, nwg, G, c;
    __device__ void init(int nM_, int nN_, int G_, int c_) { nM = nM_; nN = nN_; nwg = nM * nN; G = G_; c = c_; }
    __device__ bool tile(int i, int& pm, int& pn) const {
        const long L = (long)i * G + c; if (L >= nwg) return false;
        int wgid = (int)L; { const int q = nwg / 8, r = nwg % 8, xcd = wgid % 8, off = wgid / 8; wgid = (xcd < r ? xcd * (q + 1) : r * (q + 1) + (xcd - r) * q) + off; }
        const int nig = TO_WGM * nN, gid = wgid / nig, fm = gid * TO_WGM, gsz = (nM - fm) < TO_WGM ? (nM - fm) : TO_WGM;
        pm = fm + ((wgid % nig) % gsz); pn = (wgid % nig) / gsz; return true;
    }
};
template <bool F8_> struct SchedAT { static constexpr int NT = 0, KS = 0; TileOrder T; const char* A; const char* B; unsigned map;
    __device__ bool next(int i, pg8::GU& u) const { int pm, pq; if (!T.tile(i, pm, pq)) return false; const int pn = (int)((map >> (4 * pq)) & 15u); constexpr size_t TS = F8_ ? pg8::TSTEP / 2 : pg8::TSTEP;
        u.A = A + (size_t)pm * TS; u.B0 = B + (size_t)pn * TS; u.B1 = u.B0; u.nt = F8_ ? 8 : 16; u.ks = u.nt; u.pm = pm; u.pn = pn; u.rows = nullptr; u.rbase = 0; u.rcnt = 0; u.a0 = 0; u.a1 = 0; return true; } };
template <bool F8_> struct EpiAT { static constexpr bool F8 = F8_; static constexpr bool PERM = true; bf16* P; float* FW; bf16* KIDX;
    __device__ __forceinline__ void operator()(const pg8::f32x4 (&acc)[2][2][4][2], const pg8::GU& u, int wr, int wc, int fr, int fq) {
        const float sc = ((u.pn == 1 || u.pn == 4) ? 0.125f * LOG2E : 1.f) * (F8_ ? 1.f / GATE_WSCALE : 1.f);
        const int row0 = u.pm * 256 + wr * 64 + fr, col0 = u.pn * 256 + wc * 32 + 8 * fq;
#pragma unroll
        for (int ai = 0; ai < 2; ++ai)
#pragma unroll
            for (int m = 0; m < 4; ++m) { const int row = row0 + ai * 128 + m * 16; bf16* rowp = P + (size_t)row * PS + col0;
#pragma unroll
                for (int bj = 0; bj < 2; ++bj) { const pg8::f32x4 v0 = acc[ai][bj][m][0] * sc, v1 = acc[ai][bj][m][1] * sc; v4u w;
                    w.x = pg8::cvt_pk_bf16(v0[0], v0[1]); w.y = pg8::cvt_pk_bf16(v0[2], v0[3]); w.z = pg8::cvt_pk_bf16(v1[0], v1[1]); w.w = pg8::cvt_pk_bf16(v1[2], v1[3]);
                    *(v4u*)(rowp + bj * 128) = w;
                    if (bj == 1 && u.pn == 8 && wc < 2) *(v4u*)(KIDX + (size_t)row * 64 + wc * 32 + 8 * fq) = w;
                    if (bj == 1 && u.pn == 8 && wc == 2 && fq == 0) { *(f32x4*)(FW + (size_t)row * 8) = v0; *(f32x4*)(FW + (size_t)row * 8 + 4) = v1; } } }
    } };
struct SchedC { TileOrder T; const char* HBp; const char* BRp; const char* WGp; const char* WBp; bool collapse;
    __device__ bool next(int i, pg8::GU& u) const { int pm, pd; if (!T.tile(i >> 3, pm, pd)) return false; const int sub = i & 7, n = sub >> 1, isg = sub & 1; const int pm_o = pm, pd_o = pd; if (collapse) { pm &= 7; pd = 0; }
        u.pm = pm; u.pn = pd; u.a0 = n; u.a1 = isg; u.rows = nullptr; u.rbase = 0; u.rcnt = 0;
        if (isg) { u.A = HBp + (size_t)pm * (pg8::TSTEP / 2); u.B0 = WGp + (size_t)(n * 8 + pd) * (pg8::HSTEP / 2); u.nt = 8; }
        else     { u.A = BRp + (size_t)pm * (pg8::TSTEP / 2) + n * 256; u.B0 = WBp + (size_t)pd * (pg8::HSTEP / 2) + n * 256; u.nt = 2; }
        u.B1 = u.B0; u.ks = u.nt; u.pm = pm_o; u.pn = pd_o; return true; } };
struct EpiC { static constexpr bool F8 = false; static constexpr bool PERM = true; bf16* MIX; const float* bgate; bool dry;
    __device__ __forceinline__ void operator()(const pg8::f32x4 (&acc)[2][4][2], pg8::u32x4 (&upk)[2][4], pg8::u32x4 (&sum)[2][4]  , const pg8::GU& u, int wr, int wc, int fr, int fq) {
        const int n = u.a0;
        if (!u.a1) {
#pragma unroll
            for (int ai = 0; ai < 2; ++ai)
#pragma unroll
                for (int m = 0; m < 4; ++m) { const pg8::f32x4 v0 = acc[ai][m][0] * (1.f / (BR_SCALE * GATE_WSCALE)), v1 = acc[ai][m][1] * (1.f / (BR_SCALE * GATE_WSCALE)); v4u w;
                    w.x = pg8::cvt_pk_bf16(v0[0], v0[1]); w.y = pg8::cvt_pk_bf16(v0[2], v0[3]); w.z = pg8::cvt_pk_bf16(v1[0], v1[1]); w.w = pg8::cvt_pk_bf16(v1[2], v1[3]); upk[ai][m] = w; }
        } else {
            const int colt = u.pn * 128 + wc * 32 + 8 * fq; const float* bp = bgate + n * DM + colt; const f32x4 b0 = *(const f32x4*)bp, b1 = *(const f32x4*)(bp + 4);
#pragma unroll
            for (int ai = 0; ai < 2; ++ai)
#pragma unroll
                for (int m = 0; m < 4; ++m) { const v4u uw = upk[ai][m]; const pg8::f32x4 g0 = acc[ai][m][0] * (1.f / GATE_WSCALE) + b0, g1 = acc[ai][m][1] * (1.f / GATE_WSCALE) + b1;
                    pg8::f32x4 r0, r1; r0[0] = sigmoidf_(g0[0]) * bfl(uw.x); r0[1] = sigmoidf_(g0[1]) * bfh(uw.x); r0[2] = sigmoidf_(g0[2]) * bfl(uw.y); r0[3] = sigmoidf_(g0[3]) * bfh(uw.y);
                    r1[0] = sigmoidf_(g1[0]) * bfl(uw.z); r1[1] = sigmoidf_(g1[1]) * bfh(uw.z); r1[2] = sigmoidf_(g1[2]) * bfl(uw.w); r1[3] = sigmoidf_(g1[3]) * bfh(uw.w);
                    if (n > 0) { const v4u pw = sum[ai][m]; r0[0] += bfl(pw.x); r0[1] += bfh(pw.x); r0[2] += bfl(pw.y); r0[3] += bfh(pw.y); r1[0] += bfl(pw.z); r1[1] += bfh(pw.z); r1[2] += bfl(pw.w); r1[3] += bfh(pw.w); }
                    v4u o; o.x = pg8::cvt_pk_bf16(r0[0], r0[1]); o.y = pg8::cvt_pk_bf16(r0[2], r0[3]); o.z = pg8::cvt_pk_bf16(r1[0], r1[1]); o.w = pg8::cvt_pk_bf16(r1[2], r1[3]); sum[ai][m] = o; }
            if (n == 3) { const int row0 = u.pm * 256 + wr * 64 + fr; unsigned char* M8 = (unsigned char*)MIX;
#pragma unroll
                for (int ai = 0; ai < 2; ++ai)
#pragma unroll
                    for (int m = 0; m < 4; ++m) { const v4u pw = sum[ai][m]; v2u o;
                        o.x = pk4_fp8(bfl(pw.x) * MIX_SCALE, bfh(pw.x) * MIX_SCALE, bfl(pw.y) * MIX_SCALE, bfh(pw.y) * MIX_SCALE); o.y = pk4_fp8(bfl(pw.z) * MIX_SCALE, bfh(pw.z) * MIX_SCALE, bfl(pw.w) * MIX_SCALE, bfh(pw.w) * MIX_SCALE);
                        *(v2u*)(M8 + (size_t)(row0 + ai * 128 + m * 16) * DM + colt) = o; } }
        }
    } };
struct SchedC2 { static constexpr int NT = 0, KS = 0; TileOrder T; const char* A; const char* B;
    __device__ bool next(int i, pg8::GU& u) const { int pm, pn; if (!T.tile(i, pm, pn)) return false; u.A = A + (size_t)pm * (pg8::TSTEP / 2); u.B0 = B + (size_t)pn * (pg8::TSTEP / 2); u.B1 = u.B0; u.nt = 8; u.ks = 8; u.pm = pm; u.pn = pn; u.rows = nullptr; u.rbase = 0; u.rcnt = 0; u.a0 = 0; u.a1 = 0; return true; } };
struct EpiRes { static constexpr bool F8 = true; static constexpr bool PERM = false; bf16* V1; const bf16* HB; bool dry;
    __device__ __forceinline__ void operator()(const pg8::f32x4 (&acc)[2][2][4][2], const pg8::GU& u, int wr, int wc, int fr, int fq) {
        const int row0 = u.pm * 256 + wr * 64 + fr, col0 = u.pn * 256 + wc * 32 + 4 * fq;
#pragma unroll
        for (int ai = 0; ai < 2; ++ai)
#pragma unroll
            for (int m = 0; m < 4; ++m) { const size_t ro = (size_t)(row0 + ai * 128 + m * 16) * DM + col0;
#pragma unroll
                for (int bj = 0; bj < 2; ++bj)
#pragma unroll
                    for (int n = 0; n < 2; ++n) { const v2u hw = *(const v2u*)(HB + ro + bj * 128 + n * 16); const f32x4 hv = (f32x4){bfl(hw.x), bfh(hw.x), bfl(hw.y), bfh(hw.y)};
                        const f32x4 r_ = hv * ALPHA + acc[ai][bj][m][n] * (1.f / (MIX_SCALE * GATE_WSCALE)); v2u o; o.x = pk2(r_.x, r_.y); o.y = pk2(r_.z, r_.w); if (!dry) *(v2u*)(V1 + ro + bj * 128 + n * 16) = o; } }
    } };
__device__ __forceinline__ void cls_lookup(const LAS int* tab, int tau, int& c, int& j) {
    int cc = 0;
#pragma unroll 1
    for (int k = 1; k < NCLS; ++k) if (tab[32 + k] <= tau) cc = k;
    c = cc; j = tau - tab[32 + cc];
}
__device__ __forceinline__ void cls_experts(int c, int& ea, int& eb) { const int g = c / 6, p = c % 6; const int i = p < 3 ? 0 : (p < 5 ? 1 : 2); const int jj = p < 3 ? p + 1 : (p < 5 ? p - 1 : 3); ea = g * 4 + i; eb = g * 4 + jj; }
struct SchedD1 { static constexpr int NT = 0, KS = 0; const LAS int* tab; int G, c0; const char* HBp; const char* WGU; const int* list;
    __device__ bool next(int i, pg8::GU& u) const { const int L = i * G + c0; if (L >= tab[57] * 8) return false; const int tau = L >> 3, pn = L & 7; int c, j; cls_lookup(tab, tau, c, j); int ea, eb; cls_experts(c, ea, eb);
        const int e = (pn >> 2) ? eb : ea;
        u.A = HBp; u.B0 = WGU + (size_t)e * DM * DM + (size_t)(pn & 3) * (pg8::TSTEP / 2); u.B1 = u.B0; u.nt = 8; u.ks = 8;     u.rows = list + (size_t)c * NTOK; u.rbase = j * 256; u.rcnt = tab[c];
        u.pm = tau; u.pn = pn; u.a0 = c; u.a1 = j; return true; } };
struct EpiD1 { static constexpr bool F8 = true; static constexpr bool PERM = true; unsigned char* ACT; const float* gwl;
    __device__ __forceinline__ void operator()(const pg8::f32x4 (&acc)[2][2][4][2], const pg8::GU& u, int wr, int wc, int fr, int fq) {
        const int half = u.pn >> 2, col = half * 512 + (u.pn & 3) * 128 + wc * 32 + 8 * fq;
#pragma unroll
        for (int ai = 0; ai < 2; ++ai)
#pragma unroll
            for (int m = 0; m < 4; ++m) { const int r = ai * 128 + wr * 64 + m * 16 + opaque_i(fr), pos = u.rbase + r;
                const float gw = pos < u.rcnt ? gwl[((size_t)u.a0 * NTOK + pos) * 2 + half] * ACT_SCALE : 0.f;
                const pg8::f32x4 g0 = acc[ai][0][m][0] * (1.f / GATE_WSCALE), g1 = acc[ai][0][m][1] * (1.f / GATE_WSCALE), u0 = acc[ai][1][m][0] * (1.f / GATE_WSCALE), u1 = acc[ai][1][m][1] * (1.f / GATE_WSCALE); float r8[8];
#pragma unroll
                for (int k = 0; k < 4; ++k) { r8[k] = g0[k] * sigmoidf_(g0[k]) * u0[k] * gw; r8[4 + k] = g1[k] * sigmoidf_(g1[k]) * u1[k] * gw; }
                v2u o; o.x = pk4_fp8(r8[0], r8[1], r8[2], r8[3]); o.y = pk4_fp8(r8[4], r8[5], r8[6], r8[7]);
                *(v2u*)(ACT + ((size_t)u.pm * 256 + r) * DM + col) = o; asm volatile("" ::: "memory"); }
    } };
struct SchedD2 { static constexpr int NT = 8, KS = 4; const LAS int* tab; int G, c0; const char* ACTp; const char* WD; const int* list;
    __device__ bool next(int i, pg8::GU& u) const { const int L = i * G + c0; if (L >= __builtin_amdgcn_readfirstlane(tab[57]) * 4) return false; const int tau = L >> 2, pn = L & 3; int c, j; cls_lookup(tab, tau, c, j); c = __builtin_amdgcn_readfirstlane(c); j = __builtin_amdgcn_readfirstlane(j); int ea, eb; cls_experts(c, ea, eb);
        u.A = sptr_(ACTp + (size_t)tau * (pg8::TSTEP / 2)); u.B0 = sptr_(WD + (size_t)(ea >> 1) * DM * DM + (ea & 1) * 512 + (size_t)pn * (pg8::TSTEP / 2)); u.B1 = sptr_(WD + (size_t)(eb >> 1) * DM * DM + (eb & 1) * 512 + (size_t)pn * (pg8::TSTEP / 2));
        u.nt = 8; u.ks = 4;     u.rows = list + (size_t)c * NTOK; u.rbase = j * 256; u.rcnt = __builtin_amdgcn_readfirstlane(tab[c]); u.pm = tau; u.pn = pn; u.a0 = c; u.a1 = j; return true; } };
struct EpiD2 { static constexpr bool F8 = true; static constexpr bool PERM = false; bf16* V2; const bf16* HB; bool dry;
    __device__ __forceinline__ void operator()(const pg8::f32x4 (&acc)[2][2][4][2], const pg8::GU& u, int wr, int wc, int fr, int fq) {
        const int col0 = u.pn * 256 + wc * 32 + 4 * fq;
#pragma unroll
        for (int ai = 0; ai < 2; ++ai) { asm volatile("" ::: "memory");
#pragma unroll
            for (int m = 0; m < 4; ++m) { if (m == 2) asm volatile("" ::: "memory"); const int pos = u.rbase + ai * 128 + wr * 64 + m * 16 + opaque_i(fr);
                if (pos < u.rcnt) { const size_t ro = (size_t)u.rows[pos] * DM + col0;
#pragma unroll
                    for (int bj = 0; bj < 2; ++bj)
#pragma unroll
                        for (int n = 0; n < 2; ++n) { const v2u hw = *(const v2u*)(HB + ro + bj * 128 + n * 16); const f32x4 hv = (f32x4){bfl(hw.x), bfh(hw.x), bfl(hw.y), bfh(hw.y)};
                            const f32x4 r_ = hv * ALPHA + acc[ai][bj][m][n] * (1.f / (ACT_SCALE * GATE_WSCALE)); v2u o; o.x = pk2(r_.x, r_.y); o.y = pk2(r_.z, r_.w); if (!dry) *(v2u*)(V2 + ro + bj * 128 + n * 16) = o; } } } }
    } };
typedef float f32x2v __attribute__((ext_vector_type(2)));
__device__ __forceinline__ float log_sigmoid_(float x) { return fminf(x, 0.f) - __builtin_amdgcn_logf(1.f + __builtin_amdgcn_exp2f(-fabsf(x) * LOG2E)) * 0.6931471805599453f; }
__device__ __forceinline__ void fox_cumsum(const Frame& F_, int bh, const float* FW, const float* bfor, float* bias2) { Frame F = F_; F.lane = lane_id_(); F.tid = F.wave * 64 + F.lane;
    const int b = bh >> 2, h = bh & 3; const float bf = bfor[h]; const float* src = FW + ((size_t)b * SEQ + F.lane * 64) * 8 + h; float tot = 0.f;
    for (int i = 0; i < 64; ++i) tot += log_sigmoid_(src[(size_t)i * 8] + bf);
    float inc = tot;
#pragma unroll
    for (int o = 1; o < 64; o <<= 1) { const float t = __int_as_float(shfl_i_(__float_as_int(inc), F.lane - o)); if (F.lane >= o) inc += t; }
    float run = inc - tot; float* dst = bias2 + (size_t)bh * SEQ + F.lane * 64;
    for (int i = 0; i < 64; ++i) { run += log_sigmoid_(src[(size_t)i * 8] + bf); dst[i] = -run * LOG2E; }
}
template <int WIN> __device__ __forceinline__ void pool_frags(bf16x8 (&af)[4], const bf16* src0, int tb) {
    const int nrow = tb + 1 < WIN ? tb + 1 : WIN; const float inv = 1.f / (float)nrow;
#pragma unroll
    for (int ks = 0; ks < 4; ++ks) { const bf16* src = src0 + ks * 16; v4u wv[WIN];
#pragma unroll
        for (int j = 0; j < WIN; ++j) wv[j] = *(const v4u*)(src - (size_t)(j <= tb ? j : 0) * PS);
        float s[8];
#pragma unroll
        for (int k = 0; k < 8; ++k) s[k] = 0.f;
#pragma unroll
        for (int j = 0; j < WIN; ++j) { if (j <= tb) { const v4u w = wv[j];
            s[0] += bfl(w.x); s[1] += bfh(w.x); s[2] += bfl(w.y); s[3] += bfh(w.y); s[4] += bfl(w.z); s[5] += bfh(w.z); s[6] += bfl(w.w); s[7] += bfh(w.w); } }
        const v4u cur = wv[0];
        const float c[8] = {bfl(cur.x), bfh(cur.x), bfl(cur.y), bfh(cur.y), bfl(cur.z), bfh(cur.z), bfl(cur.w), bfh(cur.w)};
        v4u o; o.x = pk2(s[0] * inv - c[0], s[1] * inv - c[1]); o.y = pk2(s[2] * inv - c[2], s[3] * inv - c[3]); o.z = pk2(s[4] * inv - c[4], s[5] * inv - c[5]); o.w = pk2(s[6] * inv - c[6], s[7] * inv - c[7]);
        af[ks] = __builtin_bit_cast(bf16x8, o); }
}
__device__ __forceinline__ void pool_unit(const Frame& F_, int tile, const bf16* P, const float* pw, const float* pscale, bf16* BR) { Frame F = F_; F.lane = lane_id_(); F.tid = F.wave * 64 + F.lane;
    const int g = F.wave & 3, th = F.wave >> 2, r32 = F.lane & 31, hi = F.lane >> 5;
    const int tok = tile * 64 + th * 32 + r32, tb = tok & (SEQ - 1);
    const bf16* src0 = P + (size_t)tok * PS + C_POOL + g * 64 + hi * 8;
    bf16x8 af[4];
    if (g == 0) pool_frags<2>(af, src0, tb); else if (g == 1) pool_frags<4>(af, src0, tb); else if (g == 2) pool_frags<8>(af, src0, tb); else pool_frags<16>(af, src0, tb);
#pragma unroll
    for (int db = 0; db < 2; ++db) { f32x16 acc = {};
#pragma unroll
        for (int ks = 0; ks < 4; ++ks) { const float* wp = pw + ((size_t)g * 64 + ks * 16 + hi * 8) * 64 + db * 32 + r32;
            v4u o; o.x = pk2(wp[0], wp[64]); o.y = pk2(wp[128], wp[192]); o.z = pk2(wp[256], wp[320]); o.w = pk2(wp[384], wp[448]);
            acc = __builtin_amdgcn_mfma_f32_32x32x16_bf16(af[ks], __builtin_bit_cast(bf16x8, o), acc, 0, 0, 0); }
        const int col = g * 64 + db * 32 + r32; const float sc = pscale[col];
#pragma unroll
        for (int r = 0; r < 16; ++r) { const int row = tile * 64 + th * 32 + (r & 3) + 8 * (r >> 2) + 4 * hi; { const float x_ = acc[r] * sc * BR_SCALE; ((unsigned char*)BR)[(size_t)row * DM + col] = (unsigned char)(__builtin_amdgcn_cvt_pk_fp8_f32(x_, x_, 0, false) & 0xff); } } }
}
__device__ __forceinline__ void conv_unit(const Frame& F_, int tile, const bf16* P, const float* dw, const float* cb, const float* lg, const float* lb, bf16* BR) { Frame F = F_; F.lane = lane_id_(); F.tid = F.wave * 64 + F.lane;
    LAS float* hb = (LAS float*)(F.lds + RING_OFF);
    LAS float* yb = hb + 62 * 256;
    const int t0 = tile * 32, tb0 = t0 & (SEQ - 1);
    { v4u av[4], gv[4];
#pragma unroll
      for (int k = 0; k < 4; ++k) { const int e = F.tid + k * NWAVES * 64, rr = e >> 5, c8 = (e & 31) * 8, trel = rr - 30; const bool ok = e < 62 * 32 && tb0 + trel >= 0;
          const bf16* src = P + (size_t)(t0 + (ok ? trel : 0)) * PS + C_CONV + c8; av[k] = *(const v4u*)src; gv[k] = *(const v4u*)(src + 256); }
#pragma unroll
      for (int k = 0; k < 4; ++k) { const int e = F.tid + k * NWAVES * 64, rr = e >> 5, c8 = (e & 31) * 8, trel = rr - 30; const bool ok = tb0 + trel >= 0; const v4u a = av[k], gt = gv[k]; float h[8];
          h[0] = bfl(a.x) * sigmoidf_(bfl(gt.x)); h[1] = bfh(a.x) * sigmoidf_(bfh(gt.x)); h[2] = bfl(a.y) * sigmoidf_(bfl(gt.y)); h[3] = bfh(a.y) * sigmoidf_(bfh(gt.y));
          h[4] = bfl(a.z) * sigmoidf_(bfl(gt.z)); h[5] = bfh(a.z) * sigmoidf_(bfh(gt.z)); h[6] = bfl(a.w) * sigmoidf_(bfl(gt.w)); h[7] = bfh(a.w) * sigmoidf_(bfh(gt.w));
          if (!ok) {
#pragma unroll
              for (int q = 0; q < 8; ++q) h[q] = 0.f; }
          if (e < 62 * 32) { *(LAS f32x4*)(hb + rr * 256 + c8) = (f32x4){h[0], h[1], h[2], h[3]}; *(LAS f32x4*)(hb + rr * 256 + c8 + 4) = (f32x4){h[4], h[5], h[6], h[7]}; } } }
    __syncthreads();
    { const int c = F.tid & 255, hf = F.tid >> 8; float w[31];
#pragma unroll
      for (int j = 0; j < 31; ++j) w[j] = dw[j * 256 + c];
      const float bias = cb[c];
#pragma unroll 1
      for (int q4 = 0; q4 < 4; ++q4) { const int tt = hf * 16 + q4 * 4; float x[34];
#pragma unroll
          for (int j = 0; j < 34; ++j) x[j] = hb[(tt + j) * 256 + c];
#pragma unroll
          for (int o = 0; o < 4; ++o) { float a = bias;
#pragma unroll
              for (int j = 0; j < 31; ++j) a += x[o + j] * w[j];
              yb[(tt + o) * 256 + c] = a; } } }
    __syncthreads();
#pragma unroll 1
    for (int q = 0; q < 4; ++q) { const int tt = F.wave * 4 + q; const f32x4 v = *(const LAS f32x4*)(yb + tt * 256 + F.lane * 4);
        const float mean = wave_sum((v.x + v.y) + (v.z + v.w)) * (1.f / 256.f); const f32x4 d = v - mean;
        const float var = wave_sum((d.x * d.x + d.y * d.y) + (d.z * d.z + d.w * d.w)) * (1.f / 256.f); const float rstd = 1.f / sqrtf(var + LN_EPS);
        const f32x4 gg = *(const f32x4*)(lg + F.lane * 4), bb = *(const f32x4*)(lb + F.lane * 4); const f32x4 y = d * rstd * gg + bb;
        *(unsigned*)((unsigned char*)BR + (size_t)(t0 + tt) * DM + 768 + F.lane * 4) = pk4_fp8(y.x * sigmoidf_(y.x) * BR_SCALE, y.y * sigmoidf_(y.y) * BR_SCALE, y.z * sigmoidf_(y.z) * BR_SCALE, y.w * sigmoidf_(y.w) * BR_SCALE); }
    __syncthreads();
}
__device__ __forceinline__ int key28_(float s) { const int u = (int)__float_as_uint(s); int m = (u & 0x7fffffff) - 0x3B000000; m = m < 0 ? 0 : (m > 0x07FFFFFF ? 0x07FFFFFF : m); return 0x08000000 + (m ^ (u >> 31)); }
__device__ __forceinline__ int key16_(float s) { const int u = (int)__float_as_uint(s); int m = (int)(((unsigned)u >> 12) & 0x7ffffu) - 0x3B000; m = m < 0 ? 0 : (m > 0x7FFF ? 0x7FFF : m); return 0x8000 + (m ^ (u >> 31)); }
__device__ __forceinline__ int key9_(float s) { const int u = (int)__float_as_uint(s); int m = ((u >> 19) & 0xfff) - 0x760; m = m < 0 ? 0 : (m > 255 ? 255 : m); return 256 + (m ^ (u >> 31)); }
__device__ __forceinline__ float key28_lbound(long long kv) {
    if (kv <= 0) return -INFINITY; if (kv > 0x0FFFFFFFll) return INFINITY;
    if (kv > 0x08000000ll) return __uint_as_float((unsigned)(0x3B000000ll + (kv - 0x08000000ll)));
    if (kv == 0x08000000ll) return 0.f;
    return -__uint_as_float((unsigned)(0x3B000000ll + (0x07FFFFFFll - kv)));
}
constexpr int DS_HIST = 0, DS_GT = 65536, DS_EQ = 81920, DS_KT = 98304, DS_SM = LDSCTL_OFF + 1024 - RING_OFF, DS_CAP = 512;
typedef float f32x2p __attribute__((ext_vector_type(2)));
__device__ __forceinline__ float relu_(float x) { const int b = (int)__float_as_uint(x); return __uint_as_float((unsigned)(b > 0 ? b : 0)); }
__device__ __forceinline__ void dsa_ldk(bf16x8 (&kf)[4], const bf16* kp) {
#pragma unroll
    for (int m = 0; m < 4; ++m) kf[m] = *(const bf16x8*)(kp + m * 512);
}
__device__ __forceinline__ void dsa_kfrag(bf16x8 (&kf)[4], const bf16x8 (&raw)[4], LAS unsigned char* kt, int lane) {
    const int rw = lane >> 3, cw = lane & 7, r32 = lane & 31, hi = lane >> 5;
#pragma unroll
    for (int m = 0; m < 4; ++m) *(LAS bf16x8*)(kt + (8 * m + rw) * 128 + ((cw ^ rw) << 4)) = raw[m];
#pragma unroll
    for (int ks = 0; ks < 4; ++ks) kf[ks] = *(const LAS bf16x8*)(kt + r32 * 128 + (((2 * ks + hi) ^ (r32 & 7)) << 4));
}
__device__ __forceinline__ void dsa_scores(const bf16x8 (&qf)[4][4], const bf16x8 (&kf)[4], const float (&w)[4], float (&sc)[16]) {
    f32x16 a[4];
#pragma unroll
    for (int hh = 0; hh < 4; ++hh) { a[hh] = (f32x16){};
#pragma unroll
        for (int ks = 0; ks < 4; ++ks) a[hh] = __builtin_amdgcn_mfma_f32_32x32x16_bf16(kf[ks], qf[hh][ks], a[hh], 0, 0, 0); }
#pragma unroll
    for (int r = 0; r < 16; r += 2) { f32x2p s2 = (f32x2p){relu_(a[0][r]), relu_(a[0][r + 1])} * w[0];
#pragma unroll
        for (int hh = 1; hh < 4; ++hh) s2 = (f32x2p){relu_(a[hh][r]), relu_(a[hh][r + 1])} * w[hh] + s2;
        sc[r] = s2.x + 0.f; sc[r + 1] = s2.y + 0.f; }
}
template <int NB4> __device__ __forceinline__ void hist_scan(const LAS unsigned* h, int K, int lane, int& bin, int& above, int& inbin, int* total = nullptr) {
    unsigned hv[NB4 * 4]; int s = 0;
#pragma unroll
    for (int g = 0; g < NB4; ++g) { const v4u t = *(const LAS v4u*)(h + NB4 * 4 * lane + 4 * g); hv[4 * g] = t.x; hv[4 * g + 1] = t.y; hv[4 * g + 2] = t.z; hv[4 * g + 3] = t.w; s += (int)(t.x + t.y + t.z + t.w); }
    int suf = s;
#pragma unroll
    for (int o = 1; o < 64; o <<= 1) { const int t = shfl_i_(suf, lane + o); if (lane + o < 64) suf += t; }
    if (total) *total = __builtin_amdgcn_readfirstlane(suf);
    const int excl = suf - s; const bool hit = (excl < K) && (K <= suf);
    int b = 0, c = excl, nb = 0; bool done = false;
#pragma unroll
    for (int k = NB4 * 4 - 1; k >= 0; --k) { if (!done) { if (c + (int)hv[k] >= K) { b = k; nb = (int)hv[k]; done = true; } else c += (int)hv[k]; } }
    const unsigned long long m = __ballot(hit); const int src = m ? (int)__builtin_ctzll(m) : 0;
    bin = __builtin_amdgcn_readlane(NB4 * 4 * lane + b, src); above = __builtin_amdgcn_readlane(c, src); inbin = __builtin_amdgcn_readlane(nb, src);
    if (!m) { bin = 0; above = 0; inbin = 0; }
}
#define DSA_ONE_TILE(KF, I, ...) do { const int i = (I); float sc[16]; { bf16x8 kfr[4]; dsa_kfrag(kfr, KF, ktile, F.lane); dsa_scores(qf, kfr, w, sc); } \
        if (i == j) { constexpr bool DIAG = true; __VA_ARGS__ } else { constexpr bool DIAG = false; __VA_ARGS__ } } while (0)
#define DSA_TILE_LOOP_S(STRIDE, ...) do { bf16x8 ka[4], kb[4]; int i0 = F.wave; \
    { const int ia = i0 <= j ? i0 : 0, ib = i0 + (STRIDE) <= j ? i0 + (STRIDE) : ia; dsa_ldk(ka, kbase + (size_t)ia * 32 * 64); dsa_ldk(kb, kbase + (size_t)ib * 32 * 64); } \
    _Pragma("unroll 1") for (; i0 <= j; i0 += 2 * (STRIDE)) { bf16x8 na[4], nb[4]; \
        { const int ia = i0 + 2 * (STRIDE) <= j ? i0 + 2 * (STRIDE) : i0, ib = i0 + 3 * (STRIDE) <= j ? i0 + 3 * (STRIDE) : i0; dsa_ldk(na, kbase + (size_t)ia * 32 * 64); dsa_ldk(nb, kbase + (size_t)ib * 32 * 64); } \
        __builtin_amdgcn_sched_barrier(0); \
        DSA_ONE_TILE(ka, i0, __VA_ARGS__); \
        if (i0 + (STRIDE) <= j) DSA_ONE_TILE(kb, i0 + (STRIDE), __VA_ARGS__); \
        _Pragma("unroll") for (int ks = 0; ks < 4; ++ks) { ka[ks] = na[ks]; kb[ks] = nb[ks]; } } } while (0)
#define DSA_TILE_LOOP(...) DSA_TILE_LOOP_S(NWAVES, __VA_ARGS__)
#define DSA_VALID(r) (!DIAG || ((r) & 3) + 8 * ((r) >> 2) <= qlim)
__device__ __forceinline__ void dsa_mask_unit(const Frame& F_, int b, int j, const bf16* P, const bf16* KIDX, const float* FW, unsigned long long* selw, unsigned char* dk  ) { Frame F = F_; F.lane = lane_id_(); F.tid = F.wave * 64 + F.lane;
    LAS unsigned* HIST = (LAS unsigned*)(F.lds + RING_OFF + DS_HIST);
    LAS unsigned* GT = (LAS unsigned*)(F.lds + RING_OFF + DS_GT);
    LAS unsigned* EQ = (LAS unsigned*)(F.lds + RING_OFF + DS_EQ);
    LAS int* SM = (LAS int*)(F.lds + RING_OFF + DS_SM); volatile LAS unsigned* PRB = (volatile LAS unsigned*)(F.lds + LDSCTL_OFF + 512);
    PROBE_BEGIN(1);
    const int r32 = F.lane & 31, hi = F.lane >> 5, t0 = j * 32; const size_t brow = (size_t)b * SEQ;
    bf16x8 qf[4][4];
#pragma unroll
    for (int hh = 0; hh < 4; ++hh)
#pragma unroll
        for (int ks = 0; ks < 4; ++ks) qf[hh][ks] = *(const bf16x8*)(P + (brow + t0 + r32) * PS + C_IQ + hh * 64 + ks * 16 + hi * 8);
    float w[4]; { const f32x4 wv = *(const f32x4*)(FW + (brow + t0 + r32) * 8 + 4); w[0] = wv.x; w[1] = wv.y; w[2] = wv.z; w[3] = wv.w; }
    const bf16* kbase = KIDX + brow * 64 + F.lane * 8;
    LAS unsigned char* ktile = F.lds + RING_OFF + DS_KT + F.wave * 4096;
    const int qlim = r32 - 4 * hi;
    LAS unsigned* hrow = HIST + r32 * 512;
#define DSA_ZERO_HIST() do { const unsigned z_ = (unsigned)opaque_i(0); for (int e = F.tid; e < 4096; e += NWAVES * 64) ((LAS v4u*)HIST)[e] = (v4u){z_, z_, z_, z_}; } while (0)
    DSA_ZERO_HIST();
    if (F.tid < 64) SM[128 + F.tid] = 0;
    __syncthreads();
    PROBE_END(1); PROBE_BEGIN(2);
#if REP_PHASE == 41
    { float dummy = 0.f; DSA_TILE_LOOP({ _Pragma("unroll") for (int r = 0; r < 16; ++r) dummy += sc[r]; }); if (dummy == 12345.678f) SM[170] = 1; }
#endif
#if REP_PHASE == 42
    { LAS unsigned* drow = EQ + (r32 & 7) * 512; DSA_TILE_LOOP({ _Pragma("unroll") for (int r = 0; r < 16; ++r) { const int kh = key28_(sc[r]) >> 19; if (DSA_VALID(r)) __hip_atomic_fetch_add(drow + kh, 1u, __ATOMIC_RELAXED, __HIP_MEMORY_SCOPE_WORKGROUP); } }); }
#endif
#if REP_PHASE == 43
    { DSA_ZERO_HIST(); __syncthreads(); for (int q = F.wave * 4; q < F.wave * 4 + 4; ++q) { int bin, above, inbin; hist_scan<2>(HIST + q * 512, 256, F.lane, bin, above, inbin); if (F.lane == 0) SM[171] = bin; } __syncthreads(); __syncthreads(); __syncthreads(); }
#endif
    unsigned char* dkw = dk + (size_t)(F.wave * 16) * 2048 + F.lane * 32;
    DSA_TILE_LOOP({ unsigned kw[8]; _Pragma("unroll")
        for (int r = 0; r < 16; ++r) { const int k16 = key16_(sc[r]); if (DSA_VALID(r)) __hip_atomic_fetch_add(hrow + (k16 >> 7), 1u, __ATOMIC_RELAXED, __HIP_MEMORY_SCOPE_WORKGROUP);
            if (r & 1) kw[r >> 1] |= (unsigned)k16 << 16; else kw[r >> 1] = (unsigned)k16; }
        v4u* kd = (v4u*)(dkw + (size_t)(i >> 3) * 2048); kd[0] = (v4u){kw[0], kw[1], kw[2], kw[3]}; kd[1] = (v4u){kw[4], kw[5], kw[6], kw[7]}; });
    __syncthreads();
    PROBE_END(2); PROBE_BEGIN(3);
#pragma unroll 1
    for (int q = F.wave * 4; q < F.wave * 4 + 4; ++q) { int bin, above, inbin; hist_scan<2>(HIST + q * 512, 256, F.lane, bin, above, inbin);
        if (F.lane == 0) { const int total = t0 + q + 1;
            if (total <= 256) { SM[q] = -1; SM[32 + q] = 0; SM[64 + q] = 0; SM[96 + q] = 0; }
            else { SM[q] = bin; SM[32 + q] = above; SM[64 + q] = inbin; SM[96 + q] = 256 - above; if (inbin > DS_CAP) SM[160] = 1; } } }
    __syncthreads();
    PROBE_END(3); PROBE_BEGIN(4);
    const int myb1 = SM[r32];
    if (SM[160] == 0) {
        const int tge = myb1 << 7, tgt = (myb1 + 1) << 7;
        LAS unsigned* lrow = HIST + r32 * DS_CAP;
        { v4u ca = (v4u){0u, 0u, 0u, 0u}, cb = ca; if (F.wave <= j) { const v4u* kd = (const v4u*)dkw; ca = kd[0]; cb = kd[1]; }
#pragma unroll 1
          for (int i = F.wave; i <= j; i += NWAVES) { const int inx = i + NWAVES <= j ? i + NWAVES : i; const v4u* kn = (const v4u*)(dkw + (size_t)(inx >> 3) * 2048); const v4u na = kn[0], nb = kn[1];
            const unsigned kw[8] = {ca.x, ca.y, ca.z, ca.w, cb.x, cb.y, cb.z, cb.w}; const bool diag = (i == j);
            unsigned gtw = 0u; unsigned cw = 0u;
#pragma unroll
            for (int r = 0; r < 16; ++r) { const int bit = (r & 3) + 8 * (r >> 2); const bool valid = !diag || bit <= qlim; const int k = (r & 1) ? (int)(kw[r >> 1] >> 16) : (int)(kw[r >> 1] & 0xffffu);
                if (valid && k >= tgt) gtw |= 1u << bit; else if (valid && k >= tge) cw |= 1u << r; }
            if (cw) {
                LAS unsigned* sl = (LAS unsigned*)ktile + F.lane;
#pragma unroll
                for (int d = 0; d < 8; ++d) sl[d * 64] = kw[d];
                int slot = (int)__hip_atomic_fetch_add((LAS unsigned*)SM + 128 + r32, (unsigned)__popc(cw), __ATOMIC_RELAXED, __HIP_MEMORY_SCOPE_WORKGROUP);
                while (cw) { const int r = __builtin_ctz(cw); cw &= cw - 1u; const unsigned kv = (sl[(r >> 1) * 64] >> (16 * (r & 1))) & 0xffffu; const int bit = (r & 3) + 8 * (r >> 2);
                    if (slot < DS_CAP) lrow[slot] = ((kv & 0x7Fu) << 12) | (unsigned)(4095 - (i * 32 + bit + 4 * hi)); ++slot; } }
            gtw <<= 4 * hi; gtw |= (unsigned)shfl_i_((int)gtw, F.lane ^ 32);
            if (hi == 0) GT[i * 32 + r32] = gtw;
            ca = na; cb = nb; } }
        __syncthreads();
        PROBE_END(4); PROBE_BEGIN(5);
#pragma unroll 1
        for (int q = F.wave * 4; q < F.wave * 4 + 4; ++q) { const int n = SM[128 + q] < DS_CAP ? SM[128 + q] : DS_CAP, quota = SM[96 + q]; const LAS unsigned* lq = HIST + q * DS_CAP;
            for (int c0 = 0; c0 < n; c0 += 64) { const int ci = c0 + F.lane; const unsigned e = ci < n ? lq[ci] : 0xffffffffu; int rank = 0;
                int k = 0;
                for (; k + 16 <= n; k += 16) { const v4u c0 = *(const LAS v4u*)(lq + k), c1 = *(const LAS v4u*)(lq + k + 4), c2 = *(const LAS v4u*)(lq + k + 8), c3 = *(const LAS v4u*)(lq + k + 12);
                    rank += (c0.x > e ? 1 : 0) + (c0.y > e ? 1 : 0) + (c0.z > e ? 1 : 0) + (c0.w > e ? 1 : 0) + (c1.x > e ? 1 : 0) + (c1.y > e ? 1 : 0) + (c1.z > e ? 1 : 0) + (c1.w > e ? 1 : 0)
                          + (c2.x > e ? 1 : 0) + (c2.y > e ? 1 : 0) + (c2.z > e ? 1 : 0) + (c2.w > e ? 1 : 0) + (c3.x > e ? 1 : 0) + (c3.y > e ? 1 : 0) + (c3.z > e ? 1 : 0) + (c3.w > e ? 1 : 0); }
                for (; k < n; ++k) rank += (lq[k] > e) ? 1 : 0;
                if (ci < n && rank < quota) { const int idx = 4095 - (int)(e & 4095u); __hip_atomic_fetch_or(GT + (idx >> 5) * 32 + q, 1u << (idx & 31), __ATOMIC_RELAXED, __HIP_MEMORY_SCOPE_WORKGROUP); } } }
        __syncthreads();
    } else {
        DSA_ZERO_HIST();
        __syncthreads();
        DSA_TILE_LOOP({ _Pragma("unroll")
            for (int r = 0; r < 16; ++r) { const int k = key28_(sc[r]); if ((k >> 19) == myb1 && DSA_VALID(r)) __hip_atomic_fetch_add(hrow + ((k >> 11) & 255), 1u, __ATOMIC_RELAXED, __HIP_MEMORY_SCOPE_WORKGROUP); } });
        __syncthreads();
#pragma unroll 1
        for (int q = F.wave * 4; q < F.wave * 4 + 4; ++q) { int bin, above, inbin; const int b1 = SM[q], ab1 = SM[32 + q]; hist_scan<1>(HIST + q * 512, 256 - ab1, F.lane, bin, above, inbin);
            if (F.lane == 0) { if (b1 < 0) { SM[192 + q] = -1; SM[96 + q] = 0; SM[224 + q] = 0; }
                else { const int quota = 256 - (ab1 + above); SM[192 + q] = (b1 << 8) | bin; SM[96 + q] = quota; SM[224 + q] = inbin; if (quota < inbin) SM[161] = 1; } } }
        __syncthreads();
        const int thr = SM[192 + r32]; const bool allacc = SM[96 + r32] >= SM[224 + r32];
        const float lge = key28_lbound((long long)thr << 11), lgt = key28_lbound(((long long)thr + 1) << 11);
        DSA_TILE_LOOP({ unsigned gtw = 0u; unsigned gew = 0u; _Pragma("unroll")
            for (int r = 0; r < 16; ++r) { const int bit = (r & 3) + 8 * (r >> 2); const bool valid = DSA_VALID(r);
                if (valid && sc[r] >= lgt) gtw |= 1u << bit; if (valid && sc[r] >= lge) gew |= 1u << bit; }
            gtw <<= 4 * hi; gew <<= 4 * hi;
            gtw |= (unsigned)shfl_i_((int)gtw, F.lane ^ 32); gew |= (unsigned)shfl_i_((int)gew, F.lane ^ 32);
            unsigned eqw = gew & ~gtw;
            if (allacc) { gtw = gew; eqw = 0u; }
            if (hi == 0) GT[i * 32 + r32] = gtw; else EQ[i * 32 + r32] = eqw; });
        __syncthreads();
        if (SM[161] != 0 && F.tid < 32) { const int q = F.tid; const int quota = SM[96 + q]; if (quota < SM[224 + q]) { int run = 0;
                for (int i = 0; i <= j; ++i) { unsigned e = EQ[i * 32 + q]; if (e) { const int allowed = quota - run; if (allowed <= 0) e = 0u; else { int pc = __popc(e); while (pc > allowed) { e &= ~(0x80000000u >> __clz(e)); --pc; } }
                        run += __popc(e); GT[i * 32 + q] |= e; } } } }
        __syncthreads();
    }
    PROBE_END(5); PROBE_BEGIN(6);
    { const int ntile64 = 4 * (j / 8 + 1); unsigned long long* dst = selw + (size_t)b * 64 * SEQ + t0;
      for (int e = F.tid; e < ntile64 * 32; e += NWAVES * 64) { const int T = e >> 5, q = e & 31; const unsigned lo = (2 * T <= j) ? GT[(2 * T) * 32 + q] : 0u, up = (2 * T + 1 <= j) ? GT[(2 * T + 1) * 32 + q] : 0u;
          dst[(size_t)T * SEQ + q] = ((unsigned long long)up << 32) | lo; } }
    __syncthreads();
    PROBE_END(6);
}
#undef DSA_TILE_LOOP
#undef DSA_ZERO_HIST
#undef DSA_TILE_LOOP_S
#undef DSA_ONE_TILE
#undef DSA_VALID
__device__ __forceinline__ void ln1_router_phase(const Frame& F_, const Args& a, int l, bool dry = false) { Frame F = F_; F.lane = lane_id_(); F.tid = F.wave * 64 + F.lane;
    LAS float* RW = (LAS float*)(F.lds + RING_OFF);
    LAS int* LC = (LAS int*)(F.lds + RING_OFF + 81920);
    LAS int* LTOK = LC + 64;
    LAS int* LCLS = LTOK + 128; LAS int* LPOS = LCLS + 128; LAS float* LGA = (LAS float*)(LPOS + 128); LAS float* LGB = LGA + 128;
    volatile LAS unsigned* PRB = (volatile LAS unsigned*)(F.lds + LDSCTL_OFF + 512);
    PROBE_BEGIN(31);
    const float* rg = a.in[16] + (size_t)l * DM * 4; const float* re = a.in[18] + (size_t)l * DM * 16;
    for (int e = F.tid; e < DM * 4; e += NWAVES * 64) { const int k = e >> 2, c = e & 3, ln = (k & 255) >> 2, kidx = (k >> 8) * 4 + (k & 3); RW[((kidx * 5 + 0) * 64 + ln) * 4 + c] = rg[e]; }
    for (int e = F.tid; e < DM * 16; e += NWAVES * 64) { const int k = e >> 4, c = 4 + (e & 15), ln = (k & 255) >> 2, kidx = (k >> 8) * 4 + (k & 3); RW[((kidx * 5 + (c >> 2)) * 64 + ln) * 4 + (c & 3)] = re[e]; }
    if (F.tid < 64) LC[F.tid] = 0;
    __syncthreads();
    PROBE_END(31); PROBE_BEGIN(32);
    const float* rgb = a.in[17] + l * 4; const float* reb = a.in[19] + l * 16;
    const float* g1 = a.in[14] + (size_t)l * DM; const float* b1 = a.in[15] + (size_t)l * DM;
    int* list = (int*)(F.ws + WS_LIST); float* gwl = (float*)(F.ws + WS_GWL);
    const int rows_per_blk = NTOK / F.G;
    LnGB gb; ln_gb_load(F, g1, b1, gb);
    float rb[20];
#pragma unroll
    for (int c = 0; c < 4; ++c) rb[c] = rgb[c];
#pragma unroll
    for (int c = 0; c < 16; ++c) rb[4 + c] = reb[c];
    const bf16* V1 = wsb(F, WS_R2);
    f32x4 nx[4]; ln_load_bf(F, V1 + (size_t)(F.vcu * rows_per_blk + F.wave) * DM, nx);
    for (int rr = F.wave; rr < rows_per_blk; rr += NWAVES) { const int m = F.vcu * rows_per_blk + rr; f32x4 v[4];
#pragma unroll
        for (int j = 0; j < 4; ++j) v[j] = nx[j];
        if (rr + NWAVES < rows_per_blk) ln_load_bf(F, V1 + (size_t)(m + NWAVES) * DM, nx);
        ln_row(F, gb, nullptr, wsb(F, WS_HB) + (size_t)m * DM, v, dry, F.ws + WS_HB8 + (size_t)m * DM);
        float gl[4] = {0.f, 0.f, 0.f, 0.f};
#pragma unroll
        for (int jj = 0; jj < 4; ++jj)
#pragma unroll
            for (int k = 0; k < 4; ++k) { const f32x4 wv = *(const LAS f32x4*)(RW + (((jj * 4 + k) * 5) * 64 + F.lane) * 4); const float xv = v[jj][k];
                gl[0] += xv * wv.x; gl[1] += xv * wv.y; gl[2] += xv * wv.z; gl[3] += xv * wv.w; }
        int gi = 0; float gm;
#pragma unroll
        for (int c = 0; c < 4; ++c) gl[c] = wave_sum(gl[c]) + rb[c];
        gm = gl[0];
#pragma unroll
        for (int c = 1; c < 4; ++c) if (gl[c] > gm) { gm = gl[c]; gi = c; }
        float gs = 0.f;
#pragma unroll
        for (int c = 0; c < 4; ++c) gs += expf(gl[c] - gm);
        const float pg = 1.f / gs;
        float el[4] = {0.f, 0.f, 0.f, 0.f};
        { const LAS float* wg = RW + ((1 + gi) * 64 + F.lane) * 4;
#pragma unroll
          for (int jj = 0; jj < 4; ++jj)
#pragma unroll
            for (int k = 0; k < 4; ++k) { const f32x4 wv = *(const LAS f32x4*)(wg + ((jj * 4 + k) * 5) * 256); const float xv = v[jj][k];
                el[0] += xv * wv.x; el[1] += xv * wv.y; el[2] += xv * wv.z; el[3] += xv * wv.w; } }
#pragma unroll
        for (int c = 0; c < 4; ++c) { float bsel = rb[4 + c];
#pragma unroll
            for (int g = 1; g < 4; ++g) if (gi == g) bsel = rb[4 + 4 * g + c];
            el[c] = wave_sum(el[c]) + bsel; }
        int i1 = 0; float m1 = el[0];
#pragma unroll
        for (int c = 1; c < 4; ++c) if (el[c] > m1) { m1 = el[c]; i1 = c; }
        int i2 = -1; float m2 = -INFINITY;
#pragma unroll
        for (int c = 0; c < 4; ++c) if (c != i1 && el[c] > m2) { m2 = el[c]; i2 = c; }
        const float e2 = expf(m2 - m1); const float p1 = 1.f / (1.f + e2), p2 = e2 / (1.f + e2);
        const int ia = i1 < i2 ? i1 : i2, ib = i1 < i2 ? i2 : i1; const float ga = pg * (i1 < i2 ? p1 : p2), gb = pg * (i1 < i2 ? p2 : p1);
        const int pidx = ia == 0 ? ib - 1 : (ia == 1 ? ib + 1 : 5); const int cls = gi * 6 + pidx;
        if (F.lane == 0) { const int pos = __hip_atomic_fetch_add(&LC[cls], 1, __ATOMIC_RELAXED, __HIP_MEMORY_SCOPE_WORKGROUP); LTOK[rr] = m; LCLS[rr] = cls; LPOS[rr] = pos; LGA[rr] = ga; LGB[rr] = gb; }
    }
    __syncthreads();
    PROBE_END(32);
    if (dry) return;
    PROBE_BEGIN(33);
    if (F.tid < NCLS) { const int n = LC[F.tid]; LC[32 + F.tid] = n ? (int)atomicAdd((unsigned*)(F.ctl + CW_CNT + (l * NCLS + F.tid) * 64), (unsigned)n) : 0; }
    __syncthreads();
    for (int rr = F.tid; rr < rows_per_blk; rr += NWAVES * 64) { const int cls = LCLS[rr], pos = LC[32 + cls] + LPOS[rr];
        list[(size_t)cls * NTOK + pos] = LTOK[rr]; gwl[((size_t)cls * NTOK + pos) * 2] = LGA[rr]; gwl[((size_t)cls * NTOK + pos) * 2 + 1] = LGB[rr]; }
    __syncthreads();
    PROBE_END(33);
}
__device__ __forceinline__ void ln2_phase(const Frame& F_, const Args& a, int l, bool dry = false) { Frame F = F_; F.lane = lane_id_(); F.tid = F.wave * 64 + F.lane;
    const float* g2 = a.in[23] + (size_t)l * DM; const float* b2 = a.in[24] + (size_t)l * DM; const bf16* V2 = wsb(F, WS_R1); const bool last = (l == DEPTH - 1);
    const int gw = F.vcu * NWAVES + F.wave, NGW = F.G * NWAVES;
    LnGB gb; ln_gb_load(F, g2, b2, gb);
    f32x4 nx[4]; ln_load_bf(F, V2 + (size_t)gw * DM, nx);
    for (int m = gw; m < NTOK; m += NGW) { f32x4 v[4];
#pragma unroll
        for (int j = 0; j < 4; ++j) v[j] = nx[j];
        if (m + NGW < NTOK) ln_load_bf(F, V2 + (size_t)(m + NGW) * DM, nx);
        ln_row(F, gb, last ? F.out + (size_t)m * DM : nullptr, wsb(F, WS_HB) + (size_t)m * DM, v, dry, last ? nullptr : F.ws + WS_HB8 + (size_t)m * DM); }
}
__device__ __forceinline__ void moe_table(const Frame& F, int l, LAS int* tab) {
    const int tid = F.wave * 64 + lane_id_();
    if (tid < NCLS) tab[tid] = (int)__hip_atomic_load(F.ctl + CW_CNT + (l * NCLS + tid) * 64, RLX_AGENT);
    __syncthreads();
    if (tid == 0) { int s = 0; for (int c = 0; c < NCLS; ++c) { tab[32 + c] = s; s += (tab[c] + 255) >> 8; } tab[32 + NCLS] = s; tab[57] = s; }
    __syncthreads();
}
#define NREP(k) (((REP_PHASE) == (k) || ((k) == 4 && ((REP_PHASE) == 60 || (REP_PHASE) == 61))) ? 2 : 1)
#define DRY(k) ((REP_PHASE) == (k) && rep_ == 0 && args.ph_hi != 7777)
#ifndef MK_PER_PHASE
#define MK_PER_PHASE 0
#endif
constexpr int PH_PER_LAYER = 9, N_PHASES = 1 + DEPTH * PH_PER_LAYER;
__global__ void __launch_bounds__(NWAVES * 64, 2) fwd_kernel(Args args) {
    extern __shared__ __attribute__((aligned(16))) unsigned char lds[];
    Frame F0; Frame& F = F0;
    F.lds = (LAS unsigned char*)lds; F.ldsg = lds;
    F.MISC = (volatile LAS unsigned*)(F.lds + MISC_OFF);
    F.wave = __builtin_amdgcn_readfirstlane((int)threadIdx.x >> 6); F.lane = lane_id_(); F.tid = F.wave * 64 + F.lane;
    F.G = gridDim.x; { const int bx = blockIdx.x; F.vcu = (F.G % 8 == 0) ? (bx % 8) * (F.G / 8) + bx / 8 : bx; }
    F.ws = args.ws; F.out = args.out; F.ctl = (gu32*)(args.ws + WS_CTL);
    for (int u = F0.tid; u < (LDS_BYTES - LDSCTL_OFF) / 4; u += NWAVES * 64) ((LAS unsigned*)(F.lds + LDSCTL_OFF))[u] = 0u;
    __syncthreads();
    XcdBarrier bar; bar.bar = (unsigned*)(F.ctl + CW_BAR); bar.x = 0; bar.st = nullptr;
    if (!MK_PER_PHASE) bar = xcd_barrier_post((unsigned*)(F.ctl + CW_BAR), F.MISC + 8);
    const int lo = MK_PER_PHASE ? args.ph_lo : 0, hi = MK_PER_PHASE ? args.ph_hi : N_PHASES;
#define IN(k) (lo <= (k) && (k) < hi)
#ifndef PH_ONLY
#define PH_ONLY -1
#endif
#define EN(k) (PH_ONLY < 0 || PH_ONLY == (k))
#define SEAM(k) do { if (IN(k) && IN((k) + 1)) { PROBE_BEGIN(20); xcd_barrier(bar, F0.wave); PROBE_END(20); } } while (0)
    volatile LAS unsigned* PRB = (volatile LAS unsigned*)(F0.lds + LDSCTL_OFF + 512);
    LAS int* TAB = (LAS int*)(F.lds + LDSCTL_OFF + 64);
    bf16* const HB = wsb(F, WS_HB); bf16* const P = wsb(F, WS_R1); bf16* const MIX = wsb(F, WS_R1); bf16* const BR = wsb(F, WS_R2); bf16* const ACT = wsb(F, WS_R2);
    float* const FW = (float*)(F.ws + WS_FW); float* const BIAS2 = (float*)(F.ws + WS_BIAS2); unsigned long long* const SELW = (unsigned long long*)(F.ws + WS_SELW);

#define FRESH(Fn) Frame Fn = F0; Fn.vcu = opaque_s(F0.vcu); Fn.wave = opaque_s(F0.wave); Fn.lane = lane_id_(); Fn.tid = Fn.wave * 64 + Fn.lane
    for (int rep_ = 0; rep_ < ((REP_PHASE) == 10 ? 2 : 1); ++rep_) if (EN(0) && IN(0)) { FRESH(Fp); p0_prologue(Fp, args); }
    SEAM(0);
#pragma unroll 1
    for (int l0 = 0; l0 < DEPTH; ++l0) {
        const int pb = 1 + PH_PER_LAYER * l0;
#define l opaque_s(l0)
#define W (wsb(F, WS_W + (size_t)l * W_LAYER))
        for (int rep_ = 0; rep_ < NREP(1); ++rep_) if (EN(1) && IN(pb)) {
            constexpr unsigned M8 = A_F8_TILES; unsigned map8 = 0, map16 = 0; int n8 = 0, n16 = 0;
            for (int q = 0; q < 9; ++q) { if ((M8 >> q) & 1) { map8 |= (unsigned)q << (4 * n8); ++n8; } else { map16 |= (unsigned)q << (4 * n16); ++n16; } }
            const int bx_ = opaque_s((int)blockIdx.x);
            if (n8 > 0) { SchedAT<true> S; S.T.init(NTOK / 256, n8, F.G, bx_); S.A = (const char*)(F.ws + WS_HB8); S.B = (const char*)W + W_SM8; S.map = map8;
                EpiAT<true> E{P, FW, wsb(F, WS_KIDX)}; pg8::gemm_phase<EpiAT<true>, SchedAT<true>, false>(F.lds + RING_OFF, (LAS unsigned*)(F.lds + LDSCTL_OFF + 1024), F0.wave, S, E); }
            if (n16 > 0) { SchedAT<false> S; S.T.init(NTOK / 256, n16, F.G, (bx_ + F.G - ((NTOK / 256) * n8) % F.G) % F.G);
                S.A = (const char*)HB; S.B = (const char*)(W + W_SM / 2); S.map = map16;
                EpiAT<false> E{P, FW, wsb(F, WS_KIDX)}; pg8::gemm_phase<EpiAT<false>, SchedAT<false>, false>(F.lds + RING_OFF, (LAS unsigned*)(F.lds + LDSCTL_OFF + 1024), F0.wave, S, E); } }
        SEAM(pb);
        for (int rep_ = 0; rep_ < NREP(2); ++rep_) if (EN(2) && IN(pb + 1)) { FRESH(Fp);
#ifndef NO_CUMSUM
            if (Fp.vcu < 32 && Fp.wave == 0) fox_cumsum(Fp, Fp.vcu, FW, args.in[4] + l * 4, BIAS2);
#endif
#ifndef NO_POOL
            for (int rp_ = 0; rp_ < ((REP_PHASE) == 21 ? 2 : 1); ++rp_) for (int k = 0; k < 2; ++k) pool_unit(Fp, Fp.vcu * 2 + k, P, args.in[6] + (size_t)l * 4 * 64 * 64, args.in[7] + (size_t)l * 256, BR);
#endif
#ifndef NO_CONV
            for (int rp_ = 0; rp_ < ((REP_PHASE) == 22 ? 2 : 1); ++rp_) for (int k = 0; k < 4; ++k) conv_unit(Fp, Fp.vcu * 4 + k, P, args.in[8] + (size_t)l * 31 * 256, args.in[9] + (size_t)l * 256, args.in[10] + (size_t)l * 256, args.in[11] + (size_t)l * 256, BR);
#endif
#ifndef NO_DSA
            { const int b = Fp.vcu >> 5, s = Fp.vcu & 31; const int bxk_ = opaque_s((int)blockIdx.x);
#pragma unroll 1
              for (int k = 0; k < ((REP_PHASE) == 23 ? 8 : 4); ++k) { const int j = (k & 3) == 0 ? 127 - s : ((k & 3) == 1 ? 64 + s : ((k & 3) == 2 ? 63 - s : s)); dsa_mask_unit(Fp, b, j, P, wsb(F, WS_KIDX), FW, SELW, F.ws + (bxk_ < 176 ? WS_DK0 + (size_t)bxk_ * 262144 : WS_DK1 + (size_t)(bxk_ - 176) * 262144)); } }
#endif
        }
        SEAM(pb + 1);
        for (int rep_ = 0; rep_ < NREP(3); ++rep_) if (EN(3) && IN(pb + 2)) { const int vc_ = opaque_s(F0.vcu); const int sg = vc_ >> 3, s = vc_ & 7, b = sg >> 2, h = sg & 3; const size_t rb = (size_t)b * SEQ;
            const attn_body::bf16* Pb = (const attn_body::bf16*)P + rb * PS; unsigned char* Ob = (unsigned char*)BR + rb * DM;
#pragma unroll 1
            for (int k = 0; k < ((REP_PHASE) == 31 ? 4 : 2); ++k) { const int qb = (k & 1) == 0 ? 15 - s : s;
                attn_body::attn_unit<24, false>(qb * 256, Pb + C_FQ + h * 64, Pb + C_FK + h * 64, Pb + C_FV + h * 64, (attn_body::bf16*)(Ob + 256 + h * 64), BIAS2 + (size_t)(b * 4 + h) * SEQ, 0.f, nullptr, (char*)lds + RING_OFF, F0.wave); }
            const float slope2 = exp2f(-2.f * (float)(h + 1)) * LOG2E;
#pragma unroll 1
            for (int k = 0; k < ((REP_PHASE) == 32 ? 4 : 2); ++k) { const int qb = (k & 1) == 0 ? 15 - s : s;
                attn_body::attn_unit<24, true>(qb * 256, Pb + C_DQ + h * 64, Pb + C_DK, Pb + C_DV, (attn_body::bf16*)(Ob + 512 + h * 64), nullptr, slope2, SELW + (size_t)b * 64 * SEQ, (char*)lds + RING_OFF, F0.wave); }
        }
        SEAM(pb + 2);
        for (int rep_ = 0; rep_ < NREP(4); ++rep_) if (EN(4) && IN(pb + 3)) { SchedC S; S.T.init(NTOK / 256, DM / 128, F.G, opaque_s((int)blockIdx.x)); S.HBp = (const char*)(F.ws + WS_HB8); S.BRp = (const char*)BR; S.WGp = (const char*)(W + W_GT / 2); S.WBp = (const char*)(W + W_BR / 2); S.collapse = ((REP_PHASE) == 61 && rep_ == 0 && args.ph_hi != 7777);
            EpiC E; E.dry = (((REP_PHASE) == 60 || (REP_PHASE) == 61) && rep_ == 0 && args.ph_hi != 7777); E.MIX = MIX; E.bgate = args.in[5] + (size_t)l * 4 * DM; pg8::gemm_phase_c8<EpiC, SchedC>(F.lds + RING_OFF, F0.wave, S, E); }
        SEAM(pb + 3);
        for (int rep_ = 0; rep_ < NREP(5); ++rep_) if (EN(5) && IN(pb + 4)) { SchedC2 S; S.T.init(NTOK / 256, DM / 256, F.G, opaque_s((int)blockIdx.x)); S.A = (const char*)MIX; S.B = (const char*)(W + W_OUT / 2);
            EpiRes E{BR  , HB, DRY(5)}; pg8::gemm_phase<EpiRes, SchedC2, false>(F.lds + RING_OFF, (LAS unsigned*)(F.lds + LDSCTL_OFF + 1024), F0.wave, S, E); }
        SEAM(pb + 4);
        for (int rep_ = 0; rep_ < NREP(6); ++rep_) if (EN(6) && IN(pb + 5)) { FRESH(Fp); PROBE_BEGIN(21); ln1_router_phase(Fp, args, l, DRY(6)); PROBE_END(21); }
        SEAM(pb + 5);
        for (int rep_ = 0; rep_ < NREP(7); ++rep_) if (EN(7) && IN(pb + 6)) { moe_table(F, l, TAB);
            SchedD1 S{TAB, F.G, opaque_s((int)blockIdx.x), (const char*)(F.ws + WS_HB8), (const char*)(W + W_GU / 2), (const int*)(F.ws + WS_LIST)};
            EpiD1 E{(unsigned char*)ACT, (const float*)(F.ws + WS_GWL)}; pg8::gemm_phase<EpiD1, SchedD1, true>(F.lds + RING_OFF, (LAS unsigned*)(F.lds + LDSCTL_OFF + 1024), F0.wave, S, E); }
        SEAM(pb + 6);
        for (int rep_ = 0; rep_ < NREP(8); ++rep_) if (EN(8) && IN(pb + 7)) { moe_table(F, l, TAB);
            SchedD2 S{TAB, F.G, opaque_s((int)blockIdx.x), (const char*)ACT, (const char*)(W + W_D / 2), (const int*)(F.ws + WS_LIST)};
            EpiD2 E{wsb(F, WS_R1), HB, DRY(8)}; pg8::gemm_phase<EpiD2, SchedD2, false>(F.lds + RING_OFF, (LAS unsigned*)(F.lds + LDSCTL_OFF + 1024), F0.wave, S, E); }
        SEAM(pb + 7);
        for (int rep_ = 0; rep_ < NREP(9); ++rep_) if (EN(9) && IN(pb + 8)) { FRESH(Fp); PROBE_BEGIN(22); ln2_phase(Fp, args, l, DRY(9)); PROBE_END(22); }
        SEAM(pb + 8);
#undef l
#undef W
    }
#undef IN
#undef SEAM
    if ((REP_PHASE) >= 100 && blockIdx.x == 0 && F0.wave == 0 && lane_id_() == 0) { volatile LAS unsigned* PRB = (volatile LAS unsigned*)(F0.lds + LDSCTL_OFF + 512); const unsigned long long a_ = (((unsigned long long)PRB[1]) << 32) | PRB[0];
        const unsigned long long t0_ = __builtin_amdgcn_s_memrealtime(); while (__builtin_amdgcn_s_memrealtime() - t0_ < a_) __builtin_amdgcn_s_sleep(8); }
}

extern "C" void kernel_launch(void* const* d_in, const int* in_sizes, int n_in, void* d_out, int out_size, void* d_ws, size_t ws_size, hipStream_t stream) {
    static int grid = 0;
    if (grid == 0) {
        if (n_in != 25 || in_sizes[0] != NTOK * DM || out_size != NTOK * DM || ws_size < WS_END) { fprintf(stderr, "kernel_launch: unexpected shapes (n_in %d, in0 %d, out %d, ws %zu); nothing launched\n", n_in, n_in > 0 ? in_sizes[0] : -1, out_size, ws_size); grid = -1; return; }
        int dev = 0, cus = 0, per_cu = 0;
        if (hipGetDevice(&dev) != hipSuccess || hipDeviceGetAttribute(&cus, hipDeviceAttributeMultiprocessorCount, dev) != hipSuccess) { grid = -1; return; }
        if (hipFuncSetAttribute((const void*)fwd_kernel, hipFuncAttributeMaxDynamicSharedMemorySize, LDS_BYTES) != hipSuccess) { fprintf(stderr, "kernel_launch: hipFuncSetAttribute failed\n"); grid = -1; return; }
        if (hipOccupancyMaxActiveBlocksPerMultiprocessor(&per_cu, (const void*)fwd_kernel, NWAVES * 64, LDS_BYTES) != hipSuccess || per_cu < 1) fprintf(stderr, "kernel_launch: occupancy query reports %d\n", per_cu);
        (void)hipGetLastError();
        grid = cus;
        if (grid != 256) { fprintf(stderr, "kernel_launch: built for 256 CUs, device has %d; nothing launched\n", cus); grid = -1; return; }
    }
    if (grid < 0) return;
    if (hipMemsetAsync((char*)d_ws + WS_CTL, 0, CTL_ZERO_BYTES, stream) != hipSuccess) return;
    Args a{};
    for (int i = 0; i < 25; ++i) a.in[i] = (const float*)d_in[i];
    a.out = (float*)d_out; a.ws = (unsigned char*)d_ws;
#if MK_PER_PHASE
    for (int p = 0; p < N_PHASES; ++p) { a.ph_lo = p; a.ph_hi = p + 1; hipLaunchKernelGGL(fwd_kernel, dim3(grid), dim3(NWAVES * 64), LDS_BYTES, stream, a); }
#else
    a.ph_lo = 0; a.ph_hi = N_PHASES;
    hipLaunchKernelGGL(fwd_kernel, dim3(grid), dim3(NWAVES * 64), LDS_BYTES, stream, a);
#endif
}
```

```cpp
#include <hip/hip_runtime.h>
#include <hip/hip_bf16.h>
#include <cstdio>
#include <cstdint>
#include <cmath>

#ifndef REP_PHASE
#define REP_PHASE 0
#endif
#define PROBE_BEGIN(id) do { if ((REP_PHASE) == 100 + (id) && blockIdx.x == 0) { __syncthreads(); if (F.wave == 0 && lane_id_() == 0) { const unsigned long long t_ = __builtin_amdgcn_s_memrealtime(); PRB[2] = (unsigned)t_; PRB[3] = (unsigned)(t_ >> 32); } } } while (0)
#define PROBE_END(id) do { if ((REP_PHASE) == 100 + (id) && blockIdx.x == 0) { __syncthreads(); if (F.wave == 0 && lane_id_() == 0) { const unsigned long long t_ = __builtin_amdgcn_s_memrealtime() - (((unsigned long long)PRB[3] << 32) | PRB[2]); const unsigned long long a_ = ((((unsigned long long)PRB[1]) << 32) | PRB[0]) + t_; PRB[0] = (unsigned)a_; PRB[1] = (unsigned)(a_ >> 32); } } } while (0)
constexpr int BATCH = 8, SEQ = 4096, DM = 1024, NTOK = BATCH * SEQ, DEPTH = 2;
constexpr int P_TOTAL = 6344, PS = 2304;
constexpr int C_POOL = 0, C_FQ = 256, C_FK = 512, C_FV = 768, C_DQ = 1024, C_IQ = 1280, C_CONV = 1536, C_DK = 2048, C_DV = 2112, C_IK = 2176, C_FF = 2240, C_IW = 2244;
constexpr float LN_EPS = 1e-5f;
constexpr float ALPHA = 1.4142135623730951f;
constexpr float LOG2E = 1.4426950408889634f;
constexpr int NWAVES = 8;
constexpr int NCLS = 24;
constexpr int MAXTILES = NTOK / 256 + NCLS;

constexpr size_t MiB = 1u << 20;
constexpr size_t WS_CTL = 0, CTL_ZERO_BYTES = 1 * MiB;
constexpr size_t WS_FW = 1 * MiB;
constexpr size_t WS_BIAS2 = 2 * MiB;
constexpr size_t WS_LIST = 3 * MiB;
constexpr size_t WS_GWL = 6 * MiB;
constexpr size_t WS_SELW = 12 * MiB;
constexpr size_t WS_HB8 = 28 * MiB;
constexpr size_t WS_W = 60 * MiB;
constexpr size_t W_SM = 0, W_GT = 4718592, W_BR = W_GT + 8 * MiB, W_OUT = W_BR + 2 * MiB, W_GU = W_OUT + 2 * MiB, W_D = W_GU + 32 * MiB, W_LAYER = W_D + 16 * MiB;
constexpr size_t WS_HB = 190 * MiB;
constexpr size_t WS_R1 = 254 * MiB;
constexpr size_t WS_R2 = 398 * MiB;
constexpr size_t WS_KIDX = 474 * MiB;
constexpr size_t WS_DK0 = 430 * MiB, WS_DK1 = 478 * MiB;
constexpr size_t WS_END = 498 * MiB;
static_assert(WS_W + 2 * W_LAYER <= WS_HB && WS_R1 + (size_t)NTOK * PS * 2 <= WS_R2 && WS_R2 + (size_t)MAXTILES * 256 * DM * 2 <= WS_END, "d_ws map");
constexpr int CW_BAR = 4096;
constexpr int CW_SEAMC = 8192;
constexpr int CW_CNT = 16384;

constexpr int RING_OFF = 0, RING_BYTES = 131072;
constexpr int LDSCTL_OFF = RING_BYTES, MISC_OFF = LDSCTL_OFF + 320;
constexpr int LDS_BYTES = 147456;

#define GAS __attribute__((address_space(1)))
#define LAS __attribute__((address_space(3)))
typedef unsigned short bf16;
typedef unsigned v4u __attribute__((ext_vector_type(4)));
typedef unsigned v2u __attribute__((ext_vector_type(2)));
typedef float f32x4 __attribute__((ext_vector_type(4)));
typedef float f32x16 __attribute__((ext_vector_type(16)));
typedef short bf16x8 __attribute__((ext_vector_type(8)));
typedef GAS unsigned gu32;
#define RLX_AGENT __ATOMIC_RELAXED, __HIP_MEMORY_SCOPE_AGENT
#define LDS_WAIT() asm volatile("s_waitcnt lgkmcnt(0)" ::: "memory")
#define VM_WAIT() asm volatile("s_waitcnt vmcnt(0)" ::: "memory")
__device__ __forceinline__ int opaque_i(int x) { asm volatile("" : "+v"(x)); return x; }
__device__ __forceinline__ int lane_id_() { int x; asm volatile("v_mbcnt_lo_u32_b32 %0, -1, 0\n\tv_mbcnt_hi_u32_b32 %0, -1, %0" : "=v"(x)); return x; }
__device__ __forceinline__ float zero_() { int z = 0; asm volatile("" : "+v"(z)); return __builtin_bit_cast(float, z); }
__device__ __forceinline__ const char* sptr_(const char* p) { const unsigned long long v = (unsigned long long)p; const unsigned lo = (unsigned)__builtin_amdgcn_readfirstlane((int)(unsigned)v), hi = (unsigned)__builtin_amdgcn_readfirstlane((int)(unsigned)(v >> 32)); return (const char*)(((unsigned long long)hi << 32) | lo); }
__device__ __forceinline__ unsigned bit01_(bool c) { unsigned v = c ? 1u : 0u; asm volatile("" : "+v"(v)); return v; }
__device__ __forceinline__ int shfl_i_(int v, int srclane) { return __builtin_amdgcn_ds_bpermute(srclane << 2, v); }
__device__ __forceinline__ int opaque_s(int x) { asm volatile("" : "+s"(x)); return x; }
__device__ __forceinline__ unsigned f2bf(float f) { unsigned u = __builtin_bit_cast(unsigned, f); return (u + 0x7fffu + ((u >> 16) & 1u)) >> 16; }
__device__ __forceinline__ unsigned pk2(float lo, float hi) { return f2bf(lo) | (f2bf(hi) << 16); }
__device__ __forceinline__ float sat8_(float x) { return __builtin_amdgcn_fmed3f(x, -448.f, 448.f); }
__device__ __forceinline__ unsigned pk4_fp8(float a, float b, float c, float d) { int r = __builtin_amdgcn_cvt_pk_fp8_f32(sat8_(a), sat8_(b), 0, false); r = __builtin_amdgcn_cvt_pk_fp8_f32(sat8_(c), sat8_(d), r, true); return (unsigned)r; }
__device__ __forceinline__ float bfl(unsigned w) { return __uint_as_float(w << 16); }
__device__ __forceinline__ float bfh(unsigned w) { return __uint_as_float(w & 0xffff0000u); }
__device__ __forceinline__ float bf1(bf16 h) { return __uint_as_float((unsigned)h << 16); }
__device__ __forceinline__ float sigmoidf_(float x) { return __builtin_amdgcn_rcpf(1.f + __builtin_amdgcn_exp2f(-x * LOG2E)); }

#define XB_TMO      128
#define XB_XCNT(j)  (256  + 64 * (j))
#define XB_XSUB(j)  (1280 + 64 * (j))
#define XB_XGEN(j)  (2304 + 64 * (j))
#define XB_TOP      3328
#define XB_TOPGEN   3392
#define XCD_BAR_WORDS 3456
#define XB_SPIN_CAP (1u << 18)
__device__ __forceinline__ unsigned xb_ld(unsigned* p)              { return __hip_atomic_load(p, __ATOMIC_RELAXED, __HIP_MEMORY_SCOPE_AGENT); }
__device__ __forceinline__ unsigned xb_add(unsigned* p, unsigned v) { return __hip_atomic_fetch_add(p, v, __ATOMIC_RELAXED, __HIP_MEMORY_SCOPE_AGENT); }
__device__ __forceinline__ unsigned xb_xcc_id() { return (unsigned)__builtin_amdgcn_s_getreg((3 << 11) | 20) & 0xFu; }
#define XB_SPIN(cond, bar) do { unsigned _sp = 0; while (cond) { __builtin_amdgcn_s_sleep(1); \
    if ((++_sp & 255u) == 0u) { if (xb_ld(&(bar)[XB_TMO])) break; if (_sp > XB_SPIN_CAP) { atomicAdd(&(bar)[XB_TMO], 1u); break; } } } } while (0)
struct XcdBarrier { unsigned* bar; unsigned x; volatile LAS unsigned* st; };
__device__ __forceinline__ XcdBarrier xcd_barrier_post(unsigned* bar, volatile LAS unsigned* st) {
    XcdBarrier b; b.bar = bar; b.x = xb_xcc_id(); b.st = st;
    if (threadIdx.x == 0) (void)xb_add(&bar[XB_XCNT(b.x)], 1u);
    return b;
}
__device__ __forceinline__ void xcd_barrier_complete(unsigned* bar, unsigned x, unsigned& nloc, unsigned& nx) {
    const unsigned G = gridDim.x * gridDim.y * gridDim.z;
    unsigned sum, cnt, mine, sp = 0u;
    for (;;) {
        sum = 0u; cnt = 0u; mine = 0u;
#pragma unroll
        for (unsigned j = 0; j < 16; ++j) { const unsigned c = xb_ld(&bar[XB_XCNT(j)]); sum += c; cnt += (c > 0u) ? 1u : 0u; mine = (j == x) ? c : mine; }
        if (sum == G) break;
        __builtin_amdgcn_s_sleep(1);
        if ((++sp & 255u) == 0u) { if (xb_ld(&bar[XB_TMO])) break; if (sp > XB_SPIN_CAP) { atomicAdd(&bar[XB_TMO], 1u); break; } }
    }
    nloc = mine > 0u ? mine : 1u; nx = cnt > 0u ? cnt : 1u;
}
__device__ __forceinline__ void xcd_barrier(const XcdBarrier& b, int wave) {
    asm volatile("s_waitcnt vmcnt(0)" ::: "memory");
    __syncthreads();
    if (wave == 0 && lane_id_() == 0) {
        unsigned* bar = b.bar; const unsigned bx = (unsigned)opaque_s((int)xb_xcc_id());
        __builtin_amdgcn_s_waitcnt(0);
        unsigned nloc = b.st[0], nx = b.st[1];
        if (nloc == 0u) { xcd_barrier_complete(bar, bx, nloc, nx); b.st[0] = nloc; b.st[1] = nx; }
        const unsigned old = xb_add(&bar[XB_XSUB(bx)], 1u);
        const unsigned gen = old / nloc;
        if (old + 1u == (gen + 1u) * nloc) {
            __builtin_amdgcn_fence(__ATOMIC_RELEASE, "agent");
            asm volatile("s_waitcnt vmcnt(0)" ::: "memory");
            const unsigned og = xb_add(&bar[XB_TOP], 1u);
            const unsigned tg = og / nx;
            if (og + 1u == (tg + 1u) * nx) xb_add(&bar[XB_TOPGEN], 1u);
            else XB_SPIN(xb_ld(&bar[XB_TOPGEN]) == tg, bar);
            __builtin_amdgcn_fence(__ATOMIC_ACQUIRE, "agent");
            xb_add(&bar[XB_XGEN(bx)], 1u);
            asm volatile("s_waitcnt vmcnt(0)" ::: "memory");
        } else {
            XB_SPIN(xb_ld(&bar[XB_XGEN(bx)]) == gen, bar);
            __builtin_amdgcn_fence(__ATOMIC_ACQUIRE, "agent");
            asm volatile("s_waitcnt vmcnt(0)" ::: "memory");
        }
    }
    __syncthreads();
}
namespace pg8 {
#define PG8_LAS __attribute__((address_space(3)))
typedef unsigned short bf16_t;
typedef short bf16x8 __attribute__((ext_vector_type(8)));
typedef float f32x4 __attribute__((ext_vector_type(4)));
typedef float f32x2 __attribute__((ext_vector_type(2)));
typedef unsigned u32x4 __attribute__((ext_vector_type(4)));
typedef unsigned u32x2 __attribute__((ext_vector_type(2)));
constexpr int BM = 256, BK = 64, HALF = 128, HTB = HALF * BK * 2  , STAGE_BYTES = 8 * HTB, NXCD = 8, WGM = 8;
constexpr int LD = 1024;
constexpr size_t ROWB = 2048;
constexpr size_t HSTEP = (size_t)HALF * ROWB;
constexpr size_t TSTEP = 2 * HSTEP;

__host__ __device__ __forceinline__ int lds_byte(int r, int c) { const int st = (r >> 4) * 2 + (c >> 5), rr = r & 15, cc = c & 31, ob = rr * 64 + cc * 2; return st * 1024 + (ob ^ (((ob >> 9) & 1) << 5)); }
__host__ __device__ __forceinline__ void stage_rc(int b, int& R, int& C) { const int st = b / 1024, sb = b % 1024, swz = sb ^ (((sb >> 9) & 1) << 5); R = (st >> 1) * 16 + swz / 64; C = (st & 1) * 32 + (swz % 64) / 2; }
__host__ __device__ __forceinline__ int perm32(int rho) { const int n = rho >> 4, i = rho & 15; return 8 * (i >> 2) + 4 * n + (i & 3); }

struct GU {
    const char* A;
    const char* B0;
    const char* B1;
    int nt, ks;
    const int* rows;
    int rbase, rcnt;
    int pm, pn, a0, a1;
};

__device__ __forceinline__ unsigned cvt_pk_bf16(float lo, float hi) { unsigned r; asm volatile("v_cvt_pk_bf16_f32 %0, %1, %2" : "=v"(r) : "v"(lo), "v"(hi)); return r; }
__device__ __forceinline__ float bf_lo(unsigned w) { return __uint_as_float(w << 16); }
__device__ __forceinline__ float bf_hi(unsigned w) { return __uint_as_float(w & 0xffff0000u); }

__device__ __forceinline__ void glds16_s(const char* sbase, unsigned voff, unsigned lds_dst) { unsigned keep;
    asm volatile("s_mov_b32 %0, m0\n\ts_mov_b32 m0, %3\n\ts_nop 0\n\tglobal_load_lds_dwordx4 %1, %2\n\ts_mov_b32 m0, %0" : "=&s"(keep) : "v"(voff), "s"(sbase), "s"(lds_dst) : "memory"); }
typedef int v8i_t __attribute__((ext_vector_type(8)));
typedef int v4i_t __attribute__((ext_vector_type(4)));
__device__ __forceinline__ v8i_t cat8(bf16x8 lo, bf16x8 hi) { const v4i_t a = __builtin_bit_cast(v4i_t, lo), b = __builtin_bit_cast(v4i_t, hi); return __builtin_shufflevector(a, b, 0, 1, 2, 3, 4, 5, 6, 7); }
template <class Epi, class Sched, bool GATHER>
__device__ __forceinline__ void gemm_phase(PG8_LAS unsigned char* lds, PG8_LAS unsigned* xlds  , const int wid_in  , const Sched& S, Epi& E) {
    const int wid = opaque_s(wid_in), lane = lane_id_(), tid = wid * 64 + lane, wr = wid >> 2, wc = wid & 3, fr = lane & 15, fq = lane >> 4;
    constexpr bool F8 = Epi::F8;
    constexpr int RP = F8 ? 1024 : 2048;
    constexpr size_t HS = (size_t)HALF * RP;
    unsigned voffB[2], vA[2][2];
#pragma unroll
    for (int i = 0; i < 2; ++i) { int R, C; stage_rc(tid * 16 + i * 8192, R, C); const int Rb = Epi::PERM ? ((R & ~31) + perm32(R & 31)) : R;
        voffB[i] = (unsigned)(Rb * RP + C * 2);
        vA[0][i] = (unsigned)(R * RP + C * 2); vA[1][i] = vA[0][i]; }
    const size_t kstep = (size_t)(BK * 2);
    const unsigned ldsw = (unsigned)wid * 1024u;
    const unsigned ldsb = (unsigned)__builtin_amdgcn_readfirstlane((int)((unsigned)(size_t)lds + (unsigned)wid * 1024u));
    const int aoff8 = lds_byte(wr * 64 + fr, 16 * fq), boff8 = lds_byte(wc * 32 + fr, 16 * fq);
    const int aoff = lds_byte(wr * 64 + fr, fq * 8), boff = lds_byte(wc * 32 + fr, fq * 8);
#define PG8_SA(b, h) (((b) * 2 + (h)) * HTB)
#define PG8_SB(b, h) ((4 + (b) * 2 + (h)) * HTB)
#define PG8_STAGE(bufoff, gbase, voff) do { _Pragma("unroll") for (int _i = 0; _i < 2; ++_i) { \
        if constexpr (F8) glds16_s((const char*)(gbase), (voff)[_i], ldsb + (unsigned)((bufoff) + _i * 8192)); \
        else __builtin_amdgcn_global_load_lds((const unsigned*)((const char*)(gbase) + (voff)[_i]), (PG8_LAS unsigned*)(lds + (bufoff) + ldsw + _i * 8192), 16, 0, 0); } } while (0)
#define PG8_STAGEA(bufoff, gbase, h) do { if constexpr (GATHER) { PG8_STAGE(bufoff, gbase, vA[h]); } else { PG8_STAGE(bufoff, (gbase) + (h) * HS, vA[0]); } } while (0)
#define PG8_LDA(dst, b, h) do { _Pragma("unroll") for (int m = 0; m < 4; ++m) _Pragma("unroll") for (int k = 0; k < 2; ++k) dst[m][k] = *(const PG8_LAS bf16x8*)(lds + PG8_SA(b, h) + (F8 ? aoff8 + k * 16 : aoff + k * 1024) + m * 2048); } while (0)
#define PG8_LDB(dst, b, h) do { _Pragma("unroll") for (int n = 0; n < 2; ++n) _Pragma("unroll") for (int k = 0; k < 2; ++k) dst[n][k] = *(const PG8_LAS bf16x8*)(lds + PG8_SB(b, h) + (F8 ? boff8 + k * 16 : boff + k * 1024) + n * 2048); } while (0)
#define PG8_MMA(ai, bj, At, Bt) do { __builtin_amdgcn_s_setprio(1); _Pragma("unroll") for (int m = 0; m < 4; ++m) _Pragma("unroll") for (int n = 0; n < 2; ++n) { \
        if constexpr (F8) acc[ai][bj][m][n] = __builtin_amdgcn_mfma_scale_f32_16x16x128_f8f6f4(cat8(Bt[n][0], Bt[n][1]), cat8(At[m][0], At[m][1]), acc[ai][bj][m][n], 0, 0, 0, 0, 0, 0); \
        else { _Pragma("unroll") for (int k = 0; k < 2; ++k) acc[ai][bj][m][n] = __builtin_amdgcn_mfma_f32_16x16x32_bf16(Bt[n][k], At[m][k], acc[ai][bj][m][n], 0, 0, 0); } } __builtin_amdgcn_s_setprio(0); } while (0)
#define PG8_WAIT_V(n) asm volatile("s_waitcnt vmcnt(" #n ")" ::: "memory")
#define PG8_WAIT_L(n) asm volatile("s_waitcnt lgkmcnt(" #n ")" ::: "memory")
#define PG8_BAR __builtin_amdgcn_s_barrier()
#define PG8_SCHED __builtin_amdgcn_sched_barrier(0)
#define PG8_KS(u) (Sched::NT > 0 ? Sched::KS : (u).ks)
#define PG8_BP(u, tau) ((tau) < PG8_KS(u) ? (u).B0 + (size_t)(tau) * kstep : (u).B1 + (size_t)((tau) - PG8_KS(u)) * kstep)
#define PG8_GATHER_OFFS(dst, u) do { if constexpr (GATHER) { _Pragma("unroll") for (int _h = 0; _h < 2; ++_h) _Pragma("unroll") for (int _i = 0; _i < 2; ++_i) { \
        int _R, _C; stage_rc((wid * 64 + lane_id_()) * 16 + _i * 8192, _R, _C); int _p = (u).rbase + _h * HALF + _R; _p = _p < (u).rcnt ? _p : (u).rcnt - 1; dst[_h][_i] = (unsigned)(u).rows[_p] * (unsigned)RP + (unsigned)_C * 2u; } } } while (0)
    GU cur, nxt; int ui = 0;
    if (!S.next(0, cur)) return;
    f32x4 acc[2][2][4][2];
#pragma unroll
    for (int a = 0; a < 2; ++a)
#pragma unroll
        for (int b = 0; b < 2; ++b)
#pragma unroll
            for (int m = 0; m < 4; ++m)
#pragma unroll
                for (int n = 0; n < 2; ++n) { const float z_ = zero_(); acc[a][b][m][n] = (f32x4){z_, z_, z_, z_}; }
    bf16x8 At[4][2], B0[2][2], B1[2][2];
    PG8_GATHER_OFFS(vA, cur);
    const char* cA = cur.A;
    { const char* b0 = PG8_BP(cur, 0); const char* b1 = PG8_BP(cur, 1);
      PG8_STAGE(PG8_SB(0, 0), b0, voffB); PG8_STAGE(PG8_SB(0, 1), b0 + HS, voffB); PG8_STAGEA(PG8_SA(0, 0), cA, 0); PG8_STAGEA(PG8_SA(0, 1), cA, 1);
      if (wr == 1) PG8_BAR;
      PG8_WAIT_V(2); PG8_BAR;
      PG8_STAGE(PG8_SB(1, 0), b1, voffB); PG8_STAGEA(PG8_SA(1, 0), cA + kstep, 0); PG8_STAGE(PG8_SB(1, 1), b1 + HS, voffB);
      PG8_WAIT_V(6); PG8_BAR; }
    for (;;) {
        const bool has_next = S.next(ui + 1, nxt);
        if (!has_next) nxt = cur;
        if constexpr (GATHER) { unsigned vn[2][2];
#pragma unroll
            for (int h = 0; h < 2; ++h)
#pragma unroll
                for (int i = 0; i < 2; ++i) vn[h][i] = vA[h][i];
            if (has_next) { PG8_GATHER_OFFS(vn, nxt); }
#pragma unroll
            for (int h = 0; h < 2; ++h)
#pragma unroll
                for (int i = 0; i < 2; ++i) xlds[(h * 2 + i) * 512 + tid] = vn[h][i]; }
        const char* nA = nxt.A;
        const int nt = Sched::NT > 0 ? Sched::NT : cur.nt;
#pragma unroll (Sched::NT > 0 ? 2 : 1)
        for (int t = 0; t < nt; t += 2) {
            const bool last = (t == nt - 2);
            const char* a1 = cA + (size_t)(t + 1) * kstep;
            const char* a2 = last ? nA : cA + (size_t)(t + 2) * kstep;
            const char* b2 = last ? PG8_BP(nxt, 0) : PG8_BP(cur, t + 2);
            const char* a3 = a2 + kstep; const char* b3 = b2 + kstep;
            PG8_LDB(B0, 0, 0); PG8_LDB(B1, 0, 1); PG8_SCHED; PG8_LDA(At, 0, 0); PG8_STAGEA(PG8_SA(1, 1), a1, 1);
            if constexpr (GATHER) { if (last) {
#pragma unroll
                for (int h = 0; h < 2; ++h)
#pragma unroll
                    for (int i = 0; i < 2; ++i) vA[h][i] = xlds[(h * 2 + i) * 512 + tid]; } }
            PG8_WAIT_V(8); PG8_WAIT_L(0); PG8_BAR; PG8_MMA(0, 0, At, B0); PG8_MMA(0, 1, At, B1); PG8_BAR; PG8_SCHED;
            PG8_LDA(At, 0, 1); PG8_STAGE(PG8_SB(0, 0), b2, voffB); PG8_STAGE(PG8_SB(0, 1), b2 + HS, voffB); PG8_STAGEA(PG8_SA(0, 0), a2, 0);
            PG8_WAIT_V(8); PG8_WAIT_L(0); PG8_BAR; PG8_MMA(1, 0, At, B0); PG8_MMA(1, 1, At, B1); PG8_BAR; PG8_SCHED;
            PG8_LDB(B0, 1, 0); PG8_LDB(B1, 1, 1); PG8_SCHED; PG8_LDA(At, 1, 0); PG8_STAGEA(PG8_SA(0, 1), a2, 1);
            PG8_WAIT_V(8); PG8_WAIT_L(0); PG8_BAR; PG8_MMA(0, 0, At, B0); PG8_MMA(0, 1, At, B1); PG8_BAR; PG8_SCHED;
            PG8_LDA(At, 1, 1); PG8_STAGE(PG8_SB(1, 0), b3, voffB); PG8_STAGE(PG8_SB(1, 1), b3 + HS, voffB); PG8_STAGEA(PG8_SA(1, 0), a3, 0);
            PG8_WAIT_V(8); PG8_WAIT_L(0); PG8_BAR; PG8_MMA(1, 0, At, B0); PG8_MMA(1, 1, At, B1); PG8_BAR; PG8_SCHED;
        }
        if (wr == 0) PG8_BAR;
        { const int l2_ = lane_id_(); E(acc, cur, wr, wc, l2_ & 15, l2_ >> 4); }
        if (!has_next) break;
#pragma unroll
        for (int a = 0; a < 2; ++a)
#pragma unroll
            for (int b = 0; b < 2; ++b)
#pragma unroll
                for (int m = 0; m < 4; ++m)
#pragma unroll
                    for (int n = 0; n < 2; ++n) { const float z_ = zero_(); acc[a][b][m][n] = (f32x4){z_, z_, z_, z_}; }
        cur = nxt; cA = nA; ++ui;
        if (wr == 1) PG8_BAR;
    }
    PG8_WAIT_V(0);
    PG8_BAR;
#undef PG8_SA
#undef PG8_SB
#undef PG8_STAGE
#undef PG8_STAGEA
#undef PG8_LDA
#undef PG8_LDB
#undef PG8_MMA
#undef PG8_WAIT_V
#undef PG8_WAIT_L
#undef PG8_BAR
#undef PG8_SCHED
#undef PG8_BP
#undef PG8_KS
#undef PG8_GATHER_OFFS
}

template <class Epi, class Sched>
__device__ __forceinline__ void gemm_phase_n128(PG8_LAS unsigned char* lds, const int wid_in, const Sched& S, Epi& E) {
    const int wid = opaque_s(wid_in), lane = lane_id_(), tid = wid * 64 + lane, wr = wid >> 2, wc = wid & 3, fr = lane & 15, fq = lane >> 4;
    unsigned voffB[2], voffA[2];
#pragma unroll
    for (int i = 0; i < 2; ++i) { int R, C; stage_rc(tid * 16 + i * 8192, R, C); const int Rb = (R & ~31) + perm32(R & 31);
        voffB[i] = (unsigned)(Rb * LD + C) * 2u; voffA[i] = (unsigned)(R * LD + C) * 2u; }
    const size_t kstep = (size_t)(BK * 2);
    const unsigned ldsw = (unsigned)wid * 1024u;
    const int aoff = lds_byte(wr * 64 + fr, fq * 8), boff = lds_byte(wc * 32 + fr, fq * 8);
#define PG8_SA(b, h) (((b) * 2 + (h)) * HTB)
#define PG8_SB(b, h) ((4 + (b) * 2 + (h)) * HTB)
#define PG8_STAGE(bufoff, gbase, voff) do { _Pragma("unroll") for (int _i = 0; _i < 2; ++_i) \
        __builtin_amdgcn_global_load_lds((const unsigned*)((const char*)(gbase) + (voff)[_i]), (PG8_LAS unsigned*)(lds + (bufoff) + ldsw + _i * 8192), 16, 0, 0); } while (0)
#define PG8_LDA(dst, b, h) do { _Pragma("unroll") for (int m = 0; m < 4; ++m) _Pragma("unroll") for (int k = 0; k < 2; ++k) dst[m][k] = *(const PG8_LAS bf16x8*)(lds + PG8_SA(b, h) + aoff + m * 2048 + k * 1024); } while (0)
#define PG8_LDB(dst, b, h) do { _Pragma("unroll") for (int n = 0; n < 2; ++n) _Pragma("unroll") for (int k = 0; k < 2; ++k) dst[n][k] = *(const PG8_LAS bf16x8*)(lds + PG8_SB(b, h) + boff + n * 2048 + k * 1024); } while (0)
#define PG8_MMA(ai, At, Bt) do { __builtin_amdgcn_s_setprio(1); _Pragma("unroll") for (int m = 0; m < 4; ++m) _Pragma("unroll") for (int n = 0; n < 2; ++n) _Pragma("unroll") for (int k = 0; k < 2; ++k) \
        acc[ai][m][n] = __builtin_amdgcn_mfma_f32_16x16x32_bf16(Bt[n][k], At[m][k], acc[ai][m][n], 0, 0, 0); __builtin_amdgcn_s_setprio(0); } while (0)
#define PG8_WAIT_V(n) asm volatile("s_waitcnt vmcnt(" #n ")" ::: "memory")
#define PG8_WAIT_L(n) asm volatile("s_waitcnt lgkmcnt(" #n ")" ::: "memory")
#define PG8_BAR __builtin_amdgcn_s_barrier()
#define PG8_SCHED __builtin_amdgcn_sched_barrier(0)
    GU cur, nxt; int ui = 0;
    if (!S.next(0, cur)) return;
    f32x4 acc[2][4][2];
#pragma unroll
    for (int a = 0; a < 2; ++a)
#pragma unroll
        for (int m = 0; m < 4; ++m)
#pragma unroll
            for (int n = 0; n < 2; ++n) { const float z_ = zero_(); acc[a][m][n] = (f32x4){z_, z_, z_, z_}; }
    bf16x8 At[4][2], B0[2][2];
    u32x4 st_u[2][4], st_s[2][4];
    const char* cA = cur.A; const char* cB = cur.B0;
    PG8_STAGE(PG8_SB(0, 0), cB, voffB); PG8_STAGE(PG8_SA(0, 0), cA, voffA); PG8_STAGE(PG8_SA(0, 1), cA + HSTEP, voffA);
    if (wr == 1) PG8_BAR;
    PG8_WAIT_V(2); PG8_BAR;
    PG8_STAGE(PG8_SB(1, 0), cB + kstep, voffB); PG8_STAGE(PG8_SA(1, 0), cA + kstep, voffA);
    PG8_WAIT_V(4); PG8_BAR;
    for (;;) {
        const bool has_next = S.next(ui + 1, nxt);
        if (!has_next) nxt = cur;
        const char* nA = nxt.A; const char* nB = nxt.B0;
        const int nt = cur.nt;
        for (int t = 0; t < nt; t += 2) {
            const bool last = (t == nt - 2);
            const char* a1 = cA + (size_t)(t + 1) * kstep;
            const char* a2 = last ? nA : cA + (size_t)(t + 2) * kstep;
            const char* b2 = last ? nB : cB + (size_t)(t + 2) * kstep;
            const char* a3 = a2 + kstep; const char* b3 = b2 + kstep;
            PG8_LDB(B0, 0, 0); PG8_SCHED; PG8_LDA(At, 0, 0); PG8_STAGE(PG8_SA(1, 1), a1 + HSTEP, voffA);
            PG8_WAIT_V(6); PG8_WAIT_L(0); PG8_BAR; PG8_MMA(0, At, B0); PG8_BAR; PG8_SCHED;
            PG8_LDA(At, 0, 1); PG8_STAGE(PG8_SB(0, 0), b2, voffB); PG8_STAGE(PG8_SA(0, 0), a2, voffA);
            PG8_WAIT_V(6); PG8_WAIT_L(0); PG8_BAR; PG8_MMA(1, At, B0); PG8_BAR; PG8_SCHED;
            PG8_LDB(B0, 1, 0); PG8_SCHED; PG8_LDA(At, 1, 0); PG8_STAGE(PG8_SA(0, 1), a2 + HSTEP, voffA);
            PG8_WAIT_V(6); PG8_WAIT_L(0); PG8_BAR; PG8_MMA(0, At, B0); PG8_BAR; PG8_SCHED;
            PG8_LDA(At, 1, 1); PG8_STAGE(PG8_SB(1, 0), b3, voffB); PG8_STAGE(PG8_SA(1, 0), a3, voffA);
            PG8_WAIT_V(6); PG8_WAIT_L(0); PG8_BAR; PG8_MMA(1, At, B0); PG8_BAR; PG8_SCHED;
        }
        if (wr == 0) PG8_BAR;
        E(acc, st_u, st_s, cur, wr, wc, fr, fq);
        if (!has_next) break;
#pragma unroll
        for (int a = 0; a < 2; ++a)
#pragma unroll
            for (int m = 0; m < 4; ++m)
#pragma unroll
                for (int n = 0; n < 2; ++n) { const float z_ = zero_(); acc[a][m][n] = (f32x4){z_, z_, z_, z_}; }
        cur = nxt; cA = nA; cB = nB; ++ui;
        if (wr == 1) PG8_BAR;
    }
    PG8_WAIT_V(0);
    PG8_BAR;
#undef PG8_SA
#undef PG8_SB
#undef PG8_STAGE
#undef PG8_LDA
#undef PG8_LDB
#undef PG8_MMA
#undef PG8_WAIT_V
#undef PG8_WAIT_L
#undef PG8_BAR
#undef PG8_SCHED
}
template <class Epi, class Sched>
__device__ __forceinline__ void gemm_phase_c8(PG8_LAS unsigned char* lds, const int wid_in, const Sched& S, Epi& E) {
    const int wid = opaque_s(wid_in), lane = lane_id_(), tid = wid * 64 + lane, wr = wid >> 2, wc = wid & 3, fr = lane & 15, fq = lane >> 4;
    unsigned voffB[2], voffA[2];
#pragma unroll
    for (int i = 0; i < 2; ++i) { int R, C; stage_rc(tid * 16 + i * 8192, R, C); const int Rb = (R & ~31) + perm32(R & 31);
        voffB[i] = (unsigned)(Rb * LD + C) * 2u; voffA[i] = (unsigned)(R * LD + C) * 2u; }
    const size_t kstep = (size_t)(BK * 2);
    const unsigned ldsb = (unsigned)__builtin_amdgcn_readfirstlane((int)((unsigned)(size_t)lds + (unsigned)wid * 1024u));
    const int aoff = lds_byte(wr * 64 + fr, fq * 8), boff = lds_byte(wc * 32 + fr, fq * 8);
    const int aoff8 = lds_byte(wr * 64 + fr, 16 * fq), boff8 = lds_byte(wc * 32 + fr, 16 * fq);
#define PG8_SA(b, h) (((b) * 2 + (h)) * HTB)
#define PG8_SB(b, h) ((4 + (b) * 2 + (h)) * HTB)
#define PG8_STAGE(bufoff, gbase, voff) do { _Pragma("unroll") for (int _i = 0; _i < 2; ++_i) glds16_s((const char*)(gbase), (voff)[_i], ldsb + (unsigned)((bufoff) + _i * 8192)); } while (0)
#define PG8_STAGE8(bufoff, gbase, voff) do { _Pragma("unroll") for (int _i = 0; _i < 2; ++_i) { const unsigned _v = ((voff)[_i] + ((voff)[_i] & 2047u)) >> 1; glds16_s((const char*)(gbase), _v, ldsb + (unsigned)((bufoff) + _i * 8192)); } } while (0)
#define PG8_STB(bufoff, gbase, f8) do { if (f8) { PG8_STAGE8(bufoff, gbase, voffB); } else { PG8_STAGE(bufoff, gbase, voffB); } } while (0)
#define PG8_STA(bufoff, gbase, h, f8) do { if (f8) { PG8_STAGE8(bufoff, (gbase) + (h) * (HSTEP / 2), voffA); } else { PG8_STAGE(bufoff, (gbase) + (h) * HSTEP, voffA); } } while (0)
#define PG8_LDA(dst, b, h) do { _Pragma("unroll") for (int m = 0; m < 4; ++m) _Pragma("unroll") for (int k = 0; k < 2; ++k) dst[m][k] = *(const PG8_LAS bf16x8*)(lds + PG8_SA(b, h) + aoff + m * 2048 + k * 1024); } while (0)
#define PG8_LDB(dst, b, h) do { _Pragma("unroll") for (int n = 0; n < 2; ++n) _Pragma("unroll") for (int k = 0; k < 2; ++k) dst[n][k] = *(const PG8_LAS bf16x8*)(lds + PG8_SB(b, h) + boff + n * 2048 + k * 1024); } while (0)
#define PG8_LDA8(dst, b, h) do { _Pragma("unroll") for (int m = 0; m < 4; ++m) _Pragma("unroll") for (int k = 0; k < 2; ++k) dst[m][k] = *(const PG8_LAS bf16x8*)(lds + PG8_SA(b, h) + aoff8 + m * 2048 + k * 16); } while (0)
#define PG8_LDB8(dst, b, h) do { _Pragma("unroll") for (int n = 0; n < 2; ++n) _Pragma("unroll") for (int k = 0; k < 2; ++k) dst[n][k] = *(const PG8_LAS bf16x8*)(lds + PG8_SB(b, h) + boff8 + n * 2048 + k * 16); } while (0)
#define PG8_MMA(ai, At, Bt) do { __builtin_amdgcn_s_setprio(1); _Pragma("unroll") for (int m = 0; m < 4; ++m) _Pragma("unroll") for (int n = 0; n < 2; ++n) _Pragma("unroll") for (int k = 0; k < 2; ++k) \
        acc[ai][m][n] = __builtin_amdgcn_mfma_f32_16x16x32_bf16(Bt[n][k], At[m][k], acc[ai][m][n], 0, 0, 0); __builtin_amdgcn_s_setprio(0); } while (0)
#define PG8_MMA8(ai, At, Bt) do { __builtin_amdgcn_s_setprio(1); _Pragma("unroll") for (int m = 0; m < 4; ++m) _Pragma("unroll") for (int n = 0; n < 2; ++n) \
        acc[ai][m][n] = __builtin_amdgcn_mfma_scale_f32_16x16x128_f8f6f4(cat8(Bt[n][0], Bt[n][1]), cat8(At[m][0], At[m][1]), acc[ai][m][n], 0, 0, 0, 0, 0, 0); __builtin_amdgcn_s_setprio(0); } while (0)
#define PG8_WAIT_V(n) asm volatile("s_waitcnt vmcnt(" #n ")" ::: "memory")
#define PG8_WAIT_L(n) asm volatile("s_waitcnt lgkmcnt(" #n ")" ::: "memory")
#define PG8_BAR __builtin_amdgcn_s_barrier()
#define PG8_SCHED __builtin_amdgcn_sched_barrier(0)
    GU cu, cg, nxt; int ui = 0;
    if (!S.next(0, cu)) return;
    f32x4 acc[2][4][2];
#define PG8_ZACC() do { _Pragma("unroll") for (int a = 0; a < 2; ++a) _Pragma("unroll") for (int m = 0; m < 4; ++m) _Pragma("unroll") for (int n = 0; n < 2; ++n) { const float z_ = zero_(); acc[a][m][n] = (f32x4){z_, z_, z_, z_}; } } while (0)
    PG8_ZACC();
    bf16x8 At[4][2], B0[2][2];
    u32x4 st_u[4], st_s[2][4];
    PG8_LAS v4u* ulds = (PG8_LAS v4u*)(lds + 5 * HTB) + tid;
    PG8_STB(PG8_SB(0, 0), cu.B0, true); PG8_STA(PG8_SA(0, 0), cu.A, 0, true); PG8_STA(PG8_SA(0, 1), cu.A, 1, true);
    if (wr == 1) PG8_BAR;
    PG8_WAIT_V(2); PG8_BAR;
    PG8_STB(PG8_SB(1, 0), cu.B0 + kstep, true); PG8_STA(PG8_SA(1, 0), cu.A + kstep, 0, true);
    PG8_WAIT_V(4); PG8_BAR;
#define PG8_KLOOP(LDA_, LDB_, MMA_, C8, N8, cA, cB, nA, nB, nt) \
        for (int t = 0; t < (nt); t += 2) { \
            const bool last = (t == (nt) - 2); \
            const char* a1 = (cA) + (size_t)(t + 1) * kstep; \
            const char* a2 = last ? (nA) : (cA) + (size_t)(t + 2) * kstep; \
            const char* b2 = last ? (nB) : (cB) + (size_t)(t + 2) * kstep; \
            const char* a3 = a2 + kstep; const char* b3 = b2 + kstep; \
            LDB_(B0, 0, 0); PG8_SCHED; LDA_(At, 0, 0); PG8_STA(PG8_SA(1, 1), a1, 1, C8); \
            PG8_WAIT_V(6); PG8_WAIT_L(0); PG8_BAR; MMA_(0, At, B0); PG8_BAR; PG8_SCHED; \
            if (last) { LDA_(At, 0, 1); PG8_STB(PG8_SB(0, 0), b2, N8); PG8_STA(PG8_SA(0, 0), a2, 0, N8); } else { LDA_(At, 0, 1); PG8_STB(PG8_SB(0, 0), b2, C8); PG8_STA(PG8_SA(0, 0), a2, 0, C8); } \
            PG8_WAIT_V(6); PG8_WAIT_L(0); PG8_BAR; MMA_(1, At, B0); PG8_BAR; PG8_SCHED; \
            if (last) { LDB_(B0, 1, 0); PG8_SCHED; LDA_(At, 1, 0); PG8_STA(PG8_SA(0, 1), a2, 1, N8); } else { LDB_(B0, 1, 0); PG8_SCHED; LDA_(At, 1, 0); PG8_STA(PG8_SA(0, 1), a2, 1, C8); } \
            PG8_WAIT_V(6); PG8_WAIT_L(0); PG8_BAR; MMA_(0, At, B0); PG8_BAR; PG8_SCHED; \
            if (last) { LDA_(At, 1, 1); PG8_STB(PG8_SB(1, 0), b3, N8); PG8_STA(PG8_SA(1, 0), a3, 0, N8); } else { LDA_(At, 1, 1); PG8_STB(PG8_SB(1, 0), b3, C8); PG8_STA(PG8_SA(1, 0), a3, 0, C8); } \
            PG8_WAIT_V(6); PG8_WAIT_L(0); PG8_BAR; MMA_(1, At, B0); PG8_BAR; PG8_SCHED; \
        }
    for (;;) {
        S.next(ui + 1, cg);
        PG8_KLOOP(PG8_LDA8, PG8_LDB8, PG8_MMA8, true, true, cu.A, cu.B0, cg.A, cg.B0, cu.nt)
        if (wr == 0) PG8_BAR;
        { const int l2_ = lane_id_(); E(acc, st_u, (LAS v4u*)ulds, st_s, cu, wr, wc, l2_ & 15, l2_ >> 4); }
        PG8_ZACC();
        if (wr == 1) PG8_BAR;
        const bool has_next = S.next(ui + 2, nxt);
        if (!has_next) { nxt.A = S.BRp; nxt.B0 = S.WBp; }
        PG8_KLOOP(PG8_LDA8, PG8_LDB8, PG8_MMA8, true, true, cg.A, cg.B0, nxt.A, nxt.B0, cg.nt)
        if (wr == 0) PG8_BAR;
        { const int l2_ = lane_id_(); E(acc, st_u, (LAS v4u*)ulds, st_s, cg, wr, wc, l2_ & 15, l2_ >> 4); }
        if (!has_next) break;
        PG8_ZACC();
        cu = nxt; ui += 2;
        if (wr == 1) PG8_BAR;
    }
#undef PG8_KLOOP
#undef PG8_ZACC
    PG8_WAIT_V(0);
    PG8_BAR;
#undef PG8_SA
#undef PG8_SB
#undef PG8_STAGE
#undef PG8_STAGE8
#undef PG8_STB
#undef PG8_STA
#undef PG8_LDA
#undef PG8_LDB
#undef PG8_LDA8
#undef PG8_LDB8
#undef PG8_MMA
#undef PG8_MMA8
#undef PG8_WAIT_V
#undef PG8_WAIT_L
#undef PG8_BAR
#undef PG8_SCHED
}
}
namespace attn_body {
using bf16=__hip_bfloat16;
using bf16x8=__attribute__((ext_vector_type(8)))short;
using s16x4=__attribute__((ext_vector_type(4)))short;
using f32x16=__attribute__((ext_vector_type(16)))float;
using f32x4=__attribute__((ext_vector_type(4)))float;
using u32x4=__attribute__((ext_vector_type(4)))unsigned;
constexpr int SEQ=4096,D=64;
constexpr int KVP=2304;
constexpr int OP=1024;
constexpr int NW=8,QBLK=32,QB=QBLK*NW,KVBLK=64,NQB=SEQ/QB;
__device__ __forceinline__ int crow(int r,int hi){return (r&3)+8*(r>>2)+4*hi;}
#define SBAR() __builtin_amdgcn_sched_barrier(0)
__device__ __forceinline__ void cmask(f32x16&p0,f32x16&p1,int jb,int qrel,int hi){
  const float NEG=-INFINITY; int kb=64*jb+4*hi;
  #pragma unroll
  for(int r=0;r<16;++r){int kv=kb+(r&3)+8*(r>>2); if(kv>qrel)p0[r]=NEG; if(kv+32>qrel)p1[r]=NEG;}
}
__device__ __forceinline__ void bmask(f32x16&p0,f32x16&p1,unsigned long long w,int hi){
  const float NEG=-INFINITY; const unsigned lo=((unsigned)w)>>(4*hi), up=((unsigned)(w>>32))>>(4*hi);
  #pragma unroll
  for(int r=0;r<16;++r){const int bit=(r&3)+8*(r>>2); if(!((lo>>bit)&1u))p0[r]=NEG; if(!((up>>bit)&1u))p1[r]=NEG;}
}
constexpr int NSLOT=3, SLOTB=8192;
constexpr int LDS_K=0, LDS_V=NSLOT*SLOTB, LDS_WS=2*NSLOT*SLOTB, LDS_OST=LDS_WS+NW*64*4, LDS_BIAS=LDS_OST+NW*4096, LDS_BYTES=LDS_BIAS+SEQ*4;
constexpr float C2=0.125f*1.4426950408889634f;
__device__ __forceinline__ void glds16(const void*gsrc,unsigned lds_dst){unsigned keep;
  asm volatile("s_mov_b32 %0, m0\n\ts_mov_b32 m0, %2\n\ts_nop 0\n\tglobal_load_lds_dwordx4 %1, off\n\ts_mov_b32 m0, %0":"=&s"(keep):"v"(gsrc),"s"(lds_dst):"memory");}
__device__ __forceinline__ float max3f(float a,float b,float c){float r;asm("v_max3_f32 %0, %1, %2, %3":"=v"(r):"v"(a),"v"(b),"v"(c));return r;}
__device__ __forceinline__ float max2f(float a,float b){float r;asm("v_max_f32_e32 %0, %1, %2":"=v"(r):"v"(a),"v"(b));return r;}
__device__ __forceinline__ float fadd_s(float a,float b){float r;asm("v_add_f32_e32 %0, %1, %2":"=v"(r):"v"(a),"v"(b));return r;}
__device__ __forceinline__ float fsub_s(float a,float b){float r;asm("v_sub_f32_e32 %0, %1, %2":"=v"(r):"v"(a),"v"(b));return r;}
typedef float f32x2_t __attribute__((ext_vector_type(2))); typedef __bf16 bf16x2_t __attribute__((ext_vector_type(2)));
__device__ __forceinline__ unsigned cvtpk_s(float lo,float hi){f32x2_t v={lo,hi};bf16x2_t b=__builtin_convertvector(v,bf16x2_t);return __builtin_bit_cast(unsigned,b);}
#define WAIT_BAR(N) asm volatile("s_waitcnt vmcnt(" #N ") lgkmcnt(0)\n\ts_barrier":::"memory")

typedef __attribute__((address_space(3))) const char* lds_cptr;
typedef short v4i16_t __attribute__((ext_vector_type(4)));
__device__ __forceinline__ void binit(f32x16&p0,f32x16&p1,lds_cptr bp,float mhat){
  typedef float f2_ __attribute__((ext_vector_type(2))); const f2_ m2={mhat,mhat};
  #pragma unroll
  for(int g=0;g<4;++g){ const f32x4 a=*(const __attribute__((address_space(3))) f32x4*)(bp+g*32); const f32x4 b=*(const __attribute__((address_space(3))) f32x4*)(bp+128+g*32);
    const f2_ a0=(f2_){a[0],a[1]}-m2,a1=(f2_){a[2],a[3]}-m2,b0=(f2_){b[0],b[1]}-m2,b1=(f2_){b[2],b[3]}-m2;
    p0[4*g]=a0.x;p0[4*g+1]=a0.y;p0[4*g+2]=a1.x;p0[4*g+3]=a1.y; p1[4*g]=b0.x;p1[4*g+1]=b0.y;p1[4*g+2]=b1.x;p1[4*g+3]=b1.y; }
}
__device__ __forceinline__ void qkt(f32x16&p0,f32x16&p1,const char*Kslot,const bf16x8*qr,int r32,int hi){
  const char*kb=Kslot+hi*1024+r32*16;
  #pragma unroll
  for(int d0=0;d0<4;++d0){
    const bf16x8 b0=*reinterpret_cast<const bf16x8*>(kb+d0*2048);
    const bf16x8 b1=*reinterpret_cast<const bf16x8*>(kb+d0*2048+512);
    p0=__builtin_amdgcn_mfma_f32_32x32x16_bf16(b0,qr[d0],p0,0,0,0);p1=__builtin_amdgcn_mfma_f32_32x32x16_bf16(b1,qr[d0],p1,0,0,0);}
}
__device__ __forceinline__ void kload8(bf16x8*kf,lds_cptr kp){
  kf[0]=*(const __attribute__((address_space(3))) bf16x8*)(kp);      kf[1]=*(const __attribute__((address_space(3))) bf16x8*)(kp+512);
  kf[2]=*(const __attribute__((address_space(3))) bf16x8*)(kp+2048); kf[3]=*(const __attribute__((address_space(3))) bf16x8*)(kp+2560);
  kf[4]=*(const __attribute__((address_space(3))) bf16x8*)(kp+4096); kf[5]=*(const __attribute__((address_space(3))) bf16x8*)(kp+4608);
  kf[6]=*(const __attribute__((address_space(3))) bf16x8*)(kp+6144); kf[7]=*(const __attribute__((address_space(3))) bf16x8*)(kp+6656);
}
__device__ __forceinline__ void kload2(bf16x8*kf,lds_cptr kp,int j){ kf[2*j]=*(const __attribute__((address_space(3))) bf16x8*)(kp+j*2048); kf[2*j+1]=*(const __attribute__((address_space(3))) bf16x8*)(kp+j*2048+512); }
__device__ __forceinline__ s16x4 vtr(lds_cptr p){ return __builtin_bit_cast(s16x4,__builtin_amdgcn_ds_read_tr16_b64_v4i16((__attribute__((address_space(3))) v4i16_t*)p)); }
__device__ __forceinline__ float rowmax(const f32x16&p0,const f32x16&p1){
  float a=max3f(p0[0],p0[1],p1[0]),b=max3f(p0[2],p0[3],p1[1]);a=max3f(a,p1[2],p1[3]);
  #pragma unroll
  for(int r=4;r<16;r+=4){a=max3f(a,p0[r],p0[r+1]);b=max3f(b,p0[r+2],p0[r+3]);a=max3f(a,p1[r],p1[r+1]);b=max3f(b,p1[r+2],p1[r+3]);}
  const float m=max2f(a,b);
  auto rr=__builtin_amdgcn_permlane32_swap(__float_as_uint(m),__float_as_uint(m),false,false);
  return max2f(__uint_as_float(rr[0]),__uint_as_float(rr[1]));
}
__device__ __forceinline__ void pv(f32x16*o,int vb,bf16x8 pa0,bf16x8 pa1,bf16x8 pa2,bf16x8 pa3){
  #pragma unroll
  for(int d0=0;d0<2;++d0){s16x4 lo[4],hi[4];
    #pragma unroll
    for(int ks=0;ks<4;++ks){
      asm volatile("ds_read_b64_tr_b16 %0,%1 offset:%c2":"=&v"(lo[ks]):"v"(vb),"i"(d0*4096+ks*1024):"memory");
      asm volatile("ds_read_b64_tr_b16 %0,%1 offset:%c2":"=&v"(hi[ks]):"v"(vb),"i"(d0*4096+ks*1024+512):"memory");}
    asm volatile("s_waitcnt lgkmcnt(0)":::"memory");SBAR();
    #define PK(k) (bf16x8){lo[k][0],lo[k][1],lo[k][2],lo[k][3],hi[k][0],hi[k][1],hi[k][2],hi[k][3]}
    o[d0]=__builtin_amdgcn_mfma_f32_32x32x16_bf16(pa0,PK(0),o[d0],0,0,0);
    o[d0]=__builtin_amdgcn_mfma_f32_32x32x16_bf16(pa1,PK(1),o[d0],0,0,0);
    o[d0]=__builtin_amdgcn_mfma_f32_32x32x16_bf16(pa2,PK(2),o[d0],0,0,0);
    o[d0]=__builtin_amdgcn_mfma_f32_32x32x16_bf16(pa3,PK(3),o[d0],0,0,0);
    #undef PK
  }
}

template<int THRL,bool MASK> __device__ __forceinline__ void attn_unit(int q0,const bf16*Qs,const bf16*__restrict__ Ks,const bf16*__restrict__ Vs,bf16*Os,
                                                                       const float*biasg,float slope2,const unsigned long long*maskw,char*shm,const int wid_in){
  const int wid=opaque_s(wid_in),lane=lane_id_(),tid=wid*64+lane,r32=lane&31,hi=lane>>5;
  const bf16*Qw=Qs+(long)(q0+wid*QBLK)*KVP;
  const unsigned lds0=(unsigned)(uintptr_t)shm;
  float*wsf=(float*)(shm+LDS_WS)+wid*64;
  unsigned long long mwA=0ull,mwB=0ull;
  const bf16*ksrc=Ks+(long)lane*KVP+wid*8;
  const bf16*vsrc=Vs+(long)(16*(wid&3)+(lane>>2))*KVP+(wid>>2)*32+(lane&3)*8;
  const unsigned kdst=lds0+LDS_K+wid*1024, vdst=lds0+LDS_V+wid*1024;
  #define DMA_K(t,slot) glds16(ksrc+(long)(t)*KVBLK*KVP,(unsigned)__builtin_amdgcn_readfirstlane(kdst+(slot)))
  #define DMA_V(t,slot) glds16(vsrc+(long)(t)*KVBLK*KVP,(unsigned)__builtin_amdgcn_readfirstlane(vdst+(slot)))
  const int vb0=(int)(lds0+LDS_V)+((lane>>4)&1)*32+(lane&3)*8+(4*hi+((lane&15)>>2))*64;
  const char*Kbase=shm+LDS_K; bf16x8 kf[8];
  const lds_cptr shm3=(lds_cptr)shm; const lds_cptr kp0=shm3+LDS_K+hi*1024+r32*16; const lds_cptr vp0=shm3+LDS_V+((lane>>4)&1)*32+(lane&3)*8+(4*hi+((lane&15)>>2))*64;
  const int NT=(q0+QB)/KVBLK;
  DMA_K(0,0);DMA_V(0,0);DMA_K(1,SLOTB);
  bf16x8 qr[4];
  #pragma unroll
  for(int d0=0;d0<4;++d0)qr[d0]=*reinterpret_cast<const bf16x8*>(&Qw[(long)r32*KVP+d0*16+hi*8]);
  { float*bl=(float*)(shm+LDS_BIAS); const int nk=q0+QB; const lds_cptr shm3_=(lds_cptr)shm;
    if(biasg){ typedef float f4_ __attribute__((ext_vector_type(4))); const f4_*g4=(const f4_*)biasg; __attribute__((address_space(3))) f4_*b4=(__attribute__((address_space(3))) f4_*)(lds_cptr)(shm3_+LDS_BIAS); const int nk4=nk>>2;
      f4_ t0=f4_{0.f,0.f,0.f,0.f},t1=t0; if(tid<nk4)t0=g4[tid]; if(tid+NW*64<nk4)t1=g4[tid+NW*64]; if(tid<nk4)b4[tid]=t0; if(tid+NW*64<nk4)b4[tid+NW*64]=t1; }
    else { for(int s=tid;s<nk;s+=NW*64)bl[s]=slope2*(float)s; }
    if(MASK){ const unsigned long long*mp0=maskw+(q0+wid*QBLK+(lane&31)); mwA=mp0[0]; mwB=mp0[SEQ]; asm volatile("":"+v"(mwA),"+v"(mwB)); }
    asm volatile("s_waitcnt vmcnt(0) lgkmcnt(0)":::"memory"); }
  const lds_cptr bp0=shm3+LDS_BIAS+hi*16;
  const unsigned long long*mwp=MASK?maskw+(q0+wid*QBLK+r32):nullptr;
  #define MLOAD(MW,t) do{ if(MASK){ MW=mwp[(long)(t)*SEQ]; } }while(0)
  #define MPIN(MW) do{}while(0)
  float mhat=0.f,l_reg=0.f;f32x16 o[2];o[0]=f32x16{};o[1]=f32x16{};
  const int qrel=wid*QBLK+r32;
  #define CMASK(P0,P1,t,MW) do{ if(MASK){ bmask(P0,P1,MW,hi); } else { int jb_=(t)-(NT-4); if(jb_>=0)cmask(P0,P1,jb_,qrel,hi); } }while(0)
  bool resc=false;
  #define START(P0,P1) do{ const float rm=rowmax(P0,P1); resc=false; \
    { const float dl=__builtin_fmaxf(rm,-60000.f); mhat=fadd_s(mhat,dl); \
      _Pragma("unroll") for(int r=0;r<16;++r){P0[r]=fsub_s(P0[r],dl);P1[r]=fsub_s(P1[r],dl);} } \
    _Pragma("unroll") for(int r=0;r<16;++r)P0[r]=__builtin_amdgcn_exp2f(P0[r]); }while(0)
  #define RESC() do{ if(resc){ asm volatile("s_waitcnt lgkmcnt(0)":::"memory"); \
      _Pragma("unroll") for(int d_=0;d_<2;++d_) _Pragma("unroll") for(int r=0;r<16;++r)o[d_][r]*=wsf[crow(r,hi)]; } }while(0)
  f32x16 pA0,pA1,pB0,pB1;
  int sl_prev=0,sl_cur=0,sl_next=SLOTB;
  #define ROT() do{sl_prev=sl_cur;sl_cur=sl_next;sl_next=(sl_next==(NSLOT-1)*SLOTB)?0:sl_next+SLOTB;}while(0)
  DMA_K(2,2*SLOTB);
  WAIT_BAR(3);
  binit(pA0,pA1,bp0,0.f);
  qkt(pA0,pA1,Kbase,qr,r32,hi);asm volatile("s_nop 15\n\ts_nop 7":"+v"(pA0),"+v"(pA1));CMASK(pA0,pA1,0,mwA);
  START(pA0,pA1);
  _Pragma("unroll") for(int r=0;r<16;++r)pA1[r]=__builtin_amdgcn_exp2f(pA1[r]);
  WAIT_BAR(0);
  DMA_K(3,0);DMA_V(1,SLOTB);MLOAD(mwA,2);
  ROT();
  kload8(kf,kp0+sl_cur);
  if(MASK){WAIT_BAR(3);}else{WAIT_BAR(2);}
  s16x4 vlo[8],vhi[8]; u32x4 pw0,pw1,pw2,pw3;
  #define PKW(P,B) cvtpk_s(P[B],P[B+1])
  #define PAF(k) __builtin_bit_cast(bf16x8,pw##k)
  #define VFR(i) (bf16x8){vlo[i][0],vlo[i][1],vlo[i][2],vlo[i][3],vhi[i][0],vhi[i][1],vhi[i][2],vhi[i][3]}
  #define PIN(x) asm volatile("":"+v"(x))
  #define MX3(a,b,c) __builtin_fmaxf(__builtin_fmaxf((a),(b)),(c))
  #define GAPA(MF,A0,A1,A2,A3,W0,W1,PW) do{ MF; sacc+=A0; sacc+=A1; sacc+=A2; sacc+=A3; PIN(sacc); W0; W1; PIN(PW); SBAR(); }while(0)
  #define EX(v) __builtin_amdgcn_exp2f(v)
  #define GAPB(MF,X,B) do{ MF; X[B]=EX(X[B]); X[B+1]=EX(X[B+1]); X[B+2]=EX(X[B+2]); X[B+3]=EX(X[B+3]); PIN(X); SBAR(); }while(0)
  #define VRD(i) do{ vlo[i]=vtr(vp_+(((i)>>2)*4096+((i)&3)*1024)); vhi[i]=vtr(vp_+(((i)>>2)*4096+((i)&3)*1024+512)); }while(0)
  #define KRD(G,j) do{ if(G){ kload2(kf,kp0+sl_next,j); SBAR(); } }while(0)
  #define STEP(C0,C1,P0,P1,t,GK,GV,GL,MW,GM,DOCM) do{ SBAR(); \
    const lds_cptr vp_=vp0+sl_prev; \
    binit(C0,C1,bp0+(t)*256,mhat); SBAR(); \
    VRD(0); SBAR(); float sacc=(P0[0]+P0[1]); \
    GAPA(C0=__builtin_amdgcn_mfma_f32_32x32x16_bf16(kf[0],qr[0],C0,0,0,0), P0[2],P0[3],P0[4],P0[5],     pw0[0]=PKW(P0,0), pw0[1]=PKW(P0,2), pw0); \
    VRD(4); SBAR(); GAPA(C1=__builtin_amdgcn_mfma_f32_32x32x16_bf16(kf[1],qr[0],C1,0,0,0), P0[6],P0[7],P0[8],P0[9],     pw0[2]=PKW(P0,4), pw0[3]=PKW(P0,6), pw0); \
    VRD(1); SBAR(); GAPA(C0=__builtin_amdgcn_mfma_f32_32x32x16_bf16(kf[2],qr[1],C0,0,0,0),   P0[10],P0[11],P0[12],P0[13], pw1[0]=PKW(P0,8), pw1[1]=PKW(P0,10), pw1); \
    VRD(5); SBAR(); GAPA(C1=__builtin_amdgcn_mfma_f32_32x32x16_bf16(kf[3],qr[1],C1,0,0,0),   P0[14],P0[15],P1[0],P1[1],   pw1[2]=PKW(P0,12),pw1[3]=PKW(P0,14), pw1); \
    VRD(2); SBAR(); GAPA(C0=__builtin_amdgcn_mfma_f32_32x32x16_bf16(kf[4],qr[2],C0,0,0,0),   P1[2],P1[3],P1[4],P1[5],     pw2[0]=PKW(P1,0), pw2[1]=PKW(P1,2), pw2); \
    VRD(6); SBAR(); GAPA(C1=__builtin_amdgcn_mfma_f32_32x32x16_bf16(kf[5],qr[2],C1,0,0,0),   P1[6],P1[7],P1[8],P1[9],     pw2[2]=PKW(P1,4), pw2[3]=PKW(P1,6), pw2); \
    VRD(3); SBAR(); GAPA(C0=__builtin_amdgcn_mfma_f32_32x32x16_bf16(kf[6],qr[3],C0,0,0,0),   P1[10],P1[11],P1[12],P1[13], pw3[0]=PKW(P1,8), pw3[1]=PKW(P1,10), pw3); \
    VRD(7); SBAR(); GAPA(C1=__builtin_amdgcn_mfma_f32_32x32x16_bf16(kf[7],qr[3],C1,0,0,0),   P1[14],P1[15],0.f,0.f,       pw3[2]=PKW(P1,12),pw3[3]=PKW(P1,14), pw3); \
    l_reg+=sacc; \
    if(MASK&&(DOCM)){ CMASK(C0,C1,t,MW); } \
    if(GK){DMA_K((t)+3,sl_cur);} if(GV){DMA_V((t)+1,sl_next);} \
    if(!MASK&&(DOCM)){ CMASK(C0,C1,t,MW); } \
    if(GM){ MLOAD(MW,(t)+2); } \
    { float a=MX3(C0[0],C0[1],C1[0]),b=MX3(C0[2],C0[3],C1[1]); a=MX3(a,C1[2],C1[3]); \
      _Pragma("unroll") for(int r=4;r<16;r+=4){a=MX3(a,C0[r],C0[r+1]);b=MX3(b,C0[r+2],C0[r+3]);a=MX3(a,C1[r],C1[r+1]);b=MX3(b,C1[r+2],C1[r+3]);} \
      float rm=__builtin_fmaxf(a,b); { auto rr=__builtin_amdgcn_permlane32_swap(__float_as_uint(rm),__float_as_uint(rm),false,false); rm=__builtin_fmaxf(__uint_as_float(rr[0]),__uint_as_float(rr[1])); } \
      resc=false; \
      if(__builtin_expect(__any(rm>(float)THRL),0)){ const float dl=__builtin_fmaxf(rm,0.f); mhat+=dl; \
        _Pragma("unroll") for(int r=0;r<16;++r){C0[r]-=dl;C1[r]-=dl;} \
        const float f=__builtin_amdgcn_exp2f(-dl); l_reg*=f; if(hi==0)wsf[r32]=f; resc=true; } } \
    SBAR(); \
    GAPB(o[0]=__builtin_amdgcn_mfma_f32_32x32x16_bf16(PAF(0),VFR(0),o[0],0,0,0), C0,0); \
    GAPB(o[1]=__builtin_amdgcn_mfma_f32_32x32x16_bf16(PAF(0),VFR(4),o[1],0,0,0), C0,4); \
    KRD(GL,0); GAPB(o[0]=__builtin_amdgcn_mfma_f32_32x32x16_bf16(PAF(1),VFR(1),o[0],0,0,0), C0,8); \
    KRD(GL,1); GAPB(o[1]=__builtin_amdgcn_mfma_f32_32x32x16_bf16(PAF(1),VFR(5),o[1],0,0,0), C0,12); \
    KRD(GL,2); GAPB(o[0]=__builtin_amdgcn_mfma_f32_32x32x16_bf16(PAF(2),VFR(2),o[0],0,0,0), C1,0); \
    KRD(GL,3); GAPB(o[1]=__builtin_amdgcn_mfma_f32_32x32x16_bf16(PAF(2),VFR(6),o[1],0,0,0), C1,4); \
    GAPB(o[0]=__builtin_amdgcn_mfma_f32_32x32x16_bf16(PAF(3),VFR(3),o[0],0,0,0), C1,8); \
    GAPB(o[1]=__builtin_amdgcn_mfma_f32_32x32x16_bf16(PAF(3),VFR(7),o[1],0,0,0), C1,12); \
    }while(0)
  int t=1;
  #define ENDW(tt) do{ if((tt)+3<NT){ if(MASK){WAIT_BAR(3);}else{WAIT_BAR(2);} } else if((tt)+2<NT){ if(MASK){WAIT_BAR(2);}else{WAIT_BAR(1);} } else {WAIT_BAR(0);} }while(0)
  for(;t+5<NT;t+=2){
    STEP(pB0,pB1,pA0,pA1,t,true,true,true,mwB,MASK,MASK);     if(MASK){WAIT_BAR(3);}else{WAIT_BAR(2);} MPIN(mwA); RESC(); ROT();
    STEP(pA0,pA1,pB0,pB1,t+1,true,true,true,mwA,MASK,MASK);   if(MASK){WAIT_BAR(3);}else{WAIT_BAR(2);} MPIN(mwB); RESC(); ROT();
  }
  for(;t+1<NT;t+=2){
    STEP(pB0,pB1,pA0,pA1,t,(t+3<NT),(t+1<NT),(t+1<NT),mwB,(MASK&&(t+2<NT)),true);       ENDW(t);   MPIN(mwA); RESC(); ROT();
    STEP(pA0,pA1,pB0,pB1,t+1,(t+4<NT),(t+2<NT),(t+2<NT),mwA,(MASK&&(t+3<NT)),true);     ENDW(t+1); MPIN(mwB); RESC(); ROT();
  }
  STEP(pB0,pB1,pA0,pA1,NT-1,false,false,false,mwB,false,true); RESC();
  { float sacc=pB0[0]+pB0[1]; _Pragma("unroll") for(int r=2;r<16;++r)sacc+=pB0[r]; _Pragma("unroll") for(int r=0;r<16;++r)sacc+=pB1[r]; l_reg+=sacc;
    pw0=(u32x4){PKW(pB0,0),PKW(pB0,2),PKW(pB0,4),PKW(pB0,6)};pw1=(u32x4){PKW(pB0,8),PKW(pB0,10),PKW(pB0,12),PKW(pB0,14)};pw2=(u32x4){PKW(pB1,0),PKW(pB1,2),PKW(pB1,4),PKW(pB1,6)};pw3=(u32x4){PKW(pB1,8),PKW(pB1,10),PKW(pB1,12),PKW(pB1,14)};
    SBAR(); pv(o,vb0+sl_cur,PAF(0),PAF(1),PAF(2),PAF(3)); }
  #undef PKW
  #undef PAF
  #undef VFR
  #undef PIN
  #undef MX3
  #undef GAPA
  #undef GAPB
  #undef EX
  #undef VRD
  #undef KRD
  #undef STEP
  #undef ENDW
  {auto rr=__builtin_amdgcn_permlane32_swap(__float_as_uint(l_reg),__float_as_uint(l_reg),false,false);l_reg=__uint_as_float(rr[0])+__uint_as_float(rr[1]);}
  if(hi==0)wsf[32+r32]=l_reg;asm volatile("s_waitcnt lgkmcnt(0)":::"memory");
  float rli[16];
  #pragma unroll
  for(int r=0;r<16;++r)rli[r]=__builtin_amdgcn_rcpf(wsf[32+crow(r,hi)]);
  unsigned char*Ow=(unsigned char*)Os+(long)(q0+wid*QBLK)*OP;
  { unsigned char*stg=(unsigned char*)(shm+LDS_OST)+wid*4096;
    #pragma unroll
    for(int r=0;r<16;++r){const int orow=crow(r,hi); const float sc8=rli[r]*8.f;
      #pragma unroll
      for(int d0=0;d0<2;++d0){const float x=__builtin_amdgcn_fmed3f(o[d0][r]*sc8,-448.f,448.f); stg[orow*64+d0*32+r32]=(unsigned char)(__builtin_amdgcn_cvt_pk_fp8_f32(x,x,0,false)&0xff);}}
    asm volatile("s_waitcnt lgkmcnt(0)":::"memory");
    #pragma unroll
    for(int i=0;i<4;++i){const int row=i*8+(lane>>3),ch=lane&7; typedef unsigned u32x2_ __attribute__((ext_vector_type(2))); const u32x2_ v=*(const u32x2_*)(stg+row*64+ch*8); *(u32x2_*)(Ow+(long)row*OP+ch*8)=v;} }
  asm volatile("s_waitcnt lgkmcnt(0)\n\ts_barrier":::"memory");
  #undef DMA_K
  #undef MLOAD
  #undef MPIN
  #undef DMA_V
  #undef CMASK
  #undef START
  #undef RESC
  #undef ROT
}
#undef SBAR
#undef WAIT_BAR
}
struct Args { const float* in[25]; float* out; unsigned char* ws; int ph_lo, ph_hi; };
struct Frame {
    LAS unsigned char* lds; unsigned char* ldsg;
    volatile LAS unsigned* MISC;
    gu32* ctl;
    int tid, lane, wave, vcu, G;
    unsigned char* ws; float* out;
};
__device__ __forceinline__ float dpp_add_(float v, float acc_src, int) { return v; }
#define DPP_F(v, ctrl, rmask) __builtin_bit_cast(float, __builtin_amdgcn_update_dpp(0, __builtin_bit_cast(int, (v)), (ctrl), (rmask), 0xF, false))
__device__ __forceinline__ float wave_sum(float v) {
    v += DPP_F(v, 0xB1, 0xF);
    v += DPP_F(v, 0x4E, 0xF);
    v += DPP_F(v, 0x141, 0xF);
    v += DPP_F(v, 0x140, 0xF);
    v += DPP_F(v, 0x142, 0xA);
    v += DPP_F(v, 0x143, 0xC);
    return __builtin_bit_cast(float, __builtin_amdgcn_readlane(__builtin_bit_cast(int, v), 63));
}
__device__ __forceinline__ bf16* wsb(const Frame& F, size_t off) { return (bf16*)(F.ws + off); }

__device__ __forceinline__ int map_small(int r) {
    if (r < 1024) return r;
    if (r < 1280) return 1028 + (r - 1024);
    if (r < 1536) return 1412 + (r - 1280);
    if (r < 2048) return 1736 + (r - 1536);
    if (r < 2112) return 1284 + (r - 2048);
    if (r < 2176) return 1348 + (r - 2112);
    if (r < 2240) return 1668 + (r - 2176);
    if (r < 2244) return 1024 + (r - 2240);
    if (r < 2248) return 1732 + (r - 2244);
    return -1;
}
__device__ __forceinline__ void tr_item(const float* src, int ld_src, int k0, int srccol, bf16* dst, int ld_dst, LAS float* scr, int lane) {
    float tv[32];
#pragma unroll
    for (int i = 0; i < 32; ++i) { const int kk = 2 * i + (lane >> 5); tv[i] = __builtin_nontemporal_load(src + (size_t)(k0 + kk) * ld_src + (srccol >= 0 ? srccol : 0)); }
#pragma unroll
    for (int i = 0; i < 32; ++i) { const int kk = 2 * i + (lane >> 5); scr[kk * 33 + (lane & 31)] = srccol >= 0 ? tv[i] : 0.f; }
    LDS_WAIT(); asm volatile("" ::: "memory");
    const int c = lane & 7;
#pragma unroll
    for (int j = 0; j < 4; ++j) { const int n = (lane >> 3) + 8 * j; const LAS float* s = scr + (8 * c) * 33 + n;
        v4u o; o.x = pk2(s[0 * 33], s[1 * 33]); o.y = pk2(s[2 * 33], s[3 * 33]); o.z = pk2(s[4 * 33], s[5 * 33]); o.w = pk2(s[6 * 33], s[7 * 33]);
        *(GAS v4u*)(dst + (size_t)n * ld_dst + 8 * c) = o; }
    LDS_WAIT(); asm volatile("" ::: "memory");
}
#ifndef A_F8_TILES
#define A_F8_TILES 0x0DF
#endif
constexpr size_t W_SM8 = 4718592 + 4 * MiB;
constexpr float BR_SCALE = 8.f;
constexpr float MIX_SCALE = 8.f;
constexpr float ACT_SCALE = 8.f;
constexpr float GATE_WSCALE = 32.f;
__device__ __forceinline__ void tr_item8(const float* src, int ld_src, int k0, int srccol, unsigned char* dst, int ld_dst, LAS float* scr, int lane) {
    float tv[32];
#pragma unroll
    for (int i = 0; i < 32; ++i) { const int kk = 2 * i + (lane >> 5); tv[i] = __builtin_nontemporal_load(src + (size_t)(k0 + kk) * ld_src + (srccol >= 0 ? srccol : 0)); }
#pragma unroll
    for (int i = 0; i < 32; ++i) { const int kk = 2 * i + (lane >> 5); scr[kk * 33 + (lane & 31)] = srccol >= 0 ? tv[i] * GATE_WSCALE : 0.f; }
    LDS_WAIT(); asm volatile("" ::: "memory");
    const int c = lane & 7;
#pragma unroll
    for (int j = 0; j < 4; ++j) { const int n = (lane >> 3) + 8 * j; const LAS float* s = scr + (8 * c) * 33 + n;
        v2u o; o.x = pk4_fp8(s[0 * 33], s[1 * 33], s[2 * 33], s[3 * 33]); o.y = pk4_fp8(s[4 * 33], s[5 * 33], s[6 * 33], s[7 * 33]);
        *(GAS v2u*)(dst + (size_t)n * ld_dst + 8 * c) = o; }
    LDS_WAIT(); asm volatile("" ::: "memory");
}
constexpr int IT_SM = 72 * 16, IT_GT = 128 * 16, IT_BR = 512, IT_OUT = 512, IT_GU = 16 * 512, IT_D = 16 * 256, IT_LAYER = IT_SM + IT_GT + IT_BR + IT_OUT + IT_GU + IT_D;
__device__ __forceinline__ void p0_item(const Frame& F, const Args& a, int it, LAS float* scr) {
    const int l = it / IT_LAYER; int j = it % IT_LAYER; const int n = F.lane & 31;
    bf16* W = wsb(F, WS_W + (size_t)l * W_LAYER);
    if (j < IT_SM) { const int g = j / 16, kb = j % 16;
        if ((A_F8_TILES >> (g / 8)) & 1) tr_item8(a.in[3] + (size_t)l * DM * P_TOTAL, P_TOTAL, kb * 64, map_small(g * 32 + n), (unsigned char*)W + W_SM8 + (size_t)(g * 32) * DM + kb * 64, DM, scr, F.lane);
        else tr_item(a.in[3] + (size_t)l * DM * P_TOTAL, P_TOTAL, kb * 64, map_small(g * 32 + n), W + W_SM / 2 + (size_t)(g * 32) * DM + kb * 64, DM, scr, F.lane);
        return; } j -= IT_SM;
    if (j < IT_GT) { const int g = j / 16, kb = j % 16; tr_item8(a.in[3] + (size_t)l * DM * P_TOTAL, P_TOTAL, kb * 64, 2248 + g * 32 + n, (unsigned char*)W + W_GT + (size_t)(g * 32) * DM + kb * 64, DM, scr, F.lane); return; } j -= IT_GT;
    if (j < IT_BR) { const int nb = j / 128, jj = j % 128, g = jj / 4, kb = jj % 4;
        tr_item8(a.in[12] + ((size_t)l * 4 + nb) * 256 * DM, DM, kb * 64, g * 32 + n, (unsigned char*)W + W_BR + (size_t)(g * 32) * DM + nb * 256 + kb * 64, DM, scr, F.lane); return; } j -= IT_BR;
    if (j < IT_OUT) { const int g = j / 16, kb = j % 16; tr_item8(a.in[13] + (size_t)l * DM * DM, DM, kb * 64, g * 32 + n, (unsigned char*)W + W_OUT + (size_t)(g * 32) * DM + kb * 64, DM, scr, F.lane); return; } j -= IT_OUT;
    if (j < IT_GU) { const int e = j / 512, jj = j % 512, g = jj / 16, kb = jj % 16; const int r0 = g * 32, q = r0 >> 8, within = r0 & 255; const bool isup = within >= 128;
        const float* src = (isup ? a.in[21] : a.in[20]) + ((size_t)l * 16 + e) * DM * 512;
        tr_item8(src, 512, kb * 64, 128 * q + (within & 127) + n, (unsigned char*)W + W_GU + (size_t)e * DM * DM + (size_t)r0 * DM + kb * 64, DM, scr, F.lane); return; } j -= IT_GU;
    { const int e = j / 256, jj = j % 256, g = jj / 8, kb = jj % 8;
        tr_item8(a.in[22] + ((size_t)l * 16 + e) * 512 * DM, DM, kb * 64, g * 32 + n, (unsigned char*)W + W_D + (size_t)(e >> 1) * DM * DM + (size_t)(g * 32) * DM + (e & 1) * 512 + kb * 64, DM, scr, F.lane); }
}
__device__ __forceinline__ void ln_load(const Frame& F, const float* xrow, f32x4 (&v)[4]) {
    const GAS f32x4* xr = (const GAS f32x4*)xrow + 2 * F.lane;
#pragma unroll
    for (int j = 0; j < 2; ++j) { v[2 * j] = __builtin_nontemporal_load(xr + 128 * j); v[2 * j + 1] = __builtin_nontemporal_load(xr + 128 * j + 1); }
}
struct LnGB { f32x4 g[4], b[4]; };
__device__ __forceinline__ void ln_gb_load(const Frame& F, const float* g, const float* b, LnGB& gb) {
#pragma unroll
    for (int j = 0; j < 2; ++j) { gb.g[2 * j] = ((const GAS f32x4*)g)[2 * F.lane + 128 * j]; gb.g[2 * j + 1] = ((const GAS f32x4*)g)[2 * F.lane + 128 * j + 1]; gb.b[2 * j] = ((const GAS f32x4*)b)[2 * F.lane + 128 * j]; gb.b[2 * j + 1] = ((const GAS f32x4*)b)[2 * F.lane + 128 * j + 1]; }
}
__device__ __forceinline__ void ln_load_bf(const Frame& F, const bf16* xrow, f32x4 (&v)[4]) {
    const GAS v4u* xr = (const GAS v4u*)xrow + F.lane;
#pragma unroll
    for (int j = 0; j < 2; ++j) { const v4u w = __builtin_nontemporal_load(xr + 64 * j);     v[2 * j] = (f32x4){bfl(w.x), bfh(w.x), bfl(w.y), bfh(w.y)}; v[2 * j + 1] = (f32x4){bfl(w.z), bfh(w.z), bfl(w.w), bfh(w.w)}; }
}
__device__ __forceinline__ void ln_row(const Frame& F, const LnGB& gb, float* orow  , bf16* brow  , f32x4 (&v)[4], bool dry = false, unsigned char* frow = nullptr  ) {
    float s = 0.f;
#pragma unroll
    for (int j = 0; j < 4; ++j) s += (v[j].x + v[j].y) + (v[j].z + v[j].w);
    const float mean = wave_sum(s) * (1.f / DM); float s2 = 0.f;
#pragma unroll
    for (int j = 0; j < 4; ++j) { v[j] = v[j] - mean; s2 += (v[j].x * v[j].x + v[j].y * v[j].y) + (v[j].z * v[j].z + v[j].w * v[j].w); }
    const float rstd = 1.f / sqrtf(wave_sum(s2) * (1.f / DM) + LN_EPS);
    GAS f32x4* o4 = (GAS f32x4*)orow + 2 * F.lane; GAS v4u* o8 = (GAS v4u*)brow + F.lane; GAS v2u* o1 = (GAS v2u*)frow + F.lane;
#pragma unroll
    for (int j = 0; j < 4; ++j) v[j] = v[j] * rstd * gb.g[j] + gb.b[j];
#pragma unroll
    for (int j = 0; j < 2; ++j) { const f32x4 a_ = v[2 * j], b_ = v[2 * j + 1]; v4u w; w.x = pk2(a_.x, a_.y); w.y = pk2(a_.z, a_.w); w.z = pk2(b_.x, b_.y); w.w = pk2(b_.z, b_.w);
        if (!dry) { if (orow) { o4[128 * j] = a_; o4[128 * j + 1] = b_; } if (brow) o8[64 * j] = w; if (frow) { v2u f_; f_.x = pk4_fp8(a_.x, a_.y, a_.z, a_.w); f_.y = pk4_fp8(b_.x, b_.y, b_.z, b_.w); o1[64 * j] = f_; } } }
}
__device__ __forceinline__ void p0_prologue(const Frame& F_, const Args& a) { Frame F = F_; F.lane = lane_id_(); F.tid = F.wave * 64 + F.lane;
    LAS float* scr = (LAS float*)(F.lds + RING_OFF + F.wave * 16384);
    const int gw = F.vcu * NWAVES + F.wave, NGW = F.G * NWAVES;
    for (int it = gw; it < DEPTH * IT_LAYER; it += NGW) p0_item(F, a, it, scr);
    { LnGB gb; ln_gb_load(F, a.in[1], a.in[2], gb); f32x4 nx[4]; ln_load(F, a.in[0] + (size_t)gw * DM, nx);
      for (int m = gw; m < NTOK; m += NGW) { f32x4 v[4];
#pragma unroll
          for (int j = 0; j < 4; ++j) v[j] = nx[j];
          if (m + NGW < NTOK) ln_load(F, a.in[0] + (size_t)(m + NGW) * DM, nx);
          ln_row(F, gb, nullptr, wsb(F, WS_HB) + (size_t)m * DM, v, false, F.ws + WS_HB8 + (size_t)m * DM); } }
}

#ifndef TO_WGM
#define TO_WGM 8
#endif
struct TileOrder {
    int nM, nN, nwg, G, c;
    __device__ void init(int nM_, int nN_, int G_, int c_) { nM = nM_; nN = nN_; nwg = nM * nN; G = G_; c = c_; }
    __device__ bool tile(int i, int& pm, int& pn) const {
        const long L = (long)i * G + c; if (L >= nwg) return false;
        int wgid = (int)L; { const int q = nwg / 8, r = nwg % 8, xcd = wgid % 8, off = wgid / 8; wgid = (xcd < r ? xcd * (q + 1) : r * (q + 1) + (xcd - r) * q) + off; }
        const int nig = TO_WGM * nN, gid = wgid / nig, fm = gid * TO_WGM;
        pm = fm + ((wgid % nig) % TO_WGM); pn = (wgid % nig) / TO_WGM; return true;
    }
};
template <bool F8_> struct SchedAT { static constexpr int NT = 0, KS = 0; TileOrder T; const char* A; const char* B; unsigned map;
    __device__ bool next(int i, pg8::GU& u) const { int pm, pq; if (!T.tile(i, pm, pq)) return false; const int pn = (int)((map >> (4 * pq)) & 15u); constexpr size_t TS = F8_ ? pg8::TSTEP / 2 : pg8::TSTEP;
        u.A = A + (size_t)pm * TS; u.B0 = B + (size_t)pn * TS; u.B1 = u.B0; u.nt = F8_ ? 8 : 16; u.ks = u.nt; u.pm = pm; u.pn = pn; u.rows = nullptr; u.rbase = 0; u.rcnt = 0; u.a0 = 0; u.a1 = 0; return true; } };
template <bool F8_> struct EpiAT { static constexpr bool F8 = F8_; static constexpr bool PERM = true; bf16* P; float* FW; bf16* KIDX;
    __device__ __forceinline__ void operator()(const pg8::f32x4 (&acc)[2][2][4][2], const pg8::GU& u, int wr, int wc, int fr, int fq) {
        const float sc = ((u.pn == 1 || u.pn == 4) ? 0.125f * LOG2E : 1.f) * (F8_ ? 1.f / GATE_WSCALE : 1.f);
        const int row0 = u.pm * 256 + wr * 64 + fr, col0 = u.pn * 256 + wc * 32 + 8 * fq;
#pragma unroll
        for (int ai = 0; ai < 2; ++ai)
#pragma unroll
            for (int m = 0; m < 4; ++m) { const int row = row0 + ai * 128 + m * 16; bf16* rowp = P + (size_t)row * PS + col0;
#pragma unroll
                for (int bj = 0; bj < 2; ++bj) { const pg8::f32x4 v0 = acc[ai][bj][m][0] * sc, v1 = acc[ai][bj][m][1] * sc; v4u w;
                    w.x = pg8::cvt_pk_bf16(v0[0], v0[1]); w.y = pg8::cvt_pk_bf16(v0[2], v0[3]); w.z = pg8::cvt_pk_bf16(v1[0], v1[1]); w.w = pg8::cvt_pk_bf16(v1[2], v1[3]);
                    *(v4u*)(rowp + bj * 128) = w;
                    if (bj == 1 && u.pn == 8 && wc < 2) *(v4u*)(KIDX + (size_t)row * 64 + wc * 32 + 8 * fq) = w;
                    if (bj == 1 && u.pn == 8 && wc == 2 && fq == 0) { *(f32x4*)(FW + (size_t)row * 8) = v0; *(f32x4*)(FW + (size_t)row * 8 + 4) = v1; } } }
    } };
struct SchedC { TileOrder T; const char* HBp; const char* BRp; const char* WGp; const char* WBp; bool collapse;
    __device__ bool next(int i, pg8::GU& u) const { int pm, pd; if (!T.tile(i >> 3, pm, pd)) return false; const int sub = i & 7, n = sub >> 1, isg = sub & 1; const int pm_o = pm, pd_o = pd; if (collapse) { pm &= 7; pd = 0; }
        u.pm = pm; u.pn = pd; u.a0 = n; u.a1 = isg; u.rows = nullptr; u.rbase = 0; u.rcnt = 0;
        if (isg) { u.A = HBp + (size_t)pm * (pg8::TSTEP / 2); u.B0 = WGp + (size_t)(n * 8 + pd) * (pg8::HSTEP / 2); u.nt = 8; }
        else     { u.A = BRp + (size_t)pm * (pg8::TSTEP / 2) + n * 256; u.B0 = WBp + (size_t)pd * (pg8::HSTEP / 2) + n * 256; u.nt = 2; }
        u.B1 = u.B0; u.ks = u.nt; u.pm = pm_o; u.pn = pd_o; return true; } };
struct EpiC { static constexpr bool F8 = false; static constexpr bool PERM = true; bf16* MIX; const float* bgate; bool dry;
    __device__ __forceinline__ void operator()(const pg8::f32x4 (&acc)[2][4][2], pg8::u32x4 (&upk)[4]  , LAS v4u* ulds  , pg8::u32x4 (&sum)[2][4]  , const pg8::GU& u, int wr, int wc, int fr, int fq) {
        const int n = u.a0;
        if (!u.a1) {
#pragma unroll
            for (int ai = 0; ai < 2; ++ai)
#pragma unroll
                for (int m = 0; m < 4; ++m) { const pg8::f32x4 v0 = acc[ai][m][0] * (1.f / (BR_SCALE * GATE_WSCALE)), v1 = acc[ai][m][1] * (1.f / (BR_SCALE * GATE_WSCALE)); v4u w;
                    w.x = pg8::cvt_pk_bf16(v0[0], v0[1]); w.y = pg8::cvt_pk_bf16(v0[2], v0[3]); w.z = pg8::cvt_pk_bf16(v1[0], v1[1]); w.w = pg8::cvt_pk_bf16(v1[2], v1[3]); if (ai == 0) upk[m] = w; else ulds[(m >> 1) * 2048 + (m & 1) * 512] = w; }
        } else {
            const int colt = u.pn * 128 + wc * 32 + 8 * fq; const float* bp = bgate + n * DM + colt; const f32x4 b0 = *(const f32x4*)bp, b1 = *(const f32x4*)(bp + 4);
#pragma unroll
            for (int ai = 0; ai < 2; ++ai)
#pragma unroll
                for (int m = 0; m < 4; ++m) { const v4u uw = ai == 0 ? (v4u)upk[m] : ulds[(m >> 1) * 2048 + (m & 1) * 512]; const pg8::f32x4 g0 = acc[ai][m][0] * (1.f / GATE_WSCALE) + b0, g1 = acc[ai][m][1] * (1.f / GATE_WSCALE) + b1;
                    pg8::f32x4 r0, r1; r0[0] = sigmoidf_(g0[0]) * bfl(uw.x); r0[1] = sigmoidf_(g0[1]) * bfh(uw.x); r0[2] = sigmoidf_(g0[2]) * bfl(uw.y); r0[3] = sigmoidf_(g0[3]) * bfh(uw.y);
                    r1[0] = sigmoidf_(g1[0]) * bfl(uw.z); r1[1] = sigmoidf_(g1[1]) * bfh(uw.z); r1[2] = sigmoidf_(g1[2]) * bfl(uw.w); r1[3] = sigmoidf_(g1[3]) * bfh(uw.w);
                    if (n > 0) { const v4u pw = sum[ai][m]; r0[0] += bfl(pw.x); r0[1] += bfh(pw.x); r0[2] += bfl(pw.y); r0[3] += bfh(pw.y); r1[0] += bfl(pw.z); r1[1] += bfh(pw.z); r1[2] += bfl(pw.w); r1[3] += bfh(pw.w); }
                    v4u o; o.x = pg8::cvt_pk_bf16(r0[0], r0[1]); o.y = pg8::cvt_pk_bf16(r0[2], r0[3]); o.z = pg8::cvt_pk_bf16(r1[0], r1[1]); o.w = pg8::cvt_pk_bf16(r1[2], r1[3]); sum[ai][m] = o; }
            if (n == 3) { const int row0 = u.pm * 256 + wr * 64 + fr; unsigned char* M8 = (unsigned char*)MIX;
#pragma unroll
                for (int ai = 0; ai < 2; ++ai)
#pragma unroll
                    for (int m = 0; m < 4; ++m) { const v4u pw = sum[ai][m]; v2u o;
                        o.x = pk4_fp8(bfl(pw.x) * MIX_SCALE, bfh(pw.x) * MIX_SCALE, bfl(pw.y) * MIX_SCALE, bfh(pw.y) * MIX_SCALE); o.y = pk4_fp8(bfl(pw.z) * MIX_SCALE, bfh(pw.z) * MIX_SCALE, bfl(pw.w) * MIX_SCALE, bfh(pw.w) * MIX_SCALE);
                        *(v2u*)(M8 + (size_t)(row0 + ai * 128 + m * 16) * DM + colt) = o; } }
        }
    } };
struct SchedC2 { static constexpr int NT = 0, KS = 0; TileOrder T; const char* A; const char* B;
    __device__ bool next(int i, pg8::GU& u) const { int pm, pn; if (!T.tile(i, pm, pn)) return false; u.A = A + (size_t)pm * (pg8::TSTEP / 2); u.B0 = B + (size_t)pn * (pg8::TSTEP / 2); u.B1 = u.B0; u.nt = 8; u.ks = 8; u.pm = pm; u.pn = pn; u.rows = nullptr; u.rbase = 0; u.rcnt = 0; u.a0 = 0; u.a1 = 0; return true; } };
struct EpiRes { static constexpr bool F8 = true; static constexpr bool PERM = true; bf16* V1; const bf16* HB; bool dry;
    __device__ __forceinline__ void operator()(const pg8::f32x4 (&acc)[2][2][4][2], const pg8::GU& u, int wr, int wc, int fr, int fq) {
        const int row0 = u.pm * 256 + wr * 64 + fr, col0 = u.pn * 256 + wc * 32 + 8 * fq;
#pragma unroll
        for (int ai = 0; ai < 2; ++ai)
#pragma unroll
            for (int m = 0; m < 4; ++m) { const unsigned ro = ((unsigned)(row0 + ai * 128 + m * 16) * (unsigned)DM + (unsigned)col0) * 2u;
#pragma unroll
                for (int bj = 0; bj < 2; ++bj) { const v4u hw = *(const v4u*)((const char*)HB + ro + bj * 256);
                    const f32x4 h0 = (f32x4){bfl(hw.x), bfh(hw.x), bfl(hw.y), bfh(hw.y)}, h1 = (f32x4){bfl(hw.z), bfh(hw.z), bfl(hw.w), bfh(hw.w)};
                    const f32x4 r0 = h0 * ALPHA + acc[ai][bj][m][0] * (1.f / (MIX_SCALE * GATE_WSCALE)), r1 = h1 * ALPHA + acc[ai][bj][m][1] * (1.f / (MIX_SCALE * GATE_WSCALE));
                    v4u o; o.x = pk2(r0.x, r0.y); o.y = pk2(r0.z, r0.w); o.z = pk2(r1.x, r1.y); o.w = pk2(r1.z, r1.w); if (!dry) *(v4u*)((char*)V1 + ro + bj * 256) = o; } }
    } };
__device__ __forceinline__ int cls_starts(const LAS int* tab) { const int ln = lane_id_(); return ln < NCLS ? tab[32 + ln] : 0x7fffffff; }
__device__ __forceinline__ void cls_lookup(int stv, int tau, int& c, int& j) {
    const int cc = (int)__popcll(__ballot(stv <= tau)) - 1;
    c = cc; j = tau - __builtin_amdgcn_readlane(stv, cc);
}
__device__ __forceinline__ void cls_experts(int c, int& ea, int& eb) { const int g = c / 6, p = c % 6; const int i = p < 3 ? 0 : (p < 5 ? 1 : 2); const int jj = p < 3 ? p + 1 : (p < 5 ? p - 1 : 3); ea = g * 4 + i; eb = g * 4 + jj; }
struct SchedD1 { static constexpr int NT = 0, KS = 0; const LAS int* tab; int G, c0; const char* HBp; const char* WGU; const int* list;
    __device__ bool next(int i, pg8::GU& u) const { const int L = i * G + c0; if (L >= tab[57] * 8) return false; const int tau = L >> 3, pn = L & 7; int c, j; cls_lookup(cls_starts(tab), tau, c, j); int ea, eb; cls_experts(c, ea, eb);
        const int e = (pn >> 2) ? eb : ea;
        u.A = HBp; u.B0 = WGU + (size_t)e * DM * DM + (size_t)(pn & 3) * (pg8::TSTEP / 2); u.B1 = u.B0; u.nt = 8; u.ks = 8;     u.rows = list + (size_t)c * NTOK; u.rbase = j * 256; u.rcnt = tab[c];
        u.pm = tau; u.pn = pn; u.a0 = c; u.a1 = j; return true; } };
struct EpiD1 { static constexpr bool F8 = true; static constexpr bool PERM = true; unsigned char* ACT; const float* gwl;
    __device__ __forceinline__ void operator()(const pg8::f32x4 (&acc)[2][2][4][2], const pg8::GU& u, int wr, int wc, int fr, int fq) {
        const int half = u.pn >> 2, col = half * 512 + (u.pn & 3) * 128 + wc * 32 + 8 * fq;
        const int frl = opaque_i(fr); float gwv[2][4];
#pragma unroll
        for (int ai = 0; ai < 2; ++ai)
#pragma unroll
            for (int m = 0; m < 4; ++m) { const int pos = u.rbase + ai * 128 + wr * 64 + m * 16 + frl; gwv[ai][m] = pos < u.rcnt ? gwl[((size_t)u.a0 * NTOK + pos) * 2 + half] : 0.f; }
#pragma unroll
        for (int ai = 0; ai < 2; ++ai)
#pragma unroll
            for (int m = 0; m < 4; ++m) { const int r = ai * 128 + wr * 64 + m * 16 + frl;
                const float gw = gwv[ai][m] * ACT_SCALE;
                const pg8::f32x4 g0 = acc[ai][0][m][0] * (1.f / GATE_WSCALE), g1 = acc[ai][0][m][1] * (1.f / GATE_WSCALE), u0 = acc[ai][1][m][0] * (1.f / GATE_WSCALE), u1 = acc[ai][1][m][1] * (1.f / GATE_WSCALE); float r8[8];
#pragma unroll
                for (int k = 0; k < 4; ++k) { r8[k] = g0[k] * sigmoidf_(g0[k]) * u0[k] * gw; r8[4 + k] = g1[k] * sigmoidf_(g1[k]) * u1[k] * gw; }
                v2u o; o.x = pk4_fp8(r8[0], r8[1], r8[2], r8[3]); o.y = pk4_fp8(r8[4], r8[5], r8[6], r8[7]);
                *(v2u*)(ACT + ((size_t)u.pm * 256 + r) * DM + col) = o; asm volatile("" ::: "memory"); }
    } };
struct SchedD2 { static constexpr int NT = 8, KS = 4; const LAS int* tab; int G, c0; const char* ACTp; const char* WD; const int* list;
    __device__ bool next(int i, pg8::GU& u) const { const int L = i * G + c0; if (L >= __builtin_amdgcn_readfirstlane(tab[57]) * 4) return false; const int tau = L >> 2, pn = L & 3; int c, j; cls_lookup(cls_starts(tab), tau, c, j); c = __builtin_amdgcn_readfirstlane(c); j = __builtin_amdgcn_readfirstlane(j); int ea, eb; cls_experts(c, ea, eb);
        u.A = sptr_(ACTp + (size_t)tau * (pg8::TSTEP / 2)); u.B0 = sptr_(WD + (size_t)(ea >> 1) * DM * DM + (ea & 1) * 512 + (size_t)pn * (pg8::TSTEP / 2)); u.B1 = sptr_(WD + (size_t)(eb >> 1) * DM * DM + (eb & 1) * 512 + (size_t)pn * (pg8::TSTEP / 2));
        u.nt = 8; u.ks = 4;     u.rows = list + (size_t)c * NTOK; u.rbase = j * 256; u.rcnt = __builtin_amdgcn_readfirstlane(tab[c]); u.pm = tau; u.pn = pn; u.a0 = c; u.a1 = j; return true; } };
struct EpiD2 { static constexpr bool F8 = true; static constexpr bool PERM = true; bf16* V2; const bf16* HB; bool dry;
    __device__ __forceinline__ void operator()(const pg8::f32x4 (&acc)[2][2][4][2], const pg8::GU& u, int wr, int wc, int fr, int fq) {
        const int col0 = u.pn * 256 + wc * 32 + 8 * fq;
        const int frl = opaque_i(fr); int tok[2][4];
#pragma unroll
        for (int ai = 0; ai < 2; ++ai)
#pragma unroll
            for (int m = 0; m < 4; ++m) { const int pos = u.rbase + ai * 128 + wr * 64 + m * 16 + frl; tok[ai][m] = pos < u.rcnt ? *(const int*)((const char*)u.rows + (unsigned)pos * 4u) : -1; }
#define D2_LD(m_, A, B_) const unsigned ro##m_ = ((unsigned)(tok[ai][m_] >= 0 ? tok[ai][m_] : 0) * (unsigned)DM + (unsigned)col0) * 2u;     \
        const v4u A = *(const v4u*)((const char*)HB + ro##m_), B_ = *(const v4u*)((const char*)HB + ro##m_ + 256)
#define D2_ST(m_, bj_, H) do { const f32x4 h0 = (f32x4){bfl(H.x), bfh(H.x), bfl(H.y), bfh(H.y)}, h1 = (f32x4){bfl(H.z), bfh(H.z), bfl(H.w), bfh(H.w)}; \
        const f32x4 r0 = h0 * ALPHA + acc[ai][bj_][m_][0] * (1.f / (ACT_SCALE * GATE_WSCALE)), r1 = h1 * ALPHA + acc[ai][bj_][m_][1] * (1.f / (ACT_SCALE * GATE_WSCALE)); \
        v4u o; o.x = pk2(r0.x, r0.y); o.y = pk2(r0.z, r0.w); o.z = pk2(r1.x, r1.y); o.w = pk2(r1.z, r1.w); if (!dry && tok[ai][m_] >= 0) *(v4u*)((char*)V2 + ro##m_ + (bj_) * 256) = o; } while (0)
#pragma unroll
        for (int ai = 0; ai < 2; ++ai) {
            { asm volatile("" ::: "memory"); D2_LD(0, h00, h01); D2_LD(1, h10, h11); D2_ST(0, 0, h00); D2_ST(0, 1, h01); D2_ST(1, 0, h10); D2_ST(1, 1, h11); }
            { asm volatile("" ::: "memory"); D2_LD(2, h20, h21); D2_LD(3, h30, h31); D2_ST(2, 0, h20); D2_ST(2, 1, h21); D2_ST(3, 0, h30); D2_ST(3, 1, h31); } }
#undef D2_LD
#undef D2_ST
    } };
typedef float f32x2v __attribute__((ext_vector_type(2)));
__device__ __forceinline__ float log_sigmoid_(float x) { return fminf(x, 0.f) - __builtin_amdgcn_logf(1.f + __builtin_amdgcn_exp2f(-fabsf(x) * LOG2E)) * 0.6931471805599453f; }
__device__ __forceinline__ void fox_cumsum(const Frame& F_, int bh, const float* FW, const float* bfor, float* bias2) { Frame F = F_; F.lane = lane_id_(); F.tid = F.wave * 64 + F.lane;
    const int b = bh >> 2, h = bh & 3; const float bf = bfor[h]; const float* src = FW + ((size_t)b * SEQ + F.lane * 64) * 8 + h; float tot = 0.f;
    float ls[64];
#pragma unroll
    for (int i = 0; i < 64; ++i) ls[i] = src[(size_t)i * 8];
#pragma unroll
    for (int i = 0; i < 64; ++i) { ls[i] = log_sigmoid_(ls[i] + bf); tot += ls[i]; }
    float inc = tot;
#pragma unroll
    for (int o = 1; o < 64; o <<= 1) { const float t = __int_as_float(shfl_i_(__float_as_int(inc), F.lane - o)); if (F.lane >= o) inc += t; }
    float run = inc - tot; float* dst = bias2 + (size_t)bh * SEQ + F.lane * 64;
#pragma unroll
    for (int i = 0; i < 64; i += 4) { f32x4 o4; run += ls[i]; o4.x = -run * LOG2E; run += ls[i + 1]; o4.y = -run * LOG2E; run += ls[i + 2]; o4.z = -run * LOG2E; run += ls[i + 3]; o4.w = -run * LOG2E; *(f32x4*)(dst + i) = o4; }
}
template <int WIN> __device__ __forceinline__ void pool_frags(bf16x8 (&af)[4], const bf16* src0, int tb) {
    const int nrow = tb + 1 < WIN ? tb + 1 : WIN; const float inv = 1.f / (float)nrow;
#pragma unroll
    for (int ks = 0; ks < 4; ++ks) { const bf16* src = src0 + ks * 16; v4u wv[WIN];
#pragma unroll
        for (int j = 0; j < WIN; ++j) wv[j] = *(const v4u*)(src - (size_t)(j <= tb ? j : 0) * PS);
        float s[8];
#pragma unroll
        for (int k = 0; k < 8; ++k) s[k] = 0.f;
#pragma unroll
        for (int j = 0; j < WIN; ++j) { if (j <= tb) { const v4u w = wv[j];
            s[0] += bfl(w.x); s[1] += bfh(w.x); s[2] += bfl(w.y); s[3] += bfh(w.y); s[4] += bfl(w.z); s[5] += bfh(w.z); s[6] += bfl(w.w); s[7] += bfh(w.w); } }
        const v4u cur = wv[0];
        const float c[8] = {bfl(cur.x), bfh(cur.x), bfl(cur.y), bfh(cur.y), bfl(cur.z), bfh(cur.z), bfl(cur.w), bfh(cur.w)};
        v4u o; o.x = pk2(s[0] * inv - c[0], s[1] * inv - c[1]); o.y = pk2(s[2] * inv - c[2], s[3] * inv - c[3]); o.z = pk2(s[4] * inv - c[4], s[5] * inv - c[5]); o.w = pk2(s[6] * inv - c[6], s[7] * inv - c[7]);
        af[ks] = __builtin_bit_cast(bf16x8, o); }
}
__device__ __forceinline__ void pool_unit(const Frame& F_, int tile, const bf16* P, const float* pw, const float* pscale, bf16* BR) { Frame F = F_; F.lane = lane_id_(); F.tid = F.wave * 64 + F.lane;
    const int g = F.wave & 3, th = F.wave >> 2, r32 = F.lane & 31, hi = F.lane >> 5;
    const int tok = tile * 64 + th * 32 + r32, tb = tok & (SEQ - 1);
    const bf16* src0 = P + (size_t)tok * PS + C_POOL + g * 64 + hi * 8;
    bf16x8 af[4];
    if (g == 0) pool_frags<2>(af, src0, tb); else if (g == 1) pool_frags<4>(af, src0, tb); else if (g == 2) pool_frags<8>(af, src0, tb); else pool_frags<16>(af, src0, tb);
    LAS unsigned char* stg = F.lds + RING_OFF + F.wave * 2048;
#pragma unroll
    for (int db = 0; db < 2; ++db) { f32x16 acc = {};
#pragma unroll
        for (int ks = 0; ks < 4; ++ks) { const float* wp = pw + ((size_t)g * 64 + ks * 16 + hi * 8) * 64 + db * 32 + r32;
            v4u o; o.x = pk2(wp[0], wp[64]); o.y = pk2(wp[128], wp[192]); o.z = pk2(wp[256], wp[320]); o.w = pk2(wp[384], wp[448]);
            acc = __builtin_amdgcn_mfma_f32_32x32x16_bf16(af[ks], __builtin_bit_cast(bf16x8, o), acc, 0, 0, 0); }
        const int col = g * 64 + db * 32 + r32; const float sc = pscale[col];
#pragma unroll
        for (int r = 0; r < 16; ++r) { const int lrow = (r & 3) + 8 * (r >> 2) + 4 * hi; const float x_ = sat8_(acc[r] * sc * BR_SCALE); stg[lrow * 64 + db * 32 + r32] = (unsigned char)(__builtin_amdgcn_cvt_pk_fp8_f32(x_, x_, 0, false) & 0xff); } }
    asm volatile("s_waitcnt lgkmcnt(0)" ::: "memory");
#pragma unroll
    for (int i = 0; i < 2; ++i) { const int pc = F.lane + 64 * i, lrow = pc >> 2, c16 = (pc & 3) * 16; const v4u v = *(const LAS v4u*)(stg + lrow * 64 + c16);
        *(v4u*)((unsigned char*)BR + (size_t)(tile * 64 + th * 32 + lrow) * DM + g * 64 + c16) = v; }
    asm volatile("s_waitcnt lgkmcnt(0)" ::: "memory");
}
__device__ __forceinline__ void conv_unit(const Frame& F_, int tile, const bf16* P, const float* dw, const float* cb, const float* lg, const float* lb, bf16* BR) { Frame F = F_; F.lane = lane_id_(); F.tid = F.wave * 64 + F.lane;
    LAS float* hb = (LAS float*)(F.lds + RING_OFF);
    LAS float* yb = hb + 62 * 256;
    const int t0 = tile * 32, tb0 = t0 & (SEQ - 1);
    { v4u av[4], gv[4];
#pragma unroll
      for (int k = 0; k < 4; ++k) { const int e = F.tid + k * NWAVES * 64, rr = e >> 5, c8 = (e & 31) * 8, trel = rr - 30; const bool ok = e < 62 * 32 && tb0 + trel >= 0;
          const bf16* src = P + (size_t)(t0 + (ok ? trel : 0)) * PS + C_CONV + c8; av[k] = *(const v4u*)src; gv[k] = *(const v4u*)(src + 256); }
#pragma unroll
      for (int k = 0; k < 4; ++k) { const int e = F.tid + k * NWAVES * 64, rr = e >> 5, c8 = (e & 31) * 8, trel = rr - 30; const bool ok = tb0 + trel >= 0; const v4u a = av[k], gt = gv[k]; float h[8];
          h[0] = bfl(a.x) * sigmoidf_(bfl(gt.x)); h[1] = bfh(a.x) * sigmoidf_(bfh(gt.x)); h[2] = bfl(a.y) * sigmoidf_(bfl(gt.y)); h[3] = bfh(a.y) * sigmoidf_(bfh(gt.y));
          h[4] = bfl(a.z) * sigmoidf_(bfl(gt.z)); h[5] = bfh(a.z) * sigmoidf_(bfh(gt.z)); h[6] = bfl(a.w) * sigmoidf_(bfl(gt.w)); h[7] = bfh(a.w) * sigmoidf_(bfh(gt.w));
          if (!ok) {
#pragma unroll
              for (int q = 0; q < 8; ++q) h[q] = 0.f; }
          if (e < 62 * 32) { *(LAS f32x4*)(hb + rr * 256 + c8) = (f32x4){h[0], h[1], h[2], h[3]}; *(LAS f32x4*)(hb + rr * 256 + c8 + 4) = (f32x4){h[4], h[5], h[6], h[7]}; } } }
    __syncthreads();
    { const int c = F.tid & 255, hf = F.tid >> 8; float w[31];
#pragma unroll
      for (int j = 0; j < 31; ++j) w[j] = dw[j * 256 + c];
      const float bias = cb[c];
#pragma unroll 1
      for (int q4 = 0; q4 < 4; ++q4) { const int tt = hf * 16 + q4 * 4; float x[34];
#pragma unroll
          for (int j = 0; j < 34; ++j) x[j] = hb[(tt + j) * 256 + c];
#pragma unroll
          for (int o = 0; o < 4; ++o) { float a = bias;
#pragma unroll
              for (int j = 0; j < 31; ++j) a += x[o + j] * w[j];
              yb[(tt + o) * 256 + c] = a; } } }
    __syncthreads();
#pragma unroll 1
    for (int q = 0; q < 4; ++q) { const int tt = F.wave * 4 + q; const f32x4 v = *(const LAS f32x4*)(yb + tt * 256 + F.lane * 4);
        const float mean = wave_sum((v.x + v.y) + (v.z + v.w)) * (1.f / 256.f); const f32x4 d = v - mean;
        const float var = wave_sum((d.x * d.x + d.y * d.y) + (d.z * d.z + d.w * d.w)) * (1.f / 256.f); const float rstd = 1.f / sqrtf(var + LN_EPS);
        const f32x4 gg = *(const f32x4*)(lg + F.lane * 4), bb = *(const f32x4*)(lb + F.lane * 4); const f32x4 y = d * rstd * gg + bb;
        *(unsigned*)((unsigned char*)BR + (size_t)(t0 + tt) * DM + 768 + F.lane * 4) = pk4_fp8(y.x * sigmoidf_(y.x) * BR_SCALE, y.y * sigmoidf_(y.y) * BR_SCALE, y.z * sigmoidf_(y.z) * BR_SCALE, y.w * sigmoidf_(y.w) * BR_SCALE); }
    __syncthreads();
}
__device__ __forceinline__ int key28_(float s) { const int u = (int)__float_as_uint(s); int m = (u & 0x7fffffff) - 0x3B000000; m = m < 0 ? 0 : (m > 0x07FFFFFF ? 0x07FFFFFF : m); return 0x08000000 + (m ^ (u >> 31)); }
__device__ __forceinline__ int key16_(float s) { const int u = (int)__float_as_uint(s); int m = (int)(((unsigned)u >> 12) & 0x7ffffu) - 0x3B000; m = m < 0 ? 0 : (m > 0x7FFF ? 0x7FFF : m); return 0x8000 + (m ^ (u >> 31)); }
__device__ __forceinline__ int key9_(float s) { const int u = (int)__float_as_uint(s); int m = ((u >> 19) & 0xfff) - 0x760; m = m < 0 ? 0 : (m > 255 ? 255 : m); return 256 + (m ^ (u >> 31)); }
__device__ __forceinline__ float key28_lbound(long long kv) {
    if (kv <= 0) return -INFINITY; if (kv > 0x0FFFFFFFll) return INFINITY;
    if (kv > 0x08000000ll) return __uint_as_float((unsigned)(0x3B000000ll + (kv - 0x08000000ll)));
    if (kv == 0x08000000ll) return 0.f;
    return -__uint_as_float((unsigned)(0x3B000000ll + (0x07FFFFFFll - kv)));
}
constexpr int DS_HIST = 0, DS_GT = 65536, DS_EQ = 81920, DS_KT = 98304, DS_SM = LDSCTL_OFF + 1024 - RING_OFF, DS_CAP = 512;
typedef float f32x2p __attribute__((ext_vector_type(2)));
__device__ __forceinline__ float relu_(float x) { const int b = (int)__float_as_uint(x); return __uint_as_float((unsigned)(b > 0 ? b : 0)); }
__device__ __forceinline__ void dsa_ldk(bf16x8 (&kf)[4], const bf16* kp) {
#pragma unroll
    for (int m = 0; m < 4; ++m) kf[m] = *(const bf16x8*)(kp + m * 512);
}
__device__ __forceinline__ void dsa_kfrag(bf16x8 (&kf)[4], const bf16x8 (&raw)[4], LAS unsigned char* kt, int lane) {
    const int rw = lane >> 3, cw = lane & 7, r32 = lane & 31, hi = lane >> 5;
#pragma unroll
    for (int m = 0; m < 4; ++m) *(LAS bf16x8*)(kt + (8 * m + rw) * 128 + ((cw ^ rw) << 4)) = raw[m];
#pragma unroll
    for (int ks = 0; ks < 4; ++ks) kf[ks] = *(const LAS bf16x8*)(kt + r32 * 128 + (((2 * ks + hi) ^ (r32 & 7)) << 4));
}
__device__ __forceinline__ void dsa_scores(const bf16x8 (&qf)[4][4], const bf16x8 (&kf)[4], const float (&w)[4], float (&sc)[16]) {
    f32x16 a[4];
#pragma unroll
    for (int hh = 0; hh < 4; ++hh) { a[hh] = (f32x16){};
#pragma unroll
        for (int ks = 0; ks < 4; ++ks) a[hh] = __builtin_amdgcn_mfma_f32_32x32x16_bf16(kf[ks], qf[hh][ks], a[hh], 0, 0, 0); }
#pragma unroll
    for (int r = 0; r < 16; r += 2) { f32x2p s2 = (f32x2p){relu_(a[0][r]), relu_(a[0][r + 1])} * w[0];
#pragma unroll
        for (int hh = 1; hh < 4; ++hh) s2 = (f32x2p){relu_(a[hh][r]), relu_(a[hh][r + 1])} * w[hh] + s2;
        sc[r] = s2.x + 0.f; sc[r + 1] = s2.y + 0.f; }
}
template <int NB4> __device__ __forceinline__ void hist_scan(const LAS unsigned* h, int K, int lane, int& bin, int& above, int& inbin, int* total = nullptr) {
    unsigned hv[NB4 * 4]; int s = 0;
#pragma unroll
    for (int g = 0; g < NB4; ++g) { const v4u t = *(const LAS v4u*)(h + NB4 * 4 * lane + 4 * g); hv[4 * g] = t.x; hv[4 * g + 1] = t.y; hv[4 * g + 2] = t.z; hv[4 * g + 3] = t.w; s += (int)(t.x + t.y + t.z + t.w); }
    int suf = s;
#pragma unroll
    for (int o = 1; o < 64; o <<= 1) { const int t = shfl_i_(suf, lane + o); if (lane + o < 64) suf += t; }
    if (total) *total = __builtin_amdgcn_readfirstlane(suf);
    const int excl = suf - s; const bool hit = (excl < K) && (K <= suf);
    int b = 0, c = excl, nb = 0; bool done = false;
#pragma unroll
    for (int k = NB4 * 4 - 1; k >= 0; --k) { if (!done) { if (c + (int)hv[k] >= K) { b = k; nb = (int)hv[k]; done = true; } else c += (int)hv[k]; } }
    const unsigned long long m = __ballot(hit); const int src = m ? (int)__builtin_ctzll(m) : 0;
    bin = __builtin_amdgcn_readlane(NB4 * 4 * lane + b, src); above = __builtin_amdgcn_readlane(c, src); inbin = __builtin_amdgcn_readlane(nb, src);
    if (!m) { bin = 0; above = 0; inbin = 0; }
}
#define DSA_ONE_TILE(KF, I, ...) do { const int i = (I); float sc[16]; { bf16x8 kfr[4]; dsa_kfrag(kfr, KF, ktile, F.lane); dsa_scores(qf, kfr, w, sc); } \
        if (i == j) { constexpr bool DIAG = true; __VA_ARGS__ } else { constexpr bool DIAG = false; __VA_ARGS__ } } while (0)
#define DSA_TILE_LOOP_S(STRIDE, ...) do { bf16x8 ka[4], kb[4]; int i0 = F.wave; \
    { const int ia = i0 <= j ? i0 : 0, ib = i0 + (STRIDE) <= j ? i0 + (STRIDE) : ia; dsa_ldk(ka, kbase + (size_t)ia * 32 * 64); dsa_ldk(kb, kbase + (size_t)ib * 32 * 64); } \
    _Pragma("unroll 1") for (; i0 <= j; i0 += 2 * (STRIDE)) { bf16x8 na[4], nb[4]; \
        { const int ia = i0 + 2 * (STRIDE) <= j ? i0 + 2 * (STRIDE) : i0, ib = i0 + 3 * (STRIDE) <= j ? i0 + 3 * (STRIDE) : i0; dsa_ldk(na, kbase + (size_t)ia * 32 * 64); dsa_ldk(nb, kbase + (size_t)ib * 32 * 64); } \
        __builtin_amdgcn_sched_barrier(0); \
        DSA_ONE_TILE(ka, i0, __VA_ARGS__); \
        if (i0 + (STRIDE) <= j) DSA_ONE_TILE(kb, i0 + (STRIDE), __VA_ARGS__); \
        _Pragma("unroll") for (int ks = 0; ks < 4; ++ks) { ka[ks] = na[ks]; kb[ks] = nb[ks]; } } } while (0)
#define DSA_TILE_LOOP(...) DSA_TILE_LOOP_S(NWAVES, __VA_ARGS__)
#define DSA_VALID(r) (!DIAG || ((r) & 3) + 8 * ((r) >> 2) <= qlim)
__device__ __forceinline__ void dsa_mask_unit(const Frame& F_, int b, int j, const bf16* P, const bf16* KIDX, const float* FW, unsigned long long* selw, unsigned char* dk  ) { Frame F = F_; F.lane = lane_id_(); F.tid = F.wave * 64 + F.lane;
    LAS unsigned* HIST = (LAS unsigned*)(F.lds + RING_OFF + DS_HIST);
    LAS unsigned* GT = (LAS unsigned*)(F.lds + RING_OFF + DS_GT);
    LAS unsigned* EQ = (LAS unsigned*)(F.lds + RING_OFF + DS_EQ);
    LAS int* SM = (LAS int*)(F.lds + RING_OFF + DS_SM); volatile LAS unsigned* PRB = (volatile LAS unsigned*)(F.lds + LDSCTL_OFF + 512);
    PROBE_BEGIN(1);
    const int r32 = F.lane & 31, hi = F.lane >> 5, t0 = j * 32; const size_t brow = (size_t)b * SEQ;
    bf16x8 qf[4][4];
#pragma unroll
    for (int hh = 0; hh < 4; ++hh)
#pragma unroll
        for (int ks = 0; ks < 4; ++ks) qf[hh][ks] = *(const bf16x8*)(P + (brow + t0 + r32) * PS + C_IQ + hh * 64 + ks * 16 + hi * 8);
    float w[4]; { const f32x4 wv = *(const f32x4*)(FW + (brow + t0 + r32) * 8 + 4); w[0] = wv.x; w[1] = wv.y; w[2] = wv.z; w[3] = wv.w; }
    const bf16* kbase = KIDX + brow * 64 + F.lane * 8;
    LAS unsigned char* ktile = F.lds + RING_OFF + DS_KT + F.wave * 4096;
    const int qlim = r32 - 4 * hi;
    LAS unsigned* hrow = HIST + r32 * 512;
#define DSA_ZERO_HIST() do { const unsigned z_ = (unsigned)opaque_i(0); for (int e = F.tid; e < 4096; e += NWAVES * 64) ((LAS v4u*)HIST)[e] = (v4u){z_, z_, z_, z_}; } while (0)
    DSA_ZERO_HIST();
    if (F.tid < 64) SM[128 + F.tid] = 0;
    __syncthreads();
    PROBE_END(1); PROBE_BEGIN(2);
#if REP_PHASE == 41
    { float dummy = 0.f; DSA_TILE_LOOP({ _Pragma("unroll") for (int r = 0; r < 16; ++r) dummy += sc[r]; }); if (dummy == 12345.678f) SM[170] = 1; }
#endif
#if REP_PHASE == 42
    { LAS unsigned* drow = EQ + (r32 & 7) * 512; DSA_TILE_LOOP({ _Pragma("unroll") for (int r = 0; r < 16; ++r) { const int kh = key28_(sc[r]) >> 19; if (DSA_VALID(r)) __hip_atomic_fetch_add(drow + kh, 1u, __ATOMIC_RELAXED, __HIP_MEMORY_SCOPE_WORKGROUP); } }); }
#endif
#if REP_PHASE == 43
    { DSA_ZERO_HIST(); __syncthreads(); for (int q = F.wave * 4; q < F.wave * 4 + 4; ++q) { int bin, above, inbin; hist_scan<2>(HIST + q * 512, 256, F.lane, bin, above, inbin); if (F.lane == 0) SM[171] = bin; } __syncthreads(); __syncthreads(); __syncthreads(); }
#endif
    unsigned char* dkw = dk + (size_t)(F.wave * 16) * 2048 + F.lane * 32;
    DSA_TILE_LOOP({ unsigned kw[8]; _Pragma("unroll")
        for (int r = 0; r < 16; ++r) { const int k16 = key16_(sc[r]); if (DSA_VALID(r)) __hip_atomic_fetch_add(hrow + (k16 >> 7), 1u, __ATOMIC_RELAXED, __HIP_MEMORY_SCOPE_WORKGROUP);
            if (r & 1) kw[r >> 1] |= (unsigned)k16 << 16; else kw[r >> 1] = (unsigned)k16; }
        v4u* kd = (v4u*)(dkw + (size_t)(i >> 3) * 2048); kd[0] = (v4u){kw[0], kw[1], kw[2], kw[3]}; kd[1] = (v4u){kw[4], kw[5], kw[6], kw[7]}; });
    __syncthreads();
    PROBE_END(2); PROBE_BEGIN(3);
#pragma unroll
    for (int q = F.wave * 4; q < F.wave * 4 + 4; ++q) { int bin, above, inbin; hist_scan<2>(HIST + q * 512, 256, F.lane, bin, above, inbin);
        if (F.lane == 0) { const int total = t0 + q + 1;
            if (total <= 256) { SM[q] = -1; SM[32 + q] = 0; SM[64 + q] = 0; SM[96 + q] = 0; }
            else { SM[q] = bin; SM[32 + q] = above; SM[64 + q] = inbin; SM[96 + q] = 256 - above; if (inbin > DS_CAP) SM[160] = 1; } } }
    __syncthreads();
    PROBE_END(3); PROBE_BEGIN(4);
    const int myb1 = SM[r32];
    if (SM[160] == 0) {
        const int tge = myb1 << 7, tgt = (myb1 + 1) << 7;
        LAS unsigned* lrow = HIST + r32 * DS_CAP;
#define DK_LOAD(dst, I) do { const int i_ = (I) <= j ? (I) : F.wave; const v4u* kd_ = (const v4u*)(dkw + (size_t)(i_ >> 3) * 2048); dst[0] = kd_[0]; dst[1] = kd_[1]; } while (0)
#define DK_LOAD4(dst, I) do { DK_LOAD(dst[0], (I)); DK_LOAD(dst[1], (I) + NWAVES); DK_LOAD(dst[2], (I) + 2 * NWAVES); DK_LOAD(dst[3], (I) + 3 * NWAVES); } while (0)
#define DK_BITS(I, src, cwq) do { const int i = (I); cwq = 0u; if (i <= j) { const unsigned kw[8] = {src[0].x, src[0].y, src[0].z, src[0].w, src[1].x, src[1].y, src[1].z, src[1].w}; const bool diag = (i == j); unsigned gtw = 0u; \
            _Pragma("unroll") for (int r = 15; r >= 0; --r) { const int bit = (r & 3) + 8 * (r >> 2); const bool valid = !diag || bit <= qlim; const int k = (r & 1) ? (int)(kw[r >> 1] >> 16) : (int)(kw[r >> 1] & 0xffffu); \
                gtw = (gtw << (((r & 3) == 3 && r < 15) ? 5 : 1)) | bit01_(valid && k >= tgt); cwq = (cwq << 1) | bit01_(valid && k < tgt && k >= tge); }     \
            gtw <<= 4 * hi; gtw |= (unsigned)shfl_i_((int)gtw, F.lane ^ 32); \
            if (hi == 0) GT[i * 32 + r32] = gtw; } } while (0)
#define DK_APP(I, src, cq) do { if (cq) { LAS unsigned* sl = (LAS unsigned*)ktile + F.lane; sl[0] = src[0].x; sl[64] = src[0].y; sl[128] = src[0].z; sl[192] = src[0].w; sl[256] = src[1].x; sl[320] = src[1].y; sl[384] = src[1].z; sl[448] = src[1].w; \
            unsigned c_ = (cq); while (c_) { const int r = __builtin_ctz(c_); c_ &= c_ - 1u; const unsigned kv = (sl[(r >> 1) * 64] >> (16 * (r & 1))) & 0xffffu; const int bit = (r & 3) + 8 * (r >> 2); \
                if (slot < DS_CAP) lrow[slot] = ((kv & 0x7Fu) << 12) | (unsigned)(4095 - ((I) * 32 + bit + 4 * hi)); ++slot; } } } while (0)
#define DK_TRIP(IB, src) do { unsigned cq0, cq1, cq2, cq3; DK_BITS((IB), src[0], cq0); DK_BITS((IB) + NWAVES, src[1], cq1); DK_BITS((IB) + 2 * NWAVES, src[2], cq2); DK_BITS((IB) + 3 * NWAVES, src[3], cq3); \
            const unsigned ctot = (unsigned)(__popc(cq0) + __popc(cq1) + __popc(cq2) + __popc(cq3)); \
            if (ctot) { int slot = (int)__hip_atomic_fetch_add((LAS unsigned*)SM + 128 + r32, ctot, __ATOMIC_RELAXED, __HIP_MEMORY_SCOPE_WORKGROUP); \
                DK_APP((IB), src[0], cq0); DK_APP((IB) + NWAVES, src[1], cq1); DK_APP((IB) + 2 * NWAVES, src[2], cq2); DK_APP((IB) + 3 * NWAVES, src[3], cq3); } } while (0)
        { v4u X[4][2], Y[4][2];
          DK_LOAD4(X, F.wave);
#pragma unroll 1
          for (int ib = F.wave; ib <= j; ib += 8 * NWAVES) {
            DK_LOAD4(Y, ib + 4 * NWAVES); __builtin_amdgcn_sched_barrier(0);
            DK_TRIP(ib, X);
            if (ib + 4 * NWAVES > j) break;
            DK_LOAD4(X, ib + 8 * NWAVES); __builtin_amdgcn_sched_barrier(0);
            DK_TRIP(ib + 4 * NWAVES, Y); } }
#undef DK_LOAD
#undef DK_LOAD4
#undef DK_BITS
#undef DK_TRIP
#undef DK_APP
        __syncthreads();
        PROBE_END(4); PROBE_BEGIN(5);
#pragma unroll 1
        for (int q = F.wave * 4; q < F.wave * 4 + 4; ++q) { const int n = SM[128 + q] < DS_CAP ? SM[128 + q] : DS_CAP, quota = SM[96 + q]; const LAS unsigned* lq = HIST + q * DS_CAP;
            for (int c0 = 0; c0 < n; c0 += 64) { const int ci = c0 + F.lane; const unsigned e = ci < n ? lq[ci] : 0xffffffffu; int rank = 0;
                int k = 0;
                for (; k + 16 <= n; k += 16) { const v4u c0 = *(const LAS v4u*)(lq + k), c1 = *(const LAS v4u*)(lq + k + 4), c2 = *(const LAS v4u*)(lq + k + 8), c3 = *(const LAS v4u*)(lq + k + 12);
                    rank += (c0.x > e ? 1 : 0) + (c0.y > e ? 1 : 0) + (c0.z > e ? 1 : 0) + (c0.w > e ? 1 : 0) + (c1.x > e ? 1 : 0) + (c1.y > e ? 1 : 0) + (c1.z > e ? 1 : 0) + (c1.w > e ? 1 : 0)
                          + (c2.x > e ? 1 : 0) + (c2.y > e ? 1 : 0) + (c2.z > e ? 1 : 0) + (c2.w > e ? 1 : 0) + (c3.x > e ? 1 : 0) + (c3.y > e ? 1 : 0) + (c3.z > e ? 1 : 0) + (c3.w > e ? 1 : 0); }
                for (; k < n; ++k) rank += (lq[k] > e) ? 1 : 0;
                if (ci < n && rank < quota) { const int idx = 4095 - (int)(e & 4095u); __hip_atomic_fetch_or(GT + (idx >> 5) * 32 + q, 1u << (idx & 31), __ATOMIC_RELAXED, __HIP_MEMORY_SCOPE_WORKGROUP); } } }
        __syncthreads();
    } else {
        DSA_ZERO_HIST();
        __syncthreads();
        DSA_TILE_LOOP({ _Pragma("unroll")
            for (int r = 0; r < 16; ++r) { const int k = key28_(sc[r]); if ((k >> 19) == myb1 && DSA_VALID(r)) __hip_atomic_fetch_add(hrow + ((k >> 11) & 255), 1u, __ATOMIC_RELAXED, __HIP_MEMORY_SCOPE_WORKGROUP); } });
        __syncthreads();
#pragma unroll 1
        for (int q = F.wave * 4; q < F.wave * 4 + 4; ++q) { int bin, above, inbin; const int b1 = SM[q], ab1 = SM[32 + q]; hist_scan<1>(HIST + q * 512, 256 - ab1, F.lane, bin, above, inbin);
            if (F.lane == 0) { if (b1 < 0) { SM[192 + q] = -1; SM[96 + q] = 0; SM[224 + q] = 0; }
                else { const int quota = 256 - (ab1 + above); SM[192 + q] = (b1 << 8) | bin; SM[96 + q] = quota; SM[224 + q] = inbin; if (quota < inbin) SM[161] = 1; } } }
        __syncthreads();
        const int thr = SM[192 + r32]; const bool allacc = SM[96 + r32] >= SM[224 + r32];
        const float lge = key28_lbound((long long)thr << 11), lgt = key28_lbound(((long long)thr + 1) << 11);
        DSA_TILE_LOOP({ unsigned gtw = 0u; unsigned gew = 0u; _Pragma("unroll")
            for (int r = 15; r >= 0; --r) { const bool valid = DSA_VALID(r); const int sh_ = ((r & 3) == 3 && r < 15) ? 5 : 1;
                gtw = (gtw << sh_) | bit01_(valid && sc[r] >= lgt); gew = (gew << sh_) | bit01_(valid && sc[r] >= lge); }
            gtw <<= 4 * hi; gew <<= 4 * hi;
            gtw |= (unsigned)shfl_i_((int)gtw, F.lane ^ 32); gew |= (unsigned)shfl_i_((int)gew, F.lane ^ 32);
            unsigned eqw = gew & ~gtw;
            if (allacc) { gtw = gew; eqw = 0u; }
            if (hi == 0) GT[i * 32 + r32] = gtw; else EQ[i * 32 + r32] = eqw; });
        __syncthreads();
        if (SM[161] != 0 && F.tid < 32) { const int q = F.tid; const int quota = SM[96 + q]; if (quota < SM[224 + q]) { int run = 0;
                for (int i = 0; i <= j; ++i) { unsigned e = EQ[i * 32 + q]; if (e) { const int allowed = quota - run; if (allowed <= 0) e = 0u; else { int pc = __popc(e); while (pc > allowed) { e &= ~(0x80000000u >> __clz(e)); --pc; } }
                        run += __popc(e); GT[i * 32 + q] |= e; } } } }
        __syncthreads();
    }
    PROBE_END(5); PROBE_BEGIN(6);
    { const int ntile64 = 4 * (j / 8 + 1); unsigned long long* dst = selw + (size_t)b * 64 * SEQ + t0;
      for (int e = F.tid; e < ntile64 * 32; e += NWAVES * 64) { const int T = e >> 5, q = e & 31; const unsigned lo = (2 * T <= j) ? GT[(2 * T) * 32 + q] : 0u, up = (2 * T + 1 <= j) ? GT[(2 * T + 1) * 32 + q] : 0u;
          dst[(size_t)T * SEQ + q] = ((unsigned long long)up << 32) | lo; } }
    __syncthreads();
    PROBE_END(6);
}
#undef DSA_TILE_LOOP
#undef DSA_ZERO_HIST
#undef DSA_TILE_LOOP_S
#undef DSA_ONE_TILE
#undef DSA_VALID
__device__ __forceinline__ void ln1_router_phase(const Frame& F_, const Args& a, int l, bool dry = false) { Frame F = F_; F.lane = lane_id_(); F.tid = F.wave * 64 + F.lane;
    LAS float* PART = (LAS float*)(F.lds + RING_OFF);
    LAS float* LOG = (LAS float*)(F.lds + RING_OFF + 32768);
    LAS int* LC = (LAS int*)(F.lds + RING_OFF + 81920);
    LAS int* LTOK = LC + 64;
    LAS int* LCLS = LTOK + 128; LAS int* LPOS = LCLS + 128; LAS float* LGA = (LAS float*)(LPOS + 128); LAS float* LGB = LGA + 128;
    volatile LAS unsigned* PRB = (volatile LAS unsigned*)(F.lds + LDSCTL_OFF + 512);
    PROBE_BEGIN(31);
    const float* rg = a.in[16] + (size_t)l * DM * 4; const float* re = a.in[18] + (size_t)l * DM * 16;
    const int r32 = F.lane & 31, hi = F.lane >> 5;
    bf16x8 wh[8], wl[8];
#pragma unroll
    for (int ks = 0; ks < 8; ++ks) { float wv[8];
#pragma unroll
        for (int e = 0; e < 8; ++e) { const int k = 128 * F.wave + 16 * ks + 8 * hi + e; wv[e] = r32 < 4 ? rg[k * 4 + r32] : (r32 < 20 ? re[k * 16 + (r32 - 4)] : 0.f); }
#pragma unroll
        for (int e = 0; e < 8; ++e) { const unsigned hb_ = f2bf(wv[e]); const float rem = wv[e] - __uint_as_float(hb_ << 16); wh[ks][e] = (short)hb_; wl[ks][e] = (short)f2bf(rem); } }
    if (F.tid < 64) LC[F.tid] = 0;
    PROBE_END(31); PROBE_BEGIN(32);
    const float* rgb = a.in[17] + l * 4; const float* reb = a.in[19] + l * 16;
    const float* g1 = a.in[14] + (size_t)l * DM; const float* b1 = a.in[15] + (size_t)l * DM;
    int* list = (int*)(F.ws + WS_LIST); float* gwl = (float*)(F.ws + WS_GWL);
    const int rows_per_blk = NTOK / F.G;
    const int row0 = F.vcu * rows_per_blk;
    { LnGB gb; ln_gb_load(F, g1, b1, gb);
      const bf16* V1 = wsb(F, WS_R2);
      f32x4 nx[4]; ln_load_bf(F, V1 + (size_t)(row0 + F.wave) * DM, nx);
      for (int rr = F.wave; rr < rows_per_blk; rr += NWAVES) { const int m = row0 + rr; f32x4 v[4];
#pragma unroll
          for (int j = 0; j < 4; ++j) v[j] = nx[j];
          if (rr + NWAVES < rows_per_blk) ln_load_bf(F, V1 + (size_t)(m + NWAVES) * DM, nx);
          ln_row(F, gb, nullptr, wsb(F, WS_HB) + (size_t)m * DM, v, dry, F.ws + WS_HB8 + (size_t)m * DM); } }
    asm volatile("s_waitcnt vmcnt(0)" ::: "memory");
    __syncthreads();
#pragma unroll 1
    for (int bt = 0; bt < 4; ++bt) {
        const bf16* hrow = wsb(F, WS_HB) + (size_t)(row0 + bt * 32 + r32) * DM + 128 * F.wave + 8 * hi;
        bf16x8 af[8];
#pragma unroll
        for (int ks = 0; ks < 8; ++ks) af[ks] = *(const bf16x8*)(hrow + 16 * ks);
        f32x16 acc = (f32x16){};
#pragma unroll
        for (int ks = 0; ks < 8; ++ks) { acc = __builtin_amdgcn_mfma_f32_32x32x16_bf16(wh[ks], af[ks], acc, 0, 0, 0); acc = __builtin_amdgcn_mfma_f32_32x32x16_bf16(wl[ks], af[ks], acc, 0, 0, 0); }
#pragma unroll
        for (int q = 0; q < 4; ++q) *(LAS f32x4*)(PART + (F.wave * 32 + r32) * 32 + 8 * q + 4 * hi) = (f32x4){acc[4 * q], acc[4 * q + 1], acc[4 * q + 2], acc[4 * q + 3]};
        __syncthreads();
#pragma unroll
        for (int e2 = 0; e2 < 2; ++e2) { const int e = F.tid + e2 * NWAVES * 64; float sacc = 0.f;
#pragma unroll
            for (int w = 0; w < NWAVES; ++w) sacc += PART[w * 1024 + e];
            LOG[bt * 1024 + e] = sacc; }
        __syncthreads();
    }
    if (F.tid < rows_per_blk) { const int rr = F.tid, m = row0 + rr; const LAS float* lg = LOG + rr * 32;
        float gl[4];
#pragma unroll
        for (int c = 0; c < 4; ++c) gl[c] = lg[c] + rgb[c];
        int gi = 0; float gm = gl[0];
#pragma unroll
        for (int c = 1; c < 4; ++c) if (gl[c] > gm) { gm = gl[c]; gi = c; }
        float gs = 0.f;
#pragma unroll
        for (int c = 0; c < 4; ++c) gs += expf(gl[c] - gm);
        const float pg = 1.f / gs;
        float el[4];
#pragma unroll
        for (int c = 0; c < 4; ++c) el[c] = lg[4 + 4 * gi + c] + reb[4 * gi + c];
        int i1 = 0; float m1 = el[0];
#pragma unroll
        for (int c = 1; c < 4; ++c) if (el[c] > m1) { m1 = el[c]; i1 = c; }
        int i2 = -1; float m2 = -INFINITY;
#pragma unroll
        for (int c = 0; c < 4; ++c) if (c != i1 && el[c] > m2) { m2 = el[c]; i2 = c; }
        const float e2 = expf(m2 - m1); const float p1 = 1.f / (1.f + e2), p2 = e2 / (1.f + e2);
        const int ia = i1 < i2 ? i1 : i2, ib = i1 < i2 ? i2 : i1; const float ga = pg * (i1 < i2 ? p1 : p2), gb_ = pg * (i1 < i2 ? p2 : p1);
        const int pidx = ia == 0 ? ib - 1 : (ia == 1 ? ib + 1 : 5); const int cls = gi * 6 + pidx;
        const int pos = __hip_atomic_fetch_add(&LC[cls], 1, __ATOMIC_RELAXED, __HIP_MEMORY_SCOPE_WORKGROUP); LTOK[rr] = m; LCLS[rr] = cls; LPOS[rr] = pos; LGA[rr] = ga; LGB[rr] = gb_; }
    __syncthreads();
    PROBE_END(32);
    if (dry) return;
    PROBE_BEGIN(33);
    if (F.tid < NCLS) { const int n = LC[F.tid]; LC[32 + F.tid] = n ? (int)atomicAdd((unsigned*)(F.ctl + CW_CNT + (l * NCLS + F.tid) * 64), (unsigned)n) : 0; }
    __syncthreads();
    for (int rr = F.tid; rr < rows_per_blk; rr += NWAVES * 64) { const int cls = LCLS[rr], pos = LC[32 + cls] + LPOS[rr];
        list[(size_t)cls * NTOK + pos] = LTOK[rr]; gwl[((size_t)cls * NTOK + pos) * 2] = LGA[rr]; gwl[((size_t)cls * NTOK + pos) * 2 + 1] = LGB[rr]; }
    __syncthreads();
    PROBE_END(33);
}
__device__ __forceinline__ void ln2_phase(const Frame& F_, const Args& a, int l, bool dry = false) { Frame F = F_; F.lane = lane_id_(); F.tid = F.wave * 64 + F.lane;
    const float* g2 = a.in[23] + (size_t)l * DM; const float* b2 = a.in[24] + (size_t)l * DM; const bf16* V2 = wsb(F, WS_R1); const bool last = (l == DEPTH - 1);
    const int gw = F.vcu * NWAVES + F.wave, NGW = F.G * NWAVES;
    LnGB gb; ln_gb_load(F, g2, b2, gb);
    f32x4 nx[4]; ln_load_bf(F, V2 + (size_t)gw * DM, nx);
    for (int m = gw; m < NTOK; m += NGW) { f32x4 v[4];
#pragma unroll
        for (int j = 0; j < 4; ++j) v[j] = nx[j];
        if (m + NGW < NTOK) ln_load_bf(F, V2 + (size_t)(m + NGW) * DM, nx);
        ln_row(F, gb, last ? F.out + (size_t)m * DM : nullptr, last ? nullptr : wsb(F, WS_HB) + (size_t)m * DM, v, dry, last ? nullptr : F.ws + WS_HB8 + (size_t)m * DM); }
}
__device__ __forceinline__ void moe_table(const Frame& F, int l, LAS int* tab) {
    const int tid = F.wave * 64 + lane_id_();
    if (tid < NCLS) tab[tid] = (int)__hip_atomic_load(F.ctl + CW_CNT + (l * NCLS + tid) * 64, RLX_AGENT);
    __syncthreads();
    if (tid < 64) { const int nt_ = tid < NCLS ? (tab[tid] + 255) >> 8 : 0; int inc = nt_;
#pragma unroll
        for (int o = 1; o < 32; o <<= 1) { const int t_ = shfl_i_(inc, tid - o); if (tid >= o) inc += t_; }
        if (tid < NCLS) tab[32 + tid] = inc - nt_;
        if (tid == NCLS - 1) { tab[32 + NCLS] = inc; tab[57] = inc; } }
    __syncthreads();
}
#define NREP(k) (((REP_PHASE) == (k) || ((k) == 4 && ((REP_PHASE) == 60 || (REP_PHASE) == 61))) ? 2 : 1)
#define DRY(k) ((REP_PHASE) == (k) && rep_ == 0 && args.ph_hi != 7777)
#ifndef MK_PER_PHASE
#define MK_PER_PHASE 0
#endif
constexpr int PH_PER_LAYER = 9, N_PHASES = 1 + DEPTH * PH_PER_LAYER;
__global__ void __launch_bounds__(NWAVES * 64, 2) fwd_kernel(Args args) {
    extern __shared__ __attribute__((aligned(16))) unsigned char lds[];
    Frame F0; Frame& F = F0;
    F.lds = (LAS unsigned char*)lds; F.ldsg = lds;
    F.MISC = (volatile LAS unsigned*)(F.lds + MISC_OFF);
    F.wave = __builtin_amdgcn_readfirstlane((int)threadIdx.x >> 6); F.lane = lane_id_(); F.tid = F.wave * 64 + F.lane;
    F.G = gridDim.x; { const int bx = blockIdx.x; F.vcu = (F.G % 8 == 0) ? (bx % 8) * (F.G / 8) + bx / 8 : bx; }
    F.ws = args.ws; F.out = args.out; F.ctl = (gu32*)(args.ws + WS_CTL);
    for (int u = F0.tid; u < (LDS_BYTES - LDSCTL_OFF) / 4; u += NWAVES * 64) ((LAS unsigned*)(F.lds + LDSCTL_OFF))[u] = 0u;
    __syncthreads();
    XcdBarrier bar; bar.bar = (unsigned*)(F.ctl + CW_BAR); bar.x = 0; bar.st = nullptr;
    if (!MK_PER_PHASE) bar = xcd_barrier_post((unsigned*)(F.ctl + CW_BAR), F.MISC + 8);
    const int lo = MK_PER_PHASE ? args.ph_lo : 0, hi = MK_PER_PHASE ? args.ph_hi : N_PHASES;
#define IN(k) (lo <= (k) && (k) < hi)
#ifndef PH_ONLY
#define PH_ONLY -1
#endif
#define EN(k) (PH_ONLY < 0 || PH_ONLY == (k))
#define SEAM(k) do { if (IN(k) && IN((k) + 1)) { PROBE_BEGIN(20); xcd_barrier(bar, F0.wave); PROBE_END(20); } } while (0)
    volatile LAS unsigned* PRB = (volatile LAS unsigned*)(F0.lds + LDSCTL_OFF + 512);
    LAS int* TAB = (LAS int*)(F.lds + LDSCTL_OFF + 64);
    bf16* const HB = wsb(F, WS_HB); bf16* const P = wsb(F, WS_R1); bf16* const MIX = wsb(F, WS_R1); bf16* const BR = wsb(F, WS_R2); bf16* const ACT = wsb(F, WS_R2);
    float* const FW = (float*)(F.ws + WS_FW); float* const BIAS2 = (float*)(F.ws + WS_BIAS2); unsigned long long* const SELW = (unsigned long long*)(F.ws + WS_SELW);

#define FRESH(Fn) Frame Fn = F0; Fn.vcu = opaque_s(F0.vcu); Fn.wave = opaque_s(F0.wave); Fn.lane = lane_id_(); Fn.tid = Fn.wave * 64 + Fn.lane
    for (int rep_ = 0; rep_ < ((REP_PHASE) == 10 ? 2 : 1); ++rep_) if (EN(0) && IN(0)) { FRESH(Fp); p0_prologue(Fp, args); }
    SEAM(0);
#pragma unroll 1
    for (int l0 = 0; l0 < DEPTH; ++l0) {
        const int pb = 1 + PH_PER_LAYER * l0;
#define l opaque_s(l0)
#define W (wsb(F, WS_W + (size_t)l * W_LAYER))
        for (int rep_ = 0; rep_ < NREP(1); ++rep_) if (EN(1) && IN(pb)) {
            constexpr unsigned M8 = A_F8_TILES; unsigned map8 = 0, map16 = 0; int n8 = 0, n16 = 0;
            for (int q = 0; q < 9; ++q) { if ((M8 >> q) & 1) { map8 |= (unsigned)q << (4 * n8); ++n8; } else { map16 |= (unsigned)q << (4 * n16); ++n16; } }
            const int bx_ = opaque_s((int)blockIdx.x);
            if (n8 > 0) { SchedAT<true> S; S.T.init(NTOK / 256, n8, F.G, bx_); S.A = (const char*)(F.ws + WS_HB8); S.B = (const char*)W + W_SM8; S.map = map8;
                EpiAT<true> E{P, FW, wsb(F, WS_KIDX)}; pg8::gemm_phase<EpiAT<true>, SchedAT<true>, false>(F.lds + RING_OFF, (LAS unsigned*)(F.lds + LDSCTL_OFF + 1024), F0.wave, S, E); }
            if (n16 > 0) { SchedAT<false> S; S.T.init(NTOK / 256, n16, F.G, (bx_ + F.G - ((NTOK / 256) * n8) % F.G) % F.G);
                S.A = (const char*)HB; S.B = (const char*)(W + W_SM / 2); S.map = map16;
                EpiAT<false> E{P, FW, wsb(F, WS_KIDX)}; pg8::gemm_phase<EpiAT<false>, SchedAT<false>, false>(F.lds + RING_OFF, (LAS unsigned*)(F.lds + LDSCTL_OFF + 1024), F0.wave, S, E); } }
        SEAM(pb);
        for (int rep_ = 0; rep_ < NREP(2); ++rep_) if (EN(2) && IN(pb + 1)) { FRESH(Fp);
#ifndef NO_CUMSUM
            if (Fp.vcu < 32 && Fp.wave == 0) fox_cumsum(Fp, Fp.vcu, FW, args.in[4] + l * 4, BIAS2);
#endif
#ifndef NO_POOL
            for (int rp_ = 0; rp_ < ((REP_PHASE) == 21 ? 2 : 1); ++rp_) for (int k = 0; k < 2; ++k) pool_unit(Fp, Fp.vcu * 2 + k, P, args.in[6] + (size_t)l * 4 * 64 * 64, args.in[7] + (size_t)l * 256, BR);
            __syncthreads();
#endif
#ifndef NO_CONV
            for (int rp_ = 0; rp_ < ((REP_PHASE) == 22 ? 2 : 1); ++rp_) for (int k = 0; k < 4; ++k) conv_unit(Fp, Fp.vcu * 4 + k, P, args.in[8] + (size_t)l * 31 * 256, args.in[9] + (size_t)l * 256, args.in[10] + (size_t)l * 256, args.in[11] + (size_t)l * 256, BR);
#endif
#ifndef NO_DSA
            { const int b = Fp.vcu >> 5, s = Fp.vcu & 31; const int bxk_ = opaque_s((int)blockIdx.x);
#pragma unroll 1
              for (int k = 0; k < ((REP_PHASE) == 23 ? 8 : 4); ++k) { const int j = (k & 3) == 0 ? 127 - s : ((k & 3) == 1 ? 64 + s : ((k & 3) == 2 ? 63 - s : s)); dsa_mask_unit(Fp, b, j, P, wsb(F, WS_KIDX), FW, SELW, F.ws + (bxk_ < 176 ? WS_DK0 + (size_t)bxk_ * 262144 : WS_DK1 + (size_t)(bxk_ - 176) * 262144)); } }
#endif
        }
        SEAM(pb + 1);
        for (int rep_ = 0; rep_ < NREP(3); ++rep_) if (EN(3) && IN(pb + 2)) { const int vc_ = opaque_s(F0.vcu); const int sg = vc_ >> 3, s = vc_ & 7, b = sg >> 2, h = sg & 3; const size_t rb = (size_t)b * SEQ;
            const attn_body::bf16* Pb = (const attn_body::bf16*)P + rb * PS; unsigned char* Ob = (unsigned char*)BR + rb * DM;
#pragma unroll 1
            for (int k = 0; k < ((REP_PHASE) == 31 ? 4 : 2); ++k) { const int qb = (k & 1) == 0 ? 15 - s : s;
                attn_body::attn_unit<64, false>(qb * 256, Pb + C_FQ + h * 64, Pb + C_FK + h * 64, Pb + C_FV + h * 64, (attn_body::bf16*)(Ob + 256 + h * 64), BIAS2 + (size_t)(b * 4 + h) * SEQ, 0.f, nullptr, (char*)lds + RING_OFF, F0.wave); }
            const float slope2 = exp2f(-2.f * (float)(h + 1)) * LOG2E;
#pragma unroll 1
            for (int k = 0; k < ((REP_PHASE) == 32 ? 4 : 2); ++k) { const int qb = (k & 1) == 0 ? 15 - s : s;
                attn_body::attn_unit<64, true>(qb * 256, Pb + C_DQ + h * 64, Pb + C_DK, Pb + C_DV, (attn_body::bf16*)(Ob + 512 + h * 64), nullptr, slope2, SELW + (size_t)b * 64 * SEQ, (char*)lds + RING_OFF, F0.wave); }
        }
        SEAM(pb + 2);
        for (int rep_ = 0; rep_ < NREP(4); ++rep_) if (EN(4) && IN(pb + 3)) { SchedC S; S.T.init(NTOK / 256, DM / 128, F.G, opaque_s((int)blockIdx.x)); S.HBp = (const char*)(F.ws + WS_HB8); S.BRp = (const char*)BR; S.WGp = (const char*)(W + W_GT / 2); S.WBp = (const char*)(W + W_BR / 2); S.collapse = ((REP_PHASE) == 61 && rep_ == 0 && args.ph_hi != 7777);
            EpiC E; E.dry = (((REP_PHASE) == 60 || (REP_PHASE) == 61) && rep_ == 0 && args.ph_hi != 7777); E.MIX = MIX; E.bgate = args.in[5] + (size_t)l * 4 * DM; pg8::gemm_phase_c8<EpiC, SchedC>(F.lds + RING_OFF, F0.wave, S, E); }
        SEAM(pb + 3);
        for (int rep_ = 0; rep_ < NREP(5); ++rep_) if (EN(5) && IN(pb + 4)) { SchedC2 S; S.T.init(NTOK / 256, DM / 256, F.G, opaque_s((int)blockIdx.x)); S.A = (const char*)MIX; S.B = (const char*)(W + W_OUT / 2);
            EpiRes E{BR  , HB, DRY(5)}; pg8::gemm_phase<EpiRes, SchedC2, false>(F.lds + RING_OFF, (LAS unsigned*)(F.lds + LDSCTL_OFF + 1024), F0.wave, S, E); }
        SEAM(pb + 4);
        for (int rep_ = 0; rep_ < NREP(6); ++rep_) if (EN(6) && IN(pb + 5)) { FRESH(Fp); PROBE_BEGIN(21); ln1_router_phase(Fp, args, l, DRY(6)); PROBE_END(21); }
        SEAM(pb + 5);
        for (int rep_ = 0; rep_ < NREP(7); ++rep_) if (EN(7) && IN(pb + 6)) { moe_table(F, l, TAB);
            SchedD1 S{TAB, F.G, opaque_s((int)blockIdx.x), (const char*)(F.ws + WS_HB8), (const char*)(W + W_GU / 2), (const int*)(F.ws + WS_LIST)};
            EpiD1 E{(unsigned char*)ACT, (const float*)(F.ws + WS_GWL)}; pg8::gemm_phase<EpiD1, SchedD1, true>(F.lds + RING_OFF, (LAS unsigned*)(F.lds + LDSCTL_OFF + 1024), F0.wave, S, E); }
        SEAM(pb + 6);
        for (int rep_ = 0; rep_ < NREP(8); ++rep_) if (EN(8) && IN(pb + 7)) { moe_table(F, l, TAB);
            SchedD2 S{TAB, F.G, opaque_s((int)blockIdx.x), (const char*)ACT, (const char*)(W + W_D / 2), (const int*)(F.ws + WS_LIST)};
            EpiD2 E{wsb(F, WS_R1), HB, DRY(8)}; pg8::gemm_phase<EpiD2, SchedD2, false>(F.lds + RING_OFF, (LAS unsigned*)(F.lds + LDSCTL_OFF + 1024), F0.wave, S, E); }
        SEAM(pb + 7);
        for (int rep_ = 0; rep_ < NREP(9); ++rep_) if (EN(9) && IN(pb + 8)) { FRESH(Fp); PROBE_BEGIN(22); ln2_phase(Fp, args, l, DRY(9)); PROBE_END(22); }
        SEAM(pb + 8);
#undef l
#undef W
    }
#undef IN
#undef SEAM
    if ((REP_PHASE) >= 100 && blockIdx.x == 0 && F0.wave == 0 && lane_id_() == 0) { volatile LAS unsigned* PRB = (volatile LAS unsigned*)(F0.lds + LDSCTL_OFF + 512); const unsigned long long a_ = (((unsigned long long)PRB[1]) << 32) | PRB[0];
        const unsigned long long t0_ = __builtin_amdgcn_s_memrealtime(); while (__builtin_amdgcn_s_memrealtime() - t0_ < a_) __builtin_amdgcn_s_sleep(8); }
}

extern "C" void kernel_launch(void* const* d_in, const int* in_sizes, int n_in, void* d_out, int out_size, void* d_ws, size_t ws_size, hipStream_t stream) {
    static int grid = 0;
    if (grid == 0) {
        if (n_in != 25 || in_sizes[0] != NTOK * DM || out_size != NTOK * DM || ws_size < WS_END) { fprintf(stderr, "kernel_launch: unexpected shapes (n_in %d, in0 %d, out %d, ws %zu); nothing launched\n", n_in, n_in > 0 ? in_sizes[0] : -1, out_size, ws_size); grid = -1; return; }
        int dev = 0, cus = 0, per_cu = 0;
        if (hipGetDevice(&dev) != hipSuccess || hipDeviceGetAttribute(&cus, hipDeviceAttributeMultiprocessorCount, dev) != hipSuccess) { grid = -1; return; }
        if (hipFuncSetAttribute((const void*)fwd_kernel, hipFuncAttributeMaxDynamicSharedMemorySize, LDS_BYTES) != hipSuccess) { fprintf(stderr, "kernel_launch: hipFuncSetAttribute failed\n"); grid = -1; return; }
        if (hipOccupancyMaxActiveBlocksPerMultiprocessor(&per_cu, (const void*)fwd_kernel, NWAVES * 64, LDS_BYTES) != hipSuccess || per_cu < 1) fprintf(stderr, "kernel_launch: occupancy query reports %d\n", per_cu);
        (void)hipGetLastError();
        grid = cus;
        if (grid != 256) { fprintf(stderr, "kernel_launch: built for 256 CUs, device has %d; nothing launched\n", cus); grid = -1; return; }
    }
    if (grid < 0) return;
    static_assert((CW_BAR + XCD_BAR_WORDS) * 4 <= CW_CNT * 4 && (CW_CNT + DEPTH * NCLS * 64) * 4 <= 77824 && CTL_ZERO_BYTES >= 77824, "control words");
    if (hipMemsetAsync((char*)d_ws + WS_CTL + (size_t)CW_BAR * 4, 0, 77824 - (size_t)CW_BAR * 4, stream) != hipSuccess) return;
    Args a{};
    for (int i = 0; i < 25; ++i) a.in[i] = (const float*)d_in[i];
    a.out = (float*)d_out; a.ws = (unsigned char*)d_ws;
#if MK_PER_PHASE
    for (int p = 0; p < N_PHASES; ++p) { a.ph_lo = p; a.ph_hi = p + 1; hipLaunchKernelGGL(fwd_kernel, dim3(grid), dim3(NWAVES * 64), LDS_BYTES, stream, a); }
#else
    a.ph_lo = 0; a.ph_hi = N_PHASES;
    hipLaunchKernelGGL(fwd_kernel, dim3(grid), dim3(NWAVES * 64), LDS_BYTES, stream, a);
#endif
}
```
